# Optimizing an MI355X kernel written in HIP

```python
import jax, jax.numpy as jnp
from jax import lax
import numpy as np

D_MODEL = 1024
BATCH = 2
SEQ = 8192
DEPTH = 2

BLOCK = 128
NORM_EPS = 1e-6
SWA_WINDOW = 128
SWA_HEADS = 4
SWA_KV_HEADS = 2
SWA_HEAD_DIM = 64
CONV_WIDTH = 256
CONV_K = 3
MLA_HEADS = 4
MLA_Q_RANK = 256
MLA_KV_RANK = 128
MLA_NOPE_DIM = 64
MLA_ROPE_DIM = 32
MLA_V_DIM = 64
ROPE_THETA = 10000.0
SB_HEADS = 4
SB_HEAD_DIM = 64
GROUP_WIDTH = 256
N_GROUPS = 4
D_MIX = GROUP_WIDTH * N_GROUPS

A_Q = SWA_HEADS * SWA_HEAD_DIM
A_KV = SWA_KV_HEADS * SWA_HEAD_DIM
SB_W = SB_HEADS * SB_HEAD_DIM
IN_SIZES = (A_Q, A_KV, A_KV,
            CONV_WIDTH, CONV_WIDTH, CONV_WIDTH,
            MLA_Q_RANK, MLA_KV_RANK, MLA_ROPE_DIM,
            SB_W, SB_W, SB_W,
            D_MIX)
D_IN = int(sum(IN_SIZES))
SPLIT_IDX = [int(v) for v in np.cumsum(IN_SIZES)[:-1]]

kernel_name = "hymba_style_four_group_hybrid"


def rmsnorm(x, g):
    x32 = x.astype(jnp.float32)
    y = x32 * lax.rsqrt(jnp.mean(x32 * x32, axis=-1, keepdims=True) + NORM_EPS)
    return (y * g.astype(jnp.float32)).astype(x.dtype)


def to_blocks(t):
    b, s = t.shape[:2]
    t = t.reshape((b, s // BLOCK, BLOCK) + t.shape[2:])
    return jnp.moveaxis(t, 1, 0)


def from_blocks(t):
    t = jnp.moveaxis(t, 0, 1)
    return t.reshape((t.shape[0], t.shape[1] * t.shape[2]) + t.shape[3:])


def rope(x, pos):
    half = x.shape[-1] // 2
    freqs = ROPE_THETA ** (-jnp.arange(half, dtype=jnp.float32) / half)
    ang = pos.astype(jnp.float32)[..., None] * freqs
    ang = ang.reshape(ang.shape[:2] + (1,) * (x.ndim - 3) + (half,))
    cos, sin = jnp.cos(ang), jnp.sin(ang)
    x32 = x.astype(jnp.float32)
    x1, x2 = x32[..., :half], x32[..., half:]
    return jnp.concatenate([x1 * cos - x2 * sin, x1 * sin + x2 * cos], axis=-1).astype(x.dtype)


def swa_sink_attention(q, k, v, sinks):
    b, s, h, d = q.shape
    kvh = k.shape[2]
    g = h // kvh
    nb = s // BLOCK
    qb = q.reshape(b, nb, BLOCK, kvh, g, d).astype(jnp.float32)
    kb = k.reshape(b, nb, BLOCK, kvh, d).astype(jnp.float32)
    vb = v.reshape(b, nb, BLOCK, kvh, d).astype(jnp.float32)
    prev = lambda t: jnp.concatenate([jnp.zeros_like(t[:, :1]), t[:, :-1]], axis=1)
    kk = jnp.concatenate([prev(kb), kb], axis=2)
    vv = jnp.concatenate([prev(vb), vb], axis=2)
    scores = jnp.einsum('bnqhgd,bnkhd->bnhgqk', qb, kk) * (d ** -0.5)
    qi = jnp.arange(BLOCK)[:, None]
    kj = jnp.arange(2 * BLOCK)[None, :]
    diff = qi + BLOCK - kj
    blk = jnp.arange(nb)[:, None, None]
    valid = (diff >= 0) & (diff < SWA_WINDOW) & (blk * BLOCK + kj - BLOCK >= 0)
    scores = jnp.where(valid[None, :, None, None], scores, -jnp.inf)
    sink = jnp.broadcast_to(sinks.astype(jnp.float32).reshape(1, 1, kvh, g, 1, 1), scores.shape[:-1] + (1,))
    probs = jax.nn.softmax(jnp.concatenate([scores, sink], axis=-1), axis=-1)[..., :-1]
    out = jnp.einsum('bnhgqk,bnkhd->bnqhgd', probs, vv)
    return out.reshape(b, s, h * d).astype(q.dtype)


def short_gated_conv(bg, cg, xin, conv_w, conv_b):
    u = cg * xin
    y = lax.conv_general_dilated(u, conv_w[:, None, :], window_strides=(1,),
                                 padding=[(CONV_K - 1, 0)],
                                 dimension_numbers=('NWC', 'WIO', 'NWC'),
                                 feature_group_count=u.shape[-1])
    return bg * (y + conv_b)


def causal_softmax_attention(q, k, v):
    b, s, h, dk = q.shape
    scale = dk ** -0.5
    kf = k.astype(jnp.float32)
    vf = v.astype(jnp.float32)
    kpos = jnp.arange(s)

    def step(args):
        qblk, i = args
        sc = jnp.einsum('bqhd,bkhd->bhqk', qblk.astype(jnp.float32), kf) * scale
        qpos = i * BLOCK + jnp.arange(BLOCK)
        sc = jnp.where(kpos[None, :] <= qpos[:, None], sc, -jnp.inf)
        p = jax.nn.softmax(sc, axis=-1)
        return jnp.einsum('bhqk,bkhd->bqhd', p, vf)

    out = lax.map(step, (to_blocks(q), jnp.arange(s // BLOCK)))
    return from_blocks(out).reshape(b, s, -1).astype(q.dtype)


def mla(cq, ckv, kr, pos, g_q, w_uq, g_kv, w_ukv):
    b, s, _ = cq.shape
    q = (rmsnorm(cq, g_q) @ w_uq).reshape(b, s, MLA_HEADS, MLA_NOPE_DIM + MLA_ROPE_DIM)
    q = jnp.concatenate([q[..., :MLA_NOPE_DIM], rope(q[..., MLA_NOPE_DIM:], pos)], axis=-1)
    kv = (rmsnorm(ckv, g_kv) @ w_ukv).reshape(b, s, MLA_HEADS, MLA_NOPE_DIM + MLA_V_DIM)
    k_nope, v = kv[..., :MLA_NOPE_DIM], kv[..., MLA_NOPE_DIM:]
    k_rope = jnp.broadcast_to(rope(kr, pos)[:, :, None, :], (b, s, MLA_HEADS, MLA_ROPE_DIM))
    k = jnp.concatenate([k_nope, k_rope], axis=-1)
    return causal_softmax_attention(q, k, v)


def stick_breaking_attention(q, k, v):
    b, s, h, d = q.shape
    scale = d ** -0.5
    kf = k.astype(jnp.float32)
    vf = v.astype(jnp.float32)
    kpos = jnp.arange(s)

    def step(args):
        qblk, i = args
        z = jnp.einsum('bqhd,bkhd->bhqk', qblk.astype(jnp.float32), kf) * scale
        qpos = i * BLOCK + jnp.arange(BLOCK)
        mask = kpos[None, :] < qpos[:, None]
        log_keep = jnp.where(mask, jax.nn.log_sigmoid(-z), 0.0)
        after = lax.cumsum(log_keep, axis=3, reverse=True) - log_keep
        a = jnp.where(mask, jnp.exp(jax.nn.log_sigmoid(z) + after), 0.0)
        return jnp.einsum('bhqk,bkhd->bqhd', a, vf)

    out = lax.map(step, (to_blocks(q), jnp.arange(s // BLOCK)))
    return from_blocks(out).reshape(b, s, -1).astype(q.dtype)


def hybrid_layer(x, pos, g_pre, w_in, sinks, conv_w, conv_b, g_cq, w_uq, g_ckv, w_ukv, g_grp, w_out, g_post):
    b, s, _ = x.shape
    h = rmsnorm(x, g_pre) @ w_in
    (a_q, a_k, a_v, b_b, b_c, b_x, c_q, c_kv, c_kr, d_q, d_k, d_v, gate) = jnp.split(h, SPLIT_IDX, axis=-1)
    ya = swa_sink_attention(a_q.reshape(b, s, SWA_HEADS, SWA_HEAD_DIM),
                            a_k.reshape(b, s, SWA_KV_HEADS, SWA_HEAD_DIM),
                            a_v.reshape(b, s, SWA_KV_HEADS, SWA_HEAD_DIM), sinks)
    yb = short_gated_conv(b_b, b_c, b_x, conv_w, conv_b)
    yc = mla(c_q, c_kv, c_kr, pos, g_cq, w_uq, g_ckv, w_ukv)
    yd = stick_breaking_attention(d_q.reshape(b, s, SB_HEADS, SB_HEAD_DIM),
                                  d_k.reshape(b, s, SB_HEADS, SB_HEAD_DIM),
                                  d_v.reshape(b, s, SB_HEADS, SB_HEAD_DIM))
    y = jnp.stack([ya, yb, yc, yd], axis=2)
    y = rmsnorm(y, g_grp.reshape(N_GROUPS, GROUP_WIDTH)).reshape(b, s, D_MIX)
    y = y * jax.nn.silu(gate)
    return x + rmsnorm(y @ w_out, g_post)


def setup_inputs(seed: int = 0) -> dict:
    key = jax.random.key(seed)
    ks = jax.random.split(key, 16)
    f32 = jnp.float32
    nrm = lambda k, shape, scale: jax.random.normal(k, shape, f32) * scale
    gain = lambda k, shape: 1.0 + 0.02 * jax.random.normal(k, shape, f32)
    x = jax.random.normal(ks[0], (BATCH, SEQ, D_MODEL), f32)
    positions = jnp.broadcast_to(jnp.arange(SEQ, dtype=jnp.int32)[None, :], (BATCH, SEQ))
    return {
        "x": x,
        "positions": positions,
        "norm_pre": gain(ks[1], (DEPTH, D_MODEL)),
        "w_in": nrm(ks[2], (DEPTH, D_MODEL, D_IN), D_MODEL ** -0.5),
        "attn_sinks": nrm(ks[3], (DEPTH, SWA_HEADS), 0.5),
        "conv_w": nrm(ks[4], (DEPTH, CONV_K, CONV_WIDTH), CONV_K ** -0.5),
        "conv_b": nrm(ks[5], (DEPTH, CONV_WIDTH), 0.01),
        "mla_q_norm": gain(ks[6], (DEPTH, MLA_Q_RANK)),
        "mla_w_uq": nrm(ks[7], (DEPTH, MLA_Q_RANK, MLA_HEADS * (MLA_NOPE_DIM + MLA_ROPE_DIM)), MLA_Q_RANK ** -0.5),
        "mla_kv_norm": gain(ks[8], (DEPTH, MLA_KV_RANK)),
        "mla_w_ukv": nrm(ks[9], (DEPTH, MLA_KV_RANK, MLA_HEADS * (MLA_NOPE_DIM + MLA_V_DIM)), MLA_KV_RANK ** -0.5),
        "group_norm": gain(ks[10], (DEPTH, D_MIX)),
        "w_out": nrm(ks[11], (DEPTH, D_MIX, D_MODEL), D_MIX ** -0.5),
        "norm_post": gain(ks[12], (DEPTH, D_MODEL)),
    }


def reference(x, positions, norm_pre, w_in, attn_sinks, conv_w, conv_b, mla_q_norm, mla_w_uq,
              mla_kv_norm, mla_w_ukv, group_norm, w_out, norm_post):
    for l in range(DEPTH):
        x = hybrid_layer(x, positions, norm_pre[l], w_in[l], attn_sinks[l], conv_w[l], conv_b[l],
                         mla_q_norm[l], mla_w_uq[l], mla_kv_norm[l], mla_w_ukv[l],
                         group_norm[l], w_out[l], norm_post[l])
    return x
```

```cpp
#include <hip/hip_runtime.h>
#include <hip/hip_cooperative_groups.h>
#include <cstdio>
#include <cstdint>
#include <cmath>
namespace pg8 {
#define PG8_LAS __attribute__((address_space(3)))
typedef unsigned short bf16_t;
typedef short bf16x8 __attribute__((ext_vector_type(8)));
typedef float f32x4 __attribute__((ext_vector_type(4)));
typedef unsigned u32x4 __attribute__((ext_vector_type(4)));
constexpr int BM = 256, BK = 64, HALF = 128, HTB = HALF * BK * 2  , STAGE_BYTES = 8 * HTB, NXCD = 8, WGM = 8;

__host__ __device__ __forceinline__ int lds_byte(int r, int c) { const int st = (r >> 4) * 2 + (c >> 5), rr = r & 15, cc = c & 31, ob = rr * 64 + cc * 2; return st * 1024 + (ob ^ (((ob >> 9) & 1) << 5)); }
__host__ __device__ __forceinline__ void stage_rc(int b, int& R, int& C) { const int st = b / 1024, sb = b % 1024, swz = sb ^ (((sb >> 9) & 1) << 5); R = (st >> 1) * 16 + swz / 64; C = (st & 1) * 32 + (swz % 64) / 2; }
__host__ __device__ __forceinline__ int perm32(int rho) { const int n = rho >> 4, i = rho & 15; return 8 * (i >> 2) + 4 * n + (i & 3); }

struct Unit { int pm, pn; };
struct Gemm { const bf16_t* A; const bf16_t* Bt; int M, N, K; };

struct StaticOrder {
    int nM, nN, nwg, G, c;
    __host__ __device__ void init(int M, int N, int G_, int c_) { nM = M / BM; nN = N / BM; nwg = nM * nN; G = G_; c = c_; }
    __host__ __device__ bool next(int i, Unit& u) const {
        const long L = (long)i * G + c; if (L >= nwg) return false;
        int wgid = (int)L; { const int q = nwg / NXCD, r = nwg % NXCD, xcd = wgid % NXCD, off = wgid / NXCD; wgid = (xcd < r ? xcd * (q + 1) : r * (q + 1) + (xcd - r) * q) + off; }
        const int nig = WGM * nN, gid = wgid / nig, fm = gid * WGM, gsz = (nM - fm) < WGM ? (nM - fm) : WGM;
        u.pm = fm + ((wgid % nig) % gsz); u.pn = (wgid % nig) / gsz; return true;
    }
    __device__ __forceinline__ void a_ready(const Unit&) const {}
    __device__ __forceinline__ void done(const Unit&) const {}
};

__device__ __forceinline__ unsigned cvt_pk_bf16(float lo, float hi) { unsigned r; asm volatile("v_cvt_pk_bf16_f32 %0, %1, %2" : "=v"(r) : "v"(lo), "v"(hi)); return r; }
typedef float f32x2 __attribute__((ext_vector_type(2)));
__device__ __forceinline__ f32x2 gelu_pk(f32x2 v) {
    const f32x2 av = __builtin_elementwise_abs(v), d = av * 0.2316418882f + 1.0f;
    f32x2 t; t.x = __builtin_amdgcn_rcpf(d.x); t.y = __builtin_amdgcn_rcpf(d.y);
    f32x2 q = t * 0.5307027145f + (-0.7265760135f); q = q * t + 0.7107068705f; q = q * t + (-0.142248368f); q = q * t + 0.127414796f; q = q * t;
    const f32x2 s = (v * v) * (-0.72134752044f);
    f32x2 e; e.x = __builtin_amdgcn_exp2f(s.x); e.y = __builtin_amdgcn_exp2f(s.y);
    const f32x2 m = v * (q * e), r = v - m;
    f32x2 o; o.x = v.x < 0.f ? m.x : r.x; o.y = v.y < 0.f ? m.y : r.y; return o;
}

template <int ACT  > struct EpiBf16 {
    static constexpr bool PERM = true, AFTER_DRAIN = false; static_assert(ACT == 0 || ACT == 1, "EpiBf16: ACT is 0 (none) or 1 (gelu_pk)");
    bf16_t* O; int ldc; const float* bias; int split_cols; size_t split_stride; float scale0;
    __device__ __forceinline__ void operator()(const f32x4 (&acc)[2][2][4][2], const Unit& u, int wr, int wc, int fr, int fq) const {
        const int row0 = u.pm * BM + wr * 64 + fr; int colt = u.pn * BM; bf16_t* base = O;
        float sc = 1.f; if (split_cols) { const int t = colt / split_cols; base += (size_t)t * split_stride; colt -= t * split_cols; if (t == 0) sc = scale0; }
        const int col0 = colt + wc * 32 + 8 * fq, bcol0 = u.pn * BM + wc * 32 + 8 * fq;
        f32x4 bv[2][2];
#pragma unroll
        for (int bj = 0; bj < 2; ++bj)
#pragma unroll
            for (int n = 0; n < 2; ++n) bv[bj][n] = bias ? *(const f32x4*)(bias + bcol0 + bj * HALF + 4 * n) : (f32x4){0.f, 0.f, 0.f, 0.f};
#pragma unroll
        for (int ai = 0; ai < 2; ++ai)
#pragma unroll
            for (int m = 0; m < 4; ++m) { bf16_t* rowp = base + (size_t)(row0 + ai * HALF + m * 16) * ldc + col0;
#pragma unroll
                for (int bj = 0; bj < 2; ++bj) { f32x4 v0 = acc[ai][bj][m][0] + bv[bj][0], v1 = acc[ai][bj][m][1] + bv[bj][1];
                    if (ACT == 1) { f32x2 a = gelu_pk((f32x2){v0[0], v0[1]}), b = gelu_pk((f32x2){v0[2], v0[3]}), c = gelu_pk((f32x2){v1[0], v1[1]}), d = gelu_pk((f32x2){v1[2], v1[3]});
                        v0 = (f32x4){a.x, a.y, b.x, b.y}; v1 = (f32x4){c.x, c.y, d.x, d.y}; }
                    v0 = v0 * sc; v1 = v1 * sc; u32x4 w; w.x = cvt_pk_bf16(v0[0], v0[1]); w.y = cvt_pk_bf16(v0[2], v0[3]); w.z = cvt_pk_bf16(v1[0], v1[1]); w.w = cvt_pk_bf16(v1[2], v1[3]);
                    *(u32x4*)(rowp + bj * HALF) = w; } }
    }
};
template <class Epi, class Sched, bool ALIGN_EPI = false, bool SP2 = false>
__device__ __forceinline__ void gemm_phase(PG8_LAS unsigned char* lds, const Gemm g, const Sched& S, const Epi& E) {
    int tid_o = threadIdx.x; asm volatile("" : "+v"(tid_o));
    const int tid = tid_o, wid = __builtin_amdgcn_readfirstlane(tid >> 6), lane = tid & 63, wr = wid >> 2, wc = wid & 3, fr = lane & 15, fq = lane >> 4;
    const int K = g.K, nt = K / BK;
    unsigned voffA[2], voffB[2];
#pragma unroll
    for (int i = 0; i < 2; ++i) { int R, C; stage_rc(tid * 16 + i * 8192, R, C); const int Rb = Epi::PERM ? ((R & ~31) + perm32(R & 31)) : R;
        voffA[i] = (unsigned)(R * K + C) * 2u; voffB[i] = (unsigned)(Rb * K + C) * 2u; }
    const size_t kstep = (size_t)(BK * 2);
    const size_t hstep = (size_t)HALF * K * 2;
    const size_t tstep = 2 * hstep;
    const unsigned ldsw = (unsigned)wid * 1024u;
    const int aoff = lds_byte(wr * 64 + fr, fq * 8), boff = lds_byte(wc * 32 + fr, fq * 8);
#define PG8_SA(b, h) (((b) * 2 + (h)) * HTB)
#define PG8_SB(b, h) ((4 + (b) * 2 + (h)) * HTB)
#define PG8_STAGE(bufoff, gbase, voff) do { _Pragma("unroll") for (int _i = 0; _i < 2; ++_i) \
        __builtin_amdgcn_global_load_lds((const unsigned*)((const char*)(gbase) + (voff)[_i]), (PG8_LAS unsigned*)(lds + (bufoff) + ldsw + _i * 8192), 16, 0, 0); } while (0)
#define PG8_LDA(dst, b, h) do { _Pragma("unroll") for (int m = 0; m < 4; ++m) _Pragma("unroll") for (int k = 0; k < 2; ++k) dst[m][k] = *(const PG8_LAS bf16x8*)(lds + PG8_SA(b, h) + aoff + m * 2048 + k * 1024); } while (0)
#define PG8_LDB(dst, b, h) do { _Pragma("unroll") for (int n = 0; n < 2; ++n) _Pragma("unroll") for (int k = 0; k < 2; ++k) dst[n][k] = *(const PG8_LAS bf16x8*)(lds + PG8_SB(b, h) + boff + n * 2048 + k * 1024); } while (0)
#define PG8_MMA(ai, bj, At, Bt) do { __builtin_amdgcn_s_setprio(1); _Pragma("unroll") for (int m = 0; m < 4; ++m) _Pragma("unroll") for (int n = 0; n < 2; ++n) _Pragma("unroll") for (int k = 0; k < 2; ++k) \
        acc[ai][bj][m][n] = __builtin_amdgcn_mfma_f32_16x16x32_bf16(Bt[n][k], At[m][k], acc[ai][bj][m][n], 0, 0, 0); __builtin_amdgcn_s_setprio(0); } while (0)
#define PG8_WAIT_V(n) asm volatile("s_waitcnt vmcnt(" #n ")" ::: "memory")
#define PG8_WAIT_L(n) asm volatile("s_waitcnt lgkmcnt(" #n ")" ::: "memory")
#define PG8_BAR __builtin_amdgcn_s_barrier()
#define PG8_SCHED __builtin_amdgcn_sched_barrier(0)
    Unit cur, nxt; int ui = 0;
    if (!S.next(0, cur)) return;
    f32x4 acc[2][2][4][2];
#pragma unroll
    for (int a = 0; a < 2; ++a)
#pragma unroll
        for (int b = 0; b < 2; ++b)
#pragma unroll
            for (int m = 0; m < 4; ++m)
#pragma unroll
                for (int n = 0; n < 2; ++n) acc[a][b][m][n] = (f32x4){0.f, 0.f, 0.f, 0.f};
    bf16x8 At[4][2], B0[2][2], B1[2][2];
    const char* cA = (const char*)g.A + (size_t)cur.pm * tstep; const char* cB = (const char*)g.Bt + (size_t)cur.pn * tstep;
    S.a_ready(cur);
    if constexpr (SP2) {
        PG8_STAGE(PG8_SB(0, 0), cB, voffB); PG8_STAGE(PG8_SB(0, 1), cB + hstep, voffB); PG8_STAGE(PG8_SA(0, 0), cA, voffA); PG8_STAGE(PG8_SA(0, 1), cA + hstep, voffA);
        if (wr == 1) PG8_BAR;
        PG8_WAIT_V(2); PG8_BAR;
        PG8_STAGE(PG8_SB(1, 0), cB + kstep, voffB); PG8_STAGE(PG8_SA(1, 0), cA + kstep, voffA); PG8_STAGE(PG8_SB(1, 1), cB + hstep + kstep, voffB);
        PG8_WAIT_V(6); PG8_BAR;
    } else {
        PG8_STAGE(PG8_SB(0, 0), cB, voffB); PG8_STAGE(PG8_SA(0, 0), cA, voffA); PG8_STAGE(PG8_SB(0, 1), cB + hstep, voffB); PG8_STAGE(PG8_SA(0, 1), cA + hstep, voffA);
        if (wr == 1) PG8_BAR;
        PG8_WAIT_V(4); PG8_BAR;
        PG8_STAGE(PG8_SB(1, 0), cB + kstep, voffB); PG8_STAGE(PG8_SA(1, 0), cA + kstep, voffA); PG8_STAGE(PG8_SB(1, 1), cB + hstep + kstep, voffB);
        PG8_WAIT_V(6); PG8_BAR;
    }
    for (;;) {
        const bool has_next = S.next(ui + 1, nxt);
        const char* nA = has_next ? (const char*)g.A + (size_t)nxt.pm * tstep : cA; const char* nB = has_next ? (const char*)g.Bt + (size_t)nxt.pn * tstep : cB;
        for (int t = 0; t < nt; t += 2) {
            const bool last = (t == nt - 2);
            const char* a1 = cA + (size_t)(t + 1) * kstep;
            const char* a2 = last ? nA : cA + (size_t)(t + 2) * kstep; const char* b2 = last ? nB : cB + (size_t)(t + 2) * kstep;
            const char* a3 = a2 + kstep; const char* b3 = b2 + kstep;
            if (last && has_next) S.a_ready(nxt);
            if constexpr (SP2) {
            PG8_LDB(B0, 0, 0); PG8_LDB(B1, 0, 1); PG8_SCHED; PG8_LDA(At, 0, 0); PG8_STAGE(PG8_SA(1, 1), a1 + hstep, voffA);
            PG8_WAIT_V(8); PG8_WAIT_L(0); PG8_BAR; PG8_MMA(0, 0, At, B0); PG8_MMA(0, 1, At, B1); PG8_BAR; PG8_SCHED;
            PG8_LDA(At, 0, 1); PG8_STAGE(PG8_SB(0, 0), b2, voffB); PG8_STAGE(PG8_SB(0, 1), b2 + hstep, voffB); PG8_STAGE(PG8_SA(0, 0), a2, voffA);
            PG8_WAIT_V(8); PG8_WAIT_L(0); PG8_BAR; PG8_MMA(1, 0, At, B0); PG8_MMA(1, 1, At, B1); PG8_BAR; PG8_SCHED;
            PG8_LDB(B0, 1, 0); PG8_LDB(B1, 1, 1); PG8_SCHED; PG8_LDA(At, 1, 0); PG8_STAGE(PG8_SA(0, 1), a2 + hstep, voffA);
            PG8_WAIT_V(8); PG8_WAIT_L(0); PG8_BAR; PG8_MMA(0, 0, At, B0); PG8_MMA(0, 1, At, B1); PG8_BAR; PG8_SCHED;
            PG8_LDA(At, 1, 1); PG8_STAGE(PG8_SB(1, 0), b3, voffB); PG8_STAGE(PG8_SB(1, 1), b3 + hstep, voffB); PG8_STAGE(PG8_SA(1, 0), a3, voffA);
            PG8_WAIT_V(8); PG8_WAIT_L(0); PG8_BAR; PG8_MMA(1, 0, At, B0); PG8_MMA(1, 1, At, B1); PG8_BAR; PG8_SCHED;
            } else {
            PG8_LDB(B0, 0, 0); PG8_SCHED; PG8_LDA(At, 0, 0); PG8_STAGE(PG8_SA(1, 1), a1 + hstep, voffA);
            PG8_WAIT_L(8); PG8_BAR; PG8_WAIT_L(0); PG8_MMA(0, 0, At, B0); PG8_BAR; PG8_SCHED;
            PG8_LDB(B1, 0, 1); PG8_STAGE(PG8_SB(0, 0), b2, voffB);
            PG8_BAR; PG8_WAIT_L(0); PG8_MMA(0, 1, At, B1); PG8_BAR;
            PG8_LDA(At, 0, 1); PG8_STAGE(PG8_SA(0, 0), a2, voffA);
            PG8_BAR; PG8_WAIT_L(0); PG8_MMA(1, 0, At, B0); PG8_BAR; PG8_SCHED;
            PG8_STAGE(PG8_SB(0, 1), b2 + hstep, voffB);
            PG8_WAIT_V(6); PG8_BAR; PG8_MMA(1, 1, At, B1); PG8_BAR;
            PG8_LDB(B0, 1, 0); PG8_SCHED; PG8_LDA(At, 1, 0); PG8_STAGE(PG8_SA(0, 1), a2 + hstep, voffA);
            PG8_WAIT_L(8); PG8_BAR; PG8_WAIT_L(0); PG8_MMA(0, 0, At, B0); PG8_BAR; PG8_SCHED;
            PG8_LDB(B1, 1, 1); PG8_STAGE(PG8_SB(1, 0), b3, voffB);
            PG8_BAR; PG8_WAIT_L(0); PG8_MMA(0, 1, At, B1); PG8_BAR;
            PG8_LDA(At, 1, 1); PG8_STAGE(PG8_SA(1, 0), a3, voffA);
            PG8_BAR; PG8_WAIT_L(0); PG8_MMA(1, 0, At, B0); PG8_BAR; PG8_SCHED;
            PG8_STAGE(PG8_SB(1, 1), b3 + hstep, voffB);
            PG8_WAIT_V(6); PG8_BAR; PG8_MMA(1, 1, At, B1); PG8_BAR;
            }
        }
        if constexpr (ALIGN_EPI) { if (wr == 0) PG8_BAR; }
        if constexpr (!Epi::AFTER_DRAIN) { E(acc, cur, wr, wc, fr, fq); S.done(cur); }
        if (!has_next) break;
#pragma unroll
        for (int a = 0; a < 2; ++a)
#pragma unroll
            for (int b = 0; b < 2; ++b)
#pragma unroll
                for (int m = 0; m < 4; ++m)
#pragma unroll
                    for (int n = 0; n < 2; ++n) acc[a][b][m][n] = (f32x4){0.f, 0.f, 0.f, 0.f};
        cur = nxt; cA = nA; cB = nB; ++ui;
        if constexpr (ALIGN_EPI) { if (wr == 1) PG8_BAR; }
    }
    PG8_WAIT_V(0);
    if constexpr (!ALIGN_EPI) { if (wr == 0) PG8_BAR; }
    PG8_BAR;
    if constexpr (Epi::AFTER_DRAIN) { E.fused(acc, cur, wr, wc, fr, fq, lds, wid, lane); S.done(cur); }
#undef PG8_SA
#undef PG8_SB
#undef PG8_STAGE
#undef PG8_LDA
#undef PG8_LDB
#undef PG8_MMA
#undef PG8_WAIT_V
#undef PG8_WAIT_L
#undef PG8_BAR
#undef PG8_SCHED
}
}
#ifndef MK_COOP
#define MK_COOP 1
#endif
namespace mk {
using pg8::bf16_t; using pg8::bf16x8; using pg8::f32x4; using pg8::u32x4;
typedef float f32x16 __attribute__((ext_vector_type(16)));
typedef unsigned u32x2 __attribute__((ext_vector_type(2)));
typedef float f32x2_t __attribute__((ext_vector_type(2)));
typedef __bf16 bf16x2_t __attribute__((ext_vector_type(2)));
#define LAS __attribute__((address_space(3)))
#define MFMA32(a, b, c) __builtin_amdgcn_mfma_f32_32x32x16_bf16((a), (b), (c), 0, 0, 0)

constexpr int M_TOK = 16384, SEQ = 8192, DM = 1024, DIN = 3488, DINP = 3584, NLAYER = 2;
constexpr int C_AQ = 0, C_AK = 256, C_AV = 384, C_BB = 512, C_BC = 768, C_BX = 1024, C_CQ = 1280, C_CKV = 1536, C_CKR = 1664,
              C_DQ = 1696, C_DK = 1952, C_DV = 2208, C_GATE = 2464;
constexpr float EPS = 1e-6f, LOG2E = 1.4426950408889634f;
constexpr float SC64 = 0.125f * LOG2E;
constexpr float QSC_MLA = 0.10206207261596575f * LOG2E;
constexpr int NWAVES = 8, NTHREADS = 512;
constexpr int LDS_BYTES = 131072 + 1024;

constexpr size_t MiB = 1u << 20;
constexpr size_t WS_CTL = 0, CTL_BYTES = 4096;
constexpr size_t WS_WIN = 1 * MiB;
constexpr size_t WS_WOUT = 15 * MiB;
constexpr size_t WS_WUQ = 19 * MiB;
constexpr size_t WS_WUKV = 19 * MiB + 512 * 1024;
constexpr size_t WS_XN = 32 * MiB;
constexpr size_t WS_H = 64 * MiB;
constexpr size_t WS_QC = 176 * MiB;
constexpr size_t WS_KC = 188 * MiB;
constexpr size_t WS_VTC = 200 * MiB;
constexpr size_t WS_VTA = 208 * MiB;
constexpr size_t WS_VTD = 212 * MiB;
constexpr size_t WS_Y = 220 * MiB;
constexpr size_t WS_END = 252 * MiB;

struct Params {
    const float* x; const int* pos; const float* norm_pre; const float* w_in; const float* sinks; const float* conv_w; const float* conv_b;
    const float* g_cq; const float* w_uq; const float* g_ckv; const float* w_ukv; const float* g_grp; const float* w_out; const float* g_post;
    float* out; unsigned char* ws; int ph_lo, ph_hi;
};

__device__ __forceinline__ unsigned pk2(float lo, float hi) { f32x2_t v = {lo, hi}; bf16x2_t b = __builtin_convertvector(v, bf16x2_t); return __builtin_bit_cast(unsigned, b); }
__device__ __forceinline__ float bf2f(short s) { return __uint_as_float(((unsigned)(unsigned short)s) << 16); }
__device__ __forceinline__ float bflo(unsigned u) { return __uint_as_float(u << 16); }
__device__ __forceinline__ float bfhi(unsigned u) { return __uint_as_float(u & 0xffff0000u); }
__device__ __forceinline__ bf16_t f2bf(float f) { return (bf16_t)(pk2(f, 0.f) & 0xffffu); }
__device__ __forceinline__ int crow(int i, int h) { return (i & 3) + 8 * (i >> 2) + 4 * h; }
__device__ __forceinline__ float ex2(float x) { return __builtin_amdgcn_exp2f(x); }
__device__ __forceinline__ float lg2(float x) { return __builtin_amdgcn_logf(x); }
__device__ __forceinline__ float wave_sum(float v) {
#pragma unroll
    for (int o = 1; o < 64; o <<= 1) v += __shfl_xor(v, o);
    return v;
}
__device__ __forceinline__ bf16x8 pack8(const float* e) {
    u32x4 w; w.x = pk2(e[0], e[1]); w.y = pk2(e[2], e[3]); w.z = pk2(e[4], e[5]); w.w = pk2(e[6], e[7]);
    return __builtin_bit_cast(bf16x8, w);
}

__device__ __forceinline__ void conv_wT(const float* __restrict__ W, int K, int N, int NP, const float* __restrict__ gain, bf16_t* __restrict__ dst,
                                        int a0, int a1, int b0, int b1, float sc, int gtid, int gthreads) {
    const int k8n = K / 8; const int items = NP * k8n;
    for (int it = gtid; it < items; it += gthreads) {
        const int n = it % NP, k8 = it / NP;
        u32x4 o = {0u, 0u, 0u, 0u};
        if (n < N) {
            const float cs = ((n >= a0 && n < a1) || (n >= b0 && n < b1)) ? sc : 1.f;
            float v[8];
#pragma unroll
            for (int j = 0; j < 8; ++j) v[j] = W[(size_t)(k8 * 8 + j) * N + n] * gain[k8 * 8 + j] * cs;
            o.x = pk2(v[0], v[1]); o.y = pk2(v[2], v[3]); o.z = pk2(v[4], v[5]); o.w = pk2(v[6], v[7]);
        }
        *(u32x4*)(dst + (size_t)n * K + k8 * 8) = o;
    }
}
__device__ __forceinline__ void rms_row_to_bf16(const float* __restrict__ xrow, bf16_t* __restrict__ orow, int lane) {
    f32x4 v[4]; float s = 0.f;
#pragma unroll
    for (int j = 0; j < 4; ++j) { v[j] = ((const f32x4*)xrow)[lane + 64 * j]; s += (v[j].x * v[j].x + v[j].y * v[j].y) + (v[j].z * v[j].z + v[j].w * v[j].w); }
    const float rs = rsqrtf(wave_sum(s) * (1.f / DM) + EPS);
#pragma unroll
    for (int j = 0; j < 4; ++j) { u32x2 o; o.x = pk2(v[j].x * rs, v[j].y * rs); o.y = pk2(v[j].z * rs, v[j].w * rs); ((u32x2*)orow)[lane + 64 * j] = o; }
}

__device__ __forceinline__ void rope_cs(int pos, int h, float (&cs)[8], float (&sn)[8]) {
#pragma unroll
    for (int i = 0; i < 8; ++i) {
        const int f = (i & 3) + 8 * (i >> 2) + 4 * h;
        const float freq = ex2(-(float)f * 0.830482023721841f);
        const float ang = (float)pos * freq;
        const double rev = (double)ang * 0.15915494309189535;
        const float fr = (float)(rev - __builtin_rint(rev));
        cs[i] = __builtin_amdgcn_cosf(fr); sn[i] = __builtin_amdgcn_sinf(fr);
    }
}
__device__ __forceinline__ void rope_apply(f32x16& a, const float (&cs)[8], const float (&sn)[8]) {
#pragma unroll
    for (int i = 0; i < 8; ++i) { const float x1 = a[i], x2 = a[i + 8]; a[i] = x1 * cs[i] - x2 * sn[i]; a[i + 8] = x1 * sn[i] + x2 * cs[i]; }
}
__device__ __forceinline__ void store_tile_rowmajor(bf16_t* dst  , const f32x16& a, int h) {
#pragma unroll
    for (int g = 0; g < 4; ++g) { u32x2 o; o.x = pk2(a[4 * g], a[4 * g + 1]); o.y = pk2(a[4 * g + 2], a[4 * g + 3]); *(u32x2*)(dst + 8 * g + 4 * h) = o; }
}
__device__ __forceinline__ void mq_unit(const bf16_t* __restrict__ H, const bf16_t* __restrict__ WT, const int* __restrict__ pos, bf16_t* __restrict__ QC, int tb, int hh, int lane) {
    const int r = lane & 31, h = lane >> 5, tok = tb * 32 + r;
    const bf16_t* src = H + (size_t)tok * DINP + C_CQ + 8 * h;
    bf16x8 bfr[16]; float ss = 0.f;
#pragma unroll
    for (int s = 0; s < 16; ++s) { bfr[s] = *(const bf16x8*)(src + 16 * s);
#pragma unroll
        for (int j = 0; j < 8; ++j) { const float v = bf2f(bfr[s][j]); ss += v * v; } }
    ss += __shfl_xor(ss, 32);
    const float rs = rsqrtf(ss * (1.f / 256.f) + EPS) * QSC_MLA;
    float cs[8], sn[8]; rope_cs(pos[tok], h, cs, sn);
    const bf16_t* W = WT + (size_t)(hh * 96 + r) * 256 + 8 * h;
#pragma unroll 1
    for (int nt = 0; nt < 3; ++nt) {
        f32x16 acc;
#pragma unroll
        for (int i = 0; i < 16; ++i) acc[i] = 0.f;
#pragma unroll
        for (int s = 0; s < 16; ++s) { const bf16x8 a = *(const bf16x8*)(W + (size_t)nt * 32 * 256 + 16 * s); acc = MFMA32(a, bfr[s], acc); }
#pragma unroll
        for (int i = 0; i < 16; ++i) acc[i] *= rs;
        if (nt == 2) rope_apply(acc, cs, sn);
        store_tile_rowmajor(QC + (size_t)tok * 384 + hh * 96 + nt * 32, acc, h);
    }
}
__device__ __forceinline__ void vt_flush(LAS bf16_t* stg, bf16_t* __restrict__ dst  , int lane) {
    const LAS u32x4* rp = (const LAS u32x4*)(stg + lane * 32);
    u32x4 w[4];
#pragma unroll
    for (int c = 0; c < 4; ++c) w[c] = rp[c];
    u32x4* gp = (u32x4*)(dst + (size_t)lane * SEQ);
#pragma unroll
    for (int c = 0; c < 4; ++c) gp[c] = w[c];
}
__device__ __forceinline__ void mkv_unit(const bf16_t* __restrict__ H, const bf16_t* __restrict__ WT, const int* __restrict__ pos, bf16_t* __restrict__ KC, bf16_t* __restrict__ VTC, int tb, int hh, int lane, LAS bf16_t* stg) {
    const int r = lane & 31, h = lane >> 5, tok = tb * 32 + r;
    const bf16_t* src = H + (size_t)tok * DINP + C_CKV + 8 * h;
    bf16x8 bfr[8]; float ss = 0.f;
#pragma unroll
    for (int s = 0; s < 8; ++s) { bfr[s] = *(const bf16x8*)(src + 16 * s);
#pragma unroll
        for (int j = 0; j < 8; ++j) { const float v = bf2f(bfr[s][j]); ss += v * v; } }
    ss += __shfl_xor(ss, 32);
    const float rs = rsqrtf(ss * (1.f / 128.f) + EPS);
    const bf16_t* W = WT + (size_t)(hh * 128 + r) * 128 + 8 * h;
    const int b = (tb * 32) / SEQ, t0 = (tb * 32) % SEQ;
#pragma unroll 1
    for (int nt = 0; nt < 4; ++nt) {
        f32x16 acc;
#pragma unroll
        for (int i = 0; i < 16; ++i) acc[i] = 0.f;
#pragma unroll
        for (int s = 0; s < 8; ++s) { const bf16x8 a = *(const bf16x8*)(W + (size_t)nt * 32 * 128 + 16 * s); acc = MFMA32(a, bfr[s], acc); }
#pragma unroll
        for (int i = 0; i < 16; ++i) acc[i] *= rs;
        if (nt < 2) store_tile_rowmajor(KC + (size_t)tok * 384 + hh * 96 + nt * 32, acc, h);
        else {
            LAS bf16_t* sp = stg + ((nt - 2) * 32 + 4 * h) * 32 + r;
#pragma unroll
            for (int i = 0; i < 16; ++i) sp[((i & 3) + 8 * (i >> 2)) * 32] = f2bf(acc[i]);
        }
    }
    vt_flush(stg, VTC + ((size_t)((b * 4 + hh) * 64)) * SEQ + t0, lane);
    f32x16 kr;
    const bf16_t* krp = H + (size_t)tok * DINP + C_CKR + 4 * h;
#pragma unroll
    for (int g = 0; g < 4; ++g) { const u32x2 w = *(const u32x2*)(krp + 8 * g); kr[4 * g] = bflo(w.x); kr[4 * g + 1] = bfhi(w.x); kr[4 * g + 2] = bflo(w.y); kr[4 * g + 3] = bfhi(w.y); }
    float cs[8], sn[8]; rope_cs(pos[tok], h, cs, sn);
    rope_apply(kr, cs, sn);
    store_tile_rowmajor(KC + (size_t)tok * 384 + hh * 96 + 64, kr, h);
}
__device__ __forceinline__ void vt_unit(const bf16_t* __restrict__ H, int col0, int NH, bf16_t* __restrict__ VT, int tb, int head, int lane, LAS bf16_t* stg) {
    const int r = lane & 31, h = lane >> 5, tok = tb * 32 + r, b = (tb * 32) / SEQ, t0 = (tb * 32) % SEQ;
    const bf16_t* src = H + (size_t)tok * DINP + col0 + head * 64 + 32 * h;
    bf16x8 v[4];
#pragma unroll
    for (int c = 0; c < 4; ++c) v[c] = *(const bf16x8*)(src + 8 * c);
    LAS bf16_t* sp = stg + (32 * h) * 32 + r;
#pragma unroll
    for (int c = 0; c < 4; ++c)
#pragma unroll
        for (int j = 0; j < 8; ++j) sp[(8 * c + j) * 32] = (bf16_t)v[c][j];
    vt_flush(stg, VT + ((size_t)((b * NH + head) * 64)) * SEQ + t0, lane);
}
__device__ __forceinline__ void conv_unit(const bf16_t* __restrict__ H, const float* __restrict__ cw, const float* __restrict__ cb, bf16_t* __restrict__ Y, int tb, int lane) {
    const int tok0 = tb * 32, t0 = tok0 % SEQ, ch = 4 * lane;
    const f32x4 w0 = *(const f32x4*)(cw + ch), w1 = *(const f32x4*)(cw + 256 + ch), w2 = *(const f32x4*)(cw + 512 + ch), bs = *(const f32x4*)(cb + ch);
    f32x4 um1 = {0.f, 0.f, 0.f, 0.f}, um2 = {0.f, 0.f, 0.f, 0.f};
    if (t0 >= 2) {
        const bf16_t* p1 = H + (size_t)(tok0 - 1) * DINP + ch; const bf16_t* p2 = H + (size_t)(tok0 - 2) * DINP + ch;
        const u32x2 c1 = *(const u32x2*)(p1 + C_BC), x1 = *(const u32x2*)(p1 + C_BX), c2 = *(const u32x2*)(p2 + C_BC), x2 = *(const u32x2*)(p2 + C_BX);
        um1 = (f32x4){bflo(c1.x) * bflo(x1.x), bfhi(c1.x) * bfhi(x1.x), bflo(c1.y) * bflo(x1.y), bfhi(c1.y) * bfhi(x1.y)};
        um2 = (f32x4){bflo(c2.x) * bflo(x2.x), bfhi(c2.x) * bfhi(x2.x), bflo(c2.y) * bflo(x2.y), bfhi(c2.y) * bfhi(x2.y)};
    }
#pragma unroll 4
    for (int i = 0; i < 32; ++i) {
        const bf16_t* p = H + (size_t)(tok0 + i) * DINP + ch;
        const u32x2 bb = *(const u32x2*)(p + C_BB), cc = *(const u32x2*)(p + C_BC), xx = *(const u32x2*)(p + C_BX);
        const f32x4 u = {bflo(cc.x) * bflo(xx.x), bfhi(cc.x) * bfhi(xx.x), bflo(cc.y) * bflo(xx.y), bfhi(cc.y) * bfhi(xx.y)};
        const f32x4 bg = {bflo(bb.x), bfhi(bb.x), bflo(bb.y), bfhi(bb.y)};
        const f32x4 y = bg * (w0 * um2 + w1 * um1 + w2 * u + bs);
        u32x2 o; o.x = pk2(y.x, y.y); o.y = pk2(y.z, y.w);
        *(u32x2*)(Y + (size_t)(tok0 + i) * DM + 256 + ch) = o;
        um2 = um1; um1 = u;
    }
}

__device__ __forceinline__ void o_flush(LAS bf16_t* stg, bf16_t* __restrict__ Orow0, int opitch, int lane) {
    u32x4 w[4];
#pragma unroll
    for (int j = 0; j < 4; ++j) w[j] = *(const LAS u32x4*)(stg + (lane + 64 * j) * 8);
#pragma unroll
    for (int j = 0; j < 4; ++j) { const int c = lane + 64 * j; *(u32x4*)(Orow0 + (size_t)(c >> 3) * opitch + (c & 7) * 8) = w[j]; }
}
template <int DKS, bool SINK>
__device__ __forceinline__ void softmax_unit(const bf16_t* __restrict__ Qrow0, int qpitch, const bf16_t* __restrict__ Kb, int kpitch, const bf16_t* __restrict__ VT,
                                             int qb, int kt_begin, int window, float sink2, bf16_t* __restrict__ Orow0, int opitch, int lane, LAS bf16_t* stg) {
    const int r = lane & 31, h = lane >> 5;
    const int pr = (r & ~12) | ((r & 8) >> 1) | ((r & 4) << 1);
    bf16x8 qf[DKS];
#pragma unroll
    for (int s = 0; s < DKS; ++s) qf[s] = *(const bf16x8*)(Qrow0 + (size_t)r * qpitch + 16 * s + 8 * h);
    f32x16 o0, o1;
#pragma unroll
    for (int i = 0; i < 16; ++i) { o0[i] = 0.f; o1[i] = 0.f; }
    float m = -1e30f, l = 0.f;
    const int kt_end = qb + 1, q = 32 * qb + r;
    const bf16_t* kp = Kb + (size_t)(32 * kt_begin + pr) * kpitch + 8 * h;
    const bf16_t* vp = VT + (size_t)r * SEQ + 32 * kt_begin + 8 * h;
    bf16x8 kf[DKS];
#pragma unroll
    for (int s = 0; s < DKS; ++s) kf[s] = *(const bf16x8*)(kp + 16 * s);
    for (int kt = kt_begin; kt < kt_end; ++kt) {
        bf16x8 kn[DKS];
        if (kt + 1 < kt_end) {
#pragma unroll
            for (int s = 0; s < DKS; ++s) kn[s] = *(const bf16x8*)(kp + (size_t)32 * kpitch + 16 * s);
        } else {
#pragma unroll
            for (int s = 0; s < DKS; ++s) kn[s] = kf[s];
        }
        const bf16x8 v00 = *(const bf16x8*)(vp), v01 = *(const bf16x8*)(vp + 32 * SEQ), v10 = *(const bf16x8*)(vp + 16), v11 = *(const bf16x8*)(vp + 32 * SEQ + 16);
        f32x16 p;
#pragma unroll
        for (int i = 0; i < 16; ++i) p[i] = 0.f;
#pragma unroll
        for (int s = 0; s < DKS; ++s) p = MFMA32(kf[s], qf[s], p);
        if (kt == qb || (window != 0 && kt == qb - (window >> 5))) {
            const int k0 = 32 * kt + 8 * h;
#pragma unroll
            for (int i = 0; i < 16; ++i) { const int kv = k0 + 16 * (i >> 3) + (i & 7); const bool ok = (kv <= q) && (window == 0 || kv > q - window); if (!ok) p[i] = -INFINITY; }
        }
        float rm = p[0];
#pragma unroll
        for (int i = 1; i < 16; ++i) rm = fmaxf(rm, p[i]);
        rm = fmaxf(rm, __shfl_xor(rm, 32));
        if (__any(rm > m + 6.f)) {
            const float mn = fmaxf(m, rm), f = ex2(m - mn); m = mn; l *= f;
#pragma unroll
            for (int i = 0; i < 16; ++i) { const float fi = __shfl(f, crow(i, h)); o0[i] *= fi; o1[i] *= fi; }
        }
        float e[16];
#pragma unroll
        for (int i = 0; i < 16; ++i) { e[i] = ex2(p[i] - m); l += e[i]; }
        const bf16x8 pa0 = pack8(e), pa1 = pack8(e + 8);
        o0 = MFMA32(pa0, v00, o0); o1 = MFMA32(pa0, v01, o1);
        o0 = MFMA32(pa1, v10, o0); o1 = MFMA32(pa1, v11, o1);
#pragma unroll
        for (int s = 0; s < DKS; ++s) kf[s] = kn[s];
        kp += (size_t)32 * kpitch; vp += 32;
    }
    l += __shfl_xor(l, 32);
    if (SINK) l += ex2(sink2 - m);
    const float inv = 1.f / l;
    LAS bf16_t* sp = stg + (4 * h) * 64 + r;
#pragma unroll
    for (int i = 0; i < 16; ++i) { const float fi = __shfl(inv, crow(i, h)); const int ro = ((i & 3) + 8 * (i >> 2)) * 64;
        sp[ro] = f2bf(o0[i] * fi); sp[ro + 32] = f2bf(o1[i] * fi); }
    o_flush(stg, Orow0, opitch, lane);
}

__device__ __forceinline__ void sb_unit(const bf16_t* __restrict__ Qrow0, int qpitch, const bf16_t* __restrict__ Kb, int kpitch, const bf16_t* __restrict__ VT,
                                        int qb, bf16_t* __restrict__ Orow0, int opitch, int lane, LAS bf16_t* stg) {
    const int r = lane & 31, h = lane >> 5;
    const int pr = (r & ~12) | ((r & 8) >> 1) | ((r & 4) << 1);
    bf16x8 qf[4];
#pragma unroll
    for (int s = 0; s < 4; ++s) qf[s] = *(const bf16x8*)(Qrow0 + (size_t)r * qpitch + 16 * s + 8 * h);
    f32x16 o0, o1;
#pragma unroll
    for (int i = 0; i < 16; ++i) { o0[i] = 0.f; o1[i] = 0.f; }
    float carry = 0.f;
    const int q = 32 * qb + r;
    const bf16_t* kp = Kb + (size_t)(32 * qb + pr) * kpitch + 8 * h;
    const bf16_t* vp = VT + (size_t)r * SEQ + 32 * qb + 8 * h;
    bf16x8 kf[4];
#pragma unroll
    for (int s = 0; s < 4; ++s) kf[s] = *(const bf16x8*)(kp + 16 * s);
    for (int kt = qb; kt >= 0; --kt) {
        bf16x8 kn[4];
        if (kt > 0) {
#pragma unroll
            for (int s = 0; s < 4; ++s) kn[s] = *(const bf16x8*)(kp - (size_t)32 * kpitch + 16 * s);
        } else {
#pragma unroll
            for (int s = 0; s < 4; ++s) kn[s] = kf[s];
        }
        const bf16x8 v00 = *(const bf16x8*)(vp), v01 = *(const bf16x8*)(vp + 32 * SEQ), v10 = *(const bf16x8*)(vp + 16), v11 = *(const bf16x8*)(vp + 32 * SEQ + 16);
        f32x16 p;
#pragma unroll
        for (int i = 0; i < 16; ++i) p[i] = 0.f;
#pragma unroll
        for (int s = 0; s < 4; ++s) p = MFMA32(kf[s], qf[s], p);
        const bool diag = (kt == qb);
        const int k0 = 32 * kt + 8 * h;
        float sfx[16];
#pragma unroll
        for (int i = 0; i < 16; ++i) {
            const float z = p[i];
            float L = -(fmaxf(z, 0.f) + lg2(1.f + ex2(-fabsf(z))));
            if (diag) { const int kv = k0 + 16 * (i >> 3) + (i & 7); if (!(kv < q)) L = 0.f; }
            sfx[i] = L;
        }
#pragma unroll
        for (int g = 0; g < 2; ++g)
#pragma unroll
            for (int j = 6; j >= 0; --j) sfx[8 * g + j] += sfx[8 * g + j + 1];
        const float T0 = sfx[0], T1 = sfx[8];
        const float TP0 = __shfl_xor(T0, 32), TP1 = __shfl_xor(T1, 32);
        const float off1 = (h ? 0.f : TP1) + carry, off0 = T1 + TP1 + (h ? 0.f : TP0) + carry;
        float e[16];
#pragma unroll
        for (int i = 0; i < 16; ++i) {
            float a = ex2(p[i] + sfx[i] + (i < 8 ? off0 : off1));
            if (diag) { const int kv = k0 + 16 * (i >> 3) + (i & 7); if (!(kv < q)) a = 0.f; }
            e[i] = a;
        }
        carry += (T0 + T1) + (TP0 + TP1);
        const bf16x8 pa0 = pack8(e), pa1 = pack8(e + 8);
        o0 = MFMA32(pa0, v00, o0); o1 = MFMA32(pa0, v01, o1);
        o0 = MFMA32(pa1, v10, o0); o1 = MFMA32(pa1, v11, o1);
        if (__all(carry < -150.f)) break;
#pragma unroll
        for (int s = 0; s < 4; ++s) kf[s] = kn[s];
        kp -= (size_t)32 * kpitch; vp -= 32;
    }
    LAS bf16_t* sp = stg + (4 * h) * 64 + r;
#pragma unroll
    for (int i = 0; i < 16; ++i) { const int ro = ((i & 3) + 8 * (i >> 2)) * 64; sp[ro] = f2bf(o0[i]); sp[ro + 32] = f2bf(o1[i]); }
    o_flush(stg, Orow0, opitch, lane);
}

__global__ void __launch_bounds__(NTHREADS, 2) fwd(Params P) {
    extern __shared__ __attribute__((aligned(16))) unsigned char lds_raw[];
    LAS unsigned char* lds = (LAS unsigned char*)lds_raw;
    const int G = gridDim.x, bx = blockIdx.x, NGW = G * NWAVES, gthreads = G * NTHREADS;
    unsigned char* ws = P.ws;
    unsigned* ctl = (unsigned*)(ws + WS_CTL);
    bf16_t* XN = (bf16_t*)(ws + WS_XN); bf16_t* H = (bf16_t*)(ws + WS_H);
    bf16_t* QC = (bf16_t*)(ws + WS_QC); bf16_t* KC = (bf16_t*)(ws + WS_KC);
    bf16_t* VTC = (bf16_t*)(ws + WS_VTC); bf16_t* VTA = (bf16_t*)(ws + WS_VTA); bf16_t* VTD = (bf16_t*)(ws + WS_VTD);
    bf16_t* Y = (bf16_t*)(ws + WS_Y);
#if MK_COOP
    cooperative_groups::grid_group grid = cooperative_groups::this_grid();
#endif
    for (int ph = P.ph_lo; ph < P.ph_hi; ++ph) {
        int tid_o = threadIdx.x; asm volatile("" : "+v"(tid_o));
        const int tid = tid_o, lane = tid & 63, wave = __builtin_amdgcn_readfirstlane(tid >> 6);
        const int gw = bx * NWAVES + wave, gtid = bx * NTHREADS + tid;
        LAS bf16_t* stg = (LAS bf16_t*)(lds + wave * 4096);
        if (ph == 0) {
            for (int l = 0; l < NLAYER; ++l) {
                conv_wT(P.w_in + (size_t)l * DM * DIN, DM, DIN, DINP, P.norm_pre + l * DM, (bf16_t*)(ws + WS_WIN) + (size_t)l * DINP * DM, C_AQ, C_AQ + 256, C_DQ, C_DQ + 256, SC64, gtid, gthreads);
                conv_wT(P.w_out + (size_t)l * DM * DM, DM, DM, DM, P.g_grp + l * DM, (bf16_t*)(ws + WS_WOUT) + (size_t)l * DM * DM, 0, 0, 0, 0, 1.f, gtid, gthreads);
                conv_wT(P.w_uq + (size_t)l * 256 * 384, 256, 384, 384, P.g_cq + l * 256, (bf16_t*)(ws + WS_WUQ + (size_t)l * 262144), 0, 0, 0, 0, 1.f, gtid, gthreads);
                conv_wT(P.w_ukv + (size_t)l * 128 * 512, 128, 512, 512, P.g_ckv + l * 128, (bf16_t*)(ws + WS_WUKV + (size_t)l * 131072), 0, 0, 0, 0, 1.f, gtid, gthreads);
            }
            for (int mrow = gw; mrow < M_TOK; mrow += NGW) rms_row_to_bf16(P.x + (size_t)mrow * DM, XN + (size_t)mrow * DM, lane);
        } else {
            const int l = (ph - 1) / 6, k = (ph - 1) % 6;
            if (k == 0 || k == 4) {
                if (k == 0) {
                    pg8::Gemm g{XN, (const bf16_t*)(ws + WS_WIN) + (size_t)l * DINP * DM, M_TOK, DINP, DM}; pg8::StaticOrder S; S.init(M_TOK, DINP, G, bx);
                    pg8::EpiBf16<0> E{H, DINP, nullptr, 0, 0, 1.f};
                    pg8::gemm_phase<pg8::EpiBf16<0>, pg8::StaticOrder, true, true>(lds, g, S, E);
                } else {
                    pg8::Gemm g{XN, (const bf16_t*)(ws + WS_WOUT) + (size_t)l * DM * DM, M_TOK, DM, DM}; pg8::StaticOrder S; S.init(M_TOK, DM, G, bx);
                    pg8::EpiBf16<0> E{Y, DM, nullptr, 0, 0, 1.f};
                    pg8::gemm_phase<pg8::EpiBf16<0>, pg8::StaticOrder, true, true>(lds, g, S, E);
                }
            } else if (k == 1) {
                const bf16_t* WUQ = (const bf16_t*)(ws + WS_WUQ + (size_t)l * 262144);
                const bf16_t* WUKV = (const bf16_t*)(ws + WS_WUKV + (size_t)l * 131072);
                constexpr int NTB = M_TOK / 32;
                constexpr int U_MQ = NTB * 4, U_MKV = NTB * 4, U_VTA = NTB * 2, U_VTD = NTB * 4, U_CONV = NTB;
                constexpr int U_ALL = U_MQ + U_MKV + U_VTA + U_VTD + U_CONV;
                for (int u = gw; u < U_ALL; u += NGW) {
                    int v = u;
                    if (v < U_MQ) { mq_unit(H, WUQ, P.pos, QC, v >> 2, v & 3, lane); continue; } v -= U_MQ;
                    if (v < U_MKV) { mkv_unit(H, WUKV, P.pos, KC, VTC, v >> 2, v & 3, lane, stg); continue; } v -= U_MKV;
                    if (v < U_VTA) { vt_unit(H, C_AV, 2, VTA, v >> 1, v & 1, lane, stg); continue; } v -= U_VTA;
                    if (v < U_VTD) { vt_unit(H, C_DV, 4, VTD, v >> 2, v & 3, lane, stg); continue; } v -= U_VTD;
                    conv_unit(H, P.conv_w + l * 768, P.conv_b + l * 256, Y, v, lane);
                }
            } else if (k == 2) {
                for (int pu = bx; pu < 256; pu += G) {
                    const int bh = pu & 7, Gq = pu >> 3, b = bh >> 2, hh = bh & 3;
                    const int qb = (wave < 4) ? (4 * Gq + wave) : (4 * (63 - Gq) + (wave - 4));
                    const size_t row0 = (size_t)b * SEQ + 32 * qb;
                    softmax_unit<6, false>(QC + row0 * 384 + hh * 96, 384, KC + (size_t)b * SEQ * 384 + hh * 96, 384, VTC + (size_t)(b * 4 + hh) * 64 * SEQ,
                                           qb, 0, 0, 0.f, Y + row0 * DM + 512 + hh * 64, DM, lane, stg);
                }
                for (;;) {
                    unsigned u = 0;
                    if (lane == 0) u = atomicAdd(ctl + 64 * l, 1u);
                    u = (unsigned)__builtin_amdgcn_readfirstlane((int)u);
                    if (u >= 4096u) break;
                    const int v = (int)(u & 2047u), bh = v >> 8, qb = v & 255, b = bh >> 2, hh = bh & 3;
                    const size_t row0 = (size_t)b * SEQ + 32 * qb;
                    if (u < 2048u) {
                        sb_unit(H + row0 * DINP + C_DQ + hh * 64, DINP, H + (size_t)b * SEQ * DINP + C_DK + hh * 64, DINP, VTD + (size_t)(b * 4 + hh) * 64 * SEQ,
                                qb, Y + row0 * DM + 768 + hh * 64, DM, lane, stg);
                    } else {
                        const int kvh = hh >> 1;
                        const int ktb = qb - 4 > 0 ? qb - 4 : 0;
                        softmax_unit<4, true>(H + row0 * DINP + C_AQ + hh * 64, DINP, H + (size_t)b * SEQ * DINP + C_AK + kvh * 64, DINP, VTA + (size_t)(b * 2 + kvh) * 64 * SEQ,
                                              qb, ktb, 128, P.sinks[l * 4 + hh] * LOG2E, Y + row0 * DM + hh * 64, DM, lane, stg);
                    }
                }
            } else if (k == 3) {
                for (int mrow = gw; mrow < M_TOK; mrow += NGW) {
                    const u32x4* yp = (const u32x4*)(Y + (size_t)mrow * DM) + 2 * lane;
                    const u32x4* gp = (const u32x4*)(H + (size_t)mrow * DINP + C_GATE) + 2 * lane;
                    const u32x4 y0 = yp[0], y1 = yp[1], g0 = gp[0], g1 = gp[1];
                    float yv[16], gv[16];
#pragma unroll
                    for (int j = 0; j < 4; ++j) { yv[2 * j] = bflo(y0[j]); yv[2 * j + 1] = bfhi(y0[j]); yv[8 + 2 * j] = bflo(y1[j]); yv[8 + 2 * j + 1] = bfhi(y1[j]);
                                                  gv[2 * j] = bflo(g0[j]); gv[2 * j + 1] = bfhi(g0[j]); gv[8 + 2 * j] = bflo(g1[j]); gv[8 + 2 * j + 1] = bfhi(g1[j]); }
                    float ss = 0.f;
#pragma unroll
                    for (int j = 0; j < 16; ++j) ss += yv[j] * yv[j];
                    ss += __shfl_xor(ss, 1); ss += __shfl_xor(ss, 2); ss += __shfl_xor(ss, 4); ss += __shfl_xor(ss, 8);
                    const float rs = rsqrtf(ss * (1.f / 256.f) + EPS);
                    float o[16];
#pragma unroll
                    for (int j = 0; j < 16; ++j) { const float gg = gv[j]; o[j] = yv[j] * rs * gg * __builtin_amdgcn_rcpf(1.f + ex2(-gg * LOG2E)); }
                    u32x4 w0, w1;
#pragma unroll
                    for (int j = 0; j < 4; ++j) { w0[j] = pk2(o[2 * j], o[2 * j + 1]); w1[j] = pk2(o[8 + 2 * j], o[8 + 2 * j + 1]); }
                    u32x4* op = (u32x4*)(XN + (size_t)mrow * DM) + 2 * lane;
                    op[0] = w0; op[1] = w1;
                }
            } else {
                const float* base = (l == 0) ? P.x : P.out;
                const float* gpost = P.g_post + l * DM;
                for (int mrow = gw; mrow < M_TOK; mrow += NGW) {
                    f32x4 zz[4], xv[4]; float s1 = 0.f;
#pragma unroll
                    for (int j = 0; j < 4; ++j) { const u32x2 w = ((const u32x2*)(Y + (size_t)mrow * DM))[lane + 64 * j]; zz[j] = (f32x4){bflo(w.x), bfhi(w.x), bflo(w.y), bfhi(w.y)};
                        xv[j] = ((const f32x4*)(base + (size_t)mrow * DM))[lane + 64 * j];
                        s1 += (zz[j].x * zz[j].x + zz[j].y * zz[j].y) + (zz[j].z * zz[j].z + zz[j].w * zz[j].w); }
                    const float rz = rsqrtf(wave_sum(s1) * (1.f / DM) + EPS);
                    float s2 = 0.f;
#pragma unroll
                    for (int j = 0; j < 4; ++j) { const f32x4 gpv = ((const f32x4*)gpost)[lane + 64 * j]; xv[j] = xv[j] + zz[j] * rz * gpv;
                        s2 += (xv[j].x * xv[j].x + xv[j].y * xv[j].y) + (xv[j].z * xv[j].z + xv[j].w * xv[j].w);
                        ((f32x4*)(P.out + (size_t)mrow * DM))[lane + 64 * j] = xv[j]; }
                    if (l + 1 < NLAYER) {
                        const float rs = rsqrtf(wave_sum(s2) * (1.f / DM) + EPS);
#pragma unroll
                        for (int j = 0; j < 4; ++j) { u32x2 o; o.x = pk2(xv[j].x * rs, xv[j].y * rs); o.y = pk2(xv[j].z * rs, xv[j].w * rs); ((u32x2*)(XN + (size_t)mrow * DM))[lane + 64 * j] = o; }
                    }
                }
            }
        }
        if (ph + 1 < P.ph_hi) {
#if MK_COOP
            grid.sync();
#endif
        }
    }
}
}

extern "C" void kernel_launch(void* const* d_in, const int* in_sizes, int n_in, void* d_out, int out_size, void* d_ws, size_t ws_size, hipStream_t stream) {
    using namespace mk;
    static int grid = 0;
    if (grid == 0) {
        if (n_in != 14 || out_size != M_TOK * DM || ws_size < WS_END) { fprintf(stderr, "kernel_launch: unexpected shapes (n_in %d out %d ws %zu)\n", n_in, out_size, ws_size); grid = -1; return; }
        int dev = 0, cus = 0, per_cu = 0;
        (void)hipGetDevice(&dev); (void)hipDeviceGetAttribute(&cus, hipDeviceAttributeMultiprocessorCount, dev);
        if (hipFuncSetAttribute((const void*)fwd, hipFuncAttributeMaxDynamicSharedMemorySize, LDS_BYTES) != hipSuccess) { fprintf(stderr, "kernel_launch: hipFuncSetAttribute failed\n"); grid = -1; return; }
        if (hipOccupancyMaxActiveBlocksPerMultiprocessor(&per_cu, (const void*)fwd, NTHREADS, LDS_BYTES) != hipSuccess || per_cu < 1) { fprintf(stderr, "kernel_launch: occupancy query says %d\n", per_cu); per_cu = 1; }
        (void)hipGetLastError();
        grid = cus * 1;
        if (grid > 256) grid = 256;
    }
    if (grid < 0) return;
    (void)hipMemsetAsync((char*)d_ws + WS_CTL, 0, CTL_BYTES, stream);
    Params p{};
    p.x = (const float*)d_in[0]; p.pos = (const int*)d_in[1]; p.norm_pre = (const float*)d_in[2]; p.w_in = (const float*)d_in[3]; p.sinks = (const float*)d_in[4];
    p.conv_w = (const float*)d_in[5]; p.conv_b = (const float*)d_in[6]; p.g_cq = (const float*)d_in[7]; p.w_uq = (const float*)d_in[8]; p.g_ckv = (const float*)d_in[9];
    p.w_ukv = (const float*)d_in[10]; p.g_grp = (const float*)d_in[11]; p.w_out = (const float*)d_in[12]; p.g_post = (const float*)d_in[13];
    p.out = (float*)d_out; p.ws = (unsigned char*)d_ws;
    constexpr int NPH = 1 + 6 * NLAYER;
#if MK_COOP
    p.ph_lo = 0; p.ph_hi = NPH;
    void* args[] = {&p};
    hipError_t e = hipLaunchCooperativeKernel((const void*)fwd, dim3(grid), dim3(NTHREADS), args, LDS_BYTES, stream);
    if (e != hipSuccess) fprintf(stderr, "kernel_launch: cooperative launch failed: %s (grid %d)\n", hipGetErrorString(e), grid);
#else
    for (int ph = 0; ph < NPH; ++ph) { p.ph_lo = ph; p.ph_hi = ph + 1; hipLaunchKernelGGL(fwd, dim3(grid), dim3(NTHREADS), LDS_BYTES, stream, p); }
#endif
}
```

```cpp
#include <hip/hip_runtime.h>
#include <hip/hip_cooperative_groups.h>
#include <cstdio>
#include <cstdint>
#include <cmath>
namespace pg8 {
#define PG8_LAS __attribute__((address_space(3)))
typedef unsigned short bf16_t;
typedef short bf16x8 __attribute__((ext_vector_type(8)));
typedef float f32x4 __attribute__((ext_vector_type(4)));
typedef unsigned u32x4 __attribute__((ext_vector_type(4)));
constexpr int BM = 256, BK = 64, HALF = 128, HTB = HALF * BK * 2  , STAGE_BYTES = 8 * HTB, NXCD = 8, WGM = 8;

__host__ __device__ __forceinline__ int lds_byte(int r, int c) { const int st = (r >> 4) * 2 + (c >> 5), rr = r & 15, cc = c & 31, ob = rr * 64 + cc * 2; return st * 1024 + (ob ^ (((ob >> 9) & 1) << 5)); }
__host__ __device__ __forceinline__ void stage_rc(int b, int& R, int& C) { const int st = b / 1024, sb = b % 1024, swz = sb ^ (((sb >> 9) & 1) << 5); R = (st >> 1) * 16 + swz / 64; C = (st & 1) * 32 + (swz % 64) / 2; }
__host__ __device__ __forceinline__ int perm32(int rho) { const int n = rho >> 4, i = rho & 15; return 8 * (i >> 2) + 4 * n + (i & 3); }

struct Unit { int pm, pn; };
struct Gemm { const bf16_t* A; const bf16_t* Bt; int M, N, K; };

struct StaticOrder {
    int nM, nN, nwg, G, c;
    __host__ __device__ void init(int M, int N, int G_, int c_) { nM = M / BM; nN = N / BM; nwg = nM * nN; G = G_; c = c_; }
    __host__ __device__ bool next(int i, Unit& u) const {
        const long L = (long)i * G + c; if (L >= nwg) return false;
        int wgid = (int)L; { const int q = nwg / NXCD, r = nwg % NXCD, xcd = wgid % NXCD, off = wgid / NXCD; wgid = (xcd < r ? xcd * (q + 1) : r * (q + 1) + (xcd - r) * q) + off; }
        const int nig = WGM * nN, gid = wgid / nig, fm = gid * WGM, gsz = (nM - fm) < WGM ? (nM - fm) : WGM;
        u.pm = fm + ((wgid % nig) % gsz); u.pn = (wgid % nig) / gsz; return true;
    }
    __device__ __forceinline__ void a_ready(const Unit&) const {}
    __device__ __forceinline__ void done(const Unit&) const {}
};

__device__ __forceinline__ unsigned cvt_pk_bf16(float lo, float hi) { unsigned r; asm volatile("v_cvt_pk_bf16_f32 %0, %1, %2" : "=v"(r) : "v"(lo), "v"(hi)); return r; }
typedef float f32x2 __attribute__((ext_vector_type(2)));
__device__ __forceinline__ f32x2 gelu_pk(f32x2 v) {
    const f32x2 av = __builtin_elementwise_abs(v), d = av * 0.2316418882f + 1.0f;
    f32x2 t; t.x = __builtin_amdgcn_rcpf(d.x); t.y = __builtin_amdgcn_rcpf(d.y);
    f32x2 q = t * 0.5307027145f + (-0.7265760135f); q = q * t + 0.7107068705f; q = q * t + (-0.142248368f); q = q * t + 0.127414796f; q = q * t;
    const f32x2 s = (v * v) * (-0.72134752044f);
    f32x2 e; e.x = __builtin_amdgcn_exp2f(s.x); e.y = __builtin_amdgcn_exp2f(s.y);
    const f32x2 m = v * (q * e), r = v - m;
    f32x2 o; o.x = v.x < 0.f ? m.x : r.x; o.y = v.y < 0.f ? m.y : r.y; return o;
}

template <int ACT  > struct EpiBf16 {
    static constexpr bool PERM = true, AFTER_DRAIN = false; static_assert(ACT == 0 || ACT == 1, "EpiBf16: ACT is 0 (none) or 1 (gelu_pk)");
    bf16_t* O; int ldc; const float* bias; int split_cols; size_t split_stride; float scale0;
    __device__ __forceinline__ void operator()(const f32x4 (&acc)[2][2][4][2], const Unit& u, int wr, int wc, int fr, int fq) const {
        const int row0 = u.pm * BM + wr * 64 + fr; int colt = u.pn * BM; bf16_t* base = O;
        float sc = 1.f; if (split_cols) { const int t = colt / split_cols; base += (size_t)t * split_stride; colt -= t * split_cols; if (t == 0) sc = scale0; }
        const int col0 = colt + wc * 32 + 8 * fq, bcol0 = u.pn * BM + wc * 32 + 8 * fq;
        f32x4 bv[2][2];
#pragma unroll
        for (int bj = 0; bj < 2; ++bj)
#pragma unroll
            for (int n = 0; n < 2; ++n) bv[bj][n] = bias ? *(const f32x4*)(bias + bcol0 + bj * HALF + 4 * n) : (f32x4){0.f, 0.f, 0.f, 0.f};
#pragma unroll
        for (int ai = 0; ai < 2; ++ai)
#pragma unroll
            for (int m = 0; m < 4; ++m) { bf16_t* rowp = base + (size_t)(row0 + ai * HALF + m * 16) * ldc + col0;
#pragma unroll
                for (int bj = 0; bj < 2; ++bj) { f32x4 v0 = acc[ai][bj][m][0] + bv[bj][0], v1 = acc[ai][bj][m][1] + bv[bj][1];
                    if (ACT == 1) { f32x2 a = gelu_pk((f32x2){v0[0], v0[1]}), b = gelu_pk((f32x2){v0[2], v0[3]}), c = gelu_pk((f32x2){v1[0], v1[1]}), d = gelu_pk((f32x2){v1[2], v1[3]});
                        v0 = (f32x4){a.x, a.y, b.x, b.y}; v1 = (f32x4){c.x, c.y, d.x, d.y}; }
                    v0 = v0 * sc; v1 = v1 * sc; u32x4 w; w.x = cvt_pk_bf16(v0[0], v0[1]); w.y = cvt_pk_bf16(v0[2], v0[3]); w.z = cvt_pk_bf16(v1[0], v1[1]); w.w = cvt_pk_bf16(v1[2], v1[3]);
                    *(u32x4*)(rowp + bj * HALF) = w; } }
    }
};
template <class Epi, class Sched, bool ALIGN_EPI = false, bool SP2 = false>
__device__ __forceinline__ void gemm_phase(PG8_LAS unsigned char* lds, const Gemm g, const Sched& S, const Epi& E) {
    int tid_o = threadIdx.x; asm volatile("" : "+v"(tid_o));
    const int tid = tid_o, wid = __builtin_amdgcn_readfirstlane(tid >> 6), lane = tid & 63, wr = wid >> 2, wc = wid & 3, fr = lane & 15, fq = lane >> 4;
    const int K = g.K, nt = K / BK;
    unsigned voffA[2], voffB[2];
#pragma unroll
    for (int i = 0; i < 2; ++i) { int R, C; stage_rc(tid * 16 + i * 8192, R, C); const int Rb = Epi::PERM ? ((R & ~31) + perm32(R & 31)) : R;
        voffA[i] = (unsigned)(R * K + C) * 2u; voffB[i] = (unsigned)(Rb * K + C) * 2u; }
    const size_t kstep = (size_t)(BK * 2);
    const size_t hstep = (size_t)HALF * K * 2;
    const size_t tstep = 2 * hstep;
    const unsigned ldsw = (unsigned)wid * 1024u;
    const int aoff = lds_byte(wr * 64 + fr, fq * 8), boff = lds_byte(wc * 32 + fr, fq * 8);
#define PG8_SA(b, h) (((b) * 2 + (h)) * HTB)
#define PG8_SB(b, h) ((4 + (b) * 2 + (h)) * HTB)
#define PG8_STAGE(bufoff, gbase, voff) do { _Pragma("unroll") for (int _i = 0; _i < 2; ++_i) \
        __builtin_amdgcn_global_load_lds((const unsigned*)((const char*)(gbase) + (voff)[_i]), (PG8_LAS unsigned*)(lds + (bufoff) + ldsw + _i * 8192), 16, 0, 0); } while (0)
#define PG8_LDA(dst, b, h) do { _Pragma("unroll") for (int m = 0; m < 4; ++m) _Pragma("unroll") for (int k = 0; k < 2; ++k) dst[m][k] = *(const PG8_LAS bf16x8*)(lds + PG8_SA(b, h) + aoff + m * 2048 + k * 1024); } while (0)
#define PG8_LDB(dst, b, h) do { _Pragma("unroll") for (int n = 0; n < 2; ++n) _Pragma("unroll") for (int k = 0; k < 2; ++k) dst[n][k] = *(const PG8_LAS bf16x8*)(lds + PG8_SB(b, h) + boff + n * 2048 + k * 1024); } while (0)
#define PG8_MMA(ai, bj, At, Bt) do { __builtin_amdgcn_s_setprio(1); _Pragma("unroll") for (int m = 0; m < 4; ++m) _Pragma("unroll") for (int n = 0; n < 2; ++n) _Pragma("unroll") for (int k = 0; k < 2; ++k) \
        acc[ai][bj][m][n] = __builtin_amdgcn_mfma_f32_16x16x32_bf16(Bt[n][k], At[m][k], acc[ai][bj][m][n], 0, 0, 0); __builtin_amdgcn_s_setprio(0); } while (0)
#define PG8_WAIT_V(n) asm volatile("s_waitcnt vmcnt(" #n ")" ::: "memory")
#define PG8_WAIT_L(n) asm volatile("s_waitcnt lgkmcnt(" #n ")" ::: "memory")
#define PG8_BAR __builtin_amdgcn_s_barrier()
#define PG8_SCHED __builtin_amdgcn_sched_barrier(0)
    Unit cur, nxt; int ui = 0;
    if (!S.next(0, cur)) return;
    f32x4 acc[2][2][4][2];
#pragma unroll
    for (int a = 0; a < 2; ++a)
#pragma unroll
        for (int b = 0; b < 2; ++b)
#pragma unroll
            for (int m = 0; m < 4; ++m)
#pragma unroll
                for (int n = 0; n < 2; ++n) acc[a][b][m][n] = (f32x4){0.f, 0.f, 0.f, 0.f};
    bf16x8 At[4][2], B0[2][2], B1[2][2];
    const char* cA = (const char*)g.A + (size_t)cur.pm * tstep; const char* cB = (const char*)g.Bt + (size_t)cur.pn * tstep;
    S.a_ready(cur);
    if constexpr (SP2) {
        PG8_STAGE(PG8_SB(0, 0), cB, voffB); PG8_STAGE(PG8_SB(0, 1), cB + hstep, voffB); PG8_STAGE(PG8_SA(0, 0), cA, voffA); PG8_STAGE(PG8_SA(0, 1), cA + hstep, voffA);
        if (wr == 1) PG8_BAR;
        PG8_WAIT_V(2); PG8_BAR;
        PG8_STAGE(PG8_SB(1, 0), cB + kstep, voffB); PG8_STAGE(PG8_SA(1, 0), cA + kstep, voffA); PG8_STAGE(PG8_SB(1, 1), cB + hstep + kstep, voffB);
        PG8_WAIT_V(6); PG8_BAR;
    } else {
        PG8_STAGE(PG8_SB(0, 0), cB, voffB); PG8_STAGE(PG8_SA(0, 0), cA, voffA); PG8_STAGE(PG8_SB(0, 1), cB + hstep, voffB); PG8_STAGE(PG8_SA(0, 1), cA + hstep, voffA);
        if (wr == 1) PG8_BAR;
        PG8_WAIT_V(4); PG8_BAR;
        PG8_STAGE(PG8_SB(1, 0), cB + kstep, voffB); PG8_STAGE(PG8_SA(1, 0), cA + kstep, voffA); PG8_STAGE(PG8_SB(1, 1), cB + hstep + kstep, voffB);
        PG8_WAIT_V(6); PG8_BAR;
    }
    for (;;) {
        const bool has_next = S.next(ui + 1, nxt);
        const char* nA = has_next ? (const char*)g.A + (size_t)nxt.pm * tstep : cA; const char* nB = has_next ? (const char*)g.Bt + (size_t)nxt.pn * tstep : cB;
        for (int t = 0; t < nt; t += 2) {
            const bool last = (t == nt - 2);
            const char* a1 = cA + (size_t)(t + 1) * kstep;
            const char* a2 = last ? nA : cA + (size_t)(t + 2) * kstep; const char* b2 = last ? nB : cB + (size_t)(t + 2) * kstep;
            const char* a3 = a2 + kstep; const char* b3 = b2 + kstep;
            if (last && has_next) S.a_ready(nxt);
            if constexpr (SP2) {
            PG8_LDB(B0, 0, 0); PG8_LDB(B1, 0, 1); PG8_SCHED; PG8_LDA(At, 0, 0); PG8_STAGE(PG8_SA(1, 1), a1 + hstep, voffA);
            PG8_WAIT_V(8); PG8_WAIT_L(0); PG8_BAR; PG8_MMA(0, 0, At, B0); PG8_MMA(0, 1, At, B1); PG8_BAR; PG8_SCHED;
            PG8_LDA(At, 0, 1); PG8_STAGE(PG8_SB(0, 0), b2, voffB); PG8_STAGE(PG8_SB(0, 1), b2 + hstep, voffB); PG8_STAGE(PG8_SA(0, 0), a2, voffA);
            PG8_WAIT_V(8); PG8_WAIT_L(0); PG8_BAR; PG8_MMA(1, 0, At, B0); PG8_MMA(1, 1, At, B1); PG8_BAR; PG8_SCHED;
            PG8_LDB(B0, 1, 0); PG8_LDB(B1, 1, 1); PG8_SCHED; PG8_LDA(At, 1, 0); PG8_STAGE(PG8_SA(0, 1), a2 + hstep, voffA);
            PG8_WAIT_V(8); PG8_WAIT_L(0); PG8_BAR; PG8_MMA(0, 0, At, B0); PG8_MMA(0, 1, At, B1); PG8_BAR; PG8_SCHED;
            PG8_LDA(At, 1, 1); PG8_STAGE(PG8_SB(1, 0), b3, voffB); PG8_STAGE(PG8_SB(1, 1), b3 + hstep, voffB); PG8_STAGE(PG8_SA(1, 0), a3, voffA);
            PG8_WAIT_V(8); PG8_WAIT_L(0); PG8_BAR; PG8_MMA(1, 0, At, B0); PG8_MMA(1, 1, At, B1); PG8_BAR; PG8_SCHED;
            } else {
            PG8_LDB(B0, 0, 0); PG8_SCHED; PG8_LDA(At, 0, 0); PG8_STAGE(PG8_SA(1, 1), a1 + hstep, voffA);
            PG8_WAIT_L(8); PG8_BAR; PG8_WAIT_L(0); PG8_MMA(0, 0, At, B0); PG8_BAR; PG8_SCHED;
            PG8_LDB(B1, 0, 1); PG8_STAGE(PG8_SB(0, 0), b2, voffB);
            PG8_BAR; PG8_WAIT_L(0); PG8_MMA(0, 1, At, B1); PG8_BAR;
            PG8_LDA(At, 0, 1); PG8_STAGE(PG8_SA(0, 0), a2, voffA);
            PG8_BAR; PG8_WAIT_L(0); PG8_MMA(1, 0, At, B0); PG8_BAR; PG8_SCHED;
            PG8_STAGE(PG8_SB(0, 1), b2 + hstep, voffB);
            PG8_WAIT_V(6); PG8_BAR; PG8_MMA(1, 1, At, B1); PG8_BAR;
            PG8_LDB(B0, 1, 0); PG8_SCHED; PG8_LDA(At, 1, 0); PG8_STAGE(PG8_SA(0, 1), a2 + hstep, voffA);
            PG8_WAIT_L(8); PG8_BAR; PG8_WAIT_L(0); PG8_MMA(0, 0, At, B0); PG8_BAR; PG8_SCHED;
            PG8_LDB(B1, 1, 1); PG8_STAGE(PG8_SB(1, 0), b3, voffB);
            PG8_BAR; PG8_WAIT_L(0); PG8_MMA(0, 1, At, B1); PG8_BAR;
            PG8_LDA(At, 1, 1); PG8_STAGE(PG8_SA(1, 0), a3, voffA);
            PG8_BAR; PG8_WAIT_L(0); PG8_MMA(1, 0, At, B0); PG8_BAR; PG8_SCHED;
            PG8_STAGE(PG8_SB(1, 1), b3 + hstep, voffB);
            PG8_WAIT_V(6); PG8_BAR; PG8_MMA(1, 1, At, B1); PG8_BAR;
            }
        }
        if constexpr (ALIGN_EPI) { if (wr == 0) PG8_BAR; }
        if constexpr (!Epi::AFTER_DRAIN) { E(acc, cur, wr, wc, fr, fq); S.done(cur); }
        if (!has_next) break;
#pragma unroll
        for (int a = 0; a < 2; ++a)
#pragma unroll
            for (int b = 0; b < 2; ++b)
#pragma unroll
                for (int m = 0; m < 4; ++m)
#pragma unroll
                    for (int n = 0; n < 2; ++n) acc[a][b][m][n] = (f32x4){0.f, 0.f, 0.f, 0.f};
        cur = nxt; cA = nA; cB = nB; ++ui;
        if constexpr (ALIGN_EPI) { if (wr == 1) PG8_BAR; }
    }
    PG8_WAIT_V(0);
    if constexpr (!ALIGN_EPI) { if (wr == 0) PG8_BAR; }
    PG8_BAR;
    if constexpr (Epi::AFTER_DRAIN) { E.fused(acc, cur, wr, wc, fr, fq, lds, wid, lane); S.done(cur); }
#undef PG8_SA
#undef PG8_SB
#undef PG8_STAGE
#undef PG8_LDA
#undef PG8_LDB
#undef PG8_MMA
#undef PG8_WAIT_V
#undef PG8_WAIT_L
#undef PG8_BAR
#undef PG8_SCHED
}
}
#ifndef MK_COOP
#define MK_COOP 1
#endif
namespace mk {
using pg8::bf16_t; using pg8::bf16x8; using pg8::f32x4; using pg8::u32x4;
typedef float f32x16 __attribute__((ext_vector_type(16)));
typedef unsigned u32x2 __attribute__((ext_vector_type(2)));
typedef float f32x2_t __attribute__((ext_vector_type(2)));
typedef __bf16 bf16x2_t __attribute__((ext_vector_type(2)));
#define LAS __attribute__((address_space(3)))
#define MFMA32(a, b, c) __builtin_amdgcn_mfma_f32_32x32x16_bf16((a), (b), (c), 0, 0, 0)

constexpr int M_TOK = 16384, SEQ = 8192, DM = 1024, DIN = 3488, DINP = 3584, NLAYER = 2;
constexpr int C_AQ = 0, C_AK = 256, C_AV = 384, C_BB = 512, C_BC = 768, C_BX = 1024, C_CQ = 1280, C_CKV = 1536, C_CKR = 1664,
              C_DQ = 1696, C_DK = 1952, C_DV = 2208, C_GATE = 2464;
constexpr float EPS = 1e-6f, LOG2E = 1.4426950408889634f;
constexpr float SC64 = 0.125f * LOG2E;
constexpr float QSC_MLA = 0.10206207261596575f * LOG2E;
constexpr int NWAVES = 8, NTHREADS = 512;
constexpr int LDS_BYTES = 131072 + 1024;

constexpr size_t MiB = 1u << 20;
constexpr size_t WS_CTL = 0, CTL_BYTES = 65536;
constexpr int CW_BAR = 1024;
constexpr size_t WS_WIN = 1 * MiB;
constexpr size_t WS_WOUT = 15 * MiB;
constexpr size_t WS_WUQ = 19 * MiB;
constexpr size_t WS_WUKV = 19 * MiB + 512 * 1024;
constexpr size_t WS_XN = 32 * MiB;
constexpr size_t WS_H = 64 * MiB;
constexpr size_t WS_QC = 176 * MiB;
constexpr size_t WS_KC = 188 * MiB;
constexpr size_t WS_VTC = 200 * MiB;
constexpr size_t WS_VTA = 208 * MiB;
constexpr size_t WS_VTD = 212 * MiB;
constexpr size_t WS_Y = 220 * MiB;
constexpr size_t WS_END = 252 * MiB;

struct Params {
    const float* x; const int* pos; const float* norm_pre; const float* w_in; const float* sinks; const float* conv_w; const float* conv_b;
    const float* g_cq; const float* w_uq; const float* g_ckv; const float* w_ukv; const float* g_grp; const float* w_out; const float* g_post;
    float* out; unsigned char* ws; int ph_lo, ph_hi;
};

__device__ __forceinline__ unsigned pk2(float lo, float hi) { f32x2_t v = {lo, hi}; bf16x2_t b = __builtin_convertvector(v, bf16x2_t); return __builtin_bit_cast(unsigned, b); }
__device__ __forceinline__ float bf2f(short s) { return __uint_as_float(((unsigned)(unsigned short)s) << 16); }
__device__ __forceinline__ float bflo(unsigned u) { return __uint_as_float(u << 16); }
__device__ __forceinline__ float bfhi(unsigned u) { return __uint_as_float(u & 0xffff0000u); }
__device__ __forceinline__ bf16_t f2bf(float f) { return (bf16_t)(pk2(f, 0.f) & 0xffffu); }
__device__ __forceinline__ int crow(int i, int h) { return (i & 3) + 8 * (i >> 2) + 4 * h; }
__device__ __forceinline__ float ex2(float x) { return __builtin_amdgcn_exp2f(x); }
__device__ __forceinline__ float lg2(float x) { return __builtin_amdgcn_logf(x); }
__device__ __forceinline__ float wave_sum(float v) {
#pragma unroll
    for (int o = 1; o < 64; o <<= 1) v += __shfl_xor(v, o);
    return v;
}
__device__ __forceinline__ bf16x8 pack8(const float* e) {
    u32x4 w; w.x = pk2(e[0], e[1]); w.y = pk2(e[2], e[3]); w.z = pk2(e[4], e[5]); w.w = pk2(e[6], e[7]);
    return __builtin_bit_cast(bf16x8, w);
}

__device__ __forceinline__ void conv_wT(const float* __restrict__ W, int K, int N, int NP, const float* __restrict__ gain, bf16_t* __restrict__ dst,
                                        int a0, int a1, int b0, int b1, float sc, int gtid, int gthreads) {
    const int k8n = K / 8; const int items = NP * k8n;
    for (int it = gtid; it < items; it += gthreads) {
        const int n = it % NP, k8 = it / NP;
        u32x4 o = {0u, 0u, 0u, 0u};
        if (n < N) {
            const float cs = ((n >= a0 && n < a1) || (n >= b0 && n < b1)) ? sc : 1.f;
            float v[8];
#pragma unroll
            for (int j = 0; j < 8; ++j) v[j] = W[(size_t)(k8 * 8 + j) * N + n] * gain[k8 * 8 + j] * cs;
            o.x = pk2(v[0], v[1]); o.y = pk2(v[2], v[3]); o.z = pk2(v[4], v[5]); o.w = pk2(v[6], v[7]);
        }
        *(u32x4*)(dst + (size_t)n * K + k8 * 8) = o;
    }
}
__device__ __forceinline__ void rms_row_to_bf16(const float* __restrict__ xrow, bf16_t* __restrict__ orow, int lane) {
    f32x4 v[4]; float s = 0.f;
#pragma unroll
    for (int j = 0; j < 4; ++j) { v[j] = ((const f32x4*)xrow)[lane + 64 * j]; s += (v[j].x * v[j].x + v[j].y * v[j].y) + (v[j].z * v[j].z + v[j].w * v[j].w); }
    const float rs = rsqrtf(wave_sum(s) * (1.f / DM) + EPS);
#pragma unroll
    for (int j = 0; j < 4; ++j) { u32x2 o; o.x = pk2(v[j].x * rs, v[j].y * rs); o.y = pk2(v[j].z * rs, v[j].w * rs); ((u32x2*)orow)[lane + 64 * j] = o; }
}

__device__ __forceinline__ void rope_cs(int pos, int h, float (&cs)[8], float (&sn)[8]) {
#pragma unroll
    for (int i = 0; i < 8; ++i) {
        const int f = (i & 3) + 8 * (i >> 2) + 4 * h;
        const float freq = ex2(-(float)f * 0.830482023721841f);
        const float ang = (float)pos * freq;
        const double rev = (double)ang * 0.15915494309189535;
        const float fr = (float)(rev - __builtin_rint(rev));
        cs[i] = __builtin_amdgcn_cosf(fr); sn[i] = __builtin_amdgcn_sinf(fr);
    }
}
__device__ __forceinline__ void rope_apply(f32x16& a, const float (&cs)[8], const float (&sn)[8]) {
#pragma unroll
    for (int i = 0; i < 8; ++i) { const float x1 = a[i], x2 = a[i + 8]; a[i] = x1 * cs[i] - x2 * sn[i]; a[i + 8] = x1 * sn[i] + x2 * cs[i]; }
}
__device__ __forceinline__ void store_tile_rowmajor(bf16_t* dst  , const f32x16& a, int h) {
#pragma unroll
    for (int g = 0; g < 4; ++g) { u32x2 o; o.x = pk2(a[4 * g], a[4 * g + 1]); o.y = pk2(a[4 * g + 2], a[4 * g + 3]); *(u32x2*)(dst + 8 * g + 4 * h) = o; }
}
__device__ __forceinline__ void mq_unit(const bf16_t* __restrict__ H, const bf16_t* __restrict__ WT, const int* __restrict__ pos, bf16_t* __restrict__ QC, int tb, int hh, int lane) {
    const int r = lane & 31, h = lane >> 5, tok = tb * 32 + r;
    const bf16_t* src = H + (size_t)tok * DINP + C_CQ + 8 * h;
    bf16x8 bfr[16]; float ss = 0.f;
#pragma unroll
    for (int s = 0; s < 16; ++s) { bfr[s] = *(const bf16x8*)(src + 16 * s);
#pragma unroll
        for (int j = 0; j < 8; ++j) { const float v = bf2f(bfr[s][j]); ss += v * v; } }
    ss += __shfl_xor(ss, 32);
    const float rs = rsqrtf(ss * (1.f / 256.f) + EPS) * QSC_MLA;
    float cs[8], sn[8]; rope_cs(pos[tok], h, cs, sn);
    const bf16_t* W = WT + (size_t)(hh * 96 + r) * 256 + 8 * h;
#pragma unroll 1
    for (int nt = 0; nt < 3; ++nt) {
        f32x16 acc;
#pragma unroll
        for (int i = 0; i < 16; ++i) acc[i] = 0.f;
#pragma unroll
        for (int s = 0; s < 16; ++s) { const bf16x8 a = *(const bf16x8*)(W + (size_t)nt * 32 * 256 + 16 * s); acc = MFMA32(a, bfr[s], acc); }
#pragma unroll
        for (int i = 0; i < 16; ++i) acc[i] *= rs;
        if (nt == 2) rope_apply(acc, cs, sn);
        store_tile_rowmajor(QC + (size_t)tok * 384 + hh * 96 + nt * 32, acc, h);
    }
}
__device__ __forceinline__ void vt_flush(LAS bf16_t* stg, bf16_t* __restrict__ dst  , int lane) {
    const LAS u32x4* rp = (const LAS u32x4*)(stg + lane * 32);
    u32x4 w[4];
#pragma unroll
    for (int c = 0; c < 4; ++c) w[c] = rp[c];
    u32x4* gp = (u32x4*)(dst + (size_t)lane * SEQ);
#pragma unroll
    for (int c = 0; c < 4; ++c) gp[c] = w[c];
}
__device__ __forceinline__ void mkv_unit(const bf16_t* __restrict__ H, const bf16_t* __restrict__ WT, const int* __restrict__ pos, bf16_t* __restrict__ KC, bf16_t* __restrict__ VTC, int tb, int hh, int lane, LAS bf16_t* stg) {
    const int r = lane & 31, h = lane >> 5, tok = tb * 32 + r;
    const bf16_t* src = H + (size_t)tok * DINP + C_CKV + 8 * h;
    bf16x8 bfr[8]; float ss = 0.f;
#pragma unroll
    for (int s = 0; s < 8; ++s) { bfr[s] = *(const bf16x8*)(src + 16 * s);
#pragma unroll
        for (int j = 0; j < 8; ++j) { const float v = bf2f(bfr[s][j]); ss += v * v; } }
    ss += __shfl_xor(ss, 32);
    const float rs = rsqrtf(ss * (1.f / 128.f) + EPS);
    const bf16_t* W = WT + (size_t)(hh * 128 + r) * 128 + 8 * h;
    const int b = (tb * 32) / SEQ, t0 = (tb * 32) % SEQ;
#pragma unroll 1
    for (int nt = 0; nt < 4; ++nt) {
        f32x16 acc;
#pragma unroll
        for (int i = 0; i < 16; ++i) acc[i] = 0.f;
#pragma unroll
        for (int s = 0; s < 8; ++s) { const bf16x8 a = *(const bf16x8*)(W + (size_t)nt * 32 * 128 + 16 * s); acc = MFMA32(a, bfr[s], acc); }
#pragma unroll
        for (int i = 0; i < 16; ++i) acc[i] *= rs;
        if (nt < 2) store_tile_rowmajor(KC + (size_t)tok * 384 + hh * 96 + nt * 32, acc, h);
        else {
            LAS bf16_t* sp = stg + ((nt - 2) * 32 + 4 * h) * 32 + r;
#pragma unroll
            for (int i = 0; i < 16; ++i) sp[((i & 3) + 8 * (i >> 2)) * 32] = f2bf(acc[i]);
        }
    }
    vt_flush(stg, VTC + ((size_t)((b * 4 + hh) * 64)) * SEQ + t0, lane);
    f32x16 kr;
    const bf16_t* krp = H + (size_t)tok * DINP + C_CKR + 4 * h;
#pragma unroll
    for (int g = 0; g < 4; ++g) { const u32x2 w = *(const u32x2*)(krp + 8 * g); kr[4 * g] = bflo(w.x); kr[4 * g + 1] = bfhi(w.x); kr[4 * g + 2] = bflo(w.y); kr[4 * g + 3] = bfhi(w.y); }
    float cs[8], sn[8]; rope_cs(pos[tok], h, cs, sn);
    rope_apply(kr, cs, sn);
    store_tile_rowmajor(KC + (size_t)tok * 384 + hh * 96 + 64, kr, h);
}
__device__ __forceinline__ void vt_unit(const bf16_t* __restrict__ H, int col0, int NH, bf16_t* __restrict__ VT, int tb, int head, int lane, LAS bf16_t* stg) {
    const int r = lane & 31, h = lane >> 5, tok = tb * 32 + r, b = (tb * 32) / SEQ, t0 = (tb * 32) % SEQ;
    const bf16_t* src = H + (size_t)tok * DINP + col0 + head * 64 + 32 * h;
    bf16x8 v[4];
#pragma unroll
    for (int c = 0; c < 4; ++c) v[c] = *(const bf16x8*)(src + 8 * c);
    LAS bf16_t* sp = stg + (32 * h) * 32 + r;
#pragma unroll
    for (int c = 0; c < 4; ++c)
#pragma unroll
        for (int j = 0; j < 8; ++j) sp[(8 * c + j) * 32] = (bf16_t)v[c][j];
    vt_flush(stg, VT + ((size_t)((b * NH + head) * 64)) * SEQ + t0, lane);
}
__device__ __forceinline__ void conv_unit(const bf16_t* __restrict__ H, const float* __restrict__ cw, const float* __restrict__ cb, bf16_t* __restrict__ Y, int tb, int lane) {
    const int tok0 = tb * 32, t0 = tok0 % SEQ, ch = 4 * lane;
    const f32x4 w0 = *(const f32x4*)(cw + ch), w1 = *(const f32x4*)(cw + 256 + ch), w2 = *(const f32x4*)(cw + 512 + ch), bs = *(const f32x4*)(cb + ch);
    f32x4 um1 = {0.f, 0.f, 0.f, 0.f}, um2 = {0.f, 0.f, 0.f, 0.f};
    if (t0 >= 2) {
        const bf16_t* p1 = H + (size_t)(tok0 - 1) * DINP + ch; const bf16_t* p2 = H + (size_t)(tok0 - 2) * DINP + ch;
        const u32x2 c1 = *(const u32x2*)(p1 + C_BC), x1 = *(const u32x2*)(p1 + C_BX), c2 = *(const u32x2*)(p2 + C_BC), x2 = *(const u32x2*)(p2 + C_BX);
        um1 = (f32x4){bflo(c1.x) * bflo(x1.x), bfhi(c1.x) * bfhi(x1.x), bflo(c1.y) * bflo(x1.y), bfhi(c1.y) * bfhi(x1.y)};
        um2 = (f32x4){bflo(c2.x) * bflo(x2.x), bfhi(c2.x) * bfhi(x2.x), bflo(c2.y) * bflo(x2.y), bfhi(c2.y) * bfhi(x2.y)};
    }
#pragma unroll 4
    for (int i = 0; i < 32; ++i) {
        const bf16_t* p = H + (size_t)(tok0 + i) * DINP + ch;
        const u32x2 bb = *(const u32x2*)(p + C_BB), cc = *(const u32x2*)(p + C_BC), xx = *(const u32x2*)(p + C_BX);
        const f32x4 u = {bflo(cc.x) * bflo(xx.x), bfhi(cc.x) * bfhi(xx.x), bflo(cc.y) * bflo(xx.y), bfhi(cc.y) * bfhi(xx.y)};
        const f32x4 bg = {bflo(bb.x), bfhi(bb.x), bflo(bb.y), bfhi(bb.y)};
        const f32x4 y = bg * (w0 * um2 + w1 * um1 + w2 * u + bs);
        u32x2 o; o.x = pk2(y.x, y.y); o.y = pk2(y.z, y.w);
        *(u32x2*)(Y + (size_t)(tok0 + i) * DM + 256 + ch) = o;
        um2 = um1; um1 = u;
    }
}

__device__ __forceinline__ void o_flush(LAS bf16_t* stg, bf16_t* __restrict__ Orow0, int opitch, int lane) {
    u32x4 w[4];
#pragma unroll
    for (int j = 0; j < 4; ++j) w[j] = *(const LAS u32x4*)(stg + (lane + 64 * j) * 8);
#pragma unroll
    for (int j = 0; j < 4; ++j) { const int c = lane + 64 * j; *(u32x4*)(Orow0 + (size_t)(c >> 3) * opitch + (c & 7) * 8) = w[j]; }
}
template <int DKS, bool SINK>
__device__ __forceinline__ void softmax_unit(const bf16_t* __restrict__ Qrow0, int qpitch, const bf16_t* __restrict__ Kb, int kpitch, const bf16_t* __restrict__ VT,
                                             int qb, int kt_begin, int window, float sink2, bf16_t* __restrict__ Orow0, int opitch, int lane, LAS bf16_t* stg) {
    const int r = lane & 31, h = lane >> 5;
    const int pr = (r & ~12) | ((r & 8) >> 1) | ((r & 4) << 1);
    bf16x8 qf[DKS];
#pragma unroll
    for (int s = 0; s < DKS; ++s) qf[s] = *(const bf16x8*)(Qrow0 + (size_t)r * qpitch + 16 * s + 8 * h);
    f32x16 o0, o1;
#pragma unroll
    for (int i = 0; i < 16; ++i) { o0[i] = 0.f; o1[i] = 0.f; }
    float m = -1e30f, l = 0.f;
    const int kt_end = qb + 1, q = 32 * qb + r;
    const bf16_t* kp = Kb + (size_t)(32 * kt_begin + pr) * kpitch + 8 * h;
    const bf16_t* vp = VT + (size_t)r * SEQ + 32 * kt_begin + 8 * h;
    bf16x8 kf[DKS];
#pragma unroll
    for (int s = 0; s < DKS; ++s) kf[s] = *(const bf16x8*)(kp + 16 * s);
    for (int kt = kt_begin; kt < kt_end; ++kt) {
        bf16x8 kn[DKS];
        if (kt + 1 < kt_end) {
#pragma unroll
            for (int s = 0; s < DKS; ++s) kn[s] = *(const bf16x8*)(kp + (size_t)32 * kpitch + 16 * s);
        } else {
#pragma unroll
            for (int s = 0; s < DKS; ++s) kn[s] = kf[s];
        }
        const bf16x8 v00 = *(const bf16x8*)(vp), v01 = *(const bf16x8*)(vp + 32 * SEQ), v10 = *(const bf16x8*)(vp + 16), v11 = *(const bf16x8*)(vp + 32 * SEQ + 16);
        f32x16 p;
#pragma unroll
        for (int i = 0; i < 16; ++i) p[i] = 0.f;
#pragma unroll
        for (int s = 0; s < DKS; ++s) p = MFMA32(kf[s], qf[s], p);
        if (kt == qb || (window != 0 && kt == qb - (window >> 5))) {
            const int k0 = 32 * kt + 8 * h;
#pragma unroll
            for (int i = 0; i < 16; ++i) { const int kv = k0 + 16 * (i >> 3) + (i & 7); const bool ok = (kv <= q) && (window == 0 || kv > q - window); if (!ok) p[i] = -INFINITY; }
        }
        float rm = p[0];
#pragma unroll
        for (int i = 1; i < 16; ++i) rm = fmaxf(rm, p[i]);
        rm = fmaxf(rm, __shfl_xor(rm, 32));
        if (__any(rm > m + 6.f)) {
            const float mn = fmaxf(m, rm), f = ex2(m - mn); m = mn; l *= f;
#pragma unroll
            for (int i = 0; i < 16; ++i) { const float fi = __shfl(f, crow(i, h)); o0[i] *= fi; o1[i] *= fi; }
        }
        float e[16];
#pragma unroll
        for (int i = 0; i < 16; ++i) { e[i] = ex2(p[i] - m); l += e[i]; }
        const bf16x8 pa0 = pack8(e), pa1 = pack8(e + 8);
        o0 = MFMA32(pa0, v00, o0); o1 = MFMA32(pa0, v01, o1);
        o0 = MFMA32(pa1, v10, o0); o1 = MFMA32(pa1, v11, o1);
#pragma unroll
        for (int s = 0; s < DKS; ++s) kf[s] = kn[s];
        kp += (size_t)32 * kpitch; vp += 32;
    }
    l += __shfl_xor(l, 32);
    if (SINK) l += ex2(sink2 - m);
    const float inv = 1.f / l;
    LAS bf16_t* sp = stg + (4 * h) * 64 + r;
#pragma unroll
    for (int i = 0; i < 16; ++i) { const float fi = __shfl(inv, crow(i, h)); const int ro = ((i & 3) + 8 * (i >> 2)) * 64;
        sp[ro] = f2bf(o0[i] * fi); sp[ro + 32] = f2bf(o1[i] * fi); }
    o_flush(stg, Orow0, opitch, lane);
}

__device__ __forceinline__ void sb_unit(const bf16_t* __restrict__ Qrow0, int qpitch, const bf16_t* __restrict__ Kb, int kpitch, const bf16_t* __restrict__ VT,
                                        int qb, bf16_t* __restrict__ Orow0, int opitch, int lane, LAS bf16_t* stg) {
    const int r = lane & 31, h = lane >> 5;
    const int pr = (r & ~12) | ((r & 8) >> 1) | ((r & 4) << 1);
    bf16x8 qf[4];
#pragma unroll
    for (int s = 0; s < 4; ++s) qf[s] = *(const bf16x8*)(Qrow0 + (size_t)r * qpitch + 16 * s + 8 * h);
    f32x16 o0, o1;
#pragma unroll
    for (int i = 0; i < 16; ++i) { o0[i] = 0.f; o1[i] = 0.f; }
    float carry = 0.f;
    const int q = 32 * qb + r;
    const bf16_t* kp = Kb + (size_t)(32 * qb + pr) * kpitch + 8 * h;
    const bf16_t* vp = VT + (size_t)r * SEQ + 32 * qb + 8 * h;
    bf16x8 kf[4];
#pragma unroll
    for (int s = 0; s < 4; ++s) kf[s] = *(const bf16x8*)(kp + 16 * s);
    for (int kt = qb; kt >= 0; --kt) {
        bf16x8 kn[4];
        if (kt > 0) {
#pragma unroll
            for (int s = 0; s < 4; ++s) kn[s] = *(const bf16x8*)(kp - (size_t)32 * kpitch + 16 * s);
        } else {
#pragma unroll
            for (int s = 0; s < 4; ++s) kn[s] = kf[s];
        }
        const bf16x8 v00 = *(const bf16x8*)(vp), v01 = *(const bf16x8*)(vp + 32 * SEQ), v10 = *(const bf16x8*)(vp + 16), v11 = *(const bf16x8*)(vp + 32 * SEQ + 16);
        f32x16 p;
#pragma unroll
        for (int i = 0; i < 16; ++i) p[i] = 0.f;
#pragma unroll
        for (int s = 0; s < 4; ++s) p = MFMA32(kf[s], qf[s], p);
        const bool diag = (kt == qb);
        const int k0 = 32 * kt + 8 * h;
        float sfx[16];
#pragma unroll
        for (int i = 0; i < 16; ++i) {
            const float z = p[i];
            float L = -(fmaxf(z, 0.f) + lg2(1.f + ex2(-fabsf(z))));
            if (diag) { const int kv = k0 + 16 * (i >> 3) + (i & 7); if (!(kv < q)) L = 0.f; }
            sfx[i] = L;
        }
#pragma unroll
        for (int g = 0; g < 2; ++g)
#pragma unroll
            for (int j = 6; j >= 0; --j) sfx[8 * g + j] += sfx[8 * g + j + 1];
        const float T0 = sfx[0], T1 = sfx[8];
        const float TP0 = __shfl_xor(T0, 32), TP1 = __shfl_xor(T1, 32);
        const float off1 = (h ? 0.f : TP1) + carry, off0 = T1 + TP1 + (h ? 0.f : TP0) + carry;
        float e[16];
#pragma unroll
        for (int i = 0; i < 16; ++i) {
            float a = ex2(p[i] + sfx[i] + (i < 8 ? off0 : off1));
            if (diag) { const int kv = k0 + 16 * (i >> 3) + (i & 7); if (!(kv < q)) a = 0.f; }
            e[i] = a;
        }
        carry += (T0 + T1) + (TP0 + TP1);
        const bf16x8 pa0 = pack8(e), pa1 = pack8(e + 8);
        o0 = MFMA32(pa0, v00, o0); o1 = MFMA32(pa0, v01, o1);
        o0 = MFMA32(pa1, v10, o0); o1 = MFMA32(pa1, v11, o1);
        if (__all(carry < -150.f)) break;
#pragma unroll
        for (int s = 0; s < 4; ++s) kf[s] = kn[s];
        kp -= (size_t)32 * kpitch; vp -= 32;
    }
    LAS bf16_t* sp = stg + (4 * h) * 64 + r;
#pragma unroll
    for (int i = 0; i < 16; ++i) { const int ro = ((i & 3) + 8 * (i >> 2)) * 64; sp[ro] = f2bf(o0[i]); sp[ro + 32] = f2bf(o1[i]); }
    o_flush(stg, Orow0, opitch, lane);
}

#define XB_TMO      128
#define XB_XCNT(j)  (256  + 64 * (j))
#define XB_XSUB(j)  (1280 + 64 * (j))
#define XB_XGEN(j)  (2304 + 64 * (j))
#define XB_TOP      3328
#define XB_TOPGEN   3392
#define XCD_BAR_WORDS 3456
#define XB_SPIN_CAP (1u << 18)

__device__ __forceinline__ unsigned xb_ld(unsigned* p)              { return __hip_atomic_load(p, __ATOMIC_RELAXED, __HIP_MEMORY_SCOPE_AGENT); }
__device__ __forceinline__ unsigned xb_add(unsigned* p, unsigned v) { return __hip_atomic_fetch_add(p, v, __ATOMIC_RELAXED, __HIP_MEMORY_SCOPE_AGENT); }
__device__ __forceinline__ unsigned xb_xcc_id() { return (unsigned)__builtin_amdgcn_s_getreg((3 << 11) | 20) & 0xFu; }
#define XB_SPIN(cond, bar) do { unsigned _sp = 0; while (cond) { __builtin_amdgcn_s_sleep(1); \
    if ((++_sp & 255u) == 0u) { if (xb_ld(&(bar)[XB_TMO])) break; if (_sp > XB_SPIN_CAP) { atomicAdd(&(bar)[XB_TMO], 1u); break; } } } } while (0)

struct XcdBarrier {
    unsigned* bar; unsigned x;
    volatile LAS unsigned* st;
};

__device__ __forceinline__ XcdBarrier xcd_barrier_post(unsigned* bar, volatile LAS unsigned* st) {
    XcdBarrier b; b.bar = bar; b.x = xb_xcc_id(); b.st = st;
    if (threadIdx.x == 0) (void)xb_add(&bar[XB_XCNT(b.x)], 1u);
    return b;
}
__device__ __forceinline__ void xcd_barrier_complete(unsigned* bar, unsigned x, unsigned& nloc, unsigned& nx) {
    const unsigned G = gridDim.x * gridDim.y * gridDim.z;
    unsigned sum, cnt, mine, sp = 0u;
    for (;;) {
        sum = 0u; cnt = 0u; mine = 0u;
#pragma unroll
        for (unsigned j = 0; j < 16; ++j) { const unsigned c = xb_ld(&bar[XB_XCNT(j)]); sum += c; cnt += (c > 0u) ? 1u : 0u; mine = (j == x) ? c : mine; }
        if (sum == G) break;
        __builtin_amdgcn_s_sleep(1);
        if ((++sp & 255u) == 0u) { if (xb_ld(&bar[XB_TMO])) break; if (sp > XB_SPIN_CAP) { atomicAdd(&bar[XB_TMO], 1u); break; } }
    }
    nloc = mine > 0u ? mine : 1u; nx = cnt > 0u ? cnt : 1u;
}

__device__ __forceinline__ void xcd_barrier(const XcdBarrier& b) {
    asm volatile("s_waitcnt vmcnt(0)" ::: "memory");
    __syncthreads();
    if (threadIdx.x == 0) {
        unsigned* bar = b.bar;
        __builtin_amdgcn_s_waitcnt(0);
        unsigned nloc = b.st[0], nx = b.st[1];
        if (nloc == 0u) { xcd_barrier_complete(bar, b.x, nloc, nx); b.st[0] = nloc; b.st[1] = nx; }
        const unsigned old = xb_add(&bar[XB_XSUB(b.x)], 1u);
        const unsigned gen = old / nloc;
        if (old + 1u == (gen + 1u) * nloc) {
            __builtin_amdgcn_fence(__ATOMIC_RELEASE, "agent");
            asm volatile("s_waitcnt vmcnt(0)" ::: "memory");
            const unsigned og = xb_add(&bar[XB_TOP], 1u);
            const unsigned tg = og / nx;
            if (og + 1u == (tg + 1u) * nx) xb_add(&bar[XB_TOPGEN], 1u);
            else XB_SPIN(xb_ld(&bar[XB_TOPGEN]) == tg, bar);
            __builtin_amdgcn_fence(__ATOMIC_ACQUIRE, "agent");
            xb_add(&bar[XB_XGEN(b.x)], 1u);
            asm volatile("s_waitcnt vmcnt(0)" ::: "memory");
        } else {
            XB_SPIN(xb_ld(&bar[XB_XGEN(b.x)]) == gen, bar);
            __builtin_amdgcn_fence(__ATOMIC_ACQUIRE, "agent");
            asm volatile("s_waitcnt vmcnt(0)" ::: "memory");
        }
    }
    __syncthreads();
}

__global__ void __launch_bounds__(NTHREADS, 2) fwd(Params P) {
    extern __shared__ __attribute__((aligned(16))) unsigned char lds_raw[];
    LAS unsigned char* lds = (LAS unsigned char*)lds_raw;
    const int G = gridDim.x, bx = blockIdx.x, NGW = G * NWAVES, gthreads = G * NTHREADS;
    unsigned char* ws = P.ws;
    unsigned* ctl = (unsigned*)(ws + WS_CTL);
    bf16_t* XN = (bf16_t*)(ws + WS_XN); bf16_t* H = (bf16_t*)(ws + WS_H);
    bf16_t* QC = (bf16_t*)(ws + WS_QC); bf16_t* KC = (bf16_t*)(ws + WS_KC);
    bf16_t* VTC = (bf16_t*)(ws + WS_VTC); bf16_t* VTA = (bf16_t*)(ws + WS_VTA); bf16_t* VTD = (bf16_t*)(ws + WS_VTD);
    bf16_t* Y = (bf16_t*)(ws + WS_Y);
#if MK_COOP
    cooperative_groups::grid_group grid = cooperative_groups::this_grid();
    volatile LAS unsigned* MISC = (volatile LAS unsigned*)(lds + 131072);
    if (threadIdx.x < 64) MISC[threadIdx.x] = 0u;
    __syncthreads();
    XcdBarrier bar = xcd_barrier_post(ctl + CW_BAR, MISC + 8);
#endif
    for (int ph = P.ph_lo; ph < P.ph_hi; ++ph) {
        int tid_o = threadIdx.x; asm volatile("" : "+v"(tid_o));
        const int tid = tid_o, lane = tid & 63, wave = __builtin_amdgcn_readfirstlane(tid >> 6);
        const int gw = bx * NWAVES + wave, gtid = bx * NTHREADS + tid;
        LAS bf16_t* stg = (LAS bf16_t*)(lds + wave * 4096);
        if (ph == 0) {
            for (int l = 0; l < NLAYER; ++l) {
                conv_wT(P.w_in + (size_t)l * DM * DIN, DM, DIN, DINP, P.norm_pre + l * DM, (bf16_t*)(ws + WS_WIN) + (size_t)l * DINP * DM, C_AQ, C_AQ + 256, C_DQ, C_DQ + 256, SC64, gtid, gthreads);
                conv_wT(P.w_out + (size_t)l * DM * DM, DM, DM, DM, P.g_grp + l * DM, (bf16_t*)(ws + WS_WOUT) + (size_t)l * DM * DM, 0, 0, 0, 0, 1.f, gtid, gthreads);
                conv_wT(P.w_uq + (size_t)l * 256 * 384, 256, 384, 384, P.g_cq + l * 256, (bf16_t*)(ws + WS_WUQ + (size_t)l * 262144), 0, 0, 0, 0, 1.f, gtid, gthreads);
                conv_wT(P.w_ukv + (size_t)l * 128 * 512, 128, 512, 512, P.g_ckv + l * 128, (bf16_t*)(ws + WS_WUKV + (size_t)l * 131072), 0, 0, 0, 0, 1.f, gtid, gthreads);
            }
            for (int mrow = gw; mrow < M_TOK; mrow += NGW) rms_row_to_bf16(P.x + (size_t)mrow * DM, XN + (size_t)mrow * DM, lane);
        } else {
            const int l = (ph - 1) / 6, k = (ph - 1) % 6;
            if (k == 0 || k == 4) {
                if (k == 0) {
                    pg8::Gemm g{XN, (const bf16_t*)(ws + WS_WIN) + (size_t)l * DINP * DM, M_TOK, DINP, DM}; pg8::StaticOrder S; S.init(M_TOK, DINP, G, bx);
                    pg8::EpiBf16<0> E{H, DINP, nullptr, 0, 0, 1.f};
                    pg8::gemm_phase<pg8::EpiBf16<0>, pg8::StaticOrder, true, true>(lds, g, S, E);
                } else {
                    pg8::Gemm g{XN, (const bf16_t*)(ws + WS_WOUT) + (size_t)l * DM * DM, M_TOK, DM, DM}; pg8::StaticOrder S; S.init(M_TOK, DM, G, bx);
                    pg8::EpiBf16<0> E{Y, DM, nullptr, 0, 0, 1.f};
                    pg8::gemm_phase<pg8::EpiBf16<0>, pg8::StaticOrder, true, true>(lds, g, S, E);
                }
            } else if (k == 1) {
                const bf16_t* WUQ = (const bf16_t*)(ws + WS_WUQ + (size_t)l * 262144);
                const bf16_t* WUKV = (const bf16_t*)(ws + WS_WUKV + (size_t)l * 131072);
                constexpr int NTB = M_TOK / 32;
                constexpr int U_MQ = NTB * 4, U_MKV = NTB * 4, U_VTA = NTB * 2, U_VTD = NTB * 4, U_CONV = NTB;
                constexpr int U_ALL = U_MQ + U_MKV + U_VTA + U_VTD + U_CONV;
                for (int u = gw; u < U_ALL; u += NGW) {
                    int v = u;
                    if (v < U_MQ) { mq_unit(H, WUQ, P.pos, QC, v >> 2, v & 3, lane); continue; } v -= U_MQ;
                    if (v < U_MKV) { mkv_unit(H, WUKV, P.pos, KC, VTC, v >> 2, v & 3, lane, stg); continue; } v -= U_MKV;
                    if (v < U_VTA) { vt_unit(H, C_AV, 2, VTA, v >> 1, v & 1, lane, stg); continue; } v -= U_VTA;
                    if (v < U_VTD) { vt_unit(H, C_DV, 4, VTD, v >> 2, v & 3, lane, stg); continue; } v -= U_VTD;
                    conv_unit(H, P.conv_w + l * 768, P.conv_b + l * 256, Y, v, lane);
                }
            } else if (k == 2) {
                for (int pu = bx; pu < 256; pu += G) {
                    const int bh = pu & 7, Gq = pu >> 3, b = bh >> 2, hh = bh & 3;
                    const int qb = (wave < 4) ? (4 * Gq + wave) : (4 * (63 - Gq) + (wave - 4));
                    const size_t row0 = (size_t)b * SEQ + 32 * qb;
                    softmax_unit<6, false>(QC + row0 * 384 + hh * 96, 384, KC + (size_t)b * SEQ * 384 + hh * 96, 384, VTC + (size_t)(b * 4 + hh) * 64 * SEQ,
                                           qb, 0, 0, 0.f, Y + row0 * DM + 512 + hh * 64, DM, lane, stg);
                }
                for (;;) {
                    unsigned u = 0;
                    if (lane == 0) u = atomicAdd(ctl + 64 * l, 1u);
                    u = (unsigned)__builtin_amdgcn_readfirstlane((int)u);
                    if (u >= 4096u) break;
                    const int v = (int)(u & 2047u), bh = v >> 8, qb = v & 255, b = bh >> 2, hh = bh & 3;
                    const size_t row0 = (size_t)b * SEQ + 32 * qb;
                    if (u < 2048u) {
                        sb_unit(H + row0 * DINP + C_DQ + hh * 64, DINP, H + (size_t)b * SEQ * DINP + C_DK + hh * 64, DINP, VTD + (size_t)(b * 4 + hh) * 64 * SEQ,
                                qb, Y + row0 * DM + 768 + hh * 64, DM, lane, stg);
                    } else {
                        const int kvh = hh >> 1;
                        const int ktb = qb - 4 > 0 ? qb - 4 : 0;
                        softmax_unit<4, true>(H + row0 * DINP + C_AQ + hh * 64, DINP, H + (size_t)b * SEQ * DINP + C_AK + kvh * 64, DINP, VTA + (size_t)(b * 2 + kvh) * 64 * SEQ,
                                              qb, ktb, 128, P.sinks[l * 4 + hh] * LOG2E, Y + row0 * DM + hh * 64, DM, lane, stg);
                    }
                }
            } else if (k == 3) {
                for (int mrow = gw; mrow < M_TOK; mrow += NGW) {
                    const u32x4* yp = (const u32x4*)(Y + (size_t)mrow * DM) + 2 * lane;
                    const u32x4* gp = (const u32x4*)(H + (size_t)mrow * DINP + C_GATE) + 2 * lane;
                    const u32x4 y0 = yp[0], y1 = yp[1], g0 = gp[0], g1 = gp[1];
                    float yv[16], gv[16];
#pragma unroll
                    for (int j = 0; j < 4; ++j) { yv[2 * j] = bflo(y0[j]); yv[2 * j + 1] = bfhi(y0[j]); yv[8 + 2 * j] = bflo(y1[j]); yv[8 + 2 * j + 1] = bfhi(y1[j]);
                                                  gv[2 * j] = bflo(g0[j]); gv[2 * j + 1] = bfhi(g0[j]); gv[8 + 2 * j] = bflo(g1[j]); gv[8 + 2 * j + 1] = bfhi(g1[j]); }
                    float ss = 0.f;
#pragma unroll
                    for (int j = 0; j < 16; ++j) ss += yv[j] * yv[j];
                    ss += __shfl_xor(ss, 1); ss += __shfl_xor(ss, 2); ss += __shfl_xor(ss, 4); ss += __shfl_xor(ss, 8);
                    const float rs = rsqrtf(ss * (1.f / 256.f) + EPS);
                    float o[16];
#pragma unroll
                    for (int j = 0; j < 16; ++j) { const float gg = gv[j]; o[j] = yv[j] * rs * gg * __builtin_amdgcn_rcpf(1.f + ex2(-gg * LOG2E)); }
                    u32x4 w0, w1;
#pragma unroll
                    for (int j = 0; j < 4; ++j) { w0[j] = pk2(o[2 * j], o[2 * j + 1]); w1[j] = pk2(o[8 + 2 * j], o[8 + 2 * j + 1]); }
                    u32x4* op = (u32x4*)(XN + (size_t)mrow * DM) + 2 * lane;
                    op[0] = w0; op[1] = w1;
                }
            } else {
                const float* base = (l == 0) ? P.x : P.out;
                const float* gpost = P.g_post + l * DM;
                for (int mrow = gw; mrow < M_TOK; mrow += NGW) {
                    f32x4 zz[4], xv[4]; float s1 = 0.f;
#pragma unroll
                    for (int j = 0; j < 4; ++j) { const u32x2 w = ((const u32x2*)(Y + (size_t)mrow * DM))[lane + 64 * j]; zz[j] = (f32x4){bflo(w.x), bfhi(w.x), bflo(w.y), bfhi(w.y)};
                        xv[j] = ((const f32x4*)(base + (size_t)mrow * DM))[lane + 64 * j];
                        s1 += (zz[j].x * zz[j].x + zz[j].y * zz[j].y) + (zz[j].z * zz[j].z + zz[j].w * zz[j].w); }
                    const float rz = rsqrtf(wave_sum(s1) * (1.f / DM) + EPS);
                    float s2 = 0.f;
#pragma unroll
                    for (int j = 0; j < 4; ++j) { const f32x4 gpv = ((const f32x4*)gpost)[lane + 64 * j]; xv[j] = xv[j] + zz[j] * rz * gpv;
                        s2 += (xv[j].x * xv[j].x + xv[j].y * xv[j].y) + (xv[j].z * xv[j].z + xv[j].w * xv[j].w);
                        ((f32x4*)(P.out + (size_t)mrow * DM))[lane + 64 * j] = xv[j]; }
                    if (l + 1 < NLAYER) {
                        const float rs = rsqrtf(wave_sum(s2) * (1.f / DM) + EPS);
#pragma unroll
                        for (int j = 0; j < 4; ++j) { u32x2 o; o.x = pk2(xv[j].x * rs, xv[j].y * rs); o.y = pk2(xv[j].z * rs, xv[j].w * rs); ((u32x2*)(XN + (size_t)mrow * DM))[lane + 64 * j] = o; }
                    }
                }
            }
        }
        if (ph + 1 < P.ph_hi) {
#if MK_COOP
            if (ph == 0) grid.sync();
            else xcd_barrier(bar);
#endif
        }
    }
}
}

extern "C" void kernel_launch(void* const* d_in, const int* in_sizes, int n_in, void* d_out, int out_size, void* d_ws, size_t ws_size, hipStream_t stream) {
    using namespace mk;
    static int grid = 0;
    if (grid == 0) {
        if (n_in != 14 || out_size != M_TOK * DM || ws_size < WS_END) { fprintf(stderr, "kernel_launch: unexpected shapes (n_in %d out %d ws %zu)\n", n_in, out_size, ws_size); grid = -1; return; }
        int dev = 0, cus = 0, per_cu = 0;
        (void)hipGetDevice(&dev); (void)hipDeviceGetAttribute(&cus, hipDeviceAttributeMultiprocessorCount, dev);
        if (hipFuncSetAttribute((const void*)fwd, hipFuncAttributeMaxDynamicSharedMemorySize, LDS_BYTES) != hipSuccess) { fprintf(stderr, "kernel_launch: hipFuncSetAttribute failed\n"); grid = -1; return; }
        if (hipOccupancyMaxActiveBlocksPerMultiprocessor(&per_cu, (const void*)fwd, NTHREADS, LDS_BYTES) != hipSuccess || per_cu < 1) { fprintf(stderr, "kernel_launch: occupancy query says %d\n", per_cu); per_cu = 1; }
        (void)hipGetLastError();
        grid = cus * 1;
        if (grid > 256) grid = 256;
    }
    if (grid < 0) return;
    (void)hipMemsetAsync((char*)d_ws + WS_CTL, 0, CTL_BYTES, stream);
    Params p{};
    p.x = (const float*)d_in[0]; p.pos = (const int*)d_in[1]; p.norm_pre = (const float*)d_in[2]; p.w_in = (const float*)d_in[3]; p.sinks = (const float*)d_in[4];
    p.conv_w = (const float*)d_in[5]; p.conv_b = (const float*)d_in[6]; p.g_cq = (const float*)d_in[7]; p.w_uq = (const float*)d_in[8]; p.g_ckv = (const float*)d_in[9];
    p.w_ukv = (const float*)d_in[10]; p.g_grp = (const float*)d_in[11]; p.w_out = (const float*)d_in[12]; p.g_post = (const float*)d_in[13];
    p.out = (float*)d_out; p.ws = (unsigned char*)d_ws;
    constexpr int NPH = 1 + 6 * NLAYER;
#if MK_COOP
    p.ph_lo = 0; p.ph_hi = NPH;
    void* args[] = {&p};
    hipError_t e = hipLaunchCooperativeKernel((const void*)fwd, dim3(grid), dim3(NTHREADS), args, LDS_BYTES, stream);
    if (e != hipSuccess) fprintf(stderr, "kernel_launch: cooperative launch failed: %s (grid %d)\n", hipGetErrorString(e), grid);
#else
    for (int ph = 0; ph < NPH; ++ph) { p.ph_lo = ph; p.ph_hi = ph + 1; hipLaunchKernelGGL(fwd, dim3(grid), dim3(NTHREADS), LDS_BYTES, stream, p); }
#endif
}
```

```cpp
#include <hip/hip_runtime.h>
#include <hip/hip_cooperative_groups.h>
#include <cstdio>
#include <cstdint>
#include <cmath>
namespace pg8 {
#define PG8_LAS __attribute__((address_space(3)))
typedef unsigned short bf16_t;
typedef short bf16x8 __attribute__((ext_vector_type(8)));
typedef float f32x4 __attribute__((ext_vector_type(4)));
typedef unsigned u32x4 __attribute__((ext_vector_type(4)));
constexpr int BM = 256, BK = 64, HALF = 128, HTB = HALF * BK * 2  , STAGE_BYTES = 8 * HTB, NXCD = 8, WGM = 8;

__host__ __device__ __forceinline__ int lds_byte(int r, int c) { const int st = (r >> 4) * 2 + (c >> 5), rr = r & 15, cc = c & 31, ob = rr * 64 + cc * 2; return st * 1024 + (ob ^ (((ob >> 9) & 1) << 5)); }
__host__ __device__ __forceinline__ void stage_rc(int b, int& R, int& C) { const int st = b / 1024, sb = b % 1024, swz = sb ^ (((sb >> 9) & 1) << 5); R = (st >> 1) * 16 + swz / 64; C = (st & 1) * 32 + (swz % 64) / 2; }
__host__ __device__ __forceinline__ int perm32(int rho) { const int n = rho >> 4, i = rho & 15; return 8 * (i >> 2) + 4 * n + (i & 3); }

struct Unit { int pm, pn; };
struct Gemm { const bf16_t* A; const bf16_t* Bt; int M, N, K; };

struct StaticOrder {
    int nM, nN, nwg, G, c;
    __host__ __device__ void init(int M, int N, int G_, int c_) { nM = M / BM; nN = N / BM; nwg = nM * nN; G = G_; c = c_; }
    __host__ __device__ bool next(int i, Unit& u) const {
        const long L = (long)i * G + c; if (L >= nwg) return false;
        int wgid = (int)L; { const int q = nwg / NXCD, r = nwg % NXCD, xcd = wgid % NXCD, off = wgid / NXCD; wgid = (xcd < r ? xcd * (q + 1) : r * (q + 1) + (xcd - r) * q) + off; }
        const int nig = WGM * nN, gid = wgid / nig, fm = gid * WGM, gsz = (nM - fm) < WGM ? (nM - fm) : WGM;
        u.pm = fm + ((wgid % nig) % gsz); u.pn = (wgid % nig) / gsz; return true;
    }
    __device__ __forceinline__ void a_ready(const Unit&) const {}
    __device__ __forceinline__ void done(const Unit&) const {}
};

__device__ __forceinline__ unsigned cvt_pk_bf16(float lo, float hi) { unsigned r; asm volatile("v_cvt_pk_bf16_f32 %0, %1, %2" : "=v"(r) : "v"(lo), "v"(hi)); return r; }
typedef float f32x2 __attribute__((ext_vector_type(2)));
__device__ __forceinline__ f32x2 gelu_pk(f32x2 v) {
    const f32x2 av = __builtin_elementwise_abs(v), d = av * 0.2316418882f + 1.0f;
    f32x2 t; t.x = __builtin_amdgcn_rcpf(d.x); t.y = __builtin_amdgcn_rcpf(d.y);
    f32x2 q = t * 0.5307027145f + (-0.7265760135f); q = q * t + 0.7107068705f; q = q * t + (-0.142248368f); q = q * t + 0.127414796f; q = q * t;
    const f32x2 s = (v * v) * (-0.72134752044f);
    f32x2 e; e.x = __builtin_amdgcn_exp2f(s.x); e.y = __builtin_amdgcn_exp2f(s.y);
    const f32x2 m = v * (q * e), r = v - m;
    f32x2 o; o.x = v.x < 0.f ? m.x : r.x; o.y = v.y < 0.f ? m.y : r.y; return o;
}

template <int ACT  > struct EpiBf16 {
    static constexpr bool PERM = true, AFTER_DRAIN = false; static_assert(ACT == 0 || ACT == 1, "EpiBf16: ACT is 0 (none) or 1 (gelu_pk)");
    bf16_t* O; int ldc; const float* bias; int split_cols; size_t split_stride; float scale0;
    __device__ __forceinline__ void operator()(const f32x4 (&acc)[2][2][4][2], const Unit& u, int wr, int wc, int fr, int fq) const {
        const int row0 = u.pm * BM + wr * 64 + fr; int colt = u.pn * BM; bf16_t* base = O;
        float sc = 1.f; if (split_cols) { const int t = colt / split_cols; base += (size_t)t * split_stride; colt -= t * split_cols; if (t == 0) sc = scale0; }
        const int col0 = colt + wc * 32 + 8 * fq, bcol0 = u.pn * BM + wc * 32 + 8 * fq;
        f32x4 bv[2][2];
#pragma unroll
        for (int bj = 0; bj < 2; ++bj)
#pragma unroll
            for (int n = 0; n < 2; ++n) bv[bj][n] = bias ? *(const f32x4*)(bias + bcol0 + bj * HALF + 4 * n) : (f32x4){0.f, 0.f, 0.f, 0.f};
#pragma unroll
        for (int ai = 0; ai < 2; ++ai)
#pragma unroll
            for (int m = 0; m < 4; ++m) { bf16_t* rowp = base + (size_t)(row0 + ai * HALF + m * 16) * ldc + col0;
#pragma unroll
                for (int bj = 0; bj < 2; ++bj) { f32x4 v0 = acc[ai][bj][m][0] + bv[bj][0], v1 = acc[ai][bj][m][1] + bv[bj][1];
                    if (ACT == 1) { f32x2 a = gelu_pk((f32x2){v0[0], v0[1]}), b = gelu_pk((f32x2){v0[2], v0[3]}), c = gelu_pk((f32x2){v1[0], v1[1]}), d = gelu_pk((f32x2){v1[2], v1[3]});
                        v0 = (f32x4){a.x, a.y, b.x, b.y}; v1 = (f32x4){c.x, c.y, d.x, d.y}; }
                    v0 = v0 * sc; v1 = v1 * sc; u32x4 w; w.x = cvt_pk_bf16(v0[0], v0[1]); w.y = cvt_pk_bf16(v0[2], v0[3]); w.z = cvt_pk_bf16(v1[0], v1[1]); w.w = cvt_pk_bf16(v1[2], v1[3]);
                    *(u32x4*)(rowp + bj * HALF) = w; } }
    }
};
template <class Epi, class Sched, bool ALIGN_EPI = false, bool SP2 = false>
__device__ __forceinline__ void gemm_phase(PG8_LAS unsigned char* lds, const Gemm g, const Sched& S, const Epi& E) {
    int tid_o = threadIdx.x; asm volatile("" : "+v"(tid_o));
    const int tid = tid_o, wid = __builtin_amdgcn_readfirstlane(tid >> 6), lane = tid & 63, wr = wid >> 2, wc = wid & 3, fr = lane & 15, fq = lane >> 4;
    const int K = g.K, nt = K / BK;
    unsigned voffA[2], voffB[2];
#pragma unroll
    for (int i = 0; i < 2; ++i) { int R, C; stage_rc(tid * 16 + i * 8192, R, C); const int Rb = Epi::PERM ? ((R & ~31) + perm32(R & 31)) : R;
        voffA[i] = (unsigned)(R * K + C) * 2u; voffB[i] = (unsigned)(Rb * K + C) * 2u; }
    const size_t kstep = (size_t)(BK * 2);
    const size_t hstep = (size_t)HALF * K * 2;
    const size_t tstep = 2 * hstep;
    const unsigned ldsw = (unsigned)wid * 1024u;
    const int aoff = lds_byte(wr * 64 + fr, fq * 8), boff = lds_byte(wc * 32 + fr, fq * 8);
#define PG8_SA(b, h) (((b) * 2 + (h)) * HTB)
#define PG8_SB(b, h) ((4 + (b) * 2 + (h)) * HTB)
#define PG8_STAGE(bufoff, gbase, voff) do { _Pragma("unroll") for (int _i = 0; _i < 2; ++_i) \
        __builtin_amdgcn_global_load_lds((const unsigned*)((const char*)(gbase) + (voff)[_i]), (PG8_LAS unsigned*)(lds + (bufoff) + ldsw + _i * 8192), 16, 0, 0); } while (0)
#define PG8_LDA(dst, b, h) do { _Pragma("unroll") for (int m = 0; m < 4; ++m) _Pragma("unroll") for (int k = 0; k < 2; ++k) dst[m][k] = *(const PG8_LAS bf16x8*)(lds + PG8_SA(b, h) + aoff + m * 2048 + k * 1024); } while (0)
#define PG8_LDB(dst, b, h) do { _Pragma("unroll") for (int n = 0; n < 2; ++n) _Pragma("unroll") for (int k = 0; k < 2; ++k) dst[n][k] = *(const PG8_LAS bf16x8*)(lds + PG8_SB(b, h) + boff + n * 2048 + k * 1024); } while (0)
#define PG8_MMA(ai, bj, At, Bt) do { __builtin_amdgcn_s_setprio(1); _Pragma("unroll") for (int m = 0; m < 4; ++m) _Pragma("unroll") for (int n = 0; n < 2; ++n) _Pragma("unroll") for (int k = 0; k < 2; ++k) \
        acc[ai][bj][m][n] = __builtin_amdgcn_mfma_f32_16x16x32_bf16(Bt[n][k], At[m][k], acc[ai][bj][m][n], 0, 0, 0); __builtin_amdgcn_s_setprio(0); } while (0)
#define PG8_WAIT_V(n) asm volatile("s_waitcnt vmcnt(" #n ")" ::: "memory")
#define PG8_WAIT_L(n) asm volatile("s_waitcnt lgkmcnt(" #n ")" ::: "memory")
#define PG8_BAR __builtin_amdgcn_s_barrier()
#define PG8_SCHED __builtin_amdgcn_sched_barrier(0)
    Unit cur, nxt; int ui = 0;
    if (!S.next(0, cur)) return;
    f32x4 acc[2][2][4][2];
#pragma unroll
    for (int a = 0; a < 2; ++a)
#pragma unroll
        for (int b = 0; b < 2; ++b)
#pragma unroll
            for (int m = 0; m < 4; ++m)
#pragma unroll
                for (int n = 0; n < 2; ++n) acc[a][b][m][n] = (f32x4){0.f, 0.f, 0.f, 0.f};
    bf16x8 At[4][2], B0[2][2], B1[2][2];
    const char* cA = (const char*)g.A + (size_t)cur.pm * tstep; const char* cB = (const char*)g.Bt + (size_t)cur.pn * tstep;
    S.a_ready(cur);
    if constexpr (SP2) {
        PG8_STAGE(PG8_SB(0, 0), cB, voffB); PG8_STAGE(PG8_SB(0, 1), cB + hstep, voffB); PG8_STAGE(PG8_SA(0, 0), cA, voffA); PG8_STAGE(PG8_SA(0, 1), cA + hstep, voffA);
        if (wr == 1) PG8_BAR;
        PG8_WAIT_V(2); PG8_BAR;
        PG8_STAGE(PG8_SB(1, 0), cB + kstep, voffB); PG8_STAGE(PG8_SA(1, 0), cA + kstep, voffA); PG8_STAGE(PG8_SB(1, 1), cB + hstep + kstep, voffB);
        PG8_WAIT_V(6); PG8_BAR;
    } else {
        PG8_STAGE(PG8_SB(0, 0), cB, voffB); PG8_STAGE(PG8_SA(0, 0), cA, voffA); PG8_STAGE(PG8_SB(0, 1), cB + hstep, voffB); PG8_STAGE(PG8_SA(0, 1), cA + hstep, voffA);
        if (wr == 1) PG8_BAR;
        PG8_WAIT_V(4); PG8_BAR;
        PG8_STAGE(PG8_SB(1, 0), cB + kstep, voffB); PG8_STAGE(PG8_SA(1, 0), cA + kstep, voffA); PG8_STAGE(PG8_SB(1, 1), cB + hstep + kstep, voffB);
        PG8_WAIT_V(6); PG8_BAR;
    }
    for (;;) {
        const bool has_next = S.next(ui + 1, nxt);
        const char* nA = has_next ? (const char*)g.A + (size_t)nxt.pm * tstep : cA; const char* nB = has_next ? (const char*)g.Bt + (size_t)nxt.pn * tstep : cB;
        for (int t = 0; t < nt; t += 2) {
            const bool last = (t == nt - 2);
            const char* a1 = cA + (size_t)(t + 1) * kstep;
            const char* a2 = last ? nA : cA + (size_t)(t + 2) * kstep; const char* b2 = last ? nB : cB + (size_t)(t + 2) * kstep;
            const char* a3 = a2 + kstep; const char* b3 = b2 + kstep;
            if (last && has_next) S.a_ready(nxt);
            if constexpr (SP2) {
            PG8_LDB(B0, 0, 0); PG8_LDB(B1, 0, 1); PG8_SCHED; PG8_LDA(At, 0, 0); PG8_STAGE(PG8_SA(1, 1), a1 + hstep, voffA);
            PG8_WAIT_V(8); PG8_WAIT_L(0); PG8_BAR; PG8_MMA(0, 0, At, B0); PG8_MMA(0, 1, At, B1); PG8_BAR; PG8_SCHED;
            PG8_LDA(At, 0, 1); PG8_STAGE(PG8_SB(0, 0), b2, voffB); PG8_STAGE(PG8_SB(0, 1), b2 + hstep, voffB); PG8_STAGE(PG8_SA(0, 0), a2, voffA);
            PG8_WAIT_V(8); PG8_WAIT_L(0); PG8_BAR; PG8_MMA(1, 0, At, B0); PG8_MMA(1, 1, At, B1); PG8_BAR; PG8_SCHED;
            PG8_LDB(B0, 1, 0); PG8_LDB(B1, 1, 1); PG8_SCHED; PG8_LDA(At, 1, 0); PG8_STAGE(PG8_SA(0, 1), a2 + hstep, voffA);
            PG8_WAIT_V(8); PG8_WAIT_L(0); PG8_BAR; PG8_MMA(0, 0, At, B0); PG8_MMA(0, 1, At, B1); PG8_BAR; PG8_SCHED;
            PG8_LDA(At, 1, 1); PG8_STAGE(PG8_SB(1, 0), b3, voffB); PG8_STAGE(PG8_SB(1, 1), b3 + hstep, voffB); PG8_STAGE(PG8_SA(1, 0), a3, voffA);
            PG8_WAIT_V(8); PG8_WAIT_L(0); PG8_BAR; PG8_MMA(1, 0, At, B0); PG8_MMA(1, 1, At, B1); PG8_BAR; PG8_SCHED;
            } else {
            PG8_LDB(B0, 0, 0); PG8_SCHED; PG8_LDA(At, 0, 0); PG8_STAGE(PG8_SA(1, 1), a1 + hstep, voffA);
            PG8_WAIT_L(8); PG8_BAR; PG8_WAIT_L(0); PG8_MMA(0, 0, At, B0); PG8_BAR; PG8_SCHED;
            PG8_LDB(B1, 0, 1); PG8_STAGE(PG8_SB(0, 0), b2, voffB);
            PG8_BAR; PG8_WAIT_L(0); PG8_MMA(0, 1, At, B1); PG8_BAR;
            PG8_LDA(At, 0, 1); PG8_STAGE(PG8_SA(0, 0), a2, voffA);
            PG8_BAR; PG8_WAIT_L(0); PG8_MMA(1, 0, At, B0); PG8_BAR; PG8_SCHED;
            PG8_STAGE(PG8_SB(0, 1), b2 + hstep, voffB);
            PG8_WAIT_V(6); PG8_BAR; PG8_MMA(1, 1, At, B1); PG8_BAR;
            PG8_LDB(B0, 1, 0); PG8_SCHED; PG8_LDA(At, 1, 0); PG8_STAGE(PG8_SA(0, 1), a2 + hstep, voffA);
            PG8_WAIT_L(8); PG8_BAR; PG8_WAIT_L(0); PG8_MMA(0, 0, At, B0); PG8_BAR; PG8_SCHED;
            PG8_LDB(B1, 1, 1); PG8_STAGE(PG8_SB(1, 0), b3, voffB);
            PG8_BAR; PG8_WAIT_L(0); PG8_MMA(0, 1, At, B1); PG8_BAR;
            PG8_LDA(At, 1, 1); PG8_STAGE(PG8_SA(1, 0), a3, voffA);
            PG8_BAR; PG8_WAIT_L(0); PG8_MMA(1, 0, At, B0); PG8_BAR; PG8_SCHED;
            PG8_STAGE(PG8_SB(1, 1), b3 + hstep, voffB);
            PG8_WAIT_V(6); PG8_BAR; PG8_MMA(1, 1, At, B1); PG8_BAR;
            }
        }
        if constexpr (ALIGN_EPI) { if (wr == 0) PG8_BAR; }
        if constexpr (!Epi::AFTER_DRAIN) { E(acc, cur, wr, wc, fr, fq); S.done(cur); }
        if (!has_next) break;
#pragma unroll
        for (int a = 0; a < 2; ++a)
#pragma unroll
            for (int b = 0; b < 2; ++b)
#pragma unroll
                for (int m = 0; m < 4; ++m)
#pragma unroll
                    for (int n = 0; n < 2; ++n) acc[a][b][m][n] = (f32x4){0.f, 0.f, 0.f, 0.f};
        cur = nxt; cA = nA; cB = nB; ++ui;
        if constexpr (ALIGN_EPI) { if (wr == 1) PG8_BAR; }
    }
    PG8_WAIT_V(0);
    if constexpr (!ALIGN_EPI) { if (wr == 0) PG8_BAR; }
    PG8_BAR;
    if constexpr (Epi::AFTER_DRAIN) { E.fused(acc, cur, wr, wc, fr, fq, lds, wid, lane); S.done(cur); }
#undef PG8_SA
#undef PG8_SB
#undef PG8_STAGE
#undef PG8_LDA
#undef PG8_LDB
#undef PG8_MMA
#undef PG8_WAIT_V
#undef PG8_WAIT_L
#undef PG8_BAR
#undef PG8_SCHED
}
}
#ifndef MK_COOP
#define MK_COOP 1
#endif
#ifndef MK_REP_K
#define MK_REP_K -1
#endif
#ifndef MK_REP_N
#define MK_REP_N 1
#endif
namespace mk {
using pg8::bf16_t; using pg8::bf16x8; using pg8::f32x4; using pg8::u32x4;
typedef float f32x16 __attribute__((ext_vector_type(16)));
typedef unsigned u32x2 __attribute__((ext_vector_type(2)));
typedef float f32x2_t __attribute__((ext_vector_type(2)));
typedef __bf16 bf16x2_t __attribute__((ext_vector_type(2)));
#define LAS __attribute__((address_space(3)))
#define MFMA32(a, b, c) __builtin_amdgcn_mfma_f32_32x32x16_bf16((a), (b), (c), 0, 0, 0)

constexpr int M_TOK = 16384, SEQ = 8192, DM = 1024, DIN = 3488, DINP = 3584, NLAYER = 2;
constexpr int C_AQ = 0, C_AK = 256, C_AV = 384, C_BB = 512, C_BC = 768, C_BX = 1024, C_CQ = 1280, C_CKV = 1536, C_CKR = 1664,
              C_DQ = 1696, C_DK = 1952, C_DV = 2208, C_GATE = 2464;
constexpr float EPS = 1e-6f, LOG2E = 1.4426950408889634f;
constexpr float SC64 = 0.125f * LOG2E;
constexpr float QSC_MLA = 0.10206207261596575f * LOG2E;
constexpr int NWAVES = 8, NTHREADS = 512;
constexpr int LDS_BYTES = 131072 + 1024;

constexpr size_t MiB = 1u << 20;
constexpr size_t WS_CTL = 0, CTL_BYTES = 65536;
constexpr int CW_BAR = 1024;
constexpr size_t WS_WIN = 1 * MiB;
constexpr size_t WS_WOUT = 15 * MiB;
constexpr size_t WS_WUQ = 19 * MiB;
constexpr size_t WS_WUKV = 19 * MiB + 512 * 1024;
constexpr size_t WS_XN = 32 * MiB;
constexpr size_t WS_H = 64 * MiB;
constexpr size_t WS_QC = 176 * MiB;
constexpr size_t WS_KC = 188 * MiB;
constexpr size_t WS_VTC = 200 * MiB;
constexpr size_t WS_VTA = 208 * MiB;
constexpr size_t WS_VTD = 212 * MiB;
constexpr size_t WS_Y = 220 * MiB;
constexpr size_t WS_END = 252 * MiB;

struct Params {
    const float* x; const int* pos; const float* norm_pre; const float* w_in; const float* sinks; const float* conv_w; const float* conv_b;
    const float* g_cq; const float* w_uq; const float* g_ckv; const float* w_ukv; const float* g_grp; const float* w_out; const float* g_post;
    float* out; unsigned char* ws; int ph_lo, ph_hi;
};

__device__ __forceinline__ unsigned pk2(float lo, float hi) { f32x2_t v = {lo, hi}; bf16x2_t b = __builtin_convertvector(v, bf16x2_t); return __builtin_bit_cast(unsigned, b); }
__device__ __forceinline__ float bf2f(short s) { return __uint_as_float(((unsigned)(unsigned short)s) << 16); }
__device__ __forceinline__ float bflo(unsigned u) { return __uint_as_float(u << 16); }
__device__ __forceinline__ float bfhi(unsigned u) { return __uint_as_float(u & 0xffff0000u); }
__device__ __forceinline__ bf16_t f2bf(float f) { return (bf16_t)(pk2(f, 0.f) & 0xffffu); }
__device__ __forceinline__ int crow(int i, int h) { return (i & 3) + 8 * (i >> 2) + 4 * h; }
__device__ __forceinline__ float ex2(float x) { return __builtin_amdgcn_exp2f(x); }
__device__ __forceinline__ float lg2(float x) { return __builtin_amdgcn_logf(x); }
__device__ __forceinline__ float wave_sum(float v) {
#pragma unroll
    for (int o = 1; o < 64; o <<= 1) v += __shfl_xor(v, o);
    return v;
}
__device__ __forceinline__ bf16x8 pack8(const float* e) {
    u32x4 w; w.x = pk2(e[0], e[1]); w.y = pk2(e[2], e[3]); w.z = pk2(e[4], e[5]); w.w = pk2(e[6], e[7]);
    return __builtin_bit_cast(bf16x8, w);
}

__device__ __forceinline__ void conv_wT(const float* __restrict__ W, int K, int N, int NP, const float* __restrict__ gain, bf16_t* __restrict__ dst,
                                        int a0, int a1, int b0, int b1, float sc, int gtid, int gthreads) {
    const int k8n = K / 8; const int items = NP * k8n;
    for (int it = gtid; it < items; it += gthreads) {
        const int n = it % NP, k8 = it / NP;
        u32x4 o = {0u, 0u, 0u, 0u};
        if (n < N) {
            const float cs = ((n >= a0 && n < a1) || (n >= b0 && n < b1)) ? sc : 1.f;
            float v[8];
#pragma unroll
            for (int j = 0; j < 8; ++j) v[j] = W[(size_t)(k8 * 8 + j) * N + n] * gain[k8 * 8 + j] * cs;
            o.x = pk2(v[0], v[1]); o.y = pk2(v[2], v[3]); o.z = pk2(v[4], v[5]); o.w = pk2(v[6], v[7]);
        }
        *(u32x4*)(dst + (size_t)n * K + k8 * 8) = o;
    }
}
__device__ __forceinline__ void rms_row_to_bf16(const float* __restrict__ xrow, bf16_t* __restrict__ orow, int lane) {
    f32x4 v[4]; float s = 0.f;
#pragma unroll
    for (int j = 0; j < 4; ++j) { v[j] = ((const f32x4*)xrow)[lane + 64 * j]; s += (v[j].x * v[j].x + v[j].y * v[j].y) + (v[j].z * v[j].z + v[j].w * v[j].w); }
    const float rs = rsqrtf(wave_sum(s) * (1.f / DM) + EPS);
#pragma unroll
    for (int j = 0; j < 4; ++j) { u32x2 o; o.x = pk2(v[j].x * rs, v[j].y * rs); o.y = pk2(v[j].z * rs, v[j].w * rs); ((u32x2*)orow)[lane + 64 * j] = o; }
}

__device__ __forceinline__ void rope_cs(int pos, int h, float (&cs)[8], float (&sn)[8]) {
#pragma unroll
    for (int i = 0; i < 8; ++i) {
        const int f = (i & 3) + 8 * (i >> 2) + 4 * h;
        const float freq = ex2(-(float)f * 0.830482023721841f);
        const float ang = (float)pos * freq;
        const double rev = (double)ang * 0.15915494309189535;
        const float fr = (float)(rev - __builtin_rint(rev));
        cs[i] = __builtin_amdgcn_cosf(fr); sn[i] = __builtin_amdgcn_sinf(fr);
    }
}
__device__ __forceinline__ void rope_apply(f32x16& a, const float (&cs)[8], const float (&sn)[8]) {
#pragma unroll
    for (int i = 0; i < 8; ++i) { const float x1 = a[i], x2 = a[i + 8]; a[i] = x1 * cs[i] - x2 * sn[i]; a[i + 8] = x1 * sn[i] + x2 * cs[i]; }
}
__device__ __forceinline__ void store_tile_rowmajor(bf16_t* dst  , const f32x16& a, int h) {
#pragma unroll
    for (int g = 0; g < 4; ++g) { u32x2 o; o.x = pk2(a[4 * g], a[4 * g + 1]); o.y = pk2(a[4 * g + 2], a[4 * g + 3]); *(u32x2*)(dst + 8 * g + 4 * h) = o; }
}
__device__ __forceinline__ void mq_unit(const bf16_t* __restrict__ H, const bf16_t* __restrict__ WT, const int* __restrict__ pos, bf16_t* __restrict__ QC, int tb, int hh, int lane) {
    const int r = lane & 31, h = lane >> 5, tok = tb * 32 + r;
    const bf16_t* src = H + (size_t)tok * DINP + C_CQ + 8 * h;
    bf16x8 bfr[16]; float ss = 0.f;
#pragma unroll
    for (int s = 0; s < 16; ++s) { bfr[s] = *(const bf16x8*)(src + 16 * s);
#pragma unroll
        for (int j = 0; j < 8; ++j) { const float v = bf2f(bfr[s][j]); ss += v * v; } }
    ss += __shfl_xor(ss, 32);
    const float rs = rsqrtf(ss * (1.f / 256.f) + EPS) * QSC_MLA;
    float cs[8], sn[8]; rope_cs(pos[tok], h, cs, sn);
    const bf16_t* W = WT + (size_t)(hh * 96 + r) * 256 + 8 * h;
#pragma unroll 1
    for (int nt = 0; nt < 3; ++nt) {
        f32x16 acc;
#pragma unroll
        for (int i = 0; i < 16; ++i) acc[i] = 0.f;
#pragma unroll
        for (int s = 0; s < 16; ++s) { const bf16x8 a = *(const bf16x8*)(W + (size_t)nt * 32 * 256 + 16 * s); acc = MFMA32(a, bfr[s], acc); }
#pragma unroll
        for (int i = 0; i < 16; ++i) acc[i] *= rs;
        if (nt == 2) rope_apply(acc, cs, sn);
        store_tile_rowmajor(QC + (size_t)tok * 384 + hh * 96 + nt * 32, acc, h);
    }
}
__device__ __forceinline__ void vt_flush(LAS bf16_t* stg, bf16_t* __restrict__ dst  , int lane) {
    const LAS u32x4* rp = (const LAS u32x4*)(stg + lane * 32);
    u32x4 w[4];
#pragma unroll
    for (int c = 0; c < 4; ++c) w[c] = rp[c];
    u32x4* gp = (u32x4*)(dst + (size_t)lane * SEQ);
#pragma unroll
    for (int c = 0; c < 4; ++c) gp[c] = w[c];
}
__device__ __forceinline__ void mkv_unit(const bf16_t* __restrict__ H, const bf16_t* __restrict__ WT, const int* __restrict__ pos, bf16_t* __restrict__ KC, bf16_t* __restrict__ VTC, int tb, int hh, int lane, LAS bf16_t* stg) {
    const int r = lane & 31, h = lane >> 5, tok = tb * 32 + r;
    const bf16_t* src = H + (size_t)tok * DINP + C_CKV + 8 * h;
    bf16x8 bfr[8]; float ss = 0.f;
#pragma unroll
    for (int s = 0; s < 8; ++s) { bfr[s] = *(const bf16x8*)(src + 16 * s);
#pragma unroll
        for (int j = 0; j < 8; ++j) { const float v = bf2f(bfr[s][j]); ss += v * v; } }
    ss += __shfl_xor(ss, 32);
    const float rs = rsqrtf(ss * (1.f / 128.f) + EPS);
    const bf16_t* W = WT + (size_t)(hh * 128 + r) * 128 + 8 * h;
    const int b = (tb * 32) / SEQ, t0 = (tb * 32) % SEQ;
#pragma unroll 1
    for (int nt = 0; nt < 4; ++nt) {
        f32x16 acc;
#pragma unroll
        for (int i = 0; i < 16; ++i) acc[i] = 0.f;
#pragma unroll
        for (int s = 0; s < 8; ++s) { const bf16x8 a = *(const bf16x8*)(W + (size_t)nt * 32 * 128 + 16 * s); acc = MFMA32(a, bfr[s], acc); }
#pragma unroll
        for (int i = 0; i < 16; ++i) acc[i] *= rs;
        if (nt < 2) store_tile_rowmajor(KC + (size_t)tok * 384 + hh * 96 + nt * 32, acc, h);
        else {
            LAS bf16_t* sp = stg + ((nt - 2) * 32 + 4 * h) * 32 + r;
#pragma unroll
            for (int i = 0; i < 16; ++i) sp[((i & 3) + 8 * (i >> 2)) * 32] = f2bf(acc[i]);
        }
    }
    vt_flush(stg, VTC + ((size_t)((b * 4 + hh) * 64)) * SEQ + t0, lane);
    f32x16 kr;
    const bf16_t* krp = H + (size_t)tok * DINP + C_CKR + 4 * h;
#pragma unroll
    for (int g = 0; g < 4; ++g) { const u32x2 w = *(const u32x2*)(krp + 8 * g); kr[4 * g] = bflo(w.x); kr[4 * g + 1] = bfhi(w.x); kr[4 * g + 2] = bflo(w.y); kr[4 * g + 3] = bfhi(w.y); }
    float cs[8], sn[8]; rope_cs(pos[tok], h, cs, sn);
    rope_apply(kr, cs, sn);
    store_tile_rowmajor(KC + (size_t)tok * 384 + hh * 96 + 64, kr, h);
}
__device__ __forceinline__ void vt_unit(const bf16_t* __restrict__ H, int col0, int NH, bf16_t* __restrict__ VT, int tb, int head, int lane, LAS bf16_t* stg) {
    const int r = lane & 31, h = lane >> 5, tok = tb * 32 + r, b = (tb * 32) / SEQ, t0 = (tb * 32) % SEQ;
    const bf16_t* src = H + (size_t)tok * DINP + col0 + head * 64 + 32 * h;
    bf16x8 v[4];
#pragma unroll
    for (int c = 0; c < 4; ++c) v[c] = *(const bf16x8*)(src + 8 * c);
    LAS bf16_t* sp = stg + (32 * h) * 32 + r;
#pragma unroll
    for (int c = 0; c < 4; ++c)
#pragma unroll
        for (int j = 0; j < 8; ++j) sp[(8 * c + j) * 32] = (bf16_t)v[c][j];
    vt_flush(stg, VT + ((size_t)((b * NH + head) * 64)) * SEQ + t0, lane);
}
__device__ __forceinline__ void conv_unit(const bf16_t* __restrict__ H, const float* __restrict__ cw, const float* __restrict__ cb, bf16_t* __restrict__ Y, int tb, int lane) {
    const int tok0 = tb * 32, t0 = tok0 % SEQ, ch = 4 * lane;
    const f32x4 w0 = *(const f32x4*)(cw + ch), w1 = *(const f32x4*)(cw + 256 + ch), w2 = *(const f32x4*)(cw + 512 + ch), bs = *(const f32x4*)(cb + ch);
    f32x4 um1 = {0.f, 0.f, 0.f, 0.f}, um2 = {0.f, 0.f, 0.f, 0.f};
    if (t0 >= 2) {
        const bf16_t* p1 = H + (size_t)(tok0 - 1) * DINP + ch; const bf16_t* p2 = H + (size_t)(tok0 - 2) * DINP + ch;
        const u32x2 c1 = *(const u32x2*)(p1 + C_BC), x1 = *(const u32x2*)(p1 + C_BX), c2 = *(const u32x2*)(p2 + C_BC), x2 = *(const u32x2*)(p2 + C_BX);
        um1 = (f32x4){bflo(c1.x) * bflo(x1.x), bfhi(c1.x) * bfhi(x1.x), bflo(c1.y) * bflo(x1.y), bfhi(c1.y) * bfhi(x1.y)};
        um2 = (f32x4){bflo(c2.x) * bflo(x2.x), bfhi(c2.x) * bfhi(x2.x), bflo(c2.y) * bflo(x2.y), bfhi(c2.y) * bfhi(x2.y)};
    }
#pragma unroll 4
    for (int i = 0; i < 32; ++i) {
        const bf16_t* p = H + (size_t)(tok0 + i) * DINP + ch;
        const u32x2 bb = *(const u32x2*)(p + C_BB), cc = *(const u32x2*)(p + C_BC), xx = *(const u32x2*)(p + C_BX);
        const f32x4 u = {bflo(cc.x) * bflo(xx.x), bfhi(cc.x) * bfhi(xx.x), bflo(cc.y) * bflo(xx.y), bfhi(cc.y) * bfhi(xx.y)};
        const f32x4 bg = {bflo(bb.x), bfhi(bb.x), bflo(bb.y), bfhi(bb.y)};
        const f32x4 y = bg * (w0 * um2 + w1 * um1 + w2 * u + bs);
        u32x2 o; o.x = pk2(y.x, y.y); o.y = pk2(y.z, y.w);
        *(u32x2*)(Y + (size_t)(tok0 + i) * DM + 256 + ch) = o;
        um2 = um1; um1 = u;
    }
}

__device__ __forceinline__ void o_flush(LAS bf16_t* stg, bf16_t* __restrict__ Orow0, int opitch, int lane) {
    u32x4 w[4];
#pragma unroll
    for (int j = 0; j < 4; ++j) w[j] = *(const LAS u32x4*)(stg + (lane + 64 * j) * 8);
#pragma unroll
    for (int j = 0; j < 4; ++j) { const int c = lane + 64 * j; *(u32x4*)(Orow0 + (size_t)(c >> 3) * opitch + (c & 7) * 8) = w[j]; }
}
template <int DKS, bool SINK>
__device__ __forceinline__ void softmax_unit(const bf16_t* __restrict__ Qrow0, int qpitch, const bf16_t* __restrict__ Kb, int kpitch, const bf16_t* __restrict__ VT,
                                             int qb, int kt_begin, int window, float sink2, bf16_t* __restrict__ Orow0, int opitch, int lane, LAS bf16_t* stg) {
    const int r = lane & 31, h = lane >> 5;
    const int pr = (r & ~12) | ((r & 8) >> 1) | ((r & 4) << 1);
    bf16x8 qf[DKS];
#pragma unroll
    for (int s = 0; s < DKS; ++s) qf[s] = *(const bf16x8*)(Qrow0 + (size_t)r * qpitch + 16 * s + 8 * h);
    f32x16 o0, o1;
#pragma unroll
    for (int i = 0; i < 16; ++i) { o0[i] = 0.f; o1[i] = 0.f; }
    float m = -1e30f, l = 0.f;
    const int kt_end = qb + 1, q = 32 * qb + r;
    const bf16_t* kp = Kb + (size_t)(32 * kt_begin + pr) * kpitch + 8 * h;
    const bf16_t* vp = VT + (size_t)r * SEQ + 32 * kt_begin + 8 * h;
    bf16x8 kf[DKS];
#pragma unroll
    for (int s = 0; s < DKS; ++s) kf[s] = *(const bf16x8*)(kp + 16 * s);
    for (int kt = kt_begin; kt < kt_end; ++kt) {
        bf16x8 kn[DKS];
        if (kt + 1 < kt_end) {
#pragma unroll
            for (int s = 0; s < DKS; ++s) kn[s] = *(const bf16x8*)(kp + (size_t)32 * kpitch + 16 * s);
        } else {
#pragma unroll
            for (int s = 0; s < DKS; ++s) kn[s] = kf[s];
        }
        const bf16x8 v00 = *(const bf16x8*)(vp), v01 = *(const bf16x8*)(vp + 32 * SEQ), v10 = *(const bf16x8*)(vp + 16), v11 = *(const bf16x8*)(vp + 32 * SEQ + 16);
        f32x16 p;
#pragma unroll
        for (int i = 0; i < 16; ++i) p[i] = 0.f;
#pragma unroll
        for (int s = 0; s < DKS; ++s) p = MFMA32(kf[s], qf[s], p);
        if (kt == qb || (window != 0 && kt == qb - (window >> 5))) {
            const int k0 = 32 * kt + 8 * h;
#pragma unroll
            for (int i = 0; i < 16; ++i) { const int kv = k0 + 16 * (i >> 3) + (i & 7); const bool ok = (kv <= q) && (window == 0 || kv > q - window); if (!ok) p[i] = -INFINITY; }
        }
        float rm = p[0];
#pragma unroll
        for (int i = 1; i < 16; ++i) rm = fmaxf(rm, p[i]);
        rm = fmaxf(rm, __shfl_xor(rm, 32));
        if (__any(rm > m + 6.f)) {
            const float mn = fmaxf(m, rm), f = ex2(m - mn); m = mn; l *= f;
#pragma unroll
            for (int i = 0; i < 16; ++i) { const float fi = __shfl(f, crow(i, h)); o0[i] *= fi; o1[i] *= fi; }
        }
        float e[16];
#pragma unroll
        for (int i = 0; i < 16; ++i) { e[i] = ex2(p[i] - m); l += e[i]; }
        const bf16x8 pa0 = pack8(e), pa1 = pack8(e + 8);
        o0 = MFMA32(pa0, v00, o0); o1 = MFMA32(pa0, v01, o1);
        o0 = MFMA32(pa1, v10, o0); o1 = MFMA32(pa1, v11, o1);
#pragma unroll
        for (int s = 0; s < DKS; ++s) kf[s] = kn[s];
        kp += (size_t)32 * kpitch; vp += 32;
    }
    l += __shfl_xor(l, 32);
    if (SINK) l += ex2(sink2 - m);
    const float inv = 1.f / l;
    LAS bf16_t* sp = stg + (4 * h) * 64 + r;
#pragma unroll
    for (int i = 0; i < 16; ++i) { const float fi = __shfl(inv, crow(i, h)); const int ro = ((i & 3) + 8 * (i >> 2)) * 64;
        sp[ro] = f2bf(o0[i] * fi); sp[ro + 32] = f2bf(o1[i] * fi); }
    o_flush(stg, Orow0, opitch, lane);
}


constexpr int KP = 208, VP = 272;
constexpr int KT_BYTES = 128 * KP, VT_BYTES = 64 * VP, TB_BYTES = KT_BYTES + VT_BYTES, MRG_OFF = 2 * TB_BYTES;
static_assert(MRG_OFF + 4 * 34 * 64 * 4 <= 131072, "MLA LDS map");
__device__ __forceinline__ void mla_unit_blk(const bf16_t* __restrict__ QC, const bf16_t* __restrict__ KC, const bf16_t* __restrict__ VTC, bf16_t* __restrict__ Y,
                                             int bh, int g, LAS unsigned char* lds, int tid) {
    const int lane = tid & 63, wave = __builtin_amdgcn_readfirstlane(tid >> 6), r = lane & 31, h = lane >> 5, w4 = wave & 3, kh = wave >> 2;
    const int pr = (r & ~12) | ((r & 8) >> 1) | ((r & 4) << 1);
    const int b = bh >> 2, hh = bh & 3, qb = 4 * g + w4, q = 32 * qb + r;
    const bf16_t* Qp = QC + ((size_t)b * SEQ + q) * 384 + hh * 96 + 8 * h;
    bf16x8 qf[6];
#pragma unroll
    for (int s = 0; s < 6; ++s) qf[s] = *(const bf16x8*)(Qp + 16 * s);
    const bf16_t* Kg = KC + (size_t)b * SEQ * 384 + hh * 96;
    const bf16_t* Vg = VTC + (size_t)(b * 4 + hh) * 64 * SEQ;
    int kgo[3], klo[3], vgo[2], vlo[2];
#pragma unroll
    for (int i = 0; i < 3; ++i) { const int c = tid + 512 * i, row = c / 12, cc = c - 12 * row; kgo[i] = row * 384 + 8 * cc; klo[i] = row * KP + 16 * cc; }
#pragma unroll
    for (int i = 0; i < 2; ++i) { const int c = tid + 512 * i, d = c >> 4, cc = c & 15; vgo[i] = d * SEQ + 8 * cc; vlo[i] = KT_BYTES + d * VP + 16 * cc; }
    u32x4 kr[3], vr[2];
#define MLA_LOAD(ST) do { _Pragma("unroll") for (int i = 0; i < 3; ++i) kr[i] = *(const u32x4*)(Kg + (size_t)(ST) * (128 * 384) + kgo[i]); \
                          _Pragma("unroll") for (int i = 0; i < 2; ++i) vr[i] = *(const u32x4*)(Vg + (ST) * 128 + vgo[i]); } while (0)
#define MLA_STORE(buf) do { LAS unsigned char* tb_ = lds + (buf) * TB_BYTES; _Pragma("unroll") for (int i = 0; i < 3; ++i) *(LAS u32x4*)(tb_ + klo[i]) = kr[i]; \
                            _Pragma("unroll") for (int i = 0; i < 2; ++i) *(LAS u32x4*)(tb_ + vlo[i]) = vr[i]; } while (0)
    f32x16 o0, o1;
#pragma unroll
    for (int i = 0; i < 16; ++i) { o0[i] = 0.f; o1[i] = 0.f; }
    float m = -1e30f, l = 0.f;
    const int nST = g + 1;
    MLA_LOAD(0); MLA_STORE(0);
    __syncthreads();
    const int kfo = (64 * kh + pr) * KP + 16 * h;
    const int vfo = KT_BYTES + r * VP + (64 * kh + 8 * h) * 2;
    for (int ST = 0; ST < nST; ++ST) {
        if (ST + 1 < nST) MLA_LOAD(ST + 1);
        const int kt0 = 4 * ST + 2 * kh;
        if (kt0 <= qb) {
            const LAS unsigned char* tb = lds + (ST & 1) * TB_BYTES;
            f32x16 p0, p1;
#pragma unroll
            for (int i = 0; i < 16; ++i) { p0[i] = 0.f; p1[i] = 0.f; }
#pragma unroll
            for (int s = 0; s < 6; ++s) { const bf16x8 k0 = *(const LAS bf16x8*)(tb + kfo + 32 * s), k1 = *(const LAS bf16x8*)(tb + kfo + 32 * KP + 32 * s);
                p0 = MFMA32(k0, qf[s], p0); p1 = MFMA32(k1, qf[s], p1); }
            if (kt0 + 1 >= qb) {
                const int kb0 = 32 * kt0 + 8 * h;
#pragma unroll
                for (int i = 0; i < 16; ++i) { const int kv = kb0 + 16 * (i >> 3) + (i & 7); if (kv > q) p0[i] = -INFINITY; if (kv + 32 > q) p1[i] = -INFINITY; }
            }
            float rm = fmaxf(p0[0], p1[0]);
#pragma unroll
            for (int i = 1; i < 16; ++i) rm = fmaxf(rm, fmaxf(p0[i], p1[i]));
            rm = fmaxf(rm, __shfl_xor(rm, 32));
            if (__any(rm > m + 6.f)) {
                const float mn = fmaxf(m, rm), f = ex2(m - mn); m = mn; l *= f;
#pragma unroll
                for (int i = 0; i < 16; ++i) { const float fi = __shfl(f, crow(i, h)); o0[i] *= fi; o1[i] *= fi; }
            }
            float ls = 0.f;
#pragma unroll
            for (int i = 0; i < 16; ++i) { p0[i] = ex2(p0[i] - m); p1[i] = ex2(p1[i] - m); ls += p0[i] + p1[i]; }
            l += ls;
            float e[8];
#pragma unroll
            for (int ks = 0; ks < 4; ++ks) {
#pragma unroll
                for (int j = 0; j < 8; ++j) e[j] = (ks < 2) ? p0[8 * ks + j] : p1[8 * (ks - 2) + j];
                const bf16x8 pa = pack8(e);
                const bf16x8 v0 = *(const LAS bf16x8*)(tb + vfo + 32 * ks), v1 = *(const LAS bf16x8*)(tb + vfo + 32 * VP + 32 * ks);
                o0 = MFMA32(pa, v0, o0); o1 = MFMA32(pa, v1, o1);
            }
        }
        if (ST + 1 < nST) MLA_STORE((ST + 1) & 1);
        __syncthreads();
    }
#undef MLA_LOAD
#undef MLA_STORE
    l += __shfl_xor(l, 32);
    LAS float* mg = (LAS float*)(lds + MRG_OFF) + w4 * (34 * 64) + lane;
    if (kh == 1) {
#pragma unroll
        for (int i = 0; i < 16; ++i) { mg[i * 64] = o0[i]; mg[(16 + i) * 64] = o1[i]; }
        mg[32 * 64] = m; mg[33 * 64] = l;
    }
    __syncthreads();
    if (kh == 0) {
        const float mb = mg[32 * 64], lb = mg[33 * 64];
        const float mn = fmaxf(m, mb), fa = ex2(m - mn), fb = ex2(mb - mn), inv = 1.f / (l * fa + lb * fb), ga = fa * inv, gb = fb * inv;
        LAS bf16_t* stg = (LAS bf16_t*)(lds + wave * 4096);
        LAS bf16_t* sp = stg + (4 * h) * 64 + r;
#pragma unroll
        for (int i = 0; i < 16; ++i) { const float ra = __shfl(ga, crow(i, h)), rb = __shfl(gb, crow(i, h)); const int ro = ((i & 3) + 8 * (i >> 2)) * 64;
            sp[ro] = f2bf(o0[i] * ra + mg[i * 64] * rb); sp[ro + 32] = f2bf(o1[i] * ra + mg[(16 + i) * 64] * rb); }
        o_flush(stg, Y + ((size_t)b * SEQ + 32 * qb) * DM + 512 + hh * 64, DM, lane);
    }
    __syncthreads();
}

__device__ __forceinline__ void sb_unit(const bf16_t* __restrict__ Qrow0, int qpitch, const bf16_t* __restrict__ Kb, int kpitch, const bf16_t* __restrict__ VT,
                                        int qb, bf16_t* __restrict__ Orow0, int opitch, int lane, LAS bf16_t* stg) {
    const int r = lane & 31, h = lane >> 5;
    const int pr = (r & ~12) | ((r & 8) >> 1) | ((r & 4) << 1);
    bf16x8 qf[4];
#pragma unroll
    for (int s = 0; s < 4; ++s) qf[s] = *(const bf16x8*)(Qrow0 + (size_t)r * qpitch + 16 * s + 8 * h);
    f32x16 o0, o1;
#pragma unroll
    for (int i = 0; i < 16; ++i) { o0[i] = 0.f; o1[i] = 0.f; }
    float carry = 0.f;
    const int q = 32 * qb + r;
    const bf16_t* kp = Kb + (size_t)(32 * qb + pr) * kpitch + 8 * h;
    const bf16_t* vp = VT + (size_t)r * SEQ + 32 * qb + 8 * h;
    bf16x8 kf[4];
#pragma unroll
    for (int s = 0; s < 4; ++s) kf[s] = *(const bf16x8*)(kp + 16 * s);
    for (int kt = qb; kt >= 0; --kt) {
        bf16x8 kn[4];
        if (kt > 0) {
#pragma unroll
            for (int s = 0; s < 4; ++s) kn[s] = *(const bf16x8*)(kp - (size_t)32 * kpitch + 16 * s);
        } else {
#pragma unroll
            for (int s = 0; s < 4; ++s) kn[s] = kf[s];
        }
        const bf16x8 v00 = *(const bf16x8*)(vp), v01 = *(const bf16x8*)(vp + 32 * SEQ), v10 = *(const bf16x8*)(vp + 16), v11 = *(const bf16x8*)(vp + 32 * SEQ + 16);
        f32x16 p;
#pragma unroll
        for (int i = 0; i < 16; ++i) p[i] = 0.f;
#pragma unroll
        for (int s = 0; s < 4; ++s) p = MFMA32(kf[s], qf[s], p);
        const bool diag = (kt == qb);
        const int k0 = 32 * kt + 8 * h;
        float sfx[16];
#pragma unroll
        for (int i = 0; i < 16; ++i) {
            const float z = p[i];
            float L = -(fmaxf(z, 0.f) + lg2(1.f + ex2(-fabsf(z))));
            if (diag) { const int kv = k0 + 16 * (i >> 3) + (i & 7); if (!(kv < q)) L = 0.f; }
            sfx[i] = L;
        }
#pragma unroll
        for (int g = 0; g < 2; ++g)
#pragma unroll
            for (int j = 6; j >= 0; --j) sfx[8 * g + j] += sfx[8 * g + j + 1];
        const float T0 = sfx[0], T1 = sfx[8];
        const float TP0 = __shfl_xor(T0, 32), TP1 = __shfl_xor(T1, 32);
        const float off1 = (h ? 0.f : TP1) + carry, off0 = T1 + TP1 + (h ? 0.f : TP0) + carry;
        float e[16];
#pragma unroll
        for (int i = 0; i < 16; ++i) {
            float a = ex2(p[i] + sfx[i] + (i < 8 ? off0 : off1));
            if (diag) { const int kv = k0 + 16 * (i >> 3) + (i & 7); if (!(kv < q)) a = 0.f; }
            e[i] = a;
        }
        carry += (T0 + T1) + (TP0 + TP1);
        const bf16x8 pa0 = pack8(e), pa1 = pack8(e + 8);
        o0 = MFMA32(pa0, v00, o0); o1 = MFMA32(pa0, v01, o1);
        o0 = MFMA32(pa1, v10, o0); o1 = MFMA32(pa1, v11, o1);
        if (__all(carry < -150.f)) break;
#pragma unroll
        for (int s = 0; s < 4; ++s) kf[s] = kn[s];
        kp -= (size_t)32 * kpitch; vp -= 32;
    }
    LAS bf16_t* sp = stg + (4 * h) * 64 + r;
#pragma unroll
    for (int i = 0; i < 16; ++i) { const int ro = ((i & 3) + 8 * (i >> 2)) * 64; sp[ro] = f2bf(o0[i]); sp[ro + 32] = f2bf(o1[i]); }
    o_flush(stg, Orow0, opitch, lane);
}

#define XB_TMO      128
#define XB_XCNT(j)  (256  + 64 * (j))
#define XB_XSUB(j)  (1280 + 64 * (j))
#define XB_XGEN(j)  (2304 + 64 * (j))
#define XB_TOP      3328
#define XB_TOPGEN   3392
#define XCD_BAR_WORDS 3456
#define XB_SPIN_CAP (1u << 18)

__device__ __forceinline__ unsigned xb_ld(unsigned* p)              { return __hip_atomic_load(p, __ATOMIC_RELAXED, __HIP_MEMORY_SCOPE_AGENT); }
__device__ __forceinline__ unsigned xb_add(unsigned* p, unsigned v) { return __hip_atomic_fetch_add(p, v, __ATOMIC_RELAXED, __HIP_MEMORY_SCOPE_AGENT); }
__device__ __forceinline__ unsigned xb_xcc_id() { return (unsigned)__builtin_amdgcn_s_getreg((3 << 11) | 20) & 0xFu; }
#define XB_SPIN(cond, bar) do { unsigned _sp = 0; while (cond) { __builtin_amdgcn_s_sleep(1); \
    if ((++_sp & 255u) == 0u) { if (xb_ld(&(bar)[XB_TMO])) break; if (_sp > XB_SPIN_CAP) { atomicAdd(&(bar)[XB_TMO], 1u); break; } } } } while (0)

struct XcdBarrier {
    unsigned* bar; unsigned x;
    volatile LAS unsigned* st;
};

__device__ __forceinline__ XcdBarrier xcd_barrier_post(unsigned* bar, volatile LAS unsigned* st) {
    XcdBarrier b; b.bar = bar; b.x = xb_xcc_id(); b.st = st;
    if (threadIdx.x == 0) (void)xb_add(&bar[XB_XCNT(b.x)], 1u);
    return b;
}
__device__ __forceinline__ void xcd_barrier_complete(unsigned* bar, unsigned x, unsigned& nloc, unsigned& nx) {
    const unsigned G = gridDim.x * gridDim.y * gridDim.z;
    unsigned sum, cnt, mine, sp = 0u;
    for (;;) {
        sum = 0u; cnt = 0u; mine = 0u;
#pragma unroll
        for (unsigned j = 0; j < 16; ++j) { const unsigned c = xb_ld(&bar[XB_XCNT(j)]); sum += c; cnt += (c > 0u) ? 1u : 0u; mine = (j == x) ? c : mine; }
        if (sum == G) break;
        __builtin_amdgcn_s_sleep(1);
        if ((++sp & 255u) == 0u) { if (xb_ld(&bar[XB_TMO])) break; if (sp > XB_SPIN_CAP) { atomicAdd(&bar[XB_TMO], 1u); break; } }
    }
    nloc = mine > 0u ? mine : 1u; nx = cnt > 0u ? cnt : 1u;
}

__device__ __forceinline__ void xcd_barrier(const XcdBarrier& b) {
    asm volatile("s_waitcnt vmcnt(0)" ::: "memory");
    __syncthreads();
    if (threadIdx.x == 0) {
        unsigned* bar = b.bar;
        __builtin_amdgcn_s_waitcnt(0);
        unsigned nloc = b.st[0], nx = b.st[1];
        if (nloc == 0u) { xcd_barrier_complete(bar, b.x, nloc, nx); b.st[0] = nloc; b.st[1] = nx; }
        const unsigned old = xb_add(&bar[XB_XSUB(b.x)], 1u);
        const unsigned gen = old / nloc;
        if (old + 1u == (gen + 1u) * nloc) {
            __builtin_amdgcn_fence(__ATOMIC_RELEASE, "agent");
            asm volatile("s_waitcnt vmcnt(0)" ::: "memory");
            const unsigned og = xb_add(&bar[XB_TOP], 1u);
            const unsigned tg = og / nx;
            if (og + 1u == (tg + 1u) * nx) xb_add(&bar[XB_TOPGEN], 1u);
            else XB_SPIN(xb_ld(&bar[XB_TOPGEN]) == tg, bar);
            __builtin_amdgcn_fence(__ATOMIC_ACQUIRE, "agent");
            xb_add(&bar[XB_XGEN(b.x)], 1u);
            asm volatile("s_waitcnt vmcnt(0)" ::: "memory");
        } else {
            XB_SPIN(xb_ld(&bar[XB_XGEN(b.x)]) == gen, bar);
            __builtin_amdgcn_fence(__ATOMIC_ACQUIRE, "agent");
            asm volatile("s_waitcnt vmcnt(0)" ::: "memory");
        }
    }
    __syncthreads();
}

__global__ void __launch_bounds__(NTHREADS, 2) fwd(Params P) {
    extern __shared__ __attribute__((aligned(16))) unsigned char lds_raw[];
    LAS unsigned char* lds = (LAS unsigned char*)lds_raw;
    const int G = gridDim.x, bx = blockIdx.x, NGW = G * NWAVES, gthreads = G * NTHREADS;
    unsigned char* ws = P.ws;
    unsigned* ctl = (unsigned*)(ws + WS_CTL);
    bf16_t* XN = (bf16_t*)(ws + WS_XN); bf16_t* H = (bf16_t*)(ws + WS_H);
    bf16_t* QC = (bf16_t*)(ws + WS_QC); bf16_t* KC = (bf16_t*)(ws + WS_KC);
    bf16_t* VTC = (bf16_t*)(ws + WS_VTC); bf16_t* VTA = (bf16_t*)(ws + WS_VTA); bf16_t* VTD = (bf16_t*)(ws + WS_VTD);
    bf16_t* Y = (bf16_t*)(ws + WS_Y);
#if MK_COOP
    cooperative_groups::grid_group grid = cooperative_groups::this_grid();
    volatile LAS unsigned* MISC = (volatile LAS unsigned*)(lds + 131072);
    if (threadIdx.x < 64) MISC[threadIdx.x] = 0u;
    __syncthreads();
    XcdBarrier bar = xcd_barrier_post(ctl + CW_BAR, MISC + 8);
#endif
    for (int ph = P.ph_lo; ph < P.ph_hi; ++ph) {
        const int nrep = ((ph >= 1 && ph <= 6 && ((ph - 1) == MK_REP_K || (MK_REP_K == 6 && ph == 3))) || (ph == 0 && MK_REP_K == 7)) ? MK_REP_N : 1;
        for (int rep = 0; rep < nrep; ++rep) {
        int tid_o = threadIdx.x; asm volatile("" : "+v"(tid_o));
        const int tid = tid_o, lane = tid & 63, wave = __builtin_amdgcn_readfirstlane(tid >> 6);
        const int gw = bx * NWAVES + wave, gtid = bx * NTHREADS + tid;
        LAS bf16_t* stg = (LAS bf16_t*)(lds + wave * 4096);
        if (ph == 0) {
            for (int l = 0; l < NLAYER; ++l) {
                conv_wT(P.w_in + (size_t)l * DM * DIN, DM, DIN, DINP, P.norm_pre + l * DM, (bf16_t*)(ws + WS_WIN) + (size_t)l * DINP * DM, C_AQ, C_AQ + 256, C_DQ, C_DQ + 256, SC64, gtid, gthreads);
                conv_wT(P.w_out + (size_t)l * DM * DM, DM, DM, DM, P.g_grp + l * DM, (bf16_t*)(ws + WS_WOUT) + (size_t)l * DM * DM, 0, 0, 0, 0, 1.f, gtid, gthreads);
                conv_wT(P.w_uq + (size_t)l * 256 * 384, 256, 384, 384, P.g_cq + l * 256, (bf16_t*)(ws + WS_WUQ + (size_t)l * 262144), 0, 0, 0, 0, 1.f, gtid, gthreads);
                conv_wT(P.w_ukv + (size_t)l * 128 * 512, 128, 512, 512, P.g_ckv + l * 128, (bf16_t*)(ws + WS_WUKV + (size_t)l * 131072), 0, 0, 0, 0, 1.f, gtid, gthreads);
            }
            for (int mrow = gw; mrow < M_TOK; mrow += NGW) rms_row_to_bf16(P.x + (size_t)mrow * DM, XN + (size_t)mrow * DM, lane);
        } else {
            const int l = (ph - 1) / 6, k = (ph - 1) % 6;
            if (k == 0 || k == 4) {
                if (k == 0) {
                    pg8::Gemm g{XN, (const bf16_t*)(ws + WS_WIN) + (size_t)l * DINP * DM, M_TOK, DINP, DM}; pg8::StaticOrder S; S.init(M_TOK, DINP, G, bx);
                    pg8::EpiBf16<0> E{H, DINP, nullptr, 0, 0, 1.f};
                    pg8::gemm_phase<pg8::EpiBf16<0>, pg8::StaticOrder, true, true>(lds, g, S, E);
                } else {
                    pg8::Gemm g{XN, (const bf16_t*)(ws + WS_WOUT) + (size_t)l * DM * DM, M_TOK, DM, DM}; pg8::StaticOrder S; S.init(M_TOK, DM, G, bx);
                    pg8::EpiBf16<0> E{Y, DM, nullptr, 0, 0, 1.f};
                    pg8::gemm_phase<pg8::EpiBf16<0>, pg8::StaticOrder, true, true>(lds, g, S, E);
                }
            } else if (k == 1) {
                const bf16_t* WUQ = (const bf16_t*)(ws + WS_WUQ + (size_t)l * 262144);
                const bf16_t* WUKV = (const bf16_t*)(ws + WS_WUKV + (size_t)l * 131072);
                constexpr int NTB = M_TOK / 32;
                constexpr int U_MQ = NTB * 4, U_MKV = NTB * 4, U_VTA = NTB * 2, U_VTD = NTB * 4, U_CONV = NTB;
                constexpr int U_ALL = U_MQ + U_MKV + U_VTA + U_VTD + U_CONV;
                for (int u = gw; u < U_ALL; u += NGW) {
                    int v = u;
                    if (v < U_MQ) { mq_unit(H, WUQ, P.pos, QC, v >> 2, v & 3, lane); continue; } v -= U_MQ;
                    if (v < U_MKV) { mkv_unit(H, WUKV, P.pos, KC, VTC, v >> 2, v & 3, lane, stg); continue; } v -= U_MKV;
                    if (v < U_VTA) { vt_unit(H, C_AV, 2, VTA, v >> 1, v & 1, lane, stg); continue; } v -= U_VTA;
                    if (v < U_VTD) { vt_unit(H, C_DV, 4, VTD, v >> 2, v & 3, lane, stg); continue; } v -= U_VTD;
                    conv_unit(H, P.conv_w + l * 768, P.conv_b + l * 256, Y, v, lane);
                }
            } else if (k == 2) {
                if (rep == 0 || MK_REP_K == 2)
                for (int pu = bx; pu < 256; pu += G) {
                    const int bh = pu & 7, Gq = pu >> 3;
                    mla_unit_blk(QC, KC, VTC, Y, bh, 63 - Gq, lds, tid);
                    mla_unit_blk(QC, KC, VTC, Y, bh, Gq, lds, tid);
                }
                if (rep == 0 || MK_REP_K == 6)
                for (;;) {
                    unsigned u = 0;
                    if (lane == 0) u = atomicAdd(ctl + 64 * l + 128 * rep, 1u);
                    u = (unsigned)__builtin_amdgcn_readfirstlane((int)u);
                    if (u >= 4096u) break;
                    const int v = (int)(u & 2047u), bh = v >> 8, qb = v & 255, b = bh >> 2, hh = bh & 3;
                    const size_t row0 = (size_t)b * SEQ + 32 * qb;
                    if (u < 2048u) {
                        sb_unit(H + row0 * DINP + C_DQ + hh * 64, DINP, H + (size_t)b * SEQ * DINP + C_DK + hh * 64, DINP, VTD + (size_t)(b * 4 + hh) * 64 * SEQ,
                                qb, Y + row0 * DM + 768 + hh * 64, DM, lane, stg);
                    } else {
                        const int kvh = hh >> 1;
                        const int ktb = qb - 4 > 0 ? qb - 4 : 0;
                        softmax_unit<4, true>(H + row0 * DINP + C_AQ + hh * 64, DINP, H + (size_t)b * SEQ * DINP + C_AK + kvh * 64, DINP, VTA + (size_t)(b * 2 + kvh) * 64 * SEQ,
                                              qb, ktb, 128, P.sinks[l * 4 + hh] * LOG2E, Y + row0 * DM + hh * 64, DM, lane, stg);
                    }
                }
            } else if (k == 3) {
                for (int mrow = gw; mrow < M_TOK; mrow += NGW) {
                    const u32x4* yp = (const u32x4*)(Y + (size_t)mrow * DM) + 2 * lane;
                    const u32x4* gp = (const u32x4*)(H + (size_t)mrow * DINP + C_GATE) + 2 * lane;
                    const u32x4 y0 = yp[0], y1 = yp[1], g0 = gp[0], g1 = gp[1];
                    float yv[16], gv[16];
#pragma unroll
                    for (int j = 0; j < 4; ++j) { yv[2 * j] = bflo(y0[j]); yv[2 * j + 1] = bfhi(y0[j]); yv[8 + 2 * j] = bflo(y1[j]); yv[8 + 2 * j + 1] = bfhi(y1[j]);
                                                  gv[2 * j] = bflo(g0[j]); gv[2 * j + 1] = bfhi(g0[j]); gv[8 + 2 * j] = bflo(g1[j]); gv[8 + 2 * j + 1] = bfhi(g1[j]); }
                    float ss = 0.f;
#pragma unroll
                    for (int j = 0; j < 16; ++j) ss += yv[j] * yv[j];
                    ss += __shfl_xor(ss, 1); ss += __shfl_xor(ss, 2); ss += __shfl_xor(ss, 4); ss += __shfl_xor(ss, 8);
                    const float rs = rsqrtf(ss * (1.f / 256.f) + EPS);
                    float o[16];
#pragma unroll
                    for (int j = 0; j < 16; ++j) { const float gg = gv[j]; o[j] = yv[j] * rs * gg * __builtin_amdgcn_rcpf(1.f + ex2(-gg * LOG2E)); }
                    u32x4 w0, w1;
#pragma unroll
                    for (int j = 0; j < 4; ++j) { w0[j] = pk2(o[2 * j], o[2 * j + 1]); w1[j] = pk2(o[8 + 2 * j], o[8 + 2 * j + 1]); }
                    u32x4* op = (u32x4*)(XN + (size_t)mrow * DM) + 2 * lane;
                    op[0] = w0; op[1] = w1;
                }
            } else {
                const float* base = (l == 0) ? P.x : P.out;
                const float* gpost = P.g_post + l * DM;
                for (int mrow = gw; mrow < M_TOK; mrow += NGW) {
                    f32x4 zz[4], xv[4]; float s1 = 0.f;
#pragma unroll
                    for (int j = 0; j < 4; ++j) { const u32x2 w = ((const u32x2*)(Y + (size_t)mrow * DM))[lane + 64 * j]; zz[j] = (f32x4){bflo(w.x), bfhi(w.x), bflo(w.y), bfhi(w.y)};
                        xv[j] = ((const f32x4*)(base + (size_t)mrow * DM))[lane + 64 * j];
                        s1 += (zz[j].x * zz[j].x + zz[j].y * zz[j].y) + (zz[j].z * zz[j].z + zz[j].w * zz[j].w); }
                    const float rz = rsqrtf(wave_sum(s1) * (1.f / DM) + EPS);
                    float s2 = 0.f;
#pragma unroll
                    for (int j = 0; j < 4; ++j) { const f32x4 gpv = ((const f32x4*)gpost)[lane + 64 * j]; xv[j] = xv[j] + zz[j] * rz * gpv;
                        s2 += (xv[j].x * xv[j].x + xv[j].y * xv[j].y) + (xv[j].z * xv[j].z + xv[j].w * xv[j].w);
                        ((f32x4*)(P.out + (size_t)mrow * DM))[lane + 64 * j] = xv[j]; }
                    if (l + 1 < NLAYER) {
                        const float rs = rsqrtf(wave_sum(s2) * (1.f / DM) + EPS);
#pragma unroll
                        for (int j = 0; j < 4; ++j) { u32x2 o; o.x = pk2(xv[j].x * rs, xv[j].y * rs); o.y = pk2(xv[j].z * rs, xv[j].w * rs); ((u32x2*)(XN + (size_t)mrow * DM))[lane + 64 * j] = o; }
                    }
                }
            }
            }
        }
        if (ph + 1 < P.ph_hi) {
#if MK_COOP
            if (ph == 0) grid.sync();
            else xcd_barrier(bar);
#endif
        }
    }
}
}

extern "C" void kernel_launch(void* const* d_in, const int* in_sizes, int n_in, void* d_out, int out_size, void* d_ws, size_t ws_size, hipStream_t stream) {
    using namespace mk;
    static int grid = 0;
    if (grid == 0) {
        if (n_in != 14 || out_size != M_TOK * DM || ws_size < WS_END) { fprintf(stderr, "kernel_launch: unexpected shapes (n_in %d out %d ws %zu)\n", n_in, out_size, ws_size); grid = -1; return; }
        int dev = 0, cus = 0, per_cu = 0;
        (void)hipGetDevice(&dev); (void)hipDeviceGetAttribute(&cus, hipDeviceAttributeMultiprocessorCount, dev);
        if (hipFuncSetAttribute((const void*)fwd, hipFuncAttributeMaxDynamicSharedMemorySize, LDS_BYTES) != hipSuccess) { fprintf(stderr, "kernel_launch: hipFuncSetAttribute failed\n"); grid = -1; return; }
        if (hipOccupancyMaxActiveBlocksPerMultiprocessor(&per_cu, (const void*)fwd, NTHREADS, LDS_BYTES) != hipSuccess || per_cu < 1) { fprintf(stderr, "kernel_launch: occupancy query says %d\n", per_cu); per_cu = 1; }
        (void)hipGetLastError();
        grid = cus * 1;
        if (grid > 256) grid = 256;
    }
    if (grid < 0) return;
    (void)hipMemsetAsync((char*)d_ws + WS_CTL, 0, CTL_BYTES, stream);
    Params p{};
    p.x = (const float*)d_in[0]; p.pos = (const int*)d_in[1]; p.norm_pre = (const float*)d_in[2]; p.w_in = (const float*)d_in[3]; p.sinks = (const float*)d_in[4];
    p.conv_w = (const float*)d_in[5]; p.conv_b = (const float*)d_in[6]; p.g_cq = (const float*)d_in[7]; p.w_uq = (const float*)d_in[8]; p.g_ckv = (const float*)d_in[9];
    p.w_ukv = (const float*)d_in[10]; p.g_grp = (const float*)d_in[11]; p.w_out = (const float*)d_in[12]; p.g_post = (const float*)d_in[13];
    p.out = (float*)d_out; p.ws = (unsigned char*)d_ws;
    constexpr int NPH = 1 + 6 * NLAYER;
#if MK_COOP
    p.ph_lo = 0; p.ph_hi = NPH;
    void* args[] = {&p};
    hipError_t e = hipLaunchCooperativeKernel((const void*)fwd, dim3(grid), dim3(NTHREADS), args, LDS_BYTES, stream);
    if (e != hipSuccess) fprintf(stderr, "kernel_launch: cooperative launch failed: %s (grid %d)\n", hipGetErrorString(e), grid);
#else
    for (int ph = 0; ph < NPH; ++ph) { p.ph_lo = ph; p.ph_hi = ph + 1; hipLaunchKernelGGL(fwd, dim3(grid), dim3(NTHREADS), LDS_BYTES, stream, p); }
#endif
}
```

```cpp
#include <hip/hip_runtime.h>
#include <hip/hip_cooperative_groups.h>
#include <cstdio>
#include <cstdint>
#include <cmath>
namespace pg8 {
#define PG8_LAS __attribute__((address_space(3)))
typedef unsigned short bf16_t;
typedef short bf16x8 __attribute__((ext_vector_type(8)));
typedef float f32x4 __attribute__((ext_vector_type(4)));
typedef unsigned u32x4 __attribute__((ext_vector_type(4)));
constexpr int BM = 256, BK = 64, HALF = 128, HTB = HALF * BK * 2  , STAGE_BYTES = 8 * HTB, NXCD = 8, WGM = 8;

__host__ __device__ __forceinline__ int lds_byte(int r, int c) { const int st = (r >> 4) * 2 + (c >> 5), rr = r & 15, cc = c & 31, ob = rr * 64 + cc * 2; return st * 1024 + (ob ^ (((ob >> 9) & 1) << 5)); }
__host__ __device__ __forceinline__ void stage_rc(int b, int& R, int& C) { const int st = b / 1024, sb = b % 1024, swz = sb ^ (((sb >> 9) & 1) << 5); R = (st >> 1) * 16 + swz / 64; C = (st & 1) * 32 + (swz % 64) / 2; }
__host__ __device__ __forceinline__ int perm32(int rho) { const int n = rho >> 4, i = rho & 15; return 8 * (i >> 2) + 4 * n + (i & 3); }

struct Unit { int pm, pn; };
struct Gemm { const bf16_t* A; const bf16_t* Bt; int M, N, K; };

struct StaticOrder {
    int nM, nN, nwg, G, c;
    __host__ __device__ void init(int M, int N, int G_, int c_) { nM = M / BM; nN = N / BM; nwg = nM * nN; G = G_; c = c_; }
    __host__ __device__ bool next(int i, Unit& u) const {
        const long L = (long)i * G + c; if (L >= nwg) return false;
        int wgid = (int)L; { const int q = nwg / NXCD, r = nwg % NXCD, xcd = wgid % NXCD, off = wgid / NXCD; wgid = (xcd < r ? xcd * (q + 1) : r * (q + 1) + (xcd - r) * q) + off; }
        const int nig = WGM * nN, gid = wgid / nig, fm = gid * WGM, gsz = (nM - fm) < WGM ? (nM - fm) : WGM;
        u.pm = fm + ((wgid % nig) % gsz); u.pn = (wgid % nig) / gsz; return true;
    }
    __device__ __forceinline__ void a_ready(const Unit&) const {}
    __device__ __forceinline__ void done(const Unit&) const {}
};

__device__ __forceinline__ unsigned cvt_pk_bf16(float lo, float hi) { unsigned r; asm volatile("v_cvt_pk_bf16_f32 %0, %1, %2" : "=v"(r) : "v"(lo), "v"(hi)); return r; }
typedef float f32x2 __attribute__((ext_vector_type(2)));
__device__ __forceinline__ f32x2 gelu_pk(f32x2 v) {
    const f32x2 av = __builtin_elementwise_abs(v), d = av * 0.2316418882f + 1.0f;
    f32x2 t; t.x = __builtin_amdgcn_rcpf(d.x); t.y = __builtin_amdgcn_rcpf(d.y);
    f32x2 q = t * 0.5307027145f + (-0.7265760135f); q = q * t + 0.7107068705f; q = q * t + (-0.142248368f); q = q * t + 0.127414796f; q = q * t;
    const f32x2 s = (v * v) * (-0.72134752044f);
    f32x2 e; e.x = __builtin_amdgcn_exp2f(s.x); e.y = __builtin_amdgcn_exp2f(s.y);
    const f32x2 m = v * (q * e), r = v - m;
    f32x2 o; o.x = v.x < 0.f ? m.x : r.x; o.y = v.y < 0.f ? m.y : r.y; return o;
}

template <int ACT  > struct EpiBf16 {
    static constexpr bool PERM = true, AFTER_DRAIN = false; static_assert(ACT == 0 || ACT == 1, "EpiBf16: ACT is 0 (none) or 1 (gelu_pk)");
    bf16_t* O; int ldc; const float* bias; int split_cols; size_t split_stride; float scale0;
    __device__ __forceinline__ void operator()(const f32x4 (&acc)[2][2][4][2], const Unit& u, int wr, int wc, int fr, int fq) const {
        const int row0 = u.pm * BM + wr * 64 + fr; int colt = u.pn * BM; bf16_t* base = O;
        float sc = 1.f; if (split_cols) { const int t = colt / split_cols; base += (size_t)t * split_stride; colt -= t * split_cols; if (t == 0) sc = scale0; }
        const int col0 = colt + wc * 32 + 8 * fq, bcol0 = u.pn * BM + wc * 32 + 8 * fq;
        f32x4 bv[2][2];
#pragma unroll
        for (int bj = 0; bj < 2; ++bj)
#pragma unroll
            for (int n = 0; n < 2; ++n) bv[bj][n] = bias ? *(const f32x4*)(bias + bcol0 + bj * HALF + 4 * n) : (f32x4){0.f, 0.f, 0.f, 0.f};
#pragma unroll
        for (int ai = 0; ai < 2; ++ai)
#pragma unroll
            for (int m = 0; m < 4; ++m) { bf16_t* rowp = base + (size_t)(row0 + ai * HALF + m * 16) * ldc + col0;
#pragma unroll
                for (int bj = 0; bj < 2; ++bj) { f32x4 v0 = acc[ai][bj][m][0] + bv[bj][0], v1 = acc[ai][bj][m][1] + bv[bj][1];
                    if (ACT == 1) { f32x2 a = gelu_pk((f32x2){v0[0], v0[1]}), b = gelu_pk((f32x2){v0[2], v0[3]}), c = gelu_pk((f32x2){v1[0], v1[1]}), d = gelu_pk((f32x2){v1[2], v1[3]});
                        v0 = (f32x4){a.x, a.y, b.x, b.y}; v1 = (f32x4){c.x, c.y, d.x, d.y}; }
                    v0 = v0 * sc; v1 = v1 * sc; u32x4 w; w.x = cvt_pk_bf16(v0[0], v0[1]); w.y = cvt_pk_bf16(v0[2], v0[3]); w.z = cvt_pk_bf16(v1[0], v1[1]); w.w = cvt_pk_bf16(v1[2], v1[3]);
                    *(u32x4*)(rowp + bj * HALF) = w; } }
    }
};
template <class Epi, class Sched, bool ALIGN_EPI = false, bool SP2 = false>
__device__ __forceinline__ void gemm_phase(PG8_LAS unsigned char* lds, const Gemm g, const Sched& S, const Epi& E) {
    int tid_o = threadIdx.x; asm volatile("" : "+v"(tid_o));
    const int tid = tid_o, wid = __builtin_amdgcn_readfirstlane(tid >> 6), lane = tid & 63, wr = wid >> 2, wc = wid & 3, fr = lane & 15, fq = lane >> 4;
    const int K = g.K, nt = K / BK;
    unsigned voffA[2], voffB[2];
#pragma unroll
    for (int i = 0; i < 2; ++i) { int R, C; stage_rc(tid * 16 + i * 8192, R, C); const int Rb = Epi::PERM ? ((R & ~31) + perm32(R & 31)) : R;
        voffA[i] = (unsigned)(R * K + C) * 2u; voffB[i] = (unsigned)(Rb * K + C) * 2u; }
    const size_t kstep = (size_t)(BK * 2);
    const size_t hstep = (size_t)HALF * K * 2;
    const size_t tstep = 2 * hstep;
    const unsigned ldsw = (unsigned)wid * 1024u;
    const int aoff = lds_byte(wr * 64 + fr, fq * 8), boff = lds_byte(wc * 32 + fr, fq * 8);
#define PG8_SA(b, h) (((b) * 2 + (h)) * HTB)
#define PG8_SB(b, h) ((4 + (b) * 2 + (h)) * HTB)
#define PG8_STAGE(bufoff, gbase, voff) do { _Pragma("unroll") for (int _i = 0; _i < 2; ++_i) \
        __builtin_amdgcn_global_load_lds((const unsigned*)((const char*)(gbase) + (voff)[_i]), (PG8_LAS unsigned*)(lds + (bufoff) + ldsw + _i * 8192), 16, 0, 0); } while (0)
#define PG8_LDA(dst, b, h) do { _Pragma("unroll") for (int m = 0; m < 4; ++m) _Pragma("unroll") for (int k = 0; k < 2; ++k) dst[m][k] = *(const PG8_LAS bf16x8*)(lds + PG8_SA(b, h) + aoff + m * 2048 + k * 1024); } while (0)
#define PG8_LDB(dst, b, h) do { _Pragma("unroll") for (int n = 0; n < 2; ++n) _Pragma("unroll") for (int k = 0; k < 2; ++k) dst[n][k] = *(const PG8_LAS bf16x8*)(lds + PG8_SB(b, h) + boff + n * 2048 + k * 1024); } while (0)
#define PG8_MMA(ai, bj, At, Bt) do { __builtin_amdgcn_s_setprio(1); _Pragma("unroll") for (int m = 0; m < 4; ++m) _Pragma("unroll") for (int n = 0; n < 2; ++n) _Pragma("unroll") for (int k = 0; k < 2; ++k) \
        acc[ai][bj][m][n] = __builtin_amdgcn_mfma_f32_16x16x32_bf16(Bt[n][k], At[m][k], acc[ai][bj][m][n], 0, 0, 0); __builtin_amdgcn_s_setprio(0); } while (0)
#define PG8_WAIT_V(n) asm volatile("s_waitcnt vmcnt(" #n ")" ::: "memory")
#define PG8_WAIT_L(n) asm volatile("s_waitcnt lgkmcnt(" #n ")" ::: "memory")
#define PG8_BAR __builtin_amdgcn_s_barrier()
#define PG8_SCHED __builtin_amdgcn_sched_barrier(0)
    Unit cur, nxt; int ui = 0;
    if (!S.next(0, cur)) return;
    f32x4 acc[2][2][4][2];
#pragma unroll
    for (int a = 0; a < 2; ++a)
#pragma unroll
        for (int b = 0; b < 2; ++b)
#pragma unroll
            for (int m = 0; m < 4; ++m)
#pragma unroll
                for (int n = 0; n < 2; ++n) acc[a][b][m][n] = (f32x4){0.f, 0.f, 0.f, 0.f};
    bf16x8 At[4][2], B0[2][2], B1[2][2];
    const char* cA = (const char*)g.A + (size_t)cur.pm * tstep; const char* cB = (const char*)g.Bt + (size_t)cur.pn * tstep;
    S.a_ready(cur);
    if constexpr (SP2) {
        PG8_STAGE(PG8_SB(0, 0), cB, voffB); PG8_STAGE(PG8_SB(0, 1), cB + hstep, voffB); PG8_STAGE(PG8_SA(0, 0), cA, voffA); PG8_STAGE(PG8_SA(0, 1), cA + hstep, voffA);
        if (wr == 1) PG8_BAR;
        PG8_WAIT_V(2); PG8_BAR;
        PG8_STAGE(PG8_SB(1, 0), cB + kstep, voffB); PG8_STAGE(PG8_SA(1, 0), cA + kstep, voffA); PG8_STAGE(PG8_SB(1, 1), cB + hstep + kstep, voffB);
        PG8_WAIT_V(6); PG8_BAR;
    } else {
        PG8_STAGE(PG8_SB(0, 0), cB, voffB); PG8_STAGE(PG8_SA(0, 0), cA, voffA); PG8_STAGE(PG8_SB(0, 1), cB + hstep, voffB); PG8_STAGE(PG8_SA(0, 1), cA + hstep, voffA);
        if (wr == 1) PG8_BAR;
        PG8_WAIT_V(4); PG8_BAR;
        PG8_STAGE(PG8_SB(1, 0), cB + kstep, voffB); PG8_STAGE(PG8_SA(1, 0), cA + kstep, voffA); PG8_STAGE(PG8_SB(1, 1), cB + hstep + kstep, voffB);
        PG8_WAIT_V(6); PG8_BAR;
    }
    for (;;) {
        const bool has_next = S.next(ui + 1, nxt);
        const char* nA = has_next ? (const char*)g.A + (size_t)nxt.pm * tstep : cA; const char* nB = has_next ? (const char*)g.Bt + (size_t)nxt.pn * tstep : cB;
        for (int t = 0; t < nt; t += 2) {
            const bool last = (t == nt - 2);
            const char* a1 = cA + (size_t)(t + 1) * kstep;
            const char* a2 = last ? nA : cA + (size_t)(t + 2) * kstep; const char* b2 = last ? nB : cB + (size_t)(t + 2) * kstep;
            const char* a3 = a2 + kstep; const char* b3 = b2 + kstep;
            if (last && has_next) S.a_ready(nxt);
            if constexpr (SP2) {
            PG8_LDB(B0, 0, 0); PG8_LDB(B1, 0, 1); PG8_SCHED; PG8_LDA(At, 0, 0); PG8_STAGE(PG8_SA(1, 1), a1 + hstep, voffA);
            PG8_WAIT_V(8); PG8_WAIT_L(0); PG8_BAR; PG8_MMA(0, 0, At, B0); PG8_MMA(0, 1, At, B1); PG8_BAR; PG8_SCHED;
            PG8_LDA(At, 0, 1); PG8_STAGE(PG8_SB(0, 0), b2, voffB); PG8_STAGE(PG8_SB(0, 1), b2 + hstep, voffB); PG8_STAGE(PG8_SA(0, 0), a2, voffA);
            PG8_WAIT_V(8); PG8_WAIT_L(0); PG8_BAR; PG8_MMA(1, 0, At, B0); PG8_MMA(1, 1, At, B1); PG8_BAR; PG8_SCHED;
            PG8_LDB(B0, 1, 0); PG8_LDB(B1, 1, 1); PG8_SCHED; PG8_LDA(At, 1, 0); PG8_STAGE(PG8_SA(0, 1), a2 + hstep, voffA);
            PG8_WAIT_V(8); PG8_WAIT_L(0); PG8_BAR; PG8_MMA(0, 0, At, B0); PG8_MMA(0, 1, At, B1); PG8_BAR; PG8_SCHED;
            PG8_LDA(At, 1, 1); PG8_STAGE(PG8_SB(1, 0), b3, voffB); PG8_STAGE(PG8_SB(1, 1), b3 + hstep, voffB); PG8_STAGE(PG8_SA(1, 0), a3, voffA);
            PG8_WAIT_V(8); PG8_WAIT_L(0); PG8_BAR; PG8_MMA(1, 0, At, B0); PG8_MMA(1, 1, At, B1); PG8_BAR; PG8_SCHED;
            } else {
            PG8_LDB(B0, 0, 0); PG8_SCHED; PG8_LDA(At, 0, 0); PG8_STAGE(PG8_SA(1, 1), a1 + hstep, voffA);
            PG8_WAIT_L(8); PG8_BAR; PG8_WAIT_L(0); PG8_MMA(0, 0, At, B0); PG8_BAR; PG8_SCHED;
            PG8_LDB(B1, 0, 1); PG8_STAGE(PG8_SB(0, 0), b2, voffB);
            PG8_BAR; PG8_WAIT_L(0); PG8_MMA(0, 1, At, B1); PG8_BAR;
            PG8_LDA(At, 0, 1); PG8_STAGE(PG8_SA(0, 0), a2, voffA);
            PG8_BAR; PG8_WAIT_L(0); PG8_MMA(1, 0, At, B0); PG8_BAR; PG8_SCHED;
            PG8_STAGE(PG8_SB(0, 1), b2 + hstep, voffB);
            PG8_WAIT_V(6); PG8_BAR; PG8_MMA(1, 1, At, B1); PG8_BAR;
            PG8_LDB(B0, 1, 0); PG8_SCHED; PG8_LDA(At, 1, 0); PG8_STAGE(PG8_SA(0, 1), a2 + hstep, voffA);
            PG8_WAIT_L(8); PG8_BAR; PG8_WAIT_L(0); PG8_MMA(0, 0, At, B0); PG8_BAR; PG8_SCHED;
            PG8_LDB(B1, 1, 1); PG8_STAGE(PG8_SB(1, 0), b3, voffB);
            PG8_BAR; PG8_WAIT_L(0); PG8_MMA(0, 1, At, B1); PG8_BAR;
            PG8_LDA(At, 1, 1); PG8_STAGE(PG8_SA(1, 0), a3, voffA);
            PG8_BAR; PG8_WAIT_L(0); PG8_MMA(1, 0, At, B0); PG8_BAR; PG8_SCHED;
            PG8_STAGE(PG8_SB(1, 1), b3 + hstep, voffB);
            PG8_WAIT_V(6); PG8_BAR; PG8_MMA(1, 1, At, B1); PG8_BAR;
            }
        }
        if constexpr (ALIGN_EPI) { if (wr == 0) PG8_BAR; }
        if constexpr (!Epi::AFTER_DRAIN) { E(acc, cur, wr, wc, fr, fq); S.done(cur); }
        if (!has_next) break;
#pragma unroll
        for (int a = 0; a < 2; ++a)
#pragma unroll
            for (int b = 0; b < 2; ++b)
#pragma unroll
                for (int m = 0; m < 4; ++m)
#pragma unroll
                    for (int n = 0; n < 2; ++n) acc[a][b][m][n] = (f32x4){0.f, 0.f, 0.f, 0.f};
        cur = nxt; cA = nA; cB = nB; ++ui;
        if constexpr (ALIGN_EPI) { if (wr == 1) PG8_BAR; }
    }
    PG8_WAIT_V(0);
    if constexpr (!ALIGN_EPI) { if (wr == 0) PG8_BAR; }
    PG8_BAR;
    if constexpr (Epi::AFTER_DRAIN) { E.fused(acc, cur, wr, wc, fr, fq, lds, wid, lane); S.done(cur); }
#undef PG8_SA
#undef PG8_SB
#undef PG8_STAGE
#undef PG8_LDA
#undef PG8_LDB
#undef PG8_MMA
#undef PG8_WAIT_V
#undef PG8_WAIT_L
#undef PG8_BAR
#undef PG8_SCHED
}
}
#ifndef MK_COOP
#define MK_COOP 1
#endif
#ifndef MK_REP_K
#define MK_REP_K -1
#endif
#ifndef MK_REP_N
#define MK_REP_N 1
#endif
namespace mk {
using pg8::bf16_t; using pg8::bf16x8; using pg8::f32x4; using pg8::u32x4;
typedef float f32x16 __attribute__((ext_vector_type(16)));
typedef unsigned u32x2 __attribute__((ext_vector_type(2)));
typedef float f32x2_t __attribute__((ext_vector_type(2)));
typedef __bf16 bf16x2_t __attribute__((ext_vector_type(2)));
#define LAS __attribute__((address_space(3)))
#define MFMA32(a, b, c) __builtin_amdgcn_mfma_f32_32x32x16_bf16((a), (b), (c), 0, 0, 0)

constexpr int M_TOK = 16384, SEQ = 8192, DM = 1024, DIN = 3488, DINP = 3584, NLAYER = 2;
constexpr int C_AQ = 0, C_AK = 256, C_AV = 384, C_BB = 512, C_BC = 768, C_BX = 1024, C_CQ = 1280, C_CKV = 1536, C_CKR = 1664,
              C_DQ = 1696, C_DK = 1952, C_DV = 2208, C_GATE = 2464;
constexpr float EPS = 1e-6f, LOG2E = 1.4426950408889634f;
constexpr float SC64 = 0.125f * LOG2E;
constexpr float QSC_MLA = 0.10206207261596575f * LOG2E;
constexpr int NWAVES = 8, NTHREADS = 512;
constexpr int LDS_BYTES = 131072 + 1024;

constexpr size_t MiB = 1u << 20;
constexpr size_t WS_CTL = 0, CTL_BYTES = 65536;
constexpr int CW_BAR = 1024;
constexpr size_t WS_WIN = 1 * MiB;
constexpr size_t WS_WOUT = 15 * MiB;
constexpr size_t WS_WUQ = 19 * MiB;
constexpr size_t WS_WUKV = 19 * MiB + 512 * 1024;
constexpr size_t WS_XN = 32 * MiB;
constexpr size_t WS_H = 64 * MiB;
constexpr size_t WS_QC = 176 * MiB;
constexpr size_t WS_KC = 188 * MiB;
constexpr size_t WS_VTC = 200 * MiB;
constexpr size_t WS_VTA = 208 * MiB;
constexpr size_t WS_VTD = 212 * MiB;
constexpr size_t WS_Y = 220 * MiB;
constexpr size_t WS_END = 252 * MiB;

struct Params {
    const float* x; const int* pos; const float* norm_pre; const float* w_in; const float* sinks; const float* conv_w; const float* conv_b;
    const float* g_cq; const float* w_uq; const float* g_ckv; const float* w_ukv; const float* g_grp; const float* w_out; const float* g_post;
    float* out; unsigned char* ws; int ph_lo, ph_hi;
};

__device__ __forceinline__ unsigned pk2(float lo, float hi) { f32x2_t v = {lo, hi}; bf16x2_t b = __builtin_convertvector(v, bf16x2_t); return __builtin_bit_cast(unsigned, b); }
__device__ __forceinline__ float bf2f(short s) { return __uint_as_float(((unsigned)(unsigned short)s) << 16); }
__device__ __forceinline__ float bflo(unsigned u) { return __uint_as_float(u << 16); }
__device__ __forceinline__ float bfhi(unsigned u) { return __uint_as_float(u & 0xffff0000u); }
__device__ __forceinline__ bf16_t f2bf(float f) { return (bf16_t)(pk2(f, 0.f) & 0xffffu); }
__device__ __forceinline__ int crow(int i, int h) { return (i & 3) + 8 * (i >> 2) + 4 * h; }
__device__ __forceinline__ float ex2(float x) { return __builtin_amdgcn_exp2f(x); }
__device__ __forceinline__ float lg2(float x) { return __builtin_amdgcn_logf(x); }
__device__ __forceinline__ float wave_sum(float v) {
#pragma unroll
    for (int o = 1; o < 64; o <<= 1) v += __shfl_xor(v, o);
    return v;
}
__device__ __forceinline__ bf16x8 pack8(const float* e) {
    u32x4 w; w.x = pk2(e[0], e[1]); w.y = pk2(e[2], e[3]); w.z = pk2(e[4], e[5]); w.w = pk2(e[6], e[7]);
    return __builtin_bit_cast(bf16x8, w);
}

__device__ __forceinline__ void conv_wT(const float* __restrict__ W, int K, int N, int NP, const float* __restrict__ gain, bf16_t* __restrict__ dst,
                                        int a0, int a1, int b0, int b1, float sc, int gtid, int gthreads) {
    const int k8n = K / 8; const int items = NP * k8n;
#pragma unroll 2
    for (int it = gtid; it < items; it += gthreads) {
        const int n = it % NP, k8 = it / NP;
        u32x4 o = {0u, 0u, 0u, 0u};
        if (n < N) {
            const float cs = ((n >= a0 && n < a1) || (n >= b0 && n < b1)) ? sc : 1.f;
            float v[8];
#pragma unroll
            for (int j = 0; j < 8; ++j) v[j] = W[(size_t)(k8 * 8 + j) * N + n] * gain[k8 * 8 + j] * cs;
            o.x = pk2(v[0], v[1]); o.y = pk2(v[2], v[3]); o.z = pk2(v[4], v[5]); o.w = pk2(v[6], v[7]);
        }
        *(u32x4*)(dst + (size_t)n * K + k8 * 8) = o;
    }
}
__device__ __forceinline__ void rms_row_to_bf16(const float* __restrict__ xrow, bf16_t* __restrict__ orow, int lane) {
    f32x4 v[4]; float s = 0.f;
#pragma unroll
    for (int j = 0; j < 4; ++j) { v[j] = ((const f32x4*)xrow)[lane + 64 * j]; s += (v[j].x * v[j].x + v[j].y * v[j].y) + (v[j].z * v[j].z + v[j].w * v[j].w); }
    const float rs = rsqrtf(wave_sum(s) * (1.f / DM) + EPS);
#pragma unroll
    for (int j = 0; j < 4; ++j) { u32x2 o; o.x = pk2(v[j].x * rs, v[j].y * rs); o.y = pk2(v[j].z * rs, v[j].w * rs); ((u32x2*)orow)[lane + 64 * j] = o; }
}

__device__ __forceinline__ void rope_cs(int pos, int h, float (&cs)[8], float (&sn)[8]) {
#pragma unroll
    for (int i = 0; i < 8; ++i) {
        const int f = (i & 3) + 8 * (i >> 2) + 4 * h;
        const float freq = ex2(-(float)f * 0.830482023721841f);
        const float ang = (float)pos * freq;
        const double rev = (double)ang * 0.15915494309189535;
        const float fr = (float)(rev - __builtin_rint(rev));
        cs[i] = __builtin_amdgcn_cosf(fr); sn[i] = __builtin_amdgcn_sinf(fr);
    }
}
__device__ __forceinline__ void rope_apply(f32x16& a, const float (&cs)[8], const float (&sn)[8]) {
#pragma unroll
    for (int i = 0; i < 8; ++i) { const float x1 = a[i], x2 = a[i + 8]; a[i] = x1 * cs[i] - x2 * sn[i]; a[i + 8] = x1 * sn[i] + x2 * cs[i]; }
}
__device__ __forceinline__ void store_tile_rowmajor(bf16_t* dst  , const f32x16& a, int h) {
#pragma unroll
    for (int g = 0; g < 4; ++g) { u32x2 o; o.x = pk2(a[4 * g], a[4 * g + 1]); o.y = pk2(a[4 * g + 2], a[4 * g + 3]); *(u32x2*)(dst + 8 * g + 4 * h) = o; }
}
__device__ __forceinline__ void mq_unit(const bf16_t* __restrict__ H, const bf16_t* __restrict__ WT, const int* __restrict__ pos, bf16_t* __restrict__ QC, int tb, int hh, int lane) {
    const int r = lane & 31, h = lane >> 5, tok = tb * 32 + r;
    const bf16_t* src = H + (size_t)tok * DINP + C_CQ + 8 * h;
    bf16x8 bfr[16]; float ss = 0.f;
#pragma unroll
    for (int s = 0; s < 16; ++s) { bfr[s] = *(const bf16x8*)(src + 16 * s);
#pragma unroll
        for (int j = 0; j < 8; ++j) { const float v = bf2f(bfr[s][j]); ss += v * v; } }
    ss += __shfl_xor(ss, 32);
    const float rs = rsqrtf(ss * (1.f / 256.f) + EPS) * QSC_MLA;
    float cs[8], sn[8]; rope_cs(pos[tok], h, cs, sn);
    const bf16_t* W = WT + (size_t)(hh * 96 + r) * 256 + 8 * h;
#pragma unroll 1
    for (int nt = 0; nt < 3; ++nt) {
        f32x16 acc;
#pragma unroll
        for (int i = 0; i < 16; ++i) acc[i] = 0.f;
#pragma unroll
        for (int s = 0; s < 16; ++s) { const bf16x8 a = *(const bf16x8*)(W + (size_t)nt * 32 * 256 + 16 * s); acc = MFMA32(a, bfr[s], acc); }
#pragma unroll
        for (int i = 0; i < 16; ++i) acc[i] *= rs;
        if (nt == 2) rope_apply(acc, cs, sn);
        store_tile_rowmajor(QC + (size_t)tok * 384 + hh * 96 + nt * 32, acc, h);
    }
}
__device__ __forceinline__ void vt_flush(LAS bf16_t* stg, bf16_t* __restrict__ dst  , int lane) {
    const LAS u32x4* rp = (const LAS u32x4*)(stg + lane * 32);
    u32x4 w[4];
#pragma unroll
    for (int c = 0; c < 4; ++c) w[c] = rp[c];
    u32x4* gp = (u32x4*)(dst + (size_t)lane * SEQ);
#pragma unroll
    for (int c = 0; c < 4; ++c) gp[c] = w[c];
}
__device__ __forceinline__ void mkv_unit(const bf16_t* __restrict__ H, const bf16_t* __restrict__ WT, const int* __restrict__ pos, bf16_t* __restrict__ KC, bf16_t* __restrict__ VTC, int tb, int hh, int lane, LAS bf16_t* stg) {
    const int r = lane & 31, h = lane >> 5, tok = tb * 32 + r;
    const bf16_t* src = H + (size_t)tok * DINP + C_CKV + 8 * h;
    bf16x8 bfr[8]; float ss = 0.f;
#pragma unroll
    for (int s = 0; s < 8; ++s) { bfr[s] = *(const bf16x8*)(src + 16 * s);
#pragma unroll
        for (int j = 0; j < 8; ++j) { const float v = bf2f(bfr[s][j]); ss += v * v; } }
    ss += __shfl_xor(ss, 32);
    const float rs = rsqrtf(ss * (1.f / 128.f) + EPS);
    const bf16_t* W = WT + (size_t)(hh * 128 + r) * 128 + 8 * h;
    const int b = (tb * 32) / SEQ, t0 = (tb * 32) % SEQ;
#pragma unroll 1
    for (int nt = 0; nt < 4; ++nt) {
        f32x16 acc;
#pragma unroll
        for (int i = 0; i < 16; ++i) acc[i] = 0.f;
#pragma unroll
        for (int s = 0; s < 8; ++s) { const bf16x8 a = *(const bf16x8*)(W + (size_t)nt * 32 * 128 + 16 * s); acc = MFMA32(a, bfr[s], acc); }
#pragma unroll
        for (int i = 0; i < 16; ++i) acc[i] *= rs;
        if (nt < 2) store_tile_rowmajor(KC + (size_t)tok * 384 + hh * 96 + nt * 32, acc, h);
        else {
            LAS bf16_t* sp = stg + ((nt - 2) * 32 + 4 * h) * 32 + r;
#pragma unroll
            for (int i = 0; i < 16; ++i) sp[((i & 3) + 8 * (i >> 2)) * 32] = f2bf(acc[i]);
        }
    }
    vt_flush(stg, VTC + ((size_t)((b * 4 + hh) * 64)) * SEQ + t0, lane);
    f32x16 kr;
    const bf16_t* krp = H + (size_t)tok * DINP + C_CKR + 4 * h;
#pragma unroll
    for (int g = 0; g < 4; ++g) { const u32x2 w = *(const u32x2*)(krp + 8 * g); kr[4 * g] = bflo(w.x); kr[4 * g + 1] = bfhi(w.x); kr[4 * g + 2] = bflo(w.y); kr[4 * g + 3] = bfhi(w.y); }
    float cs[8], sn[8]; rope_cs(pos[tok], h, cs, sn);
    rope_apply(kr, cs, sn);
    store_tile_rowmajor(KC + (size_t)tok * 384 + hh * 96 + 64, kr, h);
}
__device__ __forceinline__ void vt_unit(const bf16_t* __restrict__ H, int col0, int NH, bf16_t* __restrict__ VT, int tb, int head, int lane, LAS bf16_t* stg) {
    const int r = lane & 31, h = lane >> 5, tok = tb * 32 + r, b = (tb * 32) / SEQ, t0 = (tb * 32) % SEQ;
    const bf16_t* src = H + (size_t)tok * DINP + col0 + head * 64 + 32 * h;
    bf16x8 v[4];
#pragma unroll
    for (int c = 0; c < 4; ++c) v[c] = *(const bf16x8*)(src + 8 * c);
    LAS bf16_t* sp = stg + (32 * h) * 32 + r;
#pragma unroll
    for (int c = 0; c < 4; ++c)
#pragma unroll
        for (int j = 0; j < 8; ++j) sp[(8 * c + j) * 32] = (bf16_t)v[c][j];
    vt_flush(stg, VT + ((size_t)((b * NH + head) * 64)) * SEQ + t0, lane);
}
__device__ __forceinline__ void conv_unit(const bf16_t* __restrict__ H, const float* __restrict__ cw, const float* __restrict__ cb, bf16_t* __restrict__ Y, int tb8, int lane) {
    const int tok0 = tb8 * 8, t0 = tok0 % SEQ, ch = 4 * lane;
    const f32x4 w0 = *(const f32x4*)(cw + ch), w1 = *(const f32x4*)(cw + 256 + ch), w2 = *(const f32x4*)(cw + 512 + ch), bs = *(const f32x4*)(cb + ch);
    u32x2 cc[10], xx[10], bb[8];
    const int back = (t0 >= 2) ? 2 : 0;
#pragma unroll
    for (int i = 0; i < 10; ++i) { const int ti = (i < 2) ? (i - back) : (i - 2); const bf16_t* p = H + (size_t)(tok0 + ti) * DINP + ch;
        cc[i] = *(const u32x2*)(p + C_BC); xx[i] = *(const u32x2*)(p + C_BX); if (i >= 2) bb[i - 2] = *(const u32x2*)(p + C_BB); }
    f32x4 u[10];
#pragma unroll
    for (int i = 0; i < 10; ++i) u[i] = (f32x4){bflo(cc[i].x) * bflo(xx[i].x), bfhi(cc[i].x) * bfhi(xx[i].x), bflo(cc[i].y) * bflo(xx[i].y), bfhi(cc[i].y) * bfhi(xx[i].y)};
    if (back == 0) { u[0] = (f32x4){0.f, 0.f, 0.f, 0.f}; u[1] = (f32x4){0.f, 0.f, 0.f, 0.f}; }
#pragma unroll
    for (int i = 0; i < 8; ++i) {
        const f32x4 bg = {bflo(bb[i].x), bfhi(bb[i].x), bflo(bb[i].y), bfhi(bb[i].y)};
        const f32x4 y = bg * (w0 * u[i] + w1 * u[i + 1] + w2 * u[i + 2] + bs);
        u32x2 o; o.x = pk2(y.x, y.y); o.y = pk2(y.z, y.w);
        *(u32x2*)(Y + (size_t)(tok0 + i) * DM + 256 + ch) = o;
    }
}

__device__ __forceinline__ void o_flush(LAS bf16_t* stg, bf16_t* __restrict__ Orow0, int opitch, int lane) {
    u32x4 w[4];
#pragma unroll
    for (int j = 0; j < 4; ++j) w[j] = *(const LAS u32x4*)(stg + (lane + 64 * j) * 8);
#pragma unroll
    for (int j = 0; j < 4; ++j) { const int c = lane + 64 * j; *(u32x4*)(Orow0 + (size_t)(c >> 3) * opitch + (c & 7) * 8) = w[j]; }
}
template <int DKS, bool SINK>
__device__ __forceinline__ void softmax_unit(const bf16_t* __restrict__ Qrow0, int qpitch, const bf16_t* __restrict__ Kb, int kpitch, const bf16_t* __restrict__ VT,
                                             int qb, int kt_begin, int window, float sink2, bf16_t* __restrict__ Orow0, int opitch, int lane, LAS bf16_t* stg) {
    const int r = lane & 31, h = lane >> 5;
    const int pr = (r & ~12) | ((r & 8) >> 1) | ((r & 4) << 1);
    bf16x8 qf[DKS];
#pragma unroll
    for (int s = 0; s < DKS; ++s) qf[s] = *(const bf16x8*)(Qrow0 + (size_t)r * qpitch + 16 * s + 8 * h);
    f32x16 o0, o1;
#pragma unroll
    for (int i = 0; i < 16; ++i) { o0[i] = 0.f; o1[i] = 0.f; }
    float m = -1e30f, l = 0.f;
    const int kt_end = qb + 1, q = 32 * qb + r;
    const bf16_t* kp = Kb + (size_t)(32 * kt_begin + pr) * kpitch + 8 * h;
    const bf16_t* vp = VT + (size_t)r * SEQ + 32 * kt_begin + 8 * h;
    bf16x8 kf[DKS];
#pragma unroll
    for (int s = 0; s < DKS; ++s) kf[s] = *(const bf16x8*)(kp + 16 * s);
    for (int kt = kt_begin; kt < kt_end; ++kt) {
        bf16x8 kn[DKS];
        if (kt + 1 < kt_end) {
#pragma unroll
            for (int s = 0; s < DKS; ++s) kn[s] = *(const bf16x8*)(kp + (size_t)32 * kpitch + 16 * s);
        } else {
#pragma unroll
            for (int s = 0; s < DKS; ++s) kn[s] = kf[s];
        }
        const bf16x8 v00 = *(const bf16x8*)(vp), v01 = *(const bf16x8*)(vp + 32 * SEQ), v10 = *(const bf16x8*)(vp + 16), v11 = *(const bf16x8*)(vp + 32 * SEQ + 16);
        f32x16 p;
#pragma unroll
        for (int i = 0; i < 16; ++i) p[i] = 0.f;
#pragma unroll
        for (int s = 0; s < DKS; ++s) p = MFMA32(kf[s], qf[s], p);
        if (kt == qb || (window != 0 && kt == qb - (window >> 5))) {
            const int k0 = 32 * kt + 8 * h;
#pragma unroll
            for (int i = 0; i < 16; ++i) { const int kv = k0 + 16 * (i >> 3) + (i & 7); const bool ok = (kv <= q) && (window == 0 || kv > q - window); if (!ok) p[i] = -INFINITY; }
        }
        float rm = p[0];
#pragma unroll
        for (int i = 1; i < 16; ++i) rm = fmaxf(rm, p[i]);
        rm = fmaxf(rm, __shfl_xor(rm, 32));
        if (__any(rm > m + 6.f)) {
            const float mn = fmaxf(m, rm), f = ex2(m - mn); m = mn; l *= f;
#pragma unroll
            for (int i = 0; i < 16; ++i) { const float fi = __shfl(f, crow(i, h)); o0[i] *= fi; o1[i] *= fi; }
        }
        float e[16];
#pragma unroll
        for (int i = 0; i < 16; ++i) { e[i] = ex2(p[i] - m); l += e[i]; }
        const bf16x8 pa0 = pack8(e), pa1 = pack8(e + 8);
        o0 = MFMA32(pa0, v00, o0); o1 = MFMA32(pa0, v01, o1);
        o0 = MFMA32(pa1, v10, o0); o1 = MFMA32(pa1, v11, o1);
#pragma unroll
        for (int s = 0; s < DKS; ++s) kf[s] = kn[s];
        kp += (size_t)32 * kpitch; vp += 32;
    }
    l += __shfl_xor(l, 32);
    if (SINK) l += ex2(sink2 - m);
    const float inv = 1.f / l;
    LAS bf16_t* sp = stg + (4 * h) * 64 + r;
#pragma unroll
    for (int i = 0; i < 16; ++i) { const float fi = __shfl(inv, crow(i, h)); const int ro = ((i & 3) + 8 * (i >> 2)) * 64;
        sp[ro] = f2bf(o0[i] * fi); sp[ro + 32] = f2bf(o1[i] * fi); }
    o_flush(stg, Orow0, opitch, lane);
}


constexpr int KP = 208, VP = 272;
constexpr int KT_BYTES = 128 * KP, VT_BYTES = 64 * VP, TB_BYTES = KT_BYTES + VT_BYTES, MRG_OFF = 2 * TB_BYTES;
static_assert(MRG_OFF + 4 * 34 * 64 * 4 <= 131072, "MLA LDS map");
__device__ __forceinline__ void mla_unit_blk(const bf16_t* __restrict__ QC, const bf16_t* __restrict__ KC, const bf16_t* __restrict__ VTC, bf16_t* __restrict__ Y,
                                             int bh, int g, LAS unsigned char* lds, int tid) {
    const int lane = tid & 63, wave = __builtin_amdgcn_readfirstlane(tid >> 6), r = lane & 31, h = lane >> 5, w4 = wave & 3, kh = wave >> 2;
    const int pr = (r & ~12) | ((r & 8) >> 1) | ((r & 4) << 1);
    const int b = bh >> 2, hh = bh & 3, qb = 4 * g + w4, q = 32 * qb + r;
    const bf16_t* Qp = QC + ((size_t)b * SEQ + q) * 384 + hh * 96 + 8 * h;
    bf16x8 qf[6];
#pragma unroll
    for (int s = 0; s < 6; ++s) qf[s] = *(const bf16x8*)(Qp + 16 * s);
    const bf16_t* Kg = KC + (size_t)b * SEQ * 384 + hh * 96;
    const bf16_t* Vg = VTC + (size_t)(b * 4 + hh) * 64 * SEQ;
    int kgo[3], klo[3], vgo[2], vlo[2];
#pragma unroll
    for (int i = 0; i < 3; ++i) { const int c = tid + 512 * i, row = c / 12, cc = c - 12 * row; kgo[i] = row * 384 + 8 * cc; klo[i] = row * KP + 16 * cc; }
#pragma unroll
    for (int i = 0; i < 2; ++i) { const int c = tid + 512 * i, d = c >> 4, cc = c & 15; vgo[i] = d * SEQ + 8 * cc; vlo[i] = KT_BYTES + d * VP + 16 * cc; }
    u32x4 kr[3], vr[2];
#define MLA_LOAD(ST) do { _Pragma("unroll") for (int i = 0; i < 3; ++i) kr[i] = *(const u32x4*)(Kg + (size_t)(ST) * (128 * 384) + kgo[i]); \
                          _Pragma("unroll") for (int i = 0; i < 2; ++i) vr[i] = *(const u32x4*)(Vg + (ST) * 128 + vgo[i]); } while (0)
#define MLA_STORE(buf) do { LAS unsigned char* tb_ = lds + (buf) * TB_BYTES; _Pragma("unroll") for (int i = 0; i < 3; ++i) *(LAS u32x4*)(tb_ + klo[i]) = kr[i]; \
                            _Pragma("unroll") for (int i = 0; i < 2; ++i) *(LAS u32x4*)(tb_ + vlo[i]) = vr[i]; } while (0)
    f32x16 o0, o1;
#pragma unroll
    for (int i = 0; i < 16; ++i) { o0[i] = 0.f; o1[i] = 0.f; }
    float m = -1e30f, l = 0.f;
    const int nST = g + 1;
    MLA_LOAD(0); MLA_STORE(0);
    __syncthreads();
    const int kfo = (64 * kh + pr) * KP + 16 * h;
    const int vfo = KT_BYTES + r * VP + (64 * kh + 8 * h) * 2;
    for (int ST = 0; ST < nST; ++ST) {
        if (ST + 1 < nST) MLA_LOAD(ST + 1);
        const int kt0 = 4 * ST + 2 * kh;
        if (kt0 <= qb) {
            const LAS unsigned char* tb = lds + (ST & 1) * TB_BYTES;
            f32x16 p0, p1;
#pragma unroll
            for (int i = 0; i < 16; ++i) { p0[i] = 0.f; p1[i] = 0.f; }
#pragma unroll
            for (int s = 0; s < 6; ++s) { const bf16x8 k0 = *(const LAS bf16x8*)(tb + kfo + 32 * s), k1 = *(const LAS bf16x8*)(tb + kfo + 32 * KP + 32 * s);
                p0 = MFMA32(k0, qf[s], p0); p1 = MFMA32(k1, qf[s], p1); }
            if (kt0 + 1 >= qb) {
                const int kb0 = 32 * kt0 + 8 * h;
#pragma unroll
                for (int i = 0; i < 16; ++i) { const int kv = kb0 + 16 * (i >> 3) + (i & 7); if (kv > q) p0[i] = -INFINITY; if (kv + 32 > q) p1[i] = -INFINITY; }
            }
            float rm = fmaxf(p0[0], p1[0]);
#pragma unroll
            for (int i = 1; i < 16; ++i) rm = fmaxf(rm, fmaxf(p0[i], p1[i]));
            rm = fmaxf(rm, __shfl_xor(rm, 32));
            if (__any(rm > m + 6.f)) {
                const float mn = fmaxf(m, rm), f = ex2(m - mn); m = mn; l *= f;
#pragma unroll
                for (int i = 0; i < 16; ++i) { const float fi = __shfl(f, crow(i, h)); o0[i] *= fi; o1[i] *= fi; }
            }
            float ls = 0.f;
#pragma unroll
            for (int i = 0; i < 16; ++i) { p0[i] = ex2(p0[i] - m); p1[i] = ex2(p1[i] - m); ls += p0[i] + p1[i]; }
            l += ls;
            float e[8];
#pragma unroll
            for (int ks = 0; ks < 4; ++ks) {
#pragma unroll
                for (int j = 0; j < 8; ++j) e[j] = (ks < 2) ? p0[8 * ks + j] : p1[8 * (ks - 2) + j];
                const bf16x8 pa = pack8(e);
                const bf16x8 v0 = *(const LAS bf16x8*)(tb + vfo + 32 * ks), v1 = *(const LAS bf16x8*)(tb + vfo + 32 * VP + 32 * ks);
                o0 = MFMA32(pa, v0, o0); o1 = MFMA32(pa, v1, o1);
            }
        }
        if (ST + 1 < nST) MLA_STORE((ST + 1) & 1);
        __syncthreads();
    }
#undef MLA_LOAD
#undef MLA_STORE
    l += __shfl_xor(l, 32);
    LAS float* mg = (LAS float*)(lds + MRG_OFF) + w4 * (34 * 64) + lane;
    if (kh == 1) {
#pragma unroll
        for (int i = 0; i < 16; ++i) { mg[i * 64] = o0[i]; mg[(16 + i) * 64] = o1[i]; }
        mg[32 * 64] = m; mg[33 * 64] = l;
    }
    __syncthreads();
    if (kh == 0) {
        const float mb = mg[32 * 64], lb = mg[33 * 64];
        const float mn = fmaxf(m, mb), fa = ex2(m - mn), fb = ex2(mb - mn), inv = 1.f / (l * fa + lb * fb), ga = fa * inv, gb = fb * inv;
        LAS bf16_t* stg = (LAS bf16_t*)(lds + wave * 4096);
        LAS bf16_t* sp = stg + (4 * h) * 64 + r;
#pragma unroll
        for (int i = 0; i < 16; ++i) { const float ra = __shfl(ga, crow(i, h)), rb = __shfl(gb, crow(i, h)); const int ro = ((i & 3) + 8 * (i >> 2)) * 64;
            sp[ro] = f2bf(o0[i] * ra + mg[i * 64] * rb); sp[ro + 32] = f2bf(o1[i] * ra + mg[(16 + i) * 64] * rb); }
        o_flush(stg, Y + ((size_t)b * SEQ + 32 * qb) * DM + 512 + hh * 64, DM, lane);
    }
    __syncthreads();
}

__device__ __forceinline__ void sb_unit(const bf16_t* __restrict__ Qrow0, int qpitch, const bf16_t* __restrict__ Kb, int kpitch, const bf16_t* __restrict__ VT,
                                        int qb, bf16_t* __restrict__ Orow0, int opitch, int lane, LAS bf16_t* stg) {
    const int r = lane & 31, h = lane >> 5;
    const int pr = (r & ~12) | ((r & 8) >> 1) | ((r & 4) << 1);
    bf16x8 qf[4];
#pragma unroll
    for (int s = 0; s < 4; ++s) qf[s] = *(const bf16x8*)(Qrow0 + (size_t)r * qpitch + 16 * s + 8 * h);
    f32x16 o0, o1;
#pragma unroll
    for (int i = 0; i < 16; ++i) { o0[i] = 0.f; o1[i] = 0.f; }
    float carry = 0.f;
    const int q = 32 * qb + r;
    const bf16_t* kp = Kb + (size_t)(32 * qb + pr) * kpitch + 8 * h;
    const bf16_t* vp = VT + (size_t)r * SEQ + 32 * qb + 8 * h;
    bf16x8 kf[4];
#pragma unroll
    for (int s = 0; s < 4; ++s) kf[s] = *(const bf16x8*)(kp + 16 * s);
    for (int kt = qb; kt >= 0; --kt) {
        bf16x8 kn[4];
        if (kt > 0) {
#pragma unroll
            for (int s = 0; s < 4; ++s) kn[s] = *(const bf16x8*)(kp - (size_t)32 * kpitch + 16 * s);
        } else {
#pragma unroll
            for (int s = 0; s < 4; ++s) kn[s] = kf[s];
        }
        const bf16x8 v00 = *(const bf16x8*)(vp), v01 = *(const bf16x8*)(vp + 32 * SEQ), v10 = *(const bf16x8*)(vp + 16), v11 = *(const bf16x8*)(vp + 32 * SEQ + 16);
        f32x16 p;
#pragma unroll
        for (int i = 0; i < 16; ++i) p[i] = 0.f;
#pragma unroll
        for (int s = 0; s < 4; ++s) p = MFMA32(kf[s], qf[s], p);
        const bool diag = (kt == qb);
        const int k0 = 32 * kt + 8 * h;
        float sfx[16];
#pragma unroll
        for (int i = 0; i < 16; ++i) {
            const float z = p[i];
            float L = -(fmaxf(z, 0.f) + lg2(1.f + ex2(-fabsf(z))));
            if (diag) { const int kv = k0 + 16 * (i >> 3) + (i & 7); if (!(kv < q)) L = 0.f; }
            sfx[i] = L;
        }
#pragma unroll
        for (int g = 0; g < 2; ++g)
#pragma unroll
            for (int j = 6; j >= 0; --j) sfx[8 * g + j] += sfx[8 * g + j + 1];
        const float T0 = sfx[0], T1 = sfx[8];
        const float TP0 = __shfl_xor(T0, 32), TP1 = __shfl_xor(T1, 32);
        const float off1 = (h ? 0.f : TP1) + carry, off0 = T1 + TP1 + (h ? 0.f : TP0) + carry;
        float e[16];
#pragma unroll
        for (int i = 0; i < 16; ++i) {
            float a = ex2(p[i] + sfx[i] + (i < 8 ? off0 : off1));
            if (diag) { const int kv = k0 + 16 * (i >> 3) + (i & 7); if (!(kv < q)) a = 0.f; }
            e[i] = a;
        }
        carry += (T0 + T1) + (TP0 + TP1);
        const bf16x8 pa0 = pack8(e), pa1 = pack8(e + 8);
        o0 = MFMA32(pa0, v00, o0); o1 = MFMA32(pa0, v01, o1);
        o0 = MFMA32(pa1, v10, o0); o1 = MFMA32(pa1, v11, o1);
        if (__all(carry < -150.f)) break;
#pragma unroll
        for (int s = 0; s < 4; ++s) kf[s] = kn[s];
        kp -= (size_t)32 * kpitch; vp -= 32;
    }
    LAS bf16_t* sp = stg + (4 * h) * 64 + r;
#pragma unroll
    for (int i = 0; i < 16; ++i) { const int ro = ((i & 3) + 8 * (i >> 2)) * 64; sp[ro] = f2bf(o0[i]); sp[ro + 32] = f2bf(o1[i]); }
    o_flush(stg, Orow0, opitch, lane);
}

#define XB_TMO      128
#define XB_XCNT(j)  (256  + 64 * (j))
#define XB_XSUB(j)  (1280 + 64 * (j))
#define XB_XGEN(j)  (2304 + 64 * (j))
#define XB_TOP      3328
#define XB_TOPGEN   3392
#define XCD_BAR_WORDS 3456
#define XB_SPIN_CAP (1u << 18)

__device__ __forceinline__ unsigned xb_ld(unsigned* p)              { return __hip_atomic_load(p, __ATOMIC_RELAXED, __HIP_MEMORY_SCOPE_AGENT); }
__device__ __forceinline__ unsigned xb_add(unsigned* p, unsigned v) { return __hip_atomic_fetch_add(p, v, __ATOMIC_RELAXED, __HIP_MEMORY_SCOPE_AGENT); }
__device__ __forceinline__ unsigned xb_xcc_id() { return (unsigned)__builtin_amdgcn_s_getreg((3 << 11) | 20) & 0xFu; }
#define XB_SPIN(cond, bar) do { unsigned _sp = 0; while (cond) { __builtin_amdgcn_s_sleep(1); \
    if ((++_sp & 255u) == 0u) { if (xb_ld(&(bar)[XB_TMO])) break; if (_sp > XB_SPIN_CAP) { atomicAdd(&(bar)[XB_TMO], 1u); break; } } } } while (0)

struct XcdBarrier {
    unsigned* bar; unsigned x;
    volatile LAS unsigned* st;
};

__device__ __forceinline__ XcdBarrier xcd_barrier_post(unsigned* bar, volatile LAS unsigned* st) {
    XcdBarrier b; b.bar = bar; b.x = xb_xcc_id(); b.st = st;
    if (threadIdx.x == 0) (void)xb_add(&bar[XB_XCNT(b.x)], 1u);
    return b;
}
__device__ __forceinline__ void xcd_barrier_complete(unsigned* bar, unsigned x, unsigned& nloc, unsigned& nx) {
    const unsigned G = gridDim.x * gridDim.y * gridDim.z;
    unsigned sum, cnt, mine, sp = 0u;
    for (;;) {
        sum = 0u; cnt = 0u; mine = 0u;
#pragma unroll
        for (unsigned j = 0; j < 16; ++j) { const unsigned c = xb_ld(&bar[XB_XCNT(j)]); sum += c; cnt += (c > 0u) ? 1u : 0u; mine = (j == x) ? c : mine; }
        if (sum == G) break;
        __builtin_amdgcn_s_sleep(1);
        if ((++sp & 255u) == 0u) { if (xb_ld(&bar[XB_TMO])) break; if (sp > XB_SPIN_CAP) { atomicAdd(&bar[XB_TMO], 1u); break; } }
    }
    nloc = mine > 0u ? mine : 1u; nx = cnt > 0u ? cnt : 1u;
}

__device__ __forceinline__ void xcd_barrier(const XcdBarrier& b) {
    asm volatile("s_waitcnt vmcnt(0)" ::: "memory");
    __syncthreads();
    if (threadIdx.x == 0) {
        unsigned* bar = b.bar;
        __builtin_amdgcn_s_waitcnt(0);
        unsigned nloc = b.st[0], nx = b.st[1];
        if (nloc == 0u) { xcd_barrier_complete(bar, b.x, nloc, nx); b.st[0] = nloc; b.st[1] = nx; }
        const unsigned old = xb_add(&bar[XB_XSUB(b.x)], 1u);
        const unsigned gen = old / nloc;
        if (old + 1u == (gen + 1u) * nloc) {
            __builtin_amdgcn_fence(__ATOMIC_RELEASE, "agent");
            asm volatile("s_waitcnt vmcnt(0)" ::: "memory");
            const unsigned og = xb_add(&bar[XB_TOP], 1u);
            const unsigned tg = og / nx;
            if (og + 1u == (tg + 1u) * nx) xb_add(&bar[XB_TOPGEN], 1u);
            else XB_SPIN(xb_ld(&bar[XB_TOPGEN]) == tg, bar);
            __builtin_amdgcn_fence(__ATOMIC_ACQUIRE, "agent");
            xb_add(&bar[XB_XGEN(b.x)], 1u);
            asm volatile("s_waitcnt vmcnt(0)" ::: "memory");
        } else {
            XB_SPIN(xb_ld(&bar[XB_XGEN(b.x)]) == gen, bar);
            __builtin_amdgcn_fence(__ATOMIC_ACQUIRE, "agent");
            asm volatile("s_waitcnt vmcnt(0)" ::: "memory");
        }
    }
    __syncthreads();
}

__global__ void __launch_bounds__(NTHREADS, 2) fwd(Params P) {
    extern __shared__ __attribute__((aligned(16))) unsigned char lds_raw[];
    LAS unsigned char* lds = (LAS unsigned char*)lds_raw;
    const int G = gridDim.x, bx = blockIdx.x, NGW = G * NWAVES, gthreads = G * NTHREADS;
    unsigned char* ws = P.ws;
    unsigned* ctl = (unsigned*)(ws + WS_CTL);
    bf16_t* XN = (bf16_t*)(ws + WS_XN); bf16_t* H = (bf16_t*)(ws + WS_H);
    bf16_t* QC = (bf16_t*)(ws + WS_QC); bf16_t* KC = (bf16_t*)(ws + WS_KC);
    bf16_t* VTC = (bf16_t*)(ws + WS_VTC); bf16_t* VTA = (bf16_t*)(ws + WS_VTA); bf16_t* VTD = (bf16_t*)(ws + WS_VTD);
    bf16_t* Y = (bf16_t*)(ws + WS_Y);
#if MK_COOP
    cooperative_groups::grid_group grid = cooperative_groups::this_grid();
    volatile LAS unsigned* MISC = (volatile LAS unsigned*)(lds + 131072);
    if (threadIdx.x < 64) MISC[threadIdx.x] = 0u;
    __syncthreads();
    XcdBarrier bar = xcd_barrier_post(ctl + CW_BAR, MISC + 8);
#endif
    for (int ph = P.ph_lo; ph < P.ph_hi; ++ph) {
        const int nrep = ((ph >= 1 && ph <= 6 && ((ph - 1) == MK_REP_K || (MK_REP_K == 6 && ph == 3))) || (ph == 0 && MK_REP_K == 7)) ? MK_REP_N : 1;
        for (int rep = 0; rep < nrep; ++rep) {
        int tid_o = threadIdx.x; asm volatile("" : "+v"(tid_o));
        const int tid = tid_o, lane = tid & 63, wave = __builtin_amdgcn_readfirstlane(tid >> 6);
        const int gw = bx * NWAVES + wave, gtid = bx * NTHREADS + tid;
        LAS bf16_t* stg = (LAS bf16_t*)(lds + wave * 4096);
        if (ph == 0) {
            for (int l = 0; l < NLAYER; ++l) {
                conv_wT(P.w_in + (size_t)l * DM * DIN, DM, DIN, DINP, P.norm_pre + l * DM, (bf16_t*)(ws + WS_WIN) + (size_t)l * DINP * DM, C_AQ, C_AQ + 256, C_DQ, C_DQ + 256, SC64, gtid, gthreads);
                conv_wT(P.w_out + (size_t)l * DM * DM, DM, DM, DM, P.g_grp + l * DM, (bf16_t*)(ws + WS_WOUT) + (size_t)l * DM * DM, 0, 0, 0, 0, 1.f, gtid, gthreads);
                conv_wT(P.w_uq + (size_t)l * 256 * 384, 256, 384, 384, P.g_cq + l * 256, (bf16_t*)(ws + WS_WUQ + (size_t)l * 262144), 0, 0, 0, 0, 1.f, gtid, gthreads);
                conv_wT(P.w_ukv + (size_t)l * 128 * 512, 128, 512, 512, P.g_ckv + l * 128, (bf16_t*)(ws + WS_WUKV + (size_t)l * 131072), 0, 0, 0, 0, 1.f, gtid, gthreads);
            }
            { const float* __restrict__ xr = P.x; bf16_t* __restrict__ xo = XN;
#pragma unroll 2
              for (int mrow = gw; mrow < M_TOK; mrow += NGW) rms_row_to_bf16(xr + (size_t)mrow * DM, xo + (size_t)mrow * DM, lane); }
        } else {
            const int l = (ph - 1) / 6, k = (ph - 1) % 6;
            if (k == 0 || k == 4) {
                if (k == 0) {
                    pg8::Gemm g{XN, (const bf16_t*)(ws + WS_WIN) + (size_t)l * DINP * DM, M_TOK, DINP, DM}; pg8::StaticOrder S; S.init(M_TOK, DINP, G, bx);
                    pg8::EpiBf16<0> E{H, DINP, nullptr, 0, 0, 1.f};
                    pg8::gemm_phase<pg8::EpiBf16<0>, pg8::StaticOrder, true, true>(lds, g, S, E);
                } else {
                    pg8::Gemm g{XN, (const bf16_t*)(ws + WS_WOUT) + (size_t)l * DM * DM, M_TOK, DM, DM}; pg8::StaticOrder S; S.init(M_TOK, DM, G, bx);
                    pg8::EpiBf16<0> E{Y, DM, nullptr, 0, 0, 1.f};
                    pg8::gemm_phase<pg8::EpiBf16<0>, pg8::StaticOrder, true, true>(lds, g, S, E);
                }
            } else if (k == 1) {
                const bf16_t* WUQ = (const bf16_t*)(ws + WS_WUQ + (size_t)l * 262144);
                const bf16_t* WUKV = (const bf16_t*)(ws + WS_WUKV + (size_t)l * 131072);
                constexpr int NTB = M_TOK / 32;
                constexpr int U_MQ = NTB * 4, U_MKV = NTB * 4, U_VTA = NTB * 2, U_VTD = NTB * 4, U_CONV = M_TOK / 8;
                constexpr int U_ALL = U_MQ + U_MKV + U_VTA + U_VTD + U_CONV;
                for (int u = gw; u < U_ALL; u += NGW) {
                    int v = u;
                    if (v < U_MQ) { mq_unit(H, WUQ, P.pos, QC, v >> 2, v & 3, lane); continue; } v -= U_MQ;
                    if (v < U_MKV) { mkv_unit(H, WUKV, P.pos, KC, VTC, v >> 2, v & 3, lane, stg); continue; } v -= U_MKV;
                    if (v < U_VTA) { vt_unit(H, C_AV, 2, VTA, v >> 1, v & 1, lane, stg); continue; } v -= U_VTA;
                    if (v < U_VTD) { vt_unit(H, C_DV, 4, VTD, v >> 2, v & 3, lane, stg); continue; } v -= U_VTD;
                    conv_unit(H, P.conv_w + l * 768, P.conv_b + l * 256, Y, v, lane);
                }
            } else if (k == 2) {
                if (rep == 0 || MK_REP_K == 2)
                for (int pu = bx; pu < 256; pu += G) {
                    const int bh = pu & 7, Gq = pu >> 3;
                    mla_unit_blk(QC, KC, VTC, Y, bh, 63 - Gq, lds, tid);
                    mla_unit_blk(QC, KC, VTC, Y, bh, Gq, lds, tid);
                }
                if (rep == 0 || MK_REP_K == 6)
                for (;;) {
                    unsigned u = 0;
                    if (lane == 0) u = atomicAdd(ctl + 64 * l + 128 * rep, 1u);
                    u = (unsigned)__builtin_amdgcn_readfirstlane((int)u);
                    if (u >= 4096u) break;
                    const int v = (int)(u & 2047u), bh = v >> 8, qb = v & 255, b = bh >> 2, hh = bh & 3;
                    const size_t row0 = (size_t)b * SEQ + 32 * qb;
                    if (u < 2048u) {
                        sb_unit(H + row0 * DINP + C_DQ + hh * 64, DINP, H + (size_t)b * SEQ * DINP + C_DK + hh * 64, DINP, VTD + (size_t)(b * 4 + hh) * 64 * SEQ,
                                qb, Y + row0 * DM + 768 + hh * 64, DM, lane, stg);
                    } else {
                        const int kvh = hh >> 1;
                        const int ktb = qb - 4 > 0 ? qb - 4 : 0;
                        softmax_unit<4, true>(H + row0 * DINP + C_AQ + hh * 64, DINP, H + (size_t)b * SEQ * DINP + C_AK + kvh * 64, DINP, VTA + (size_t)(b * 2 + kvh) * 64 * SEQ,
                                              qb, ktb, 128, P.sinks[l * 4 + hh] * LOG2E, Y + row0 * DM + hh * 64, DM, lane, stg);
                    }
                }
            } else if (k == 3) {
                const bf16_t* __restrict__ Yr = Y; const bf16_t* __restrict__ Hr = H; bf16_t* __restrict__ XNw = XN;
#pragma unroll 2
                for (int mrow = gw; mrow < M_TOK; mrow += NGW) {
                    const u32x4* yp = (const u32x4*)(Yr + (size_t)mrow * DM) + 2 * lane;
                    const u32x4* gp = (const u32x4*)(Hr + (size_t)mrow * DINP + C_GATE) + 2 * lane;
                    const u32x4 y0 = yp[0], y1 = yp[1], g0 = gp[0], g1 = gp[1];
                    float yv[16], gv[16];
#pragma unroll
                    for (int j = 0; j < 4; ++j) { yv[2 * j] = bflo(y0[j]); yv[2 * j + 1] = bfhi(y0[j]); yv[8 + 2 * j] = bflo(y1[j]); yv[8 + 2 * j + 1] = bfhi(y1[j]);
                                                  gv[2 * j] = bflo(g0[j]); gv[2 * j + 1] = bfhi(g0[j]); gv[8 + 2 * j] = bflo(g1[j]); gv[8 + 2 * j + 1] = bfhi(g1[j]); }
                    float ss = 0.f;
#pragma unroll
                    for (int j = 0; j < 16; ++j) ss += yv[j] * yv[j];
                    ss += __shfl_xor(ss, 1); ss += __shfl_xor(ss, 2); ss += __shfl_xor(ss, 4); ss += __shfl_xor(ss, 8);
                    const float rs = rsqrtf(ss * (1.f / 256.f) + EPS);
                    float o[16];
#pragma unroll
                    for (int j = 0; j < 16; ++j) { const float gg = gv[j]; o[j] = yv[j] * rs * gg * __builtin_amdgcn_rcpf(1.f + ex2(-gg * LOG2E)); }
                    u32x4 w0, w1;
#pragma unroll
                    for (int j = 0; j < 4; ++j) { w0[j] = pk2(o[2 * j], o[2 * j + 1]); w1[j] = pk2(o[8 + 2 * j], o[8 + 2 * j + 1]); }
                    u32x4* op = (u32x4*)(XNw + (size_t)mrow * DM) + 2 * lane;
                    op[0] = w0; op[1] = w1;
                }
            } else {
                const float* base = (l == 0) ? P.x : P.out;
                const float* gpost = P.g_post + l * DM;
                for (int mrow0 = gw; mrow0 < M_TOK; mrow0 += 2 * NGW) {
                    f32x4 zz[2][4], xv[2][4]; float s1[2] = {0.f, 0.f}, s2[2] = {0.f, 0.f};
                    const bool two = (mrow0 + NGW < M_TOK);
#pragma unroll
                    for (int rr = 0; rr < 2; ++rr) { const int mrow = (rr == 0 || two) ? mrow0 + rr * NGW : mrow0;
#pragma unroll
                        for (int j = 0; j < 4; ++j) { const u32x2 w = ((const u32x2*)(Y + (size_t)mrow * DM))[lane + 64 * j]; zz[rr][j] = (f32x4){bflo(w.x), bfhi(w.x), bflo(w.y), bfhi(w.y)};
                            xv[rr][j] = ((const f32x4*)(base + (size_t)mrow * DM))[lane + 64 * j]; } }
                    f32x4 gpv[4];
#pragma unroll
                    for (int j = 0; j < 4; ++j) gpv[j] = ((const f32x4*)gpost)[lane + 64 * j];
#pragma unroll
                    for (int rr = 0; rr < 2; ++rr)
#pragma unroll
                        for (int j = 0; j < 4; ++j) s1[rr] += (zz[rr][j].x * zz[rr][j].x + zz[rr][j].y * zz[rr][j].y) + (zz[rr][j].z * zz[rr][j].z + zz[rr][j].w * zz[rr][j].w);
                    const float rz0 = rsqrtf(wave_sum(s1[0]) * (1.f / DM) + EPS), rz1 = rsqrtf(wave_sum(s1[1]) * (1.f / DM) + EPS);
#pragma unroll
                    for (int rr = 0; rr < 2; ++rr) { const float rz = rr ? rz1 : rz0;
#pragma unroll
                        for (int j = 0; j < 4; ++j) { xv[rr][j] = xv[rr][j] + zz[rr][j] * rz * gpv[j];
                            s2[rr] += (xv[rr][j].x * xv[rr][j].x + xv[rr][j].y * xv[rr][j].y) + (xv[rr][j].z * xv[rr][j].z + xv[rr][j].w * xv[rr][j].w); } }
#pragma unroll
                    for (int rr = 0; rr < 2; ++rr) { if (rr == 1 && !two) break; const int mrow = mrow0 + rr * NGW;
#pragma unroll
                        for (int j = 0; j < 4; ++j) ((f32x4*)(P.out + (size_t)mrow * DM))[lane + 64 * j] = xv[rr][j]; }
                    if (l + 1 < NLAYER) {
                        const float r0 = rsqrtf(wave_sum(s2[0]) * (1.f / DM) + EPS), r1 = rsqrtf(wave_sum(s2[1]) * (1.f / DM) + EPS);
#pragma unroll
                        for (int rr = 0; rr < 2; ++rr) { if (rr == 1 && !two) break; const int mrow = mrow0 + rr * NGW; const float rs = rr ? r1 : r0;
#pragma unroll
                            for (int j = 0; j < 4; ++j) { u32x2 o; o.x = pk2(xv[rr][j].x * rs, xv[rr][j].y * rs); o.y = pk2(xv[rr][j].z * rs, xv[rr][j].w * rs); ((u32x2*)(XN + (size_t)mrow * DM))[lane + 64 * j] = o; } }
                    }
                }
            }
            }
        }
        if (ph + 1 < P.ph_hi) {
#if MK_COOP
            if (ph == 0) grid.sync();
            else xcd_barrier(bar);
#endif
        }
    }
}
}

extern "C" void kernel_launch(void* const* d_in, const int* in_sizes, int n_in, void* d_out, int out_size, void* d_ws, size_t ws_size, hipStream_t stream) {
    using namespace mk;
    static int grid = 0;
    if (grid == 0) {
        if (n_in != 14 || out_size != M_TOK * DM || ws_size < WS_END) { fprintf(stderr, "kernel_launch: unexpected shapes (n_in %d out %d ws %zu)\n", n_in, out_size, ws_size); grid = -1; return; }
        int dev = 0, cus = 0, per_cu = 0;
        (void)hipGetDevice(&dev); (void)hipDeviceGetAttribute(&cus, hipDeviceAttributeMultiprocessorCount, dev);
        if (hipFuncSetAttribute((const void*)fwd, hipFuncAttributeMaxDynamicSharedMemorySize, LDS_BYTES) != hipSuccess) { fprintf(stderr, "kernel_launch: hipFuncSetAttribute failed\n"); grid = -1; return; }
        if (hipOccupancyMaxActiveBlocksPerMultiprocessor(&per_cu, (const void*)fwd, NTHREADS, LDS_BYTES) != hipSuccess || per_cu < 1) { fprintf(stderr, "kernel_launch: occupancy query says %d\n", per_cu); per_cu = 1; }
        (void)hipGetLastError();
        grid = cus * 1;
        if (grid > 256) grid = 256;
    }
    if (grid < 0) return;
    (void)hipMemsetAsync((char*)d_ws + WS_CTL, 0, CTL_BYTES, stream);
    Params p{};
    p.x = (const float*)d_in[0]; p.pos = (const int*)d_in[1]; p.norm_pre = (const float*)d_in[2]; p.w_in = (const float*)d_in[3]; p.sinks = (const float*)d_in[4];
    p.conv_w = (const float*)d_in[5]; p.conv_b = (const float*)d_in[6]; p.g_cq = (const float*)d_in[7]; p.w_uq = (const float*)d_in[8]; p.g_ckv = (const float*)d_in[9];
    p.w_ukv = (const float*)d_in[10]; p.g_grp = (const float*)d_in[11]; p.w_out = (const float*)d_in[12]; p.g_post = (const float*)d_in[13];
    p.out = (float*)d_out; p.ws = (unsigned char*)d_ws;
    constexpr int NPH = 1 + 6 * NLAYER;
#if MK_COOP
    p.ph_lo = 0; p.ph_hi = NPH;
    void* args[] = {&p};
    hipError_t e = hipLaunchCooperativeKernel((const void*)fwd, dim3(grid), dim3(NTHREADS), args, LDS_BYTES, stream);
    if (e != hipSuccess) fprintf(stderr, "kernel_launch: cooperative launch failed: %s (grid %d)\n", hipGetErrorString(e), grid);
#else
    for (int ph = 0; ph < NPH; ++ph) { p.ph_lo = ph; p.ph_hi = ph + 1; hipLaunchKernelGGL(fwd, dim3(grid), dim3(NTHREADS), LDS_BYTES, stream, p); }
#endif
}
```

```cpp
#include <hip/hip_runtime.h>
#include <hip/hip_cooperative_groups.h>
#include <cstdio>
#include <cstdint>
#include <cmath>
namespace pg8 {
#define PG8_LAS __attribute__((address_space(3)))
typedef unsigned short bf16_t;
typedef short bf16x8 __attribute__((ext_vector_type(8)));
typedef float f32x4 __attribute__((ext_vector_type(4)));
typedef unsigned u32x4 __attribute__((ext_vector_type(4)));
constexpr int BM = 256, BK = 64, HALF = 128, HTB = HALF * BK * 2  , STAGE_BYTES = 8 * HTB, NXCD = 8, WGM = 8;

__host__ __device__ __forceinline__ int lds_byte(int r, int c) { const int st = (r >> 4) * 2 + (c >> 5), rr = r & 15, cc = c & 31, ob = rr * 64 + cc * 2; return st * 1024 + (ob ^ (((ob >> 9) & 1) << 5)); }
__host__ __device__ __forceinline__ void stage_rc(int b, int& R, int& C) { const int st = b / 1024, sb = b % 1024, swz = sb ^ (((sb >> 9) & 1) << 5); R = (st >> 1) * 16 + swz / 64; C = (st & 1) * 32 + (swz % 64) / 2; }
__host__ __device__ __forceinline__ int perm32(int rho) { const int n = rho >> 4, i = rho & 15; return 8 * (i >> 2) + 4 * n + (i & 3); }

struct Unit { int pm, pn; };
struct Gemm { const bf16_t* A; const bf16_t* Bt; int M, N, K; };

struct StaticOrder {
    int nM, nN, nwg, G, c;
    __host__ __device__ void init(int M, int N, int G_, int c_) { nM = M / BM; nN = N / BM; nwg = nM * nN; G = G_; c = c_; }
    __host__ __device__ bool next(int i, Unit& u) const {
        const long L = (long)i * G + c; if (L >= nwg) return false;
        int wgid = (int)L; { const int q = nwg / NXCD, r = nwg % NXCD, xcd = wgid % NXCD, off = wgid / NXCD; wgid = (xcd < r ? xcd * (q + 1) : r * (q + 1) + (xcd - r) * q) + off; }
        const int nig = WGM * nN, gid = wgid / nig, fm = gid * WGM, gsz = (nM - fm) < WGM ? (nM - fm) : WGM;
        u.pm = fm + ((wgid % nig) % gsz); u.pn = (wgid % nig) / gsz; return true;
    }
    __device__ __forceinline__ void a_ready(const Unit&) const {}
    __device__ __forceinline__ void done(const Unit&) const {}
};

__device__ __forceinline__ unsigned cvt_pk_bf16(float lo, float hi) { unsigned r; asm volatile("v_cvt_pk_bf16_f32 %0, %1, %2" : "=v"(r) : "v"(lo), "v"(hi)); return r; }
typedef float f32x2 __attribute__((ext_vector_type(2)));
__device__ __forceinline__ f32x2 gelu_pk(f32x2 v) {
    const f32x2 av = __builtin_elementwise_abs(v), d = av * 0.2316418882f + 1.0f;
    f32x2 t; t.x = __builtin_amdgcn_rcpf(d.x); t.y = __builtin_amdgcn_rcpf(d.y);
    f32x2 q = t * 0.5307027145f + (-0.7265760135f); q = q * t + 0.7107068705f; q = q * t + (-0.142248368f); q = q * t + 0.127414796f; q = q * t;
    const f32x2 s = (v * v) * (-0.72134752044f);
    f32x2 e; e.x = __builtin_amdgcn_exp2f(s.x); e.y = __builtin_amdgcn_exp2f(s.y);
    const f32x2 m = v * (q * e), r = v - m;
    f32x2 o; o.x = v.x < 0.f ? m.x : r.x; o.y = v.y < 0.f ? m.y : r.y; return o;
}

template <int ACT  > struct EpiBf16 {
    static constexpr bool PERM = true, AFTER_DRAIN = false; static_assert(ACT == 0 || ACT == 1, "EpiBf16: ACT is 0 (none) or 1 (gelu_pk)");
    bf16_t* O; int ldc; const float* bias; int split_cols; size_t split_stride; float scale0;
    __device__ __forceinline__ void operator()(const f32x4 (&acc)[2][2][4][2], const Unit& u, int wr, int wc, int fr, int fq) const {
        const int row0 = u.pm * BM + wr * 64 + fr; int colt = u.pn * BM; bf16_t* base = O;
        float sc = 1.f; if (split_cols) { const int t = colt / split_cols; base += (size_t)t * split_stride; colt -= t * split_cols; if (t == 0) sc = scale0; }
        const int col0 = colt + wc * 32 + 8 * fq, bcol0 = u.pn * BM + wc * 32 + 8 * fq;
        f32x4 bv[2][2];
#pragma unroll
        for (int bj = 0; bj < 2; ++bj)
#pragma unroll
            for (int n = 0; n < 2; ++n) bv[bj][n] = bias ? *(const f32x4*)(bias + bcol0 + bj * HALF + 4 * n) : (f32x4){0.f, 0.f, 0.f, 0.f};
#pragma unroll
        for (int ai = 0; ai < 2; ++ai)
#pragma unroll
            for (int m = 0; m < 4; ++m) { bf16_t* rowp = base + (size_t)(row0 + ai * HALF + m * 16) * ldc + col0;
#pragma unroll
                for (int bj = 0; bj < 2; ++bj) { f32x4 v0 = acc[ai][bj][m][0] + bv[bj][0], v1 = acc[ai][bj][m][1] + bv[bj][1];
                    if (ACT == 1) { f32x2 a = gelu_pk((f32x2){v0[0], v0[1]}), b = gelu_pk((f32x2){v0[2], v0[3]}), c = gelu_pk((f32x2){v1[0], v1[1]}), d = gelu_pk((f32x2){v1[2], v1[3]});
                        v0 = (f32x4){a.x, a.y, b.x, b.y}; v1 = (f32x4){c.x, c.y, d.x, d.y}; }
                    v0 = v0 * sc; v1 = v1 * sc; u32x4 w; w.x = cvt_pk_bf16(v0[0], v0[1]); w.y = cvt_pk_bf16(v0[2], v0[3]); w.z = cvt_pk_bf16(v1[0], v1[1]); w.w = cvt_pk_bf16(v1[2], v1[3]);
                    *(u32x4*)(rowp + bj * HALF) = w; } }
    }
};
template <class Epi, class Sched, bool ALIGN_EPI = false, bool SP2 = false>
__device__ __forceinline__ void gemm_phase(PG8_LAS unsigned char* lds, const Gemm g, const Sched& S, const Epi& E) {
    int tid_o = threadIdx.x; asm volatile("" : "+v"(tid_o));
    const int tid = tid_o, wid = __builtin_amdgcn_readfirstlane(tid >> 6), lane = tid & 63, wr = wid >> 2, wc = wid & 3, fr = lane & 15, fq = lane >> 4;
    const int K = g.K, nt = K / BK;
    unsigned voffA[2], voffB[2];
#pragma unroll
    for (int i = 0; i < 2; ++i) { int R, C; stage_rc(tid * 16 + i * 8192, R, C); const int Rb = Epi::PERM ? ((R & ~31) + perm32(R & 31)) : R;
        voffA[i] = (unsigned)(R * K + C) * 2u; voffB[i] = (unsigned)(Rb * K + C) * 2u; }
    const size_t kstep = (size_t)(BK * 2);
    const size_t hstep = (size_t)HALF * K * 2;
    const size_t tstep = 2 * hstep;
    const unsigned ldsw = (unsigned)wid * 1024u;
    const int aoff = lds_byte(wr * 64 + fr, fq * 8), boff = lds_byte(wc * 32 + fr, fq * 8);
#define PG8_SA(b, h) (((b) * 2 + (h)) * HTB)
#define PG8_SB(b, h) ((4 + (b) * 2 + (h)) * HTB)
#define PG8_STAGE(bufoff, gbase, voff) do { _Pragma("unroll") for (int _i = 0; _i < 2; ++_i) \
        __builtin_amdgcn_global_load_lds((const unsigned*)((const char*)(gbase) + (voff)[_i]), (PG8_LAS unsigned*)(lds + (bufoff) + ldsw + _i * 8192), 16, 0, 0); } while (0)
#define PG8_LDA(dst, b, h) do { _Pragma("unroll") for (int m = 0; m < 4; ++m) _Pragma("unroll") for (int k = 0; k < 2; ++k) dst[m][k] = *(const PG8_LAS bf16x8*)(lds + PG8_SA(b, h) + aoff + m * 2048 + k * 1024); } while (0)
#define PG8_LDB(dst, b, h) do { _Pragma("unroll") for (int n = 0; n < 2; ++n) _Pragma("unroll") for (int k = 0; k < 2; ++k) dst[n][k] = *(const PG8_LAS bf16x8*)(lds + PG8_SB(b, h) + boff + n * 2048 + k * 1024); } while (0)
#define PG8_MMA(ai, bj, At, Bt) do { __builtin_amdgcn_s_setprio(1); _Pragma("unroll") for (int m = 0; m < 4; ++m) _Pragma("unroll") for (int n = 0; n < 2; ++n) _Pragma("unroll") for (int k = 0; k < 2; ++k) \
        acc[ai][bj][m][n] = __builtin_amdgcn_mfma_f32_16x16x32_bf16(Bt[n][k], At[m][k], acc[ai][bj][m][n], 0, 0, 0); __builtin_amdgcn_s_setprio(0); } while (0)
#define PG8_WAIT_V(n) asm volatile("s_waitcnt vmcnt(" #n ")" ::: "memory")
#define PG8_WAIT_L(n) asm volatile("s_waitcnt lgkmcnt(" #n ")" ::: "memory")
#define PG8_BAR __builtin_amdgcn_s_barrier()
#define PG8_SCHED __builtin_amdgcn_sched_barrier(0)
    Unit cur, nxt; int ui = 0;
    if (!S.next(0, cur)) return;
    f32x4 acc[2][2][4][2];
#pragma unroll
    for (int a = 0; a < 2; ++a)
#pragma unroll
        for (int b = 0; b < 2; ++b)
#pragma unroll
            for (int m = 0; m < 4; ++m)
#pragma unroll
                for (int n = 0; n < 2; ++n) acc[a][b][m][n] = (f32x4){0.f, 0.f, 0.f, 0.f};
    bf16x8 At[4][2], B0[2][2], B1[2][2];
    const char* cA = (const char*)g.A + (size_t)cur.pm * tstep; const char* cB = (const char*)g.Bt + (size_t)cur.pn * tstep;
    S.a_ready(cur);
    if constexpr (SP2) {
        PG8_STAGE(PG8_SB(0, 0), cB, voffB); PG8_STAGE(PG8_SB(0, 1), cB + hstep, voffB); PG8_STAGE(PG8_SA(0, 0), cA, voffA); PG8_STAGE(PG8_SA(0, 1), cA + hstep, voffA);
        if (wr == 1) PG8_BAR;
        PG8_WAIT_V(2); PG8_BAR;
        PG8_STAGE(PG8_SB(1, 0), cB + kstep, voffB); PG8_STAGE(PG8_SA(1, 0), cA + kstep, voffA); PG8_STAGE(PG8_SB(1, 1), cB + hstep + kstep, voffB);
        PG8_WAIT_V(6); PG8_BAR;
    } else {
        PG8_STAGE(PG8_SB(0, 0), cB, voffB); PG8_STAGE(PG8_SA(0, 0), cA, voffA); PG8_STAGE(PG8_SB(0, 1), cB + hstep, voffB); PG8_STAGE(PG8_SA(0, 1), cA + hstep, voffA);
        if (wr == 1) PG8_BAR;
        PG8_WAIT_V(4); PG8_BAR;
        PG8_STAGE(PG8_SB(1, 0), cB + kstep, voffB); PG8_STAGE(PG8_SA(1, 0), cA + kstep, voffA); PG8_STAGE(PG8_SB(1, 1), cB + hstep + kstep, voffB);
        PG8_WAIT_V(6); PG8_BAR;
    }
    for (;;) {
        const bool has_next = S.next(ui + 1, nxt);
        const char* nA = has_next ? (const char*)g.A + (size_t)nxt.pm * tstep : cA; const char* nB = has_next ? (const char*)g.Bt + (size_t)nxt.pn * tstep : cB;
        for (int t = 0; t < nt; t += 2) {
            const bool last = (t == nt - 2);
            const char* a1 = cA + (size_t)(t + 1) * kstep;
            const char* a2 = last ? nA : cA + (size_t)(t + 2) * kstep; const char* b2 = last ? nB : cB + (size_t)(t + 2) * kstep;
            const char* a3 = a2 + kstep; const char* b3 = b2 + kstep;
            if (last && has_next) S.a_ready(nxt);
            if constexpr (SP2) {
            PG8_LDB(B0, 0, 0); PG8_LDB(B1, 0, 1); PG8_SCHED; PG8_LDA(At, 0, 0); PG8_STAGE(PG8_SA(1, 1), a1 + hstep, voffA);
            PG8_WAIT_V(8); PG8_WAIT_L(0); PG8_BAR; PG8_MMA(0, 0, At, B0); PG8_MMA(0, 1, At, B1); PG8_BAR; PG8_SCHED;
            PG8_LDA(At, 0, 1); PG8_STAGE(PG8_SB(0, 0), b2, voffB); PG8_STAGE(PG8_SB(0, 1), b2 + hstep, voffB); PG8_STAGE(PG8_SA(0, 0), a2, voffA);
            PG8_WAIT_V(8); PG8_WAIT_L(0); PG8_BAR; PG8_MMA(1, 0, At, B0); PG8_MMA(1, 1, At, B1); PG8_BAR; PG8_SCHED;
            PG8_LDB(B0, 1, 0); PG8_LDB(B1, 1, 1); PG8_SCHED; PG8_LDA(At, 1, 0); PG8_STAGE(PG8_SA(0, 1), a2 + hstep, voffA);
            PG8_WAIT_V(8); PG8_WAIT_L(0); PG8_BAR; PG8_MMA(0, 0, At, B0); PG8_MMA(0, 1, At, B1); PG8_BAR; PG8_SCHED;
            PG8_LDA(At, 1, 1); PG8_STAGE(PG8_SB(1, 0), b3, voffB); PG8_STAGE(PG8_SB(1, 1), b3 + hstep, voffB); PG8_STAGE(PG8_SA(1, 0), a3, voffA);
            PG8_WAIT_V(8); PG8_WAIT_L(0); PG8_BAR; PG8_MMA(1, 0, At, B0); PG8_MMA(1, 1, At, B1); PG8_BAR; PG8_SCHED;
            } else {
            PG8_LDB(B0, 0, 0); PG8_SCHED; PG8_LDA(At, 0, 0); PG8_STAGE(PG8_SA(1, 1), a1 + hstep, voffA);
            PG8_WAIT_L(8); PG8_BAR; PG8_WAIT_L(0); PG8_MMA(0, 0, At, B0); PG8_BAR; PG8_SCHED;
            PG8_LDB(B1, 0, 1); PG8_STAGE(PG8_SB(0, 0), b2, voffB);
            PG8_BAR; PG8_WAIT_L(0); PG8_MMA(0, 1, At, B1); PG8_BAR;
            PG8_LDA(At, 0, 1); PG8_STAGE(PG8_SA(0, 0), a2, voffA);
            PG8_BAR; PG8_WAIT_L(0); PG8_MMA(1, 0, At, B0); PG8_BAR; PG8_SCHED;
            PG8_STAGE(PG8_SB(0, 1), b2 + hstep, voffB);
            PG8_WAIT_V(6); PG8_BAR; PG8_MMA(1, 1, At, B1); PG8_BAR;
            PG8_LDB(B0, 1, 0); PG8_SCHED; PG8_LDA(At, 1, 0); PG8_STAGE(PG8_SA(0, 1), a2 + hstep, voffA);
            PG8_WAIT_L(8); PG8_BAR; PG8_WAIT_L(0); PG8_MMA(0, 0, At, B0); PG8_BAR; PG8_SCHED;
            PG8_LDB(B1, 1, 1); PG8_STAGE(PG8_SB(1, 0), b3, voffB);
            PG8_BAR; PG8_WAIT_L(0); PG8_MMA(0, 1, At, B1); PG8_BAR;
            PG8_LDA(At, 1, 1); PG8_STAGE(PG8_SA(1, 0), a3, voffA);
            PG8_BAR; PG8_WAIT_L(0); PG8_MMA(1, 0, At, B0); PG8_BAR; PG8_SCHED;
            PG8_STAGE(PG8_SB(1, 1), b3 + hstep, voffB);
            PG8_WAIT_V(6); PG8_BAR; PG8_MMA(1, 1, At, B1); PG8_BAR;
            }
        }
        if constexpr (ALIGN_EPI) { if (wr == 0) PG8_BAR; }
        if constexpr (!Epi::AFTER_DRAIN) { E(acc, cur, wr, wc, fr, fq); S.done(cur); }
        if (!has_next) break;
#pragma unroll
        for (int a = 0; a < 2; ++a)
#pragma unroll
            for (int b = 0; b < 2; ++b)
#pragma unroll
                for (int m = 0; m < 4; ++m)
#pragma unroll
                    for (int n = 0; n < 2; ++n) acc[a][b][m][n] = (f32x4){0.f, 0.f, 0.f, 0.f};
        cur = nxt; cA = nA; cB = nB; ++ui;
        if constexpr (ALIGN_EPI) { if (wr == 1) PG8_BAR; }
    }
    PG8_WAIT_V(0);
    if constexpr (!ALIGN_EPI) { if (wr == 0) PG8_BAR; }
    PG8_BAR;
    if constexpr (Epi::AFTER_DRAIN) { E.fused(acc, cur, wr, wc, fr, fq, lds, wid, lane); S.done(cur); }
#undef PG8_SA
#undef PG8_SB
#undef PG8_STAGE
#undef PG8_LDA
#undef PG8_LDB
#undef PG8_MMA
#undef PG8_WAIT_V
#undef PG8_WAIT_L
#undef PG8_BAR
#undef PG8_SCHED
}
}
#ifndef MK_COOP
#define MK_COOP 1
#endif
#ifndef MK_REP_K
#define MK_REP_K -1
#endif
#ifndef MK_REP_N
#define MK_REP_N 1
#endif
namespace mk {
using pg8::bf16_t; using pg8::bf16x8; using pg8::f32x4; using pg8::u32x4;
typedef float f32x16 __attribute__((ext_vector_type(16)));
typedef unsigned u32x2 __attribute__((ext_vector_type(2)));
typedef float f32x2_t __attribute__((ext_vector_type(2)));
typedef __bf16 bf16x2_t __attribute__((ext_vector_type(2)));
#define LAS __attribute__((address_space(3)))
#define MFMA32(a, b, c) __builtin_amdgcn_mfma_f32_32x32x16_bf16((a), (b), (c), 0, 0, 0)

constexpr int M_TOK = 16384, SEQ = 8192, DM = 1024, DIN = 3488, DINP = 3584, NLAYER = 2;
constexpr int C_AQ = 0, C_AK = 256, C_AV = 384, C_BB = 512, C_BC = 768, C_BX = 1024, C_CQ = 1280, C_CKV = 1536, C_CKR = 1664,
              C_DQ = 1696, C_DK = 1952, C_DV = 2208, C_GATE = 2464;
constexpr float EPS = 1e-6f, LOG2E = 1.4426950408889634f;
constexpr float SC64 = 0.125f * LOG2E;
constexpr float QSC_MLA = 0.10206207261596575f * LOG2E;
constexpr int NWAVES = 8, NTHREADS = 512;
constexpr int LDS_BYTES = 132096 + 1024;

constexpr size_t MiB = 1u << 20;
constexpr size_t WS_CTL = 0, CTL_BYTES = 65536;
constexpr int CW_BAR = 1024;
constexpr size_t WS_WIN = 1 * MiB;
constexpr size_t WS_WOUT = 15 * MiB;
constexpr size_t WS_WUQ = 19 * MiB;
constexpr size_t WS_WUKV = 19 * MiB + 512 * 1024;
constexpr size_t WS_XN = 32 * MiB;
constexpr size_t WS_H = 64 * MiB;
constexpr size_t WS_QC = 176 * MiB;
constexpr size_t WS_KC = 188 * MiB;
constexpr size_t WS_VTC = 200 * MiB;
constexpr size_t WS_VTA = 208 * MiB;
constexpr size_t WS_VTD = 212 * MiB;
constexpr size_t WS_Y = 220 * MiB;
constexpr size_t WS_END = 252 * MiB;

struct Params {
    const float* x; const int* pos; const float* norm_pre; const float* w_in; const float* sinks; const float* conv_w; const float* conv_b;
    const float* g_cq; const float* w_uq; const float* g_ckv; const float* w_ukv; const float* g_grp; const float* w_out; const float* g_post;
    float* out; unsigned char* ws; int ph_lo, ph_hi;
};

__device__ __forceinline__ unsigned pk2(float lo, float hi) { f32x2_t v = {lo, hi}; bf16x2_t b = __builtin_convertvector(v, bf16x2_t); return __builtin_bit_cast(unsigned, b); }
__device__ __forceinline__ float bf2f(short s) { return __uint_as_float(((unsigned)(unsigned short)s) << 16); }
__device__ __forceinline__ float bflo(unsigned u) { return __uint_as_float(u << 16); }
__device__ __forceinline__ float bfhi(unsigned u) { return __uint_as_float(u & 0xffff0000u); }
__device__ __forceinline__ bf16_t f2bf(float f) { return (bf16_t)(pk2(f, 0.f) & 0xffffu); }
__device__ __forceinline__ int crow(int i, int h) { return (i & 3) + 8 * (i >> 2) + 4 * h; }
__device__ __forceinline__ float ex2(float x) { return __builtin_amdgcn_exp2f(x); }
__device__ __forceinline__ float lg2(float x) { return __builtin_amdgcn_logf(x); }
__device__ __forceinline__ float wave_sum(float v) {
#pragma unroll
    for (int o = 1; o < 64; o <<= 1) v += __shfl_xor(v, o);
    return v;
}
__device__ __forceinline__ bf16x8 pack8(const float* e) {
    u32x4 w; w.x = pk2(e[0], e[1]); w.y = pk2(e[2], e[3]); w.z = pk2(e[4], e[5]); w.w = pk2(e[6], e[7]);
    return __builtin_bit_cast(bf16x8, w);
}

__device__ __forceinline__ void conv_wT(const float* __restrict__ W, int K, int N, int NP, const float* __restrict__ gain, bf16_t* __restrict__ dst,
                                        int a0, int a1, int b0, int b1, float sc, int gtid, int gthreads) {
    const int k8n = K / 8; const int items = NP * k8n;
#pragma unroll 2
    for (int it = gtid; it < items; it += gthreads) {
        const int n = it % NP, k8 = it / NP;
        u32x4 o = {0u, 0u, 0u, 0u};
        if (n < N) {
            const float cs = ((n >= a0 && n < a1) || (n >= b0 && n < b1)) ? sc : 1.f;
            float v[8];
#pragma unroll
            for (int j = 0; j < 8; ++j) v[j] = W[(size_t)(k8 * 8 + j) * N + n] * gain[k8 * 8 + j] * cs;
            o.x = pk2(v[0], v[1]); o.y = pk2(v[2], v[3]); o.z = pk2(v[4], v[5]); o.w = pk2(v[6], v[7]);
        }
        *(u32x4*)(dst + (size_t)n * K + k8 * 8) = o;
    }
}
__device__ __forceinline__ void rms_row_to_bf16(const float* __restrict__ xrow, bf16_t* __restrict__ orow, int lane) {
    f32x4 v[4]; float s = 0.f;
#pragma unroll
    for (int j = 0; j < 4; ++j) { v[j] = ((const f32x4*)xrow)[lane + 64 * j]; s += (v[j].x * v[j].x + v[j].y * v[j].y) + (v[j].z * v[j].z + v[j].w * v[j].w); }
    const float rs = rsqrtf(wave_sum(s) * (1.f / DM) + EPS);
#pragma unroll
    for (int j = 0; j < 4; ++j) { u32x2 o; o.x = pk2(v[j].x * rs, v[j].y * rs); o.y = pk2(v[j].z * rs, v[j].w * rs); ((u32x2*)orow)[lane + 64 * j] = o; }
}

__device__ __forceinline__ void rope_cs(int pos, int h, float (&cs)[8], float (&sn)[8]) {
#pragma unroll
    for (int i = 0; i < 8; ++i) {
        const int f = (i & 3) + 8 * (i >> 2) + 4 * h;
        const float freq = ex2(-(float)f * 0.830482023721841f);
        const float ang = (float)pos * freq;
        const double rev = (double)ang * 0.15915494309189535;
        const float fr = (float)(rev - __builtin_rint(rev));
        cs[i] = __builtin_amdgcn_cosf(fr); sn[i] = __builtin_amdgcn_sinf(fr);
    }
}
__device__ __forceinline__ void rope_apply(f32x16& a, const float (&cs)[8], const float (&sn)[8]) {
#pragma unroll
    for (int i = 0; i < 8; ++i) { const float x1 = a[i], x2 = a[i + 8]; a[i] = x1 * cs[i] - x2 * sn[i]; a[i + 8] = x1 * sn[i] + x2 * cs[i]; }
}
__device__ __forceinline__ void store_tile_rowmajor(bf16_t* dst  , const f32x16& a, int h) {
#pragma unroll
    for (int g = 0; g < 4; ++g) { u32x2 o; o.x = pk2(a[4 * g], a[4 * g + 1]); o.y = pk2(a[4 * g + 2], a[4 * g + 3]); *(u32x2*)(dst + 8 * g + 4 * h) = o; }
}
__device__ __forceinline__ void mq_unit(const bf16_t* __restrict__ H, const bf16_t* __restrict__ WT, const int* __restrict__ pos, bf16_t* __restrict__ QC, int tb, int hh, int lane) {
    const int r = lane & 31, h = lane >> 5, tok = tb * 32 + r;
    const bf16_t* src = H + (size_t)tok * DINP + C_CQ + 8 * h;
    bf16x8 bfr[16]; float ss = 0.f;
#pragma unroll
    for (int s = 0; s < 16; ++s) { bfr[s] = *(const bf16x8*)(src + 16 * s);
#pragma unroll
        for (int j = 0; j < 8; ++j) { const float v = bf2f(bfr[s][j]); ss += v * v; } }
    ss += __shfl_xor(ss, 32);
    const float rs = rsqrtf(ss * (1.f / 256.f) + EPS) * QSC_MLA;
    float cs[8], sn[8]; rope_cs(pos[tok], h, cs, sn);
    const bf16_t* W = WT + (size_t)(hh * 96 + r) * 256 + 8 * h;
#pragma unroll 1
    for (int nt = 0; nt < 3; ++nt) {
        f32x16 acc;
#pragma unroll
        for (int i = 0; i < 16; ++i) acc[i] = 0.f;
#pragma unroll
        for (int s = 0; s < 16; ++s) { const bf16x8 a = *(const bf16x8*)(W + (size_t)nt * 32 * 256 + 16 * s); acc = MFMA32(a, bfr[s], acc); }
#pragma unroll
        for (int i = 0; i < 16; ++i) acc[i] *= rs;
        if (nt == 2) rope_apply(acc, cs, sn);
        store_tile_rowmajor(QC + (size_t)tok * 384 + hh * 96 + nt * 32, acc, h);
    }
}
__device__ __forceinline__ void vt_flush(LAS bf16_t* stg, bf16_t* __restrict__ dst  , int lane) {
    const LAS u32x4* rp = (const LAS u32x4*)(stg + lane * 32);
    u32x4 w[4];
#pragma unroll
    for (int c = 0; c < 4; ++c) w[c] = rp[c];
    u32x4* gp = (u32x4*)(dst + (size_t)lane * SEQ);
#pragma unroll
    for (int c = 0; c < 4; ++c) gp[c] = w[c];
}
__device__ __forceinline__ void mkv_unit(const bf16_t* __restrict__ H, const bf16_t* __restrict__ WT, const int* __restrict__ pos, bf16_t* __restrict__ KC, bf16_t* __restrict__ VTC, int tb, int hh, int lane, LAS bf16_t* stg) {
    const int r = lane & 31, h = lane >> 5, tok = tb * 32 + r;
    const bf16_t* src = H + (size_t)tok * DINP + C_CKV + 8 * h;
    bf16x8 bfr[8]; float ss = 0.f;
#pragma unroll
    for (int s = 0; s < 8; ++s) { bfr[s] = *(const bf16x8*)(src + 16 * s);
#pragma unroll
        for (int j = 0; j < 8; ++j) { const float v = bf2f(bfr[s][j]); ss += v * v; } }
    ss += __shfl_xor(ss, 32);
    const float rs = rsqrtf(ss * (1.f / 128.f) + EPS);
    const bf16_t* W = WT + (size_t)(hh * 128 + r) * 128 + 8 * h;
    const int b = (tb * 32) / SEQ, t0 = (tb * 32) % SEQ;
#pragma unroll 1
    for (int nt = 0; nt < 4; ++nt) {
        f32x16 acc;
#pragma unroll
        for (int i = 0; i < 16; ++i) acc[i] = 0.f;
#pragma unroll
        for (int s = 0; s < 8; ++s) { const bf16x8 a = *(const bf16x8*)(W + (size_t)nt * 32 * 128 + 16 * s); acc = MFMA32(a, bfr[s], acc); }
#pragma unroll
        for (int i = 0; i < 16; ++i) acc[i] *= rs;
        if (nt < 2) store_tile_rowmajor(KC + (size_t)tok * 384 + hh * 96 + nt * 32, acc, h);
        else {
            LAS bf16_t* sp = stg + ((nt - 2) * 32 + 4 * h) * 32 + r;
#pragma unroll
            for (int i = 0; i < 16; ++i) sp[((i & 3) + 8 * (i >> 2)) * 32] = f2bf(acc[i]);
        }
    }
    vt_flush(stg, VTC + ((size_t)((b * 4 + hh) * 64)) * SEQ + t0, lane);
    f32x16 kr;
    const bf16_t* krp = H + (size_t)tok * DINP + C_CKR + 4 * h;
#pragma unroll
    for (int g = 0; g < 4; ++g) { const u32x2 w = *(const u32x2*)(krp + 8 * g); kr[4 * g] = bflo(w.x); kr[4 * g + 1] = bfhi(w.x); kr[4 * g + 2] = bflo(w.y); kr[4 * g + 3] = bfhi(w.y); }
    float cs[8], sn[8]; rope_cs(pos[tok], h, cs, sn);
    rope_apply(kr, cs, sn);
    store_tile_rowmajor(KC + (size_t)tok * 384 + hh * 96 + 64, kr, h);
}
__device__ __forceinline__ void vt_unit(const bf16_t* __restrict__ H, int col0, int NH, bf16_t* __restrict__ VT, int tb, int head, int lane, LAS bf16_t* stg) {
    const int r = lane & 31, h = lane >> 5, tok = tb * 32 + r, b = (tb * 32) / SEQ, t0 = (tb * 32) % SEQ;
    const bf16_t* src = H + (size_t)tok * DINP + col0 + head * 64 + 32 * h;
    bf16x8 v[4];
#pragma unroll
    for (int c = 0; c < 4; ++c) v[c] = *(const bf16x8*)(src + 8 * c);
    LAS bf16_t* sp = stg + (32 * h) * 32 + r;
#pragma unroll
    for (int c = 0; c < 4; ++c)
#pragma unroll
        for (int j = 0; j < 8; ++j) sp[(8 * c + j) * 32] = (bf16_t)v[c][j];
    vt_flush(stg, VT + ((size_t)((b * NH + head) * 64)) * SEQ + t0, lane);
}
__device__ __forceinline__ void conv_unit(const bf16_t* __restrict__ H, const float* __restrict__ cw, const float* __restrict__ cb, bf16_t* __restrict__ Y, int tb8, int lane) {
    const int tok0 = tb8 * 8, t0 = tok0 % SEQ, ch = 4 * lane;
    const f32x4 w0 = *(const f32x4*)(cw + ch), w1 = *(const f32x4*)(cw + 256 + ch), w2 = *(const f32x4*)(cw + 512 + ch), bs = *(const f32x4*)(cb + ch);
    u32x2 cc[10], xx[10], bb[8];
    const int back = (t0 >= 2) ? 2 : 0;
#pragma unroll
    for (int i = 0; i < 10; ++i) { const int ti = (i < 2) ? (i - back) : (i - 2); const bf16_t* p = H + (size_t)(tok0 + ti) * DINP + ch;
        cc[i] = *(const u32x2*)(p + C_BC); xx[i] = *(const u32x2*)(p + C_BX); if (i >= 2) bb[i - 2] = *(const u32x2*)(p + C_BB); }
    f32x4 u[10];
#pragma unroll
    for (int i = 0; i < 10; ++i) u[i] = (f32x4){bflo(cc[i].x) * bflo(xx[i].x), bfhi(cc[i].x) * bfhi(xx[i].x), bflo(cc[i].y) * bflo(xx[i].y), bfhi(cc[i].y) * bfhi(xx[i].y)};
    if (back == 0) { u[0] = (f32x4){0.f, 0.f, 0.f, 0.f}; u[1] = (f32x4){0.f, 0.f, 0.f, 0.f}; }
#pragma unroll
    for (int i = 0; i < 8; ++i) {
        const f32x4 bg = {bflo(bb[i].x), bfhi(bb[i].x), bflo(bb[i].y), bfhi(bb[i].y)};
        const f32x4 y = bg * (w0 * u[i] + w1 * u[i + 1] + w2 * u[i + 2] + bs);
        u32x2 o; o.x = pk2(y.x, y.y); o.y = pk2(y.z, y.w);
        *(u32x2*)(Y + (size_t)(tok0 + i) * DM + 256 + ch) = o;
    }
}

__device__ __forceinline__ void o_flush(LAS bf16_t* stg, bf16_t* __restrict__ Orow0, int opitch, int lane) {
    u32x4 w[4];
#pragma unroll
    for (int j = 0; j < 4; ++j) w[j] = *(const LAS u32x4*)(stg + (lane + 64 * j) * 8);
#pragma unroll
    for (int j = 0; j < 4; ++j) { const int c = lane + 64 * j; *(u32x4*)(Orow0 + (size_t)(c >> 3) * opitch + (c & 7) * 8) = w[j]; }
}
template <int DKS, bool SINK>
__device__ __forceinline__ void softmax_unit(const bf16_t* __restrict__ Qrow0, int qpitch, const bf16_t* __restrict__ Kb, int kpitch, const bf16_t* __restrict__ VT,
                                             int qb, int kt_begin, int window, float sink2, bf16_t* __restrict__ Orow0, int opitch, int lane, LAS bf16_t* stg) {
    const int r = lane & 31, h = lane >> 5;
    const int pr = (r & ~12) | ((r & 8) >> 1) | ((r & 4) << 1);
    bf16x8 qf[DKS];
#pragma unroll
    for (int s = 0; s < DKS; ++s) qf[s] = *(const bf16x8*)(Qrow0 + (size_t)r * qpitch + 16 * s + 8 * h);
    f32x16 o0, o1;
#pragma unroll
    for (int i = 0; i < 16; ++i) { o0[i] = 0.f; o1[i] = 0.f; }
    float m = -1e30f, l = 0.f;
    const int kt_end = qb + 1, q = 32 * qb + r;
    const bf16_t* kp = Kb + (size_t)(32 * kt_begin + pr) * kpitch + 8 * h;
    const bf16_t* vp = VT + (size_t)r * SEQ + 32 * kt_begin + 8 * h;
    bf16x8 kf[DKS];
#pragma unroll
    for (int s = 0; s < DKS; ++s) kf[s] = *(const bf16x8*)(kp + 16 * s);
    for (int kt = kt_begin; kt < kt_end; ++kt) {
        bf16x8 kn[DKS];
        if (kt + 1 < kt_end) {
#pragma unroll
            for (int s = 0; s < DKS; ++s) kn[s] = *(const bf16x8*)(kp + (size_t)32 * kpitch + 16 * s);
        } else {
#pragma unroll
            for (int s = 0; s < DKS; ++s) kn[s] = kf[s];
        }
        const bf16x8 v00 = *(const bf16x8*)(vp), v01 = *(const bf16x8*)(vp + 32 * SEQ), v10 = *(const bf16x8*)(vp + 16), v11 = *(const bf16x8*)(vp + 32 * SEQ + 16);
        f32x16 p;
#pragma unroll
        for (int i = 0; i < 16; ++i) p[i] = 0.f;
#pragma unroll
        for (int s = 0; s < DKS; ++s) p = MFMA32(kf[s], qf[s], p);
        if (kt == qb || (window != 0 && kt == qb - (window >> 5))) {
            const int k0 = 32 * kt + 8 * h;
#pragma unroll
            for (int i = 0; i < 16; ++i) { const int kv = k0 + 16 * (i >> 3) + (i & 7); const bool ok = (kv <= q) && (window == 0 || kv > q - window); if (!ok) p[i] = -INFINITY; }
        }
        float rm = p[0];
#pragma unroll
        for (int i = 1; i < 16; ++i) rm = fmaxf(rm, p[i]);
        rm = fmaxf(rm, __shfl_xor(rm, 32));
        if (__any(rm > m + 6.f)) {
            const float mn = fmaxf(m, rm), f = ex2(m - mn); m = mn; l *= f;
#pragma unroll
            for (int i = 0; i < 16; ++i) { const float fi = __shfl(f, crow(i, h)); o0[i] *= fi; o1[i] *= fi; }
        }
        float e[16];
#pragma unroll
        for (int i = 0; i < 16; ++i) { e[i] = ex2(p[i] - m); l += e[i]; }
        const bf16x8 pa0 = pack8(e), pa1 = pack8(e + 8);
        o0 = MFMA32(pa0, v00, o0); o1 = MFMA32(pa0, v01, o1);
        o0 = MFMA32(pa1, v10, o0); o1 = MFMA32(pa1, v11, o1);
#pragma unroll
        for (int s = 0; s < DKS; ++s) kf[s] = kn[s];
        kp += (size_t)32 * kpitch; vp += 32;
    }
    l += __shfl_xor(l, 32);
    if (SINK) l += ex2(sink2 - m);
    const float inv = 1.f / l;
    LAS bf16_t* sp = stg + (4 * h) * 64 + r;
#pragma unroll
    for (int i = 0; i < 16; ++i) { const float fi = __shfl(inv, crow(i, h)); const int ro = ((i & 3) + 8 * (i >> 2)) * 64;
        sp[ro] = f2bf(o0[i] * fi); sp[ro + 32] = f2bf(o1[i] * fi); }
    o_flush(stg, Orow0, opitch, lane);
}


constexpr int KP = 208, VP = 272;
constexpr int KT_BYTES = 128 * KP, VT_BYTES = 64 * VP, TB_BYTES = KT_BYTES + VT_BYTES, MRG_OFF = 2 * TB_BYTES;
static_assert(MRG_OFF + 4 * 34 * 64 * 4 <= 131072, "MLA LDS map");
__device__ __forceinline__ void mla_unit_blk(const bf16_t* __restrict__ QC, const bf16_t* __restrict__ KC, const bf16_t* __restrict__ VTC, bf16_t* __restrict__ Y,
                                             int bh, int g, LAS unsigned char* lds, int tid) {
    const int lane = tid & 63, wave = __builtin_amdgcn_readfirstlane(tid >> 6), r = lane & 31, h = lane >> 5, w4 = wave & 3, kh = wave >> 2;
    const int pr = (r & ~12) | ((r & 8) >> 1) | ((r & 4) << 1);
    const int b = bh >> 2, hh = bh & 3, qb = 4 * g + w4, q = 32 * qb + r;
    const bf16_t* Qp = QC + ((size_t)b * SEQ + q) * 384 + hh * 96 + 8 * h;
    bf16x8 qf[6];
#pragma unroll
    for (int s = 0; s < 6; ++s) qf[s] = *(const bf16x8*)(Qp + 16 * s);
    const bf16_t* Kg = KC + (size_t)b * SEQ * 384 + hh * 96;
    const bf16_t* Vg = VTC + (size_t)(b * 4 + hh) * 64 * SEQ;
    int kgo[3], klo[3], vgo[2], vlo[2];
#pragma unroll
    for (int i = 0; i < 3; ++i) { const int c = tid + 512 * i, row = c / 12, cc = c - 12 * row; kgo[i] = row * 384 + 8 * cc; klo[i] = row * KP + 16 * cc; }
#pragma unroll
    for (int i = 0; i < 2; ++i) { const int c = tid + 512 * i, d = c >> 4, cc = c & 15; vgo[i] = d * SEQ + 8 * cc; vlo[i] = KT_BYTES + d * VP + 16 * cc; }
    u32x4 kr[3], vr[2];
#define MLA_LOAD(ST) do { _Pragma("unroll") for (int i = 0; i < 3; ++i) kr[i] = *(const u32x4*)(Kg + (size_t)(ST) * (128 * 384) + kgo[i]); \
                          _Pragma("unroll") for (int i = 0; i < 2; ++i) vr[i] = *(const u32x4*)(Vg + (ST) * 128 + vgo[i]); } while (0)
#define MLA_STORE(buf) do { LAS unsigned char* tb_ = lds + (buf) * TB_BYTES; _Pragma("unroll") for (int i = 0; i < 3; ++i) *(LAS u32x4*)(tb_ + klo[i]) = kr[i]; \
                            _Pragma("unroll") for (int i = 0; i < 2; ++i) *(LAS u32x4*)(tb_ + vlo[i]) = vr[i]; } while (0)
    f32x16 o0, o1;
#pragma unroll
    for (int i = 0; i < 16; ++i) { o0[i] = 0.f; o1[i] = 0.f; }
    float m = -1e30f, l = 0.f;
    const int nST = g + 1;
    MLA_LOAD(0); MLA_STORE(0);
    __syncthreads();
    const int kfo = (64 * kh + pr) * KP + 16 * h;
    const int vfo = KT_BYTES + r * VP + (64 * kh + 8 * h) * 2;
    for (int ST = 0; ST < nST; ++ST) {
        if (ST + 1 < nST) MLA_LOAD(ST + 1);
        const int kt0 = 4 * ST + 2 * kh;
        if (kt0 <= qb) {
            const LAS unsigned char* tb = lds + (ST & 1) * TB_BYTES;
            f32x16 p0, p1;
#pragma unroll
            for (int i = 0; i < 16; ++i) { p0[i] = 0.f; p1[i] = 0.f; }
#pragma unroll
            for (int s = 0; s < 6; ++s) { const bf16x8 k0 = *(const LAS bf16x8*)(tb + kfo + 32 * s), k1 = *(const LAS bf16x8*)(tb + kfo + 32 * KP + 32 * s);
                p0 = MFMA32(k0, qf[s], p0); p1 = MFMA32(k1, qf[s], p1); }
            if (kt0 + 1 >= qb) {
                const int kb0 = 32 * kt0 + 8 * h;
#pragma unroll
                for (int i = 0; i < 16; ++i) { const int kv = kb0 + 16 * (i >> 3) + (i & 7); if (kv > q) p0[i] = -INFINITY; if (kv + 32 > q) p1[i] = -INFINITY; }
            }
            float rm = fmaxf(p0[0], p1[0]);
#pragma unroll
            for (int i = 1; i < 16; ++i) rm = fmaxf(rm, fmaxf(p0[i], p1[i]));
            rm = fmaxf(rm, __shfl_xor(rm, 32));
            if (__any(rm > m + 6.f)) {
                const float mn = fmaxf(m, rm), f = ex2(m - mn); m = mn; l *= f;
#pragma unroll
                for (int i = 0; i < 16; ++i) { const float fi = __shfl(f, crow(i, h)); o0[i] *= fi; o1[i] *= fi; }
            }
            float ls = 0.f;
#pragma unroll
            for (int i = 0; i < 16; ++i) { p0[i] = ex2(p0[i] - m); p1[i] = ex2(p1[i] - m); ls += p0[i] + p1[i]; }
            l += ls;
            float e[8];
#pragma unroll
            for (int ks = 0; ks < 4; ++ks) {
#pragma unroll
                for (int j = 0; j < 8; ++j) e[j] = (ks < 2) ? p0[8 * ks + j] : p1[8 * (ks - 2) + j];
                const bf16x8 pa = pack8(e);
                const bf16x8 v0 = *(const LAS bf16x8*)(tb + vfo + 32 * ks), v1 = *(const LAS bf16x8*)(tb + vfo + 32 * VP + 32 * ks);
                o0 = MFMA32(pa, v0, o0); o1 = MFMA32(pa, v1, o1);
            }
        }
        if (ST + 1 < nST) MLA_STORE((ST + 1) & 1);
        __syncthreads();
    }
#undef MLA_LOAD
#undef MLA_STORE
    l += __shfl_xor(l, 32);
    LAS float* mg = (LAS float*)(lds + MRG_OFF) + w4 * (34 * 64) + lane;
    if (kh == 1) {
#pragma unroll
        for (int i = 0; i < 16; ++i) { mg[i * 64] = o0[i]; mg[(16 + i) * 64] = o1[i]; }
        mg[32 * 64] = m; mg[33 * 64] = l;
    }
    __syncthreads();
    if (kh == 0) {
        const float mb = mg[32 * 64], lb = mg[33 * 64];
        const float mn = fmaxf(m, mb), fa = ex2(m - mn), fb = ex2(mb - mn), inv = 1.f / (l * fa + lb * fb), ga = fa * inv, gb = fb * inv;
        LAS bf16_t* stg = (LAS bf16_t*)(lds + wave * 4096);
        LAS bf16_t* sp = stg + (4 * h) * 64 + r;
#pragma unroll
        for (int i = 0; i < 16; ++i) { const float ra = __shfl(ga, crow(i, h)), rb = __shfl(gb, crow(i, h)); const int ro = ((i & 3) + 8 * (i >> 2)) * 64;
            sp[ro] = f2bf(o0[i] * ra + mg[i * 64] * rb); sp[ro + 32] = f2bf(o1[i] * ra + mg[(16 + i) * 64] * rb); }
        o_flush(stg, Y + ((size_t)b * SEQ + 32 * qb) * DM + 512 + hh * 64, DM, lane);
    }
    __syncthreads();
}

__device__ __forceinline__ void sb_unit(const bf16_t* __restrict__ Qrow0, int qpitch, const bf16_t* __restrict__ Kb, int kpitch, const bf16_t* __restrict__ VT,
                                        int qb, bf16_t* __restrict__ Orow0, int opitch, int lane, LAS bf16_t* stg) {
    const int r = lane & 31, h = lane >> 5;
    const int pr = (r & ~12) | ((r & 8) >> 1) | ((r & 4) << 1);
    bf16x8 qf[4];
#pragma unroll
    for (int s = 0; s < 4; ++s) qf[s] = *(const bf16x8*)(Qrow0 + (size_t)r * qpitch + 16 * s + 8 * h);
    f32x16 o0, o1;
#pragma unroll
    for (int i = 0; i < 16; ++i) { o0[i] = 0.f; o1[i] = 0.f; }
    float carry = 0.f;
    const int q = 32 * qb + r;
    const bf16_t* kp = Kb + (size_t)(32 * qb + pr) * kpitch + 8 * h;
    const bf16_t* vp = VT + (size_t)r * SEQ + 32 * qb + 8 * h;
    bf16x8 kf[4];
#pragma unroll
    for (int s = 0; s < 4; ++s) kf[s] = *(const bf16x8*)(kp + 16 * s);
    for (int kt = qb; kt >= 0; --kt) {
        bf16x8 kn[4];
        if (kt > 0) {
#pragma unroll
            for (int s = 0; s < 4; ++s) kn[s] = *(const bf16x8*)(kp - (size_t)32 * kpitch + 16 * s);
        } else {
#pragma unroll
            for (int s = 0; s < 4; ++s) kn[s] = kf[s];
        }
        const bf16x8 v00 = *(const bf16x8*)(vp), v01 = *(const bf16x8*)(vp + 32 * SEQ), v10 = *(const bf16x8*)(vp + 16), v11 = *(const bf16x8*)(vp + 32 * SEQ + 16);
        f32x16 p;
#pragma unroll
        for (int i = 0; i < 16; ++i) p[i] = 0.f;
#pragma unroll
        for (int s = 0; s < 4; ++s) p = MFMA32(kf[s], qf[s], p);
        const bool diag = (kt == qb);
        const int k0 = 32 * kt + 8 * h;
        float sfx[16];
#pragma unroll
        for (int i = 0; i < 16; ++i) {
            const float z = p[i];
            float L = -(fmaxf(z, 0.f) + lg2(1.f + ex2(-fabsf(z))));
            if (diag) { const int kv = k0 + 16 * (i >> 3) + (i & 7); if (!(kv < q)) L = 0.f; }
            sfx[i] = L;
        }
#pragma unroll
        for (int g = 0; g < 2; ++g)
#pragma unroll
            for (int j = 6; j >= 0; --j) sfx[8 * g + j] += sfx[8 * g + j + 1];
        const float T0 = sfx[0], T1 = sfx[8];
        const float TP0 = __shfl_xor(T0, 32), TP1 = __shfl_xor(T1, 32);
        const float off1 = (h ? 0.f : TP1) + carry, off0 = T1 + TP1 + (h ? 0.f : TP0) + carry;
        float e[16];
#pragma unroll
        for (int i = 0; i < 16; ++i) {
            float a = ex2(p[i] + sfx[i] + (i < 8 ? off0 : off1));
            if (diag) { const int kv = k0 + 16 * (i >> 3) + (i & 7); if (!(kv < q)) a = 0.f; }
            e[i] = a;
        }
        carry += (T0 + T1) + (TP0 + TP1);
        const bf16x8 pa0 = pack8(e), pa1 = pack8(e + 8);
        o0 = MFMA32(pa0, v00, o0); o1 = MFMA32(pa0, v01, o1);
        o0 = MFMA32(pa1, v10, o0); o1 = MFMA32(pa1, v11, o1);
        if (__all(carry < -150.f)) break;
#pragma unroll
        for (int s = 0; s < 4; ++s) kf[s] = kn[s];
        kp -= (size_t)32 * kpitch; vp -= 32;
    }
    LAS bf16_t* sp = stg + (4 * h) * 64 + r;
#pragma unroll
    for (int i = 0; i < 16; ++i) { const int ro = ((i & 3) + 8 * (i >> 2)) * 64; sp[ro] = f2bf(o0[i]); sp[ro + 32] = f2bf(o1[i]); }
    o_flush(stg, Orow0, opitch, lane);
}

#define XB_TMO      128
#define XB_XCNT(j)  (256  + 64 * (j))
#define XB_XSUB(j)  (1280 + 64 * (j))
#define XB_XGEN(j)  (2304 + 64 * (j))
#define XB_TOP      3328
#define XB_TOPGEN   3392
#define XCD_BAR_WORDS 3456
#define XB_SPIN_CAP (1u << 18)

__device__ __forceinline__ unsigned xb_ld(unsigned* p)              { return __hip_atomic_load(p, __ATOMIC_RELAXED, __HIP_MEMORY_SCOPE_AGENT); }
__device__ __forceinline__ unsigned xb_add(unsigned* p, unsigned v) { return __hip_atomic_fetch_add(p, v, __ATOMIC_RELAXED, __HIP_MEMORY_SCOPE_AGENT); }
__device__ __forceinline__ unsigned xb_xcc_id() { return (unsigned)__builtin_amdgcn_s_getreg((3 << 11) | 20) & 0xFu; }
#define XB_SPIN(cond, bar) do { unsigned _sp = 0; while (cond) { __builtin_amdgcn_s_sleep(1); \
    if ((++_sp & 255u) == 0u) { if (xb_ld(&(bar)[XB_TMO])) break; if (_sp > XB_SPIN_CAP) { atomicAdd(&(bar)[XB_TMO], 1u); break; } } } } while (0)

struct XcdBarrier {
    unsigned* bar; unsigned x;
    volatile LAS unsigned* st;
};

__device__ __forceinline__ XcdBarrier xcd_barrier_post(unsigned* bar, volatile LAS unsigned* st) {
    XcdBarrier b; b.bar = bar; b.x = xb_xcc_id(); b.st = st;
    if (threadIdx.x == 0) (void)xb_add(&bar[XB_XCNT(b.x)], 1u);
    return b;
}
__device__ __forceinline__ void xcd_barrier_complete(unsigned* bar, unsigned x, unsigned& nloc, unsigned& nx) {
    const unsigned G = gridDim.x * gridDim.y * gridDim.z;
    unsigned sum, cnt, mine, sp = 0u;
    for (;;) {
        sum = 0u; cnt = 0u; mine = 0u;
#pragma unroll
        for (unsigned j = 0; j < 16; ++j) { const unsigned c = xb_ld(&bar[XB_XCNT(j)]); sum += c; cnt += (c > 0u) ? 1u : 0u; mine = (j == x) ? c : mine; }
        if (sum == G) break;
        __builtin_amdgcn_s_sleep(1);
        if ((++sp & 255u) == 0u) { if (xb_ld(&bar[XB_TMO])) break; if (sp > XB_SPIN_CAP) { atomicAdd(&bar[XB_TMO], 1u); break; } }
    }
    nloc = mine > 0u ? mine : 1u; nx = cnt > 0u ? cnt : 1u;
}

__device__ __forceinline__ void xcd_barrier(const XcdBarrier& b) {
    asm volatile("s_waitcnt vmcnt(0)" ::: "memory");
    __syncthreads();
    if (threadIdx.x == 0) {
        unsigned* bar = b.bar;
        __builtin_amdgcn_s_waitcnt(0);
        unsigned nloc = b.st[0], nx = b.st[1];
        if (nloc == 0u) { xcd_barrier_complete(bar, b.x, nloc, nx); b.st[0] = nloc; b.st[1] = nx; }
        const unsigned old = xb_add(&bar[XB_XSUB(b.x)], 1u);
        const unsigned gen = old / nloc;
        if (old + 1u == (gen + 1u) * nloc) {
            __builtin_amdgcn_fence(__ATOMIC_RELEASE, "agent");
            asm volatile("s_waitcnt vmcnt(0)" ::: "memory");
            const unsigned og = xb_add(&bar[XB_TOP], 1u);
            const unsigned tg = og / nx;
            if (og + 1u == (tg + 1u) * nx) xb_add(&bar[XB_TOPGEN], 1u);
            else XB_SPIN(xb_ld(&bar[XB_TOPGEN]) == tg, bar);
            __builtin_amdgcn_fence(__ATOMIC_ACQUIRE, "agent");
            xb_add(&bar[XB_XGEN(b.x)], 1u);
            asm volatile("s_waitcnt vmcnt(0)" ::: "memory");
        } else {
            XB_SPIN(xb_ld(&bar[XB_XGEN(b.x)]) == gen, bar);
            __builtin_amdgcn_fence(__ATOMIC_ACQUIRE, "agent");
            asm volatile("s_waitcnt vmcnt(0)" ::: "memory");
        }
    }
    __syncthreads();
}

__global__ void __launch_bounds__(NTHREADS, 2) fwd(Params P) {
    extern __shared__ __attribute__((aligned(16))) unsigned char lds_raw[];
    LAS unsigned char* lds = (LAS unsigned char*)lds_raw;
    constexpr int G = 256, NGW = G * NWAVES, gthreads = G * NTHREADS;
    const int bx = blockIdx.x;
#if MK_COOP
    cooperative_groups::grid_group grid = cooperative_groups::this_grid();
    volatile LAS unsigned* MISC = (volatile LAS unsigned*)(lds + 132096);
    if (threadIdx.x < 64) MISC[threadIdx.x] = 0u;
    __syncthreads();
    XcdBarrier bar = xcd_barrier_post((unsigned*)(P.ws + WS_CTL) + CW_BAR, MISC + 8);
#endif
    for (int ph = P.ph_lo; ph < P.ph_hi; ++ph) {
        const int nrep = ((ph >= 1 && ph <= 6 && ((ph - 1) == MK_REP_K || (MK_REP_K == 6 && ph == 3))) || (ph == 0 && MK_REP_K == 7)) ? MK_REP_N : 1;
        for (int rep = 0; rep < nrep; ++rep) {
        int tid_o = threadIdx.x; asm volatile("" : "+v"(tid_o));
        const int tid = tid_o, lane = tid & 63, wave = __builtin_amdgcn_readfirstlane(tid >> 6);
        const int gw = bx * NWAVES + wave, gtid = bx * NTHREADS + tid;
        LAS bf16_t* stg = (LAS bf16_t*)(lds + wave * 4096);
        unsigned char* ws = P.ws; asm volatile("" : "+s"(ws));
        unsigned* ctl = (unsigned*)(ws + WS_CTL);
        bf16_t* XN = (bf16_t*)(ws + WS_XN); bf16_t* H = (bf16_t*)(ws + WS_H);
        bf16_t* QC = (bf16_t*)(ws + WS_QC); bf16_t* KC = (bf16_t*)(ws + WS_KC);
        bf16_t* VTC = (bf16_t*)(ws + WS_VTC); bf16_t* VTA = (bf16_t*)(ws + WS_VTA); bf16_t* VTD = (bf16_t*)(ws + WS_VTD);
        bf16_t* Y = (bf16_t*)(ws + WS_Y);
        if (ph == 0) {
            for (int l = 0; l < NLAYER; ++l) {
                conv_wT(P.w_in + (size_t)l * DM * DIN, DM, DIN, DINP, P.norm_pre + l * DM, (bf16_t*)(ws + WS_WIN) + (size_t)l * DINP * DM, C_AQ, C_AQ + 256, C_DQ, C_DQ + 256, SC64, gtid, gthreads);
                conv_wT(P.w_out + (size_t)l * DM * DM, DM, DM, DM, P.g_grp + l * DM, (bf16_t*)(ws + WS_WOUT) + (size_t)l * DM * DM, 0, 0, 0, 0, 1.f, gtid, gthreads);
                conv_wT(P.w_uq + (size_t)l * 256 * 384, 256, 384, 384, P.g_cq + l * 256, (bf16_t*)(ws + WS_WUQ + (size_t)l * 262144), 0, 0, 0, 0, 1.f, gtid, gthreads);
                conv_wT(P.w_ukv + (size_t)l * 128 * 512, 128, 512, 512, P.g_ckv + l * 128, (bf16_t*)(ws + WS_WUKV + (size_t)l * 131072), 0, 0, 0, 0, 1.f, gtid, gthreads);
            }
            { const float* __restrict__ xr = P.x; bf16_t* __restrict__ xo = XN;
#pragma unroll 2
              for (int mrow = gw; mrow < M_TOK; mrow += NGW) rms_row_to_bf16(xr + (size_t)mrow * DM, xo + (size_t)mrow * DM, lane); }
        } else {
            const int l = (ph - 1) / 6, k = (ph - 1) % 6;
            if (k == 0 || k == 4) {
                if (k == 0) {
                    pg8::Gemm g{XN, (const bf16_t*)(ws + WS_WIN) + (size_t)l * DINP * DM, M_TOK, DINP, DM}; pg8::StaticOrder S; S.init(M_TOK, DINP, G, bx);
                    pg8::EpiBf16<0> E{H, DINP, nullptr, 0, 0, 1.f};
                    pg8::gemm_phase<pg8::EpiBf16<0>, pg8::StaticOrder, true, true>(lds, g, S, E);
                } else {
                    pg8::Gemm g{XN, (const bf16_t*)(ws + WS_WOUT) + (size_t)l * DM * DM, M_TOK, DM, DM}; pg8::StaticOrder S; S.init(M_TOK, DM, G, bx);
                    pg8::EpiBf16<0> E{Y, DM, nullptr, 0, 0, 1.f};
                    pg8::gemm_phase<pg8::EpiBf16<0>, pg8::StaticOrder, true, true>(lds, g, S, E);
                }
            } else if (k == 1) {
                const bf16_t* WUQ = (const bf16_t*)(ws + WS_WUQ + (size_t)l * 262144);
                const bf16_t* WUKV = (const bf16_t*)(ws + WS_WUKV + (size_t)l * 131072);
                constexpr int NTB = M_TOK / 32;
                constexpr int U_MQ = NTB * 4, U_MKV = NTB * 4, U_VTA = NTB * 2, U_VTD = NTB * 4, U_CONV = M_TOK / 8;
                constexpr int U_ALL = U_MQ + U_MKV + U_VTA + U_VTD + U_CONV;
                for (int u = gw; u < U_ALL; u += NGW) {
                    int v = u;
                    if (v < U_MQ) { mq_unit(H, WUQ, P.pos, QC, v >> 2, v & 3, lane); continue; } v -= U_MQ;
                    if (v < U_MKV) { mkv_unit(H, WUKV, P.pos, KC, VTC, v >> 2, v & 3, lane, stg); continue; } v -= U_MKV;
                    if (v < U_VTA) { vt_unit(H, C_AV, 2, VTA, v >> 1, v & 1, lane, stg); continue; } v -= U_VTA;
                    if (v < U_VTD) { vt_unit(H, C_DV, 4, VTD, v >> 2, v & 3, lane, stg); continue; } v -= U_VTD;
                    conv_unit(H, P.conv_w + l * 768, P.conv_b + l * 256, Y, v, lane);
                }
            } else if (k == 2) {
                if (rep == 0 || MK_REP_K == 2)
                for (int pu = bx; pu < 256; pu += G) {
                    const int bh = pu & 7, Gq = pu >> 3;
                    mla_unit_blk(QC, KC, VTC, Y, bh, 63 - Gq, lds, tid);
                    mla_unit_blk(QC, KC, VTC, Y, bh, Gq, lds, tid);
                }
                if (rep == 0 || MK_REP_K == 6)
                for (;;) {
                    unsigned u = 0;
                    if (lane == 0) u = atomicAdd(ctl + 64 * l + 128 * rep, 1u);
                    u = (unsigned)__builtin_amdgcn_readfirstlane((int)u);
                    if (u >= 4096u) break;
                    const int v = (int)(u & 2047u), bh = v >> 8, qb = v & 255, b = bh >> 2, hh = bh & 3;
                    const size_t row0 = (size_t)b * SEQ + 32 * qb;
                    if (u < 2048u) {
                        sb_unit(H + row0 * DINP + C_DQ + hh * 64, DINP, H + (size_t)b * SEQ * DINP + C_DK + hh * 64, DINP, VTD + (size_t)(b * 4 + hh) * 64 * SEQ,
                                qb, Y + row0 * DM + 768 + hh * 64, DM, lane, stg);
                    } else {
                        const int kvh = hh >> 1;
                        const int ktb = qb - 4 > 0 ? qb - 4 : 0;
                        softmax_unit<4, true>(H + row0 * DINP + C_AQ + hh * 64, DINP, H + (size_t)b * SEQ * DINP + C_AK + kvh * 64, DINP, VTA + (size_t)(b * 2 + kvh) * 64 * SEQ,
                                              qb, ktb, 128, P.sinks[l * 4 + hh] * LOG2E, Y + row0 * DM + hh * 64, DM, lane, stg);
                    }
                }
            } else if (k == 3) {
                const bf16_t* __restrict__ Yr = Y; const bf16_t* __restrict__ Hr = H; bf16_t* __restrict__ XNw = XN;
#pragma unroll 2
                for (int mrow = gw; mrow < M_TOK; mrow += NGW) {
                    const u32x4* yp = (const u32x4*)(Yr + (size_t)mrow * DM) + 2 * lane;
                    const u32x4* gp = (const u32x4*)(Hr + (size_t)mrow * DINP + C_GATE) + 2 * lane;
                    const u32x4 y0 = yp[0], y1 = yp[1], g0 = gp[0], g1 = gp[1];
                    float yv[16], gv[16];
#pragma unroll
                    for (int j = 0; j < 4; ++j) { yv[2 * j] = bflo(y0[j]); yv[2 * j + 1] = bfhi(y0[j]); yv[8 + 2 * j] = bflo(y1[j]); yv[8 + 2 * j + 1] = bfhi(y1[j]);
                                                  gv[2 * j] = bflo(g0[j]); gv[2 * j + 1] = bfhi(g0[j]); gv[8 + 2 * j] = bflo(g1[j]); gv[8 + 2 * j + 1] = bfhi(g1[j]); }
                    float ss = 0.f;
#pragma unroll
                    for (int j = 0; j < 16; ++j) ss += yv[j] * yv[j];
                    ss += __shfl_xor(ss, 1); ss += __shfl_xor(ss, 2); ss += __shfl_xor(ss, 4); ss += __shfl_xor(ss, 8);
                    const float rs = rsqrtf(ss * (1.f / 256.f) + EPS);
                    float o[16];
#pragma unroll
                    for (int j = 0; j < 16; ++j) { const float gg = gv[j]; o[j] = yv[j] * rs * gg * __builtin_amdgcn_rcpf(1.f + ex2(-gg * LOG2E)); }
                    u32x4 w0, w1;
#pragma unroll
                    for (int j = 0; j < 4; ++j) { w0[j] = pk2(o[2 * j], o[2 * j + 1]); w1[j] = pk2(o[8 + 2 * j], o[8 + 2 * j + 1]); }
                    u32x4* op = (u32x4*)(XNw + (size_t)mrow * DM) + 2 * lane;
                    op[0] = w0; op[1] = w1;
                }
            } else {
                const float* base = (l == 0) ? P.x : P.out;
                const float* gpost = P.g_post + l * DM;
                for (int mrow0 = gw; mrow0 < M_TOK; mrow0 += 2 * NGW) {
                    f32x4 zz[2][4], xv[2][4]; float s1[2] = {0.f, 0.f}, s2[2] = {0.f, 0.f};
                    const bool two = (mrow0 + NGW < M_TOK);
#pragma unroll
                    for (int rr = 0; rr < 2; ++rr) { const int mrow = (rr == 0 || two) ? mrow0 + rr * NGW : mrow0;
#pragma unroll
                        for (int j = 0; j < 4; ++j) { const u32x2 w = ((const u32x2*)(Y + (size_t)mrow * DM))[lane + 64 * j]; zz[rr][j] = (f32x4){bflo(w.x), bfhi(w.x), bflo(w.y), bfhi(w.y)};
                            xv[rr][j] = ((const f32x4*)(base + (size_t)mrow * DM))[lane + 64 * j]; } }
                    f32x4 gpv[4];
#pragma unroll
                    for (int j = 0; j < 4; ++j) gpv[j] = ((const f32x4*)gpost)[lane + 64 * j];
#pragma unroll
                    for (int rr = 0; rr < 2; ++rr)
#pragma unroll
                        for (int j = 0; j < 4; ++j) s1[rr] += (zz[rr][j].x * zz[rr][j].x + zz[rr][j].y * zz[rr][j].y) + (zz[rr][j].z * zz[rr][j].z + zz[rr][j].w * zz[rr][j].w);
                    const float rz0 = rsqrtf(wave_sum(s1[0]) * (1.f / DM) + EPS), rz1 = rsqrtf(wave_sum(s1[1]) * (1.f / DM) + EPS);
#pragma unroll
                    for (int rr = 0; rr < 2; ++rr) { const float rz = rr ? rz1 : rz0;
#pragma unroll
                        for (int j = 0; j < 4; ++j) { xv[rr][j] = xv[rr][j] + zz[rr][j] * rz * gpv[j];
                            s2[rr] += (xv[rr][j].x * xv[rr][j].x + xv[rr][j].y * xv[rr][j].y) + (xv[rr][j].z * xv[rr][j].z + xv[rr][j].w * xv[rr][j].w); } }
#pragma unroll
                    for (int rr = 0; rr < 2; ++rr) { if (rr == 1 && !two) break; const int mrow = mrow0 + rr * NGW;
#pragma unroll
                        for (int j = 0; j < 4; ++j) ((f32x4*)(P.out + (size_t)mrow * DM))[lane + 64 * j] = xv[rr][j]; }
                    if (l + 1 < NLAYER) {
                        const float r0 = rsqrtf(wave_sum(s2[0]) * (1.f / DM) + EPS), r1 = rsqrtf(wave_sum(s2[1]) * (1.f / DM) + EPS);
#pragma unroll
                        for (int rr = 0; rr < 2; ++rr) { if (rr == 1 && !two) break; const int mrow = mrow0 + rr * NGW; const float rs = rr ? r1 : r0;
#pragma unroll
                            for (int j = 0; j < 4; ++j) { u32x2 o; o.x = pk2(xv[rr][j].x * rs, xv[rr][j].y * rs); o.y = pk2(xv[rr][j].z * rs, xv[rr][j].w * rs); ((u32x2*)(XN + (size_t)mrow * DM))[lane + 64 * j] = o; } }
                    }
                }
            }
            }
        }
        if (ph + 1 < P.ph_hi) {
#if MK_COOP
            if (P.ph_hi < 0) grid.sync();
            xcd_barrier(bar);
#endif
        }
    }
}
}

extern "C" void kernel_launch(void* const* d_in, const int* in_sizes, int n_in, void* d_out, int out_size, void* d_ws, size_t ws_size, hipStream_t stream) {
    using namespace mk;
    static int grid = 0;
    if (grid == 0) {
        if (n_in != 14 || out_size != M_TOK * DM || ws_size < WS_END) { fprintf(stderr, "kernel_launch: unexpected shapes (n_in %d out %d ws %zu)\n", n_in, out_size, ws_size); grid = -1; return; }
        int dev = 0, cus = 0, per_cu = 0;
        (void)hipGetDevice(&dev); (void)hipDeviceGetAttribute(&cus, hipDeviceAttributeMultiprocessorCount, dev);
        if (hipFuncSetAttribute((const void*)fwd, hipFuncAttributeMaxDynamicSharedMemorySize, LDS_BYTES) != hipSuccess) { fprintf(stderr, "kernel_launch: hipFuncSetAttribute failed\n"); grid = -1; return; }
        if (hipOccupancyMaxActiveBlocksPerMultiprocessor(&per_cu, (const void*)fwd, NTHREADS, LDS_BYTES) != hipSuccess || per_cu < 1) { fprintf(stderr, "kernel_launch: occupancy query says %d\n", per_cu); per_cu = 1; }
        (void)hipGetLastError();
        if (cus < 256) { fprintf(stderr, "kernel_launch: built for a 256-CU device (one workgroup per CU), found %d CUs\n", cus); grid = -1; return; }
        grid = 256;
    }
    if (grid < 0) return;
    (void)hipMemsetAsync((char*)d_ws + WS_CTL, 0, CTL_BYTES, stream);
    Params p{};
    p.x = (const float*)d_in[0]; p.pos = (const int*)d_in[1]; p.norm_pre = (const float*)d_in[2]; p.w_in = (const float*)d_in[3]; p.sinks = (const float*)d_in[4];
    p.conv_w = (const float*)d_in[5]; p.conv_b = (const float*)d_in[6]; p.g_cq = (const float*)d_in[7]; p.w_uq = (const float*)d_in[8]; p.g_ckv = (const float*)d_in[9];
    p.w_ukv = (const float*)d_in[10]; p.g_grp = (const float*)d_in[11]; p.w_out = (const float*)d_in[12]; p.g_post = (const float*)d_in[13];
    p.out = (float*)d_out; p.ws = (unsigned char*)d_ws;
    constexpr int NPH = 1 + 6 * NLAYER;
#if MK_COOP
    p.ph_lo = 0; p.ph_hi = NPH;
    void* args[] = {&p};
    hipError_t e = hipLaunchCooperativeKernel((const void*)fwd, dim3(grid), dim3(NTHREADS), args, LDS_BYTES, stream);
    if (e != hipSuccess) fprintf(stderr, "kernel_launch: cooperative launch failed: %s (grid %d)\n", hipGetErrorString(e), grid);
#else
    for (int ph = 0; ph < NPH; ++ph) { p.ph_lo = ph; p.ph_hi = ph + 1; hipLaunchKernelGGL(fwd, dim3(grid), dim3(NTHREADS), LDS_BYTES, stream, p); }
#endif
}
```

```cpp
#include <hip/hip_runtime.h>
#include <hip/hip_cooperative_groups.h>
#include <cstdio>
#include <cstdint>
#include <cmath>
namespace pg8 {
#define PG8_LAS __attribute__((address_space(3)))
typedef unsigned short bf16_t;
typedef short bf16x8 __attribute__((ext_vector_type(8)));
typedef float f32x4 __attribute__((ext_vector_type(4)));
typedef unsigned u32x4 __attribute__((ext_vector_type(4)));
constexpr int BM = 256, BK = 64, HALF = 128, HTB = HALF * BK * 2  , STAGE_BYTES = 8 * HTB, NXCD = 8, WGM = 8;

__host__ __device__ __forceinline__ int lds_byte(int r, int c) { const int st = (r >> 4) * 2 + (c >> 5), rr = r & 15, cc = c & 31, ob = rr * 64 + cc * 2; return st * 1024 + (ob ^ (((ob >> 9) & 1) << 5)); }
__host__ __device__ __forceinline__ void stage_rc(int b, int& R, int& C) { const int st = b / 1024, sb = b % 1024, swz = sb ^ (((sb >> 9) & 1) << 5); R = (st >> 1) * 16 + swz / 64; C = (st & 1) * 32 + (swz % 64) / 2; }
__host__ __device__ __forceinline__ int perm32(int rho) { const int n = rho >> 4, i = rho & 15; return 8 * (i >> 2) + 4 * n + (i & 3); }

struct Unit { int pm, pn; };
struct Gemm { const bf16_t* A; const bf16_t* Bt; int M, N, K; };

struct StaticOrder {
    int nM, nN, nwg, G, c;
    __host__ __device__ void init(int M, int N, int G_, int c_) { nM = M / BM; nN = N / BM; nwg = nM * nN; G = G_; c = c_; }
    __host__ __device__ bool next(int i, Unit& u) const {
        const long L = (long)i * G + c; if (L >= nwg) return false;
        int wgid = (int)L; { const int q = nwg / NXCD, r = nwg % NXCD, xcd = wgid % NXCD, off = wgid / NXCD; wgid = (xcd < r ? xcd * (q + 1) : r * (q + 1) + (xcd - r) * q) + off; }
        const int nig = WGM * nN, gid = wgid / nig, fm = gid * WGM, gsz = (nM - fm) < WGM ? (nM - fm) : WGM;
        u.pm = fm + ((wgid % nig) % gsz); u.pn = (wgid % nig) / gsz; return true;
    }
    __device__ __forceinline__ void a_ready(const Unit&) const {}
    __device__ __forceinline__ void done(const Unit&) const {}
};

__device__ __forceinline__ unsigned cvt_pk_bf16(float lo, float hi) { unsigned r; asm volatile("v_cvt_pk_bf16_f32 %0, %1, %2" : "=v"(r) : "v"(lo), "v"(hi)); return r; }
typedef float f32x2 __attribute__((ext_vector_type(2)));
__device__ __forceinline__ f32x2 gelu_pk(f32x2 v) {
    const f32x2 av = __builtin_elementwise_abs(v), d = av * 0.2316418882f + 1.0f;
    f32x2 t; t.x = __builtin_amdgcn_rcpf(d.x); t.y = __builtin_amdgcn_rcpf(d.y);
    f32x2 q = t * 0.5307027145f + (-0.7265760135f); q = q * t + 0.7107068705f; q = q * t + (-0.142248368f); q = q * t + 0.127414796f; q = q * t;
    const f32x2 s = (v * v) * (-0.72134752044f);
    f32x2 e; e.x = __builtin_amdgcn_exp2f(s.x); e.y = __builtin_amdgcn_exp2f(s.y);
    const f32x2 m = v * (q * e), r = v - m;
    f32x2 o; o.x = v.x < 0.f ? m.x : r.x; o.y = v.y < 0.f ? m.y : r.y; return o;
}

template <int ACT  > struct EpiBf16 {
    static constexpr bool PERM = true, AFTER_DRAIN = false; static_assert(ACT == 0 || ACT == 1, "EpiBf16: ACT is 0 (none) or 1 (gelu_pk)");
    bf16_t* O; int ldc; const float* bias; int split_cols; size_t split_stride; float scale0;
    __device__ __forceinline__ void operator()(const f32x4 (&acc)[2][2][4][2], const Unit& u, int wr, int wc, int fr, int fq) const {
        const int row0 = u.pm * BM + wr * 64 + fr; int colt = u.pn * BM; bf16_t* base = O;
        float sc = 1.f; if (split_cols) { const int t = colt / split_cols; base += (size_t)t * split_stride; colt -= t * split_cols; if (t == 0) sc = scale0; }
        const int col0 = colt + wc * 32 + 8 * fq, bcol0 = u.pn * BM + wc * 32 + 8 * fq;
        f32x4 bv[2][2];
#pragma unroll
        for (int bj = 0; bj < 2; ++bj)
#pragma unroll
            for (int n = 0; n < 2; ++n) bv[bj][n] = bias ? *(const f32x4*)(bias + bcol0 + bj * HALF + 4 * n) : (f32x4){0.f, 0.f, 0.f, 0.f};
#pragma unroll
        for (int ai = 0; ai < 2; ++ai)
#pragma unroll
            for (int m = 0; m < 4; ++m) { bf16_t* rowp = base + (size_t)(row0 + ai * HALF + m * 16) * ldc + col0;
#pragma unroll
                for (int bj = 0; bj < 2; ++bj) { f32x4 v0 = acc[ai][bj][m][0] + bv[bj][0], v1 = acc[ai][bj][m][1] + bv[bj][1];
                    if (ACT == 1) { f32x2 a = gelu_pk((f32x2){v0[0], v0[1]}), b = gelu_pk((f32x2){v0[2], v0[3]}), c = gelu_pk((f32x2){v1[0], v1[1]}), d = gelu_pk((f32x2){v1[2], v1[3]});
                        v0 = (f32x4){a.x, a.y, b.x, b.y}; v1 = (f32x4){c.x, c.y, d.x, d.y}; }
                    v0 = v0 * sc; v1 = v1 * sc; u32x4 w; w.x = cvt_pk_bf16(v0[0], v0[1]); w.y = cvt_pk_bf16(v0[2], v0[3]); w.z = cvt_pk_bf16(v1[0], v1[1]); w.w = cvt_pk_bf16(v1[2], v1[3]);
                    *(u32x4*)(rowp + bj * HALF) = w; } }
    }
};
template <class Epi, class Sched, bool ALIGN_EPI = false, bool SP2 = false>
__device__ __forceinline__ void gemm_phase(PG8_LAS unsigned char* lds, const Gemm g, const Sched& S, const Epi& E) {
    int tid_o = threadIdx.x; asm volatile("" : "+v"(tid_o));
    const int tid = tid_o, wid = __builtin_amdgcn_readfirstlane(tid >> 6), lane = tid & 63, wr = wid >> 2, wc = wid & 3, fr = lane & 15, fq = lane >> 4;
    const int K = g.K, nt = K / BK;
    unsigned voffA[2], voffB[2];
#pragma unroll
    for (int i = 0; i < 2; ++i) { int R, C; stage_rc(tid * 16 + i * 8192, R, C); const int Rb = Epi::PERM ? ((R & ~31) + perm32(R & 31)) : R;
        voffA[i] = (unsigned)(R * K + C) * 2u; voffB[i] = (unsigned)(Rb * K + C) * 2u; }
    const size_t kstep = (size_t)(BK * 2);
    const size_t hstep = (size_t)HALF * K * 2;
    const size_t tstep = 2 * hstep;
    const unsigned ldsw = (unsigned)wid * 1024u;
    const int aoff = lds_byte(wr * 64 + fr, fq * 8), boff = lds_byte(wc * 32 + fr, fq * 8);
#define PG8_SA(b, h) (((b) * 2 + (h)) * HTB)
#define PG8_SB(b, h) ((4 + (b) * 2 + (h)) * HTB)
#define PG8_STAGE(bufoff, gbase, voff) do { _Pragma("unroll") for (int _i = 0; _i < 2; ++_i) \
        __builtin_amdgcn_global_load_lds((const unsigned*)((const char*)(gbase) + (voff)[_i]), (PG8_LAS unsigned*)(lds + (bufoff) + ldsw + _i * 8192), 16, 0, 0); } while (0)
#define PG8_LDA(dst, b, h) do { _Pragma("unroll") for (int m = 0; m < 4; ++m) _Pragma("unroll") for (int k = 0; k < 2; ++k) dst[m][k] = *(const PG8_LAS bf16x8*)(lds + PG8_SA(b, h) + aoff + m * 2048 + k * 1024); } while (0)
#define PG8_LDB(dst, b, h) do { _Pragma("unroll") for (int n = 0; n < 2; ++n) _Pragma("unroll") for (int k = 0; k < 2; ++k) dst[n][k] = *(const PG8_LAS bf16x8*)(lds + PG8_SB(b, h) + boff + n * 2048 + k * 1024); } while (0)
#define PG8_MMA(ai, bj, At, Bt) do { __builtin_amdgcn_s_setprio(1); _Pragma("unroll") for (int m = 0; m < 4; ++m) _Pragma("unroll") for (int n = 0; n < 2; ++n) _Pragma("unroll") for (int k = 0; k < 2; ++k) \
        acc[ai][bj][m][n] = __builtin_amdgcn_mfma_f32_16x16x32_bf16(Bt[n][k], At[m][k], acc[ai][bj][m][n], 0, 0, 0); __builtin_amdgcn_s_setprio(0); } while (0)
#define PG8_WAIT_V(n) asm volatile("s_waitcnt vmcnt(" #n ")" ::: "memory")
#define PG8_WAIT_L(n) asm volatile("s_waitcnt lgkmcnt(" #n ")" ::: "memory")
#define PG8_BAR __builtin_amdgcn_s_barrier()
#define PG8_SCHED __builtin_amdgcn_sched_barrier(0)
    Unit cur, nxt; int ui = 0;
    if (!S.next(0, cur)) return;
    f32x4 acc[2][2][4][2];
#pragma unroll
    for (int a = 0; a < 2; ++a)
#pragma unroll
        for (int b = 0; b < 2; ++b)
#pragma unroll
            for (int m = 0; m < 4; ++m)
#pragma unroll
                for (int n = 0; n < 2; ++n) acc[a][b][m][n] = (f32x4){0.f, 0.f, 0.f, 0.f};
    bf16x8 At[4][2], B0[2][2], B1[2][2];
    const char* cA = (const char*)g.A + (size_t)cur.pm * tstep; const char* cB = (const char*)g.Bt + (size_t)cur.pn * tstep;
    S.a_ready(cur);
    if constexpr (SP2) {
        PG8_STAGE(PG8_SB(0, 0), cB, voffB); PG8_STAGE(PG8_SB(0, 1), cB + hstep, voffB); PG8_STAGE(PG8_SA(0, 0), cA, voffA); PG8_STAGE(PG8_SA(0, 1), cA + hstep, voffA);
        if (wr == 1) PG8_BAR;
        PG8_WAIT_V(2); PG8_BAR;
        PG8_STAGE(PG8_SB(1, 0), cB + kstep, voffB); PG8_STAGE(PG8_SA(1, 0), cA + kstep, voffA); PG8_STAGE(PG8_SB(1, 1), cB + hstep + kstep, voffB);
        PG8_WAIT_V(6); PG8_BAR;
    } else {
        PG8_STAGE(PG8_SB(0, 0), cB, voffB); PG8_STAGE(PG8_SA(0, 0), cA, voffA); PG8_STAGE(PG8_SB(0, 1), cB + hstep, voffB); PG8_STAGE(PG8_SA(0, 1), cA + hstep, voffA);
        if (wr == 1) PG8_BAR;
        PG8_WAIT_V(4); PG8_BAR;
        PG8_STAGE(PG8_SB(1, 0), cB + kstep, voffB); PG8_STAGE(PG8_SA(1, 0), cA + kstep, voffA); PG8_STAGE(PG8_SB(1, 1), cB + hstep + kstep, voffB);
        PG8_WAIT_V(6); PG8_BAR;
    }
    for (;;) {
        const bool has_next = S.next(ui + 1, nxt);
        const char* nA = has_next ? (const char*)g.A + (size_t)nxt.pm * tstep : cA; const char* nB = has_next ? (const char*)g.Bt + (size_t)nxt.pn * tstep : cB;
        for (int t = 0; t < nt; t += 2) {
            const bool last = (t == nt - 2);
            const char* a1 = cA + (size_t)(t + 1) * kstep;
            const char* a2 = last ? nA : cA + (size_t)(t + 2) * kstep; const char* b2 = last ? nB : cB + (size_t)(t + 2) * kstep;
            const char* a3 = a2 + kstep; const char* b3 = b2 + kstep;
            if (last && has_next) S.a_ready(nxt);
            if constexpr (SP2) {
            PG8_LDB(B0, 0, 0); PG8_LDB(B1, 0, 1); PG8_SCHED; PG8_LDA(At, 0, 0); PG8_STAGE(PG8_SA(1, 1), a1 + hstep, voffA);
            PG8_WAIT_V(8); PG8_WAIT_L(0); PG8_BAR; PG8_MMA(0, 0, At, B0); PG8_MMA(0, 1, At, B1); PG8_BAR; PG8_SCHED;
            PG8_LDA(At, 0, 1); PG8_STAGE(PG8_SB(0, 0), b2, voffB); PG8_STAGE(PG8_SB(0, 1), b2 + hstep, voffB); PG8_STAGE(PG8_SA(0, 0), a2, voffA);
            PG8_WAIT_V(8); PG8_WAIT_L(0); PG8_BAR; PG8_MMA(1, 0, At, B0); PG8_MMA(1, 1, At, B1); PG8_BAR; PG8_SCHED;
            PG8_LDB(B0, 1, 0); PG8_LDB(B1, 1, 1); PG8_SCHED; PG8_LDA(At, 1, 0); PG8_STAGE(PG8_SA(0, 1), a2 + hstep, voffA);
            PG8_WAIT_V(8); PG8_WAIT_L(0); PG8_BAR; PG8_MMA(0, 0, At, B0); PG8_MMA(0, 1, At, B1); PG8_BAR; PG8_SCHED;
            PG8_LDA(At, 1, 1); PG8_STAGE(PG8_SB(1, 0), b3, voffB); PG8_STAGE(PG8_SB(1, 1), b3 + hstep, voffB); PG8_STAGE(PG8_SA(1, 0), a3, voffA);
            PG8_WAIT_V(8); PG8_WAIT_L(0); PG8_BAR; PG8_MMA(1, 0, At, B0); PG8_MMA(1, 1, At, B1); PG8_BAR; PG8_SCHED;
            } else {
            PG8_LDB(B0, 0, 0); PG8_SCHED; PG8_LDA(At, 0, 0); PG8_STAGE(PG8_SA(1, 1), a1 + hstep, voffA);
            PG8_WAIT_L(8); PG8_BAR; PG8_WAIT_L(0); PG8_MMA(0, 0, At, B0); PG8_BAR; PG8_SCHED;
            PG8_LDB(B1, 0, 1); PG8_STAGE(PG8_SB(0, 0), b2, voffB);
            PG8_BAR; PG8_WAIT_L(0); PG8_MMA(0, 1, At, B1); PG8_BAR;
            PG8_LDA(At, 0, 1); PG8_STAGE(PG8_SA(0, 0), a2, voffA);
            PG8_BAR; PG8_WAIT_L(0); PG8_MMA(1, 0, At, B0); PG8_BAR; PG8_SCHED;
            PG8_STAGE(PG8_SB(0, 1), b2 + hstep, voffB);
            PG8_WAIT_V(6); PG8_BAR; PG8_MMA(1, 1, At, B1); PG8_BAR;
            PG8_LDB(B0, 1, 0); PG8_SCHED; PG8_LDA(At, 1, 0); PG8_STAGE(PG8_SA(0, 1), a2 + hstep, voffA);
            PG8_WAIT_L(8); PG8_BAR; PG8_WAIT_L(0); PG8_MMA(0, 0, At, B0); PG8_BAR; PG8_SCHED;
            PG8_LDB(B1, 1, 1); PG8_STAGE(PG8_SB(1, 0), b3, voffB);
            PG8_BAR; PG8_WAIT_L(0); PG8_MMA(0, 1, At, B1); PG8_BAR;
            PG8_LDA(At, 1, 1); PG8_STAGE(PG8_SA(1, 0), a3, voffA);
            PG8_BAR; PG8_WAIT_L(0); PG8_MMA(1, 0, At, B0); PG8_BAR; PG8_SCHED;
            PG8_STAGE(PG8_SB(1, 1), b3 + hstep, voffB);
            PG8_WAIT_V(6); PG8_BAR; PG8_MMA(1, 1, At, B1); PG8_BAR;
            }
        }
        if constexpr (ALIGN_EPI) { if (wr == 0) PG8_BAR; }
        if constexpr (!Epi::AFTER_DRAIN) { E(acc, cur, wr, wc, fr, fq); S.done(cur); }
        if (!has_next) break;
#pragma unroll
        for (int a = 0; a < 2; ++a)
#pragma unroll
            for (int b = 0; b < 2; ++b)
#pragma unroll
                for (int m = 0; m < 4; ++m)
#pragma unroll
                    for (int n = 0; n < 2; ++n) acc[a][b][m][n] = (f32x4){0.f, 0.f, 0.f, 0.f};
        cur = nxt; cA = nA; cB = nB; ++ui;
        if constexpr (ALIGN_EPI) { if (wr == 1) PG8_BAR; }
    }
    PG8_WAIT_V(0);
    if constexpr (!ALIGN_EPI) { if (wr == 0) PG8_BAR; }
    PG8_BAR;
    if constexpr (Epi::AFTER_DRAIN) { E.fused(acc, cur, wr, wc, fr, fq, lds, wid, lane); S.done(cur); }
#undef PG8_SA
#undef PG8_SB
#undef PG8_STAGE
#undef PG8_LDA
#undef PG8_LDB
#undef PG8_MMA
#undef PG8_WAIT_V
#undef PG8_WAIT_L
#undef PG8_BAR
#undef PG8_SCHED
}
}
#ifndef MK_COOP
#define MK_COOP 1
#endif
#ifndef MK_REP_K
#define MK_REP_K -1
#endif
#ifndef MK_REP_N
#define MK_REP_N 1
#endif
namespace mk {
using pg8::bf16_t; using pg8::bf16x8; using pg8::f32x4; using pg8::u32x4;
typedef float f32x16 __attribute__((ext_vector_type(16)));
typedef unsigned u32x2 __attribute__((ext_vector_type(2)));
typedef float f32x2_t __attribute__((ext_vector_type(2)));
typedef __bf16 bf16x2_t __attribute__((ext_vector_type(2)));
#define LAS __attribute__((address_space(3)))
#define MFMA32(a, b, c) __builtin_amdgcn_mfma_f32_32x32x16_bf16((a), (b), (c), 0, 0, 0)

constexpr int M_TOK = 16384, SEQ = 8192, DM = 1024, DIN = 3488, DINP = 3584, NLAYER = 2;
constexpr int C_AQ = 0, C_AK = 256, C_AV = 384, C_BB = 512, C_BC = 768, C_BX = 1024, C_CQ = 1280, C_CKV = 1536, C_CKR = 1664,
              C_DQ = 1696, C_DK = 1952, C_DV = 2208, C_GATE = 2464;
constexpr float EPS = 1e-6f, LOG2E = 1.4426950408889634f;
constexpr float SC64 = 0.125f * LOG2E;
constexpr float QSC_MLA = 0.10206207261596575f * LOG2E;
constexpr int NWAVES = 8, NTHREADS = 512;
constexpr int LDS_BYTES = 122880 + 8 * 4096 + 1024;

constexpr size_t MiB = 1u << 20;
constexpr size_t WS_CTL = 0, CTL_BYTES = 65536;
constexpr int CW_BAR = 1024;
constexpr size_t WS_WIN = 1 * MiB;
constexpr size_t WS_WOUT = 15 * MiB;
constexpr size_t WS_WUQ = 19 * MiB;
constexpr size_t WS_WUKV = 19 * MiB + 512 * 1024;
constexpr size_t WS_XN = 32 * MiB;
constexpr size_t WS_H = 64 * MiB;
constexpr size_t WS_QC = 176 * MiB;
constexpr size_t WS_KC = 188 * MiB;
constexpr size_t WS_VTC = 200 * MiB;
constexpr size_t WS_VTA = 208 * MiB;
constexpr size_t WS_VTD = 212 * MiB;
constexpr size_t WS_Y = 220 * MiB;
constexpr size_t WS_END = 252 * MiB;

struct Params {
    const float* x; const int* pos; const float* norm_pre; const float* w_in; const float* sinks; const float* conv_w; const float* conv_b;
    const float* g_cq; const float* w_uq; const float* g_ckv; const float* w_ukv; const float* g_grp; const float* w_out; const float* g_post;
    float* out; unsigned char* ws; int ph_lo, ph_hi;
};

__device__ __forceinline__ unsigned pk2(float lo, float hi) { f32x2_t v = {lo, hi}; bf16x2_t b = __builtin_convertvector(v, bf16x2_t); return __builtin_bit_cast(unsigned, b); }
__device__ __forceinline__ float bf2f(short s) { return __uint_as_float(((unsigned)(unsigned short)s) << 16); }
__device__ __forceinline__ float bflo(unsigned u) { return __uint_as_float(u << 16); }
__device__ __forceinline__ float bfhi(unsigned u) { return __uint_as_float(u & 0xffff0000u); }
__device__ __forceinline__ bf16_t f2bf(float f) { return (bf16_t)(pk2(f, 0.f) & 0xffffu); }
__device__ __forceinline__ int crow(int i, int h) { return (i & 3) + 8 * (i >> 2) + 4 * h; }
__device__ __forceinline__ float ex2(float x) { return __builtin_amdgcn_exp2f(x); }
__device__ __forceinline__ float lg2(float x) { return __builtin_amdgcn_logf(x); }
__device__ __forceinline__ float wave_sum(float v) {
#pragma unroll
    for (int o = 1; o < 64; o <<= 1) v += __shfl_xor(v, o);
    return v;
}
__device__ __forceinline__ bf16x8 pack8(const float* e) {
    u32x4 w; w.x = pk2(e[0], e[1]); w.y = pk2(e[2], e[3]); w.z = pk2(e[4], e[5]); w.w = pk2(e[6], e[7]);
    return __builtin_bit_cast(bf16x8, w);
}

__device__ __forceinline__ void conv_wT(const float* __restrict__ W, int K, int N, int NP, const float* __restrict__ gain, bf16_t* __restrict__ dst,
                                        int a0, int a1, int b0, int b1, float sc, int gtid, int gthreads) {
    const int k8n = K / 8; const int items = NP * k8n;
#pragma unroll 2
    for (int it = gtid; it < items; it += gthreads) {
        const int n = it % NP, k8 = it / NP;
        u32x4 o = {0u, 0u, 0u, 0u};
        if (n < N) {
            const float cs = ((n >= a0 && n < a1) || (n >= b0 && n < b1)) ? sc : 1.f;
            float v[8];
#pragma unroll
            for (int j = 0; j < 8; ++j) v[j] = W[(size_t)(k8 * 8 + j) * N + n] * gain[k8 * 8 + j] * cs;
            o.x = pk2(v[0], v[1]); o.y = pk2(v[2], v[3]); o.z = pk2(v[4], v[5]); o.w = pk2(v[6], v[7]);
        }
        *(u32x4*)(dst + (size_t)n * K + k8 * 8) = o;
    }
}
__device__ __forceinline__ void rms_row_to_bf16(const float* __restrict__ xrow, bf16_t* __restrict__ orow, int lane) {
    f32x4 v[4]; float s = 0.f;
#pragma unroll
    for (int j = 0; j < 4; ++j) { v[j] = ((const f32x4*)xrow)[lane + 64 * j]; s += (v[j].x * v[j].x + v[j].y * v[j].y) + (v[j].z * v[j].z + v[j].w * v[j].w); }
    const float rs = rsqrtf(wave_sum(s) * (1.f / DM) + EPS);
#pragma unroll
    for (int j = 0; j < 4; ++j) { u32x2 o; o.x = pk2(v[j].x * rs, v[j].y * rs); o.y = pk2(v[j].z * rs, v[j].w * rs); ((u32x2*)orow)[lane + 64 * j] = o; }
}

__device__ __forceinline__ void rope_cs(int pos, int h, float (&cs)[8], float (&sn)[8]) {
#pragma unroll
    for (int i = 0; i < 8; ++i) {
        const int f = (i & 3) + 8 * (i >> 2) + 4 * h;
        const float freq = ex2(-(float)f * 0.830482023721841f);
        const float ang = (float)pos * freq;
        const double rev = (double)ang * 0.15915494309189535;
        const float fr = (float)(rev - __builtin_rint(rev));
        cs[i] = __builtin_amdgcn_cosf(fr); sn[i] = __builtin_amdgcn_sinf(fr);
    }
}
__device__ __forceinline__ void rope_apply(f32x16& a, const float (&cs)[8], const float (&sn)[8]) {
#pragma unroll
    for (int i = 0; i < 8; ++i) { const float x1 = a[i], x2 = a[i + 8]; a[i] = x1 * cs[i] - x2 * sn[i]; a[i + 8] = x1 * sn[i] + x2 * cs[i]; }
}
__device__ __forceinline__ void store_tile_rowmajor(bf16_t* dst  , const f32x16& a, int h) {
#pragma unroll
    for (int g = 0; g < 4; ++g) { u32x2 o; o.x = pk2(a[4 * g], a[4 * g + 1]); o.y = pk2(a[4 * g + 2], a[4 * g + 3]); *(u32x2*)(dst + 8 * g + 4 * h) = o; }
}
__device__ __forceinline__ void mq_unit(const bf16_t* __restrict__ H, const bf16_t* __restrict__ WT, const int* __restrict__ pos, bf16_t* __restrict__ QC, int tb, int hh, int lane) {
    const int r = lane & 31, h = lane >> 5, tok = tb * 32 + r;
    const bf16_t* src = H + (size_t)tok * DINP + C_CQ + 8 * h;
    bf16x8 bfr[16]; float ss = 0.f;
#pragma unroll
    for (int s = 0; s < 16; ++s) { bfr[s] = *(const bf16x8*)(src + 16 * s);
#pragma unroll
        for (int j = 0; j < 8; ++j) { const float v = bf2f(bfr[s][j]); ss += v * v; } }
    ss += __shfl_xor(ss, 32);
    const float rs = rsqrtf(ss * (1.f / 256.f) + EPS) * QSC_MLA;
    float cs[8], sn[8]; rope_cs(pos[tok], h, cs, sn);
    const bf16_t* W = WT + (size_t)(hh * 96 + r) * 256 + 8 * h;
#pragma unroll 1
    for (int nt = 0; nt < 3; ++nt) {
        f32x16 acc;
#pragma unroll
        for (int i = 0; i < 16; ++i) acc[i] = 0.f;
#pragma unroll
        for (int s = 0; s < 16; ++s) { const bf16x8 a = *(const bf16x8*)(W + (size_t)nt * 32 * 256 + 16 * s); acc = MFMA32(a, bfr[s], acc); }
#pragma unroll
        for (int i = 0; i < 16; ++i) acc[i] *= rs;
        if (nt == 2) rope_apply(acc, cs, sn);
        store_tile_rowmajor(QC + (size_t)tok * 384 + hh * 96 + nt * 32, acc, h);
    }
}
__device__ __forceinline__ void vt_flush(LAS bf16_t* stg, bf16_t* __restrict__ dst  , int lane) {
    const LAS u32x4* rp = (const LAS u32x4*)(stg + lane * 32);
    u32x4 w[4];
#pragma unroll
    for (int c = 0; c < 4; ++c) w[c] = rp[c];
    u32x4* gp = (u32x4*)(dst + (size_t)lane * SEQ);
#pragma unroll
    for (int c = 0; c < 4; ++c) gp[c] = w[c];
}
__device__ __forceinline__ void mkv_unit(const bf16_t* __restrict__ H, const bf16_t* __restrict__ WT, const int* __restrict__ pos, bf16_t* __restrict__ KC, bf16_t* __restrict__ VTC, int tb, int hh, int lane, LAS bf16_t* stg) {
    const int r = lane & 31, h = lane >> 5, tok = tb * 32 + r;
    const bf16_t* src = H + (size_t)tok * DINP + C_CKV + 8 * h;
    bf16x8 bfr[8]; float ss = 0.f;
#pragma unroll
    for (int s = 0; s < 8; ++s) { bfr[s] = *(const bf16x8*)(src + 16 * s);
#pragma unroll
        for (int j = 0; j < 8; ++j) { const float v = bf2f(bfr[s][j]); ss += v * v; } }
    ss += __shfl_xor(ss, 32);
    const float rs = rsqrtf(ss * (1.f / 128.f) + EPS);
    const bf16_t* W = WT + (size_t)(hh * 128 + r) * 128 + 8 * h;
    const int b = (tb * 32) / SEQ, t0 = (tb * 32) % SEQ;
#pragma unroll 1
    for (int nt = 0; nt < 4; ++nt) {
        f32x16 acc;
#pragma unroll
        for (int i = 0; i < 16; ++i) acc[i] = 0.f;
#pragma unroll
        for (int s = 0; s < 8; ++s) { const bf16x8 a = *(const bf16x8*)(W + (size_t)nt * 32 * 128 + 16 * s); acc = MFMA32(a, bfr[s], acc); }
#pragma unroll
        for (int i = 0; i < 16; ++i) acc[i] *= rs;
        if (nt < 2) store_tile_rowmajor(KC + (size_t)tok * 384 + hh * 96 + nt * 32, acc, h);
        else {
            LAS bf16_t* sp = stg + ((nt - 2) * 32 + 4 * h) * 32 + r;
#pragma unroll
            for (int i = 0; i < 16; ++i) sp[((i & 3) + 8 * (i >> 2)) * 32] = f2bf(acc[i]);
        }
    }
    vt_flush(stg, VTC + ((size_t)((b * 4 + hh) * 64)) * SEQ + t0, lane);
    f32x16 kr;
    const bf16_t* krp = H + (size_t)tok * DINP + C_CKR + 4 * h;
#pragma unroll
    for (int g = 0; g < 4; ++g) { const u32x2 w = *(const u32x2*)(krp + 8 * g); kr[4 * g] = bflo(w.x); kr[4 * g + 1] = bfhi(w.x); kr[4 * g + 2] = bflo(w.y); kr[4 * g + 3] = bfhi(w.y); }
    float cs[8], sn[8]; rope_cs(pos[tok], h, cs, sn);
    rope_apply(kr, cs, sn);
    store_tile_rowmajor(KC + (size_t)tok * 384 + hh * 96 + 64, kr, h);
}
__device__ __forceinline__ void vt_unit(const bf16_t* __restrict__ H, int col0, int NH, bf16_t* __restrict__ VT, int tb, int head, int lane, LAS bf16_t* stg) {
    const int r = lane & 31, h = lane >> 5, tok = tb * 32 + r, b = (tb * 32) / SEQ, t0 = (tb * 32) % SEQ;
    const bf16_t* src = H + (size_t)tok * DINP + col0 + head * 64 + 32 * h;
    bf16x8 v[4];
#pragma unroll
    for (int c = 0; c < 4; ++c) v[c] = *(const bf16x8*)(src + 8 * c);
    LAS bf16_t* sp = stg + (32 * h) * 32 + r;
#pragma unroll
    for (int c = 0; c < 4; ++c)
#pragma unroll
        for (int j = 0; j < 8; ++j) sp[(8 * c + j) * 32] = (bf16_t)v[c][j];
    vt_flush(stg, VT + ((size_t)((b * NH + head) * 64)) * SEQ + t0, lane);
}
__device__ __forceinline__ void conv_unit(const bf16_t* __restrict__ H, const float* __restrict__ cw, const float* __restrict__ cb, bf16_t* __restrict__ Y, int tb8, int lane) {
    const int tok0 = tb8 * 8, t0 = tok0 % SEQ, ch = 4 * lane;
    const f32x4 w0 = *(const f32x4*)(cw + ch), w1 = *(const f32x4*)(cw + 256 + ch), w2 = *(const f32x4*)(cw + 512 + ch), bs = *(const f32x4*)(cb + ch);
    u32x2 cc[10], xx[10], bb[8];
    const int back = (t0 >= 2) ? 2 : 0;
#pragma unroll
    for (int i = 0; i < 10; ++i) { const int ti = (i < 2) ? (i - back) : (i - 2); const bf16_t* p = H + (size_t)(tok0 + ti) * DINP + ch;
        cc[i] = *(const u32x2*)(p + C_BC); xx[i] = *(const u32x2*)(p + C_BX); if (i >= 2) bb[i - 2] = *(const u32x2*)(p + C_BB); }
    f32x4 u[10];
#pragma unroll
    for (int i = 0; i < 10; ++i) u[i] = (f32x4){bflo(cc[i].x) * bflo(xx[i].x), bfhi(cc[i].x) * bfhi(xx[i].x), bflo(cc[i].y) * bflo(xx[i].y), bfhi(cc[i].y) * bfhi(xx[i].y)};
    if (back == 0) { u[0] = (f32x4){0.f, 0.f, 0.f, 0.f}; u[1] = (f32x4){0.f, 0.f, 0.f, 0.f}; }
#pragma unroll
    for (int i = 0; i < 8; ++i) {
        const f32x4 bg = {bflo(bb[i].x), bfhi(bb[i].x), bflo(bb[i].y), bfhi(bb[i].y)};
        const f32x4 y = bg * (w0 * u[i] + w1 * u[i + 1] + w2 * u[i + 2] + bs);
        u32x2 o; o.x = pk2(y.x, y.y); o.y = pk2(y.z, y.w);
        *(u32x2*)(Y + (size_t)(tok0 + i) * DM + 256 + ch) = o;
    }
}

__device__ __forceinline__ void o_flush(LAS bf16_t* stg, bf16_t* __restrict__ Orow0, int opitch, int lane) {
    u32x4 w[4];
#pragma unroll
    for (int j = 0; j < 4; ++j) w[j] = *(const LAS u32x4*)(stg + (lane + 64 * j) * 8);
#pragma unroll
    for (int j = 0; j < 4; ++j) { const int c = lane + 64 * j; *(u32x4*)(Orow0 + (size_t)(c >> 3) * opitch + (c & 7) * 8) = w[j]; }
}
template <int DKS, bool SINK>
__device__ __forceinline__ void softmax_unit(const bf16_t* __restrict__ Qrow0, int qpitch, const bf16_t* __restrict__ Kb, int kpitch, const bf16_t* __restrict__ VT,
                                             int qb, int kt_begin, int window, float sink2, bf16_t* __restrict__ Orow0, int opitch, int lane, LAS bf16_t* stg) {
    const int r = lane & 31, h = lane >> 5;
    const int pr = (r & ~12) | ((r & 8) >> 1) | ((r & 4) << 1);
    bf16x8 qf[DKS];
#pragma unroll
    for (int s = 0; s < DKS; ++s) qf[s] = *(const bf16x8*)(Qrow0 + (size_t)r * qpitch + 16 * s + 8 * h);
    f32x16 o0, o1;
#pragma unroll
    for (int i = 0; i < 16; ++i) { o0[i] = 0.f; o1[i] = 0.f; }
    float m = -1e30f, l = 0.f;
    const int kt_end = qb + 1, q = 32 * qb + r;
    const bf16_t* kp = Kb + (size_t)(32 * kt_begin + pr) * kpitch + 8 * h;
    const bf16_t* vp = VT + (size_t)r * SEQ + 32 * kt_begin + 8 * h;
    bf16x8 kf[DKS];
#pragma unroll
    for (int s = 0; s < DKS; ++s) kf[s] = *(const bf16x8*)(kp + 16 * s);
    for (int kt = kt_begin; kt < kt_end; ++kt) {
        bf16x8 kn[DKS];
        if (kt + 1 < kt_end) {
#pragma unroll
            for (int s = 0; s < DKS; ++s) kn[s] = *(const bf16x8*)(kp + (size_t)32 * kpitch + 16 * s);
        } else {
#pragma unroll
            for (int s = 0; s < DKS; ++s) kn[s] = kf[s];
        }
        const bf16x8 v00 = *(const bf16x8*)(vp), v01 = *(const bf16x8*)(vp + 32 * SEQ), v10 = *(const bf16x8*)(vp + 16), v11 = *(const bf16x8*)(vp + 32 * SEQ + 16);
        f32x16 p;
#pragma unroll
        for (int i = 0; i < 16; ++i) p[i] = 0.f;
#pragma unroll
        for (int s = 0; s < DKS; ++s) p = MFMA32(kf[s], qf[s], p);
        if (kt == qb || (window != 0 && kt == qb - (window >> 5))) {
            const int k0 = 32 * kt + 8 * h;
#pragma unroll
            for (int i = 0; i < 16; ++i) { const int kv = k0 + 16 * (i >> 3) + (i & 7); const bool ok = (kv <= q) && (window == 0 || kv > q - window); if (!ok) p[i] = -INFINITY; }
        }
        float rm = p[0];
#pragma unroll
        for (int i = 1; i < 16; ++i) rm = fmaxf(rm, p[i]);
        rm = fmaxf(rm, __shfl_xor(rm, 32));
        if (__any(rm > m + 6.f)) {
            const float mn = fmaxf(m, rm), f = ex2(m - mn); m = mn; l *= f;
#pragma unroll
            for (int i = 0; i < 16; ++i) { const float fi = __shfl(f, crow(i, h)); o0[i] *= fi; o1[i] *= fi; }
        }
        float e[16];
#pragma unroll
        for (int i = 0; i < 16; ++i) { e[i] = ex2(p[i] - m); l += e[i]; }
        const bf16x8 pa0 = pack8(e), pa1 = pack8(e + 8);
        o0 = MFMA32(pa0, v00, o0); o1 = MFMA32(pa0, v01, o1);
        o0 = MFMA32(pa1, v10, o0); o1 = MFMA32(pa1, v11, o1);
#pragma unroll
        for (int s = 0; s < DKS; ++s) kf[s] = kn[s];
        kp += (size_t)32 * kpitch; vp += 32;
    }
    l += __shfl_xor(l, 32);
    if (SINK) l += ex2(sink2 - m);
    const float inv = 1.f / l;
    LAS bf16_t* sp = stg + (4 * h) * 64 + r;
#pragma unroll
    for (int i = 0; i < 16; ++i) { const float fi = __shfl(inv, crow(i, h)); const int ro = ((i & 3) + 8 * (i >> 2)) * 64;
        sp[ro] = f2bf(o0[i] * fi); sp[ro + 32] = f2bf(o1[i] * fi); }
    o_flush(stg, Orow0, opitch, lane);
}


constexpr int KP = 208, VP = 272;
constexpr int KT_BYTES = 128 * KP, VT_BYTES = 64 * VP, TB_BYTES = KT_BYTES + VT_BYTES, MRG_OFF = 2 * TB_BYTES;
static_assert(MRG_OFF + 4 * 34 * 64 * 4 <= 131072, "MLA LDS map");
__device__ __forceinline__ void mla_unit_blk(const bf16_t* __restrict__ QC, const bf16_t* __restrict__ KC, const bf16_t* __restrict__ VTC, bf16_t* __restrict__ Y,
                                             int bh, int g, LAS unsigned char* lds, int tid) {
    const int lane = tid & 63, wave = __builtin_amdgcn_readfirstlane(tid >> 6), r = lane & 31, h = lane >> 5, w4 = wave & 3, kh = wave >> 2;
    const int pr = (r & ~12) | ((r & 8) >> 1) | ((r & 4) << 1);
    const int b = bh >> 2, hh = bh & 3, qb = 4 * g + w4, q = 32 * qb + r;
    const bf16_t* Qp = QC + ((size_t)b * SEQ + q) * 384 + hh * 96 + 8 * h;
    bf16x8 qf[6];
#pragma unroll
    for (int s = 0; s < 6; ++s) qf[s] = *(const bf16x8*)(Qp + 16 * s);
    const bf16_t* Kg = KC + (size_t)b * SEQ * 384 + hh * 96;
    const bf16_t* Vg = VTC + (size_t)(b * 4 + hh) * 64 * SEQ;
    int kgo[3], klo[3], vgo[2], vlo[2];
#pragma unroll
    for (int i = 0; i < 3; ++i) { const int c = tid + 512 * i, row = c / 12, cc = c - 12 * row; kgo[i] = row * 384 + 8 * cc; klo[i] = row * KP + 16 * cc; }
#pragma unroll
    for (int i = 0; i < 2; ++i) { const int c = tid + 512 * i, d = c >> 4, cc = c & 15; vgo[i] = d * SEQ + 8 * cc; vlo[i] = KT_BYTES + d * VP + 16 * cc; }
    u32x4 kr[3], vr[2];
#define MLA_LOAD(ST) do { _Pragma("unroll") for (int i = 0; i < 3; ++i) kr[i] = *(const u32x4*)(Kg + (size_t)(ST) * (128 * 384) + kgo[i]); \
                          _Pragma("unroll") for (int i = 0; i < 2; ++i) vr[i] = *(const u32x4*)(Vg + (ST) * 128 + vgo[i]); } while (0)
#define MLA_STORE(buf) do { LAS unsigned char* tb_ = lds + (buf) * TB_BYTES; _Pragma("unroll") for (int i = 0; i < 3; ++i) *(LAS u32x4*)(tb_ + klo[i]) = kr[i]; \
                            _Pragma("unroll") for (int i = 0; i < 2; ++i) *(LAS u32x4*)(tb_ + vlo[i]) = vr[i]; } while (0)
    f32x16 o0, o1;
#pragma unroll
    for (int i = 0; i < 16; ++i) { o0[i] = 0.f; o1[i] = 0.f; }
    float m = -1e30f, l = 0.f;
    const int nST = g + 1;
    MLA_LOAD(0); MLA_STORE(0);
    __syncthreads();
    const int kfo = (64 * kh + pr) * KP + 16 * h;
    const int vfo = KT_BYTES + r * VP + (64 * kh + 8 * h) * 2;
    for (int ST = 0; ST < nST; ++ST) {
        if (ST + 1 < nST) MLA_LOAD(ST + 1);
        const int kt0 = 4 * ST + 2 * kh;
        if (kt0 <= qb) {
            const LAS unsigned char* tb = lds + (ST & 1) * TB_BYTES;
            f32x16 p0, p1;
#pragma unroll
            for (int i = 0; i < 16; ++i) { p0[i] = 0.f; p1[i] = 0.f; }
#pragma unroll
            for (int s = 0; s < 6; ++s) { const bf16x8 k0 = *(const LAS bf16x8*)(tb + kfo + 32 * s), k1 = *(const LAS bf16x8*)(tb + kfo + 32 * KP + 32 * s);
                p0 = MFMA32(k0, qf[s], p0); p1 = MFMA32(k1, qf[s], p1); }
            if (kt0 + 1 >= qb) {
                const int kb0 = 32 * kt0 + 8 * h;
#pragma unroll
                for (int i = 0; i < 16; ++i) { const int kv = kb0 + 16 * (i >> 3) + (i & 7); if (kv > q) p0[i] = -INFINITY; if (kv + 32 > q) p1[i] = -INFINITY; }
            }
            float rm = fmaxf(p0[0], p1[0]);
#pragma unroll
            for (int i = 1; i < 16; ++i) rm = fmaxf(rm, fmaxf(p0[i], p1[i]));
            rm = fmaxf(rm, __shfl_xor(rm, 32));
            if (__any(rm > m + 6.f)) {
                const float mn = fmaxf(m, rm), f = ex2(m - mn); m = mn; l *= f;
#pragma unroll
                for (int i = 0; i < 16; ++i) { const float fi = __shfl(f, crow(i, h)); o0[i] *= fi; o1[i] *= fi; }
            }
            float ls = 0.f;
#pragma unroll
            for (int i = 0; i < 16; ++i) { p0[i] = ex2(p0[i] - m); p1[i] = ex2(p1[i] - m); ls += p0[i] + p1[i]; }
            l += ls;
            float e[8];
#pragma unroll
            for (int ks = 0; ks < 4; ++ks) {
#pragma unroll
                for (int j = 0; j < 8; ++j) e[j] = (ks < 2) ? p0[8 * ks + j] : p1[8 * (ks - 2) + j];
                const bf16x8 pa = pack8(e);
                const bf16x8 v0 = *(const LAS bf16x8*)(tb + vfo + 32 * ks), v1 = *(const LAS bf16x8*)(tb + vfo + 32 * VP + 32 * ks);
                o0 = MFMA32(pa, v0, o0); o1 = MFMA32(pa, v1, o1);
            }
        }
        if (ST + 1 < nST) MLA_STORE((ST + 1) & 1);
        __syncthreads();
    }
#undef MLA_LOAD
#undef MLA_STORE
    l += __shfl_xor(l, 32);
    LAS float* mg = (LAS float*)(lds + MRG_OFF) + w4 * (34 * 64) + lane;
    if (kh == 1) {
#pragma unroll
        for (int i = 0; i < 16; ++i) { mg[i * 64] = o0[i]; mg[(16 + i) * 64] = o1[i]; }
        mg[32 * 64] = m; mg[33 * 64] = l;
    }
    __syncthreads();
    if (kh == 0) {
        const float mb = mg[32 * 64], lb = mg[33 * 64];
        const float mn = fmaxf(m, mb), fa = ex2(m - mn), fb = ex2(mb - mn), inv = 1.f / (l * fa + lb * fb), ga = fa * inv, gb = fb * inv;
        LAS bf16_t* stg = (LAS bf16_t*)(lds + wave * 4096);
        LAS bf16_t* sp = stg + (4 * h) * 64 + r;
#pragma unroll
        for (int i = 0; i < 16; ++i) { const float ra = __shfl(ga, crow(i, h)), rb = __shfl(gb, crow(i, h)); const int ro = ((i & 3) + 8 * (i >> 2)) * 64;
            sp[ro] = f2bf(o0[i] * ra + mg[i * 64] * rb); sp[ro + 32] = f2bf(o1[i] * ra + mg[(16 + i) * 64] * rb); }
        o_flush(stg, Y + ((size_t)b * SEQ + 32 * qb) * DM + 512 + hh * 64, DM, lane);
    }
    __syncthreads();
}

__device__ __forceinline__ void sb_unit(const bf16_t* __restrict__ Qrow0, int qpitch, const bf16_t* __restrict__ Kb, int kpitch, const bf16_t* __restrict__ VT,
                                        int qb, bf16_t* __restrict__ Orow0, int opitch, int lane, LAS bf16_t* stg) {
    const int r = lane & 31, h = lane >> 5;
    const int pr = (r & ~12) | ((r & 8) >> 1) | ((r & 4) << 1);
    bf16x8 qf[4];
#pragma unroll
    for (int s = 0; s < 4; ++s) qf[s] = *(const bf16x8*)(Qrow0 + (size_t)r * qpitch + 16 * s + 8 * h);
    f32x16 o0, o1;
#pragma unroll
    for (int i = 0; i < 16; ++i) { o0[i] = 0.f; o1[i] = 0.f; }
    float carry = 0.f;
    const int q = 32 * qb + r;
    const bf16_t* kp = Kb + (size_t)(32 * qb + pr) * kpitch + 8 * h;
    const bf16_t* vp = VT + (size_t)r * SEQ + 32 * qb + 8 * h;
    bf16x8 kf[4];
#pragma unroll
    for (int s = 0; s < 4; ++s) kf[s] = *(const bf16x8*)(kp + 16 * s);
    for (int kt = qb; kt >= 0; --kt) {
        bf16x8 kn[4];
        if (kt > 0) {
#pragma unroll
            for (int s = 0; s < 4; ++s) kn[s] = *(const bf16x8*)(kp - (size_t)32 * kpitch + 16 * s);
        } else {
#pragma unroll
            for (int s = 0; s < 4; ++s) kn[s] = kf[s];
        }
        const bf16x8 v00 = *(const bf16x8*)(vp), v01 = *(const bf16x8*)(vp + 32 * SEQ), v10 = *(const bf16x8*)(vp + 16), v11 = *(const bf16x8*)(vp + 32 * SEQ + 16);
        f32x16 p;
#pragma unroll
        for (int i = 0; i < 16; ++i) p[i] = 0.f;
#pragma unroll
        for (int s = 0; s < 4; ++s) p = MFMA32(kf[s], qf[s], p);
        const bool diag = (kt == qb);
        const int k0 = 32 * kt + 8 * h;
        float sfx[16];
#pragma unroll
        for (int i = 0; i < 16; ++i) {
            const float z = p[i];
            float L = -(fmaxf(z, 0.f) + lg2(1.f + ex2(-fabsf(z))));
            if (diag) { const int kv = k0 + 16 * (i >> 3) + (i & 7); if (!(kv < q)) L = 0.f; }
            sfx[i] = L;
        }
#pragma unroll
        for (int g = 0; g < 2; ++g)
#pragma unroll
            for (int j = 6; j >= 0; --j) sfx[8 * g + j] += sfx[8 * g + j + 1];
        const float T0 = sfx[0], T1 = sfx[8];
        const float TP0 = __shfl_xor(T0, 32), TP1 = __shfl_xor(T1, 32);
        const float off1 = (h ? 0.f : TP1) + carry, off0 = T1 + TP1 + (h ? 0.f : TP0) + carry;
        float e[16];
#pragma unroll
        for (int i = 0; i < 16; ++i) {
            float a = ex2(p[i] + sfx[i] + (i < 8 ? off0 : off1));
            if (diag) { const int kv = k0 + 16 * (i >> 3) + (i & 7); if (!(kv < q)) a = 0.f; }
            e[i] = a;
        }
        carry += (T0 + T1) + (TP0 + TP1);
        const bf16x8 pa0 = pack8(e), pa1 = pack8(e + 8);
        o0 = MFMA32(pa0, v00, o0); o1 = MFMA32(pa0, v01, o1);
        o0 = MFMA32(pa1, v10, o0); o1 = MFMA32(pa1, v11, o1);
        if (__all(carry < -150.f)) break;
#pragma unroll
        for (int s = 0; s < 4; ++s) kf[s] = kn[s];
        kp -= (size_t)32 * kpitch; vp -= 32;
    }
    LAS bf16_t* sp = stg + (4 * h) * 64 + r;
#pragma unroll
    for (int i = 0; i < 16; ++i) { const int ro = ((i & 3) + 8 * (i >> 2)) * 64; sp[ro] = f2bf(o0[i]); sp[ro + 32] = f2bf(o1[i]); }
    o_flush(stg, Orow0, opitch, lane);
}


constexpr int AKP = 144;
constexpr int SWA_NK = 384, SWA_VP = SWA_NK * 2 + 16, SWA_KB = SWA_NK * AKP;
constexpr int SB_NK = 448, SB_VP = SB_NK * 2 + 16, SB_KB = SB_NK * AKP;
constexpr int STG_OFF = 122880, MISC_OFF = STG_OFF + 8 * 4096;
static_assert(SWA_KB + 64 * SWA_VP <= STG_OFF && SB_KB + 64 * SB_VP <= STG_OFF && MISC_OFF + 1024 == LDS_BYTES, "window LDS map");
template <int NK, int VPB>
__device__ __forceinline__ void stage_kv64(const bf16_t* __restrict__ Kb, int kpitch, const bf16_t* __restrict__ VT, int key0, LAS unsigned char* lds, int tid) {
    constexpr int NCH = NK * 8 / 512, VC = NK / 8;
    u32x4 kr[NCH], vr[NCH];
#pragma unroll
    for (int i = 0; i < NCH; ++i) { const int c = tid + 512 * i, row = c >> 3, cc = c & 7; int key = key0 + row; key = key < 0 ? 0 : key;
        kr[i] = *(const u32x4*)(Kb + (size_t)key * kpitch + 8 * cc); }
#pragma unroll
    for (int i = 0; i < NCH; ++i) { const int c = tid + 512 * i, d = c / VC, cc = c - d * VC; int key = key0 + 8 * cc; key = key < 0 ? 0 : key;
        vr[i] = *(const u32x4*)(VT + (size_t)d * SEQ + key); }
#pragma unroll
    for (int i = 0; i < NCH; ++i) { const int c = tid + 512 * i, row = c >> 3, cc = c & 7; *(LAS u32x4*)(lds + row * AKP + 16 * cc) = kr[i]; }
#pragma unroll
    for (int i = 0; i < NCH; ++i) { const int c = tid + 512 * i, d = c / VC, cc = c - d * VC; *(LAS u32x4*)(lds + NK * AKP + d * VPB + 16 * cc) = vr[i]; }
}
__device__ __forceinline__ void swa_wave_lds(const bf16_t* __restrict__ Qrow0, int qpitch, const LAS unsigned char* lds, int qb, int kt_base, float sink2,
                                             bf16_t* __restrict__ Orow0, int opitch, int lane, LAS bf16_t* stg) {
    const int r = lane & 31, h = lane >> 5;
    const int pr = (r & ~12) | ((r & 8) >> 1) | ((r & 4) << 1);
    bf16x8 qf[4];
#pragma unroll
    for (int s = 0; s < 4; ++s) qf[s] = *(const bf16x8*)(Qrow0 + (size_t)r * qpitch + 16 * s + 8 * h);
    f32x16 o0, o1;
#pragma unroll
    for (int i = 0; i < 16; ++i) { o0[i] = 0.f; o1[i] = 0.f; }
    float m = -1e30f, l = 0.f;
    const int q = 32 * qb + r, kt_begin = qb - 4 > 0 ? qb - 4 : 0;
    for (int kt = kt_begin; kt <= qb; ++kt) {
        const int rel = kt - kt_base;
        const LAS unsigned char* kp = lds + (32 * rel + pr) * AKP + 16 * h;
        const LAS unsigned char* vp = lds + SWA_KB + r * SWA_VP + (32 * rel + 8 * h) * 2;
        f32x16 p;
#pragma unroll
        for (int i = 0; i < 16; ++i) p[i] = 0.f;
#pragma unroll
        for (int s = 0; s < 4; ++s) p = MFMA32(*(const LAS bf16x8*)(kp + 32 * s), qf[s], p);
        if (kt == qb || kt == qb - 4) {
            const int k0 = 32 * kt + 8 * h;
#pragma unroll
            for (int i = 0; i < 16; ++i) { const int kv = k0 + 16 * (i >> 3) + (i & 7); const bool ok = (kv <= q) && (kv > q - 128); if (!ok) p[i] = -INFINITY; }
        }
        float rm = p[0];
#pragma unroll
        for (int i = 1; i < 16; ++i) rm = fmaxf(rm, p[i]);
        rm = fmaxf(rm, __shfl_xor(rm, 32));
        if (__any(rm > m + 6.f)) {
            const float mn = fmaxf(m, rm), f = ex2(m - mn); m = mn; l *= f;
#pragma unroll
            for (int i = 0; i < 16; ++i) { const float fi = __shfl(f, crow(i, h)); o0[i] *= fi; o1[i] *= fi; }
        }
        float e[16];
#pragma unroll
        for (int i = 0; i < 16; ++i) { e[i] = ex2(p[i] - m); l += e[i]; }
        const bf16x8 pa0 = pack8(e), pa1 = pack8(e + 8);
        o0 = MFMA32(pa0, *(const LAS bf16x8*)(vp), o0); o1 = MFMA32(pa0, *(const LAS bf16x8*)(vp + 32 * SWA_VP), o1);
        o0 = MFMA32(pa1, *(const LAS bf16x8*)(vp + 32), o0); o1 = MFMA32(pa1, *(const LAS bf16x8*)(vp + 32 * SWA_VP + 32), o1);
    }
    l += __shfl_xor(l, 32);
    l += ex2(sink2 - m);
    const float inv = 1.f / l;
    LAS bf16_t* sp = stg + (4 * h) * 64 + r;
#pragma unroll
    for (int i = 0; i < 16; ++i) { const float fi = __shfl(inv, crow(i, h)); const int ro = ((i & 3) + 8 * (i >> 2)) * 64;
        sp[ro] = f2bf(o0[i] * fi); sp[ro + 32] = f2bf(o1[i] * fi); }
    o_flush(stg, Orow0, opitch, lane);
}
#define SB_STEP(KT_, V00_, V01_, V10_, V11_) do { \
        const bool diag = ((KT_) == qb); const int k0 = 32 * (KT_) + 8 * h; float sfx[16]; \
        _Pragma("unroll") for (int i = 0; i < 16; ++i) { const float z = p[i]; float L = -(fmaxf(z, 0.f) + lg2(1.f + ex2(-fabsf(z)))); \
            if (diag) { const int kv = k0 + 16 * (i >> 3) + (i & 7); if (!(kv < q)) L = 0.f; } sfx[i] = L; } \
        _Pragma("unroll") for (int g = 0; g < 2; ++g) _Pragma("unroll") for (int j = 6; j >= 0; --j) sfx[8 * g + j] += sfx[8 * g + j + 1]; \
        const float T0 = sfx[0], T1 = sfx[8]; const float TP0 = __shfl_xor(T0, 32), TP1 = __shfl_xor(T1, 32); \
        const float off1 = (h ? 0.f : TP1) + carry, off0 = T1 + TP1 + (h ? 0.f : TP0) + carry; float e[16]; \
        _Pragma("unroll") for (int i = 0; i < 16; ++i) { float a = ex2(p[i] + sfx[i] + (i < 8 ? off0 : off1)); \
            if (diag) { const int kv = k0 + 16 * (i >> 3) + (i & 7); if (!(kv < q)) a = 0.f; } e[i] = a; } \
        carry += (T0 + T1) + (TP0 + TP1); \
        const bf16x8 pa0 = pack8(e), pa1 = pack8(e + 8); \
        o0 = MFMA32(pa0, (V00_), o0); o1 = MFMA32(pa0, (V01_), o1); o0 = MFMA32(pa1, (V10_), o0); o1 = MFMA32(pa1, (V11_), o1); } while (0)
__device__ __forceinline__ void sb_wave_lds(const bf16_t* __restrict__ Qrow0, int qpitch, const LAS unsigned char* lds, const bf16_t* __restrict__ Kb, int kpitch,
                                            const bf16_t* __restrict__ VT, int qb, int kt_base, bf16_t* __restrict__ Orow0, int opitch, int lane, LAS bf16_t* stg) {
    const int r = lane & 31, h = lane >> 5;
    const int pr = (r & ~12) | ((r & 8) >> 1) | ((r & 4) << 1);
    bf16x8 qf[4];
#pragma unroll
    for (int s = 0; s < 4; ++s) qf[s] = *(const bf16x8*)(Qrow0 + (size_t)r * qpitch + 16 * s + 8 * h);
    f32x16 o0, o1;
#pragma unroll
    for (int i = 0; i < 16; ++i) { o0[i] = 0.f; o1[i] = 0.f; }
    float carry = 0.f;
    const int q = 32 * qb + r;
    const int kt_lo = kt_base > 0 ? kt_base : 0;
    bool done = false;
    int kt = qb;
    for (; kt >= kt_lo; --kt) {
        const int rel = kt - kt_base;
        const LAS unsigned char* kp = lds + (32 * rel + pr) * AKP + 16 * h;
        const LAS unsigned char* vp = lds + SB_KB + r * SB_VP + (32 * rel + 8 * h) * 2;
        f32x16 p;
#pragma unroll
        for (int i = 0; i < 16; ++i) p[i] = 0.f;
#pragma unroll
        for (int s = 0; s < 4; ++s) p = MFMA32(*(const LAS bf16x8*)(kp + 32 * s), qf[s], p);
        SB_STEP(kt, *(const LAS bf16x8*)(vp), *(const LAS bf16x8*)(vp + 32 * SB_VP), *(const LAS bf16x8*)(vp + 32), *(const LAS bf16x8*)(vp + 32 * SB_VP + 32));
        if (__all(carry < -150.f)) { done = true; break; }
    }
    if (!done && kt >= 0) {
        const bf16_t* kp = Kb + (size_t)(32 * kt + pr) * kpitch + 8 * h;
        const bf16_t* vp = VT + (size_t)r * SEQ + 32 * kt + 8 * h;
        for (; kt >= 0; --kt) {
            bf16x8 kf[4];
#pragma unroll
            for (int s = 0; s < 4; ++s) kf[s] = *(const bf16x8*)(kp + 16 * s);
            const bf16x8 v00 = *(const bf16x8*)(vp), v01 = *(const bf16x8*)(vp + 32 * SEQ), v10 = *(const bf16x8*)(vp + 16), v11 = *(const bf16x8*)(vp + 32 * SEQ + 16);
            f32x16 p;
#pragma unroll
            for (int i = 0; i < 16; ++i) p[i] = 0.f;
#pragma unroll
            for (int s = 0; s < 4; ++s) p = MFMA32(kf[s], qf[s], p);
            SB_STEP(kt, v00, v01, v10, v11);
            if (__all(carry < -150.f)) break;
            kp -= (size_t)32 * kpitch; vp -= 32;
        }
    }
    LAS bf16_t* sp = stg + (4 * h) * 64 + r;
#pragma unroll
    for (int i = 0; i < 16; ++i) { const int ro = ((i & 3) + 8 * (i >> 2)) * 64; sp[ro] = f2bf(o0[i]); sp[ro + 32] = f2bf(o1[i]); }
    o_flush(stg, Orow0, opitch, lane);
}
#undef SB_STEP

#define XB_TMO      128
#define XB_XCNT(j)  (256  + 64 * (j))
#define XB_XSUB(j)  (1280 + 64 * (j))
#define XB_XGEN(j)  (2304 + 64 * (j))
#define XB_TOP      3328
#define XB_TOPGEN   3392
#define XCD_BAR_WORDS 3456
#define XB_SPIN_CAP (1u << 18)

__device__ __forceinline__ unsigned xb_ld(unsigned* p)              { return __hip_atomic_load(p, __ATOMIC_RELAXED, __HIP_MEMORY_SCOPE_AGENT); }
__device__ __forceinline__ unsigned xb_add(unsigned* p, unsigned v) { return __hip_atomic_fetch_add(p, v, __ATOMIC_RELAXED, __HIP_MEMORY_SCOPE_AGENT); }
__device__ __forceinline__ unsigned xb_xcc_id() { return (unsigned)__builtin_amdgcn_s_getreg((3 << 11) | 20) & 0xFu; }
#define XB_SPIN(cond, bar) do { unsigned _sp = 0; while (cond) { __builtin_amdgcn_s_sleep(1); \
    if ((++_sp & 255u) == 0u) { if (xb_ld(&(bar)[XB_TMO])) break; if (_sp > XB_SPIN_CAP) { atomicAdd(&(bar)[XB_TMO], 1u); break; } } } } while (0)

struct XcdBarrier {
    unsigned* bar; unsigned x;
    volatile LAS unsigned* st;
};

__device__ __forceinline__ XcdBarrier xcd_barrier_post(unsigned* bar, volatile LAS unsigned* st) {
    XcdBarrier b; b.bar = bar; b.x = xb_xcc_id(); b.st = st;
    if (threadIdx.x == 0) (void)xb_add(&bar[XB_XCNT(b.x)], 1u);
    return b;
}
__device__ __forceinline__ void xcd_barrier_complete(unsigned* bar, unsigned x, unsigned& nloc, unsigned& nx) {
    const unsigned G = gridDim.x * gridDim.y * gridDim.z;
    unsigned sum, cnt, mine, sp = 0u;
    for (;;) {
        sum = 0u; cnt = 0u; mine = 0u;
#pragma unroll
        for (unsigned j = 0; j < 16; ++j) { const unsigned c = xb_ld(&bar[XB_XCNT(j)]); sum += c; cnt += (c > 0u) ? 1u : 0u; mine = (j == x) ? c : mine; }
        if (sum == G) break;
        __builtin_amdgcn_s_sleep(1);
        if ((++sp & 255u) == 0u) { if (xb_ld(&bar[XB_TMO])) break; if (sp > XB_SPIN_CAP) { atomicAdd(&bar[XB_TMO], 1u); break; } }
    }
    nloc = mine > 0u ? mine : 1u; nx = cnt > 0u ? cnt : 1u;
}

__device__ __forceinline__ void xcd_barrier(const XcdBarrier& b) {
    asm volatile("s_waitcnt vmcnt(0)" ::: "memory");
    __syncthreads();
    if (threadIdx.x == 0) {
        unsigned* bar = b.bar;
        __builtin_amdgcn_s_waitcnt(0);
        unsigned nloc = b.st[0], nx = b.st[1];
        if (nloc == 0u) { xcd_barrier_complete(bar, b.x, nloc, nx); b.st[0] = nloc; b.st[1] = nx; }
        const unsigned old = xb_add(&bar[XB_XSUB(b.x)], 1u);
        const unsigned gen = old / nloc;
        if (old + 1u == (gen + 1u) * nloc) {
            __builtin_amdgcn_fence(__ATOMIC_RELEASE, "agent");
            asm volatile("s_waitcnt vmcnt(0)" ::: "memory");
            const unsigned og = xb_add(&bar[XB_TOP], 1u);
            const unsigned tg = og / nx;
            if (og + 1u == (tg + 1u) * nx) xb_add(&bar[XB_TOPGEN], 1u);
            else XB_SPIN(xb_ld(&bar[XB_TOPGEN]) == tg, bar);
            __builtin_amdgcn_fence(__ATOMIC_ACQUIRE, "agent");
            xb_add(&bar[XB_XGEN(b.x)], 1u);
            asm volatile("s_waitcnt vmcnt(0)" ::: "memory");
        } else {
            XB_SPIN(xb_ld(&bar[XB_XGEN(b.x)]) == gen, bar);
            __builtin_amdgcn_fence(__ATOMIC_ACQUIRE, "agent");
            asm volatile("s_waitcnt vmcnt(0)" ::: "memory");
        }
    }
    __syncthreads();
}

__global__ void __launch_bounds__(NTHREADS, 2) fwd(Params P) {
    extern __shared__ __attribute__((aligned(16))) unsigned char lds_raw[];
    LAS unsigned char* lds = (LAS unsigned char*)lds_raw;
    constexpr int G = 256, NGW = G * NWAVES, gthreads = G * NTHREADS;
    const int bx = blockIdx.x;
#if MK_COOP
    cooperative_groups::grid_group grid = cooperative_groups::this_grid();
    volatile LAS unsigned* MISC = (volatile LAS unsigned*)(lds + MISC_OFF);
    if (threadIdx.x < 64) MISC[threadIdx.x] = 0u;
    __syncthreads();
    XcdBarrier bar = xcd_barrier_post((unsigned*)(P.ws + WS_CTL) + CW_BAR, MISC + 8);
#endif
    for (int ph = P.ph_lo; ph < P.ph_hi; ++ph) {
        const int nrep = ((ph >= 1 && ph <= 6 && ((ph - 1) == MK_REP_K || (MK_REP_K == 6 && ph == 3))) || (ph == 0 && MK_REP_K == 7)) ? MK_REP_N : 1;
        for (int rep = 0; rep < nrep; ++rep) {
        int tid_o = threadIdx.x; asm volatile("" : "+v"(tid_o));
        const int tid = tid_o, lane = tid & 63, wave = __builtin_amdgcn_readfirstlane(tid >> 6);
        const int gw = bx * NWAVES + wave, gtid = bx * NTHREADS + tid;
        LAS bf16_t* stg = (LAS bf16_t*)(lds + wave * 4096);
        unsigned char* ws = P.ws; asm volatile("" : "+s"(ws));
        unsigned* ctl = (unsigned*)(ws + WS_CTL);
        bf16_t* XN = (bf16_t*)(ws + WS_XN); bf16_t* H = (bf16_t*)(ws + WS_H);
        bf16_t* QC = (bf16_t*)(ws + WS_QC); bf16_t* KC = (bf16_t*)(ws + WS_KC);
        bf16_t* VTC = (bf16_t*)(ws + WS_VTC); bf16_t* VTA = (bf16_t*)(ws + WS_VTA); bf16_t* VTD = (bf16_t*)(ws + WS_VTD);
        bf16_t* Y = (bf16_t*)(ws + WS_Y);
        if (ph == 0) {
            for (int l = 0; l < NLAYER; ++l) {
                conv_wT(P.w_in + (size_t)l * DM * DIN, DM, DIN, DINP, P.norm_pre + l * DM, (bf16_t*)(ws + WS_WIN) + (size_t)l * DINP * DM, C_AQ, C_AQ + 256, C_DQ, C_DQ + 256, SC64, gtid, gthreads);
                conv_wT(P.w_out + (size_t)l * DM * DM, DM, DM, DM, P.g_grp + l * DM, (bf16_t*)(ws + WS_WOUT) + (size_t)l * DM * DM, 0, 0, 0, 0, 1.f, gtid, gthreads);
                conv_wT(P.w_uq + (size_t)l * 256 * 384, 256, 384, 384, P.g_cq + l * 256, (bf16_t*)(ws + WS_WUQ + (size_t)l * 262144), 0, 0, 0, 0, 1.f, gtid, gthreads);
                conv_wT(P.w_ukv + (size_t)l * 128 * 512, 128, 512, 512, P.g_ckv + l * 128, (bf16_t*)(ws + WS_WUKV + (size_t)l * 131072), 0, 0, 0, 0, 1.f, gtid, gthreads);
            }
            { const float* __restrict__ xr = P.x; bf16_t* __restrict__ xo = XN;
#pragma unroll 2
              for (int mrow = gw; mrow < M_TOK; mrow += NGW) rms_row_to_bf16(xr + (size_t)mrow * DM, xo + (size_t)mrow * DM, lane); }
        } else {
            const int l = (ph - 1) / 6, k = (ph - 1) % 6;
            if (k == 0 || k == 4) {
                if (k == 0) {
                    pg8::Gemm g{XN, (const bf16_t*)(ws + WS_WIN) + (size_t)l * DINP * DM, M_TOK, DINP, DM}; pg8::StaticOrder S; S.init(M_TOK, DINP, G, bx);
                    pg8::EpiBf16<0> E{H, DINP, nullptr, 0, 0, 1.f};
                    pg8::gemm_phase<pg8::EpiBf16<0>, pg8::StaticOrder, true, true>(lds, g, S, E);
                } else {
                    pg8::Gemm g{XN, (const bf16_t*)(ws + WS_WOUT) + (size_t)l * DM * DM, M_TOK, DM, DM}; pg8::StaticOrder S; S.init(M_TOK, DM, G, bx);
                    pg8::EpiBf16<0> E{Y, DM, nullptr, 0, 0, 1.f};
                    pg8::gemm_phase<pg8::EpiBf16<0>, pg8::StaticOrder, true, true>(lds, g, S, E);
                }
            } else if (k == 1) {
                const bf16_t* WUQ = (const bf16_t*)(ws + WS_WUQ + (size_t)l * 262144);
                const bf16_t* WUKV = (const bf16_t*)(ws + WS_WUKV + (size_t)l * 131072);
                constexpr int NTB = M_TOK / 32;
                constexpr int U_MQ = NTB * 4, U_MKV = NTB * 4, U_VTA = NTB * 2, U_VTD = NTB * 4, U_CONV = M_TOK / 8;
                constexpr int U_ALL = U_MQ + U_MKV + U_VTA + U_VTD + U_CONV;
                for (int u = gw; u < U_ALL; u += NGW) {
                    int v = u;
                    if (v < U_MQ) { mq_unit(H, WUQ, P.pos, QC, v >> 2, v & 3, lane); continue; } v -= U_MQ;
                    if (v < U_MKV) { mkv_unit(H, WUKV, P.pos, KC, VTC, v >> 2, v & 3, lane, stg); continue; } v -= U_MKV;
                    if (v < U_VTA) { vt_unit(H, C_AV, 2, VTA, v >> 1, v & 1, lane, stg); continue; } v -= U_VTA;
                    if (v < U_VTD) { vt_unit(H, C_DV, 4, VTD, v >> 2, v & 3, lane, stg); continue; } v -= U_VTD;
                    conv_unit(H, P.conv_w + l * 768, P.conv_b + l * 256, Y, v, lane);
                }
            } else if (k == 2) {
                if (rep == 0 || MK_REP_K == 2)
                for (int pu = bx; pu < 256; pu += G) {
                    const int bh = pu & 7, Gq = pu >> 3;
                    mla_unit_blk(QC, KC, VTC, Y, bh, 63 - Gq, lds, tid);
                    mla_unit_blk(QC, KC, VTC, Y, bh, Gq, lds, tid);
                }
                if (rep == 0 || MK_REP_K == 6) {
                    const int bh = bx & 7, G8 = bx >> 3, b = bh >> 2, hh = bh & 3, qb = 8 * G8 + wave;
                    const size_t row0 = (size_t)b * SEQ + 32 * qb;
                    LAS bf16_t* ostg = (LAS bf16_t*)(lds + STG_OFF + wave * 4096);
                    {
                        const int kvh = hh >> 1;
                        const bf16_t* Kb = H + (size_t)b * SEQ * DINP + C_AK + kvh * 64;
                        const bf16_t* VT = VTA + (size_t)(b * 2 + kvh) * 64 * SEQ;
                        stage_kv64<SWA_NK, SWA_VP>(Kb, DINP, VT, 256 * G8 - 128, lds, tid);
                        __syncthreads();
                        swa_wave_lds(H + row0 * DINP + C_AQ + hh * 64, DINP, lds, qb, 8 * G8 - 4, P.sinks[l * 4 + hh] * LOG2E, Y + row0 * DM + hh * 64, DM, lane, ostg);
                        __syncthreads();
                    }
                    {
                        const bf16_t* Kb = H + (size_t)b * SEQ * DINP + C_DK + hh * 64;
                        const bf16_t* VT = VTD + (size_t)(b * 4 + hh) * 64 * SEQ;
                        stage_kv64<SB_NK, SB_VP>(Kb, DINP, VT, 256 * G8 - 192, lds, tid);
                        __syncthreads();
                        sb_wave_lds(H + row0 * DINP + C_DQ + hh * 64, DINP, lds, Kb, DINP, VT, qb, 8 * G8 - 6, Y + row0 * DM + 768 + hh * 64, DM, lane, ostg);
                        __syncthreads();
                    }
                }
            } else if (k == 3) {
                const bf16_t* __restrict__ Yr = Y; const bf16_t* __restrict__ Hr = H; bf16_t* __restrict__ XNw = XN;
#pragma unroll 2
                for (int mrow = gw; mrow < M_TOK; mrow += NGW) {
                    const u32x4* yp = (const u32x4*)(Yr + (size_t)mrow * DM) + 2 * lane;
                    const u32x4* gp = (const u32x4*)(Hr + (size_t)mrow * DINP + C_GATE) + 2 * lane;
                    const u32x4 y0 = yp[0], y1 = yp[1], g0 = gp[0], g1 = gp[1];
                    float yv[16], gv[16];
#pragma unroll
                    for (int j = 0; j < 4; ++j) { yv[2 * j] = bflo(y0[j]); yv[2 * j + 1] = bfhi(y0[j]); yv[8 + 2 * j] = bflo(y1[j]); yv[8 + 2 * j + 1] = bfhi(y1[j]);
                                                  gv[2 * j] = bflo(g0[j]); gv[2 * j + 1] = bfhi(g0[j]); gv[8 + 2 * j] = bflo(g1[j]); gv[8 + 2 * j + 1] = bfhi(g1[j]); }
                    float ss = 0.f;
#pragma unroll
                    for (int j = 0; j < 16; ++j) ss += yv[j] * yv[j];
                    ss += __shfl_xor(ss, 1); ss += __shfl_xor(ss, 2); ss += __shfl_xor(ss, 4); ss += __shfl_xor(ss, 8);
                    const float rs = rsqrtf(ss * (1.f / 256.f) + EPS);
                    float o[16];
#pragma unroll
                    for (int j = 0; j < 16; ++j) { const float gg = gv[j]; o[j] = yv[j] * rs * gg * __builtin_amdgcn_rcpf(1.f + ex2(-gg * LOG2E)); }
                    u32x4 w0, w1;
#pragma unroll
                    for (int j = 0; j < 4; ++j) { w0[j] = pk2(o[2 * j], o[2 * j + 1]); w1[j] = pk2(o[8 + 2 * j], o[8 + 2 * j + 1]); }
                    u32x4* op = (u32x4*)(XNw + (size_t)mrow * DM) + 2 * lane;
                    op[0] = w0; op[1] = w1;
                }
            } else {
                const float* base = (l == 0) ? P.x : P.out;
                const float* gpost = P.g_post + l * DM;
                for (int mrow0 = gw; mrow0 < M_TOK; mrow0 += 2 * NGW) {
                    f32x4 zz[2][4], xv[2][4]; float s1[2] = {0.f, 0.f}, s2[2] = {0.f, 0.f};
                    const bool two = (mrow0 + NGW < M_TOK);
#pragma unroll
                    for (int rr = 0; rr < 2; ++rr) { const int mrow = (rr == 0 || two) ? mrow0 + rr * NGW : mrow0;
#pragma unroll
                        for (int j = 0; j < 4; ++j) { const u32x2 w = ((const u32x2*)(Y + (size_t)mrow * DM))[lane + 64 * j]; zz[rr][j] = (f32x4){bflo(w.x), bfhi(w.x), bflo(w.y), bfhi(w.y)};
                            xv[rr][j] = ((const f32x4*)(base + (size_t)mrow * DM))[lane + 64 * j]; } }
                    f32x4 gpv[4];
#pragma unroll
                    for (int j = 0; j < 4; ++j) gpv[j] = ((const f32x4*)gpost)[lane + 64 * j];
#pragma unroll
                    for (int rr = 0; rr < 2; ++rr)
#pragma unroll
                        for (int j = 0; j < 4; ++j) s1[rr] += (zz[rr][j].x * zz[rr][j].x + zz[rr][j].y * zz[rr][j].y) + (zz[rr][j].z * zz[rr][j].z + zz[rr][j].w * zz[rr][j].w);
                    const float rz0 = rsqrtf(wave_sum(s1[0]) * (1.f / DM) + EPS), rz1 = rsqrtf(wave_sum(s1[1]) * (1.f / DM) + EPS);
#pragma unroll
                    for (int rr = 0; rr < 2; ++rr) { const float rz = rr ? rz1 : rz0;
#pragma unroll
                        for (int j = 0; j < 4; ++j) { xv[rr][j] = xv[rr][j] + zz[rr][j] * rz * gpv[j];
                            s2[rr] += (xv[rr][j].x * xv[rr][j].x + xv[rr][j].y * xv[rr][j].y) + (xv[rr][j].z * xv[rr][j].z + xv[rr][j].w * xv[rr][j].w); } }
#pragma unroll
                    for (int rr = 0; rr < 2; ++rr) { if (rr == 1 && !two) break; const int mrow = mrow0 + rr * NGW;
#pragma unroll
                        for (int j = 0; j < 4; ++j) ((f32x4*)(P.out + (size_t)mrow * DM))[lane + 64 * j] = xv[rr][j]; }
                    if (l + 1 < NLAYER) {
                        const float r0 = rsqrtf(wave_sum(s2[0]) * (1.f / DM) + EPS), r1 = rsqrtf(wave_sum(s2[1]) * (1.f / DM) + EPS);
#pragma unroll
                        for (int rr = 0; rr < 2; ++rr) { if (rr == 1 && !two) break; const int mrow = mrow0 + rr * NGW; const float rs = rr ? r1 : r0;
#pragma unroll
                            for (int j = 0; j < 4; ++j) { u32x2 o; o.x = pk2(xv[rr][j].x * rs, xv[rr][j].y * rs); o.y = pk2(xv[rr][j].z * rs, xv[rr][j].w * rs); ((u32x2*)(XN + (size_t)mrow * DM))[lane + 64 * j] = o; } }
                    }
                }
            }
            }
        }
        if (ph + 1 < P.ph_hi) {
#if MK_COOP
            if (P.ph_hi < 0) grid.sync();
            xcd_barrier(bar);
#endif
        }
    }
}
}

extern "C" void kernel_launch(void* const* d_in, const int* in_sizes, int n_in, void* d_out, int out_size, void* d_ws, size_t ws_size, hipStream_t stream) {
    using namespace mk;
    static int grid = 0;
    if (grid == 0) {
        if (n_in != 14 || out_size != M_TOK * DM || ws_size < WS_END) { fprintf(stderr, "kernel_launch: unexpected shapes (n_in %d out %d ws %zu)\n", n_in, out_size, ws_size); grid = -1; return; }
        int dev = 0, cus = 0, per_cu = 0;
        (void)hipGetDevice(&dev); (void)hipDeviceGetAttribute(&cus, hipDeviceAttributeMultiprocessorCount, dev);
        if (hipFuncSetAttribute((const void*)fwd, hipFuncAttributeMaxDynamicSharedMemorySize, LDS_BYTES) != hipSuccess) { fprintf(stderr, "kernel_launch: hipFuncSetAttribute failed\n"); grid = -1; return; }
        if (hipOccupancyMaxActiveBlocksPerMultiprocessor(&per_cu, (const void*)fwd, NTHREADS, LDS_BYTES) != hipSuccess || per_cu < 1) { fprintf(stderr, "kernel_launch: occupancy query says %d\n", per_cu); per_cu = 1; }
        (void)hipGetLastError();
        if (cus < 256) { fprintf(stderr, "kernel_launch: built for a 256-CU device (one workgroup per CU), found %d CUs\n", cus); grid = -1; return; }
        grid = 256;
    }
    if (grid < 0) return;
    (void)hipMemsetAsync((char*)d_ws + WS_CTL, 0, CTL_BYTES, stream);
    Params p{};
    p.x = (const float*)d_in[0]; p.pos = (const int*)d_in[1]; p.norm_pre = (const float*)d_in[2]; p.w_in = (const float*)d_in[3]; p.sinks = (const float*)d_in[4];
    p.conv_w = (const float*)d_in[5]; p.conv_b = (const float*)d_in[6]; p.g_cq = (const float*)d_in[7]; p.w_uq = (const float*)d_in[8]; p.g_ckv = (const float*)d_in[9];
    p.w_ukv = (const float*)d_in[10]; p.g_grp = (const float*)d_in[11]; p.w_out = (const float*)d_in[12]; p.g_post = (const float*)d_in[13];
    p.out = (float*)d_out; p.ws = (unsigned char*)d_ws;
    constexpr int NPH = 1 + 6 * NLAYER;
#if MK_COOP
    p.ph_lo = 0; p.ph_hi = NPH;
    void* args[] = {&p};
    hipError_t e = hipLaunchCooperativeKernel((const void*)fwd, dim3(grid), dim3(NTHREADS), args, LDS_BYTES, stream);
    if (e != hipSuccess) fprintf(stderr, "kernel_launch: cooperative launch failed: %s (grid %d)\n", hipGetErrorString(e), grid);
#else
    for (int ph = 0; ph < NPH; ++ph) { p.ph_lo = ph; p.ph_hi = ph + 1; hipLaunchKernelGGL(fwd, dim3(grid), dim3(NTHREADS), LDS_BYTES, stream, p); }
#endif
}
```

```cpp
#include <hip/hip_runtime.h>
#include <hip/hip_cooperative_groups.h>
#include <cstdio>
#include <cstdint>
#include <cmath>
namespace pg8 {
#define PG8_LAS __attribute__((address_space(3)))
typedef unsigned short bf16_t;
typedef short bf16x8 __attribute__((ext_vector_type(8)));
typedef float f32x4 __attribute__((ext_vector_type(4)));
typedef unsigned u32x4 __attribute__((ext_vector_type(4)));
constexpr int BM = 256, BK = 64, HALF = 128, HTB = HALF * BK * 2  , STAGE_BYTES = 8 * HTB, NXCD = 8, WGM = 8;

__host__ __device__ __forceinline__ int lds_byte(int r, int c) { const int st = (r >> 4) * 2 + (c >> 5), rr = r & 15, cc = c & 31, ob = rr * 64 + cc * 2; return st * 1024 + (ob ^ (((ob >> 9) & 1) << 5)); }
__host__ __device__ __forceinline__ void stage_rc(int b, int& R, int& C) { const int st = b / 1024, sb = b % 1024, swz = sb ^ (((sb >> 9) & 1) << 5); R = (st >> 1) * 16 + swz / 64; C = (st & 1) * 32 + (swz % 64) / 2; }
__host__ __device__ __forceinline__ int perm32(int rho) { const int n = rho >> 4, i = rho & 15; return 8 * (i >> 2) + 4 * n + (i & 3); }

struct Unit { int pm, pn; };
struct Gemm { const bf16_t* A; const bf16_t* Bt; int M, N, K; };

struct StaticOrder {
    int nM, nN, nwg, G, c;
    __host__ __device__ void init(int M, int N, int G_, int c_) { nM = M / BM; nN = N / BM; nwg = nM * nN; G = G_; c = c_; }
    __host__ __device__ bool next(int i, Unit& u) const {
        const long L = (long)i * G + c; if (L >= nwg) return false;
        int wgid = (int)L; { const int q = nwg / NXCD, r = nwg % NXCD, xcd = wgid % NXCD, off = wgid / NXCD; wgid = (xcd < r ? xcd * (q + 1) : r * (q + 1) + (xcd - r) * q) + off; }
        const int nig = WGM * nN, gid = wgid / nig, fm = gid * WGM, gsz = (nM - fm) < WGM ? (nM - fm) : WGM;
        u.pm = fm + ((wgid % nig) % gsz); u.pn = (wgid % nig) / gsz; return true;
    }
    __device__ __forceinline__ void a_ready(const Unit&) const {}
    __device__ __forceinline__ void done(const Unit&) const {}
};

__device__ __forceinline__ unsigned cvt_pk_bf16(float lo, float hi) { unsigned r; asm volatile("v_cvt_pk_bf16_f32 %0, %1, %2" : "=v"(r) : "v"(lo), "v"(hi)); return r; }
typedef float f32x2 __attribute__((ext_vector_type(2)));
__device__ __forceinline__ f32x2 gelu_pk(f32x2 v) {
    const f32x2 av = __builtin_elementwise_abs(v), d = av * 0.2316418882f + 1.0f;
    f32x2 t; t.x = __builtin_amdgcn_rcpf(d.x); t.y = __builtin_amdgcn_rcpf(d.y);
    f32x2 q = t * 0.5307027145f + (-0.7265760135f); q = q * t + 0.7107068705f; q = q * t + (-0.142248368f); q = q * t + 0.127414796f; q = q * t;
    const f32x2 s = (v * v) * (-0.72134752044f);
    f32x2 e; e.x = __builtin_amdgcn_exp2f(s.x); e.y = __builtin_amdgcn_exp2f(s.y);
    const f32x2 m = v * (q * e), r = v - m;
    f32x2 o; o.x = v.x < 0.f ? m.x : r.x; o.y = v.y < 0.f ? m.y : r.y; return o;
}

template <int ACT  > struct EpiBf16 {
    static constexpr bool PERM = true, AFTER_DRAIN = false; static_assert(ACT == 0 || ACT == 1, "EpiBf16: ACT is 0 (none) or 1 (gelu_pk)");
    bf16_t* O; int ldc; const float* bias; int split_cols; size_t split_stride; float scale0;
    __device__ __forceinline__ void operator()(const f32x4 (&acc)[2][2][4][2], const Unit& u, int wr, int wc, int fr, int fq) const {
        const int row0 = u.pm * BM + wr * 64 + fr; int colt = u.pn * BM; bf16_t* base = O;
        float sc = 1.f; if (split_cols) { const int t = colt / split_cols; base += (size_t)t * split_stride; colt -= t * split_cols; if (t == 0) sc = scale0; }
        const int col0 = colt + wc * 32 + 8 * fq, bcol0 = u.pn * BM + wc * 32 + 8 * fq;
        f32x4 bv[2][2];
#pragma unroll
        for (int bj = 0; bj < 2; ++bj)
#pragma unroll
            for (int n = 0; n < 2; ++n) bv[bj][n] = bias ? *(const f32x4*)(bias + bcol0 + bj * HALF + 4 * n) : (f32x4){0.f, 0.f, 0.f, 0.f};
#pragma unroll
        for (int ai = 0; ai < 2; ++ai)
#pragma unroll
            for (int m = 0; m < 4; ++m) { bf16_t* rowp = base + (size_t)(row0 + ai * HALF + m * 16) * ldc + col0;
#pragma unroll
                for (int bj = 0; bj < 2; ++bj) { f32x4 v0 = acc[ai][bj][m][0] + bv[bj][0], v1 = acc[ai][bj][m][1] + bv[bj][1];
                    if (ACT == 1) { f32x2 a = gelu_pk((f32x2){v0[0], v0[1]}), b = gelu_pk((f32x2){v0[2], v0[3]}), c = gelu_pk((f32x2){v1[0], v1[1]}), d = gelu_pk((f32x2){v1[2], v1[3]});
                        v0 = (f32x4){a.x, a.y, b.x, b.y}; v1 = (f32x4){c.x, c.y, d.x, d.y}; }
                    v0 = v0 * sc; v1 = v1 * sc; u32x4 w; w.x = cvt_pk_bf16(v0[0], v0[1]); w.y = cvt_pk_bf16(v0[2], v0[3]); w.z = cvt_pk_bf16(v1[0], v1[1]); w.w = cvt_pk_bf16(v1[2], v1[3]);
                    *(u32x4*)(rowp + bj * HALF) = w; } }
    }
};
template <class Epi, class Sched, bool ALIGN_EPI = false, bool SP2 = false>
__device__ __forceinline__ void gemm_phase(PG8_LAS unsigned char* lds, const Gemm g, const Sched& S, const Epi& E) {
    int tid_o = threadIdx.x; asm volatile("" : "+v"(tid_o));
    const int tid = tid_o, wid = __builtin_amdgcn_readfirstlane(tid >> 6), lane = tid & 63, wr = wid >> 2, wc = wid & 3, fr = lane & 15, fq = lane >> 4;
    const int K = g.K, nt = K / BK;
    unsigned voffA[2], voffB[2];
#pragma unroll
    for (int i = 0; i < 2; ++i) { int R, C; stage_rc(tid * 16 + i * 8192, R, C); const int Rb = Epi::PERM ? ((R & ~31) + perm32(R & 31)) : R;
        voffA[i] = (unsigned)(R * K + C) * 2u; voffB[i] = (unsigned)(Rb * K + C) * 2u; }
    const size_t kstep = (size_t)(BK * 2);
    const size_t hstep = (size_t)HALF * K * 2;
    const size_t tstep = 2 * hstep;
    const unsigned ldsw = (unsigned)wid * 1024u;
    const int aoff = lds_byte(wr * 64 + fr, fq * 8), boff = lds_byte(wc * 32 + fr, fq * 8);
#define PG8_SA(b, h) (((b) * 2 + (h)) * HTB)
#define PG8_SB(b, h) ((4 + (b) * 2 + (h)) * HTB)
#define PG8_STAGE(bufoff, gbase, voff) do { _Pragma("unroll") for (int _i = 0; _i < 2; ++_i) \
        __builtin_amdgcn_global_load_lds((const unsigned*)((const char*)(gbase) + (voff)[_i]), (PG8_LAS unsigned*)(lds + (bufoff) + ldsw + _i * 8192), 16, 0, 0); } while (0)
#define PG8_LDA(dst, b, h) do { _Pragma("unroll") for (int m = 0; m < 4; ++m) _Pragma("unroll") for (int k = 0; k < 2; ++k) dst[m][k] = *(const PG8_LAS bf16x8*)(lds + PG8_SA(b, h) + aoff + m * 2048 + k * 1024); } while (0)
#define PG8_LDB(dst, b, h) do { _Pragma("unroll") for (int n = 0; n < 2; ++n) _Pragma("unroll") for (int k = 0; k < 2; ++k) dst[n][k] = *(const PG8_LAS bf16x8*)(lds + PG8_SB(b, h) + boff + n * 2048 + k * 1024); } while (0)
#define PG8_MMA(ai, bj, At, Bt) do { __builtin_amdgcn_s_setprio(1); _Pragma("unroll") for (int m = 0; m < 4; ++m) _Pragma("unroll") for (int n = 0; n < 2; ++n) _Pragma("unroll") for (int k = 0; k < 2; ++k) \
        acc[ai][bj][m][n] = __builtin_amdgcn_mfma_f32_16x16x32_bf16(Bt[n][k], At[m][k], acc[ai][bj][m][n], 0, 0, 0); __builtin_amdgcn_s_setprio(0); } while (0)
#define PG8_WAIT_V(n) asm volatile("s_waitcnt vmcnt(" #n ")" ::: "memory")
#define PG8_WAIT_L(n) asm volatile("s_waitcnt lgkmcnt(" #n ")" ::: "memory")
#define PG8_BAR __builtin_amdgcn_s_barrier()
#define PG8_SCHED __builtin_amdgcn_sched_barrier(0)
    Unit cur, nxt; int ui = 0;
    if (!S.next(0, cur)) return;
    f32x4 acc[2][2][4][2];
#pragma unroll
    for (int a = 0; a < 2; ++a)
#pragma unroll
        for (int b = 0; b < 2; ++b)
#pragma unroll
            for (int m = 0; m < 4; ++m)
#pragma unroll
                for (int n = 0; n < 2; ++n) acc[a][b][m][n] = (f32x4){0.f, 0.f, 0.f, 0.f};
    bf16x8 At[4][2], B0[2][2], B1[2][2];
    const char* cA = (const char*)g.A + (size_t)cur.pm * tstep; const char* cB = (const char*)g.Bt + (size_t)cur.pn * tstep;
    S.a_ready(cur);
    if constexpr (SP2) {
        PG8_STAGE(PG8_SB(0, 0), cB, voffB); PG8_STAGE(PG8_SB(0, 1), cB + hstep, voffB); PG8_STAGE(PG8_SA(0, 0), cA, voffA); PG8_STAGE(PG8_SA(0, 1), cA + hstep, voffA);
        if (wr == 1) PG8_BAR;
        PG8_WAIT_V(2); PG8_BAR;
        PG8_STAGE(PG8_SB(1, 0), cB + kstep, voffB); PG8_STAGE(PG8_SA(1, 0), cA + kstep, voffA); PG8_STAGE(PG8_SB(1, 1), cB + hstep + kstep, voffB);
        PG8_WAIT_V(6); PG8_BAR;
    } else {
        PG8_STAGE(PG8_SB(0, 0), cB, voffB); PG8_STAGE(PG8_SA(0, 0), cA, voffA); PG8_STAGE(PG8_SB(0, 1), cB + hstep, voffB); PG8_STAGE(PG8_SA(0, 1), cA + hstep, voffA);
        if (wr == 1) PG8_BAR;
        PG8_WAIT_V(4); PG8_BAR;
        PG8_STAGE(PG8_SB(1, 0), cB + kstep, voffB); PG8_STAGE(PG8_SA(1, 0), cA + kstep, voffA); PG8_STAGE(PG8_SB(1, 1), cB + hstep + kstep, voffB);
        PG8_WAIT_V(6); PG8_BAR;
    }
    for (;;) {
        const bool has_next = S.next(ui + 1, nxt);
        const char* nA = has_next ? (const char*)g.A + (size_t)nxt.pm * tstep : cA; const char* nB = has_next ? (const char*)g.Bt + (size_t)nxt.pn * tstep : cB;
        for (int t = 0; t < nt; t += 2) {
            const bool last = (t == nt - 2);
            const char* a1 = cA + (size_t)(t + 1) * kstep;
            const char* a2 = last ? nA : cA + (size_t)(t + 2) * kstep; const char* b2 = last ? nB : cB + (size_t)(t + 2) * kstep;
            const char* a3 = a2 + kstep; const char* b3 = b2 + kstep;
            if (last && has_next) S.a_ready(nxt);
            if constexpr (SP2) {
            PG8_LDB(B0, 0, 0); PG8_LDB(B1, 0, 1); PG8_SCHED; PG8_LDA(At, 0, 0); PG8_STAGE(PG8_SA(1, 1), a1 + hstep, voffA);
            PG8_WAIT_V(8); PG8_WAIT_L(0); PG8_BAR; PG8_MMA(0, 0, At, B0); PG8_MMA(0, 1, At, B1); PG8_BAR; PG8_SCHED;
            PG8_LDA(At, 0, 1); PG8_STAGE(PG8_SB(0, 0), b2, voffB); PG8_STAGE(PG8_SB(0, 1), b2 + hstep, voffB); PG8_STAGE(PG8_SA(0, 0), a2, voffA);
            PG8_WAIT_V(8); PG8_WAIT_L(0); PG8_BAR; PG8_MMA(1, 0, At, B0); PG8_MMA(1, 1, At, B1); PG8_BAR; PG8_SCHED;
            PG8_LDB(B0, 1, 0); PG8_LDB(B1, 1, 1); PG8_SCHED; PG8_LDA(At, 1, 0); PG8_STAGE(PG8_SA(0, 1), a2 + hstep, voffA);
            PG8_WAIT_V(8); PG8_WAIT_L(0); PG8_BAR; PG8_MMA(0, 0, At, B0); PG8_MMA(0, 1, At, B1); PG8_BAR; PG8_SCHED;
            PG8_LDA(At, 1, 1); PG8_STAGE(PG8_SB(1, 0), b3, voffB); PG8_STAGE(PG8_SB(1, 1), b3 + hstep, voffB); PG8_STAGE(PG8_SA(1, 0), a3, voffA);
            PG8_WAIT_V(8); PG8_WAIT_L(0); PG8_BAR; PG8_MMA(1, 0, At, B0); PG8_MMA(1, 1, At, B1); PG8_BAR; PG8_SCHED;
            } else {
            PG8_LDB(B0, 0, 0); PG8_SCHED; PG8_LDA(At, 0, 0); PG8_STAGE(PG8_SA(1, 1), a1 + hstep, voffA);
            PG8_WAIT_L(8); PG8_BAR; PG8_WAIT_L(0); PG8_MMA(0, 0, At, B0); PG8_BAR; PG8_SCHED;
            PG8_LDB(B1, 0, 1); PG8_STAGE(PG8_SB(0, 0), b2, voffB);
            PG8_BAR; PG8_WAIT_L(0); PG8_MMA(0, 1, At, B1); PG8_BAR;
            PG8_LDA(At, 0, 1); PG8_STAGE(PG8_SA(0, 0), a2, voffA);
            PG8_BAR; PG8_WAIT_L(0); PG8_MMA(1, 0, At, B0); PG8_BAR; PG8_SCHED;
            PG8_STAGE(PG8_SB(0, 1), b2 + hstep, voffB);
            PG8_WAIT_V(6); PG8_BAR; PG8_MMA(1, 1, At, B1); PG8_BAR;
            PG8_LDB(B0, 1, 0); PG8_SCHED; PG8_LDA(At, 1, 0); PG8_STAGE(PG8_SA(0, 1), a2 + hstep, voffA);
            PG8_WAIT_L(8); PG8_BAR; PG8_WAIT_L(0); PG8_MMA(0, 0, At, B0); PG8_BAR; PG8_SCHED;
            PG8_LDB(B1, 1, 1); PG8_STAGE(PG8_SB(1, 0), b3, voffB);
            PG8_BAR; PG8_WAIT_L(0); PG8_MMA(0, 1, At, B1); PG8_BAR;
            PG8_LDA(At, 1, 1); PG8_STAGE(PG8_SA(1, 0), a3, voffA);
            PG8_BAR; PG8_WAIT_L(0); PG8_MMA(1, 0, At, B0); PG8_BAR; PG8_SCHED;
            PG8_STAGE(PG8_SB(1, 1), b3 + hstep, voffB);
            PG8_WAIT_V(6); PG8_BAR; PG8_MMA(1, 1, At, B1); PG8_BAR;
            }
        }
        if constexpr (ALIGN_EPI) { if (wr == 0) PG8_BAR; }
        if constexpr (!Epi::AFTER_DRAIN) { E(acc, cur, wr, wc, fr, fq); S.done(cur); }
        if (!has_next) break;
#pragma unroll
        for (int a = 0; a < 2; ++a)
#pragma unroll
            for (int b = 0; b < 2; ++b)
#pragma unroll
                for (int m = 0; m < 4; ++m)
#pragma unroll
                    for (int n = 0; n < 2; ++n) acc[a][b][m][n] = (f32x4){0.f, 0.f, 0.f, 0.f};
        cur = nxt; cA = nA; cB = nB; ++ui;
        if constexpr (ALIGN_EPI) { if (wr == 1) PG8_BAR; }
    }
    PG8_WAIT_V(0);
    if constexpr (!ALIGN_EPI) { if (wr == 0) PG8_BAR; }
    PG8_BAR;
    if constexpr (Epi::AFTER_DRAIN) { E.fused(acc, cur, wr, wc, fr, fq, lds, wid, lane); S.done(cur); }
#undef PG8_SA
#undef PG8_SB
#undef PG8_STAGE
#undef PG8_LDA
#undef PG8_LDB
#undef PG8_MMA
#undef PG8_WAIT_V
#undef PG8_WAIT_L
#undef PG8_BAR
#undef PG8_SCHED
}
}
#ifndef MK_COOP
#define MK_COOP 1
#endif
#ifndef MK_REP_K
#define MK_REP_K -1
#endif
#ifndef MK_REP_N
#define MK_REP_N 1
#endif
namespace mk {
using pg8::bf16_t; using pg8::bf16x8; using pg8::f32x4; using pg8::u32x4;
typedef float f32x16 __attribute__((ext_vector_type(16)));
typedef unsigned u32x2 __attribute__((ext_vector_type(2)));
typedef float f32x2_t __attribute__((ext_vector_type(2)));
typedef __bf16 bf16x2_t __attribute__((ext_vector_type(2)));
#define LAS __attribute__((address_space(3)))
#define MFMA32(a, b, c) __builtin_amdgcn_mfma_f32_32x32x16_bf16((a), (b), (c), 0, 0, 0)

constexpr int M_TOK = 16384, SEQ = 8192, DM = 1024, DIN = 3488, DINP = 3584, NLAYER = 2;
constexpr int C_AQ = 0, C_AK = 256, C_AV = 384, C_BB = 512, C_BC = 768, C_BX = 1024, C_CQ = 1280, C_CKV = 1536, C_CKR = 1664,
              C_DQ = 1696, C_DK = 1952, C_DV = 2208, C_GATE = 2464;
constexpr float EPS = 1e-6f, LOG2E = 1.4426950408889634f;
constexpr float SC64 = 0.125f * LOG2E;
constexpr float QSC_MLA = 0.10206207261596575f * LOG2E;
constexpr int NWAVES = 8, NTHREADS = 512;
constexpr int LDS_BYTES = 122880 + 8 * 4096 + 1024;

constexpr size_t MiB = 1u << 20;
constexpr size_t WS_CTL = 0, CTL_BYTES = 65536;
constexpr int CW_BAR = 1024;
constexpr size_t WS_WIN = 1 * MiB;
constexpr size_t WS_WOUT = 15 * MiB;
constexpr size_t WS_WUQ = 19 * MiB;
constexpr size_t WS_WUKV = 19 * MiB + 512 * 1024;
constexpr size_t WS_XN = 32 * MiB;
constexpr size_t WS_H = 64 * MiB;
constexpr size_t WS_QC = 176 * MiB;
constexpr size_t WS_KC = 188 * MiB;
constexpr size_t WS_VTC = 200 * MiB;
constexpr size_t WS_VTA = 208 * MiB;
constexpr size_t WS_VTD = 212 * MiB;
constexpr size_t WS_Y = 220 * MiB;
constexpr size_t WS_END = 252 * MiB;

struct Params {
    const float* x; const int* pos; const float* norm_pre; const float* w_in; const float* sinks; const float* conv_w; const float* conv_b;
    const float* g_cq; const float* w_uq; const float* g_ckv; const float* w_ukv; const float* g_grp; const float* w_out; const float* g_post;
    float* out; unsigned char* ws; int ph_lo, ph_hi;
};

__device__ __forceinline__ unsigned pk2(float lo, float hi) { f32x2_t v = {lo, hi}; bf16x2_t b = __builtin_convertvector(v, bf16x2_t); return __builtin_bit_cast(unsigned, b); }
__device__ __forceinline__ float bf2f(short s) { return __uint_as_float(((unsigned)(unsigned short)s) << 16); }
__device__ __forceinline__ float bflo(unsigned u) { return __uint_as_float(u << 16); }
__device__ __forceinline__ float bfhi(unsigned u) { return __uint_as_float(u & 0xffff0000u); }
__device__ __forceinline__ bf16_t f2bf(float f) { return (bf16_t)(pk2(f, 0.f) & 0xffffu); }
__device__ __forceinline__ int crow(int i, int h) { return (i & 3) + 8 * (i >> 2) + 4 * h; }
__device__ __forceinline__ float ex2(float x) { return __builtin_amdgcn_exp2f(x); }
__device__ __forceinline__ float lg2(float x) { return __builtin_amdgcn_logf(x); }
__device__ __forceinline__ float wave_sum(float v) {
#pragma unroll
    for (int o = 1; o < 64; o <<= 1) v += __shfl_xor(v, o);
    return v;
}
__device__ __forceinline__ bf16x8 pack8(const float* e) {
    u32x4 w; w.x = pk2(e[0], e[1]); w.y = pk2(e[2], e[3]); w.z = pk2(e[4], e[5]); w.w = pk2(e[6], e[7]);
    return __builtin_bit_cast(bf16x8, w);
}

__device__ __forceinline__ void conv_wT(const float* __restrict__ W, int K, int N, int NP, const float* __restrict__ gain, bf16_t* __restrict__ dst,
                                        int a0, int a1, int b0, int b1, float sc, int gtid, int gthreads) {
    const int k8n = K / 8; const int items = NP * k8n;
#pragma unroll 2
    for (int it = gtid; it < items; it += gthreads) {
        const int n = it % NP, k8 = it / NP;
        u32x4 o = {0u, 0u, 0u, 0u};
        if (n < N) {
            const float cs = ((n >= a0 && n < a1) || (n >= b0 && n < b1)) ? sc : 1.f;
            float v[8];
#pragma unroll
            for (int j = 0; j < 8; ++j) v[j] = W[(size_t)(k8 * 8 + j) * N + n] * gain[k8 * 8 + j] * cs;
            o.x = pk2(v[0], v[1]); o.y = pk2(v[2], v[3]); o.z = pk2(v[4], v[5]); o.w = pk2(v[6], v[7]);
        }
        *(u32x4*)(dst + (size_t)n * K + k8 * 8) = o;
    }
}
__device__ __forceinline__ void wT_item(const float* __restrict__ W, int K, int N, const float* __restrict__ gain, bf16_t* __restrict__ WT, int a0, int a1, int b0, int b1, float sc,
                                        LAS float* scr, int item, int lane) {
    const int nblk = N / 32, kb = item / nblk, nb = item - kb * nblk, k0 = 64 * kb, n0 = 32 * nb;
#pragma unroll 8
    for (int i = 0; i < 32; ++i) { const int kk = 2 * i + (lane >> 5); scr[kk * 33 + (lane & 31)] = W[(size_t)(k0 + kk) * N + n0 + (lane & 31)]; }
    const int c = lane & 7;
    float g8[8];
#pragma unroll
    for (int j = 0; j < 8; ++j) g8[j] = gain[k0 + 8 * c + j];
#pragma unroll
    for (int j = 0; j < 4; ++j) { const int n = (lane >> 3) + 8 * j, nn = n0 + n; const LAS float* sp = scr + (8 * c) * 33 + n;
        const float cs = ((nn >= a0 && nn < a1) || (nn >= b0 && nn < b1)) ? sc : 1.f;
        u32x4 o; o.x = pk2(sp[0 * 33] * g8[0] * cs, sp[1 * 33] * g8[1] * cs); o.y = pk2(sp[2 * 33] * g8[2] * cs, sp[3 * 33] * g8[3] * cs);
        o.z = pk2(sp[4 * 33] * g8[4] * cs, sp[5 * 33] * g8[5] * cs); o.w = pk2(sp[6 * 33] * g8[6] * cs, sp[7 * 33] * g8[7] * cs);
        *(u32x4*)(WT + (size_t)nn * K + k0 + 8 * c) = o; }
}
__device__ __forceinline__ void rms_row_to_bf16(const float* __restrict__ xrow, bf16_t* __restrict__ orow, int lane) {
    f32x4 v[4]; float s = 0.f;
#pragma unroll
    for (int j = 0; j < 4; ++j) { v[j] = ((const f32x4*)xrow)[lane + 64 * j]; s += (v[j].x * v[j].x + v[j].y * v[j].y) + (v[j].z * v[j].z + v[j].w * v[j].w); }
    const float rs = rsqrtf(wave_sum(s) * (1.f / DM) + EPS);
#pragma unroll
    for (int j = 0; j < 4; ++j) { u32x2 o; o.x = pk2(v[j].x * rs, v[j].y * rs); o.y = pk2(v[j].z * rs, v[j].w * rs); ((u32x2*)orow)[lane + 64 * j] = o; }
}

__device__ __forceinline__ void rope_cs(int pos, int h, float (&cs)[8], float (&sn)[8]) {
#pragma unroll
    for (int i = 0; i < 8; ++i) {
        const int f = (i & 3) + 8 * (i >> 2) + 4 * h;
        const float freq = ex2(-(float)f * 0.830482023721841f);
        const float ang = (float)pos * freq;
        const double rev = (double)ang * 0.15915494309189535;
        const float fr = (float)(rev - __builtin_rint(rev));
        cs[i] = __builtin_amdgcn_cosf(fr); sn[i] = __builtin_amdgcn_sinf(fr);
    }
}
__device__ __forceinline__ void rope_apply(f32x16& a, const float (&cs)[8], const float (&sn)[8]) {
#pragma unroll
    for (int i = 0; i < 8; ++i) { const float x1 = a[i], x2 = a[i + 8]; a[i] = x1 * cs[i] - x2 * sn[i]; a[i + 8] = x1 * sn[i] + x2 * cs[i]; }
}
__device__ __forceinline__ void store_tile_rowmajor(bf16_t* dst  , const f32x16& a, int h) {
#pragma unroll
    for (int g = 0; g < 4; ++g) { u32x2 o; o.x = pk2(a[4 * g], a[4 * g + 1]); o.y = pk2(a[4 * g + 2], a[4 * g + 3]); *(u32x2*)(dst + 8 * g + 4 * h) = o; }
}
constexpr int WQP = 528, WKP = 272, WQ_BYTES = 96 * WQP;
__device__ __forceinline__ void mq_unit(const bf16_t* __restrict__ H, const LAS unsigned char* Wl, const int* __restrict__ pos, bf16_t* __restrict__ QC, int tb, int hh, int lane) {
    const int r = lane & 31, h = lane >> 5, tok = tb * 32 + r;
    const bf16_t* src = H + (size_t)tok * DINP + C_CQ + 8 * h;
    bf16x8 bfr[16]; float ss = 0.f;
#pragma unroll
    for (int s = 0; s < 16; ++s) { bfr[s] = *(const bf16x8*)(src + 16 * s);
#pragma unroll
        for (int j = 0; j < 8; ++j) { const float v = bf2f(bfr[s][j]); ss += v * v; } }
    ss += __shfl_xor(ss, 32);
    const float rs = rsqrtf(ss * (1.f / 256.f) + EPS) * QSC_MLA;
    float cs[8], sn[8]; rope_cs(pos[tok], h, cs, sn);
    const LAS unsigned char* W = Wl + r * WQP + 16 * h;
#pragma unroll 1
    for (int nt = 0; nt < 3; ++nt) {
        f32x16 acc;
#pragma unroll
        for (int i = 0; i < 16; ++i) acc[i] = 0.f;
#pragma unroll
        for (int s = 0; s < 16; ++s) { const bf16x8 a = *(const LAS bf16x8*)(W + nt * 32 * WQP + 32 * s); acc = MFMA32(a, bfr[s], acc); }
#pragma unroll
        for (int i = 0; i < 16; ++i) acc[i] *= rs;
        if (nt == 2) rope_apply(acc, cs, sn);
        store_tile_rowmajor(QC + (size_t)tok * 384 + hh * 96 + nt * 32, acc, h);
    }
}
__device__ __forceinline__ void vt_flush(LAS bf16_t* stg, bf16_t* __restrict__ dst  , int lane) {
    const LAS u32x4* rp = (const LAS u32x4*)(stg + lane * 32);
    u32x4 w[4];
#pragma unroll
    for (int c = 0; c < 4; ++c) w[c] = rp[c];
    u32x4* gp = (u32x4*)(dst + (size_t)lane * SEQ);
#pragma unroll
    for (int c = 0; c < 4; ++c) gp[c] = w[c];
}
__device__ __forceinline__ void mkv_unit(const bf16_t* __restrict__ H, const LAS unsigned char* Wl, const int* __restrict__ pos, bf16_t* __restrict__ KC, bf16_t* __restrict__ VTC, int tb, int hh, int lane, LAS bf16_t* stg) {
    const int r = lane & 31, h = lane >> 5, tok = tb * 32 + r;
    const bf16_t* src = H + (size_t)tok * DINP + C_CKV + 8 * h;
    bf16x8 bfr[8]; float ss = 0.f;
#pragma unroll
    for (int s = 0; s < 8; ++s) { bfr[s] = *(const bf16x8*)(src + 16 * s);
#pragma unroll
        for (int j = 0; j < 8; ++j) { const float v = bf2f(bfr[s][j]); ss += v * v; } }
    ss += __shfl_xor(ss, 32);
    const float rs = rsqrtf(ss * (1.f / 128.f) + EPS);
    const LAS unsigned char* W = Wl + r * WKP + 16 * h;
    const int b = (tb * 32) / SEQ, t0 = (tb * 32) % SEQ;
#pragma unroll 1
    for (int nt = 0; nt < 4; ++nt) {
        f32x16 acc;
#pragma unroll
        for (int i = 0; i < 16; ++i) acc[i] = 0.f;
#pragma unroll
        for (int s = 0; s < 8; ++s) { const bf16x8 a = *(const LAS bf16x8*)(W + nt * 32 * WKP + 32 * s); acc = MFMA32(a, bfr[s], acc); }
#pragma unroll
        for (int i = 0; i < 16; ++i) acc[i] *= rs;
        if (nt < 2) store_tile_rowmajor(KC + (size_t)tok * 384 + hh * 96 + nt * 32, acc, h);
        else {
            LAS bf16_t* sp = stg + ((nt - 2) * 32 + 4 * h) * 32 + r;
#pragma unroll
            for (int i = 0; i < 16; ++i) sp[((i & 3) + 8 * (i >> 2)) * 32] = f2bf(acc[i]);
        }
    }
    vt_flush(stg, VTC + ((size_t)((b * 4 + hh) * 64)) * SEQ + t0, lane);
    f32x16 kr;
    const bf16_t* krp = H + (size_t)tok * DINP + C_CKR + 4 * h;
#pragma unroll
    for (int g = 0; g < 4; ++g) { const u32x2 w = *(const u32x2*)(krp + 8 * g); kr[4 * g] = bflo(w.x); kr[4 * g + 1] = bfhi(w.x); kr[4 * g + 2] = bflo(w.y); kr[4 * g + 3] = bfhi(w.y); }
    float cs[8], sn[8]; rope_cs(pos[tok], h, cs, sn);
    rope_apply(kr, cs, sn);
    store_tile_rowmajor(KC + (size_t)tok * 384 + hh * 96 + 64, kr, h);
}
__device__ __forceinline__ void vt_unit(const bf16_t* __restrict__ H, int col0, int NH, bf16_t* __restrict__ VT, int tb, int head, int lane, LAS bf16_t* stg) {
    const int r = lane & 31, h = lane >> 5, tok = tb * 32 + r, b = (tb * 32) / SEQ, t0 = (tb * 32) % SEQ;
    const bf16_t* src = H + (size_t)tok * DINP + col0 + head * 64 + 32 * h;
    bf16x8 v[4];
#pragma unroll
    for (int c = 0; c < 4; ++c) v[c] = *(const bf16x8*)(src + 8 * c);
    LAS bf16_t* sp = stg + (32 * h) * 32 + r;
#pragma unroll
    for (int c = 0; c < 4; ++c)
#pragma unroll
        for (int j = 0; j < 8; ++j) sp[(8 * c + j) * 32] = (bf16_t)v[c][j];
    vt_flush(stg, VT + ((size_t)((b * NH + head) * 64)) * SEQ + t0, lane);
}
__device__ __forceinline__ void conv_unit(const bf16_t* __restrict__ H, const float* __restrict__ cw, const float* __restrict__ cb, bf16_t* __restrict__ Y, int tb8, int lane) {
    const int tok0 = tb8 * 8, t0 = tok0 % SEQ, ch = 4 * lane;
    const f32x4 w0 = *(const f32x4*)(cw + ch), w1 = *(const f32x4*)(cw + 256 + ch), w2 = *(const f32x4*)(cw + 512 + ch), bs = *(const f32x4*)(cb + ch);
    u32x2 cc[10], xx[10], bb[8];
    const int back = (t0 >= 2) ? 2 : 0;
#pragma unroll
    for (int i = 0; i < 10; ++i) { const int ti = (i < 2) ? (i - back) : (i - 2); const bf16_t* p = H + (size_t)(tok0 + ti) * DINP + ch;
        cc[i] = *(const u32x2*)(p + C_BC); xx[i] = *(const u32x2*)(p + C_BX); if (i >= 2) bb[i - 2] = *(const u32x2*)(p + C_BB); }
    f32x4 u[10];
#pragma unroll
    for (int i = 0; i < 10; ++i) u[i] = (f32x4){bflo(cc[i].x) * bflo(xx[i].x), bfhi(cc[i].x) * bfhi(xx[i].x), bflo(cc[i].y) * bflo(xx[i].y), bfhi(cc[i].y) * bfhi(xx[i].y)};
    if (back == 0) { u[0] = (f32x4){0.f, 0.f, 0.f, 0.f}; u[1] = (f32x4){0.f, 0.f, 0.f, 0.f}; }
#pragma unroll
    for (int i = 0; i < 8; ++i) {
        const f32x4 bg = {bflo(bb[i].x), bfhi(bb[i].x), bflo(bb[i].y), bfhi(bb[i].y)};
        const f32x4 y = bg * (w0 * u[i] + w1 * u[i + 1] + w2 * u[i + 2] + bs);
        u32x2 o; o.x = pk2(y.x, y.y); o.y = pk2(y.z, y.w);
        *(u32x2*)(Y + (size_t)(tok0 + i) * DM + 256 + ch) = o;
    }
}

__device__ __forceinline__ void o_flush(LAS bf16_t* stg, bf16_t* __restrict__ Orow0, int opitch, int lane) {
    u32x4 w[4];
#pragma unroll
    for (int j = 0; j < 4; ++j) w[j] = *(const LAS u32x4*)(stg + (lane + 64 * j) * 8);
#pragma unroll
    for (int j = 0; j < 4; ++j) { const int c = lane + 64 * j; *(u32x4*)(Orow0 + (size_t)(c >> 3) * opitch + (c & 7) * 8) = w[j]; }
}
template <int DKS, bool SINK>
__device__ __forceinline__ void softmax_unit(const bf16_t* __restrict__ Qrow0, int qpitch, const bf16_t* __restrict__ Kb, int kpitch, const bf16_t* __restrict__ VT,
                                             int qb, int kt_begin, int window, float sink2, bf16_t* __restrict__ Orow0, int opitch, int lane, LAS bf16_t* stg) {
    const int r = lane & 31, h = lane >> 5;
    const int pr = (r & ~12) | ((r & 8) >> 1) | ((r & 4) << 1);
    bf16x8 qf[DKS];
#pragma unroll
    for (int s = 0; s < DKS; ++s) qf[s] = *(const bf16x8*)(Qrow0 + (size_t)r * qpitch + 16 * s + 8 * h);
    f32x16 o0, o1;
#pragma unroll
    for (int i = 0; i < 16; ++i) { o0[i] = 0.f; o1[i] = 0.f; }
    float m = -1e30f, l = 0.f;
    const int kt_end = qb + 1, q = 32 * qb + r;
    const bf16_t* kp = Kb + (size_t)(32 * kt_begin + pr) * kpitch + 8 * h;
    const bf16_t* vp = VT + (size_t)r * SEQ + 32 * kt_begin + 8 * h;
    bf16x8 kf[DKS];
#pragma unroll
    for (int s = 0; s < DKS; ++s) kf[s] = *(const bf16x8*)(kp + 16 * s);
    for (int kt = kt_begin; kt < kt_end; ++kt) {
        bf16x8 kn[DKS];
        if (kt + 1 < kt_end) {
#pragma unroll
            for (int s = 0; s < DKS; ++s) kn[s] = *(const bf16x8*)(kp + (size_t)32 * kpitch + 16 * s);
        } else {
#pragma unroll
            for (int s = 0; s < DKS; ++s) kn[s] = kf[s];
        }
        const bf16x8 v00 = *(const bf16x8*)(vp), v01 = *(const bf16x8*)(vp + 32 * SEQ), v10 = *(const bf16x8*)(vp + 16), v11 = *(const bf16x8*)(vp + 32 * SEQ + 16);
        f32x16 p;
#pragma unroll
        for (int i = 0; i < 16; ++i) p[i] = 0.f;
#pragma unroll
        for (int s = 0; s < DKS; ++s) p = MFMA32(kf[s], qf[s], p);
        if (kt == qb || (window != 0 && kt == qb - (window >> 5))) {
            const int k0 = 32 * kt + 8 * h;
#pragma unroll
            for (int i = 0; i < 16; ++i) { const int kv = k0 + 16 * (i >> 3) + (i & 7); const bool ok = (kv <= q) && (window == 0 || kv > q - window); if (!ok) p[i] = -INFINITY; }
        }
        float rm = p[0];
#pragma unroll
        for (int i = 1; i < 16; ++i) rm = fmaxf(rm, p[i]);
        rm = fmaxf(rm, __shfl_xor(rm, 32));
        if (__any(rm > m + 6.f)) {
            const float mn = fmaxf(m, rm), f = ex2(m - mn); m = mn; l *= f;
#pragma unroll
            for (int i = 0; i < 16; ++i) { const float fi = __shfl(f, crow(i, h)); o0[i] *= fi; o1[i] *= fi; }
        }
        float e[16];
#pragma unroll
        for (int i = 0; i < 16; ++i) { e[i] = ex2(p[i] - m); l += e[i]; }
        const bf16x8 pa0 = pack8(e), pa1 = pack8(e + 8);
        o0 = MFMA32(pa0, v00, o0); o1 = MFMA32(pa0, v01, o1);
        o0 = MFMA32(pa1, v10, o0); o1 = MFMA32(pa1, v11, o1);
#pragma unroll
        for (int s = 0; s < DKS; ++s) kf[s] = kn[s];
        kp += (size_t)32 * kpitch; vp += 32;
    }
    l += __shfl_xor(l, 32);
    if (SINK) l += ex2(sink2 - m);
    const float inv = 1.f / l;
    LAS bf16_t* sp = stg + (4 * h) * 64 + r;
#pragma unroll
    for (int i = 0; i < 16; ++i) { const float fi = __shfl(inv, crow(i, h)); const int ro = ((i & 3) + 8 * (i >> 2)) * 64;
        sp[ro] = f2bf(o0[i] * fi); sp[ro + 32] = f2bf(o1[i] * fi); }
    o_flush(stg, Orow0, opitch, lane);
}


constexpr int KP = 208, VP = 272;
constexpr int KT_BYTES = 128 * KP, VT_BYTES = 64 * VP, TB_BYTES = KT_BYTES + VT_BYTES, MRG_OFF = 2 * TB_BYTES;
static_assert(MRG_OFF + 4 * 34 * 64 * 4 <= 131072, "MLA LDS map");
__device__ __forceinline__ void mla_unit_blk(const bf16_t* __restrict__ QC, const bf16_t* __restrict__ KC, const bf16_t* __restrict__ VTC, bf16_t* __restrict__ Y,
                                             int bh, int g, LAS unsigned char* lds, int tid) {
    const int lane = tid & 63, wave = __builtin_amdgcn_readfirstlane(tid >> 6), r = lane & 31, h = lane >> 5, w4 = wave & 3, kh = wave >> 2;
    const int pr = (r & ~12) | ((r & 8) >> 1) | ((r & 4) << 1);
    const int b = bh >> 2, hh = bh & 3, qb = 4 * g + w4, q = 32 * qb + r;
    const bf16_t* Qp = QC + ((size_t)b * SEQ + q) * 384 + hh * 96 + 8 * h;
    bf16x8 qf[6];
#pragma unroll
    for (int s = 0; s < 6; ++s) qf[s] = *(const bf16x8*)(Qp + 16 * s);
    const bf16_t* Kg = KC + (size_t)b * SEQ * 384 + hh * 96;
    const bf16_t* Vg = VTC + (size_t)(b * 4 + hh) * 64 * SEQ;
    int kgo[3], klo[3], vgo[2], vlo[2];
#pragma unroll
    for (int i = 0; i < 3; ++i) { const int c = tid + 512 * i, row = c / 12, cc = c - 12 * row; kgo[i] = row * 384 + 8 * cc; klo[i] = row * KP + 16 * cc; }
#pragma unroll
    for (int i = 0; i < 2; ++i) { const int c = tid + 512 * i, d = c >> 4, cc = c & 15; vgo[i] = d * SEQ + 8 * cc; vlo[i] = KT_BYTES + d * VP + 16 * cc; }
    u32x4 kr[3], vr[2];
#define MLA_LOAD(ST) do { _Pragma("unroll") for (int i = 0; i < 3; ++i) kr[i] = *(const u32x4*)(Kg + (size_t)(ST) * (128 * 384) + kgo[i]); \
                          _Pragma("unroll") for (int i = 0; i < 2; ++i) vr[i] = *(const u32x4*)(Vg + (ST) * 128 + vgo[i]); } while (0)
#define MLA_STORE(buf) do { LAS unsigned char* tb_ = lds + (buf) * TB_BYTES; _Pragma("unroll") for (int i = 0; i < 3; ++i) *(LAS u32x4*)(tb_ + klo[i]) = kr[i]; \
                            _Pragma("unroll") for (int i = 0; i < 2; ++i) *(LAS u32x4*)(tb_ + vlo[i]) = vr[i]; } while (0)
    f32x16 o0, o1;
#pragma unroll
    for (int i = 0; i < 16; ++i) { o0[i] = 0.f; o1[i] = 0.f; }
    float m = -1e30f, l = 0.f;
    const int nST = g + 1;
    MLA_LOAD(0); MLA_STORE(0);
    __syncthreads();
    const int kfo = (64 * kh + pr) * KP + 16 * h;
    const int vfo = KT_BYTES + r * VP + (64 * kh + 8 * h) * 2;
    for (int ST = 0; ST < nST; ++ST) {
        if (ST + 1 < nST) MLA_LOAD(ST + 1);
        const int kt0 = 4 * ST + 2 * kh;
        if (kt0 <= qb) {
            const LAS unsigned char* tb = lds + (ST & 1) * TB_BYTES;
            f32x16 p0, p1;
#pragma unroll
            for (int i = 0; i < 16; ++i) { p0[i] = 0.f; p1[i] = 0.f; }
#pragma unroll
            for (int s = 0; s < 6; ++s) { const bf16x8 k0 = *(const LAS bf16x8*)(tb + kfo + 32 * s), k1 = *(const LAS bf16x8*)(tb + kfo + 32 * KP + 32 * s);
                p0 = MFMA32(k0, qf[s], p0); p1 = MFMA32(k1, qf[s], p1); }
            if (kt0 + 1 >= qb) {
                const int kb0 = 32 * kt0 + 8 * h;
#pragma unroll
                for (int i = 0; i < 16; ++i) { const int kv = kb0 + 16 * (i >> 3) + (i & 7); if (kv > q) p0[i] = -INFINITY; if (kv + 32 > q) p1[i] = -INFINITY; }
            }
            float rm = fmaxf(p0[0], p1[0]);
#pragma unroll
            for (int i = 1; i < 16; ++i) rm = fmaxf(rm, fmaxf(p0[i], p1[i]));
            rm = fmaxf(rm, __shfl_xor(rm, 32));
            if (__any(rm > m + 6.f)) {
                const float mn = fmaxf(m, rm), f = ex2(m - mn); m = mn; l *= f;
#pragma unroll
                for (int i = 0; i < 16; ++i) { const float fi = __shfl(f, crow(i, h)); o0[i] *= fi; o1[i] *= fi; }
            }
            float ls = 0.f;
#pragma unroll
            for (int i = 0; i < 16; ++i) { p0[i] = ex2(p0[i] - m); p1[i] = ex2(p1[i] - m); ls += p0[i] + p1[i]; }
            l += ls;
            float e[8];
#pragma unroll
            for (int ks = 0; ks < 4; ++ks) {
#pragma unroll
                for (int j = 0; j < 8; ++j) e[j] = (ks < 2) ? p0[8 * ks + j] : p1[8 * (ks - 2) + j];
                const bf16x8 pa = pack8(e);
                const bf16x8 v0 = *(const LAS bf16x8*)(tb + vfo + 32 * ks), v1 = *(const LAS bf16x8*)(tb + vfo + 32 * VP + 32 * ks);
                o0 = MFMA32(pa, v0, o0); o1 = MFMA32(pa, v1, o1);
            }
        }
        if (ST + 1 < nST) MLA_STORE((ST + 1) & 1);
        __syncthreads();
    }
#undef MLA_LOAD
#undef MLA_STORE
    l += __shfl_xor(l, 32);
    LAS float* mg = (LAS float*)(lds + MRG_OFF) + w4 * (34 * 64) + lane;
    if (kh == 1) {
#pragma unroll
        for (int i = 0; i < 16; ++i) { mg[i * 64] = o0[i]; mg[(16 + i) * 64] = o1[i]; }
        mg[32 * 64] = m; mg[33 * 64] = l;
    }
    __syncthreads();
    if (kh == 0) {
        const float mb = mg[32 * 64], lb = mg[33 * 64];
        const float mn = fmaxf(m, mb), fa = ex2(m - mn), fb = ex2(mb - mn), inv = 1.f / (l * fa + lb * fb), ga = fa * inv, gb = fb * inv;
        LAS bf16_t* stg = (LAS bf16_t*)(lds + wave * 4096);
        LAS bf16_t* sp = stg + (4 * h) * 64 + r;
#pragma unroll
        for (int i = 0; i < 16; ++i) { const float ra = __shfl(ga, crow(i, h)), rb = __shfl(gb, crow(i, h)); const int ro = ((i & 3) + 8 * (i >> 2)) * 64;
            sp[ro] = f2bf(o0[i] * ra + mg[i * 64] * rb); sp[ro + 32] = f2bf(o1[i] * ra + mg[(16 + i) * 64] * rb); }
        o_flush(stg, Y + ((size_t)b * SEQ + 32 * qb) * DM + 512 + hh * 64, DM, lane);
    }
    __syncthreads();
}

__device__ __forceinline__ void sb_unit(const bf16_t* __restrict__ Qrow0, int qpitch, const bf16_t* __restrict__ Kb, int kpitch, const bf16_t* __restrict__ VT,
                                        int qb, bf16_t* __restrict__ Orow0, int opitch, int lane, LAS bf16_t* stg) {
    const int r = lane & 31, h = lane >> 5;
    const int pr = (r & ~12) | ((r & 8) >> 1) | ((r & 4) << 1);
    bf16x8 qf[4];
#pragma unroll
    for (int s = 0; s < 4; ++s) qf[s] = *(const bf16x8*)(Qrow0 + (size_t)r * qpitch + 16 * s + 8 * h);
    f32x16 o0, o1;
#pragma unroll
    for (int i = 0; i < 16; ++i) { o0[i] = 0.f; o1[i] = 0.f; }
    float carry = 0.f;
    const int q = 32 * qb + r;
    const bf16_t* kp = Kb + (size_t)(32 * qb + pr) * kpitch + 8 * h;
    const bf16_t* vp = VT + (size_t)r * SEQ + 32 * qb + 8 * h;
    bf16x8 kf[4];
#pragma unroll
    for (int s = 0; s < 4; ++s) kf[s] = *(const bf16x8*)(kp + 16 * s);
    for (int kt = qb; kt >= 0; --kt) {
        bf16x8 kn[4];
        if (kt > 0) {
#pragma unroll
            for (int s = 0; s < 4; ++s) kn[s] = *(const bf16x8*)(kp - (size_t)32 * kpitch + 16 * s);
        } else {
#pragma unroll
            for (int s = 0; s < 4; ++s) kn[s] = kf[s];
        }
        const bf16x8 v00 = *(const bf16x8*)(vp), v01 = *(const bf16x8*)(vp + 32 * SEQ), v10 = *(const bf16x8*)(vp + 16), v11 = *(const bf16x8*)(vp + 32 * SEQ + 16);
        f32x16 p;
#pragma unroll
        for (int i = 0; i < 16; ++i) p[i] = 0.f;
#pragma unroll
        for (int s = 0; s < 4; ++s) p = MFMA32(kf[s], qf[s], p);
        const bool diag = (kt == qb);
        const int k0 = 32 * kt + 8 * h;
        float sfx[16];
#pragma unroll
        for (int i = 0; i < 16; ++i) {
            const float z = p[i];
            float L = -(fmaxf(z, 0.f) + lg2(1.f + ex2(-fabsf(z))));
            if (diag) { const int kv = k0 + 16 * (i >> 3) + (i & 7); if (!(kv < q)) L = 0.f; }
            sfx[i] = L;
        }
#pragma unroll
        for (int g = 0; g < 2; ++g)
#pragma unroll
            for (int j = 6; j >= 0; --j) sfx[8 * g + j] += sfx[8 * g + j + 1];
        const float T0 = sfx[0], T1 = sfx[8];
        const float TP0 = __shfl_xor(T0, 32), TP1 = __shfl_xor(T1, 32);
        const float off1 = (h ? 0.f : TP1) + carry, off0 = T1 + TP1 + (h ? 0.f : TP0) + carry;
        float e[16];
#pragma unroll
        for (int i = 0; i < 16; ++i) {
            float a = ex2(p[i] + sfx[i] + (i < 8 ? off0 : off1));
            if (diag) { const int kv = k0 + 16 * (i >> 3) + (i & 7); if (!(kv < q)) a = 0.f; }
            e[i] = a;
        }
        carry += (T0 + T1) + (TP0 + TP1);
        const bf16x8 pa0 = pack8(e), pa1 = pack8(e + 8);
        o0 = MFMA32(pa0, v00, o0); o1 = MFMA32(pa0, v01, o1);
        o0 = MFMA32(pa1, v10, o0); o1 = MFMA32(pa1, v11, o1);
        if (__all(carry < -150.f)) break;
#pragma unroll
        for (int s = 0; s < 4; ++s) kf[s] = kn[s];
        kp -= (size_t)32 * kpitch; vp -= 32;
    }
    LAS bf16_t* sp = stg + (4 * h) * 64 + r;
#pragma unroll
    for (int i = 0; i < 16; ++i) { const int ro = ((i & 3) + 8 * (i >> 2)) * 64; sp[ro] = f2bf(o0[i]); sp[ro + 32] = f2bf(o1[i]); }
    o_flush(stg, Orow0, opitch, lane);
}


constexpr int AKP = 144;
constexpr int SWA_NK = 384, SWA_VP = SWA_NK * 2 + 16, SWA_KB = SWA_NK * AKP;
constexpr int SB_NK = 448, SB_VP = SB_NK * 2 + 16, SB_KB = SB_NK * AKP;
constexpr int STG_OFF = 122880, MISC_OFF = STG_OFF + 8 * 4096;
static_assert(SWA_KB + 64 * SWA_VP <= STG_OFF && SB_KB + 64 * SB_VP <= STG_OFF && MISC_OFF + 1024 == LDS_BYTES, "window LDS map");
template <int NK, int VPB>
__device__ __forceinline__ void stage_kv64(const bf16_t* __restrict__ Kb, int kpitch, const bf16_t* __restrict__ VT, int key0, LAS unsigned char* lds, int tid) {
    constexpr int NCH = NK * 8 / 512, VC = NK / 8;
    u32x4 kr[NCH], vr[NCH];
#pragma unroll
    for (int i = 0; i < NCH; ++i) { const int c = tid + 512 * i, row = c >> 3, cc = c & 7; int key = key0 + row; key = key < 0 ? 0 : key;
        kr[i] = *(const u32x4*)(Kb + (size_t)key * kpitch + 8 * cc); }
#pragma unroll
    for (int i = 0; i < NCH; ++i) { const int c = tid + 512 * i, d = c / VC, cc = c - d * VC; int key = key0 + 8 * cc; key = key < 0 ? 0 : key;
        vr[i] = *(const u32x4*)(VT + (size_t)d * SEQ + key); }
#pragma unroll
    for (int i = 0; i < NCH; ++i) { const int c = tid + 512 * i, row = c >> 3, cc = c & 7; *(LAS u32x4*)(lds + row * AKP + 16 * cc) = kr[i]; }
#pragma unroll
    for (int i = 0; i < NCH; ++i) { const int c = tid + 512 * i, d = c / VC, cc = c - d * VC; *(LAS u32x4*)(lds + NK * AKP + d * VPB + 16 * cc) = vr[i]; }
}
__device__ __forceinline__ void swa_wave_lds(const bf16_t* __restrict__ Qrow0, int qpitch, const LAS unsigned char* lds, int qb, int kt_base, float sink2,
                                             bf16_t* __restrict__ Orow0, int opitch, int lane, LAS bf16_t* stg) {
    const int r = lane & 31, h = lane >> 5;
    const int pr = (r & ~12) | ((r & 8) >> 1) | ((r & 4) << 1);
    bf16x8 qf[4];
#pragma unroll
    for (int s = 0; s < 4; ++s) qf[s] = *(const bf16x8*)(Qrow0 + (size_t)r * qpitch + 16 * s + 8 * h);
    f32x16 o0, o1;
#pragma unroll
    for (int i = 0; i < 16; ++i) { o0[i] = 0.f; o1[i] = 0.f; }
    float m = -1e30f, l = 0.f;
    const int q = 32 * qb + r, kt_begin = qb - 4 > 0 ? qb - 4 : 0;
    for (int kt = kt_begin; kt <= qb; ++kt) {
        const int rel = kt - kt_base;
        const LAS unsigned char* kp = lds + (32 * rel + pr) * AKP + 16 * h;
        const LAS unsigned char* vp = lds + SWA_KB + r * SWA_VP + (32 * rel + 8 * h) * 2;
        f32x16 p;
#pragma unroll
        for (int i = 0; i < 16; ++i) p[i] = 0.f;
#pragma unroll
        for (int s = 0; s < 4; ++s) p = MFMA32(*(const LAS bf16x8*)(kp + 32 * s), qf[s], p);
        if (kt == qb || kt == qb - 4) {
            const int k0 = 32 * kt + 8 * h;
#pragma unroll
            for (int i = 0; i < 16; ++i) { const int kv = k0 + 16 * (i >> 3) + (i & 7); const bool ok = (kv <= q) && (kv > q - 128); if (!ok) p[i] = -INFINITY; }
        }
        float rm = p[0];
#pragma unroll
        for (int i = 1; i < 16; ++i) rm = fmaxf(rm, p[i]);
        rm = fmaxf(rm, __shfl_xor(rm, 32));
        if (__any(rm > m + 6.f)) {
            const float mn = fmaxf(m, rm), f = ex2(m - mn); m = mn; l *= f;
#pragma unroll
            for (int i = 0; i < 16; ++i) { const float fi = __shfl(f, crow(i, h)); o0[i] *= fi; o1[i] *= fi; }
        }
        float e[16];
#pragma unroll
        for (int i = 0; i < 16; ++i) { e[i] = ex2(p[i] - m); l += e[i]; }
        const bf16x8 pa0 = pack8(e), pa1 = pack8(e + 8);
        o0 = MFMA32(pa0, *(const LAS bf16x8*)(vp), o0); o1 = MFMA32(pa0, *(const LAS bf16x8*)(vp + 32 * SWA_VP), o1);
        o0 = MFMA32(pa1, *(const LAS bf16x8*)(vp + 32), o0); o1 = MFMA32(pa1, *(const LAS bf16x8*)(vp + 32 * SWA_VP + 32), o1);
    }
    l += __shfl_xor(l, 32);
    l += ex2(sink2 - m);
    const float inv = 1.f / l;
    LAS bf16_t* sp = stg + (4 * h) * 64 + r;
#pragma unroll
    for (int i = 0; i < 16; ++i) { const float fi = __shfl(inv, crow(i, h)); const int ro = ((i & 3) + 8 * (i >> 2)) * 64;
        sp[ro] = f2bf(o0[i] * fi); sp[ro + 32] = f2bf(o1[i] * fi); }
    o_flush(stg, Orow0, opitch, lane);
}
#define SB_STEP(KT_, V00_, V01_, V10_, V11_) do { \
        const bool diag = ((KT_) == qb); const int k0 = 32 * (KT_) + 8 * h; float sfx[16]; \
        _Pragma("unroll") for (int i = 0; i < 16; ++i) { const float z = p[i]; float L = -(fmaxf(z, 0.f) + lg2(1.f + ex2(-fabsf(z)))); \
            if (diag) { const int kv = k0 + 16 * (i >> 3) + (i & 7); if (!(kv < q)) L = 0.f; } sfx[i] = L; } \
        _Pragma("unroll") for (int g = 0; g < 2; ++g) _Pragma("unroll") for (int j = 6; j >= 0; --j) sfx[8 * g + j] += sfx[8 * g + j + 1]; \
        const float T0 = sfx[0], T1 = sfx[8]; const float TP0 = __shfl_xor(T0, 32), TP1 = __shfl_xor(T1, 32); \
        const float off1 = (h ? 0.f : TP1) + carry, off0 = T1 + TP1 + (h ? 0.f : TP0) + carry; float e[16]; \
        _Pragma("unroll") for (int i = 0; i < 16; ++i) { float a = ex2(p[i] + sfx[i] + (i < 8 ? off0 : off1)); \
            if (diag) { const int kv = k0 + 16 * (i >> 3) + (i & 7); if (!(kv < q)) a = 0.f; } e[i] = a; } \
        carry += (T0 + T1) + (TP0 + TP1); \
        const bf16x8 pa0 = pack8(e), pa1 = pack8(e + 8); \
        o0 = MFMA32(pa0, (V00_), o0); o1 = MFMA32(pa0, (V01_), o1); o0 = MFMA32(pa1, (V10_), o0); o1 = MFMA32(pa1, (V11_), o1); } while (0)
__device__ __forceinline__ void sb_wave_lds(const bf16_t* __restrict__ Qrow0, int qpitch, const LAS unsigned char* lds, const bf16_t* __restrict__ Kb, int kpitch,
                                            const bf16_t* __restrict__ VT, int qb, int kt_base, bf16_t* __restrict__ Orow0, int opitch, int lane, LAS bf16_t* stg) {
    const int r = lane & 31, h = lane >> 5;
    const int pr = (r & ~12) | ((r & 8) >> 1) | ((r & 4) << 1);
    bf16x8 qf[4];
#pragma unroll
    for (int s = 0; s < 4; ++s) qf[s] = *(const bf16x8*)(Qrow0 + (size_t)r * qpitch + 16 * s + 8 * h);
    f32x16 o0, o1;
#pragma unroll
    for (int i = 0; i < 16; ++i) { o0[i] = 0.f; o1[i] = 0.f; }
    float carry = 0.f;
    const int q = 32 * qb + r;
    const int kt_lo = kt_base > 0 ? kt_base : 0;
    bool done = false;
    int kt = qb;
    for (; kt >= kt_lo; --kt) {
        const int rel = kt - kt_base;
        const LAS unsigned char* kp = lds + (32 * rel + pr) * AKP + 16 * h;
        const LAS unsigned char* vp = lds + SB_KB + r * SB_VP + (32 * rel + 8 * h) * 2;
        f32x16 p;
#pragma unroll
        for (int i = 0; i < 16; ++i) p[i] = 0.f;
#pragma unroll
        for (int s = 0; s < 4; ++s) p = MFMA32(*(const LAS bf16x8*)(kp + 32 * s), qf[s], p);
        SB_STEP(kt, *(const LAS bf16x8*)(vp), *(const LAS bf16x8*)(vp + 32 * SB_VP), *(const LAS bf16x8*)(vp + 32), *(const LAS bf16x8*)(vp + 32 * SB_VP + 32));
        if (__all(carry < -150.f)) { done = true; break; }
    }
    if (!done && kt >= 0) {
        const bf16_t* kp = Kb + (size_t)(32 * kt + pr) * kpitch + 8 * h;
        const bf16_t* vp = VT + (size_t)r * SEQ + 32 * kt + 8 * h;
        for (; kt >= 0; --kt) {
            bf16x8 kf[4];
#pragma unroll
            for (int s = 0; s < 4; ++s) kf[s] = *(const bf16x8*)(kp + 16 * s);
            const bf16x8 v00 = *(const bf16x8*)(vp), v01 = *(const bf16x8*)(vp + 32 * SEQ), v10 = *(const bf16x8*)(vp + 16), v11 = *(const bf16x8*)(vp + 32 * SEQ + 16);
            f32x16 p;
#pragma unroll
            for (int i = 0; i < 16; ++i) p[i] = 0.f;
#pragma unroll
            for (int s = 0; s < 4; ++s) p = MFMA32(kf[s], qf[s], p);
            SB_STEP(kt, v00, v01, v10, v11);
            if (__all(carry < -150.f)) break;
            kp -= (size_t)32 * kpitch; vp -= 32;
        }
    }
    LAS bf16_t* sp = stg + (4 * h) * 64 + r;
#pragma unroll
    for (int i = 0; i < 16; ++i) { const int ro = ((i & 3) + 8 * (i >> 2)) * 64; sp[ro] = f2bf(o0[i]); sp[ro + 32] = f2bf(o1[i]); }
    o_flush(stg, Orow0, opitch, lane);
}
#undef SB_STEP

#define XB_TMO      128
#define XB_XCNT(j)  (256  + 64 * (j))
#define XB_XSUB(j)  (1280 + 64 * (j))
#define XB_XGEN(j)  (2304 + 64 * (j))
#define XB_TOP      3328
#define XB_TOPGEN   3392
#define XCD_BAR_WORDS 3456
#define XB_SPIN_CAP (1u << 18)

__device__ __forceinline__ unsigned xb_ld(unsigned* p)              { return __hip_atomic_load(p, __ATOMIC_RELAXED, __HIP_MEMORY_SCOPE_AGENT); }
__device__ __forceinline__ unsigned xb_add(unsigned* p, unsigned v) { return __hip_atomic_fetch_add(p, v, __ATOMIC_RELAXED, __HIP_MEMORY_SCOPE_AGENT); }
__device__ __forceinline__ unsigned xb_xcc_id() { return (unsigned)__builtin_amdgcn_s_getreg((3 << 11) | 20) & 0xFu; }
#define XB_SPIN(cond, bar) do { unsigned _sp = 0; while (cond) { __builtin_amdgcn_s_sleep(1); \
    if ((++_sp & 255u) == 0u) { if (xb_ld(&(bar)[XB_TMO])) break; if (_sp > XB_SPIN_CAP) { atomicAdd(&(bar)[XB_TMO], 1u); break; } } } } while (0)

struct XcdBarrier {
    unsigned* bar; unsigned x;
    volatile LAS unsigned* st;
};

__device__ __forceinline__ XcdBarrier xcd_barrier_post(unsigned* bar, volatile LAS unsigned* st) {
    XcdBarrier b; b.bar = bar; b.x = xb_xcc_id(); b.st = st;
    if (threadIdx.x == 0) (void)xb_add(&bar[XB_XCNT(b.x)], 1u);
    return b;
}
__device__ __forceinline__ void xcd_barrier_complete(unsigned* bar, unsigned x, unsigned& nloc, unsigned& nx) {
    const unsigned G = gridDim.x * gridDim.y * gridDim.z;
    unsigned sum, cnt, mine, sp = 0u;
    for (;;) {
        sum = 0u; cnt = 0u; mine = 0u;
#pragma unroll
        for (unsigned j = 0; j < 16; ++j) { const unsigned c = xb_ld(&bar[XB_XCNT(j)]); sum += c; cnt += (c > 0u) ? 1u : 0u; mine = (j == x) ? c : mine; }
        if (sum == G) break;
        __builtin_amdgcn_s_sleep(1);
        if ((++sp & 255u) == 0u) { if (xb_ld(&bar[XB_TMO])) break; if (sp > XB_SPIN_CAP) { atomicAdd(&bar[XB_TMO], 1u); break; } }
    }
    nloc = mine > 0u ? mine : 1u; nx = cnt > 0u ? cnt : 1u;
}

__device__ __forceinline__ void xcd_barrier(const XcdBarrier& b) {
    asm volatile("s_waitcnt vmcnt(0)" ::: "memory");
    __syncthreads();
    if (threadIdx.x == 0) {
        unsigned* bar = b.bar;
        __builtin_amdgcn_s_waitcnt(0);
        unsigned nloc = b.st[0], nx = b.st[1];
        if (nloc == 0u) { xcd_barrier_complete(bar, b.x, nloc, nx); b.st[0] = nloc; b.st[1] = nx; }
        const unsigned old = xb_add(&bar[XB_XSUB(b.x)], 1u);
        const unsigned gen = old / nloc;
        if (old + 1u == (gen + 1u) * nloc) {
            __builtin_amdgcn_fence(__ATOMIC_RELEASE, "agent");
            asm volatile("s_waitcnt vmcnt(0)" ::: "memory");
            const unsigned og = xb_add(&bar[XB_TOP], 1u);
            const unsigned tg = og / nx;
            if (og + 1u == (tg + 1u) * nx) xb_add(&bar[XB_TOPGEN], 1u);
            else XB_SPIN(xb_ld(&bar[XB_TOPGEN]) == tg, bar);
            __builtin_amdgcn_fence(__ATOMIC_ACQUIRE, "agent");
            xb_add(&bar[XB_XGEN(b.x)], 1u);
            asm volatile("s_waitcnt vmcnt(0)" ::: "memory");
        } else {
            XB_SPIN(xb_ld(&bar[XB_XGEN(b.x)]) == gen, bar);
            __builtin_amdgcn_fence(__ATOMIC_ACQUIRE, "agent");
            asm volatile("s_waitcnt vmcnt(0)" ::: "memory");
        }
    }
    __syncthreads();
}

__global__ void __launch_bounds__(NTHREADS, 2) fwd(Params P) {
    extern __shared__ __attribute__((aligned(16))) unsigned char lds_raw[];
    LAS unsigned char* lds = (LAS unsigned char*)lds_raw;
    constexpr int G = 256, NGW = G * NWAVES, gthreads = G * NTHREADS;
    const int bx = blockIdx.x;
#if MK_COOP
    cooperative_groups::grid_group grid = cooperative_groups::this_grid();
    volatile LAS unsigned* MISC = (volatile LAS unsigned*)(lds + MISC_OFF);
    if (threadIdx.x < 64) MISC[threadIdx.x] = 0u;
    __syncthreads();
    XcdBarrier bar = xcd_barrier_post((unsigned*)(P.ws + WS_CTL) + CW_BAR, MISC + 8);
#endif
    for (int ph = P.ph_lo; ph < P.ph_hi; ++ph) {
        const int nrep = ((ph >= 1 && ph <= 6 && ((ph - 1) == MK_REP_K || (MK_REP_K == 6 && ph == 3))) || (ph == 0 && MK_REP_K == 7)) ? MK_REP_N : 1;
        for (int rep = 0; rep < nrep; ++rep) {
        int tid_o = threadIdx.x; asm volatile("" : "+v"(tid_o));
        const int tid = tid_o, lane = tid & 63, wave = __builtin_amdgcn_readfirstlane(tid >> 6);
        const int gw = bx * NWAVES + wave, gtid = bx * NTHREADS + tid;
        LAS bf16_t* stg = (LAS bf16_t*)(lds + 122880 + wave * 4096);
        unsigned char* ws = P.ws; asm volatile("" : "+s"(ws));
        unsigned* ctl = (unsigned*)(ws + WS_CTL);
        bf16_t* XN = (bf16_t*)(ws + WS_XN); bf16_t* H = (bf16_t*)(ws + WS_H);
        bf16_t* QC = (bf16_t*)(ws + WS_QC); bf16_t* KC = (bf16_t*)(ws + WS_KC);
        bf16_t* VTC = (bf16_t*)(ws + WS_VTC); bf16_t* VTA = (bf16_t*)(ws + WS_VTA); bf16_t* VTD = (bf16_t*)(ws + WS_VTD);
        bf16_t* Y = (bf16_t*)(ws + WS_Y);
        if (ph == 0) {
            {
                LAS float* scr = (LAS float*)(lds + wave * 16384);
                constexpr int I_IN = (DM / 64) * (DIN / 32), I_OUT = (DM / 64) * (DM / 32), I_UQ = (256 / 64) * (384 / 32), I_UKV = (128 / 64) * (512 / 32), I_L = I_IN + I_OUT + I_UQ + I_UKV;
                for (int it = gw; it < NLAYER * I_L; it += NGW) {
                    const int l = it / I_L; int v = it - l * I_L;
                    if (v < I_IN) { wT_item(P.w_in + (size_t)l * DM * DIN, DM, DIN, P.norm_pre + l * DM, (bf16_t*)(ws + WS_WIN) + (size_t)l * DINP * DM, C_AQ, C_AQ + 256, C_DQ, C_DQ + 256, SC64, scr, v, lane); continue; } v -= I_IN;
                    if (v < I_OUT) { wT_item(P.w_out + (size_t)l * DM * DM, DM, DM, P.g_grp + l * DM, (bf16_t*)(ws + WS_WOUT) + (size_t)l * DM * DM, 0, 0, 0, 0, 1.f, scr, v, lane); continue; } v -= I_OUT;
                    if (v < I_UQ) { wT_item(P.w_uq + (size_t)l * 256 * 384, 256, 384, P.g_cq + l * 256, (bf16_t*)(ws + WS_WUQ + (size_t)l * 262144), 0, 0, 0, 0, 1.f, scr, v, lane); continue; } v -= I_UQ;
                    wT_item(P.w_ukv + (size_t)l * 128 * 512, 128, 512, P.g_ckv + l * 128, (bf16_t*)(ws + WS_WUKV + (size_t)l * 131072), 0, 0, 0, 0, 1.f, scr, v, lane);
                }
                for (int it = gtid; it < NLAYER * (DINP - DIN) * (DM / 8); it += gthreads) { const int l = it / ((DINP - DIN) * (DM / 8)), v = it - l * ((DINP - DIN) * (DM / 8));
                    *(u32x4*)((bf16_t*)(ws + WS_WIN) + (size_t)l * DINP * DM + (size_t)DIN * DM + (size_t)v * 8) = (u32x4){0u, 0u, 0u, 0u}; }
            }
            { const float* __restrict__ xr = P.x; bf16_t* __restrict__ xo = XN;
#pragma unroll 2
              for (int mrow = gw; mrow < M_TOK; mrow += NGW) rms_row_to_bf16(xr + (size_t)mrow * DM, xo + (size_t)mrow * DM, lane); }
        } else {
            const int l = (ph - 1) / 6, k = (ph - 1) % 6;
            if (k == 0 || k == 4) {
                if (k == 0) {
                    pg8::Gemm g{XN, (const bf16_t*)(ws + WS_WIN) + (size_t)l * DINP * DM, M_TOK, DINP, DM}; pg8::StaticOrder S; S.init(M_TOK, DINP, G, bx);
                    pg8::EpiBf16<0> E{H, DINP, nullptr, 0, 0, 1.f};
                    pg8::gemm_phase<pg8::EpiBf16<0>, pg8::StaticOrder, true, true>(lds, g, S, E);
                } else {
                    pg8::Gemm g{XN, (const bf16_t*)(ws + WS_WOUT) + (size_t)l * DM * DM, M_TOK, DM, DM}; pg8::StaticOrder S; S.init(M_TOK, DM, G, bx);
                    pg8::EpiBf16<0> E{Y, DM, nullptr, 0, 0, 1.f};
                    pg8::gemm_phase<pg8::EpiBf16<0>, pg8::StaticOrder, true, true>(lds, g, S, E);
                }
            } else if (k == 1) {
                const bf16_t* WUQ = (const bf16_t*)(ws + WS_WUQ + (size_t)l * 262144);
                const bf16_t* WUKV = (const bf16_t*)(ws + WS_WUKV + (size_t)l * 131072);
                {
                    const int hh = bx & 3, tg = bx >> 2;
                    u32x4 wq[6], wk[4];
#pragma unroll
                    for (int i = 0; i < 6; ++i) { const int c = tid + 512 * i, row = c >> 5, cc = c & 31; wq[i] = *(const u32x4*)(WUQ + (size_t)(hh * 96 + row) * 256 + 8 * cc); }
#pragma unroll
                    for (int i = 0; i < 4; ++i) { const int c = tid + 512 * i, row = c >> 4, cc = c & 15; wk[i] = *(const u32x4*)(WUKV + (size_t)(hh * 128 + row) * 128 + 8 * cc); }
#pragma unroll
                    for (int i = 0; i < 6; ++i) { const int c = tid + 512 * i, row = c >> 5, cc = c & 31; *(LAS u32x4*)(lds + row * WQP + 16 * cc) = wq[i]; }
#pragma unroll
                    for (int i = 0; i < 4; ++i) { const int c = tid + 512 * i, row = c >> 4, cc = c & 15; *(LAS u32x4*)(lds + WQ_BYTES + row * WKP + 16 * cc) = wk[i]; }
                    __syncthreads();
                    const int tb = 8 * tg + wave;
                    mq_unit(H, lds, P.pos, QC, tb, hh, lane);
                    mkv_unit(H, lds + WQ_BYTES, P.pos, KC, VTC, tb, hh, lane, stg);
                }
                constexpr int NTB = M_TOK / 32;
                constexpr int U_VTA = NTB * 2, U_VTD = NTB * 4, U_CONV = M_TOK / 8;
                constexpr int U_ALL = U_VTA + U_VTD + U_CONV;
                for (int u = gw; u < U_ALL; u += NGW) {
                    int v = u;
                    if (v < U_VTA) { vt_unit(H, C_AV, 2, VTA, v >> 1, v & 1, lane, stg); continue; } v -= U_VTA;
                    if (v < U_VTD) { vt_unit(H, C_DV, 4, VTD, v >> 2, v & 3, lane, stg); continue; } v -= U_VTD;
                    conv_unit(H, P.conv_w + l * 768, P.conv_b + l * 256, Y, v, lane);
                }
            } else if (k == 2) {
                if (rep == 0 || MK_REP_K == 2)
                for (int pu = bx; pu < 256; pu += G) {
                    const int bh = pu & 7, Gq = pu >> 3;
                    mla_unit_blk(QC, KC, VTC, Y, bh, 63 - Gq, lds, tid);
                    mla_unit_blk(QC, KC, VTC, Y, bh, Gq, lds, tid);
                }
                if (rep == 0 || MK_REP_K == 6) {
                    const int bh = bx & 7, G8 = bx >> 3, b = bh >> 2, hh = bh & 3, qb = 8 * G8 + wave;
                    const size_t row0 = (size_t)b * SEQ + 32 * qb;
                    LAS bf16_t* ostg = (LAS bf16_t*)(lds + STG_OFF + wave * 4096);
                    {
                        const int kvh = hh >> 1;
                        const bf16_t* Kb = H + (size_t)b * SEQ * DINP + C_AK + kvh * 64;
                        const bf16_t* VT = VTA + (size_t)(b * 2 + kvh) * 64 * SEQ;
                        stage_kv64<SWA_NK, SWA_VP>(Kb, DINP, VT, 256 * G8 - 128, lds, tid);
                        __syncthreads();
                        swa_wave_lds(H + row0 * DINP + C_AQ + hh * 64, DINP, lds, qb, 8 * G8 - 4, P.sinks[l * 4 + hh] * LOG2E, Y + row0 * DM + hh * 64, DM, lane, ostg);
                        __syncthreads();
                    }
                    {
                        const bf16_t* Kb = H + (size_t)b * SEQ * DINP + C_DK + hh * 64;
                        const bf16_t* VT = VTD + (size_t)(b * 4 + hh) * 64 * SEQ;
                        stage_kv64<SB_NK, SB_VP>(Kb, DINP, VT, 256 * G8 - 192, lds, tid);
                        __syncthreads();
                        sb_wave_lds(H + row0 * DINP + C_DQ + hh * 64, DINP, lds, Kb, DINP, VT, qb, 8 * G8 - 6, Y + row0 * DM + 768 + hh * 64, DM, lane, ostg);
                        __syncthreads();
                    }
                }
            } else if (k == 3) {
                const bf16_t* __restrict__ Yr = Y; const bf16_t* __restrict__ Hr = H; bf16_t* __restrict__ XNw = XN;
#pragma unroll 2
                for (int mrow = gw; mrow < M_TOK; mrow += NGW) {
                    const u32x4* yp = (const u32x4*)(Yr + (size_t)mrow * DM) + 2 * lane;
                    const u32x4* gp = (const u32x4*)(Hr + (size_t)mrow * DINP + C_GATE) + 2 * lane;
                    const u32x4 y0 = yp[0], y1 = yp[1], g0 = gp[0], g1 = gp[1];
                    float yv[16], gv[16];
#pragma unroll
                    for (int j = 0; j < 4; ++j) { yv[2 * j] = bflo(y0[j]); yv[2 * j + 1] = bfhi(y0[j]); yv[8 + 2 * j] = bflo(y1[j]); yv[8 + 2 * j + 1] = bfhi(y1[j]);
                                                  gv[2 * j] = bflo(g0[j]); gv[2 * j + 1] = bfhi(g0[j]); gv[8 + 2 * j] = bflo(g1[j]); gv[8 + 2 * j + 1] = bfhi(g1[j]); }
                    float ss = 0.f;
#pragma unroll
                    for (int j = 0; j < 16; ++j) ss += yv[j] * yv[j];
                    ss += __shfl_xor(ss, 1); ss += __shfl_xor(ss, 2); ss += __shfl_xor(ss, 4); ss += __shfl_xor(ss, 8);
                    const float rs = rsqrtf(ss * (1.f / 256.f) + EPS);
                    float o[16];
#pragma unroll
                    for (int j = 0; j < 16; ++j) { const float gg = gv[j]; o[j] = yv[j] * rs * gg * __builtin_amdgcn_rcpf(1.f + ex2(-gg * LOG2E)); }
                    u32x4 w0, w1;
#pragma unroll
                    for (int j = 0; j < 4; ++j) { w0[j] = pk2(o[2 * j], o[2 * j + 1]); w1[j] = pk2(o[8 + 2 * j], o[8 + 2 * j + 1]); }
                    u32x4* op = (u32x4*)(XNw + (size_t)mrow * DM) + 2 * lane;
                    op[0] = w0; op[1] = w1;
                }
            } else {
                const float* base = (l == 0) ? P.x : P.out;
                const float* gpost = P.g_post + l * DM;
                for (int mrow0 = gw; mrow0 < M_TOK; mrow0 += 2 * NGW) {
                    f32x4 zz[2][4], xv[2][4]; float s1[2] = {0.f, 0.f}, s2[2] = {0.f, 0.f};
                    const bool two = (mrow0 + NGW < M_TOK);
#pragma unroll
                    for (int rr = 0; rr < 2; ++rr) { const int mrow = (rr == 0 || two) ? mrow0 + rr * NGW : mrow0;
#pragma unroll
                        for (int j = 0; j < 4; ++j) { const u32x2 w = ((const u32x2*)(Y + (size_t)mrow * DM))[lane + 64 * j]; zz[rr][j] = (f32x4){bflo(w.x), bfhi(w.x), bflo(w.y), bfhi(w.y)};
                            xv[rr][j] = ((const f32x4*)(base + (size_t)mrow * DM))[lane + 64 * j]; } }
                    f32x4 gpv[4];
#pragma unroll
                    for (int j = 0; j < 4; ++j) gpv[j] = ((const f32x4*)gpost)[lane + 64 * j];
#pragma unroll
                    for (int rr = 0; rr < 2; ++rr)
#pragma unroll
                        for (int j = 0; j < 4; ++j) s1[rr] += (zz[rr][j].x * zz[rr][j].x + zz[rr][j].y * zz[rr][j].y) + (zz[rr][j].z * zz[rr][j].z + zz[rr][j].w * zz[rr][j].w);
                    const float rz0 = rsqrtf(wave_sum(s1[0]) * (1.f / DM) + EPS), rz1 = rsqrtf(wave_sum(s1[1]) * (1.f / DM) + EPS);
#pragma unroll
                    for (int rr = 0; rr < 2; ++rr) { const float rz = rr ? rz1 : rz0;
#pragma unroll
                        for (int j = 0; j < 4; ++j) { xv[rr][j] = xv[rr][j] + zz[rr][j] * rz * gpv[j];
                            s2[rr] += (xv[rr][j].x * xv[rr][j].x + xv[rr][j].y * xv[rr][j].y) + (xv[rr][j].z * xv[rr][j].z + xv[rr][j].w * xv[rr][j].w); } }
#pragma unroll
                    for (int rr = 0; rr < 2; ++rr) { if (rr == 1 && !two) break; const int mrow = mrow0 + rr * NGW;
#pragma unroll
                        for (int j = 0; j < 4; ++j) ((f32x4*)(P.out + (size_t)mrow * DM))[lane + 64 * j] = xv[rr][j]; }
                    if (l + 1 < NLAYER) {
                        const float r0 = rsqrtf(wave_sum(s2[0]) * (1.f / DM) + EPS), r1 = rsqrtf(wave_sum(s2[1]) * (1.f / DM) + EPS);
#pragma unroll
                        for (int rr = 0; rr < 2; ++rr) { if (rr == 1 && !two) break; const int mrow = mrow0 + rr * NGW; const float rs = rr ? r1 : r0;
#pragma unroll
                            for (int j = 0; j < 4; ++j) { u32x2 o; o.x = pk2(xv[rr][j].x * rs, xv[rr][j].y * rs); o.y = pk2(xv[rr][j].z * rs, xv[rr][j].w * rs); ((u32x2*)(XN + (size_t)mrow * DM))[lane + 64 * j] = o; } }
                    }
                }
            }
            }
        }
        if (ph + 1 < P.ph_hi) {
#if MK_COOP
            if (P.ph_hi < 0) grid.sync();
            xcd_barrier(bar);
#endif
        }
    }
}
}

extern "C" void kernel_launch(void* const* d_in, const int* in_sizes, int n_in, void* d_out, int out_size, void* d_ws, size_t ws_size, hipStream_t stream) {
    using namespace mk;
    static int grid = 0;
    if (grid == 0) {
        if (n_in != 14 || out_size != M_TOK * DM || ws_size < WS_END) { fprintf(stderr, "kernel_launch: unexpected shapes (n_in %d out %d ws %zu)\n", n_in, out_size, ws_size); grid = -1; return; }
        int dev = 0, cus = 0, per_cu = 0;
        (void)hipGetDevice(&dev); (void)hipDeviceGetAttribute(&cus, hipDeviceAttributeMultiprocessorCount, dev);
        if (hipFuncSetAttribute((const void*)fwd, hipFuncAttributeMaxDynamicSharedMemorySize, LDS_BYTES) != hipSuccess) { fprintf(stderr, "kernel_launch: hipFuncSetAttribute failed\n"); grid = -1; return; }
        if (hipOccupancyMaxActiveBlocksPerMultiprocessor(&per_cu, (const void*)fwd, NTHREADS, LDS_BYTES) != hipSuccess || per_cu < 1) { fprintf(stderr, "kernel_launch: occupancy query says %d\n", per_cu); per_cu = 1; }
        (void)hipGetLastError();
        if (cus < 256) { fprintf(stderr, "kernel_launch: built for a 256-CU device (one workgroup per CU), found %d CUs\n", cus); grid = -1; return; }
        grid = 256;
    }
    if (grid < 0) return;
    (void)hipMemsetAsync((char*)d_ws + WS_CTL, 0, CTL_BYTES, stream);
    Params p{};
    p.x = (const float*)d_in[0]; p.pos = (const int*)d_in[1]; p.norm_pre = (const float*)d_in[2]; p.w_in = (const float*)d_in[3]; p.sinks = (const float*)d_in[4];
    p.conv_w = (const float*)d_in[5]; p.conv_b = (const float*)d_in[6]; p.g_cq = (const float*)d_in[7]; p.w_uq = (const float*)d_in[8]; p.g_ckv = (const float*)d_in[9];
    p.w_ukv = (const float*)d_in[10]; p.g_grp = (const float*)d_in[11]; p.w_out = (const float*)d_in[12]; p.g_post = (const float*)d_in[13];
    p.out = (float*)d_out; p.ws = (unsigned char*)d_ws;
    constexpr int NPH = 1 + 6 * NLAYER;
#if MK_COOP
    p.ph_lo = 0; p.ph_hi = NPH;
    void* args[] = {&p};
    hipError_t e = hipLaunchCooperativeKernel((const void*)fwd, dim3(grid), dim3(NTHREADS), args, LDS_BYTES, stream);
    if (e != hipSuccess) fprintf(stderr, "kernel_launch: cooperative launch failed: %s (grid %d)\n", hipGetErrorString(e), grid);
#else
    for (int ph = 0; ph < NPH; ++ph) { p.ph_lo = ph; p.ph_hi = ph + 1; hipLaunchKernelGGL(fwd, dim3(grid), dim3(NTHREADS), LDS_BYTES, stream, p); }
#endif
}
```

```cpp
#include <hip/hip_runtime.h>
#include <hip/hip_cooperative_groups.h>
#include <cstdio>
#include <cstdint>
#include <cmath>
namespace pg8 {
#define PG8_LAS __attribute__((address_space(3)))
typedef unsigned short bf16_t;
typedef short bf16x8 __attribute__((ext_vector_type(8)));
typedef float f32x4 __attribute__((ext_vector_type(4)));
typedef unsigned u32x4 __attribute__((ext_vector_type(4)));
constexpr int BM = 256, BK = 64, HALF = 128, HTB = HALF * BK * 2  , STAGE_BYTES = 8 * HTB, NXCD = 8, WGM = 8;

__host__ __device__ __forceinline__ int lds_byte(int r, int c) { const int st = (r >> 4) * 2 + (c >> 5), rr = r & 15, cc = c & 31, ob = rr * 64 + cc * 2; return st * 1024 + (ob ^ (((ob >> 9) & 1) << 5)); }
__host__ __device__ __forceinline__ void stage_rc(int b, int& R, int& C) { const int st = b / 1024, sb = b % 1024, swz = sb ^ (((sb >> 9) & 1) << 5); R = (st >> 1) * 16 + swz / 64; C = (st & 1) * 32 + (swz % 64) / 2; }
__host__ __device__ __forceinline__ int perm32(int rho) { const int n = rho >> 4, i = rho & 15; return 8 * (i >> 2) + 4 * n + (i & 3); }

struct Unit { int pm, pn; };
struct Gemm { const bf16_t* A; const bf16_t* Bt; int M, N, K; };

struct StaticOrder {
    int nM, nN, nwg, G, c;
    __host__ __device__ void init(int M, int N, int G_, int c_) { nM = M / BM; nN = N / BM; nwg = nM * nN; G = G_; c = c_; }
    __host__ __device__ bool next(int i, Unit& u) const {
        const long L = (long)i * G + c; if (L >= nwg) return false;
        int wgid = (int)L; { const int q = nwg / NXCD, r = nwg % NXCD, xcd = wgid % NXCD, off = wgid / NXCD; wgid = (xcd < r ? xcd * (q + 1) : r * (q + 1) + (xcd - r) * q) + off; }
        const int nig = WGM * nN, gid = wgid / nig, fm = gid * WGM, gsz = (nM - fm) < WGM ? (nM - fm) : WGM;
        u.pm = fm + ((wgid % nig) % gsz); u.pn = (wgid % nig) / gsz; return true;
    }
    __device__ __forceinline__ void a_ready(const Unit&) const {}
    __device__ __forceinline__ void done(const Unit&) const {}
};

__device__ __forceinline__ unsigned cvt_pk_bf16(float lo, float hi) { unsigned r; asm volatile("v_cvt_pk_bf16_f32 %0, %1, %2" : "=v"(r) : "v"(lo), "v"(hi)); return r; }
typedef float f32x2 __attribute__((ext_vector_type(2)));
__device__ __forceinline__ f32x2 gelu_pk(f32x2 v) {
    const f32x2 av = __builtin_elementwise_abs(v), d = av * 0.2316418882f + 1.0f;
    f32x2 t; t.x = __builtin_amdgcn_rcpf(d.x); t.y = __builtin_amdgcn_rcpf(d.y);
    f32x2 q = t * 0.5307027145f + (-0.7265760135f); q = q * t + 0.7107068705f; q = q * t + (-0.142248368f); q = q * t + 0.127414796f; q = q * t;
    const f32x2 s = (v * v) * (-0.72134752044f);
    f32x2 e; e.x = __builtin_amdgcn_exp2f(s.x); e.y = __builtin_amdgcn_exp2f(s.y);
    const f32x2 m = v * (q * e), r = v - m;
    f32x2 o; o.x = v.x < 0.f ? m.x : r.x; o.y = v.y < 0.f ? m.y : r.y; return o;
}

template <int ACT  > struct EpiBf16 {
    static constexpr bool PERM = true, AFTER_DRAIN = false; static_assert(ACT == 0 || ACT == 1, "EpiBf16: ACT is 0 (none) or 1 (gelu_pk)");
    bf16_t* O; int ldc; const float* bias; int split_cols; size_t split_stride; float scale0;
    __device__ __forceinline__ void operator()(const f32x4 (&acc)[2][2][4][2], const Unit& u, int wr, int wc, int fr, int fq) const {
        const int row0 = u.pm * BM + wr * 64 + fr; int colt = u.pn * BM; bf16_t* base = O;
        float sc = 1.f; if (split_cols) { const int t = colt / split_cols; base += (size_t)t * split_stride; colt -= t * split_cols; if (t == 0) sc = scale0; }
        const int col0 = colt + wc * 32 + 8 * fq, bcol0 = u.pn * BM + wc * 32 + 8 * fq;
        f32x4 bv[2][2];
#pragma unroll
        for (int bj = 0; bj < 2; ++bj)
#pragma unroll
            for (int n = 0; n < 2; ++n) bv[bj][n] = bias ? *(const f32x4*)(bias + bcol0 + bj * HALF + 4 * n) : (f32x4){0.f, 0.f, 0.f, 0.f};
#pragma unroll
        for (int ai = 0; ai < 2; ++ai)
#pragma unroll
            for (int m = 0; m < 4; ++m) { bf16_t* rowp = base + (size_t)(row0 + ai * HALF + m * 16) * ldc + col0;
#pragma unroll
                for (int bj = 0; bj < 2; ++bj) { f32x4 v0 = acc[ai][bj][m][0] + bv[bj][0], v1 = acc[ai][bj][m][1] + bv[bj][1];
                    if (ACT == 1) { f32x2 a = gelu_pk((f32x2){v0[0], v0[1]}), b = gelu_pk((f32x2){v0[2], v0[3]}), c = gelu_pk((f32x2){v1[0], v1[1]}), d = gelu_pk((f32x2){v1[2], v1[3]});
                        v0 = (f32x4){a.x, a.y, b.x, b.y}; v1 = (f32x4){c.x, c.y, d.x, d.y}; }
                    v0 = v0 * sc; v1 = v1 * sc; u32x4 w; w.x = cvt_pk_bf16(v0[0], v0[1]); w.y = cvt_pk_bf16(v0[2], v0[3]); w.z = cvt_pk_bf16(v1[0], v1[1]); w.w = cvt_pk_bf16(v1[2], v1[3]);
                    *(u32x4*)(rowp + bj * HALF) = w; } }
    }
};
template <class Epi, class Sched, bool ALIGN_EPI = false, bool SP2 = false>
__device__ __forceinline__ void gemm_phase(PG8_LAS unsigned char* lds, const Gemm g, const Sched& S, const Epi& E) {
    int tid_o = threadIdx.x; asm volatile("" : "+v"(tid_o));
    const int tid = tid_o, wid = __builtin_amdgcn_readfirstlane(tid >> 6), lane = tid & 63, wr = wid >> 2, wc = wid & 3, fr = lane & 15, fq = lane >> 4;
    const int K = g.K, nt = K / BK;
    unsigned voffA[2], voffB[2];
#pragma unroll
    for (int i = 0; i < 2; ++i) { int R, C; stage_rc(tid * 16 + i * 8192, R, C); const int Rb = Epi::PERM ? ((R & ~31) + perm32(R & 31)) : R;
        voffA[i] = (unsigned)(R * K + C) * 2u; voffB[i] = (unsigned)(Rb * K + C) * 2u; }
    const size_t kstep = (size_t)(BK * 2);
    const size_t hstep = (size_t)HALF * K * 2;
    const size_t tstep = 2 * hstep;
    const unsigned ldsw = (unsigned)wid * 1024u;
    const int aoff = lds_byte(wr * 64 + fr, fq * 8), boff = lds_byte(wc * 32 + fr, fq * 8);
#define PG8_SA(b, h) (((b) * 2 + (h)) * HTB)
#define PG8_SB(b, h) ((4 + (b) * 2 + (h)) * HTB)
#define PG8_STAGE(bufoff, gbase, voff) do { _Pragma("unroll") for (int _i = 0; _i < 2; ++_i) \
        __builtin_amdgcn_global_load_lds((const unsigned*)((const char*)(gbase) + (voff)[_i]), (PG8_LAS unsigned*)(lds + (bufoff) + ldsw + _i * 8192), 16, 0, 0); } while (0)
#define PG8_LDA(dst, b, h) do { _Pragma("unroll") for (int m = 0; m < 4; ++m) _Pragma("unroll") for (int k = 0; k < 2; ++k) dst[m][k] = *(const PG8_LAS bf16x8*)(lds + PG8_SA(b, h) + aoff + m * 2048 + k * 1024); } while (0)
#define PG8_LDB(dst, b, h) do { _Pragma("unroll") for (int n = 0; n < 2; ++n) _Pragma("unroll") for (int k = 0; k < 2; ++k) dst[n][k] = *(const PG8_LAS bf16x8*)(lds + PG8_SB(b, h) + boff + n * 2048 + k * 1024); } while (0)
#define PG8_MMA(ai, bj, At, Bt) do { __builtin_amdgcn_s_setprio(1); _Pragma("unroll") for (int m = 0; m < 4; ++m) _Pragma("unroll") for (int n = 0; n < 2; ++n) _Pragma("unroll") for (int k = 0; k < 2; ++k) \
        acc[ai][bj][m][n] = __builtin_amdgcn_mfma_f32_16x16x32_bf16(Bt[n][k], At[m][k], acc[ai][bj][m][n], 0, 0, 0); __builtin_amdgcn_s_setprio(0); } while (0)
#define PG8_WAIT_V(n) asm volatile("s_waitcnt vmcnt(" #n ")" ::: "memory")
#define PG8_WAIT_L(n) asm volatile("s_waitcnt lgkmcnt(" #n ")" ::: "memory")
#define PG8_BAR __builtin_amdgcn_s_barrier()
#define PG8_SCHED __builtin_amdgcn_sched_barrier(0)
    Unit cur, nxt; int ui = 0;
    if (!S.next(0, cur)) return;
    f32x4 acc[2][2][4][2];
#pragma unroll
    for (int a = 0; a < 2; ++a)
#pragma unroll
        for (int b = 0; b < 2; ++b)
#pragma unroll
            for (int m = 0; m < 4; ++m)
#pragma unroll
                for (int n = 0; n < 2; ++n) acc[a][b][m][n] = (f32x4){0.f, 0.f, 0.f, 0.f};
    bf16x8 At[4][2], B0[2][2], B1[2][2];
    const char* cA = (const char*)g.A + (size_t)cur.pm * tstep; const char* cB = (const char*)g.Bt + (size_t)cur.pn * tstep;
    S.a_ready(cur);
    if constexpr (SP2) {
        PG8_STAGE(PG8_SB(0, 0), cB, voffB); PG8_STAGE(PG8_SB(0, 1), cB + hstep, voffB); PG8_STAGE(PG8_SA(0, 0), cA, voffA); PG8_STAGE(PG8_SA(0, 1), cA + hstep, voffA);
        if (wr == 1) PG8_BAR;
        PG8_WAIT_V(2); PG8_BAR;
        PG8_STAGE(PG8_SB(1, 0), cB + kstep, voffB); PG8_STAGE(PG8_SA(1, 0), cA + kstep, voffA); PG8_STAGE(PG8_SB(1, 1), cB + hstep + kstep, voffB);
        PG8_WAIT_V(6); PG8_BAR;
    } else {
        PG8_STAGE(PG8_SB(0, 0), cB, voffB); PG8_STAGE(PG8_SA(0, 0), cA, voffA); PG8_STAGE(PG8_SB(0, 1), cB + hstep, voffB); PG8_STAGE(PG8_SA(0, 1), cA + hstep, voffA);
        if (wr == 1) PG8_BAR;
        PG8_WAIT_V(4); PG8_BAR;
        PG8_STAGE(PG8_SB(1, 0), cB + kstep, voffB); PG8_STAGE(PG8_SA(1, 0), cA + kstep, voffA); PG8_STAGE(PG8_SB(1, 1), cB + hstep + kstep, voffB);
        PG8_WAIT_V(6); PG8_BAR;
    }
    for (;;) {
        const bool has_next = S.next(ui + 1, nxt);
        const char* nA = has_next ? (const char*)g.A + (size_t)nxt.pm * tstep : cA; const char* nB = has_next ? (const char*)g.Bt + (size_t)nxt.pn * tstep : cB;
        for (int t = 0; t < nt; t += 2) {
            const bool last = (t == nt - 2);
            const char* a1 = cA + (size_t)(t + 1) * kstep;
            const char* a2 = last ? nA : cA + (size_t)(t + 2) * kstep; const char* b2 = last ? nB : cB + (size_t)(t + 2) * kstep;
            const char* a3 = a2 + kstep; const char* b3 = b2 + kstep;
            if (last && has_next) S.a_ready(nxt);
            if constexpr (SP2) {
            PG8_LDB(B0, 0, 0); PG8_LDB(B1, 0, 1); PG8_SCHED; PG8_LDA(At, 0, 0); PG8_STAGE(PG8_SA(1, 1), a1 + hstep, voffA);
            PG8_WAIT_V(8); PG8_WAIT_L(0); PG8_BAR; PG8_MMA(0, 0, At, B0); PG8_MMA(0, 1, At, B1); PG8_BAR; PG8_SCHED;
            PG8_LDA(At, 0, 1); PG8_STAGE(PG8_SB(0, 0), b2, voffB); PG8_STAGE(PG8_SB(0, 1), b2 + hstep, voffB); PG8_STAGE(PG8_SA(0, 0), a2, voffA);
            PG8_WAIT_V(8); PG8_WAIT_L(0); PG8_BAR; PG8_MMA(1, 0, At, B0); PG8_MMA(1, 1, At, B1); PG8_BAR; PG8_SCHED;
            PG8_LDB(B0, 1, 0); PG8_LDB(B1, 1, 1); PG8_SCHED; PG8_LDA(At, 1, 0); PG8_STAGE(PG8_SA(0, 1), a2 + hstep, voffA);
            PG8_WAIT_V(8); PG8_WAIT_L(0); PG8_BAR; PG8_MMA(0, 0, At, B0); PG8_MMA(0, 1, At, B1); PG8_BAR; PG8_SCHED;
            PG8_LDA(At, 1, 1); PG8_STAGE(PG8_SB(1, 0), b3, voffB); PG8_STAGE(PG8_SB(1, 1), b3 + hstep, voffB); PG8_STAGE(PG8_SA(1, 0), a3, voffA);
            PG8_WAIT_V(8); PG8_WAIT_L(0); PG8_BAR; PG8_MMA(1, 0, At, B0); PG8_MMA(1, 1, At, B1); PG8_BAR; PG8_SCHED;
            } else {
            PG8_LDB(B0, 0, 0); PG8_SCHED; PG8_LDA(At, 0, 0); PG8_STAGE(PG8_SA(1, 1), a1 + hstep, voffA);
            PG8_WAIT_L(8); PG8_BAR; PG8_WAIT_L(0); PG8_MMA(0, 0, At, B0); PG8_BAR; PG8_SCHED;
            PG8_LDB(B1, 0, 1); PG8_STAGE(PG8_SB(0, 0), b2, voffB);
            PG8_BAR; PG8_WAIT_L(0); PG8_MMA(0, 1, At, B1); PG8_BAR;
            PG8_LDA(At, 0, 1); PG8_STAGE(PG8_SA(0, 0), a2, voffA);
            PG8_BAR; PG8_WAIT_L(0); PG8_MMA(1, 0, At, B0); PG8_BAR; PG8_SCHED;
            PG8_STAGE(PG8_SB(0, 1), b2 + hstep, voffB);
            PG8_WAIT_V(6); PG8_BAR; PG8_MMA(1, 1, At, B1); PG8_BAR;
            PG8_LDB(B0, 1, 0); PG8_SCHED; PG8_LDA(At, 1, 0); PG8_STAGE(PG8_SA(0, 1), a2 + hstep, voffA);
            PG8_WAIT_L(8); PG8_BAR; PG8_WAIT_L(0); PG8_MMA(0, 0, At, B0); PG8_BAR; PG8_SCHED;
            PG8_LDB(B1, 1, 1); PG8_STAGE(PG8_SB(1, 0), b3, voffB);
            PG8_BAR; PG8_WAIT_L(0); PG8_MMA(0, 1, At, B1); PG8_BAR;
            PG8_LDA(At, 1, 1); PG8_STAGE(PG8_SA(1, 0), a3, voffA);
            PG8_BAR; PG8_WAIT_L(0); PG8_MMA(1, 0, At, B0); PG8_BAR; PG8_SCHED;
            PG8_STAGE(PG8_SB(1, 1), b3 + hstep, voffB);
            PG8_WAIT_V(6); PG8_BAR; PG8_MMA(1, 1, At, B1); PG8_BAR;
            }
        }
        if constexpr (ALIGN_EPI) { if (wr == 0) PG8_BAR; }
        if constexpr (!Epi::AFTER_DRAIN) { E(acc, cur, wr, wc, fr, fq); S.done(cur); }
        if (!has_next) break;
#pragma unroll
        for (int a = 0; a < 2; ++a)
#pragma unroll
            for (int b = 0; b < 2; ++b)
#pragma unroll
                for (int m = 0; m < 4; ++m)
#pragma unroll
                    for (int n = 0; n < 2; ++n) acc[a][b][m][n] = (f32x4){0.f, 0.f, 0.f, 0.f};
        cur = nxt; cA = nA; cB = nB; ++ui;
        if constexpr (ALIGN_EPI) { if (wr == 1) PG8_BAR; }
    }
    PG8_WAIT_V(0);
    if constexpr (!ALIGN_EPI) { if (wr == 0) PG8_BAR; }
    PG8_BAR;
    if constexpr (Epi::AFTER_DRAIN) { E.fused(acc, cur, wr, wc, fr, fq, lds, wid, lane); S.done(cur); }
#undef PG8_SA
#undef PG8_SB
#undef PG8_STAGE
#undef PG8_LDA
#undef PG8_LDB
#undef PG8_MMA
#undef PG8_WAIT_V
#undef PG8_WAIT_L
#undef PG8_BAR
#undef PG8_SCHED
}
}
#ifndef MK_COOP
#define MK_COOP 1
#endif
#ifndef MK_REP_K
#define MK_REP_K -1
#endif
#ifndef MK_REP_N
#define MK_REP_N 1
#endif
namespace mk {
using pg8::bf16_t; using pg8::bf16x8; using pg8::f32x4; using pg8::u32x4;
typedef float f32x16 __attribute__((ext_vector_type(16)));
typedef unsigned u32x2 __attribute__((ext_vector_type(2)));
typedef float f32x2_t __attribute__((ext_vector_type(2)));
typedef __bf16 bf16x2_t __attribute__((ext_vector_type(2)));
#define LAS __attribute__((address_space(3)))
#define MFMA32(a, b, c) __builtin_amdgcn_mfma_f32_32x32x16_bf16((a), (b), (c), 0, 0, 0)

constexpr int M_TOK = 16384, SEQ = 8192, DM = 1024, DIN = 3488, DINP = 3584, NLAYER = 2;
constexpr int C_AQ = 0, C_AK = 256, C_AV = 384, C_BB = 512, C_BC = 768, C_BX = 1024, C_CQ = 1280, C_CKV = 1536, C_CKR = 1664,
              C_DQ = 1696, C_DK = 1952, C_DV = 2208, C_GATE = 2464;
constexpr float EPS = 1e-6f, LOG2E = 1.4426950408889634f;
constexpr float SC64 = 0.125f * LOG2E;
constexpr float QSC_MLA = 0.10206207261596575f * LOG2E;
constexpr int NWAVES = 8, NTHREADS = 512;
constexpr int LDS_BYTES = 122880 + 8 * 4096 + 1024;

constexpr size_t MiB = 1u << 20;
constexpr size_t WS_CTL = 0, CTL_BYTES = 65536;
constexpr int CW_BAR = 1024;
constexpr size_t WS_WIN = 1 * MiB;
constexpr size_t WS_WOUT = 15 * MiB;
constexpr size_t WS_WUQ = 19 * MiB;
constexpr size_t WS_WUKV = 19 * MiB + 512 * 1024;
constexpr size_t WS_XN = 32 * MiB;
constexpr size_t WS_H = 64 * MiB;
constexpr size_t WS_QC = 176 * MiB;
constexpr size_t WS_KC = 188 * MiB;
constexpr size_t WS_VTC = 200 * MiB;
constexpr size_t WS_VTA = 208 * MiB;
constexpr size_t WS_VTD = 212 * MiB;
constexpr size_t WS_Y = 220 * MiB;
constexpr size_t WS_END = 252 * MiB;

struct Params {
    const float* x; const int* pos; const float* norm_pre; const float* w_in; const float* sinks; const float* conv_w; const float* conv_b;
    const float* g_cq; const float* w_uq; const float* g_ckv; const float* w_ukv; const float* g_grp; const float* w_out; const float* g_post;
    float* out; unsigned char* ws; int ph_lo, ph_hi;
};

__device__ __forceinline__ unsigned pk2(float lo, float hi) { f32x2_t v = {lo, hi}; bf16x2_t b = __builtin_convertvector(v, bf16x2_t); return __builtin_bit_cast(unsigned, b); }
__device__ __forceinline__ float bf2f(short s) { return __uint_as_float(((unsigned)(unsigned short)s) << 16); }
__device__ __forceinline__ float bflo(unsigned u) { return __uint_as_float(u << 16); }
__device__ __forceinline__ float bfhi(unsigned u) { return __uint_as_float(u & 0xffff0000u); }
__device__ __forceinline__ bf16_t f2bf(float f) { return (bf16_t)(pk2(f, 0.f) & 0xffffu); }
__device__ __forceinline__ int crow(int i, int h) { return (i & 3) + 8 * (i >> 2) + 4 * h; }
__device__ __forceinline__ float ex2(float x) { return __builtin_amdgcn_exp2f(x); }
__device__ __forceinline__ float lg2(float x) { return __builtin_amdgcn_logf(x); }
__device__ __forceinline__ float xh_max(float v) { auto rr = __builtin_amdgcn_permlane32_swap(__float_as_uint(v), __float_as_uint(v), false, false); return fmaxf(__uint_as_float(rr[0]), __uint_as_float(rr[1])); }
__device__ __forceinline__ float xh_sum(float v) { auto rr = __builtin_amdgcn_permlane32_swap(__float_as_uint(v), __float_as_uint(v), false, false); return __uint_as_float(rr[0]) + __uint_as_float(rr[1]); }
__device__ __forceinline__ float xh_other(float v, int h) { auto rr = __builtin_amdgcn_permlane32_swap(__float_as_uint(v), __float_as_uint(v), false, false); return __uint_as_float(h ? rr[0] : rr[1]); }
#define MX3(a, b, c) __builtin_fmaxf(__builtin_fmaxf((a), (b)), (c))
__device__ __forceinline__ float wave_sum(float v) {
#pragma unroll
    for (int o = 1; o < 64; o <<= 1) v += __shfl_xor(v, o);
    return v;
}
__device__ __forceinline__ bf16x8 pack8(const float* e) {
    u32x4 w; w.x = pk2(e[0], e[1]); w.y = pk2(e[2], e[3]); w.z = pk2(e[4], e[5]); w.w = pk2(e[6], e[7]);
    return __builtin_bit_cast(bf16x8, w);
}

__device__ __forceinline__ void conv_wT(const float* __restrict__ W, int K, int N, int NP, const float* __restrict__ gain, bf16_t* __restrict__ dst,
                                        int a0, int a1, int b0, int b1, float sc, int gtid, int gthreads) {
    const int k8n = K / 8; const int items = NP * k8n;
#pragma unroll 2
    for (int it = gtid; it < items; it += gthreads) {
        const int n = it % NP, k8 = it / NP;
        u32x4 o = {0u, 0u, 0u, 0u};
        if (n < N) {
            const float cs = ((n >= a0 && n < a1) || (n >= b0 && n < b1)) ? sc : 1.f;
            float v[8];
#pragma unroll
            for (int j = 0; j < 8; ++j) v[j] = W[(size_t)(k8 * 8 + j) * N + n] * gain[k8 * 8 + j] * cs;
            o.x = pk2(v[0], v[1]); o.y = pk2(v[2], v[3]); o.z = pk2(v[4], v[5]); o.w = pk2(v[6], v[7]);
        }
        *(u32x4*)(dst + (size_t)n * K + k8 * 8) = o;
    }
}
__device__ __forceinline__ void wT_item(const float* __restrict__ W, int K, int N, const float* __restrict__ gain, bf16_t* __restrict__ WT, int a0, int a1, int b0, int b1, float sc,
                                        LAS float* scr, int item, int lane) {
    const int nblk = N / 32, kb = item / nblk, nb = item - kb * nblk, k0 = 64 * kb, n0 = 32 * nb;
#pragma unroll 8
    for (int i = 0; i < 32; ++i) { const int kk = 2 * i + (lane >> 5); scr[kk * 33 + (lane & 31)] = W[(size_t)(k0 + kk) * N + n0 + (lane & 31)]; }
    const int c = lane & 7;
    float g8[8];
#pragma unroll
    for (int j = 0; j < 8; ++j) g8[j] = gain[k0 + 8 * c + j];
#pragma unroll
    for (int j = 0; j < 4; ++j) { const int n = (lane >> 3) + 8 * j, nn = n0 + n; const LAS float* sp = scr + (8 * c) * 33 + n;
        const float cs = ((nn >= a0 && nn < a1) || (nn >= b0 && nn < b1)) ? sc : 1.f;
        u32x4 o; o.x = pk2(sp[0 * 33] * g8[0] * cs, sp[1 * 33] * g8[1] * cs); o.y = pk2(sp[2 * 33] * g8[2] * cs, sp[3 * 33] * g8[3] * cs);
        o.z = pk2(sp[4 * 33] * g8[4] * cs, sp[5 * 33] * g8[5] * cs); o.w = pk2(sp[6 * 33] * g8[6] * cs, sp[7 * 33] * g8[7] * cs);
        *(u32x4*)(WT + (size_t)nn * K + k0 + 8 * c) = o; }
}
__device__ __forceinline__ void rms_row_to_bf16(const float* __restrict__ xrow, bf16_t* __restrict__ orow, int lane) {
    f32x4 v[4]; float s = 0.f;
#pragma unroll
    for (int j = 0; j < 4; ++j) { v[j] = ((const f32x4*)xrow)[lane + 64 * j]; s += (v[j].x * v[j].x + v[j].y * v[j].y) + (v[j].z * v[j].z + v[j].w * v[j].w); }
    const float rs = rsqrtf(wave_sum(s) * (1.f / DM) + EPS);
#pragma unroll
    for (int j = 0; j < 4; ++j) { u32x2 o; o.x = pk2(v[j].x * rs, v[j].y * rs); o.y = pk2(v[j].z * rs, v[j].w * rs); ((u32x2*)orow)[lane + 64 * j] = o; }
}

__device__ __forceinline__ void rope_cs(int pos, int h, float (&cs)[8], float (&sn)[8]) {
#pragma unroll
    for (int i = 0; i < 8; ++i) {
        const int f = (i & 3) + 8 * (i >> 2) + 4 * h;
        const float freq = ex2(-(float)f * 0.830482023721841f);
        const float ang = (float)pos * freq;
        const double rev = (double)ang * 0.15915494309189535;
        const float fr = (float)(rev - __builtin_rint(rev));
        cs[i] = __builtin_amdgcn_cosf(fr); sn[i] = __builtin_amdgcn_sinf(fr);
    }
}
__device__ __forceinline__ void rope_apply(f32x16& a, const float (&cs)[8], const float (&sn)[8]) {
#pragma unroll
    for (int i = 0; i < 8; ++i) { const float x1 = a[i], x2 = a[i + 8]; a[i] = x1 * cs[i] - x2 * sn[i]; a[i + 8] = x1 * sn[i] + x2 * cs[i]; }
}
__device__ __forceinline__ void store_tile_rowmajor(bf16_t* dst  , const f32x16& a, int h) {
#pragma unroll
    for (int g = 0; g < 4; ++g) { u32x2 o; o.x = pk2(a[4 * g], a[4 * g + 1]); o.y = pk2(a[4 * g + 2], a[4 * g + 3]); *(u32x2*)(dst + 8 * g + 4 * h) = o; }
}
constexpr int WQP = 528, WKP = 272, WQ_BYTES = 96 * WQP;
__device__ __forceinline__ void mq_unit(const bf16_t* __restrict__ H, const LAS unsigned char* Wl, const int* __restrict__ pos, bf16_t* __restrict__ QC, int tb, int hh, int lane) {
    const int r = lane & 31, h = lane >> 5, tok = tb * 32 + r;
    const bf16_t* src = H + (size_t)tok * DINP + C_CQ + 8 * h;
    bf16x8 bfr[16]; float ss = 0.f;
#pragma unroll
    for (int s = 0; s < 16; ++s) { bfr[s] = *(const bf16x8*)(src + 16 * s);
#pragma unroll
        for (int j = 0; j < 8; ++j) { const float v = bf2f(bfr[s][j]); ss += v * v; } }
    ss += __shfl_xor(ss, 32);
    const float rs = rsqrtf(ss * (1.f / 256.f) + EPS) * QSC_MLA;
    float cs[8], sn[8]; rope_cs(pos[tok], h, cs, sn);
    const LAS unsigned char* W = Wl + r * WQP + 16 * h;
#pragma unroll 1
    for (int nt = 0; nt < 3; ++nt) {
        f32x16 acc;
#pragma unroll
        for (int i = 0; i < 16; ++i) acc[i] = 0.f;
#pragma unroll
        for (int s = 0; s < 16; ++s) { const bf16x8 a = *(const LAS bf16x8*)(W + nt * 32 * WQP + 32 * s); acc = MFMA32(a, bfr[s], acc); }
#pragma unroll
        for (int i = 0; i < 16; ++i) acc[i] *= rs;
        if (nt == 2) rope_apply(acc, cs, sn);
        store_tile_rowmajor(QC + (size_t)tok * 384 + hh * 96 + nt * 32, acc, h);
    }
}
__device__ __forceinline__ void vt_flush(LAS bf16_t* stg, bf16_t* __restrict__ dst  , int lane) {
    const LAS u32x4* rp = (const LAS u32x4*)(stg + lane * 32);
    u32x4 w[4];
#pragma unroll
    for (int c = 0; c < 4; ++c) w[c] = rp[c];
    u32x4* gp = (u32x4*)(dst + (size_t)lane * SEQ);
#pragma unroll
    for (int c = 0; c < 4; ++c) gp[c] = w[c];
}
__device__ __forceinline__ void mkv_unit(const bf16_t* __restrict__ H, const LAS unsigned char* Wl, const int* __restrict__ pos, bf16_t* __restrict__ KC, bf16_t* __restrict__ VTC, int tb, int hh, int lane, LAS bf16_t* stg) {
    const int r = lane & 31, h = lane >> 5, tok = tb * 32 + r;
    const bf16_t* src = H + (size_t)tok * DINP + C_CKV + 8 * h;
    bf16x8 bfr[8]; float ss = 0.f;
#pragma unroll
    for (int s = 0; s < 8; ++s) { bfr[s] = *(const bf16x8*)(src + 16 * s);
#pragma unroll
        for (int j = 0; j < 8; ++j) { const float v = bf2f(bfr[s][j]); ss += v * v; } }
    ss += __shfl_xor(ss, 32);
    const float rs = rsqrtf(ss * (1.f / 128.f) + EPS);
    const LAS unsigned char* W = Wl + r * WKP + 16 * h;
    const int b = (tb * 32) / SEQ, t0 = (tb * 32) % SEQ;
#pragma unroll 1
    for (int nt = 0; nt < 4; ++nt) {
        f32x16 acc;
#pragma unroll
        for (int i = 0; i < 16; ++i) acc[i] = 0.f;
#pragma unroll
        for (int s = 0; s < 8; ++s) { const bf16x8 a = *(const LAS bf16x8*)(W + nt * 32 * WKP + 32 * s); acc = MFMA32(a, bfr[s], acc); }
#pragma unroll
        for (int i = 0; i < 16; ++i) acc[i] *= rs;
        if (nt < 2) store_tile_rowmajor(KC + (size_t)tok * 384 + hh * 96 + nt * 32, acc, h);
        else {
            LAS bf16_t* sp = stg + ((nt - 2) * 32 + 4 * h) * 32 + r;
#pragma unroll
            for (int i = 0; i < 16; ++i) sp[((i & 3) + 8 * (i >> 2)) * 32] = f2bf(acc[i]);
        }
    }
    vt_flush(stg, VTC + ((size_t)((b * 4 + hh) * 64)) * SEQ + t0, lane);
    f32x16 kr;
    const bf16_t* krp = H + (size_t)tok * DINP + C_CKR + 4 * h;
#pragma unroll
    for (int g = 0; g < 4; ++g) { const u32x2 w = *(const u32x2*)(krp + 8 * g); kr[4 * g] = bflo(w.x); kr[4 * g + 1] = bfhi(w.x); kr[4 * g + 2] = bflo(w.y); kr[4 * g + 3] = bfhi(w.y); }
    float cs[8], sn[8]; rope_cs(pos[tok], h, cs, sn);
    rope_apply(kr, cs, sn);
    store_tile_rowmajor(KC + (size_t)tok * 384 + hh * 96 + 64, kr, h);
}
__device__ __forceinline__ void vt_unit(const bf16_t* __restrict__ H, int col0, int NH, bf16_t* __restrict__ VT, int tb, int head, int lane, LAS bf16_t* stg) {
    const int r = lane & 31, h = lane >> 5, tok = tb * 32 + r, b = (tb * 32) / SEQ, t0 = (tb * 32) % SEQ;
    const bf16_t* src = H + (size_t)tok * DINP + col0 + head * 64 + 32 * h;
    bf16x8 v[4];
#pragma unroll
    for (int c = 0; c < 4; ++c) v[c] = *(const bf16x8*)(src + 8 * c);
    LAS bf16_t* sp = stg + (32 * h) * 32 + r;
#pragma unroll
    for (int c = 0; c < 4; ++c)
#pragma unroll
        for (int j = 0; j < 8; ++j) sp[(8 * c + j) * 32] = (bf16_t)v[c][j];
    vt_flush(stg, VT + ((size_t)((b * NH + head) * 64)) * SEQ + t0, lane);
}
__device__ __forceinline__ void conv_unit(const bf16_t* __restrict__ H, const float* __restrict__ cw, const float* __restrict__ cb, bf16_t* __restrict__ Y, int tb8, int lane) {
    const int tok0 = tb8 * 8, t0 = tok0 % SEQ, ch = 4 * lane;
    const f32x4 w0 = *(const f32x4*)(cw + ch), w1 = *(const f32x4*)(cw + 256 + ch), w2 = *(const f32x4*)(cw + 512 + ch), bs = *(const f32x4*)(cb + ch);
    u32x2 cc[10], xx[10], bb[8];
    const int back = (t0 >= 2) ? 2 : 0;
#pragma unroll
    for (int i = 0; i < 10; ++i) { const int ti = (i < 2) ? (i - back) : (i - 2); const bf16_t* p = H + (size_t)(tok0 + ti) * DINP + ch;
        cc[i] = *(const u32x2*)(p + C_BC); xx[i] = *(const u32x2*)(p + C_BX); if (i >= 2) bb[i - 2] = *(const u32x2*)(p + C_BB); }
    f32x4 u[10];
#pragma unroll
    for (int i = 0; i < 10; ++i) u[i] = (f32x4){bflo(cc[i].x) * bflo(xx[i].x), bfhi(cc[i].x) * bfhi(xx[i].x), bflo(cc[i].y) * bflo(xx[i].y), bfhi(cc[i].y) * bfhi(xx[i].y)};
    if (back == 0) { u[0] = (f32x4){0.f, 0.f, 0.f, 0.f}; u[1] = (f32x4){0.f, 0.f, 0.f, 0.f}; }
#pragma unroll
    for (int i = 0; i < 8; ++i) {
        const f32x4 bg = {bflo(bb[i].x), bfhi(bb[i].x), bflo(bb[i].y), bfhi(bb[i].y)};
        const f32x4 y = bg * (w0 * u[i] + w1 * u[i + 1] + w2 * u[i + 2] + bs);
        u32x2 o; o.x = pk2(y.x, y.y); o.y = pk2(y.z, y.w);
        *(u32x2*)(Y + (size_t)(tok0 + i) * DM + 256 + ch) = o;
    }
}

__device__ __forceinline__ void o_flush(LAS bf16_t* stg, bf16_t* __restrict__ Orow0, int opitch, int lane) {
    u32x4 w[4];
#pragma unroll
    for (int j = 0; j < 4; ++j) w[j] = *(const LAS u32x4*)(stg + (lane + 64 * j) * 8);
#pragma unroll
    for (int j = 0; j < 4; ++j) { const int c = lane + 64 * j; *(u32x4*)(Orow0 + (size_t)(c >> 3) * opitch + (c & 7) * 8) = w[j]; }
}
template <int DKS, bool SINK>
__device__ __forceinline__ void softmax_unit(const bf16_t* __restrict__ Qrow0, int qpitch, const bf16_t* __restrict__ Kb, int kpitch, const bf16_t* __restrict__ VT,
                                             int qb, int kt_begin, int window, float sink2, bf16_t* __restrict__ Orow0, int opitch, int lane, LAS bf16_t* stg) {
    const int r = lane & 31, h = lane >> 5;
    const int pr = (r & ~12) | ((r & 8) >> 1) | ((r & 4) << 1);
    bf16x8 qf[DKS];
#pragma unroll
    for (int s = 0; s < DKS; ++s) qf[s] = *(const bf16x8*)(Qrow0 + (size_t)r * qpitch + 16 * s + 8 * h);
    f32x16 o0, o1;
#pragma unroll
    for (int i = 0; i < 16; ++i) { o0[i] = 0.f; o1[i] = 0.f; }
    float m = -1e30f, l = 0.f;
    const int kt_end = qb + 1, q = 32 * qb + r;
    const bf16_t* kp = Kb + (size_t)(32 * kt_begin + pr) * kpitch + 8 * h;
    const bf16_t* vp = VT + (size_t)r * SEQ + 32 * kt_begin + 8 * h;
    bf16x8 kf[DKS];
#pragma unroll
    for (int s = 0; s < DKS; ++s) kf[s] = *(const bf16x8*)(kp + 16 * s);
    for (int kt = kt_begin; kt < kt_end; ++kt) {
        bf16x8 kn[DKS];
        if (kt + 1 < kt_end) {
#pragma unroll
            for (int s = 0; s < DKS; ++s) kn[s] = *(const bf16x8*)(kp + (size_t)32 * kpitch + 16 * s);
        } else {
#pragma unroll
            for (int s = 0; s < DKS; ++s) kn[s] = kf[s];
        }
        const bf16x8 v00 = *(const bf16x8*)(vp), v01 = *(const bf16x8*)(vp + 32 * SEQ), v10 = *(const bf16x8*)(vp + 16), v11 = *(const bf16x8*)(vp + 32 * SEQ + 16);
        f32x16 p;
#pragma unroll
        for (int i = 0; i < 16; ++i) p[i] = 0.f;
#pragma unroll
        for (int s = 0; s < DKS; ++s) p = MFMA32(kf[s], qf[s], p);
        if (kt == qb || (window != 0 && kt == qb - (window >> 5))) {
            const int k0 = 32 * kt + 8 * h;
#pragma unroll
            for (int i = 0; i < 16; ++i) { const int kv = k0 + 16 * (i >> 3) + (i & 7); const bool ok = (kv <= q) && (window == 0 || kv > q - window); if (!ok) p[i] = -INFINITY; }
        }
        float rm = MX3(p[0], p[1], p[2]);
#pragma unroll
        for (int i = 3; i < 15; i += 2) rm = MX3(rm, p[i], p[i + 1]);
        rm = xh_max(fmaxf(rm, p[15]));
        if (__any(rm > m + 6.f)) {
            const float mn = fmaxf(m, rm), f = ex2(m - mn); m = mn; l *= f;
#pragma unroll
            for (int i = 0; i < 16; ++i) { const float fi = __shfl(f, crow(i, h)); o0[i] *= fi; o1[i] *= fi; }
        }
        float e[16];
#pragma unroll
        for (int i = 0; i < 16; ++i) { e[i] = ex2(p[i] - m); l += e[i]; }
        const bf16x8 pa0 = pack8(e), pa1 = pack8(e + 8);
        o0 = MFMA32(pa0, v00, o0); o1 = MFMA32(pa0, v01, o1);
        o0 = MFMA32(pa1, v10, o0); o1 = MFMA32(pa1, v11, o1);
#pragma unroll
        for (int s = 0; s < DKS; ++s) kf[s] = kn[s];
        kp += (size_t)32 * kpitch; vp += 32;
    }
    l = xh_sum(l);
    if (SINK) l += ex2(sink2 - m);
    const float inv = 1.f / l;
    LAS bf16_t* sp = stg + (4 * h) * 64 + r;
#pragma unroll
    for (int i = 0; i < 16; ++i) { const float fi = __shfl(inv, crow(i, h)); const int ro = ((i & 3) + 8 * (i >> 2)) * 64;
        sp[ro] = f2bf(o0[i] * fi); sp[ro + 32] = f2bf(o1[i] * fi); }
    o_flush(stg, Orow0, opitch, lane);
}


constexpr int KP = 208, VP = 272;
constexpr int KT_BYTES = 128 * KP, VT_BYTES = 64 * VP, TB_BYTES = KT_BYTES + VT_BYTES, MRG_OFF = 2 * TB_BYTES;
static_assert(MRG_OFF + 4 * 34 * 64 * 4 <= 131072, "MLA LDS map");
__device__ __forceinline__ void mla_unit_blk(const bf16_t* __restrict__ QC, const bf16_t* __restrict__ KC, const bf16_t* __restrict__ VTC, bf16_t* __restrict__ Y,
                                             int bh, int g, LAS unsigned char* lds, int tid) {
    const int lane = tid & 63, wave = __builtin_amdgcn_readfirstlane(tid >> 6), r = lane & 31, h = lane >> 5, w4 = wave & 3, kh = wave >> 2;
    const int pr = (r & ~12) | ((r & 8) >> 1) | ((r & 4) << 1);
    const int b = bh >> 2, hh = bh & 3, qb = 4 * g + w4, q = 32 * qb + r;
    const bf16_t* Qp = QC + ((size_t)b * SEQ + q) * 384 + hh * 96 + 8 * h;
    bf16x8 qf[6];
#pragma unroll
    for (int s = 0; s < 6; ++s) qf[s] = *(const bf16x8*)(Qp + 16 * s);
    const bf16_t* Kg = KC + (size_t)b * SEQ * 384 + hh * 96;
    const bf16_t* Vg = VTC + (size_t)(b * 4 + hh) * 64 * SEQ;
    int kgo[3], klo[3], vgo[2], vlo[2];
#pragma unroll
    for (int i = 0; i < 3; ++i) { const int c = tid + 512 * i, row = c / 12, cc = c - 12 * row; kgo[i] = row * 384 + 8 * cc; klo[i] = row * KP + 16 * cc; }
#pragma unroll
    for (int i = 0; i < 2; ++i) { const int c = tid + 512 * i, d = c >> 4, cc = c & 15; vgo[i] = d * SEQ + 8 * cc; vlo[i] = KT_BYTES + d * VP + 16 * cc; }
    u32x4 kr[3], vr[2];
#define MLA_LOAD(ST) do { _Pragma("unroll") for (int i = 0; i < 3; ++i) kr[i] = *(const u32x4*)(Kg + (size_t)(ST) * (128 * 384) + kgo[i]); \
                          _Pragma("unroll") for (int i = 0; i < 2; ++i) vr[i] = *(const u32x4*)(Vg + (ST) * 128 + vgo[i]); } while (0)
#define MLA_STORE(buf) do { LAS unsigned char* tb_ = lds + (buf) * TB_BYTES; _Pragma("unroll") for (int i = 0; i < 3; ++i) *(LAS u32x4*)(tb_ + klo[i]) = kr[i]; \
                            _Pragma("unroll") for (int i = 0; i < 2; ++i) *(LAS u32x4*)(tb_ + vlo[i]) = vr[i]; } while (0)
    f32x16 o0, o1;
#pragma unroll
    for (int i = 0; i < 16; ++i) { o0[i] = 0.f; o1[i] = 0.f; }
    float m = -1e30f, l = 0.f;
    const int nST = g + 1;
    MLA_LOAD(0); MLA_STORE(0);
    __syncthreads();
    const int kfo = (64 * kh + pr) * KP + 16 * h;
    const int vfo = KT_BYTES + r * VP + (64 * kh + 8 * h) * 2;
    for (int ST = 0; ST < nST; ++ST) {
        if (ST + 1 < nST) MLA_LOAD(ST + 1);
        const int kt0 = 4 * ST + 2 * kh;
        if (kt0 <= qb) {
            const LAS unsigned char* tb = lds + (ST & 1) * TB_BYTES;
            f32x16 p0, p1;
#pragma unroll
            for (int i = 0; i < 16; ++i) { p0[i] = 0.f; p1[i] = 0.f; }
#pragma unroll
            for (int s = 0; s < 6; ++s) { const bf16x8 k0 = *(const LAS bf16x8*)(tb + kfo + 32 * s), k1 = *(const LAS bf16x8*)(tb + kfo + 32 * KP + 32 * s);
                p0 = MFMA32(k0, qf[s], p0); p1 = MFMA32(k1, qf[s], p1); }
            if (kt0 + 1 >= qb) {
                const int kb0 = 32 * kt0 + 8 * h;
#pragma unroll
                for (int i = 0; i < 16; ++i) { const int kv = kb0 + 16 * (i >> 3) + (i & 7); if (kv > q) p0[i] = -INFINITY; if (kv + 32 > q) p1[i] = -INFINITY; }
            }
            float ra_ = MX3(p0[0], p0[1], p1[0]), rb_ = MX3(p0[2], p0[3], p1[1]); ra_ = MX3(ra_, p1[2], p1[3]);
#pragma unroll
            for (int i = 4; i < 16; i += 4) { ra_ = MX3(ra_, p0[i], p0[i + 1]); rb_ = MX3(rb_, p0[i + 2], p0[i + 3]); ra_ = MX3(ra_, p1[i], p1[i + 1]); rb_ = MX3(rb_, p1[i + 2], p1[i + 3]); }
            const float rm = xh_max(fmaxf(ra_, rb_));
            if (__any(rm > m + 6.f)) {
                const float mn = fmaxf(m, rm), f = ex2(m - mn); m = mn; l *= f;
#pragma unroll
                for (int i = 0; i < 16; ++i) { const float fi = __shfl(f, crow(i, h)); o0[i] *= fi; o1[i] *= fi; }
            }
            float ls = 0.f;
#pragma unroll
            for (int i = 0; i < 16; ++i) { p0[i] = ex2(p0[i] - m); p1[i] = ex2(p1[i] - m); ls += p0[i] + p1[i]; }
            l += ls;
            float e[8];
#pragma unroll
            for (int ks = 0; ks < 4; ++ks) {
#pragma unroll
                for (int j = 0; j < 8; ++j) e[j] = (ks < 2) ? p0[8 * ks + j] : p1[8 * (ks - 2) + j];
                const bf16x8 pa = pack8(e);
                const bf16x8 v0 = *(const LAS bf16x8*)(tb + vfo + 32 * ks), v1 = *(const LAS bf16x8*)(tb + vfo + 32 * VP + 32 * ks);
                o0 = MFMA32(pa, v0, o0); o1 = MFMA32(pa, v1, o1);
            }
        }
        if (ST + 1 < nST) MLA_STORE((ST + 1) & 1);
        __syncthreads();
    }
#undef MLA_LOAD
#undef MLA_STORE
    l = xh_sum(l);
    LAS float* mg = (LAS float*)(lds + MRG_OFF) + w4 * (34 * 64) + lane;
    if (kh == 1) {
#pragma unroll
        for (int i = 0; i < 16; ++i) { mg[i * 64] = o0[i]; mg[(16 + i) * 64] = o1[i]; }
        mg[32 * 64] = m; mg[33 * 64] = l;
    }
    __syncthreads();
    if (kh == 0) {
        const float mb = mg[32 * 64], lb = mg[33 * 64];
        const float mn = fmaxf(m, mb), fa = ex2(m - mn), fb = ex2(mb - mn), inv = 1.f / (l * fa + lb * fb), ga = fa * inv, gb = fb * inv;
        LAS bf16_t* stg = (LAS bf16_t*)(lds + wave * 4096);
        LAS bf16_t* sp = stg + (4 * h) * 64 + r;
#pragma unroll
        for (int i = 0; i < 16; ++i) { const float ra = __shfl(ga, crow(i, h)), rb = __shfl(gb, crow(i, h)); const int ro = ((i & 3) + 8 * (i >> 2)) * 64;
            sp[ro] = f2bf(o0[i] * ra + mg[i * 64] * rb); sp[ro + 32] = f2bf(o1[i] * ra + mg[(16 + i) * 64] * rb); }
        o_flush(stg, Y + ((size_t)b * SEQ + 32 * qb) * DM + 512 + hh * 64, DM, lane);
    }
    __syncthreads();
}

__device__ __forceinline__ void sb_unit(const bf16_t* __restrict__ Qrow0, int qpitch, const bf16_t* __restrict__ Kb, int kpitch, const bf16_t* __restrict__ VT,
                                        int qb, bf16_t* __restrict__ Orow0, int opitch, int lane, LAS bf16_t* stg) {
    const int r = lane & 31, h = lane >> 5;
    const int pr = (r & ~12) | ((r & 8) >> 1) | ((r & 4) << 1);
    bf16x8 qf[4];
#pragma unroll
    for (int s = 0; s < 4; ++s) qf[s] = *(const bf16x8*)(Qrow0 + (size_t)r * qpitch + 16 * s + 8 * h);
    f32x16 o0, o1;
#pragma unroll
    for (int i = 0; i < 16; ++i) { o0[i] = 0.f; o1[i] = 0.f; }
    float carry = 0.f;
    const int q = 32 * qb + r;
    const bf16_t* kp = Kb + (size_t)(32 * qb + pr) * kpitch + 8 * h;
    const bf16_t* vp = VT + (size_t)r * SEQ + 32 * qb + 8 * h;
    bf16x8 kf[4];
#pragma unroll
    for (int s = 0; s < 4; ++s) kf[s] = *(const bf16x8*)(kp + 16 * s);
    for (int kt = qb; kt >= 0; --kt) {
        bf16x8 kn[4];
        if (kt > 0) {
#pragma unroll
            for (int s = 0; s < 4; ++s) kn[s] = *(const bf16x8*)(kp - (size_t)32 * kpitch + 16 * s);
        } else {
#pragma unroll
            for (int s = 0; s < 4; ++s) kn[s] = kf[s];
        }
        const bf16x8 v00 = *(const bf16x8*)(vp), v01 = *(const bf16x8*)(vp + 32 * SEQ), v10 = *(const bf16x8*)(vp + 16), v11 = *(const bf16x8*)(vp + 32 * SEQ + 16);
        f32x16 p;
#pragma unroll
        for (int i = 0; i < 16; ++i) p[i] = 0.f;
#pragma unroll
        for (int s = 0; s < 4; ++s) p = MFMA32(kf[s], qf[s], p);
        const bool diag = (kt == qb);
        const int k0 = 32 * kt + 8 * h;
        float sfx[16];
#pragma unroll
        for (int i = 0; i < 16; ++i) {
            const float z = p[i];
            float L = -(fmaxf(z, 0.f) + lg2(1.f + ex2(-fabsf(z))));
            if (diag) { const int kv = k0 + 16 * (i >> 3) + (i & 7); if (!(kv < q)) L = 0.f; }
            sfx[i] = L;
        }
#pragma unroll
        for (int g = 0; g < 2; ++g)
#pragma unroll
            for (int j = 6; j >= 0; --j) sfx[8 * g + j] += sfx[8 * g + j + 1];
        const float T0 = sfx[0], T1 = sfx[8];
        const float TP0 = __shfl_xor(T0, 32), TP1 = __shfl_xor(T1, 32);
        const float off1 = (h ? 0.f : TP1) + carry, off0 = T1 + TP1 + (h ? 0.f : TP0) + carry;
        float e[16];
#pragma unroll
        for (int i = 0; i < 16; ++i) {
            float a = ex2(p[i] + sfx[i] + (i < 8 ? off0 : off1));
            if (diag) { const int kv = k0 + 16 * (i >> 3) + (i & 7); if (!(kv < q)) a = 0.f; }
            e[i] = a;
        }
        carry += (T0 + T1) + (TP0 + TP1);
        const bf16x8 pa0 = pack8(e), pa1 = pack8(e + 8);
        o0 = MFMA32(pa0, v00, o0); o1 = MFMA32(pa0, v01, o1);
        o0 = MFMA32(pa1, v10, o0); o1 = MFMA32(pa1, v11, o1);
        if (__all(carry < -150.f)) break;
#pragma unroll
        for (int s = 0; s < 4; ++s) kf[s] = kn[s];
        kp -= (size_t)32 * kpitch; vp -= 32;
    }
    LAS bf16_t* sp = stg + (4 * h) * 64 + r;
#pragma unroll
    for (int i = 0; i < 16; ++i) { const int ro = ((i & 3) + 8 * (i >> 2)) * 64; sp[ro] = f2bf(o0[i]); sp[ro + 32] = f2bf(o1[i]); }
    o_flush(stg, Orow0, opitch, lane);
}


constexpr int AKP = 144;
constexpr int SWA_NK = 384, SWA_VP = SWA_NK * 2 + 16, SWA_KB = SWA_NK * AKP;
constexpr int SB_NK = 448, SB_VP = SB_NK * 2 + 16, SB_KB = SB_NK * AKP;
constexpr int STG_OFF = 122880, MISC_OFF = STG_OFF + 8 * 4096;
static_assert(SWA_KB + 64 * SWA_VP <= STG_OFF && SB_KB + 64 * SB_VP <= STG_OFF && MISC_OFF + 1024 == LDS_BYTES, "window LDS map");
template <int NK, int VPB>
__device__ __forceinline__ void stage_kv64(const bf16_t* __restrict__ Kb, int kpitch, const bf16_t* __restrict__ VT, int key0, LAS unsigned char* lds, int tid) {
    constexpr int NCH = NK * 8 / 512, VC = NK / 8;
    u32x4 kr[NCH], vr[NCH];
#pragma unroll
    for (int i = 0; i < NCH; ++i) { const int c = tid + 512 * i, row = c >> 3, cc = c & 7; int key = key0 + row; key = key < 0 ? 0 : key;
        kr[i] = *(const u32x4*)(Kb + (size_t)key * kpitch + 8 * cc); }
#pragma unroll
    for (int i = 0; i < NCH; ++i) { const int c = tid + 512 * i, d = c / VC, cc = c - d * VC; int key = key0 + 8 * cc; key = key < 0 ? 0 : key;
        vr[i] = *(const u32x4*)(VT + (size_t)d * SEQ + key); }
#pragma unroll
    for (int i = 0; i < NCH; ++i) { const int c = tid + 512 * i, row = c >> 3, cc = c & 7; *(LAS u32x4*)(lds + row * AKP + 16 * cc) = kr[i]; }
#pragma unroll
    for (int i = 0; i < NCH; ++i) { const int c = tid + 512 * i, d = c / VC, cc = c - d * VC; *(LAS u32x4*)(lds + NK * AKP + d * VPB + 16 * cc) = vr[i]; }
}
__device__ __forceinline__ void swa_wave_lds(const bf16_t* __restrict__ Qrow0, int qpitch, const LAS unsigned char* lds, int qb, int kt_base, float sink2,
                                             bf16_t* __restrict__ Orow0, int opitch, int lane, LAS bf16_t* stg) {
    const int r = lane & 31, h = lane >> 5;
    const int pr = (r & ~12) | ((r & 8) >> 1) | ((r & 4) << 1);
    bf16x8 qf[4];
#pragma unroll
    for (int s = 0; s < 4; ++s) qf[s] = *(const bf16x8*)(Qrow0 + (size_t)r * qpitch + 16 * s + 8 * h);
    f32x16 o0, o1;
#pragma unroll
    for (int i = 0; i < 16; ++i) { o0[i] = 0.f; o1[i] = 0.f; }
    float m = -1e30f, l = 0.f;
    const int q = 32 * qb + r, kt_begin = qb - 4 > 0 ? qb - 4 : 0;
    for (int kt = kt_begin; kt <= qb; ++kt) {
        const int rel = kt - kt_base;
        const LAS unsigned char* kp = lds + (32 * rel + pr) * AKP + 16 * h;
        const LAS unsigned char* vp = lds + SWA_KB + r * SWA_VP + (32 * rel + 8 * h) * 2;
        f32x16 p;
#pragma unroll
        for (int i = 0; i < 16; ++i) p[i] = 0.f;
#pragma unroll
        for (int s = 0; s < 4; ++s) p = MFMA32(*(const LAS bf16x8*)(kp + 32 * s), qf[s], p);
        if (kt == qb || kt == qb - 4) {
            const int k0 = 32 * kt + 8 * h;
#pragma unroll
            for (int i = 0; i < 16; ++i) { const int kv = k0 + 16 * (i >> 3) + (i & 7); const bool ok = (kv <= q) && (kv > q - 128); if (!ok) p[i] = -INFINITY; }
        }
        float rm = MX3(p[0], p[1], p[2]);
#pragma unroll
        for (int i = 3; i < 15; i += 2) rm = MX3(rm, p[i], p[i + 1]);
        rm = xh_max(fmaxf(rm, p[15]));
        if (__any(rm > m + 6.f)) {
            const float mn = fmaxf(m, rm), f = ex2(m - mn); m = mn; l *= f;
#pragma unroll
            for (int i = 0; i < 16; ++i) { const float fi = __shfl(f, crow(i, h)); o0[i] *= fi; o1[i] *= fi; }
        }
        float e[16];
#pragma unroll
        for (int i = 0; i < 16; ++i) { e[i] = ex2(p[i] - m); l += e[i]; }
        const bf16x8 pa0 = pack8(e), pa1 = pack8(e + 8);
        o0 = MFMA32(pa0, *(const LAS bf16x8*)(vp), o0); o1 = MFMA32(pa0, *(const LAS bf16x8*)(vp + 32 * SWA_VP), o1);
        o0 = MFMA32(pa1, *(const LAS bf16x8*)(vp + 32), o0); o1 = MFMA32(pa1, *(const LAS bf16x8*)(vp + 32 * SWA_VP + 32), o1);
    }
    l = xh_sum(l);
    l += ex2(sink2 - m);
    const float inv = 1.f / l;
    LAS bf16_t* sp = stg + (4 * h) * 64 + r;
#pragma unroll
    for (int i = 0; i < 16; ++i) { const float fi = __shfl(inv, crow(i, h)); const int ro = ((i & 3) + 8 * (i >> 2)) * 64;
        sp[ro] = f2bf(o0[i] * fi); sp[ro + 32] = f2bf(o1[i] * fi); }
    o_flush(stg, Orow0, opitch, lane);
}
#define SB_STEP(KT_, V00_, V01_, V10_, V11_) do { \
        const bool diag = ((KT_) == qb); const int k0 = 32 * (KT_) + 8 * h; float sfx[16]; \
        _Pragma("unroll") for (int i = 0; i < 16; ++i) { const float z = p[i]; float L = -(fmaxf(z, 0.f) + lg2(1.f + ex2(-fabsf(z)))); \
            if (diag) { const int kv = k0 + 16 * (i >> 3) + (i & 7); if (!(kv < q)) L = 0.f; } sfx[i] = L; } \
        _Pragma("unroll") for (int g = 0; g < 2; ++g) _Pragma("unroll") for (int j = 6; j >= 0; --j) sfx[8 * g + j] += sfx[8 * g + j + 1]; \
        const float T0 = sfx[0], T1 = sfx[8]; const float TP0 = xh_other(T0, h), TP1 = xh_other(T1, h); \
        const float off1 = (h ? 0.f : TP1) + carry, off0 = T1 + TP1 + (h ? 0.f : TP0) + carry; float e[16]; \
        _Pragma("unroll") for (int i = 0; i < 16; ++i) { float a = ex2(p[i] + sfx[i] + (i < 8 ? off0 : off1)); \
            if (diag) { const int kv = k0 + 16 * (i >> 3) + (i & 7); if (!(kv < q)) a = 0.f; } e[i] = a; } \
        carry += (T0 + T1) + (TP0 + TP1); \
        const bf16x8 pa0 = pack8(e), pa1 = pack8(e + 8); \
        o0 = MFMA32(pa0, (V00_), o0); o1 = MFMA32(pa0, (V01_), o1); o0 = MFMA32(pa1, (V10_), o0); o1 = MFMA32(pa1, (V11_), o1); } while (0)
__device__ __forceinline__ void sb_wave_lds(const bf16_t* __restrict__ Qrow0, int qpitch, const LAS unsigned char* lds, const bf16_t* __restrict__ Kb, int kpitch,
                                            const bf16_t* __restrict__ VT, int qb, int kt_base, bf16_t* __restrict__ Orow0, int opitch, int lane, LAS bf16_t* stg) {
    const int r = lane & 31, h = lane >> 5;
    const int pr = (r & ~12) | ((r & 8) >> 1) | ((r & 4) << 1);
    bf16x8 qf[4];
#pragma unroll
    for (int s = 0; s < 4; ++s) qf[s] = *(const bf16x8*)(Qrow0 + (size_t)r * qpitch + 16 * s + 8 * h);
    f32x16 o0, o1;
#pragma unroll
    for (int i = 0; i < 16; ++i) { o0[i] = 0.f; o1[i] = 0.f; }
    float carry = 0.f;
    const int q = 32 * qb + r;
    const int kt_lo = kt_base > 0 ? kt_base : 0;
    bool done = false;
    int kt = qb;
    for (; kt >= kt_lo; --kt) {
        const int rel = kt - kt_base;
        const LAS unsigned char* kp = lds + (32 * rel + pr) * AKP + 16 * h;
        const LAS unsigned char* vp = lds + SB_KB + r * SB_VP + (32 * rel + 8 * h) * 2;
        f32x16 p;
#pragma unroll
        for (int i = 0; i < 16; ++i) p[i] = 0.f;
#pragma unroll
        for (int s = 0; s < 4; ++s) p = MFMA32(*(const LAS bf16x8*)(kp + 32 * s), qf[s], p);
        SB_STEP(kt, *(const LAS bf16x8*)(vp), *(const LAS bf16x8*)(vp + 32 * SB_VP), *(const LAS bf16x8*)(vp + 32), *(const LAS bf16x8*)(vp + 32 * SB_VP + 32));
        if (__all(carry < -150.f)) { done = true; break; }
    }
    if (!done && kt >= 0) {
        const bf16_t* kp = Kb + (size_t)(32 * kt + pr) * kpitch + 8 * h;
        const bf16_t* vp = VT + (size_t)r * SEQ + 32 * kt + 8 * h;
        for (; kt >= 0; --kt) {
            bf16x8 kf[4];
#pragma unroll
            for (int s = 0; s < 4; ++s) kf[s] = *(const bf16x8*)(kp + 16 * s);
            const bf16x8 v00 = *(const bf16x8*)(vp), v01 = *(const bf16x8*)(vp + 32 * SEQ), v10 = *(const bf16x8*)(vp + 16), v11 = *(const bf16x8*)(vp + 32 * SEQ + 16);
            f32x16 p;
#pragma unroll
            for (int i = 0; i < 16; ++i) p[i] = 0.f;
#pragma unroll
            for (int s = 0; s < 4; ++s) p = MFMA32(kf[s], qf[s], p);
            SB_STEP(kt, v00, v01, v10, v11);
            if (__all(carry < -150.f)) break;
            kp -= (size_t)32 * kpitch; vp -= 32;
        }
    }
    LAS bf16_t* sp = stg + (4 * h) * 64 + r;
#pragma unroll
    for (int i = 0; i < 16; ++i) { const int ro = ((i & 3) + 8 * (i >> 2)) * 64; sp[ro] = f2bf(o0[i]); sp[ro + 32] = f2bf(o1[i]); }
    o_flush(stg, Orow0, opitch, lane);
}
#undef SB_STEP

#define XB_TMO      128
#define XB_XCNT(j)  (256  + 64 * (j))
#define XB_XSUB(j)  (1280 + 64 * (j))
#define XB_XGEN(j)  (2304 + 64 * (j))
#define XB_TOP      3328
#define XB_TOPGEN   3392
#define XCD_BAR_WORDS 3456
#define XB_SPIN_CAP (1u << 18)

__device__ __forceinline__ unsigned xb_ld(unsigned* p)              { return __hip_atomic_load(p, __ATOMIC_RELAXED, __HIP_MEMORY_SCOPE_AGENT); }
__device__ __forceinline__ unsigned xb_add(unsigned* p, unsigned v) { return __hip_atomic_fetch_add(p, v, __ATOMIC_RELAXED, __HIP_MEMORY_SCOPE_AGENT); }
__device__ __forceinline__ unsigned xb_xcc_id() { return (unsigned)__builtin_amdgcn_s_getreg((3 << 11) | 20) & 0xFu; }
#define XB_SPIN(cond, bar) do { unsigned _sp = 0; while (cond) { __builtin_amdgcn_s_sleep(1); \
    if ((++_sp & 255u) == 0u) { if (xb_ld(&(bar)[XB_TMO])) break; if (_sp > XB_SPIN_CAP) { atomicAdd(&(bar)[XB_TMO], 1u); break; } } } } while (0)

struct XcdBarrier {
    unsigned* bar; unsigned x;
    volatile LAS unsigned* st;
};

__device__ __forceinline__ XcdBarrier xcd_barrier_post(unsigned* bar, volatile LAS unsigned* st) {
    XcdBarrier b; b.bar = bar; b.x = xb_xcc_id(); b.st = st;
    if (threadIdx.x == 0) (void)xb_add(&bar[XB_XCNT(b.x)], 1u);
    return b;
}
__device__ __forceinline__ void xcd_barrier_complete(unsigned* bar, unsigned x, unsigned& nloc, unsigned& nx) {
    const unsigned G = gridDim.x * gridDim.y * gridDim.z;
    unsigned sum, cnt, mine, sp = 0u;
    for (;;) {
        sum = 0u; cnt = 0u; mine = 0u;
#pragma unroll
        for (unsigned j = 0; j < 16; ++j) { const unsigned c = xb_ld(&bar[XB_XCNT(j)]); sum += c; cnt += (c > 0u) ? 1u : 0u; mine = (j == x) ? c : mine; }
        if (sum == G) break;
        __builtin_amdgcn_s_sleep(1);
        if ((++sp & 255u) == 0u) { if (xb_ld(&bar[XB_TMO])) break; if (sp > XB_SPIN_CAP) { atomicAdd(&bar[XB_TMO], 1u); break; } }
    }
    nloc = mine > 0u ? mine : 1u; nx = cnt > 0u ? cnt : 1u;
}

__device__ __forceinline__ void xcd_barrier(const XcdBarrier& b) {
    asm volatile("s_waitcnt vmcnt(0)" ::: "memory");
    __syncthreads();
    if (threadIdx.x == 0) {
        unsigned* bar = b.bar;
        __builtin_amdgcn_s_waitcnt(0);
        unsigned nloc = b.st[0], nx = b.st[1];
        if (nloc == 0u) { xcd_barrier_complete(bar, b.x, nloc, nx); b.st[0] = nloc; b.st[1] = nx; }
        const unsigned old = xb_add(&bar[XB_XSUB(b.x)], 1u);
        const unsigned gen = old / nloc;
        if (old + 1u == (gen + 1u) * nloc) {
            __builtin_amdgcn_fence(__ATOMIC_RELEASE, "agent");
            asm volatile("s_waitcnt vmcnt(0)" ::: "memory");
            const unsigned og = xb_add(&bar[XB_TOP], 1u);
            const unsigned tg = og / nx;
            if (og + 1u == (tg + 1u) * nx) xb_add(&bar[XB_TOPGEN], 1u);
            else XB_SPIN(xb_ld(&bar[XB_TOPGEN]) == tg, bar);
            __builtin_amdgcn_fence(__ATOMIC_ACQUIRE, "agent");
            xb_add(&bar[XB_XGEN(b.x)], 1u);
            asm volatile("s_waitcnt vmcnt(0)" ::: "memory");
        } else {
            XB_SPIN(xb_ld(&bar[XB_XGEN(b.x)]) == gen, bar);
            __builtin_amdgcn_fence(__ATOMIC_ACQUIRE, "agent");
            asm volatile("s_waitcnt vmcnt(0)" ::: "memory");
        }
    }
    __syncthreads();
}

__global__ void __launch_bounds__(NTHREADS, 2) fwd(Params P) {
    extern __shared__ __attribute__((aligned(16))) unsigned char lds_raw[];
    LAS unsigned char* lds = (LAS unsigned char*)lds_raw;
    constexpr int G = 256, NGW = G * NWAVES, gthreads = G * NTHREADS;
    const int bx = blockIdx.x;
#if MK_COOP
    cooperative_groups::grid_group grid = cooperative_groups::this_grid();
    volatile LAS unsigned* MISC = (volatile LAS unsigned*)(lds + MISC_OFF);
    if (threadIdx.x < 64) MISC[threadIdx.x] = 0u;
    __syncthreads();
    XcdBarrier bar = xcd_barrier_post((unsigned*)(P.ws + WS_CTL) + CW_BAR, MISC + 8);
#endif
    for (int ph = P.ph_lo; ph < P.ph_hi; ++ph) {
        const int nrep = ((ph >= 1 && ph <= 6 && ((ph - 1) == MK_REP_K || (MK_REP_K == 6 && ph == 3))) || (ph == 0 && MK_REP_K == 7)) ? MK_REP_N : 1;
        for (int rep = 0; rep < nrep; ++rep) {
        int tid_o = threadIdx.x; asm volatile("" : "+v"(tid_o));
        const int tid = tid_o, lane = tid & 63, wave = __builtin_amdgcn_readfirstlane(tid >> 6);
        const int gw = bx * NWAVES + wave, gtid = bx * NTHREADS + tid;
        LAS bf16_t* stg = (LAS bf16_t*)(lds + 122880 + wave * 4096);
        unsigned char* ws = P.ws; asm volatile("" : "+s"(ws));
        unsigned* ctl = (unsigned*)(ws + WS_CTL);
        bf16_t* XN = (bf16_t*)(ws + WS_XN); bf16_t* H = (bf16_t*)(ws + WS_H);
        bf16_t* QC = (bf16_t*)(ws + WS_QC); bf16_t* KC = (bf16_t*)(ws + WS_KC);
        bf16_t* VTC = (bf16_t*)(ws + WS_VTC); bf16_t* VTA = (bf16_t*)(ws + WS_VTA); bf16_t* VTD = (bf16_t*)(ws + WS_VTD);
        bf16_t* Y = (bf16_t*)(ws + WS_Y);
        if (ph == 0) {
            {
                LAS float* scr = (LAS float*)(lds + wave * 16384);
                constexpr int I_IN = (DM / 64) * (DIN / 32), I_OUT = (DM / 64) * (DM / 32), I_UQ = (256 / 64) * (384 / 32), I_UKV = (128 / 64) * (512 / 32), I_L = I_IN + I_OUT + I_UQ + I_UKV;
                for (int it = gw; it < NLAYER * I_L; it += NGW) {
                    const int l = it / I_L; int v = it - l * I_L;
                    if (v < I_IN) { wT_item(P.w_in + (size_t)l * DM * DIN, DM, DIN, P.norm_pre + l * DM, (bf16_t*)(ws + WS_WIN) + (size_t)l * DINP * DM, C_AQ, C_AQ + 256, C_DQ, C_DQ + 256, SC64, scr, v, lane); continue; } v -= I_IN;
                    if (v < I_OUT) { wT_item(P.w_out + (size_t)l * DM * DM, DM, DM, P.g_grp + l * DM, (bf16_t*)(ws + WS_WOUT) + (size_t)l * DM * DM, 0, 0, 0, 0, 1.f, scr, v, lane); continue; } v -= I_OUT;
                    if (v < I_UQ) { wT_item(P.w_uq + (size_t)l * 256 * 384, 256, 384, P.g_cq + l * 256, (bf16_t*)(ws + WS_WUQ + (size_t)l * 262144), 0, 0, 0, 0, 1.f, scr, v, lane); continue; } v -= I_UQ;
                    wT_item(P.w_ukv + (size_t)l * 128 * 512, 128, 512, P.g_ckv + l * 128, (bf16_t*)(ws + WS_WUKV + (size_t)l * 131072), 0, 0, 0, 0, 1.f, scr, v, lane);
                }
                for (int it = gtid; it < NLAYER * (DINP - DIN) * (DM / 8); it += gthreads) { const int l = it / ((DINP - DIN) * (DM / 8)), v = it - l * ((DINP - DIN) * (DM / 8));
                    *(u32x4*)((bf16_t*)(ws + WS_WIN) + (size_t)l * DINP * DM + (size_t)DIN * DM + (size_t)v * 8) = (u32x4){0u, 0u, 0u, 0u}; }
            }
            { const float* __restrict__ xr = P.x; bf16_t* __restrict__ xo = XN;
#pragma unroll 2
              for (int mrow = gw; mrow < M_TOK; mrow += NGW) rms_row_to_bf16(xr + (size_t)mrow * DM, xo + (size_t)mrow * DM, lane); }
        } else {
            const int l = (ph - 1) / 6, k = (ph - 1) % 6;
            if (k == 0 || k == 4) {
                if (k == 0) {
                    pg8::Gemm g{XN, (const bf16_t*)(ws + WS_WIN) + (size_t)l * DINP * DM, M_TOK, DINP, DM}; pg8::StaticOrder S; S.init(M_TOK, DINP, G, bx);
                    pg8::EpiBf16<0> E{H, DINP, nullptr, 0, 0, 1.f};
                    pg8::gemm_phase<pg8::EpiBf16<0>, pg8::StaticOrder, true, true>(lds, g, S, E);
                } else {
                    pg8::Gemm g{XN, (const bf16_t*)(ws + WS_WOUT) + (size_t)l * DM * DM, M_TOK, DM, DM}; pg8::StaticOrder S; S.init(M_TOK, DM, G, bx);
                    pg8::EpiBf16<0> E{Y, DM, nullptr, 0, 0, 1.f};
                    pg8::gemm_phase<pg8::EpiBf16<0>, pg8::StaticOrder, true, true>(lds, g, S, E);
                }
            } else if (k == 1) {
                const bf16_t* WUQ = (const bf16_t*)(ws + WS_WUQ + (size_t)l * 262144);
                const bf16_t* WUKV = (const bf16_t*)(ws + WS_WUKV + (size_t)l * 131072);
                {
                    const int hh = bx & 3, tg = bx >> 2;
                    u32x4 wq[6], wk[4];
#pragma unroll
                    for (int i = 0; i < 6; ++i) { const int c = tid + 512 * i, row = c >> 5, cc = c & 31; wq[i] = *(const u32x4*)(WUQ + (size_t)(hh * 96 + row) * 256 + 8 * cc); }
#pragma unroll
                    for (int i = 0; i < 4; ++i) { const int c = tid + 512 * i, row = c >> 4, cc = c & 15; wk[i] = *(const u32x4*)(WUKV + (size_t)(hh * 128 + row) * 128 + 8 * cc); }
#pragma unroll
                    for (int i = 0; i < 6; ++i) { const int c = tid + 512 * i, row = c >> 5, cc = c & 31; *(LAS u32x4*)(lds + row * WQP + 16 * cc) = wq[i]; }
#pragma unroll
                    for (int i = 0; i < 4; ++i) { const int c = tid + 512 * i, row = c >> 4, cc = c & 15; *(LAS u32x4*)(lds + WQ_BYTES + row * WKP + 16 * cc) = wk[i]; }
                    __syncthreads();
                    const int tb = 8 * tg + wave;
                    mq_unit(H, lds, P.pos, QC, tb, hh, lane);
                    mkv_unit(H, lds + WQ_BYTES, P.pos, KC, VTC, tb, hh, lane, stg);
                }
                constexpr int NTB = M_TOK / 32;
                constexpr int U_VTA = NTB * 2, U_VTD = NTB * 4, U_CONV = M_TOK / 8;
                constexpr int U_ALL = U_VTA + U_VTD + U_CONV;
                for (int u = gw; u < U_ALL; u += NGW) {
                    int v = u;
                    if (v < U_VTA) { vt_unit(H, C_AV, 2, VTA, v >> 1, v & 1, lane, stg); continue; } v -= U_VTA;
                    if (v < U_VTD) { vt_unit(H, C_DV, 4, VTD, v >> 2, v & 3, lane, stg); continue; } v -= U_VTD;
                    conv_unit(H, P.conv_w + l * 768, P.conv_b + l * 256, Y, v, lane);
                }
            } else if (k == 2) {
                if (rep == 0 || MK_REP_K == 2)
                for (int pu = bx; pu < 256; pu += G) {
                    const int bh = pu & 7, Gq = pu >> 3;
                    mla_unit_blk(QC, KC, VTC, Y, bh, 63 - Gq, lds, tid);
                    mla_unit_blk(QC, KC, VTC, Y, bh, Gq, lds, tid);
                }
                if (rep == 0 || MK_REP_K == 6) {
                    const int bh = bx & 7, G8 = bx >> 3, b = bh >> 2, hh = bh & 3, qb = 8 * G8 + wave;
                    const size_t row0 = (size_t)b * SEQ + 32 * qb;
                    LAS bf16_t* ostg = (LAS bf16_t*)(lds + STG_OFF + wave * 4096);
                    {
                        const int kvh = hh >> 1;
                        const bf16_t* Kb = H + (size_t)b * SEQ * DINP + C_AK + kvh * 64;
                        const bf16_t* VT = VTA + (size_t)(b * 2 + kvh) * 64 * SEQ;
                        stage_kv64<SWA_NK, SWA_VP>(Kb, DINP, VT, 256 * G8 - 128, lds, tid);
                        __syncthreads();
                        swa_wave_lds(H + row0 * DINP + C_AQ + hh * 64, DINP, lds, qb, 8 * G8 - 4, P.sinks[l * 4 + hh] * LOG2E, Y + row0 * DM + hh * 64, DM, lane, ostg);
                        __syncthreads();
                    }
                    {
                        const bf16_t* Kb = H + (size_t)b * SEQ * DINP + C_DK + hh * 64;
                        const bf16_t* VT = VTD + (size_t)(b * 4 + hh) * 64 * SEQ;
                        stage_kv64<SB_NK, SB_VP>(Kb, DINP, VT, 256 * G8 - 192, lds, tid);
                        __syncthreads();
                        sb_wave_lds(H + row0 * DINP + C_DQ + hh * 64, DINP, lds, Kb, DINP, VT, qb, 8 * G8 - 6, Y + row0 * DM + 768 + hh * 64, DM, lane, ostg);
                        __syncthreads();
                    }
                }
            } else if (k == 3) {
                const bf16_t* __restrict__ Yr = Y; const bf16_t* __restrict__ Hr = H; bf16_t* __restrict__ XNw = XN;
#pragma unroll 2
                for (int mrow = gw; mrow < M_TOK; mrow += NGW) {
                    const u32x4* yp = (const u32x4*)(Yr + (size_t)mrow * DM) + 2 * lane;
                    const u32x4* gp = (const u32x4*)(Hr + (size_t)mrow * DINP + C_GATE) + 2 * lane;
                    const u32x4 y0 = yp[0], y1 = yp[1], g0 = gp[0], g1 = gp[1];
                    float yv[16], gv[16];
#pragma unroll
                    for (int j = 0; j < 4; ++j) { yv[2 * j] = bflo(y0[j]); yv[2 * j + 1] = bfhi(y0[j]); yv[8 + 2 * j] = bflo(y1[j]); yv[8 + 2 * j + 1] = bfhi(y1[j]);
                                                  gv[2 * j] = bflo(g0[j]); gv[2 * j + 1] = bfhi(g0[j]); gv[8 + 2 * j] = bflo(g1[j]); gv[8 + 2 * j + 1] = bfhi(g1[j]); }
                    float ss = 0.f;
#pragma unroll
                    for (int j = 0; j < 16; ++j) ss += yv[j] * yv[j];
                    ss += __shfl_xor(ss, 1); ss += __shfl_xor(ss, 2); ss += __shfl_xor(ss, 4); ss += __shfl_xor(ss, 8);
                    const float rs = rsqrtf(ss * (1.f / 256.f) + EPS);
                    float o[16];
#pragma unroll
                    for (int j = 0; j < 16; ++j) { const float gg = gv[j]; o[j] = yv[j] * rs * gg * __builtin_amdgcn_rcpf(1.f + ex2(-gg * LOG2E)); }
                    u32x4 w0, w1;
#pragma unroll
                    for (int j = 0; j < 4; ++j) { w0[j] = pk2(o[2 * j], o[2 * j + 1]); w1[j] = pk2(o[8 + 2 * j], o[8 + 2 * j + 1]); }
                    u32x4* op = (u32x4*)(XNw + (size_t)mrow * DM) + 2 * lane;
                    op[0] = w0; op[1] = w1;
                }
            } else {
                const float* base = P.x;
                const float* gpost = P.g_post + l * DM;
                for (int mrow0 = gw; mrow0 < M_TOK; mrow0 += 2 * NGW) {
                    f32x4 zz[2][4], xv[2][4]; float s1[2] = {0.f, 0.f}, s2[2] = {0.f, 0.f};
                    const bool two = (mrow0 + NGW < M_TOK);
#pragma unroll
                    for (int rr = 0; rr < 2; ++rr) { const int mrow = (rr == 0 || two) ? mrow0 + rr * NGW : mrow0;
#pragma unroll
                        for (int j = 0; j < 4; ++j) { const u32x2 w = ((const u32x2*)(Y + (size_t)mrow * DM))[lane + 64 * j]; zz[rr][j] = (f32x4){bflo(w.x), bfhi(w.x), bflo(w.y), bfhi(w.y)};
                            if (l == 0) xv[rr][j] = ((const f32x4*)(base + (size_t)mrow * DM))[lane + 64 * j];
                            else { const u32x2 xb = ((const u32x2*)(P.out + (size_t)mrow * DM))[lane + 64 * j]; xv[rr][j] = (f32x4){bflo(xb.x), bfhi(xb.x), bflo(xb.y), bfhi(xb.y)}; } } }
                    f32x4 gpv[4];
#pragma unroll
                    for (int j = 0; j < 4; ++j) gpv[j] = ((const f32x4*)gpost)[lane + 64 * j];
#pragma unroll
                    for (int rr = 0; rr < 2; ++rr)
#pragma unroll
                        for (int j = 0; j < 4; ++j) s1[rr] += (zz[rr][j].x * zz[rr][j].x + zz[rr][j].y * zz[rr][j].y) + (zz[rr][j].z * zz[rr][j].z + zz[rr][j].w * zz[rr][j].w);
                    const float rz0 = rsqrtf(wave_sum(s1[0]) * (1.f / DM) + EPS), rz1 = rsqrtf(wave_sum(s1[1]) * (1.f / DM) + EPS);
#pragma unroll
                    for (int rr = 0; rr < 2; ++rr) { const float rz = rr ? rz1 : rz0;
#pragma unroll
                        for (int j = 0; j < 4; ++j) { xv[rr][j] = xv[rr][j] + zz[rr][j] * rz * gpv[j];
                            s2[rr] += (xv[rr][j].x * xv[rr][j].x + xv[rr][j].y * xv[rr][j].y) + (xv[rr][j].z * xv[rr][j].z + xv[rr][j].w * xv[rr][j].w); } }
#pragma unroll
                    for (int rr = 0; rr < 2; ++rr) { if (rr == 1 && !two) break; const int mrow = mrow0 + rr * NGW;
#pragma unroll
                        for (int j = 0; j < 4; ++j) {
                            if (l + 1 < NLAYER) { u32x2 o; o.x = pk2(xv[rr][j].x, xv[rr][j].y); o.y = pk2(xv[rr][j].z, xv[rr][j].w); ((u32x2*)(P.out + (size_t)mrow * DM))[lane + 64 * j] = o; }
                            else ((f32x4*)(P.out + (size_t)mrow * DM))[lane + 64 * j] = xv[rr][j]; } }
                    if (l + 1 < NLAYER) {
                        const float r0 = rsqrtf(wave_sum(s2[0]) * (1.f / DM) + EPS), r1 = rsqrtf(wave_sum(s2[1]) * (1.f / DM) + EPS);
#pragma unroll
                        for (int rr = 0; rr < 2; ++rr) { if (rr == 1 && !two) break; const int mrow = mrow0 + rr * NGW; const float rs = rr ? r1 : r0;
#pragma unroll
                            for (int j = 0; j < 4; ++j) { u32x2 o; o.x = pk2(xv[rr][j].x * rs, xv[rr][j].y * rs); o.y = pk2(xv[rr][j].z * rs, xv[rr][j].w * rs); ((u32x2*)(XN + (size_t)mrow * DM))[lane + 64 * j] = o; } }
                    }
                }
            }
            }
        }
        if (ph + 1 < P.ph_hi) {
#if MK_COOP
            if (P.ph_hi < 0) grid.sync();
            xcd_barrier(bar);
#endif
        }
    }
}
}

extern "C" void kernel_launch(void* const* d_in, const int* in_sizes, int n_in, void* d_out, int out_size, void* d_ws, size_t ws_size, hipStream_t stream) {
    using namespace mk;
    static int grid = 0;
    if (grid == 0) {
        if (n_in != 14 || out_size != M_TOK * DM || ws_size < WS_END) { fprintf(stderr, "kernel_launch: unexpected shapes (n_in %d out %d ws %zu)\n", n_in, out_size, ws_size); grid = -1; return; }
        int dev = 0, cus = 0, per_cu = 0;
        (void)hipGetDevice(&dev); (void)hipDeviceGetAttribute(&cus, hipDeviceAttributeMultiprocessorCount, dev);
        if (hipFuncSetAttribute((const void*)fwd, hipFuncAttributeMaxDynamicSharedMemorySize, LDS_BYTES) != hipSuccess) { fprintf(stderr, "kernel_launch: hipFuncSetAttribute failed\n"); grid = -1; return; }
        if (hipOccupancyMaxActiveBlocksPerMultiprocessor(&per_cu, (const void*)fwd, NTHREADS, LDS_BYTES) != hipSuccess || per_cu < 1) { fprintf(stderr, "kernel_launch: occupancy query says %d\n", per_cu); per_cu = 1; }
        (void)hipGetLastError();
        if (cus < 256) { fprintf(stderr, "kernel_launch: built for a 256-CU device (one workgroup per CU), found %d CUs\n", cus); grid = -1; return; }
        grid = 256;
    }
    if (grid < 0) return;
    (void)hipMemsetAsync((char*)d_ws + WS_CTL, 0, CTL_BYTES, stream);
    Params p{};
    p.x = (const float*)d_in[0]; p.pos = (const int*)d_in[1]; p.norm_pre = (const float*)d_in[2]; p.w_in = (const float*)d_in[3]; p.sinks = (const float*)d_in[4];
    p.conv_w = (const float*)d_in[5]; p.conv_b = (const float*)d_in[6]; p.g_cq = (const float*)d_in[7]; p.w_uq = (const float*)d_in[8]; p.g_ckv = (const float*)d_in[9];
    p.w_ukv = (const float*)d_in[10]; p.g_grp = (const float*)d_in[11]; p.w_out = (const float*)d_in[12]; p.g_post = (const float*)d_in[13];
    p.out = (float*)d_out; p.ws = (unsigned char*)d_ws;
    constexpr int NPH = 1 + 6 * NLAYER;
#if MK_COOP
    p.ph_lo = 0; p.ph_hi = NPH;
    void* args[] = {&p};
    hipError_t e = hipLaunchCooperativeKernel((const void*)fwd, dim3(grid), dim3(NTHREADS), args, LDS_BYTES, stream);
    if (e != hipSuccess) fprintf(stderr, "kernel_launch: cooperative launch failed: %s (grid %d)\n", hipGetErrorString(e), grid);
#else
    for (int ph = 0; ph < NPH; ++ph) { p.ph_lo = ph; p.ph_hi = ph + 1; hipLaunchKernelGGL(fwd, dim3(grid), dim3(NTHREADS), LDS_BYTES, stream, p); }
#endif
}
```

```cpp
#include <hip/hip_runtime.h>
#include <hip/hip_cooperative_groups.h>
#include <cstdio>
#include <cstdint>
#include <cmath>
namespace pg8 {
#define PG8_LAS __attribute__((address_space(3)))
typedef unsigned short bf16_t;
typedef short bf16x8 __attribute__((ext_vector_type(8)));
typedef float f32x4 __attribute__((ext_vector_type(4)));
typedef unsigned u32x4 __attribute__((ext_vector_type(4)));
constexpr int BM = 256, BK = 64, HALF = 128, HTB = HALF * BK * 2  , STAGE_BYTES = 8 * HTB, NXCD = 8, WGM = 8;

__host__ __device__ __forceinline__ int lds_byte(int r, int c) { const int st = (r >> 4) * 2 + (c >> 5), rr = r & 15, cc = c & 31, ob = rr * 64 + cc * 2; return st * 1024 + (ob ^ (((ob >> 9) & 1) << 5)); }
__host__ __device__ __forceinline__ void stage_rc(int b, int& R, int& C) { const int st = b / 1024, sb = b % 1024, swz = sb ^ (((sb >> 9) & 1) << 5); R = (st >> 1) * 16 + swz / 64; C = (st & 1) * 32 + (swz % 64) / 2; }
__host__ __device__ __forceinline__ int perm32(int rho) { const int n = rho >> 4, i = rho & 15; return 8 * (i >> 2) + 4 * n + (i & 3); }

struct Unit { int pm, pn; };
struct Gemm { const bf16_t* A; const bf16_t* Bt; int M, N, K; };

struct StaticOrder {
    int nM, nN, nwg, G, c;
    __host__ __device__ void init(int M, int N, int G_, int c_) { nM = M / BM; nN = N / BM; nwg = nM * nN; G = G_; c = c_; }
    __host__ __device__ bool next(int i, Unit& u) const {
        const long L = (long)i * G + c; if (L >= nwg) return false;
        int wgid = (int)L; { const int q = nwg / NXCD, r = nwg % NXCD, xcd = wgid % NXCD, off = wgid / NXCD; wgid = (xcd < r ? xcd * (q + 1) : r * (q + 1) + (xcd - r) * q) + off; }
        const int nig = WGM * nN, gid = wgid / nig, fm = gid * WGM, gsz = (nM - fm) < WGM ? (nM - fm) : WGM;
        u.pm = fm + ((wgid % nig) % gsz); u.pn = (wgid % nig) / gsz; return true;
    }
    __device__ __forceinline__ void a_ready(const Unit&) const {}
    __device__ __forceinline__ void done(const Unit&) const {}
};

__device__ __forceinline__ unsigned cvt_pk_bf16(float lo, float hi) { unsigned r; asm volatile("v_cvt_pk_bf16_f32 %0, %1, %2" : "=v"(r) : "v"(lo), "v"(hi)); return r; }
typedef float f32x2 __attribute__((ext_vector_type(2)));
__device__ __forceinline__ f32x2 gelu_pk(f32x2 v) {
    const f32x2 av = __builtin_elementwise_abs(v), d = av * 0.2316418882f + 1.0f;
    f32x2 t; t.x = __builtin_amdgcn_rcpf(d.x); t.y = __builtin_amdgcn_rcpf(d.y);
    f32x2 q = t * 0.5307027145f + (-0.7265760135f); q = q * t + 0.7107068705f; q = q * t + (-0.142248368f); q = q * t + 0.127414796f; q = q * t;
    const f32x2 s = (v * v) * (-0.72134752044f);
    f32x2 e; e.x = __builtin_amdgcn_exp2f(s.x); e.y = __builtin_amdgcn_exp2f(s.y);
    const f32x2 m = v * (q * e), r = v - m;
    f32x2 o; o.x = v.x < 0.f ? m.x : r.x; o.y = v.y < 0.f ? m.y : r.y; return o;
}

template <int ACT  > struct EpiBf16 {
    static constexpr bool PERM = true, AFTER_DRAIN = false; static_assert(ACT == 0 || ACT == 1, "EpiBf16: ACT is 0 (none) or 1 (gelu_pk)");
    bf16_t* O; int ldc; const float* bias; int split_cols; size_t split_stride; float scale0;
    __device__ __forceinline__ void operator()(const f32x4 (&acc)[2][2][4][2], const Unit& u, int wr, int wc, int fr, int fq) const {
        const int row0 = u.pm * BM + wr * 64 + fr; int colt = u.pn * BM; bf16_t* base = O;
        float sc = 1.f; if (split_cols) { const int t = colt / split_cols; base += (size_t)t * split_stride; colt -= t * split_cols; if (t == 0) sc = scale0; }
        const int col0 = colt + wc * 32 + 8 * fq, bcol0 = u.pn * BM + wc * 32 + 8 * fq;
        f32x4 bv[2][2];
#pragma unroll
        for (int bj = 0; bj < 2; ++bj)
#pragma unroll
            for (int n = 0; n < 2; ++n) bv[bj][n] = bias ? *(const f32x4*)(bias + bcol0 + bj * HALF + 4 * n) : (f32x4){0.f, 0.f, 0.f, 0.f};
#pragma unroll
        for (int ai = 0; ai < 2; ++ai)
#pragma unroll
            for (int m = 0; m < 4; ++m) { bf16_t* rowp = base + (size_t)(row0 + ai * HALF + m * 16) * ldc + col0;
#pragma unroll
                for (int bj = 0; bj < 2; ++bj) { f32x4 v0 = acc[ai][bj][m][0] + bv[bj][0], v1 = acc[ai][bj][m][1] + bv[bj][1];
                    if (ACT == 1) { f32x2 a = gelu_pk((f32x2){v0[0], v0[1]}), b = gelu_pk((f32x2){v0[2], v0[3]}), c = gelu_pk((f32x2){v1[0], v1[1]}), d = gelu_pk((f32x2){v1[2], v1[3]});
                        v0 = (f32x4){a.x, a.y, b.x, b.y}; v1 = (f32x4){c.x, c.y, d.x, d.y}; }
                    v0 = v0 * sc; v1 = v1 * sc; u32x4 w; w.x = cvt_pk_bf16(v0[0], v0[1]); w.y = cvt_pk_bf16(v0[2], v0[3]); w.z = cvt_pk_bf16(v1[0], v1[1]); w.w = cvt_pk_bf16(v1[2], v1[3]);
                    *(u32x4*)(rowp + bj * HALF) = w; } }
    }
};
template <class Epi, class Sched, bool ALIGN_EPI = false, bool SP2 = false>
__device__ __forceinline__ void gemm_phase(PG8_LAS unsigned char* lds, const Gemm g, const Sched& S, const Epi& E) {
    int tid_o = threadIdx.x; asm volatile("" : "+v"(tid_o));
    const int tid = tid_o, wid = __builtin_amdgcn_readfirstlane(tid >> 6), lane = tid & 63, wr = wid >> 2, wc = wid & 3, fr = lane & 15, fq = lane >> 4;
    const int K = g.K, nt = K / BK;
    unsigned voffA[2], voffB[2];
#pragma unroll
    for (int i = 0; i < 2; ++i) { int R, C; stage_rc(tid * 16 + i * 8192, R, C); const int Rb = Epi::PERM ? ((R & ~31) + perm32(R & 31)) : R;
        voffA[i] = (unsigned)(R * K + C) * 2u; voffB[i] = (unsigned)(Rb * K + C) * 2u; }
    const size_t kstep = (size_t)(BK * 2);
    const size_t hstep = (size_t)HALF * K * 2;
    const size_t tstep = 2 * hstep;
    const unsigned ldsw = (unsigned)wid * 1024u;
    const int aoff = lds_byte(wr * 64 + fr, fq * 8), boff = lds_byte(wc * 32 + fr, fq * 8);
#define PG8_SA(b, h) (((b) * 2 + (h)) * HTB)
#define PG8_SB(b, h) ((4 + (b) * 2 + (h)) * HTB)
#define PG8_STAGE(bufoff, gbase, voff) do { _Pragma("unroll") for (int _i = 0; _i < 2; ++_i) \
        __builtin_amdgcn_global_load_lds((const unsigned*)((const char*)(gbase) + (voff)[_i]), (PG8_LAS unsigned*)(lds + (bufoff) + ldsw + _i * 8192), 16, 0, 0); } while (0)
#define PG8_LDA(dst, b, h) do { _Pragma("unroll") for (int m = 0; m < 4; ++m) _Pragma("unroll") for (int k = 0; k < 2; ++k) dst[m][k] = *(const PG8_LAS bf16x8*)(lds + PG8_SA(b, h) + aoff + m * 2048 + k * 1024); } while (0)
#define PG8_LDB(dst, b, h) do { _Pragma("unroll") for (int n = 0; n < 2; ++n) _Pragma("unroll") for (int k = 0; k < 2; ++k) dst[n][k] = *(const PG8_LAS bf16x8*)(lds + PG8_SB(b, h) + boff + n * 2048 + k * 1024); } while (0)
#define PG8_MMA(ai, bj, At, Bt) do { __builtin_amdgcn_s_setprio(1); _Pragma("unroll") for (int m = 0; m < 4; ++m) _Pragma("unroll") for (int n = 0; n < 2; ++n) _Pragma("unroll") for (int k = 0; k < 2; ++k) \
        acc[ai][bj][m][n] = __builtin_amdgcn_mfma_f32_16x16x32_bf16(Bt[n][k], At[m][k], acc[ai][bj][m][n], 0, 0, 0); __builtin_amdgcn_s_setprio(0); } while (0)
#define PG8_WAIT_V(n) asm volatile("s_waitcnt vmcnt(" #n ")" ::: "memory")
#define PG8_WAIT_L(n) asm volatile("s_waitcnt lgkmcnt(" #n ")" ::: "memory")
#define PG8_BAR __builtin_amdgcn_s_barrier()
#define PG8_SCHED __builtin_amdgcn_sched_barrier(0)
    Unit cur, nxt; int ui = 0;
    if (!S.next(0, cur)) return;
    f32x4 acc[2][2][4][2];
#pragma unroll
    for (int a = 0; a < 2; ++a)
#pragma unroll
        for (int b = 0; b < 2; ++b)
#pragma unroll
            for (int m = 0; m < 4; ++m)
#pragma unroll
                for (int n = 0; n < 2; ++n) acc[a][b][m][n] = (f32x4){0.f, 0.f, 0.f, 0.f};
    bf16x8 At[4][2], B0[2][2], B1[2][2];
    const char* cA = (const char*)g.A + (size_t)cur.pm * tstep; const char* cB = (const char*)g.Bt + (size_t)cur.pn * tstep;
    S.a_ready(cur);
    if constexpr (SP2) {
        PG8_STAGE(PG8_SB(0, 0), cB, voffB); PG8_STAGE(PG8_SB(0, 1), cB + hstep, voffB); PG8_STAGE(PG8_SA(0, 0), cA, voffA); PG8_STAGE(PG8_SA(0, 1), cA + hstep, voffA);
        if (wr == 1) PG8_BAR;
        PG8_WAIT_V(2); PG8_BAR;
        PG8_STAGE(PG8_SB(1, 0), cB + kstep, voffB); PG8_STAGE(PG8_SA(1, 0), cA + kstep, voffA); PG8_STAGE(PG8_SB(1, 1), cB + hstep + kstep, voffB);
        PG8_WAIT_V(6); PG8_BAR;
    } else {
        PG8_STAGE(PG8_SB(0, 0), cB, voffB); PG8_STAGE(PG8_SA(0, 0), cA, voffA); PG8_STAGE(PG8_SB(0, 1), cB + hstep, voffB); PG8_STAGE(PG8_SA(0, 1), cA + hstep, voffA);
        if (wr == 1) PG8_BAR;
        PG8_WAIT_V(4); PG8_BAR;
        PG8_STAGE(PG8_SB(1, 0), cB + kstep, voffB); PG8_STAGE(PG8_SA(1, 0), cA + kstep, voffA); PG8_STAGE(PG8_SB(1, 1), cB + hstep + kstep, voffB);
        PG8_WAIT_V(6); PG8_BAR;
    }
    for (;;) {
        const bool has_next = S.next(ui + 1, nxt);
        const char* nA = has_next ? (const char*)g.A + (size_t)nxt.pm * tstep : cA; const char* nB = has_next ? (const char*)g.Bt + (size_t)nxt.pn * tstep : cB;
        for (int t = 0; t < nt; t += 2) {
            const bool last = (t == nt - 2);
            const char* a1 = cA + (size_t)(t + 1) * kstep;
            const char* a2 = last ? nA : cA + (size_t)(t + 2) * kstep; const char* b2 = last ? nB : cB + (size_t)(t + 2) * kstep;
            const char* a3 = a2 + kstep; const char* b3 = b2 + kstep;
            if (last && has_next) S.a_ready(nxt);
            if constexpr (SP2) {
            PG8_LDB(B0, 0, 0); PG8_LDB(B1, 0, 1); PG8_SCHED; PG8_LDA(At, 0, 0); PG8_STAGE(PG8_SA(1, 1), a1 + hstep, voffA);
            PG8_WAIT_V(8); PG8_WAIT_L(0); PG8_BAR; PG8_MMA(0, 0, At, B0); PG8_MMA(0, 1, At, B1); PG8_BAR; PG8_SCHED;
            PG8_LDA(At, 0, 1); PG8_STAGE(PG8_SB(0, 0), b2, voffB); PG8_STAGE(PG8_SB(0, 1), b2 + hstep, voffB); PG8_STAGE(PG8_SA(0, 0), a2, voffA);
            PG8_WAIT_V(8); PG8_WAIT_L(0); PG8_BAR; PG8_MMA(1, 0, At, B0); PG8_MMA(1, 1, At, B1); PG8_BAR; PG8_SCHED;
            PG8_LDB(B0, 1, 0); PG8_LDB(B1, 1, 1); PG8_SCHED; PG8_LDA(At, 1, 0); PG8_STAGE(PG8_SA(0, 1), a2 + hstep, voffA);
            PG8_WAIT_V(8); PG8_WAIT_L(0); PG8_BAR; PG8_MMA(0, 0, At, B0); PG8_MMA(0, 1, At, B1); PG8_BAR; PG8_SCHED;
            PG8_LDA(At, 1, 1); PG8_STAGE(PG8_SB(1, 0), b3, voffB); PG8_STAGE(PG8_SB(1, 1), b3 + hstep, voffB); PG8_STAGE(PG8_SA(1, 0), a3, voffA);
            PG8_WAIT_V(8); PG8_WAIT_L(0); PG8_BAR; PG8_MMA(1, 0, At, B0); PG8_MMA(1, 1, At, B1); PG8_BAR; PG8_SCHED;
            } else {
            PG8_LDB(B0, 0, 0); PG8_SCHED; PG8_LDA(At, 0, 0); PG8_STAGE(PG8_SA(1, 1), a1 + hstep, voffA);
            PG8_WAIT_L(8); PG8_BAR; PG8_WAIT_L(0); PG8_MMA(0, 0, At, B0); PG8_BAR; PG8_SCHED;
            PG8_LDB(B1, 0, 1); PG8_STAGE(PG8_SB(0, 0), b2, voffB);
            PG8_BAR; PG8_WAIT_L(0); PG8_MMA(0, 1, At, B1); PG8_BAR;
            PG8_LDA(At, 0, 1); PG8_STAGE(PG8_SA(0, 0), a2, voffA);
            PG8_BAR; PG8_WAIT_L(0); PG8_MMA(1, 0, At, B0); PG8_BAR; PG8_SCHED;
            PG8_STAGE(PG8_SB(0, 1), b2 + hstep, voffB);
            PG8_WAIT_V(6); PG8_BAR; PG8_MMA(1, 1, At, B1); PG8_BAR;
            PG8_LDB(B0, 1, 0); PG8_SCHED; PG8_LDA(At, 1, 0); PG8_STAGE(PG8_SA(0, 1), a2 + hstep, voffA);
            PG8_WAIT_L(8); PG8_BAR; PG8_WAIT_L(0); PG8_MMA(0, 0, At, B0); PG8_BAR; PG8_SCHED;
            PG8_LDB(B1, 1, 1); PG8_STAGE(PG8_SB(1, 0), b3, voffB);
            PG8_BAR; PG8_WAIT_L(0); PG8_MMA(0, 1, At, B1); PG8_BAR;
            PG8_LDA(At, 1, 1); PG8_STAGE(PG8_SA(1, 0), a3, voffA);
            PG8_BAR; PG8_WAIT_L(0); PG8_MMA(1, 0, At, B0); PG8_BAR; PG8_SCHED;
            PG8_STAGE(PG8_SB(1, 1), b3 + hstep, voffB);
            PG8_WAIT_V(6); PG8_BAR; PG8_MMA(1, 1, At, B1); PG8_BAR;
            }
        }
        if constexpr (ALIGN_EPI) { if (wr == 0) PG8_BAR; }
        if constexpr (!Epi::AFTER_DRAIN) { E(acc, cur, wr, wc, fr, fq); S.done(cur); }
        if (!has_next) break;
#pragma unroll
        for (int a = 0; a < 2; ++a)
#pragma unroll
            for (int b = 0; b < 2; ++b)
#pragma unroll
                for (int m = 0; m < 4; ++m)
#pragma unroll
                    for (int n = 0; n < 2; ++n) acc[a][b][m][n] = (f32x4){0.f, 0.f, 0.f, 0.f};
        cur = nxt; cA = nA; cB = nB; ++ui;
        if constexpr (ALIGN_EPI) { if (wr == 1) PG8_BAR; }
    }
    PG8_WAIT_V(0);
    if constexpr (!ALIGN_EPI) { if (wr == 0) PG8_BAR; }
    PG8_BAR;
    if constexpr (Epi::AFTER_DRAIN) { E.fused(acc, cur, wr, wc, fr, fq, lds, wid, lane); S.done(cur); }
#undef PG8_SA
#undef PG8_SB
#undef PG8_STAGE
#undef PG8_LDA
#undef PG8_LDB
#undef PG8_MMA
#undef PG8_WAIT_V
#undef PG8_WAIT_L
#undef PG8_BAR
#undef PG8_SCHED
}
}
#ifndef MK_COOP
#define MK_COOP 1
#endif
#ifndef MK_REP_K
#define MK_REP_K -1
#endif
#ifndef MK_REP_N
#define MK_REP_N 1
#endif
namespace mk {
using pg8::bf16_t; using pg8::bf16x8; using pg8::f32x4; using pg8::u32x4;
typedef float f32x16 __attribute__((ext_vector_type(16)));
typedef unsigned u32x2 __attribute__((ext_vector_type(2)));
typedef float f32x2_t __attribute__((ext_vector_type(2)));
typedef __bf16 bf16x2_t __attribute__((ext_vector_type(2)));
#define LAS __attribute__((address_space(3)))
#define MFMA32(a, b, c) __builtin_amdgcn_mfma_f32_32x32x16_bf16((a), (b), (c), 0, 0, 0)

constexpr int M_TOK = 16384, SEQ = 8192, DM = 1024, DIN = 3488, DINP = 3584, NLAYER = 2;
constexpr int C_AQ = 0, C_AK = 256, C_AV = 384, C_BB = 512, C_BC = 768, C_BX = 1024, C_CQ = 1280, C_CKV = 1536, C_CKR = 1664,
              C_DQ = 1696, C_DK = 1952, C_DV = 2208, C_GATE = 2464;
constexpr float EPS = 1e-6f, LOG2E = 1.4426950408889634f;
constexpr float SC64 = 0.125f * LOG2E;
constexpr float QSC_MLA = 0.10206207261596575f * LOG2E;
constexpr int NWAVES = 8, NTHREADS = 512;
constexpr int LDS_BYTES = 122880 + 8 * 4096 + 1024;

constexpr size_t MiB = 1u << 20;
constexpr size_t WS_CTL = 0, CTL_BYTES = 65536;
constexpr int CW_BAR = 1024;
constexpr size_t WS_WIN = 1 * MiB;
constexpr size_t WS_WOUT = 15 * MiB;
constexpr size_t WS_WUQ = 19 * MiB;
constexpr size_t WS_WUKV = 19 * MiB + 512 * 1024;
constexpr size_t WS_XN = 32 * MiB;
constexpr size_t WS_H = 64 * MiB;
constexpr size_t WS_QC = 176 * MiB;
constexpr size_t WS_KC = 188 * MiB;
constexpr size_t WS_VTC = 200 * MiB;
constexpr size_t WS_VTA = 208 * MiB;
constexpr size_t WS_VTD = 212 * MiB;
constexpr size_t WS_Y = 220 * MiB;
constexpr size_t WS_END = 252 * MiB;

struct Params {
    const float* x; const int* pos; const float* norm_pre; const float* w_in; const float* sinks; const float* conv_w; const float* conv_b;
    const float* g_cq; const float* w_uq; const float* g_ckv; const float* w_ukv; const float* g_grp; const float* w_out; const float* g_post;
    float* out; unsigned char* ws; int ph_lo, ph_hi;
};

__device__ __forceinline__ unsigned pk2(float lo, float hi) { f32x2_t v = {lo, hi}; bf16x2_t b = __builtin_convertvector(v, bf16x2_t); return __builtin_bit_cast(unsigned, b); }
__device__ __forceinline__ float bf2f(short s) { return __uint_as_float(((unsigned)(unsigned short)s) << 16); }
__device__ __forceinline__ float bflo(unsigned u) { return __uint_as_float(u << 16); }
__device__ __forceinline__ float bfhi(unsigned u) { return __uint_as_float(u & 0xffff0000u); }
__device__ __forceinline__ bf16_t f2bf(float f) { return (bf16_t)(pk2(f, 0.f) & 0xffffu); }
__device__ __forceinline__ int crow(int i, int h) { return (i & 3) + 8 * (i >> 2) + 4 * h; }
__device__ __forceinline__ float ex2(float x) { return __builtin_amdgcn_exp2f(x); }
__device__ __forceinline__ float lg2(float x) { return __builtin_amdgcn_logf(x); }
__device__ __forceinline__ float xh_max(float v) { auto rr = __builtin_amdgcn_permlane32_swap(__float_as_uint(v), __float_as_uint(v), false, false); return fmaxf(__uint_as_float(rr[0]), __uint_as_float(rr[1])); }
__device__ __forceinline__ float xh_sum(float v) { auto rr = __builtin_amdgcn_permlane32_swap(__float_as_uint(v), __float_as_uint(v), false, false); return __uint_as_float(rr[0]) + __uint_as_float(rr[1]); }
__device__ __forceinline__ float xh_other(float v, int h) { auto rr = __builtin_amdgcn_permlane32_swap(__float_as_uint(v), __float_as_uint(v), false, false); return __uint_as_float(h ? rr[0] : rr[1]); }
#define MX3(a, b, c) __builtin_fmaxf(__builtin_fmaxf((a), (b)), (c))
__device__ __forceinline__ float wave_sum(float v) {
#pragma unroll
    for (int o = 1; o < 64; o <<= 1) v += __shfl_xor(v, o);
    return v;
}
__device__ __forceinline__ bf16x8 pack8(const float* e) {
    u32x4 w; w.x = pk2(e[0], e[1]); w.y = pk2(e[2], e[3]); w.z = pk2(e[4], e[5]); w.w = pk2(e[6], e[7]);
    return __builtin_bit_cast(bf16x8, w);
}

__device__ __forceinline__ void conv_wT(const float* __restrict__ W, int K, int N, int NP, const float* __restrict__ gain, bf16_t* __restrict__ dst,
                                        int a0, int a1, int b0, int b1, float sc, int gtid, int gthreads) {
    const int k8n = K / 8; const int items = NP * k8n;
#pragma unroll 2
    for (int it = gtid; it < items; it += gthreads) {
        const int n = it % NP, k8 = it / NP;
        u32x4 o = {0u, 0u, 0u, 0u};
        if (n < N) {
            const float cs = ((n >= a0 && n < a1) || (n >= b0 && n < b1)) ? sc : 1.f;
            float v[8];
#pragma unroll
            for (int j = 0; j < 8; ++j) v[j] = W[(size_t)(k8 * 8 + j) * N + n] * gain[k8 * 8 + j] * cs;
            o.x = pk2(v[0], v[1]); o.y = pk2(v[2], v[3]); o.z = pk2(v[4], v[5]); o.w = pk2(v[6], v[7]);
        }
        *(u32x4*)(dst + (size_t)n * K + k8 * 8) = o;
    }
}
__device__ __forceinline__ void wT_item(const float* __restrict__ W, int K, int N, const float* __restrict__ gain, bf16_t* __restrict__ WT, int a0, int a1, int b0, int b1, float sc,
                                        LAS float* scr, int item, int lane) {
    const int nblk = N / 32, kb = item / nblk, nb = item - kb * nblk, k0 = 64 * kb, n0 = 32 * nb;
#pragma unroll 8
    for (int i = 0; i < 32; ++i) { const int kk = 2 * i + (lane >> 5); scr[kk * 33 + (lane & 31)] = W[(size_t)(k0 + kk) * N + n0 + (lane & 31)]; }
    const int c = lane & 7;
    float g8[8];
#pragma unroll
    for (int j = 0; j < 8; ++j) g8[j] = gain[k0 + 8 * c + j];
#pragma unroll
    for (int j = 0; j < 4; ++j) { const int n = (lane >> 3) + 8 * j, nn = n0 + n; const LAS float* sp = scr + (8 * c) * 33 + n;
        const float cs = ((nn >= a0 && nn < a1) || (nn >= b0 && nn < b1)) ? sc : 1.f;
        u32x4 o; o.x = pk2(sp[0 * 33] * g8[0] * cs, sp[1 * 33] * g8[1] * cs); o.y = pk2(sp[2 * 33] * g8[2] * cs, sp[3 * 33] * g8[3] * cs);
        o.z = pk2(sp[4 * 33] * g8[4] * cs, sp[5 * 33] * g8[5] * cs); o.w = pk2(sp[6 * 33] * g8[6] * cs, sp[7 * 33] * g8[7] * cs);
        *(u32x4*)(WT + (size_t)nn * K + k0 + 8 * c) = o; }
}
__device__ __forceinline__ void rms_row_to_bf16(const float* __restrict__ xrow, bf16_t* __restrict__ orow, int lane) {
    f32x4 v[4]; float s = 0.f;
#pragma unroll
    for (int j = 0; j < 4; ++j) { v[j] = ((const f32x4*)xrow)[lane + 64 * j]; s += (v[j].x * v[j].x + v[j].y * v[j].y) + (v[j].z * v[j].z + v[j].w * v[j].w); }
    const float rs = rsqrtf(wave_sum(s) * (1.f / DM) + EPS);
#pragma unroll
    for (int j = 0; j < 4; ++j) { u32x2 o; o.x = pk2(v[j].x * rs, v[j].y * rs); o.y = pk2(v[j].z * rs, v[j].w * rs); ((u32x2*)orow)[lane + 64 * j] = o; }
}

__device__ __forceinline__ void rope_cs(int pos, int h, float (&cs)[8], float (&sn)[8]) {
#pragma unroll
    for (int i = 0; i < 8; ++i) {
        const int f = (i & 3) + 8 * (i >> 2) + 4 * h;
        const float freq = ex2(-(float)f * 0.830482023721841f);
        const float ang = (float)pos * freq;
        const double rev = (double)ang * 0.15915494309189535;
        const float fr = (float)(rev - __builtin_rint(rev));
        cs[i] = __builtin_amdgcn_cosf(fr); sn[i] = __builtin_amdgcn_sinf(fr);
    }
}
__device__ __forceinline__ void rope_apply(f32x16& a, const float (&cs)[8], const float (&sn)[8]) {
#pragma unroll
    for (int i = 0; i < 8; ++i) { const float x1 = a[i], x2 = a[i + 8]; a[i] = x1 * cs[i] - x2 * sn[i]; a[i + 8] = x1 * sn[i] + x2 * cs[i]; }
}
__device__ __forceinline__ void store_tile_rowmajor(bf16_t* dst  , const f32x16& a, int h) {
#pragma unroll
    for (int g = 0; g < 4; ++g) { u32x2 o; o.x = pk2(a[4 * g], a[4 * g + 1]); o.y = pk2(a[4 * g + 2], a[4 * g + 3]); *(u32x2*)(dst + 8 * g + 4 * h) = o; }
}
constexpr int WQP = 528, WKP = 272, WQ_BYTES = 96 * WQP;
__device__ __forceinline__ void mq_unit(const bf16_t* __restrict__ H, const LAS unsigned char* Wl, const int* __restrict__ pos, bf16_t* __restrict__ QC, int tb, int hh, int lane) {
    const int r = lane & 31, h = lane >> 5, tok = tb * 32 + r;
    const bf16_t* src = H + (size_t)tok * DINP + C_CQ + 8 * h;
    bf16x8 bfr[16]; float ss = 0.f;
#pragma unroll
    for (int s = 0; s < 16; ++s) { bfr[s] = *(const bf16x8*)(src + 16 * s);
#pragma unroll
        for (int j = 0; j < 8; ++j) { const float v = bf2f(bfr[s][j]); ss += v * v; } }
    ss += __shfl_xor(ss, 32);
    const float rs = rsqrtf(ss * (1.f / 256.f) + EPS) * QSC_MLA;
    float cs[8], sn[8]; rope_cs(pos[tok], h, cs, sn);
    const LAS unsigned char* W = Wl + r * WQP + 16 * h;
#pragma unroll 1
    for (int nt = 0; nt < 3; ++nt) {
        f32x16 acc;
#pragma unroll
        for (int i = 0; i < 16; ++i) acc[i] = 0.f;
#pragma unroll
        for (int s = 0; s < 16; ++s) { const bf16x8 a = *(const LAS bf16x8*)(W + nt * 32 * WQP + 32 * s); acc = MFMA32(a, bfr[s], acc); }
#pragma unroll
        for (int i = 0; i < 16; ++i) acc[i] *= rs;
        if (nt == 2) rope_apply(acc, cs, sn);
        store_tile_rowmajor(QC + (size_t)tok * 384 + hh * 96 + nt * 32, acc, h);
    }
}
__device__ __forceinline__ void vt_flush(LAS bf16_t* stg, bf16_t* __restrict__ dst  , int lane) {
    const LAS u32x4* rp = (const LAS u32x4*)(stg + lane * 32);
    u32x4 w[4];
#pragma unroll
    for (int c = 0; c < 4; ++c) w[c] = rp[c];
    u32x4* gp = (u32x4*)(dst + (size_t)lane * SEQ);
#pragma unroll
    for (int c = 0; c < 4; ++c) gp[c] = w[c];
}
__device__ __forceinline__ void mkv_unit(const bf16_t* __restrict__ H, const LAS unsigned char* Wl, const int* __restrict__ pos, bf16_t* __restrict__ KC, bf16_t* __restrict__ VTC, int tb, int hh, int lane, LAS bf16_t* stg) {
    const int r = lane & 31, h = lane >> 5, tok = tb * 32 + r;
    const bf16_t* src = H + (size_t)tok * DINP + C_CKV + 8 * h;
    bf16x8 bfr[8]; float ss = 0.f;
#pragma unroll
    for (int s = 0; s < 8; ++s) { bfr[s] = *(const bf16x8*)(src + 16 * s);
#pragma unroll
        for (int j = 0; j < 8; ++j) { const float v = bf2f(bfr[s][j]); ss += v * v; } }
    ss += __shfl_xor(ss, 32);
    const float rs = rsqrtf(ss * (1.f / 128.f) + EPS);
    const LAS unsigned char* W = Wl + r * WKP + 16 * h;
    const int b = (tb * 32) / SEQ, t0 = (tb * 32) % SEQ;
#pragma unroll 1
    for (int nt = 0; nt < 4; ++nt) {
        f32x16 acc;
#pragma unroll
        for (int i = 0; i < 16; ++i) acc[i] = 0.f;
#pragma unroll
        for (int s = 0; s < 8; ++s) { const bf16x8 a = *(const LAS bf16x8*)(W + nt * 32 * WKP + 32 * s); acc = MFMA32(a, bfr[s], acc); }
#pragma unroll
        for (int i = 0; i < 16; ++i) acc[i] *= rs;
        if (nt < 2) store_tile_rowmajor(KC + (size_t)tok * 384 + hh * 96 + nt * 32, acc, h);
        else {
            LAS bf16_t* sp = stg + ((nt - 2) * 32 + 4 * h) * 32 + r;
#pragma unroll
            for (int i = 0; i < 16; ++i) sp[((i & 3) + 8 * (i >> 2)) * 32] = f2bf(acc[i]);
        }
    }
    vt_flush(stg, VTC + ((size_t)((b * 4 + hh) * 64)) * SEQ + t0, lane);
    f32x16 kr;
    const bf16_t* krp = H + (size_t)tok * DINP + C_CKR + 4 * h;
#pragma unroll
    for (int g = 0; g < 4; ++g) { const u32x2 w = *(const u32x2*)(krp + 8 * g); kr[4 * g] = bflo(w.x); kr[4 * g + 1] = bfhi(w.x); kr[4 * g + 2] = bflo(w.y); kr[4 * g + 3] = bfhi(w.y); }
    float cs[8], sn[8]; rope_cs(pos[tok], h, cs, sn);
    rope_apply(kr, cs, sn);
    store_tile_rowmajor(KC + (size_t)tok * 384 + hh * 96 + 64, kr, h);
}
__device__ __forceinline__ void vt_unit(const bf16_t* __restrict__ H, int col0, int NH, bf16_t* __restrict__ VT, int tb, int head, int lane, LAS bf16_t* stg) {
    const int r = lane & 31, h = lane >> 5, tok = tb * 32 + r, b = (tb * 32) / SEQ, t0 = (tb * 32) % SEQ;
    const bf16_t* src = H + (size_t)tok * DINP + col0 + head * 64 + 32 * h;
    bf16x8 v[4];
#pragma unroll
    for (int c = 0; c < 4; ++c) v[c] = *(const bf16x8*)(src + 8 * c);
    LAS bf16_t* sp = stg + (32 * h) * 32 + r;
#pragma unroll
    for (int c = 0; c < 4; ++c)
#pragma unroll
        for (int j = 0; j < 8; ++j) sp[(8 * c + j) * 32] = (bf16_t)v[c][j];
    vt_flush(stg, VT + ((size_t)((b * NH + head) * 64)) * SEQ + t0, lane);
}
__device__ __forceinline__ void conv_unit(const bf16_t* __restrict__ H, const float* __restrict__ cw, const float* __restrict__ cb, bf16_t* __restrict__ Y, int tb8, int lane) {
    const int tok0 = tb8 * 8, t0 = tok0 % SEQ, ch = 4 * lane;
    const f32x4 w0 = *(const f32x4*)(cw + ch), w1 = *(const f32x4*)(cw + 256 + ch), w2 = *(const f32x4*)(cw + 512 + ch), bs = *(const f32x4*)(cb + ch);
    u32x2 cc[10], xx[10], bb[8];
    const int back = (t0 >= 2) ? 2 : 0;
#pragma unroll
    for (int i = 0; i < 10; ++i) { const int ti = (i < 2) ? (i - back) : (i - 2); const bf16_t* p = H + (size_t)(tok0 + ti) * DINP + ch;
        cc[i] = *(const u32x2*)(p + C_BC); xx[i] = *(const u32x2*)(p + C_BX); if (i >= 2) bb[i - 2] = *(const u32x2*)(p + C_BB); }
    f32x4 u[10];
#pragma unroll
    for (int i = 0; i < 10; ++i) u[i] = (f32x4){bflo(cc[i].x) * bflo(xx[i].x), bfhi(cc[i].x) * bfhi(xx[i].x), bflo(cc[i].y) * bflo(xx[i].y), bfhi(cc[i].y) * bfhi(xx[i].y)};
    if (back == 0) { u[0] = (f32x4){0.f, 0.f, 0.f, 0.f}; u[1] = (f32x4){0.f, 0.f, 0.f, 0.f}; }
#pragma unroll
    for (int i = 0; i < 8; ++i) {
        const f32x4 bg = {bflo(bb[i].x), bfhi(bb[i].x), bflo(bb[i].y), bfhi(bb[i].y)};
        const f32x4 y = bg * (w0 * u[i] + w1 * u[i + 1] + w2 * u[i + 2] + bs);
        u32x2 o; o.x = pk2(y.x, y.y); o.y = pk2(y.z, y.w);
        *(u32x2*)(Y + (size_t)(tok0 + i) * DM + 256 + ch) = o;
    }
}

__device__ __forceinline__ void o_flush(LAS bf16_t* stg, bf16_t* __restrict__ Orow0, int opitch, int lane) {
    u32x4 w[4];
#pragma unroll
    for (int j = 0; j < 4; ++j) w[j] = *(const LAS u32x4*)(stg + (lane + 64 * j) * 8);
#pragma unroll
    for (int j = 0; j < 4; ++j) { const int c = lane + 64 * j; *(u32x4*)(Orow0 + (size_t)(c >> 3) * opitch + (c & 7) * 8) = w[j]; }
}
template <int DKS, bool SINK>
__device__ __forceinline__ void softmax_unit(const bf16_t* __restrict__ Qrow0, int qpitch, const bf16_t* __restrict__ Kb, int kpitch, const bf16_t* __restrict__ VT,
                                             int qb, int kt_begin, int window, float sink2, bf16_t* __restrict__ Orow0, int opitch, int lane, LAS bf16_t* stg) {
    const int r = lane & 31, h = lane >> 5;
    const int pr = (r & ~12) | ((r & 8) >> 1) | ((r & 4) << 1);
    bf16x8 qf[DKS];
#pragma unroll
    for (int s = 0; s < DKS; ++s) qf[s] = *(const bf16x8*)(Qrow0 + (size_t)r * qpitch + 16 * s + 8 * h);
    f32x16 o0, o1;
#pragma unroll
    for (int i = 0; i < 16; ++i) { o0[i] = 0.f; o1[i] = 0.f; }
    float m = -1e30f, l = 0.f;
    const int kt_end = qb + 1, q = 32 * qb + r;
    const bf16_t* kp = Kb + (size_t)(32 * kt_begin + pr) * kpitch + 8 * h;
    const bf16_t* vp = VT + (size_t)r * SEQ + 32 * kt_begin + 8 * h;
    bf16x8 kf[DKS];
#pragma unroll
    for (int s = 0; s < DKS; ++s) kf[s] = *(const bf16x8*)(kp + 16 * s);
    for (int kt = kt_begin; kt < kt_end; ++kt) {
        bf16x8 kn[DKS];
        if (kt + 1 < kt_end) {
#pragma unroll
            for (int s = 0; s < DKS; ++s) kn[s] = *(const bf16x8*)(kp + (size_t)32 * kpitch + 16 * s);
        } else {
#pragma unroll
            for (int s = 0; s < DKS; ++s) kn[s] = kf[s];
        }
        const bf16x8 v00 = *(const bf16x8*)(vp), v01 = *(const bf16x8*)(vp + 32 * SEQ), v10 = *(const bf16x8*)(vp + 16), v11 = *(const bf16x8*)(vp + 32 * SEQ + 16);
        f32x16 p;
#pragma unroll
        for (int i = 0; i < 16; ++i) p[i] = 0.f;
#pragma unroll
        for (int s = 0; s < DKS; ++s) p = MFMA32(kf[s], qf[s], p);
        if (kt == qb || (window != 0 && kt == qb - (window >> 5))) {
            const int k0 = 32 * kt + 8 * h;
#pragma unroll
            for (int i = 0; i < 16; ++i) { const int kv = k0 + 16 * (i >> 3) + (i & 7); const bool ok = (kv <= q) && (window == 0 || kv > q - window); if (!ok) p[i] = -INFINITY; }
        }
        float rm = MX3(p[0], p[1], p[2]);
#pragma unroll
        for (int i = 3; i < 15; i += 2) rm = MX3(rm, p[i], p[i + 1]);
        rm = xh_max(fmaxf(rm, p[15]));
        if (__any(rm > m + 6.f)) {
            const float mn = fmaxf(m, rm), f = ex2(m - mn); m = mn; l *= f;
#pragma unroll
            for (int i = 0; i < 16; ++i) { const float fi = __shfl(f, crow(i, h)); o0[i] *= fi; o1[i] *= fi; }
        }
        float e[16];
#pragma unroll
        for (int i = 0; i < 16; ++i) { e[i] = ex2(p[i] - m); l += e[i]; }
        const bf16x8 pa0 = pack8(e), pa1 = pack8(e + 8);
        o0 = MFMA32(pa0, v00, o0); o1 = MFMA32(pa0, v01, o1);
        o0 = MFMA32(pa1, v10, o0); o1 = MFMA32(pa1, v11, o1);
#pragma unroll
        for (int s = 0; s < DKS; ++s) kf[s] = kn[s];
        kp += (size_t)32 * kpitch; vp += 32;
    }
    l = xh_sum(l);
    if (SINK) l += ex2(sink2 - m);
    const float inv = 1.f / l;
    LAS bf16_t* sp = stg + (4 * h) * 64 + r;
#pragma unroll
    for (int i = 0; i < 16; ++i) { const float fi = __shfl(inv, crow(i, h)); const int ro = ((i & 3) + 8 * (i >> 2)) * 64;
        sp[ro] = f2bf(o0[i] * fi); sp[ro + 32] = f2bf(o1[i] * fi); }
    o_flush(stg, Orow0, opitch, lane);
}


constexpr int KP = 208, VP = 272;
constexpr int KT_BYTES = 128 * KP, VT_BYTES = 64 * VP, TB_BYTES = KT_BYTES + VT_BYTES, MRG_OFF = 2 * TB_BYTES;
static_assert(MRG_OFF + 4 * 34 * 64 * 4 <= 131072, "MLA LDS map");
__device__ __forceinline__ void mla_unit_blk(const bf16_t* __restrict__ QC, const bf16_t* __restrict__ KC, const bf16_t* __restrict__ VTC, bf16_t* __restrict__ Y,
                                             int bh, int g, LAS unsigned char* lds, int tid) {
    const int lane = tid & 63, wave = __builtin_amdgcn_readfirstlane(tid >> 6), r = lane & 31, h = lane >> 5, w4 = wave & 3, kh = wave >> 2;
    const int pr = (r & ~12) | ((r & 8) >> 1) | ((r & 4) << 1);
    const int b = bh >> 2, hh = bh & 3, qb = 4 * g + w4, q = 32 * qb + r;
    const bf16_t* Qp = QC + ((size_t)b * SEQ + q) * 384 + hh * 96 + 8 * h;
    bf16x8 qf[6];
#pragma unroll
    for (int s = 0; s < 6; ++s) qf[s] = *(const bf16x8*)(Qp + 16 * s);
    const bf16_t* Kg = KC + (size_t)b * SEQ * 384 + hh * 96;
    const bf16_t* Vg = VTC + (size_t)(b * 4 + hh) * 64 * SEQ;
    unsigned dgo[6];
#pragma unroll
    for (int i = 0; i < 6; ++i) { const int n = wave + 8 * i; unsigned o = 0u;
        if (n < 26) { const int j = 64 * n + lane, row = j / 13; int cc = j - 13 * row; cc = cc == 12 ? 0 : cc; o = (unsigned)(row * 384 + 8 * cc) * 2u; }
        else if (n < 43) { const int j = 64 * (n - 26) + lane, d = j / 17; int cc = j - 17 * d; cc = cc == 16 ? 0 : cc; o = (unsigned)(d * SEQ + 8 * cc) * 2u; }
        dgo[i] = o; }
#define MLA_DMA(ST, BO) do { const char* kb_ = (const char*)(Kg + (size_t)(ST) * (128 * 384)); const char* vb_ = (const char*)(Vg + (ST) * 128); \
        _Pragma("unroll") for (int i = 0; i < 6; ++i) { const int n = wave + 8 * i; \
            if (n < 26) __builtin_amdgcn_global_load_lds((const unsigned*)(kb_ + dgo[i]), (LAS unsigned*)(lds + (BO) + n * 1024), 16, 0, 0); \
            else if (n < 43) __builtin_amdgcn_global_load_lds((const unsigned*)(vb_ + dgo[i]), (LAS unsigned*)(lds + (BO) + KT_BYTES + (n - 26) * 1024), 16, 0, 0); } } while (0)
#define MLA_DMA_WAIT() asm volatile("s_waitcnt vmcnt(0)" ::: "memory")
    f32x16 o0, o1;
#pragma unroll
    for (int i = 0; i < 16; ++i) { o0[i] = 0.f; o1[i] = 0.f; }
    float m = -1e30f, l = 0.f;
    const int nST = g + 1;
    MLA_DMA(0, 0); MLA_DMA_WAIT();
    __syncthreads();
    const int kfo = (64 * kh + pr) * KP + 16 * h;
    const int vfo = KT_BYTES + r * VP + (64 * kh + 8 * h) * 2;
    for (int ST = 0; ST < nST; ++ST) {
        if (ST + 1 < nST) MLA_DMA(ST + 1, ((ST + 1) & 1) * TB_BYTES);
        const int kt0 = 4 * ST + 2 * kh;
        if (kt0 <= qb) {
            const LAS unsigned char* tb = lds + (ST & 1) * TB_BYTES;
            f32x16 p0, p1;
#pragma unroll
            for (int i = 0; i < 16; ++i) { p0[i] = 0.f; p1[i] = 0.f; }
#pragma unroll
            for (int s = 0; s < 6; ++s) { const bf16x8 k0 = *(const LAS bf16x8*)(tb + kfo + 32 * s), k1 = *(const LAS bf16x8*)(tb + kfo + 32 * KP + 32 * s);
                p0 = MFMA32(k0, qf[s], p0); p1 = MFMA32(k1, qf[s], p1); }
            if (kt0 + 1 >= qb) {
                const int kb0 = 32 * kt0 + 8 * h;
#pragma unroll
                for (int i = 0; i < 16; ++i) { const int kv = kb0 + 16 * (i >> 3) + (i & 7); if (kv > q) p0[i] = -INFINITY; if (kv + 32 > q) p1[i] = -INFINITY; }
            }
            float ra_ = MX3(p0[0], p0[1], p1[0]), rb_ = MX3(p0[2], p0[3], p1[1]); ra_ = MX3(ra_, p1[2], p1[3]);
#pragma unroll
            for (int i = 4; i < 16; i += 4) { ra_ = MX3(ra_, p0[i], p0[i + 1]); rb_ = MX3(rb_, p0[i + 2], p0[i + 3]); ra_ = MX3(ra_, p1[i], p1[i + 1]); rb_ = MX3(rb_, p1[i + 2], p1[i + 3]); }
            const float rm = xh_max(fmaxf(ra_, rb_));
            if (__any(rm > m + 6.f)) {
                const float mn = fmaxf(m, rm), f = ex2(m - mn); m = mn; l *= f;
#pragma unroll
                for (int i = 0; i < 16; ++i) { const float fi = __shfl(f, crow(i, h)); o0[i] *= fi; o1[i] *= fi; }
            }
            float ls = 0.f;
#pragma unroll
            for (int i = 0; i < 16; ++i) { p0[i] = ex2(p0[i] - m); p1[i] = ex2(p1[i] - m); ls += p0[i] + p1[i]; }
            l += ls;
            float e[8];
#pragma unroll
            for (int ks = 0; ks < 4; ++ks) {
#pragma unroll
                for (int j = 0; j < 8; ++j) e[j] = (ks < 2) ? p0[8 * ks + j] : p1[8 * (ks - 2) + j];
                const bf16x8 pa = pack8(e);
                const bf16x8 v0 = *(const LAS bf16x8*)(tb + vfo + 32 * ks), v1 = *(const LAS bf16x8*)(tb + vfo + 32 * VP + 32 * ks);
                o0 = MFMA32(pa, v0, o0); o1 = MFMA32(pa, v1, o1);
            }
        }
        MLA_DMA_WAIT();
        __syncthreads();
    }
#undef MLA_DMA
#undef MLA_DMA_WAIT
    l = xh_sum(l);
    LAS float* mg = (LAS float*)(lds + MRG_OFF) + w4 * (34 * 64) + lane;
    if (kh == 1) {
#pragma unroll
        for (int i = 0; i < 16; ++i) { mg[i * 64] = o0[i]; mg[(16 + i) * 64] = o1[i]; }
        mg[32 * 64] = m; mg[33 * 64] = l;
    }
    __syncthreads();
    if (kh == 0) {
        const float mb = mg[32 * 64], lb = mg[33 * 64];
        const float mn = fmaxf(m, mb), fa = ex2(m - mn), fb = ex2(mb - mn), inv = 1.f / (l * fa + lb * fb), ga = fa * inv, gb = fb * inv;
        LAS bf16_t* stg = (LAS bf16_t*)(lds + wave * 4096);
        LAS bf16_t* sp = stg + (4 * h) * 64 + r;
#pragma unroll
        for (int i = 0; i < 16; ++i) { const float ra = __shfl(ga, crow(i, h)), rb = __shfl(gb, crow(i, h)); const int ro = ((i & 3) + 8 * (i >> 2)) * 64;
            sp[ro] = f2bf(o0[i] * ra + mg[i * 64] * rb); sp[ro + 32] = f2bf(o1[i] * ra + mg[(16 + i) * 64] * rb); }
        o_flush(stg, Y + ((size_t)b * SEQ + 32 * qb) * DM + 512 + hh * 64, DM, lane);
    }
    __syncthreads();
}

__device__ __forceinline__ void sb_unit(const bf16_t* __restrict__ Qrow0, int qpitch, const bf16_t* __restrict__ Kb, int kpitch, const bf16_t* __restrict__ VT,
                                        int qb, bf16_t* __restrict__ Orow0, int opitch, int lane, LAS bf16_t* stg) {
    const int r = lane & 31, h = lane >> 5;
    const int pr = (r & ~12) | ((r & 8) >> 1) | ((r & 4) << 1);
    bf16x8 qf[4];
#pragma unroll
    for (int s = 0; s < 4; ++s) qf[s] = *(const bf16x8*)(Qrow0 + (size_t)r * qpitch + 16 * s + 8 * h);
    f32x16 o0, o1;
#pragma unroll
    for (int i = 0; i < 16; ++i) { o0[i] = 0.f; o1[i] = 0.f; }
    float carry = 0.f;
    const int q = 32 * qb + r;
    const bf16_t* kp = Kb + (size_t)(32 * qb + pr) * kpitch + 8 * h;
    const bf16_t* vp = VT + (size_t)r * SEQ + 32 * qb + 8 * h;
    bf16x8 kf[4];
#pragma unroll
    for (int s = 0; s < 4; ++s) kf[s] = *(const bf16x8*)(kp + 16 * s);
    for (int kt = qb; kt >= 0; --kt) {
        bf16x8 kn[4];
        if (kt > 0) {
#pragma unroll
            for (int s = 0; s < 4; ++s) kn[s] = *(const bf16x8*)(kp - (size_t)32 * kpitch + 16 * s);
        } else {
#pragma unroll
            for (int s = 0; s < 4; ++s) kn[s] = kf[s];
        }
        const bf16x8 v00 = *(const bf16x8*)(vp), v01 = *(const bf16x8*)(vp + 32 * SEQ), v10 = *(const bf16x8*)(vp + 16), v11 = *(const bf16x8*)(vp + 32 * SEQ + 16);
        f32x16 p;
#pragma unroll
        for (int i = 0; i < 16; ++i) p[i] = 0.f;
#pragma unroll
        for (int s = 0; s < 4; ++s) p = MFMA32(kf[s], qf[s], p);
        const bool diag = (kt == qb);
        const int k0 = 32 * kt + 8 * h;
        float sfx[16];
#pragma unroll
        for (int i = 0; i < 16; ++i) {
            const float z = p[i];
            float L = -(fmaxf(z, 0.f) + lg2(1.f + ex2(-fabsf(z))));
            if (diag) { const int kv = k0 + 16 * (i >> 3) + (i & 7); if (!(kv < q)) L = 0.f; }
            sfx[i] = L;
        }
#pragma unroll
        for (int g = 0; g < 2; ++g)
#pragma unroll
            for (int j = 6; j >= 0; --j) sfx[8 * g + j] += sfx[8 * g + j + 1];
        const float T0 = sfx[0], T1 = sfx[8];
        const float TP0 = __shfl_xor(T0, 32), TP1 = __shfl_xor(T1, 32);
        const float off1 = (h ? 0.f : TP1) + carry, off0 = T1 + TP1 + (h ? 0.f : TP0) + carry;
        float e[16];
#pragma unroll
        for (int i = 0; i < 16; ++i) {
            float a = ex2(p[i] + sfx[i] + (i < 8 ? off0 : off1));
            if (diag) { const int kv = k0 + 16 * (i >> 3) + (i & 7); if (!(kv < q)) a = 0.f; }
            e[i] = a;
        }
        carry += (T0 + T1) + (TP0 + TP1);
        const bf16x8 pa0 = pack8(e), pa1 = pack8(e + 8);
        o0 = MFMA32(pa0, v00, o0); o1 = MFMA32(pa0, v01, o1);
        o0 = MFMA32(pa1, v10, o0); o1 = MFMA32(pa1, v11, o1);
        if (__all(carry < -150.f)) break;
#pragma unroll
        for (int s = 0; s < 4; ++s) kf[s] = kn[s];
        kp -= (size_t)32 * kpitch; vp -= 32;
    }
    LAS bf16_t* sp = stg + (4 * h) * 64 + r;
#pragma unroll
    for (int i = 0; i < 16; ++i) { const int ro = ((i & 3) + 8 * (i >> 2)) * 64; sp[ro] = f2bf(o0[i]); sp[ro + 32] = f2bf(o1[i]); }
    o_flush(stg, Orow0, opitch, lane);
}


constexpr int AKP = 144;
constexpr int SWA_NK = 384, SWA_VP = SWA_NK * 2 + 16, SWA_KB = SWA_NK * AKP;
constexpr int SB_NK = 448, SB_VP = SB_NK * 2 + 16, SB_KB = SB_NK * AKP;
constexpr int STG_OFF = 122880, MISC_OFF = STG_OFF + 8 * 4096;
static_assert(SWA_KB + 64 * SWA_VP <= STG_OFF && SB_KB + 64 * SB_VP <= STG_OFF && MISC_OFF + 1024 == LDS_BYTES, "window LDS map");
template <int NK, int VPB>
__device__ __forceinline__ void stage_kv64(const bf16_t* __restrict__ Kb, int kpitch, const bf16_t* __restrict__ VT, int key0, LAS unsigned char* lds, int tid) {
    constexpr int NCH = NK * 8 / 512, VC = NK / 8;
    u32x4 kr[NCH], vr[NCH];
#pragma unroll
    for (int i = 0; i < NCH; ++i) { const int c = tid + 512 * i, row = c >> 3, cc = c & 7; int key = key0 + row; key = key < 0 ? 0 : key;
        kr[i] = *(const u32x4*)(Kb + (size_t)key * kpitch + 8 * cc); }
#pragma unroll
    for (int i = 0; i < NCH; ++i) { const int c = tid + 512 * i, d = c / VC, cc = c - d * VC; int key = key0 + 8 * cc; key = key < 0 ? 0 : key;
        vr[i] = *(const u32x4*)(VT + (size_t)d * SEQ + key); }
#pragma unroll
    for (int i = 0; i < NCH; ++i) { const int c = tid + 512 * i, row = c >> 3, cc = c & 7; *(LAS u32x4*)(lds + row * AKP + 16 * cc) = kr[i]; }
#pragma unroll
    for (int i = 0; i < NCH; ++i) { const int c = tid + 512 * i, d = c / VC, cc = c - d * VC; *(LAS u32x4*)(lds + NK * AKP + d * VPB + 16 * cc) = vr[i]; }
}
__device__ __forceinline__ void swa_wave_lds(const bf16_t* __restrict__ Qrow0, int qpitch, const LAS unsigned char* lds, int qb, int kt_base, float sink2,
                                             bf16_t* __restrict__ Orow0, int opitch, int lane, LAS bf16_t* stg) {
    const int r = lane & 31, h = lane >> 5;
    const int pr = (r & ~12) | ((r & 8) >> 1) | ((r & 4) << 1);
    bf16x8 qf[4];
#pragma unroll
    for (int s = 0; s < 4; ++s) qf[s] = *(const bf16x8*)(Qrow0 + (size_t)r * qpitch + 16 * s + 8 * h);
    f32x16 o0, o1;
#pragma unroll
    for (int i = 0; i < 16; ++i) { o0[i] = 0.f; o1[i] = 0.f; }
    float m = -1e30f, l = 0.f;
    const int q = 32 * qb + r, kt_begin = qb - 4 > 0 ? qb - 4 : 0;
    for (int kt = kt_begin; kt <= qb; ++kt) {
        const int rel = kt - kt_base;
        const LAS unsigned char* kp = lds + (32 * rel + pr) * AKP + 16 * h;
        const LAS unsigned char* vp = lds + SWA_KB + r * SWA_VP + (32 * rel + 8 * h) * 2;
        f32x16 p;
#pragma unroll
        for (int i = 0; i < 16; ++i) p[i] = 0.f;
#pragma unroll
        for (int s = 0; s < 4; ++s) p = MFMA32(*(const LAS bf16x8*)(kp + 32 * s), qf[s], p);
        if (kt == qb || kt == qb - 4) {
            const int k0 = 32 * kt + 8 * h;
#pragma unroll
            for (int i = 0; i < 16; ++i) { const int kv = k0 + 16 * (i >> 3) + (i & 7); const bool ok = (kv <= q) && (kv > q - 128); if (!ok) p[i] = -INFINITY; }
        }
        float rm = MX3(p[0], p[1], p[2]);
#pragma unroll
        for (int i = 3; i < 15; i += 2) rm = MX3(rm, p[i], p[i + 1]);
        rm = xh_max(fmaxf(rm, p[15]));
        if (__any(rm > m + 6.f)) {
            const float mn = fmaxf(m, rm), f = ex2(m - mn); m = mn; l *= f;
#pragma unroll
            for (int i = 0; i < 16; ++i) { const float fi = __shfl(f, crow(i, h)); o0[i] *= fi; o1[i] *= fi; }
        }
        float e[16];
#pragma unroll
        for (int i = 0; i < 16; ++i) { e[i] = ex2(p[i] - m); l += e[i]; }
        const bf16x8 pa0 = pack8(e), pa1 = pack8(e + 8);
        o0 = MFMA32(pa0, *(const LAS bf16x8*)(vp), o0); o1 = MFMA32(pa0, *(const LAS bf16x8*)(vp + 32 * SWA_VP), o1);
        o0 = MFMA32(pa1, *(const LAS bf16x8*)(vp + 32), o0); o1 = MFMA32(pa1, *(const LAS bf16x8*)(vp + 32 * SWA_VP + 32), o1);
    }
    l = xh_sum(l);
    l += ex2(sink2 - m);
    const float inv = 1.f / l;
    LAS bf16_t* sp = stg + (4 * h) * 64 + r;
#pragma unroll
    for (int i = 0; i < 16; ++i) { const float fi = __shfl(inv, crow(i, h)); const int ro = ((i & 3) + 8 * (i >> 2)) * 64;
        sp[ro] = f2bf(o0[i] * fi); sp[ro + 32] = f2bf(o1[i] * fi); }
    o_flush(stg, Orow0, opitch, lane);
}
#define SB_STEP(KT_, V00_, V01_, V10_, V11_) do { \
        const bool diag = ((KT_) == qb); const int k0 = 32 * (KT_) + 8 * h; float sfx[16]; \
        _Pragma("unroll") for (int i = 0; i < 16; ++i) { const float z = p[i]; float L = -(fmaxf(z, 0.f) + lg2(1.f + ex2(-fabsf(z)))); \
            if (diag) { const int kv = k0 + 16 * (i >> 3) + (i & 7); if (!(kv < q)) L = 0.f; } sfx[i] = L; } \
        _Pragma("unroll") for (int g = 0; g < 2; ++g) _Pragma("unroll") for (int j = 6; j >= 0; --j) sfx[8 * g + j] += sfx[8 * g + j + 1]; \
        const float T0 = sfx[0], T1 = sfx[8]; const float TP0 = xh_other(T0, h), TP1 = xh_other(T1, h); \
        const float off1 = (h ? 0.f : TP1) + carry, off0 = T1 + TP1 + (h ? 0.f : TP0) + carry; float e[16]; \
        _Pragma("unroll") for (int i = 0; i < 16; ++i) { float a = ex2(p[i] + sfx[i] + (i < 8 ? off0 : off1)); \
            if (diag) { const int kv = k0 + 16 * (i >> 3) + (i & 7); if (!(kv < q)) a = 0.f; } e[i] = a; } \
        carry += (T0 + T1) + (TP0 + TP1); \
        const bf16x8 pa0 = pack8(e), pa1 = pack8(e + 8); \
        o0 = MFMA32(pa0, (V00_), o0); o1 = MFMA32(pa0, (V01_), o1); o0 = MFMA32(pa1, (V10_), o0); o1 = MFMA32(pa1, (V11_), o1); } while (0)
__device__ __forceinline__ void sb_wave_lds(const bf16_t* __restrict__ Qrow0, int qpitch, const LAS unsigned char* lds, const bf16_t* __restrict__ Kb, int kpitch,
                                            const bf16_t* __restrict__ VT, int qb, int kt_base, bf16_t* __restrict__ Orow0, int opitch, int lane, LAS bf16_t* stg) {
    const int r = lane & 31, h = lane >> 5;
    const int pr = (r & ~12) | ((r & 8) >> 1) | ((r & 4) << 1);
    bf16x8 qf[4];
#pragma unroll
    for (int s = 0; s < 4; ++s) qf[s] = *(const bf16x8*)(Qrow0 + (size_t)r * qpitch + 16 * s + 8 * h);
    f32x16 o0, o1;
#pragma unroll
    for (int i = 0; i < 16; ++i) { o0[i] = 0.f; o1[i] = 0.f; }
    float carry = 0.f;
    const int q = 32 * qb + r;
    const int kt_lo = kt_base > 0 ? kt_base : 0;
    bool done = false;
    int kt = qb;
    for (; kt >= kt_lo; --kt) {
        const int rel = kt - kt_base;
        const LAS unsigned char* kp = lds + (32 * rel + pr) * AKP + 16 * h;
        const LAS unsigned char* vp = lds + SB_KB + r * SB_VP + (32 * rel + 8 * h) * 2;
        f32x16 p;
#pragma unroll
        for (int i = 0; i < 16; ++i) p[i] = 0.f;
#pragma unroll
        for (int s = 0; s < 4; ++s) p = MFMA32(*(const LAS bf16x8*)(kp + 32 * s), qf[s], p);
        SB_STEP(kt, *(const LAS bf16x8*)(vp), *(const LAS bf16x8*)(vp + 32 * SB_VP), *(const LAS bf16x8*)(vp + 32), *(const LAS bf16x8*)(vp + 32 * SB_VP + 32));
        if (__all(carry < -150.f)) { done = true; break; }
    }
    if (!done && kt >= 0) {
        const bf16_t* kp = Kb + (size_t)(32 * kt + pr) * kpitch + 8 * h;
        const bf16_t* vp = VT + (size_t)r * SEQ + 32 * kt + 8 * h;
        for (; kt >= 0; --kt) {
            bf16x8 kf[4];
#pragma unroll
            for (int s = 0; s < 4; ++s) kf[s] = *(const bf16x8*)(kp + 16 * s);
            const bf16x8 v00 = *(const bf16x8*)(vp), v01 = *(const bf16x8*)(vp + 32 * SEQ), v10 = *(const bf16x8*)(vp + 16), v11 = *(const bf16x8*)(vp + 32 * SEQ + 16);
            f32x16 p;
#pragma unroll
            for (int i = 0; i < 16; ++i) p[i] = 0.f;
#pragma unroll
            for (int s = 0; s < 4; ++s) p = MFMA32(kf[s], qf[s], p);
            SB_STEP(kt, v00, v01, v10, v11);
            if (__all(carry < -150.f)) break;
            kp -= (size_t)32 * kpitch; vp -= 32;
        }
    }
    LAS bf16_t* sp = stg + (4 * h) * 64 + r;
#pragma unroll
    for (int i = 0; i < 16; ++i) { const int ro = ((i & 3) + 8 * (i >> 2)) * 64; sp[ro] = f2bf(o0[i]); sp[ro + 32] = f2bf(o1[i]); }
    o_flush(stg, Orow0, opitch, lane);
}
#undef SB_STEP

#define XB_TMO      128
#define XB_XCNT(j)  (256  + 64 * (j))
#define XB_XSUB(j)  (1280 + 64 * (j))
#define XB_XGEN(j)  (2304 + 64 * (j))
#define XB_TOP      3328
#define XB_TOPGEN   3392
#define XCD_BAR_WORDS 3456
#define XB_SPIN_CAP (1u << 18)

__device__ __forceinline__ unsigned xb_ld(unsigned* p)              { return __hip_atomic_load(p, __ATOMIC_RELAXED, __HIP_MEMORY_SCOPE_AGENT); }
__device__ __forceinline__ unsigned xb_add(unsigned* p, unsigned v) { return __hip_atomic_fetch_add(p, v, __ATOMIC_RELAXED, __HIP_MEMORY_SCOPE_AGENT); }
__device__ __forceinline__ unsigned xb_xcc_id() { return (unsigned)__builtin_amdgcn_s_getreg((3 << 11) | 20) & 0xFu; }
#define XB_SPIN(cond, bar) do { unsigned _sp = 0; while (cond) { __builtin_amdgcn_s_sleep(1); \
    if ((++_sp & 255u) == 0u) { if (xb_ld(&(bar)[XB_TMO])) break; if (_sp > XB_SPIN_CAP) { atomicAdd(&(bar)[XB_TMO], 1u); break; } } } } while (0)

struct XcdBarrier {
    unsigned* bar; unsigned x;
    volatile LAS unsigned* st;
};

__device__ __forceinline__ XcdBarrier xcd_barrier_post(unsigned* bar, volatile LAS unsigned* st) {
    XcdBarrier b; b.bar = bar; b.x = xb_xcc_id(); b.st = st;
    if (threadIdx.x == 0) (void)xb_add(&bar[XB_XCNT(b.x)], 1u);
    return b;
}
__device__ __forceinline__ void xcd_barrier_complete(unsigned* bar, unsigned x, unsigned& nloc, unsigned& nx) {
    const unsigned G = gridDim.x * gridDim.y * gridDim.z;
    unsigned sum, cnt, mine, sp = 0u;
    for (;;) {
        sum = 0u; cnt = 0u; mine = 0u;
#pragma unroll
        for (unsigned j = 0; j < 16; ++j) { const unsigned c = xb_ld(&bar[XB_XCNT(j)]); sum += c; cnt += (c > 0u) ? 1u : 0u; mine = (j == x) ? c : mine; }
        if (sum == G) break;
        __builtin_amdgcn_s_sleep(1);
        if ((++sp & 255u) == 0u) { if (xb_ld(&bar[XB_TMO])) break; if (sp > XB_SPIN_CAP) { atomicAdd(&bar[XB_TMO], 1u); break; } }
    }
    nloc = mine > 0u ? mine : 1u; nx = cnt > 0u ? cnt : 1u;
}

__device__ __forceinline__ void xcd_barrier(const XcdBarrier& b) {
    asm volatile("s_waitcnt vmcnt(0)" ::: "memory");
    __syncthreads();
    if (threadIdx.x == 0) {
        unsigned* bar = b.bar;
        __builtin_amdgcn_s_waitcnt(0);
        unsigned nloc = b.st[0], nx = b.st[1];
        if (nloc == 0u) { xcd_barrier_complete(bar, b.x, nloc, nx); b.st[0] = nloc; b.st[1] = nx; }
        const unsigned old = xb_add(&bar[XB_XSUB(b.x)], 1u);
        const unsigned gen = old / nloc;
        if (old + 1u == (gen + 1u) * nloc) {
            __builtin_amdgcn_fence(__ATOMIC_RELEASE, "agent");
            asm volatile("s_waitcnt vmcnt(0)" ::: "memory");
            const unsigned og = xb_add(&bar[XB_TOP], 1u);
            const unsigned tg = og / nx;
            if (og + 1u == (tg + 1u) * nx) xb_add(&bar[XB_TOPGEN], 1u);
            else XB_SPIN(xb_ld(&bar[XB_TOPGEN]) == tg, bar);
            __builtin_amdgcn_fence(__ATOMIC_ACQUIRE, "agent");
            xb_add(&bar[XB_XGEN(b.x)], 1u);
            asm volatile("s_waitcnt vmcnt(0)" ::: "memory");
        } else {
            XB_SPIN(xb_ld(&bar[XB_XGEN(b.x)]) == gen, bar);
            __builtin_amdgcn_fence(__ATOMIC_ACQUIRE, "agent");
            asm volatile("s_waitcnt vmcnt(0)" ::: "memory");
        }
    }
    __syncthreads();
}

__global__ void __launch_bounds__(NTHREADS, 2) fwd(Params P) {
    extern __shared__ __attribute__((aligned(16))) unsigned char lds_raw[];
    LAS unsigned char* lds = (LAS unsigned char*)lds_raw;
    constexpr int G = 256, NGW = G * NWAVES, gthreads = G * NTHREADS;
    const int bx = blockIdx.x;
#if MK_COOP
    cooperative_groups::grid_group grid = cooperative_groups::this_grid();
    volatile LAS unsigned* MISC = (volatile LAS unsigned*)(lds + MISC_OFF);
    if (threadIdx.x < 64) MISC[threadIdx.x] = 0u;
    __syncthreads();
    XcdBarrier bar = xcd_barrier_post((unsigned*)(P.ws + WS_CTL) + CW_BAR, MISC + 8);
#endif
    for (int ph = P.ph_lo; ph < P.ph_hi; ++ph) {
        const int nrep = ((ph >= 1 && ph <= 6 && ((ph - 1) == MK_REP_K || (MK_REP_K == 6 && ph == 3))) || (ph == 0 && MK_REP_K == 7)) ? MK_REP_N : 1;
        for (int rep = 0; rep < nrep; ++rep) {
        int tid_o = threadIdx.x; asm volatile("" : "+v"(tid_o));
        const int tid = tid_o, lane = tid & 63, wave = __builtin_amdgcn_readfirstlane(tid >> 6);
        const int gw = bx * NWAVES + wave, gtid = bx * NTHREADS + tid;
        LAS bf16_t* stg = (LAS bf16_t*)(lds + 122880 + wave * 4096);
        unsigned char* ws = P.ws; asm volatile("" : "+s"(ws));
        unsigned* ctl = (unsigned*)(ws + WS_CTL);
        bf16_t* XN = (bf16_t*)(ws + WS_XN); bf16_t* H = (bf16_t*)(ws + WS_H);
        bf16_t* QC = (bf16_t*)(ws + WS_QC); bf16_t* KC = (bf16_t*)(ws + WS_KC);
        bf16_t* VTC = (bf16_t*)(ws + WS_VTC); bf16_t* VTA = (bf16_t*)(ws + WS_VTA); bf16_t* VTD = (bf16_t*)(ws + WS_VTD);
        bf16_t* Y = (bf16_t*)(ws + WS_Y);
        if (ph == 0) {
            {
                LAS float* scr = (LAS float*)(lds + wave * 16384);
                constexpr int I_IN = (DM / 64) * (DIN / 32), I_OUT = (DM / 64) * (DM / 32), I_UQ = (256 / 64) * (384 / 32), I_UKV = (128 / 64) * (512 / 32), I_L = I_IN + I_OUT + I_UQ + I_UKV;
                for (int it = gw; it < NLAYER * I_L; it += NGW) {
                    const int l = it / I_L; int v = it - l * I_L;
                    if (v < I_IN) { wT_item(P.w_in + (size_t)l * DM * DIN, DM, DIN, P.norm_pre + l * DM, (bf16_t*)(ws + WS_WIN) + (size_t)l * DINP * DM, C_AQ, C_AQ + 256, C_DQ, C_DQ + 256, SC64, scr, v, lane); continue; } v -= I_IN;
                    if (v < I_OUT) { wT_item(P.w_out + (size_t)l * DM * DM, DM, DM, P.g_grp + l * DM, (bf16_t*)(ws + WS_WOUT) + (size_t)l * DM * DM, 0, 0, 0, 0, 1.f, scr, v, lane); continue; } v -= I_OUT;
                    if (v < I_UQ) { wT_item(P.w_uq + (size_t)l * 256 * 384, 256, 384, P.g_cq + l * 256, (bf16_t*)(ws + WS_WUQ + (size_t)l * 262144), 0, 0, 0, 0, 1.f, scr, v, lane); continue; } v -= I_UQ;
                    wT_item(P.w_ukv + (size_t)l * 128 * 512, 128, 512, P.g_ckv + l * 128, (bf16_t*)(ws + WS_WUKV + (size_t)l * 131072), 0, 0, 0, 0, 1.f, scr, v, lane);
                }
                for (int it = gtid; it < NLAYER * (DINP - DIN) * (DM / 8); it += gthreads) { const int l = it / ((DINP - DIN) * (DM / 8)), v = it - l * ((DINP - DIN) * (DM / 8));
                    *(u32x4*)((bf16_t*)(ws + WS_WIN) + (size_t)l * DINP * DM + (size_t)DIN * DM + (size_t)v * 8) = (u32x4){0u, 0u, 0u, 0u}; }
            }
            { const float* __restrict__ xr = P.x; bf16_t* __restrict__ xo = XN;
#pragma unroll 2
              for (int mrow = gw; mrow < M_TOK; mrow += NGW) rms_row_to_bf16(xr + (size_t)mrow * DM, xo + (size_t)mrow * DM, lane); }
        } else {
            const int l = (ph - 1) / 6, k = (ph - 1) % 6;
            if (k == 0 || k == 4) {
                if (k == 0) {
                    pg8::Gemm g{XN, (const bf16_t*)(ws + WS_WIN) + (size_t)l * DINP * DM, M_TOK, DINP, DM}; pg8::StaticOrder S; S.init(M_TOK, DINP, G, bx);
                    pg8::EpiBf16<0> E{H, DINP, nullptr, 0, 0, 1.f};
                    pg8::gemm_phase<pg8::EpiBf16<0>, pg8::StaticOrder, true, true>(lds, g, S, E);
                } else {
                    pg8::Gemm g{XN, (const bf16_t*)(ws + WS_WOUT) + (size_t)l * DM * DM, M_TOK, DM, DM}; pg8::StaticOrder S; S.init(M_TOK, DM, G, bx);
                    pg8::EpiBf16<0> E{Y, DM, nullptr, 0, 0, 1.f};
                    pg8::gemm_phase<pg8::EpiBf16<0>, pg8::StaticOrder, true, true>(lds, g, S, E);
                }
            } else if (k == 1) {
                const bf16_t* WUQ = (const bf16_t*)(ws + WS_WUQ + (size_t)l * 262144);
                const bf16_t* WUKV = (const bf16_t*)(ws + WS_WUKV + (size_t)l * 131072);
                {
                    const int hh = bx & 3, tg = bx >> 2;
                    u32x4 wq[6], wk[4];
#pragma unroll
                    for (int i = 0; i < 6; ++i) { const int c = tid + 512 * i, row = c >> 5, cc = c & 31; wq[i] = *(const u32x4*)(WUQ + (size_t)(hh * 96 + row) * 256 + 8 * cc); }
#pragma unroll
                    for (int i = 0; i < 4; ++i) { const int c = tid + 512 * i, row = c >> 4, cc = c & 15; wk[i] = *(const u32x4*)(WUKV + (size_t)(hh * 128 + row) * 128 + 8 * cc); }
#pragma unroll
                    for (int i = 0; i < 6; ++i) { const int c = tid + 512 * i, row = c >> 5, cc = c & 31; *(LAS u32x4*)(lds + row * WQP + 16 * cc) = wq[i]; }
#pragma unroll
                    for (int i = 0; i < 4; ++i) { const int c = tid + 512 * i, row = c >> 4, cc = c & 15; *(LAS u32x4*)(lds + WQ_BYTES + row * WKP + 16 * cc) = wk[i]; }
                    __syncthreads();
                    const int tb = 8 * tg + wave;
                    mq_unit(H, lds, P.pos, QC, tb, hh, lane);
                    mkv_unit(H, lds + WQ_BYTES, P.pos, KC, VTC, tb, hh, lane, stg);
                }
                constexpr int NTB = M_TOK / 32;
                constexpr int U_VTA = NTB * 2, U_VTD = NTB * 4, U_CONV = M_TOK / 8;
                constexpr int U_ALL = U_VTA + U_VTD + U_CONV;
                for (int u = gw; u < U_ALL; u += NGW) {
                    int v = u;
                    if (v < U_VTA) { vt_unit(H, C_AV, 2, VTA, v >> 1, v & 1, lane, stg); continue; } v -= U_VTA;
                    if (v < U_VTD) { vt_unit(H, C_DV, 4, VTD, v >> 2, v & 3, lane, stg); continue; } v -= U_VTD;
                    conv_unit(H, P.conv_w + l * 768, P.conv_b + l * 256, Y, v, lane);
                }
            } else if (k == 2) {
                if (rep == 0 || MK_REP_K == 2)
                for (int pu = bx; pu < 256; pu += G) {
                    const int bh = pu & 7, Gq = pu >> 3;
                    mla_unit_blk(QC, KC, VTC, Y, bh, 63 - Gq, lds, tid);
                    mla_unit_blk(QC, KC, VTC, Y, bh, Gq, lds, tid);
                }
                if (rep == 0 || MK_REP_K == 6) {
                    const int bh = bx & 7, G8 = bx >> 3, b = bh >> 2, hh = bh & 3, qb = 8 * G8 + wave;
                    const size_t row0 = (size_t)b * SEQ + 32 * qb;
                    LAS bf16_t* ostg = (LAS bf16_t*)(lds + STG_OFF + wave * 4096);
                    {
                        const int kvh = hh >> 1;
                        const bf16_t* Kb = H + (size_t)b * SEQ * DINP + C_AK + kvh * 64;
                        const bf16_t* VT = VTA + (size_t)(b * 2 + kvh) * 64 * SEQ;
                        stage_kv64<SWA_NK, SWA_VP>(Kb, DINP, VT, 256 * G8 - 128, lds, tid);
                        __syncthreads();
                        swa_wave_lds(H + row0 * DINP + C_AQ + hh * 64, DINP, lds, qb, 8 * G8 - 4, P.sinks[l * 4 + hh] * LOG2E, Y + row0 * DM + hh * 64, DM, lane, ostg);
                        __syncthreads();
                    }
                    {
                        const bf16_t* Kb = H + (size_t)b * SEQ * DINP + C_DK + hh * 64;
                        const bf16_t* VT = VTD + (size_t)(b * 4 + hh) * 64 * SEQ;
                        stage_kv64<SB_NK, SB_VP>(Kb, DINP, VT, 256 * G8 - 192, lds, tid);
                        __syncthreads();
                        sb_wave_lds(H + row0 * DINP + C_DQ + hh * 64, DINP, lds, Kb, DINP, VT, qb, 8 * G8 - 6, Y + row0 * DM + 768 + hh * 64, DM, lane, ostg);
                        __syncthreads();
                    }
                }
            } else if (k == 3) {
                const bf16_t* __restrict__ Yr = Y; const bf16_t* __restrict__ Hr = H; bf16_t* __restrict__ XNw = XN;
#pragma unroll 2
                for (int mrow = gw; mrow < M_TOK; mrow += NGW) {
                    const u32x4* yp = (const u32x4*)(Yr + (size_t)mrow * DM) + 2 * lane;
                    const u32x4* gp = (const u32x4*)(Hr + (size_t)mrow * DINP + C_GATE) + 2 * lane;
                    const u32x4 y0 = yp[0], y1 = yp[1], g0 = gp[0], g1 = gp[1];
                    float yv[16], gv[16];
#pragma unroll
                    for (int j = 0; j < 4; ++j) { yv[2 * j] = bflo(y0[j]); yv[2 * j + 1] = bfhi(y0[j]); yv[8 + 2 * j] = bflo(y1[j]); yv[8 + 2 * j + 1] = bfhi(y1[j]);
                                                  gv[2 * j] = bflo(g0[j]); gv[2 * j + 1] = bfhi(g0[j]); gv[8 + 2 * j] = bflo(g1[j]); gv[8 + 2 * j + 1] = bfhi(g1[j]); }
                    float ss = 0.f;
#pragma unroll
                    for (int j = 0; j < 16; ++j) ss += yv[j] * yv[j];
                    ss += __shfl_xor(ss, 1); ss += __shfl_xor(ss, 2); ss += __shfl_xor(ss, 4); ss += __shfl_xor(ss, 8);
                    const float rs = rsqrtf(ss * (1.f / 256.f) + EPS);
                    float o[16];
#pragma unroll
                    for (int j = 0; j < 16; ++j) { const float gg = gv[j]; o[j] = yv[j] * rs * gg * __builtin_amdgcn_rcpf(1.f + ex2(-gg * LOG2E)); }
                    u32x4 w0, w1;
#pragma unroll
                    for (int j = 0; j < 4; ++j) { w0[j] = pk2(o[2 * j], o[2 * j + 1]); w1[j] = pk2(o[8 + 2 * j], o[8 + 2 * j + 1]); }
                    u32x4* op = (u32x4*)(XNw + (size_t)mrow * DM) + 2 * lane;
                    op[0] = w0; op[1] = w1;
                }
            } else {
                const float* base = P.x;
                const float* gpost = P.g_post + l * DM;
                for (int mrow0 = gw; mrow0 < M_TOK; mrow0 += 2 * NGW) {
                    f32x4 zz[2][4], xv[2][4]; float s1[2] = {0.f, 0.f}, s2[2] = {0.f, 0.f};
                    const bool two = (mrow0 + NGW < M_TOK);
#pragma unroll
                    for (int rr = 0; rr < 2; ++rr) { const int mrow = (rr == 0 || two) ? mrow0 + rr * NGW : mrow0;
#pragma unroll
                        for (int j = 0; j < 4; ++j) { const u32x2 w = ((const u32x2*)(Y + (size_t)mrow * DM))[lane + 64 * j]; zz[rr][j] = (f32x4){bflo(w.x), bfhi(w.x), bflo(w.y), bfhi(w.y)};
                            if (l == 0) xv[rr][j] = ((const f32x4*)(base + (size_t)mrow * DM))[lane + 64 * j];
                            else { const u32x2 xb = ((const u32x2*)(P.out + (size_t)mrow * DM))[lane + 64 * j]; xv[rr][j] = (f32x4){bflo(xb.x), bfhi(xb.x), bflo(xb.y), bfhi(xb.y)}; } } }
                    f32x4 gpv[4];
#pragma unroll
                    for (int j = 0; j < 4; ++j) gpv[j] = ((const f32x4*)gpost)[lane + 64 * j];
#pragma unroll
                    for (int rr = 0; rr < 2; ++rr)
#pragma unroll
                        for (int j = 0; j < 4; ++j) s1[rr] += (zz[rr][j].x * zz[rr][j].x + zz[rr][j].y * zz[rr][j].y) + (zz[rr][j].z * zz[rr][j].z + zz[rr][j].w * zz[rr][j].w);
                    const float rz0 = rsqrtf(wave_sum(s1[0]) * (1.f / DM) + EPS), rz1 = rsqrtf(wave_sum(s1[1]) * (1.f / DM) + EPS);
#pragma unroll
                    for (int rr = 0; rr < 2; ++rr) { const float rz = rr ? rz1 : rz0;
#pragma unroll
                        for (int j = 0; j < 4; ++j) { xv[rr][j] = xv[rr][j] + zz[rr][j] * rz * gpv[j];
                            s2[rr] += (xv[rr][j].x * xv[rr][j].x + xv[rr][j].y * xv[rr][j].y) + (xv[rr][j].z * xv[rr][j].z + xv[rr][j].w * xv[rr][j].w); } }
#pragma unroll
                    for (int rr = 0; rr < 2; ++rr) { if (rr == 1 && !two) break; const int mrow = mrow0 + rr * NGW;
#pragma unroll
                        for (int j = 0; j < 4; ++j) {
                            if (l + 1 < NLAYER) { u32x2 o; o.x = pk2(xv[rr][j].x, xv[rr][j].y); o.y = pk2(xv[rr][j].z, xv[rr][j].w); ((u32x2*)(P.out + (size_t)mrow * DM))[lane + 64 * j] = o; }
                            else ((f32x4*)(P.out + (size_t)mrow * DM))[lane + 64 * j] = xv[rr][j]; } }
                    if (l + 1 < NLAYER) {
                        const float r0 = rsqrtf(wave_sum(s2[0]) * (1.f / DM) + EPS), r1 = rsqrtf(wave_sum(s2[1]) * (1.f / DM) + EPS);
#pragma unroll
                        for (int rr = 0; rr < 2; ++rr) { if (rr == 1 && !two) break; const int mrow = mrow0 + rr * NGW; const float rs = rr ? r1 : r0;
#pragma unroll
                            for (int j = 0; j < 4; ++j) { u32x2 o; o.x = pk2(xv[rr][j].x * rs, xv[rr][j].y * rs); o.y = pk2(xv[rr][j].z * rs, xv[rr][j].w * rs); ((u32x2*)(XN + (size_t)mrow * DM))[lane + 64 * j] = o; } }
                    }
                }
            }
            }
        }
        if (ph + 1 < P.ph_hi) {
#if MK_COOP
            if (P.ph_hi < 0) grid.sync();
            xcd_barrier(bar);
#endif
        }
    }
}
}

extern "C" void kernel_launch(void* const* d_in, const int* in_sizes, int n_in, void* d_out, int out_size, void* d_ws, size_t ws_size, hipStream_t stream) {
    using namespace mk;
    static int grid = 0;
    if (grid == 0) {
        if (n_in != 14 || out_size != M_TOK * DM || ws_size < WS_END) { fprintf(stderr, "kernel_launch: unexpected shapes (n_in %d out %d ws %zu)\n", n_in, out_size, ws_size); grid = -1; return; }
        int dev = 0, cus = 0, per_cu = 0;
        (void)hipGetDevice(&dev); (void)hipDeviceGetAttribute(&cus, hipDeviceAttributeMultiprocessorCount, dev);
        if (hipFuncSetAttribute((const void*)fwd, hipFuncAttributeMaxDynamicSharedMemorySize, LDS_BYTES) != hipSuccess) { fprintf(stderr, "kernel_launch: hipFuncSetAttribute failed\n"); grid = -1; return; }
        if (hipOccupancyMaxActiveBlocksPerMultiprocessor(&per_cu, (const void*)fwd, NTHREADS, LDS_BYTES) != hipSuccess || per_cu < 1) { fprintf(stderr, "kernel_launch: occupancy query says %d\n", per_cu); per_cu = 1; }
        (void)hipGetLastError();
        if (cus < 256) { fprintf(stderr, "kernel_launch: built for a 256-CU device (one workgroup per CU), found %d CUs\n", cus); grid = -1; return; }
        grid = 256;
    }
    if (grid < 0) return;
    (void)hipMemsetAsync((char*)d_ws + WS_CTL, 0, CTL_BYTES, stream);
    Params p{};
    p.x = (const float*)d_in[0]; p.pos = (const int*)d_in[1]; p.norm_pre = (const float*)d_in[2]; p.w_in = (const float*)d_in[3]; p.sinks = (const float*)d_in[4];
    p.conv_w = (const float*)d_in[5]; p.conv_b = (const float*)d_in[6]; p.g_cq = (const float*)d_in[7]; p.w_uq = (const float*)d_in[8]; p.g_ckv = (const float*)d_in[9];
    p.w_ukv = (const float*)d_in[10]; p.g_grp = (const float*)d_in[11]; p.w_out = (const float*)d_in[12]; p.g_post = (const float*)d_in[13];
    p.out = (float*)d_out; p.ws = (unsigned char*)d_ws;
    constexpr int NPH = 1 + 6 * NLAYER;
#if MK_COOP
    p.ph_lo = 0; p.ph_hi = NPH;
    void* args[] = {&p};
    hipError_t e = hipLaunchCooperativeKernel((const void*)fwd, dim3(grid), dim3(NTHREADS), args, LDS_BYTES, stream);
    if (e != hipSuccess) fprintf(stderr, "kernel_launch: cooperative launch failed: %s (grid %d)\n", hipGetErrorString(e), grid);
#else
    for (int ph = 0; ph < NPH; ++ph) { p.ph_lo = ph; p.ph_hi = ph + 1; hipLaunchKernelGGL(fwd, dim3(grid), dim3(NTHREADS), LDS_BYTES, stream, p); }
#endif
}
```

```cpp
#include <hip/hip_runtime.h>
#include <hip/hip_cooperative_groups.h>
#include <cstdio>
#include <cstdint>
#include <cmath>
namespace pg8 {
#define PG8_LAS __attribute__((address_space(3)))
typedef unsigned short bf16_t;
typedef short bf16x8 __attribute__((ext_vector_type(8)));
typedef float f32x4 __attribute__((ext_vector_type(4)));
typedef unsigned u32x4 __attribute__((ext_vector_type(4)));
constexpr int BM = 256, BK = 64, HALF = 128, HTB = HALF * BK * 2  , STAGE_BYTES = 8 * HTB, NXCD = 8, WGM = 8;

__host__ __device__ __forceinline__ int lds_byte(int r, int c) { const int st = (r >> 4) * 2 + (c >> 5), rr = r & 15, cc = c & 31, ob = rr * 64 + cc * 2; return st * 1024 + (ob ^ (((ob >> 9) & 1) << 5)); }
__host__ __device__ __forceinline__ void stage_rc(int b, int& R, int& C) { const int st = b / 1024, sb = b % 1024, swz = sb ^ (((sb >> 9) & 1) << 5); R = (st >> 1) * 16 + swz / 64; C = (st & 1) * 32 + (swz % 64) / 2; }
__host__ __device__ __forceinline__ int perm32(int rho) { const int n = rho >> 4, i = rho & 15; return 8 * (i >> 2) + 4 * n + (i & 3); }

struct Unit { int pm, pn; };
struct Gemm { const bf16_t* A; const bf16_t* Bt; int M, N, K; };

struct StaticOrder {
    int nM, nN, nwg, G, c;
    __host__ __device__ void init(int M, int N, int G_, int c_) { nM = M / BM; nN = N / BM; nwg = nM * nN; G = G_; c = c_; }
    __host__ __device__ bool next(int i, Unit& u) const {
        const long L = (long)i * G + c; if (L >= nwg) return false;
        int wgid = (int)L; { const int q = nwg / NXCD, r = nwg % NXCD, xcd = wgid % NXCD, off = wgid / NXCD; wgid = (xcd < r ? xcd * (q + 1) : r * (q + 1) + (xcd - r) * q) + off; }
        const int nig = WGM * nN, gid = wgid / nig, fm = gid * WGM, gsz = (nM - fm) < WGM ? (nM - fm) : WGM;
        u.pm = fm + ((wgid % nig) % gsz); u.pn = (wgid % nig) / gsz; return true;
    }
    __device__ __forceinline__ void a_ready(const Unit&) const {}
    __device__ __forceinline__ void done(const Unit&) const {}
};

__device__ __forceinline__ unsigned cvt_pk_bf16(float lo, float hi) { unsigned r; asm volatile("v_cvt_pk_bf16_f32 %0, %1, %2" : "=v"(r) : "v"(lo), "v"(hi)); return r; }
typedef float f32x2 __attribute__((ext_vector_type(2)));
__device__ __forceinline__ f32x2 gelu_pk(f32x2 v) {
    const f32x2 av = __builtin_elementwise_abs(v), d = av * 0.2316418882f + 1.0f;
    f32x2 t; t.x = __builtin_amdgcn_rcpf(d.x); t.y = __builtin_amdgcn_rcpf(d.y);
    f32x2 q = t * 0.5307027145f + (-0.7265760135f); q = q * t + 0.7107068705f; q = q * t + (-0.142248368f); q = q * t + 0.127414796f; q = q * t;
    const f32x2 s = (v * v) * (-0.72134752044f);
    f32x2 e; e.x = __builtin_amdgcn_exp2f(s.x); e.y = __builtin_amdgcn_exp2f(s.y);
    const f32x2 m = v * (q * e), r = v - m;
    f32x2 o; o.x = v.x < 0.f ? m.x : r.x; o.y = v.y < 0.f ? m.y : r.y; return o;
}

template <int ACT  > struct EpiBf16 {
    static constexpr bool PERM = true, AFTER_DRAIN = false; static_assert(ACT == 0 || ACT == 1, "EpiBf16: ACT is 0 (none) or 1 (gelu_pk)");
    bf16_t* O; int ldc; const float* bias; int split_cols; size_t split_stride; float scale0;
    __device__ __forceinline__ void operator()(const f32x4 (&acc)[2][2][4][2], const Unit& u, int wr, int wc, int fr, int fq) const {
        const int row0 = u.pm * BM + wr * 64 + fr; int colt = u.pn * BM; bf16_t* base = O;
        float sc = 1.f; if (split_cols) { const int t = colt / split_cols; base += (size_t)t * split_stride; colt -= t * split_cols; if (t == 0) sc = scale0; }
        const int col0 = colt + wc * 32 + 8 * fq, bcol0 = u.pn * BM + wc * 32 + 8 * fq;
        f32x4 bv[2][2];
#pragma unroll
        for (int bj = 0; bj < 2; ++bj)
#pragma unroll
            for (int n = 0; n < 2; ++n) bv[bj][n] = bias ? *(const f32x4*)(bias + bcol0 + bj * HALF + 4 * n) : (f32x4){0.f, 0.f, 0.f, 0.f};
#pragma unroll
        for (int ai = 0; ai < 2; ++ai)
#pragma unroll
            for (int m = 0; m < 4; ++m) { bf16_t* rowp = base + (size_t)(row0 + ai * HALF + m * 16) * ldc + col0;
#pragma unroll
                for (int bj = 0; bj < 2; ++bj) { f32x4 v0 = acc[ai][bj][m][0] + bv[bj][0], v1 = acc[ai][bj][m][1] + bv[bj][1];
                    if (ACT == 1) { f32x2 a = gelu_pk((f32x2){v0[0], v0[1]}), b = gelu_pk((f32x2){v0[2], v0[3]}), c = gelu_pk((f32x2){v1[0], v1[1]}), d = gelu_pk((f32x2){v1[2], v1[3]});
                        v0 = (f32x4){a.x, a.y, b.x, b.y}; v1 = (f32x4){c.x, c.y, d.x, d.y}; }
                    v0 = v0 * sc; v1 = v1 * sc; u32x4 w; w.x = cvt_pk_bf16(v0[0], v0[1]); w.y = cvt_pk_bf16(v0[2], v0[3]); w.z = cvt_pk_bf16(v1[0], v1[1]); w.w = cvt_pk_bf16(v1[2], v1[3]);
                    *(u32x4*)(rowp + bj * HALF) = w; } }
    }
};
template <class Epi, class Sched, bool ALIGN_EPI = false, bool SP2 = false>
__device__ __forceinline__ void gemm_phase(PG8_LAS unsigned char* lds, const Gemm g, const Sched& S, const Epi& E) {
    int tid_o = threadIdx.x; asm volatile("" : "+v"(tid_o));
    const int tid = tid_o, wid = __builtin_amdgcn_readfirstlane(tid >> 6), lane = tid & 63, wr = wid >> 2, wc = wid & 3, fr = lane & 15, fq = lane >> 4;
    const int K = g.K, nt = K / BK;
    unsigned voffA[2], voffB[2];
#pragma unroll
    for (int i = 0; i < 2; ++i) { int R, C; stage_rc(tid * 16 + i * 8192, R, C); const int Rb = Epi::PERM ? ((R & ~31) + perm32(R & 31)) : R;
        voffA[i] = (unsigned)(R * K + C) * 2u; voffB[i] = (unsigned)(Rb * K + C) * 2u; }
    const size_t kstep = (size_t)(BK * 2);
    const size_t hstep = (size_t)HALF * K * 2;
    const size_t tstep = 2 * hstep;
    const unsigned ldsw = (unsigned)wid * 1024u;
    const int aoff = lds_byte(wr * 64 + fr, fq * 8), boff = lds_byte(wc * 32 + fr, fq * 8);
#define PG8_SA(b, h) (((b) * 2 + (h)) * HTB)
#define PG8_SB(b, h) ((4 + (b) * 2 + (h)) * HTB)
#define PG8_STAGE(bufoff, gbase, voff) do { _Pragma("unroll") for (int _i = 0; _i < 2; ++_i) \
        __builtin_amdgcn_global_load_lds((const unsigned*)((const char*)(gbase) + (voff)[_i]), (PG8_LAS unsigned*)(lds + (bufoff) + ldsw + _i * 8192), 16, 0, 0); } while (0)
#define PG8_LDA(dst, b, h) do { _Pragma("unroll") for (int m = 0; m < 4; ++m) _Pragma("unroll") for (int k = 0; k < 2; ++k) dst[m][k] = *(const PG8_LAS bf16x8*)(lds + PG8_SA(b, h) + aoff + m * 2048 + k * 1024); } while (0)
#define PG8_LDB(dst, b, h) do { _Pragma("unroll") for (int n = 0; n < 2; ++n) _Pragma("unroll") for (int k = 0; k < 2; ++k) dst[n][k] = *(const PG8_LAS bf16x8*)(lds + PG8_SB(b, h) + boff + n * 2048 + k * 1024); } while (0)
#define PG8_MMA(ai, bj, At, Bt) do { __builtin_amdgcn_s_setprio(1); _Pragma("unroll") for (int m = 0; m < 4; ++m) _Pragma("unroll") for (int n = 0; n < 2; ++n) _Pragma("unroll") for (int k = 0; k < 2; ++k) \
        acc[ai][bj][m][n] = __builtin_amdgcn_mfma_f32_16x16x32_bf16(Bt[n][k], At[m][k], acc[ai][bj][m][n], 0, 0, 0); __builtin_amdgcn_s_setprio(0); } while (0)
#define PG8_WAIT_V(n) asm volatile("s_waitcnt vmcnt(" #n ")" ::: "memory")
#define PG8_WAIT_L(n) asm volatile("s_waitcnt lgkmcnt(" #n ")" ::: "memory")
#define PG8_BAR __builtin_amdgcn_s_barrier()
#define PG8_SCHED __builtin_amdgcn_sched_barrier(0)
    Unit cur, nxt; int ui = 0;
    if (!S.next(0, cur)) return;
    f32x4 acc[2][2][4][2];
#pragma unroll
    for (int a = 0; a < 2; ++a)
#pragma unroll
        for (int b = 0; b < 2; ++b)
#pragma unroll
            for (int m = 0; m < 4; ++m)
#pragma unroll
                for (int n = 0; n < 2; ++n) acc[a][b][m][n] = (f32x4){0.f, 0.f, 0.f, 0.f};
    bf16x8 At[4][2], B0[2][2], B1[2][2];
    const char* cA = (const char*)g.A + (size_t)cur.pm * tstep; const char* cB = (const char*)g.Bt + (size_t)cur.pn * tstep;
    S.a_ready(cur);
    if constexpr (SP2) {
        PG8_STAGE(PG8_SB(0, 0), cB, voffB); PG8_STAGE(PG8_SB(0, 1), cB + hstep, voffB); PG8_STAGE(PG8_SA(0, 0), cA, voffA); PG8_STAGE(PG8_SA(0, 1), cA + hstep, voffA);
        if (wr == 1) PG8_BAR;
        PG8_WAIT_V(2); PG8_BAR;
        PG8_STAGE(PG8_SB(1, 0), cB + kstep, voffB); PG8_STAGE(PG8_SA(1, 0), cA + kstep, voffA); PG8_STAGE(PG8_SB(1, 1), cB + hstep + kstep, voffB);
        PG8_WAIT_V(6); PG8_BAR;
    } else {
        PG8_STAGE(PG8_SB(0, 0), cB, voffB); PG8_STAGE(PG8_SA(0, 0), cA, voffA); PG8_STAGE(PG8_SB(0, 1), cB + hstep, voffB); PG8_STAGE(PG8_SA(0, 1), cA + hstep, voffA);
        if (wr == 1) PG8_BAR;
        PG8_WAIT_V(4); PG8_BAR;
        PG8_STAGE(PG8_SB(1, 0), cB + kstep, voffB); PG8_STAGE(PG8_SA(1, 0), cA + kstep, voffA); PG8_STAGE(PG8_SB(1, 1), cB + hstep + kstep, voffB);
        PG8_WAIT_V(6); PG8_BAR;
    }
    for (;;) {
        const bool has_next = S.next(ui + 1, nxt);
        const char* nA = has_next ? (const char*)g.A + (size_t)nxt.pm * tstep : cA; const char* nB = has_next ? (const char*)g.Bt + (size_t)nxt.pn * tstep : cB;
        for (int t = 0; t < nt; t += 2) {
            const bool last = (t == nt - 2);
            const char* a1 = cA + (size_t)(t + 1) * kstep;
            const char* a2 = last ? nA : cA + (size_t)(t + 2) * kstep; const char* b2 = last ? nB : cB + (size_t)(t + 2) * kstep;
            const char* a3 = a2 + kstep; const char* b3 = b2 + kstep;
            if (last && has_next) S.a_ready(nxt);
            if constexpr (SP2) {
            PG8_LDB(B0, 0, 0); PG8_LDB(B1, 0, 1); PG8_SCHED; PG8_LDA(At, 0, 0); PG8_STAGE(PG8_SA(1, 1), a1 + hstep, voffA);
            PG8_WAIT_V(8); PG8_WAIT_L(0); PG8_BAR; PG8_MMA(0, 0, At, B0); PG8_MMA(0, 1, At, B1); PG8_BAR; PG8_SCHED;
            PG8_LDA(At, 0, 1); PG8_STAGE(PG8_SB(0, 0), b2, voffB); PG8_STAGE(PG8_SB(0, 1), b2 + hstep, voffB); PG8_STAGE(PG8_SA(0, 0), a2, voffA);
            PG8_WAIT_V(8); PG8_WAIT_L(0); PG8_BAR; PG8_MMA(1, 0, At, B0); PG8_MMA(1, 1, At, B1); PG8_BAR; PG8_SCHED;
            PG8_LDB(B0, 1, 0); PG8_LDB(B1, 1, 1); PG8_SCHED; PG8_LDA(At, 1, 0); PG8_STAGE(PG8_SA(0, 1), a2 + hstep, voffA);
            PG8_WAIT_V(8); PG8_WAIT_L(0); PG8_BAR; PG8_MMA(0, 0, At, B0); PG8_MMA(0, 1, At, B1); PG8_BAR; PG8_SCHED;
            PG8_LDA(At, 1, 1); PG8_STAGE(PG8_SB(1, 0), b3, voffB); PG8_STAGE(PG8_SB(1, 1), b3 + hstep, voffB); PG8_STAGE(PG8_SA(1, 0), a3, voffA);
            PG8_WAIT_V(8); PG8_WAIT_L(0); PG8_BAR; PG8_MMA(1, 0, At, B0); PG8_MMA(1, 1, At, B1); PG8_BAR; PG8_SCHED;
            } else {
            PG8_LDB(B0, 0, 0); PG8_SCHED; PG8_LDA(At, 0, 0); PG8_STAGE(PG8_SA(1, 1), a1 + hstep, voffA);
            PG8_WAIT_L(8); PG8_BAR; PG8_WAIT_L(0); PG8_MMA(0, 0, At, B0); PG8_BAR; PG8_SCHED;
            PG8_LDB(B1, 0, 1); PG8_STAGE(PG8_SB(0, 0), b2, voffB);
            PG8_BAR; PG8_WAIT_L(0); PG8_MMA(0, 1, At, B1); PG8_BAR;
            PG8_LDA(At, 0, 1); PG8_STAGE(PG8_SA(0, 0), a2, voffA);
            PG8_BAR; PG8_WAIT_L(0); PG8_MMA(1, 0, At, B0); PG8_BAR; PG8_SCHED;
            PG8_STAGE(PG8_SB(0, 1), b2 + hstep, voffB);
            PG8_WAIT_V(6); PG8_BAR; PG8_MMA(1, 1, At, B1); PG8_BAR;
            PG8_LDB(B0, 1, 0); PG8_SCHED; PG8_LDA(At, 1, 0); PG8_STAGE(PG8_SA(0, 1), a2 + hstep, voffA);
            PG8_WAIT_L(8); PG8_BAR; PG8_WAIT_L(0); PG8_MMA(0, 0, At, B0); PG8_BAR; PG8_SCHED;
            PG8_LDB(B1, 1, 1); PG8_STAGE(PG8_SB(1, 0), b3, voffB);
            PG8_BAR; PG8_WAIT_L(0); PG8_MMA(0, 1, At, B1); PG8_BAR;
            PG8_LDA(At, 1, 1); PG8_STAGE(PG8_SA(1, 0), a3, voffA);
            PG8_BAR; PG8_WAIT_L(0); PG8_MMA(1, 0, At, B0); PG8_BAR; PG8_SCHED;
            PG8_STAGE(PG8_SB(1, 1), b3 + hstep, voffB);
            PG8_WAIT_V(6); PG8_BAR; PG8_MMA(1, 1, At, B1); PG8_BAR;
            }
        }
        if constexpr (ALIGN_EPI) { if (wr == 0) PG8_BAR; }
        if constexpr (!Epi::AFTER_DRAIN) { E(acc, cur, wr, wc, fr, fq); S.done(cur); }
        if (!has_next) break;
#pragma unroll
        for (int a = 0; a < 2; ++a)
#pragma unroll
            for (int b = 0; b < 2; ++b)
#pragma unroll
                for (int m = 0; m < 4; ++m)
#pragma unroll
                    for (int n = 0; n < 2; ++n) acc[a][b][m][n] = (f32x4){0.f, 0.f, 0.f, 0.f};
        cur = nxt; cA = nA; cB = nB; ++ui;
        if constexpr (ALIGN_EPI) { if (wr == 1) PG8_BAR; }
    }
    PG8_WAIT_V(0);
    if constexpr (!ALIGN_EPI) { if (wr == 0) PG8_BAR; }
    PG8_BAR;
    if constexpr (Epi::AFTER_DRAIN) { E.fused(acc, cur, wr, wc, fr, fq, lds, wid, lane); S.done(cur); }
#undef PG8_SA
#undef PG8_SB
#undef PG8_STAGE
#undef PG8_LDA
#undef PG8_LDB
#undef PG8_MMA
#undef PG8_WAIT_V
#undef PG8_WAIT_L
#undef PG8_BAR
#undef PG8_SCHED
}
}
#ifndef MK_COOP
#define MK_COOP 1
#endif
#ifndef MK_REP_K
#define MK_REP_K -1
#endif
#ifndef MK_REP_N
#define MK_REP_N 1
#endif
namespace mk {
using pg8::bf16_t; using pg8::bf16x8; using pg8::f32x4; using pg8::u32x4;
typedef float f32x16 __attribute__((ext_vector_type(16)));
typedef unsigned u32x2 __attribute__((ext_vector_type(2)));
typedef float f32x2_t __attribute__((ext_vector_type(2)));
typedef __bf16 bf16x2_t __attribute__((ext_vector_type(2)));
#define LAS __attribute__((address_space(3)))
#define MFMA32(a, b, c) __builtin_amdgcn_mfma_f32_32x32x16_bf16((a), (b), (c), 0, 0, 0)

constexpr int M_TOK = 16384, SEQ = 8192, DM = 1024, DIN = 3488, DINP = 3584, NLAYER = 2;
constexpr int C_AQ = 0, C_AK = 256, C_AV = 384, C_BB = 512, C_BC = 768, C_BX = 1024, C_CQ = 1280, C_CKV = 1536, C_CKR = 1664,
              C_DQ = 1696, C_DK = 1952, C_DV = 2208, C_GATE = 2464;
constexpr float EPS = 1e-6f, LOG2E = 1.4426950408889634f;
constexpr float SC64 = 0.125f * LOG2E;
constexpr float QSC_MLA = 0.10206207261596575f * LOG2E;
constexpr int NWAVES = 8, NTHREADS = 512;
constexpr int LDS_BYTES = 122880 + 8 * 4096 + 1024;

constexpr size_t MiB = 1u << 20;
constexpr size_t WS_CTL = 0, CTL_BYTES = 65536;
constexpr int CW_BAR = 1024;
constexpr size_t WS_WIN = 1 * MiB;
constexpr size_t WS_WOUT = 15 * MiB;
constexpr size_t WS_WUQ = 19 * MiB;
constexpr size_t WS_WUKV = 19 * MiB + 512 * 1024;
constexpr size_t WS_XN = 32 * MiB;
constexpr size_t WS_H = 64 * MiB;
constexpr size_t WS_QC = 176 * MiB;
constexpr size_t WS_KC = 188 * MiB;
constexpr size_t WS_VTC = 200 * MiB;
constexpr size_t WS_VTA = 208 * MiB;
constexpr size_t WS_VTD = 212 * MiB;
constexpr size_t WS_Y = 220 * MiB;
constexpr size_t WS_END = 252 * MiB;

struct Params {
    const float* x; const int* pos; const float* norm_pre; const float* w_in; const float* sinks; const float* conv_w; const float* conv_b;
    const float* g_cq; const float* w_uq; const float* g_ckv; const float* w_ukv; const float* g_grp; const float* w_out; const float* g_post;
    float* out; unsigned char* ws; int ph_lo, ph_hi;
};

__device__ __forceinline__ unsigned pk2(float lo, float hi) { f32x2_t v = {lo, hi}; bf16x2_t b = __builtin_convertvector(v, bf16x2_t); return __builtin_bit_cast(unsigned, b); }
__device__ __forceinline__ float bf2f(short s) { return __uint_as_float(((unsigned)(unsigned short)s) << 16); }
__device__ __forceinline__ float bflo(unsigned u) { return __uint_as_float(u << 16); }
__device__ __forceinline__ float bfhi(unsigned u) { return __uint_as_float(u & 0xffff0000u); }
__device__ __forceinline__ bf16_t f2bf(float f) { return (bf16_t)(pk2(f, 0.f) & 0xffffu); }
__device__ __forceinline__ int crow(int i, int h) { return (i & 3) + 8 * (i >> 2) + 4 * h; }
__device__ __forceinline__ float ex2(float x) { return __builtin_amdgcn_exp2f(x); }
__device__ __forceinline__ float lg2(float x) { return __builtin_amdgcn_logf(x); }
__device__ __forceinline__ float xh_max(float v) { auto rr = __builtin_amdgcn_permlane32_swap(__float_as_uint(v), __float_as_uint(v), false, false); return fmaxf(__uint_as_float(rr[0]), __uint_as_float(rr[1])); }
__device__ __forceinline__ float xh_sum(float v) { auto rr = __builtin_amdgcn_permlane32_swap(__float_as_uint(v), __float_as_uint(v), false, false); return __uint_as_float(rr[0]) + __uint_as_float(rr[1]); }
__device__ __forceinline__ float xh_other(float v, int h) { auto rr = __builtin_amdgcn_permlane32_swap(__float_as_uint(v), __float_as_uint(v), false, false); return __uint_as_float(h ? rr[0] : rr[1]); }
#define MX3(a, b, c) __builtin_fmaxf(__builtin_fmaxf((a), (b)), (c))
__device__ __forceinline__ float wave_sum(float v) {
#pragma unroll
    for (int o = 1; o < 64; o <<= 1) v += __shfl_xor(v, o);
    return v;
}
__device__ __forceinline__ bf16x8 pack8(const float* e) {
    u32x4 w; w.x = pk2(e[0], e[1]); w.y = pk2(e[2], e[3]); w.z = pk2(e[4], e[5]); w.w = pk2(e[6], e[7]);
    return __builtin_bit_cast(bf16x8, w);
}

__device__ __forceinline__ void conv_wT(const float* __restrict__ W, int K, int N, int NP, const float* __restrict__ gain, bf16_t* __restrict__ dst,
                                        int a0, int a1, int b0, int b1, float sc, int gtid, int gthreads) {
    const int k8n = K / 8; const int items = NP * k8n;
#pragma unroll 2
    for (int it = gtid; it < items; it += gthreads) {
        const int n = it % NP, k8 = it / NP;
        u32x4 o = {0u, 0u, 0u, 0u};
        if (n < N) {
            const float cs = ((n >= a0 && n < a1) || (n >= b0 && n < b1)) ? sc : 1.f;
            float v[8];
#pragma unroll
            for (int j = 0; j < 8; ++j) v[j] = W[(size_t)(k8 * 8 + j) * N + n] * gain[k8 * 8 + j] * cs;
            o.x = pk2(v[0], v[1]); o.y = pk2(v[2], v[3]); o.z = pk2(v[4], v[5]); o.w = pk2(v[6], v[7]);
        }
        *(u32x4*)(dst + (size_t)n * K + k8 * 8) = o;
    }
}
__device__ __forceinline__ void wT_item(const float* __restrict__ W, int K, int N, const float* __restrict__ gain, bf16_t* __restrict__ WT, int a0, int a1, int b0, int b1, float sc,
                                        LAS float* scr, int item, int lane) {
    const int nblk = N / 32, kb = item / nblk, nb = item - kb * nblk, k0 = 64 * kb, n0 = 32 * nb;
#pragma unroll 8
    for (int i = 0; i < 32; ++i) { const int kk = 2 * i + (lane >> 5); scr[kk * 33 + (lane & 31)] = W[(size_t)(k0 + kk) * N + n0 + (lane & 31)]; }
    const int c = lane & 7;
    float g8[8];
#pragma unroll
    for (int j = 0; j < 8; ++j) g8[j] = gain[k0 + 8 * c + j];
#pragma unroll
    for (int j = 0; j < 4; ++j) { const int n = (lane >> 3) + 8 * j, nn = n0 + n; const LAS float* sp = scr + (8 * c) * 33 + n;
        const float cs = ((nn >= a0 && nn < a1) || (nn >= b0 && nn < b1)) ? sc : 1.f;
        u32x4 o; o.x = pk2(sp[0 * 33] * g8[0] * cs, sp[1 * 33] * g8[1] * cs); o.y = pk2(sp[2 * 33] * g8[2] * cs, sp[3 * 33] * g8[3] * cs);
        o.z = pk2(sp[4 * 33] * g8[4] * cs, sp[5 * 33] * g8[5] * cs); o.w = pk2(sp[6 * 33] * g8[6] * cs, sp[7 * 33] * g8[7] * cs);
        *(u32x4*)(WT + (size_t)nn * K + k0 + 8 * c) = o; }
}
__device__ __forceinline__ void rms_row_to_bf16(const float* __restrict__ xrow, bf16_t* __restrict__ orow, int lane) {
    f32x4 v[4]; float s = 0.f;
#pragma unroll
    for (int j = 0; j < 4; ++j) { v[j] = ((const f32x4*)xrow)[lane + 64 * j]; s += (v[j].x * v[j].x + v[j].y * v[j].y) + (v[j].z * v[j].z + v[j].w * v[j].w); }
    const float rs = rsqrtf(wave_sum(s) * (1.f / DM) + EPS);
#pragma unroll
    for (int j = 0; j < 4; ++j) { u32x2 o; o.x = pk2(v[j].x * rs, v[j].y * rs); o.y = pk2(v[j].z * rs, v[j].w * rs); ((u32x2*)orow)[lane + 64 * j] = o; }
}

__device__ __forceinline__ void rope_cs(int pos, int h, float (&cs)[8], float (&sn)[8]) {
#pragma unroll
    for (int i = 0; i < 8; ++i) {
        const int f = (i & 3) + 8 * (i >> 2) + 4 * h;
        const float freq = ex2(-(float)f * 0.830482023721841f);
        const float ang = (float)pos * freq;
        const double rev = (double)ang * 0.15915494309189535;
        const float fr = (float)(rev - __builtin_rint(rev));
        cs[i] = __builtin_amdgcn_cosf(fr); sn[i] = __builtin_amdgcn_sinf(fr);
    }
}
__device__ __forceinline__ void rope_apply(f32x16& a, const float (&cs)[8], const float (&sn)[8]) {
#pragma unroll
    for (int i = 0; i < 8; ++i) { const float x1 = a[i], x2 = a[i + 8]; a[i] = x1 * cs[i] - x2 * sn[i]; a[i + 8] = x1 * sn[i] + x2 * cs[i]; }
}
__device__ __forceinline__ void store_tile_rowmajor(bf16_t* dst  , const f32x16& a, int h) {
#pragma unroll
    for (int g = 0; g < 4; ++g) { u32x2 o; o.x = pk2(a[4 * g], a[4 * g + 1]); o.y = pk2(a[4 * g + 2], a[4 * g + 3]); *(u32x2*)(dst + 8 * g + 4 * h) = o; }
}
constexpr int WQP = 528, WKP = 272, WQ_BYTES = 96 * WQP;
__device__ __forceinline__ void mq_unit(const bf16_t* __restrict__ H, const LAS unsigned char* Wl, const int* __restrict__ pos, bf16_t* __restrict__ QC, int tb, int hh, int lane) {
    const int r = lane & 31, h = lane >> 5, tok = tb * 32 + r;
    const bf16_t* src = H + (size_t)tok * DINP + C_CQ + 8 * h;
    bf16x8 bfr[16]; float ss = 0.f;
#pragma unroll
    for (int s = 0; s < 16; ++s) { bfr[s] = *(const bf16x8*)(src + 16 * s);
#pragma unroll
        for (int j = 0; j < 8; ++j) { const float v = bf2f(bfr[s][j]); ss += v * v; } }
    ss += __shfl_xor(ss, 32);
    const float rs = rsqrtf(ss * (1.f / 256.f) + EPS) * QSC_MLA;
    float cs[8], sn[8]; rope_cs(pos[tok], h, cs, sn);
    const LAS unsigned char* W = Wl + r * WQP + 16 * h;
#pragma unroll 1
    for (int nt = 0; nt < 3; ++nt) {
        f32x16 acc;
#pragma unroll
        for (int i = 0; i < 16; ++i) acc[i] = 0.f;
#pragma unroll
        for (int s = 0; s < 16; ++s) { const bf16x8 a = *(const LAS bf16x8*)(W + nt * 32 * WQP + 32 * s); acc = MFMA32(a, bfr[s], acc); }
#pragma unroll
        for (int i = 0; i < 16; ++i) acc[i] *= rs;
        if (nt == 2) rope_apply(acc, cs, sn);
        store_tile_rowmajor(QC + (size_t)tok * 384 + hh * 96 + nt * 32, acc, h);
    }
}
__device__ __forceinline__ void vt_flush(LAS bf16_t* stg, bf16_t* __restrict__ dst  , int lane) {
    const LAS u32x4* rp = (const LAS u32x4*)(stg + lane * 32);
    u32x4 w[4];
#pragma unroll
    for (int c = 0; c < 4; ++c) w[c] = rp[c];
    u32x4* gp = (u32x4*)(dst + (size_t)lane * SEQ);
#pragma unroll
    for (int c = 0; c < 4; ++c) gp[c] = w[c];
}
__device__ __forceinline__ void mkv_unit(const bf16_t* __restrict__ H, const LAS unsigned char* Wl, const int* __restrict__ pos, bf16_t* __restrict__ KC, bf16_t* __restrict__ VTC, int tb, int hh, int lane, LAS bf16_t* stg) {
    const int r = lane & 31, h = lane >> 5, tok = tb * 32 + r;
    const bf16_t* src = H + (size_t)tok * DINP + C_CKV + 8 * h;
    bf16x8 bfr[8]; float ss = 0.f;
#pragma unroll
    for (int s = 0; s < 8; ++s) { bfr[s] = *(const bf16x8*)(src + 16 * s);
#pragma unroll
        for (int j = 0; j < 8; ++j) { const float v = bf2f(bfr[s][j]); ss += v * v; } }
    ss += __shfl_xor(ss, 32);
    const float rs = rsqrtf(ss * (1.f / 128.f) + EPS);
    const LAS unsigned char* W = Wl + r * WKP + 16 * h;
    const int b = (tb * 32) / SEQ, t0 = (tb * 32) % SEQ;
#pragma unroll 1
    for (int nt = 0; nt < 4; ++nt) {
        f32x16 acc;
#pragma unroll
        for (int i = 0; i < 16; ++i) acc[i] = 0.f;
#pragma unroll
        for (int s = 0; s < 8; ++s) { const bf16x8 a = *(const LAS bf16x8*)(W + nt * 32 * WKP + 32 * s); acc = MFMA32(a, bfr[s], acc); }
#pragma unroll
        for (int i = 0; i < 16; ++i) acc[i] *= rs;
        if (nt < 2) store_tile_rowmajor(KC + (size_t)tok * 384 + hh * 96 + nt * 32, acc, h);
        else {
            LAS bf16_t* sp = stg + ((nt - 2) * 32 + 4 * h) * 32 + r;
#pragma unroll
            for (int i = 0; i < 16; ++i) sp[((i & 3) + 8 * (i >> 2)) * 32] = f2bf(acc[i]);
        }
    }
    vt_flush(stg, VTC + ((size_t)((b * 4 + hh) * 64)) * SEQ + t0, lane);
    f32x16 kr;
    const bf16_t* krp = H + (size_t)tok * DINP + C_CKR + 4 * h;
#pragma unroll
    for (int g = 0; g < 4; ++g) { const u32x2 w = *(const u32x2*)(krp + 8 * g); kr[4 * g] = bflo(w.x); kr[4 * g + 1] = bfhi(w.x); kr[4 * g + 2] = bflo(w.y); kr[4 * g + 3] = bfhi(w.y); }
    float cs[8], sn[8]; rope_cs(pos[tok], h, cs, sn);
    rope_apply(kr, cs, sn);
    store_tile_rowmajor(KC + (size_t)tok * 384 + hh * 96 + 64, kr, h);
}
__device__ __forceinline__ void vt_unit(const bf16_t* __restrict__ H, int col0, int NH, bf16_t* __restrict__ VT, int tb, int head, int lane, LAS bf16_t* stg) {
    const int r = lane & 31, h = lane >> 5, tok = tb * 32 + r, b = (tb * 32) / SEQ, t0 = (tb * 32) % SEQ;
    const bf16_t* src = H + (size_t)tok * DINP + col0 + head * 64 + 32 * h;
    bf16x8 v[4];
#pragma unroll
    for (int c = 0; c < 4; ++c) v[c] = *(const bf16x8*)(src + 8 * c);
    LAS bf16_t* sp = stg + (32 * h) * 32 + r;
#pragma unroll
    for (int c = 0; c < 4; ++c)
#pragma unroll
        for (int j = 0; j < 8; ++j) sp[(8 * c + j) * 32] = (bf16_t)v[c][j];
    vt_flush(stg, VT + ((size_t)((b * NH + head) * 64)) * SEQ + t0, lane);
}
__device__ __forceinline__ void conv_unit(const bf16_t* __restrict__ H, const float* __restrict__ cw, const float* __restrict__ cb, bf16_t* __restrict__ Y, int tb8, int lane) {
    const int tok0 = tb8 * 8, t0 = tok0 % SEQ, ch = 4 * lane;
    const f32x4 w0 = *(const f32x4*)(cw + ch), w1 = *(const f32x4*)(cw + 256 + ch), w2 = *(const f32x4*)(cw + 512 + ch), bs = *(const f32x4*)(cb + ch);
    u32x2 cc[10], xx[10], bb[8];
    const int back = (t0 >= 2) ? 2 : 0;
#pragma unroll
    for (int i = 0; i < 10; ++i) { const int ti = (i < 2) ? (i - back) : (i - 2); const bf16_t* p = H + (size_t)(tok0 + ti) * DINP + ch;
        cc[i] = *(const u32x2*)(p + C_BC); xx[i] = *(const u32x2*)(p + C_BX); if (i >= 2) bb[i - 2] = *(const u32x2*)(p + C_BB); }
    f32x4 u[10];
#pragma unroll
    for (int i = 0; i < 10; ++i) u[i] = (f32x4){bflo(cc[i].x) * bflo(xx[i].x), bfhi(cc[i].x) * bfhi(xx[i].x), bflo(cc[i].y) * bflo(xx[i].y), bfhi(cc[i].y) * bfhi(xx[i].y)};
    if (back == 0) { u[0] = (f32x4){0.f, 0.f, 0.f, 0.f}; u[1] = (f32x4){0.f, 0.f, 0.f, 0.f}; }
#pragma unroll
    for (int i = 0; i < 8; ++i) {
        const f32x4 bg = {bflo(bb[i].x), bfhi(bb[i].x), bflo(bb[i].y), bfhi(bb[i].y)};
        const f32x4 y = bg * (w0 * u[i] + w1 * u[i + 1] + w2 * u[i + 2] + bs);
        u32x2 o; o.x = pk2(y.x, y.y); o.y = pk2(y.z, y.w);
        *(u32x2*)(Y + (size_t)(tok0 + i) * DM + 256 + ch) = o;
    }
}

__device__ __forceinline__ void o_flush(LAS bf16_t* stg, bf16_t* __restrict__ Orow0, int opitch, int lane) {
    u32x4 w[4];
#pragma unroll
    for (int j = 0; j < 4; ++j) w[j] = *(const LAS u32x4*)(stg + (lane + 64 * j) * 8);
#pragma unroll
    for (int j = 0; j < 4; ++j) { const int c = lane + 64 * j; *(u32x4*)(Orow0 + (size_t)(c >> 3) * opitch + (c & 7) * 8) = w[j]; }
}
template <int DKS, bool SINK>
__device__ __forceinline__ void softmax_unit(const bf16_t* __restrict__ Qrow0, int qpitch, const bf16_t* __restrict__ Kb, int kpitch, const bf16_t* __restrict__ VT,
                                             int qb, int kt_begin, int window, float sink2, bf16_t* __restrict__ Orow0, int opitch, int lane, LAS bf16_t* stg) {
    const int r = lane & 31, h = lane >> 5;
    const int pr = (r & ~12) | ((r & 8) >> 1) | ((r & 4) << 1);
    bf16x8 qf[DKS];
#pragma unroll
    for (int s = 0; s < DKS; ++s) qf[s] = *(const bf16x8*)(Qrow0 + (size_t)r * qpitch + 16 * s + 8 * h);
    f32x16 o0, o1;
#pragma unroll
    for (int i = 0; i < 16; ++i) { o0[i] = 0.f; o1[i] = 0.f; }
    float m = -1e30f, l = 0.f;
    const int kt_end = qb + 1, q = 32 * qb + r;
    const bf16_t* kp = Kb + (size_t)(32 * kt_begin + pr) * kpitch + 8 * h;
    const bf16_t* vp = VT + (size_t)r * SEQ + 32 * kt_begin + 8 * h;
    bf16x8 kf[DKS];
#pragma unroll
    for (int s = 0; s < DKS; ++s) kf[s] = *(const bf16x8*)(kp + 16 * s);
    for (int kt = kt_begin; kt < kt_end; ++kt) {
        bf16x8 kn[DKS];
        if (kt + 1 < kt_end) {
#pragma unroll
            for (int s = 0; s < DKS; ++s) kn[s] = *(const bf16x8*)(kp + (size_t)32 * kpitch + 16 * s);
        } else {
#pragma unroll
            for (int s = 0; s < DKS; ++s) kn[s] = kf[s];
        }
        const bf16x8 v00 = *(const bf16x8*)(vp), v01 = *(const bf16x8*)(vp + 32 * SEQ), v10 = *(const bf16x8*)(vp + 16), v11 = *(const bf16x8*)(vp + 32 * SEQ + 16);
        f32x16 p;
#pragma unroll
        for (int i = 0; i < 16; ++i) p[i] = 0.f;
#pragma unroll
        for (int s = 0; s < DKS; ++s) p = MFMA32(kf[s], qf[s], p);
        if (kt == qb || (window != 0 && kt == qb - (window >> 5))) {
            const int k0 = 32 * kt + 8 * h;
#pragma unroll
            for (int i = 0; i < 16; ++i) { const int kv = k0 + 16 * (i >> 3) + (i & 7); const bool ok = (kv <= q) && (window == 0 || kv > q - window); if (!ok) p[i] = -INFINITY; }
        }
        float rm = MX3(p[0], p[1], p[2]);
#pragma unroll
        for (int i = 3; i < 15; i += 2) rm = MX3(rm, p[i], p[i + 1]);
        rm = xh_max(fmaxf(rm, p[15]));
        if (__any(rm > m + 6.f)) {
            const float mn = fmaxf(m, rm), f = ex2(m - mn); m = mn; l *= f;
#pragma unroll
            for (int i = 0; i < 16; ++i) { const float fi = __shfl(f, crow(i, h)); o0[i] *= fi; o1[i] *= fi; }
        }
        float e[16];
#pragma unroll
        for (int i = 0; i < 16; ++i) { e[i] = ex2(p[i] - m); l += e[i]; }
        const bf16x8 pa0 = pack8(e), pa1 = pack8(e + 8);
        o0 = MFMA32(pa0, v00, o0); o1 = MFMA32(pa0, v01, o1);
        o0 = MFMA32(pa1, v10, o0); o1 = MFMA32(pa1, v11, o1);
#pragma unroll
        for (int s = 0; s < DKS; ++s) kf[s] = kn[s];
        kp += (size_t)32 * kpitch; vp += 32;
    }
    l = xh_sum(l);
    if (SINK) l += ex2(sink2 - m);
    const float inv = 1.f / l;
    LAS bf16_t* sp = stg + (4 * h) * 64 + r;
#pragma unroll
    for (int i = 0; i < 16; ++i) { const float fi = __shfl(inv, crow(i, h)); const int ro = ((i & 3) + 8 * (i >> 2)) * 64;
        sp[ro] = f2bf(o0[i] * fi); sp[ro + 32] = f2bf(o1[i] * fi); }
    o_flush(stg, Orow0, opitch, lane);
}


constexpr int KP = 208, VP = 272;
constexpr int KT_BYTES = 128 * KP, VT_BYTES = 64 * VP, TB_BYTES = KT_BYTES + VT_BYTES, MRG_OFF = 2 * TB_BYTES;
static_assert(MRG_OFF + 4 * 34 * 64 * 4 <= 131072, "MLA LDS map");
__device__ __forceinline__ void mla_unit_blk(const bf16_t* __restrict__ QC, const bf16_t* __restrict__ KC, const bf16_t* __restrict__ VTC, bf16_t* __restrict__ Y,
                                             int bh, int g, LAS unsigned char* lds, int tid) {
    const int lane = tid & 63, wave = __builtin_amdgcn_readfirstlane(tid >> 6), r = lane & 31, h = lane >> 5, w4 = wave & 3, kh = wave >> 2;
    const int pr = (r & ~12) | ((r & 8) >> 1) | ((r & 4) << 1);
    const int b = bh >> 2, hh = bh & 3, qb = 4 * g + w4, q = 32 * qb + r;
    const bf16_t* Qp = QC + ((size_t)b * SEQ + q) * 384 + hh * 96 + 8 * h;
    bf16x8 qf[6];
#pragma unroll
    for (int s = 0; s < 6; ++s) qf[s] = *(const bf16x8*)(Qp + 16 * s);
    const bf16_t* Kg = KC + (size_t)b * SEQ * 384 + hh * 96;
    const bf16_t* Vg = VTC + (size_t)(b * 4 + hh) * 64 * SEQ;
    unsigned dgo[6];
#pragma unroll
    for (int i = 0; i < 6; ++i) { const int n = wave + 8 * i; unsigned o = 0u;
        if (n < 26) { const int j = 64 * n + lane, row = j / 13; int cc = j - 13 * row; cc = cc == 12 ? 0 : cc; o = (unsigned)(row * 384 + 8 * cc) * 2u; }
        else if (n < 43) { const int j = 64 * (n - 26) + lane, d = j / 17; int cc = j - 17 * d; cc = cc == 16 ? 0 : cc; o = (unsigned)(d * SEQ + 8 * cc) * 2u; }
        dgo[i] = o; }
#define MLA_DMA(ST, BO) do { const char* kb_ = (const char*)(Kg + (size_t)(ST) * (128 * 384)); const char* vb_ = (const char*)(Vg + (ST) * 128); \
        _Pragma("unroll") for (int i = 0; i < 6; ++i) { const int n = wave + 8 * i; \
            if (n < 26) __builtin_amdgcn_global_load_lds((const unsigned*)(kb_ + dgo[i]), (LAS unsigned*)(lds + (BO) + n * 1024), 16, 0, 0); \
            else if (n < 43) __builtin_amdgcn_global_load_lds((const unsigned*)(vb_ + dgo[i]), (LAS unsigned*)(lds + (BO) + KT_BYTES + (n - 26) * 1024), 16, 0, 0); } } while (0)
#define MLA_DMA_WAIT() asm volatile("s_waitcnt vmcnt(0)" ::: "memory")
    f32x16 o0, o1;
#pragma unroll
    for (int i = 0; i < 16; ++i) { o0[i] = 0.f; o1[i] = 0.f; }
    float m = 0.f, l = 0.f; bool first = true;
    f32x16 negm;
#pragma unroll
    for (int i = 0; i < 16; ++i) negm[i] = 0.f;
    const int nST = g + 1;
    MLA_DMA(0, 0); MLA_DMA_WAIT();
    __syncthreads();
    const int kfo = (64 * kh + pr) * KP + 16 * h;
    const int vfo = KT_BYTES + r * VP + (64 * kh + 8 * h) * 2;
    for (int ST = 0; ST < nST; ++ST) {
        if (ST + 1 < nST) MLA_DMA(ST + 1, ((ST + 1) & 1) * TB_BYTES);
        const int kt0 = 4 * ST + 2 * kh;
        if (kt0 <= qb) {
            const LAS unsigned char* tb = lds + (ST & 1) * TB_BYTES;
            f32x16 p0, p1;
            { const bf16x8 k0 = *(const LAS bf16x8*)(tb + kfo), k1 = *(const LAS bf16x8*)(tb + kfo + 32 * KP); p0 = MFMA32(k0, qf[0], negm); p1 = MFMA32(k1, qf[0], negm); }
#pragma unroll
            for (int s = 1; s < 6; ++s) { const bf16x8 k0 = *(const LAS bf16x8*)(tb + kfo + 32 * s), k1 = *(const LAS bf16x8*)(tb + kfo + 32 * KP + 32 * s);
                p0 = MFMA32(k0, qf[s], p0); p1 = MFMA32(k1, qf[s], p1); }
            if (kt0 + 1 >= qb) {
                const int kb0 = 32 * kt0 + 8 * h;
#pragma unroll
                for (int i = 0; i < 16; ++i) { const int kv = kb0 + 16 * (i >> 3) + (i & 7); if (kv > q) p0[i] = -INFINITY; if (kv + 32 > q) p1[i] = -INFINITY; }
            }
            float ra_ = MX3(p0[0], p0[1], p1[0]), rb_ = MX3(p0[2], p0[3], p1[1]); ra_ = MX3(ra_, p1[2], p1[3]);
#pragma unroll
            for (int i = 4; i < 16; i += 4) { ra_ = MX3(ra_, p0[i], p0[i + 1]); rb_ = MX3(rb_, p0[i + 2], p0[i + 3]); ra_ = MX3(ra_, p1[i], p1[i + 1]); rb_ = MX3(rb_, p1[i + 2], p1[i + 3]); }
            const float rm = xh_max(fmaxf(ra_, rb_));
            if (first || __any(rm > 6.f)) {
                const float dl = first ? rm : fmaxf(rm, 0.f);
                m += dl;
#pragma unroll
                for (int i = 0; i < 16; ++i) { p0[i] -= dl; p1[i] -= dl; negm[i] = -m; }
                if (!first) { const float f = ex2(-dl); l *= f;
#pragma unroll
                    for (int i = 0; i < 16; ++i) { const float fi = __shfl(f, crow(i, h)); o0[i] *= fi; o1[i] *= fi; } }
                first = false;
            }
            float ls = 0.f;
#pragma unroll
            for (int i = 0; i < 16; ++i) { p0[i] = ex2(p0[i]); p1[i] = ex2(p1[i]); ls += p0[i] + p1[i]; }
            l += ls;
            float e[8];
#pragma unroll
            for (int ks = 0; ks < 4; ++ks) {
#pragma unroll
                for (int j = 0; j < 8; ++j) e[j] = (ks < 2) ? p0[8 * ks + j] : p1[8 * (ks - 2) + j];
                const bf16x8 pa = pack8(e);
                const bf16x8 v0 = *(const LAS bf16x8*)(tb + vfo + 32 * ks), v1 = *(const LAS bf16x8*)(tb + vfo + 32 * VP + 32 * ks);
                o0 = MFMA32(pa, v0, o0); o1 = MFMA32(pa, v1, o1);
            }
        }
        MLA_DMA_WAIT();
        __syncthreads();
    }
#undef MLA_DMA
#undef MLA_DMA_WAIT
    if (first) m = -1e30f;
    l = xh_sum(l);
    LAS float* mg = (LAS float*)(lds + MRG_OFF) + w4 * (34 * 64) + lane;
    if (kh == 1) {
#pragma unroll
        for (int i = 0; i < 16; ++i) { mg[i * 64] = o0[i]; mg[(16 + i) * 64] = o1[i]; }
        mg[32 * 64] = m; mg[33 * 64] = l;
    }
    __syncthreads();
    if (kh == 0) {
        const float mb = mg[32 * 64], lb = mg[33 * 64];
        const float mn = fmaxf(m, mb), fa = ex2(m - mn), fb = ex2(mb - mn), inv = 1.f / (l * fa + lb * fb), ga = fa * inv, gb = fb * inv;
        LAS bf16_t* stg = (LAS bf16_t*)(lds + wave * 4096);
        LAS bf16_t* sp = stg + (4 * h) * 64 + r;
#pragma unroll
        for (int i = 0; i < 16; ++i) { const float ra = __shfl(ga, crow(i, h)), rb = __shfl(gb, crow(i, h)); const int ro = ((i & 3) + 8 * (i >> 2)) * 64;
            sp[ro] = f2bf(o0[i] * ra + mg[i * 64] * rb); sp[ro + 32] = f2bf(o1[i] * ra + mg[(16 + i) * 64] * rb); }
        o_flush(stg, Y + ((size_t)b * SEQ + 32 * qb) * DM + 512 + hh * 64, DM, lane);
    }
    __syncthreads();
}

__device__ __forceinline__ void sb_unit(const bf16_t* __restrict__ Qrow0, int qpitch, const bf16_t* __restrict__ Kb, int kpitch, const bf16_t* __restrict__ VT,
                                        int qb, bf16_t* __restrict__ Orow0, int opitch, int lane, LAS bf16_t* stg) {
    const int r = lane & 31, h = lane >> 5;
    const int pr = (r & ~12) | ((r & 8) >> 1) | ((r & 4) << 1);
    bf16x8 qf[4];
#pragma unroll
    for (int s = 0; s < 4; ++s) qf[s] = *(const bf16x8*)(Qrow0 + (size_t)r * qpitch + 16 * s + 8 * h);
    f32x16 o0, o1;
#pragma unroll
    for (int i = 0; i < 16; ++i) { o0[i] = 0.f; o1[i] = 0.f; }
    float carry = 0.f;
    const int q = 32 * qb + r;
    const bf16_t* kp = Kb + (size_t)(32 * qb + pr) * kpitch + 8 * h;
    const bf16_t* vp = VT + (size_t)r * SEQ + 32 * qb + 8 * h;
    bf16x8 kf[4];
#pragma unroll
    for (int s = 0; s < 4; ++s) kf[s] = *(const bf16x8*)(kp + 16 * s);
    for (int kt = qb; kt >= 0; --kt) {
        bf16x8 kn[4];
        if (kt > 0) {
#pragma unroll
            for (int s = 0; s < 4; ++s) kn[s] = *(const bf16x8*)(kp - (size_t)32 * kpitch + 16 * s);
        } else {
#pragma unroll
            for (int s = 0; s < 4; ++s) kn[s] = kf[s];
        }
        const bf16x8 v00 = *(const bf16x8*)(vp), v01 = *(const bf16x8*)(vp + 32 * SEQ), v10 = *(const bf16x8*)(vp + 16), v11 = *(const bf16x8*)(vp + 32 * SEQ + 16);
        f32x16 p;
#pragma unroll
        for (int i = 0; i < 16; ++i) p[i] = 0.f;
#pragma unroll
        for (int s = 0; s < 4; ++s) p = MFMA32(kf[s], qf[s], p);
        const bool diag = (kt == qb);
        const int k0 = 32 * kt + 8 * h;
        float sfx[16];
#pragma unroll
        for (int i = 0; i < 16; ++i) {
            const float z = p[i];
            float L = -(fmaxf(z, 0.f) + lg2(1.f + ex2(-fabsf(z))));
            if (diag) { const int kv = k0 + 16 * (i >> 3) + (i & 7); if (!(kv < q)) L = 0.f; }
            sfx[i] = L;
        }
#pragma unroll
        for (int g = 0; g < 2; ++g)
#pragma unroll
            for (int j = 6; j >= 0; --j) sfx[8 * g + j] += sfx[8 * g + j + 1];
        const float T0 = sfx[0], T1 = sfx[8];
        const float TP0 = __shfl_xor(T0, 32), TP1 = __shfl_xor(T1, 32);
        const float off1 = (h ? 0.f : TP1) + carry, off0 = T1 + TP1 + (h ? 0.f : TP0) + carry;
        float e[16];
#pragma unroll
        for (int i = 0; i < 16; ++i) {
            float a = ex2(p[i] + sfx[i] + (i < 8 ? off0 : off1));
            if (diag) { const int kv = k0 + 16 * (i >> 3) + (i & 7); if (!(kv < q)) a = 0.f; }
            e[i] = a;
        }
        carry += (T0 + T1) + (TP0 + TP1);
        const bf16x8 pa0 = pack8(e), pa1 = pack8(e + 8);
        o0 = MFMA32(pa0, v00, o0); o1 = MFMA32(pa0, v01, o1);
        o0 = MFMA32(pa1, v10, o0); o1 = MFMA32(pa1, v11, o1);
        if (__all(carry < -150.f)) break;
#pragma unroll
        for (int s = 0; s < 4; ++s) kf[s] = kn[s];
        kp -= (size_t)32 * kpitch; vp -= 32;
    }
    LAS bf16_t* sp = stg + (4 * h) * 64 + r;
#pragma unroll
    for (int i = 0; i < 16; ++i) { const int ro = ((i & 3) + 8 * (i >> 2)) * 64; sp[ro] = f2bf(o0[i]); sp[ro + 32] = f2bf(o1[i]); }
    o_flush(stg, Orow0, opitch, lane);
}


constexpr int AKP = 144;
constexpr int SWA_NK = 384, SWA_VP = SWA_NK * 2 + 16, SWA_KB = SWA_NK * AKP;
constexpr int SB_NK = 448, SB_VP = SB_NK * 2 + 16, SB_KB = SB_NK * AKP;
constexpr int STG_OFF = 122880, MISC_OFF = STG_OFF + 8 * 4096;
static_assert(SWA_KB + 64 * SWA_VP <= STG_OFF && SB_KB + 64 * SB_VP <= STG_OFF && MISC_OFF + 1024 == LDS_BYTES, "window LDS map");
template <int NK, int VPB>
__device__ __forceinline__ void stage_kv64(const bf16_t* __restrict__ Kb, int kpitch, const bf16_t* __restrict__ VT, int key0, LAS unsigned char* lds, int tid) {
    constexpr int NCH = NK * 8 / 512, VC = NK / 8;
    u32x4 kr[NCH], vr[NCH];
#pragma unroll
    for (int i = 0; i < NCH; ++i) { const int c = tid + 512 * i, row = c >> 3, cc = c & 7; int key = key0 + row; key = key < 0 ? 0 : key;
        kr[i] = *(const u32x4*)(Kb + (size_t)key * kpitch + 8 * cc); }
#pragma unroll
    for (int i = 0; i < NCH; ++i) { const int c = tid + 512 * i, d = c / VC, cc = c - d * VC; int key = key0 + 8 * cc; key = key < 0 ? 0 : key;
        vr[i] = *(const u32x4*)(VT + (size_t)d * SEQ + key); }
#pragma unroll
    for (int i = 0; i < NCH; ++i) { const int c = tid + 512 * i, row = c >> 3, cc = c & 7; *(LAS u32x4*)(lds + row * AKP + 16 * cc) = kr[i]; }
#pragma unroll
    for (int i = 0; i < NCH; ++i) { const int c = tid + 512 * i, d = c / VC, cc = c - d * VC; *(LAS u32x4*)(lds + NK * AKP + d * VPB + 16 * cc) = vr[i]; }
}
__device__ __forceinline__ void swa_wave_lds(const bf16_t* __restrict__ Qrow0, int qpitch, const LAS unsigned char* lds, int qb, int kt_base, float sink2,
                                             bf16_t* __restrict__ Orow0, int opitch, int lane, LAS bf16_t* stg) {
    const int r = lane & 31, h = lane >> 5;
    const int pr = (r & ~12) | ((r & 8) >> 1) | ((r & 4) << 1);
    bf16x8 qf[4];
#pragma unroll
    for (int s = 0; s < 4; ++s) qf[s] = *(const bf16x8*)(Qrow0 + (size_t)r * qpitch + 16 * s + 8 * h);
    f32x16 o0, o1;
#pragma unroll
    for (int i = 0; i < 16; ++i) { o0[i] = 0.f; o1[i] = 0.f; }
    float m = -1e30f, l = 0.f;
    const int q = 32 * qb + r, kt_begin = qb - 4 > 0 ? qb - 4 : 0;
    for (int kt = kt_begin; kt <= qb; ++kt) {
        const int rel = kt - kt_base;
        const LAS unsigned char* kp = lds + (32 * rel + pr) * AKP + 16 * h;
        const LAS unsigned char* vp = lds + SWA_KB + r * SWA_VP + (32 * rel + 8 * h) * 2;
        f32x16 p;
#pragma unroll
        for (int i = 0; i < 16; ++i) p[i] = 0.f;
#pragma unroll
        for (int s = 0; s < 4; ++s) p = MFMA32(*(const LAS bf16x8*)(kp + 32 * s), qf[s], p);
        if (kt == qb || kt == qb - 4) {
            const int k0 = 32 * kt + 8 * h;
#pragma unroll
            for (int i = 0; i < 16; ++i) { const int kv = k0 + 16 * (i >> 3) + (i & 7); const bool ok = (kv <= q) && (kv > q - 128); if (!ok) p[i] = -INFINITY; }
        }
        float rm = MX3(p[0], p[1], p[2]);
#pragma unroll
        for (int i = 3; i < 15; i += 2) rm = MX3(rm, p[i], p[i + 1]);
        rm = xh_max(fmaxf(rm, p[15]));
        if (__any(rm > m + 6.f)) {
            const float mn = fmaxf(m, rm), f = ex2(m - mn); m = mn; l *= f;
#pragma unroll
            for (int i = 0; i < 16; ++i) { const float fi = __shfl(f, crow(i, h)); o0[i] *= fi; o1[i] *= fi; }
        }
        float e[16];
#pragma unroll
        for (int i = 0; i < 16; ++i) { e[i] = ex2(p[i] - m); l += e[i]; }
        const bf16x8 pa0 = pack8(e), pa1 = pack8(e + 8);
        o0 = MFMA32(pa0, *(const LAS bf16x8*)(vp), o0); o1 = MFMA32(pa0, *(const LAS bf16x8*)(vp + 32 * SWA_VP), o1);
        o0 = MFMA32(pa1, *(const LAS bf16x8*)(vp + 32), o0); o1 = MFMA32(pa1, *(const LAS bf16x8*)(vp + 32 * SWA_VP + 32), o1);
    }
    l = xh_sum(l);
    l += ex2(sink2 - m);
    const float inv = 1.f / l;
    LAS bf16_t* sp = stg + (4 * h) * 64 + r;
#pragma unroll
    for (int i = 0; i < 16; ++i) { const float fi = __shfl(inv, crow(i, h)); const int ro = ((i & 3) + 8 * (i >> 2)) * 64;
        sp[ro] = f2bf(o0[i] * fi); sp[ro + 32] = f2bf(o1[i] * fi); }
    o_flush(stg, Orow0, opitch, lane);
}
#define SB_STEP(KT_, V00_, V01_, V10_, V11_) do { \
        const bool diag = ((KT_) == qb); const int k0 = 32 * (KT_) + 8 * h; float sfx[16]; \
        _Pragma("unroll") for (int i = 0; i < 16; ++i) { const float z = p[i]; float L = -(fmaxf(z, 0.f) + lg2(1.f + ex2(-fabsf(z)))); \
            if (diag) { const int kv = k0 + 16 * (i >> 3) + (i & 7); if (!(kv < q)) L = 0.f; } sfx[i] = L; } \
        _Pragma("unroll") for (int g = 0; g < 2; ++g) _Pragma("unroll") for (int j = 6; j >= 0; --j) sfx[8 * g + j] += sfx[8 * g + j + 1]; \
        const float T0 = sfx[0], T1 = sfx[8]; const float TP0 = xh_other(T0, h), TP1 = xh_other(T1, h); \
        const float off1 = (h ? 0.f : TP1) + carry, off0 = T1 + TP1 + (h ? 0.f : TP0) + carry; float e[16]; \
        _Pragma("unroll") for (int i = 0; i < 16; ++i) { float a = ex2(p[i] + sfx[i] + (i < 8 ? off0 : off1)); \
            if (diag) { const int kv = k0 + 16 * (i >> 3) + (i & 7); if (!(kv < q)) a = 0.f; } e[i] = a; } \
        carry += (T0 + T1) + (TP0 + TP1); \
        const bf16x8 pa0 = pack8(e), pa1 = pack8(e + 8); \
        o0 = MFMA32(pa0, (V00_), o0); o1 = MFMA32(pa0, (V01_), o1); o0 = MFMA32(pa1, (V10_), o0); o1 = MFMA32(pa1, (V11_), o1); } while (0)
__device__ __forceinline__ void sb_wave_lds(const bf16_t* __restrict__ Qrow0, int qpitch, const LAS unsigned char* lds, const bf16_t* __restrict__ Kb, int kpitch,
                                            const bf16_t* __restrict__ VT, int qb, int kt_base, bf16_t* __restrict__ Orow0, int opitch, int lane, LAS bf16_t* stg) {
    const int r = lane & 31, h = lane >> 5;
    const int pr = (r & ~12) | ((r & 8) >> 1) | ((r & 4) << 1);
    bf16x8 qf[4];
#pragma unroll
    for (int s = 0; s < 4; ++s) qf[s] = *(const bf16x8*)(Qrow0 + (size_t)r * qpitch + 16 * s + 8 * h);
    f32x16 o0, o1;
#pragma unroll
    for (int i = 0; i < 16; ++i) { o0[i] = 0.f; o1[i] = 0.f; }
    float carry = 0.f;
    const int q = 32 * qb + r;
    const int kt_lo = kt_base > 0 ? kt_base : 0;
    bool done = false;
    int kt = qb;
    for (; kt >= kt_lo; --kt) {
        const int rel = kt - kt_base;
        const LAS unsigned char* kp = lds + (32 * rel + pr) * AKP + 16 * h;
        const LAS unsigned char* vp = lds + SB_KB + r * SB_VP + (32 * rel + 8 * h) * 2;
        f32x16 p;
#pragma unroll
        for (int i = 0; i < 16; ++i) p[i] = 0.f;
#pragma unroll
        for (int s = 0; s < 4; ++s) p = MFMA32(*(const LAS bf16x8*)(kp + 32 * s), qf[s], p);
        SB_STEP(kt, *(const LAS bf16x8*)(vp), *(const LAS bf16x8*)(vp + 32 * SB_VP), *(const LAS bf16x8*)(vp + 32), *(const LAS bf16x8*)(vp + 32 * SB_VP + 32));
        if (__all(carry < -150.f)) { done = true; break; }
    }
    if (!done && kt >= 0) {
        const bf16_t* kp = Kb + (size_t)(32 * kt + pr) * kpitch + 8 * h;
        const bf16_t* vp = VT + (size_t)r * SEQ + 32 * kt + 8 * h;
        for (; kt >= 0; --kt) {
            bf16x8 kf[4];
#pragma unroll
            for (int s = 0; s < 4; ++s) kf[s] = *(const bf16x8*)(kp + 16 * s);
            const bf16x8 v00 = *(const bf16x8*)(vp), v01 = *(const bf16x8*)(vp + 32 * SEQ), v10 = *(const bf16x8*)(vp + 16), v11 = *(const bf16x8*)(vp + 32 * SEQ + 16);
            f32x16 p;
#pragma unroll
            for (int i = 0; i < 16; ++i) p[i] = 0.f;
#pragma unroll
            for (int s = 0; s < 4; ++s) p = MFMA32(kf[s], qf[s], p);
            SB_STEP(kt, v00, v01, v10, v11);
            if (__all(carry < -150.f)) break;
            kp -= (size_t)32 * kpitch; vp -= 32;
        }
    }
    LAS bf16_t* sp = stg + (4 * h) * 64 + r;
#pragma unroll
    for (int i = 0; i < 16; ++i) { const int ro = ((i & 3) + 8 * (i >> 2)) * 64; sp[ro] = f2bf(o0[i]); sp[ro + 32] = f2bf(o1[i]); }
    o_flush(stg, Orow0, opitch, lane);
}
#undef SB_STEP

#define XB_TMO      128
#define XB_XCNT(j)  (256  + 64 * (j))
#define XB_XSUB(j)  (1280 + 64 * (j))
#define XB_XGEN(j)  (2304 + 64 * (j))
#define XB_TOP      3328
#define XB_TOPGEN   3392
#define XCD_BAR_WORDS 3456
#define XB_SPIN_CAP (1u << 18)

__device__ __forceinline__ unsigned xb_ld(unsigned* p)              { return __hip_atomic_load(p, __ATOMIC_RELAXED, __HIP_MEMORY_SCOPE_AGENT); }
__device__ __forceinline__ unsigned xb_add(unsigned* p, unsigned v) { return __hip_atomic_fetch_add(p, v, __ATOMIC_RELAXED, __HIP_MEMORY_SCOPE_AGENT); }
__device__ __forceinline__ unsigned xb_xcc_id() { return (unsigned)__builtin_amdgcn_s_getreg((3 << 11) | 20) & 0xFu; }
#define XB_SPIN(cond, bar) do { unsigned _sp = 0; while (cond) { __builtin_amdgcn_s_sleep(1); \
    if ((++_sp & 255u) == 0u) { if (xb_ld(&(bar)[XB_TMO])) break; if (_sp > XB_SPIN_CAP) { atomicAdd(&(bar)[XB_TMO], 1u); break; } } } } while (0)

struct XcdBarrier {
    unsigned* bar; unsigned x;
    volatile LAS unsigned* st;
};

__device__ __forceinline__ XcdBarrier xcd_barrier_post(unsigned* bar, volatile LAS unsigned* st) {
    XcdBarrier b; b.bar = bar; b.x = xb_xcc_id(); b.st = st;
    if (threadIdx.x == 0) (void)xb_add(&bar[XB_XCNT(b.x)], 1u);
    return b;
}
__device__ __forceinline__ void xcd_barrier_complete(unsigned* bar, unsigned x, unsigned& nloc, unsigned& nx) {
    const unsigned G = gridDim.x * gridDim.y * gridDim.z;
    unsigned sum, cnt, mine, sp = 0u;
    for (;;) {
        sum = 0u; cnt = 0u; mine = 0u;
#pragma unroll
        for (unsigned j = 0; j < 16; ++j) { const unsigned c = xb_ld(&bar[XB_XCNT(j)]); sum += c; cnt += (c > 0u) ? 1u : 0u; mine = (j == x) ? c : mine; }
        if (sum == G) break;
        __builtin_amdgcn_s_sleep(1);
        if ((++sp & 255u) == 0u) { if (xb_ld(&bar[XB_TMO])) break; if (sp > XB_SPIN_CAP) { atomicAdd(&bar[XB_TMO], 1u); break; } }
    }
    nloc = mine > 0u ? mine : 1u; nx = cnt > 0u ? cnt : 1u;
}

__device__ __forceinline__ void xcd_barrier(const XcdBarrier& b) {
    asm volatile("s_waitcnt vmcnt(0)" ::: "memory");
    __syncthreads();
    if (threadIdx.x == 0) {
        unsigned* bar = b.bar;
        __builtin_amdgcn_s_waitcnt(0);
        unsigned nloc = b.st[0], nx = b.st[1];
        if (nloc == 0u) { xcd_barrier_complete(bar, b.x, nloc, nx); b.st[0] = nloc; b.st[1] = nx; }
        const unsigned old = xb_add(&bar[XB_XSUB(b.x)], 1u);
        const unsigned gen = old / nloc;
        if (old + 1u == (gen + 1u) * nloc) {
            __builtin_amdgcn_fence(__ATOMIC_RELEASE, "agent");
            asm volatile("s_waitcnt vmcnt(0)" ::: "memory");
            const unsigned og = xb_add(&bar[XB_TOP], 1u);
            const unsigned tg = og / nx;
            if (og + 1u == (tg + 1u) * nx) xb_add(&bar[XB_TOPGEN], 1u);
            else XB_SPIN(xb_ld(&bar[XB_TOPGEN]) == tg, bar);
            __builtin_amdgcn_fence(__ATOMIC_ACQUIRE, "agent");
            xb_add(&bar[XB_XGEN(b.x)], 1u);
            asm volatile("s_waitcnt vmcnt(0)" ::: "memory");
        } else {
            XB_SPIN(xb_ld(&bar[XB_XGEN(b.x)]) == gen, bar);
            __builtin_amdgcn_fence(__ATOMIC_ACQUIRE, "agent");
            asm volatile("s_waitcnt vmcnt(0)" ::: "memory");
        }
    }
    __syncthreads();
}

__global__ void __launch_bounds__(NTHREADS, 2) fwd(Params P) {
    extern __shared__ __attribute__((aligned(16))) unsigned char lds_raw[];
    LAS unsigned char* lds = (LAS unsigned char*)lds_raw;
    constexpr int G = 256, NGW = G * NWAVES, gthreads = G * NTHREADS;
    const int bx = blockIdx.x;
#if MK_COOP
    cooperative_groups::grid_group grid = cooperative_groups::this_grid();
    volatile LAS unsigned* MISC = (volatile LAS unsigned*)(lds + MISC_OFF);
    if (threadIdx.x < 64) MISC[threadIdx.x] = 0u;
    __syncthreads();
    XcdBarrier bar = xcd_barrier_post((unsigned*)(P.ws + WS_CTL) + CW_BAR, MISC + 8);
#endif
    for (int ph = P.ph_lo; ph < P.ph_hi; ++ph) {
        const int nrep = ((ph >= 1 && ph <= 6 && ((ph - 1) == MK_REP_K || (MK_REP_K == 6 && ph == 3))) || (ph == 0 && MK_REP_K == 7)) ? MK_REP_N : 1;
        for (int rep = 0; rep < nrep; ++rep) {
        int tid_o = threadIdx.x; asm volatile("" : "+v"(tid_o));
        const int tid = tid_o, lane = tid & 63, wave = __builtin_amdgcn_readfirstlane(tid >> 6);
        const int gw = bx * NWAVES + wave, gtid = bx * NTHREADS + tid;
        LAS bf16_t* stg = (LAS bf16_t*)(lds + 122880 + wave * 4096);
        unsigned char* ws = P.ws; asm volatile("" : "+s"(ws));
        unsigned* ctl = (unsigned*)(ws + WS_CTL);
        bf16_t* XN = (bf16_t*)(ws + WS_XN); bf16_t* H = (bf16_t*)(ws + WS_H);
        bf16_t* QC = (bf16_t*)(ws + WS_QC); bf16_t* KC = (bf16_t*)(ws + WS_KC);
        bf16_t* VTC = (bf16_t*)(ws + WS_VTC); bf16_t* VTA = (bf16_t*)(ws + WS_VTA); bf16_t* VTD = (bf16_t*)(ws + WS_VTD);
        bf16_t* Y = (bf16_t*)(ws + WS_Y);
        if (ph == 0) {
            {
                LAS float* scr = (LAS float*)(lds + wave * 16384);
                constexpr int I_IN = (DM / 64) * (DIN / 32), I_OUT = (DM / 64) * (DM / 32), I_UQ = (256 / 64) * (384 / 32), I_UKV = (128 / 64) * (512 / 32), I_L = I_IN + I_OUT + I_UQ + I_UKV;
                for (int it = gw; it < NLAYER * I_L; it += NGW) {
                    const int l = it / I_L; int v = it - l * I_L;
                    if (v < I_IN) { wT_item(P.w_in + (size_t)l * DM * DIN, DM, DIN, P.norm_pre + l * DM, (bf16_t*)(ws + WS_WIN) + (size_t)l * DINP * DM, C_AQ, C_AQ + 256, C_DQ, C_DQ + 256, SC64, scr, v, lane); continue; } v -= I_IN;
                    if (v < I_OUT) { wT_item(P.w_out + (size_t)l * DM * DM, DM, DM, P.g_grp + l * DM, (bf16_t*)(ws + WS_WOUT) + (size_t)l * DM * DM, 0, 0, 0, 0, 1.f, scr, v, lane); continue; } v -= I_OUT;
                    if (v < I_UQ) { wT_item(P.w_uq + (size_t)l * 256 * 384, 256, 384, P.g_cq + l * 256, (bf16_t*)(ws + WS_WUQ + (size_t)l * 262144), 0, 0, 0, 0, 1.f, scr, v, lane); continue; } v -= I_UQ;
                    wT_item(P.w_ukv + (size_t)l * 128 * 512, 128, 512, P.g_ckv + l * 128, (bf16_t*)(ws + WS_WUKV + (size_t)l * 131072), 0, 0, 0, 0, 1.f, scr, v, lane);
                }
                for (int it = gtid; it < NLAYER * (DINP - DIN) * (DM / 8); it += gthreads) { const int l = it / ((DINP - DIN) * (DM / 8)), v = it - l * ((DINP - DIN) * (DM / 8));
                    *(u32x4*)((bf16_t*)(ws + WS_WIN) + (size_t)l * DINP * DM + (size_t)DIN * DM + (size_t)v * 8) = (u32x4){0u, 0u, 0u, 0u}; }
            }
            { const float* __restrict__ xr = P.x; bf16_t* __restrict__ xo = XN;
#pragma unroll 2
              for (int mrow = gw; mrow < M_TOK; mrow += NGW) rms_row_to_bf16(xr + (size_t)mrow * DM, xo + (size_t)mrow * DM, lane); }
        } else {
            const int l = (ph - 1) / 6, k = (ph - 1) % 6;
            if (k == 0 || k == 4) {
                if (k == 0) {
                    pg8::Gemm g{XN, (const bf16_t*)(ws + WS_WIN) + (size_t)l * DINP * DM, M_TOK, DINP, DM}; pg8::StaticOrder S; S.init(M_TOK, DINP, G, bx);
                    pg8::EpiBf16<0> E{H, DINP, nullptr, 0, 0, 1.f};
                    pg8::gemm_phase<pg8::EpiBf16<0>, pg8::StaticOrder, true, true>(lds, g, S, E);
                } else {
                    pg8::Gemm g{XN, (const bf16_t*)(ws + WS_WOUT) + (size_t)l * DM * DM, M_TOK, DM, DM}; pg8::StaticOrder S; S.init(M_TOK, DM, G, bx);
                    pg8::EpiBf16<0> E{Y, DM, nullptr, 0, 0, 1.f};
                    pg8::gemm_phase<pg8::EpiBf16<0>, pg8::StaticOrder, true, true>(lds, g, S, E);
                }
            } else if (k == 1) {
                const bf16_t* WUQ = (const bf16_t*)(ws + WS_WUQ + (size_t)l * 262144);
                const bf16_t* WUKV = (const bf16_t*)(ws + WS_WUKV + (size_t)l * 131072);
                {
                    const int hh = bx & 3, tg = bx >> 2;
                    u32x4 wq[6], wk[4];
#pragma unroll
                    for (int i = 0; i < 6; ++i) { const int c = tid + 512 * i, row = c >> 5, cc = c & 31; wq[i] = *(const u32x4*)(WUQ + (size_t)(hh * 96 + row) * 256 + 8 * cc); }
#pragma unroll
                    for (int i = 0; i < 4; ++i) { const int c = tid + 512 * i, row = c >> 4, cc = c & 15; wk[i] = *(const u32x4*)(WUKV + (size_t)(hh * 128 + row) * 128 + 8 * cc); }
#pragma unroll
                    for (int i = 0; i < 6; ++i) { const int c = tid + 512 * i, row = c >> 5, cc = c & 31; *(LAS u32x4*)(lds + row * WQP + 16 * cc) = wq[i]; }
#pragma unroll
                    for (int i = 0; i < 4; ++i) { const int c = tid + 512 * i, row = c >> 4, cc = c & 15; *(LAS u32x4*)(lds + WQ_BYTES + row * WKP + 16 * cc) = wk[i]; }
                    __syncthreads();
                    const int tb = 8 * tg + wave;
                    mq_unit(H, lds, P.pos, QC, tb, hh, lane);
                    mkv_unit(H, lds + WQ_BYTES, P.pos, KC, VTC, tb, hh, lane, stg);
                }
                constexpr int NTB = M_TOK / 32;
                constexpr int U_VTA = NTB * 2, U_VTD = NTB * 4, U_CONV = M_TOK / 8;
                constexpr int U_ALL = U_VTA + U_VTD + U_CONV;
                for (int u = gw; u < U_ALL; u += NGW) {
                    int v = u;
                    if (v < U_VTA) { vt_unit(H, C_AV, 2, VTA, v >> 1, v & 1, lane, stg); continue; } v -= U_VTA;
                    if (v < U_VTD) { vt_unit(H, C_DV, 4, VTD, v >> 2, v & 3, lane, stg); continue; } v -= U_VTD;
                    conv_unit(H, P.conv_w + l * 768, P.conv_b + l * 256, Y, v, lane);
                }
            } else if (k == 2) {
                if (rep == 0 || MK_REP_K == 2)
                for (int pu = bx; pu < 256; pu += G) {
                    const int bh = pu & 7, Gq = pu >> 3;
                    mla_unit_blk(QC, KC, VTC, Y, bh, 63 - Gq, lds, tid);
                    mla_unit_blk(QC, KC, VTC, Y, bh, Gq, lds, tid);
                }
                if (rep == 0 || MK_REP_K == 6) {
                    const int bh = bx & 7, G8 = bx >> 3, b = bh >> 2, hh = bh & 3, qb = 8 * G8 + wave;
                    const size_t row0 = (size_t)b * SEQ + 32 * qb;
                    LAS bf16_t* ostg = (LAS bf16_t*)(lds + STG_OFF + wave * 4096);
                    {
                        const int kvh = hh >> 1;
                        const bf16_t* Kb = H + (size_t)b * SEQ * DINP + C_AK + kvh * 64;
                        const bf16_t* VT = VTA + (size_t)(b * 2 + kvh) * 64 * SEQ;
                        stage_kv64<SWA_NK, SWA_VP>(Kb, DINP, VT, 256 * G8 - 128, lds, tid);
                        __syncthreads();
                        swa_wave_lds(H + row0 * DINP + C_AQ + hh * 64, DINP, lds, qb, 8 * G8 - 4, P.sinks[l * 4 + hh] * LOG2E, Y + row0 * DM + hh * 64, DM, lane, ostg);
                        __syncthreads();
                    }
                    {
                        const bf16_t* Kb = H + (size_t)b * SEQ * DINP + C_DK + hh * 64;
                        const bf16_t* VT = VTD + (size_t)(b * 4 + hh) * 64 * SEQ;
                        stage_kv64<SB_NK, SB_VP>(Kb, DINP, VT, 256 * G8 - 192, lds, tid);
                        __syncthreads();
                        sb_wave_lds(H + row0 * DINP + C_DQ + hh * 64, DINP, lds, Kb, DINP, VT, qb, 8 * G8 - 6, Y + row0 * DM + 768 + hh * 64, DM, lane, ostg);
                        __syncthreads();
                    }
                }
            } else if (k == 3) {
                const bf16_t* __restrict__ Yr = Y; const bf16_t* __restrict__ Hr = H; bf16_t* __restrict__ XNw = XN;
#pragma unroll 2
                for (int mrow = gw; mrow < M_TOK; mrow += NGW) {
                    const u32x4* yp = (const u32x4*)(Yr + (size_t)mrow * DM) + 2 * lane;
                    const u32x4* gp = (const u32x4*)(Hr + (size_t)mrow * DINP + C_GATE) + 2 * lane;
                    const u32x4 y0 = yp[0], y1 = yp[1], g0 = gp[0], g1 = gp[1];
                    float yv[16], gv[16];
#pragma unroll
                    for (int j = 0; j < 4; ++j) { yv[2 * j] = bflo(y0[j]); yv[2 * j + 1] = bfhi(y0[j]); yv[8 + 2 * j] = bflo(y1[j]); yv[8 + 2 * j + 1] = bfhi(y1[j]);
                                                  gv[2 * j] = bflo(g0[j]); gv[2 * j + 1] = bfhi(g0[j]); gv[8 + 2 * j] = bflo(g1[j]); gv[8 + 2 * j + 1] = bfhi(g1[j]); }
                    float ss = 0.f;
#pragma unroll
                    for (int j = 0; j < 16; ++j) ss += yv[j] * yv[j];
                    ss += __shfl_xor(ss, 1); ss += __shfl_xor(ss, 2); ss += __shfl_xor(ss, 4); ss += __shfl_xor(ss, 8);
                    const float rs = rsqrtf(ss * (1.f / 256.f) + EPS);
                    float o[16];
#pragma unroll
                    for (int j = 0; j < 16; ++j) { const float gg = gv[j]; o[j] = yv[j] * rs * gg * __builtin_amdgcn_rcpf(1.f + ex2(-gg * LOG2E)); }
                    u32x4 w0, w1;
#pragma unroll
                    for (int j = 0; j < 4; ++j) { w0[j] = pk2(o[2 * j], o[2 * j + 1]); w1[j] = pk2(o[8 + 2 * j], o[8 + 2 * j + 1]); }
                    u32x4* op = (u32x4*)(XNw + (size_t)mrow * DM) + 2 * lane;
                    op[0] = w0; op[1] = w1;
                }
            } else {
                const float* base = P.x;
                const float* gpost = P.g_post + l * DM;
                for (int mrow0 = gw; mrow0 < M_TOK; mrow0 += 2 * NGW) {
                    f32x4 zz[2][4], xv[2][4]; float s1[2] = {0.f, 0.f}, s2[2] = {0.f, 0.f};
                    const bool two = (mrow0 + NGW < M_TOK);
#pragma unroll
                    for (int rr = 0; rr < 2; ++rr) { const int mrow = (rr == 0 || two) ? mrow0 + rr * NGW : mrow0;
#pragma unroll
                        for (int j = 0; j < 4; ++j) { const u32x2 w = ((const u32x2*)(Y + (size_t)mrow * DM))[lane + 64 * j]; zz[rr][j] = (f32x4){bflo(w.x), bfhi(w.x), bflo(w.y), bfhi(w.y)};
                            if (l == 0) xv[rr][j] = ((const f32x4*)(base + (size_t)mrow * DM))[lane + 64 * j];
                            else { const u32x2 xb = ((const u32x2*)(P.out + (size_t)mrow * DM))[lane + 64 * j]; xv[rr][j] = (f32x4){bflo(xb.x), bfhi(xb.x), bflo(xb.y), bfhi(xb.y)}; } } }
                    f32x4 gpv[4];
#pragma unroll
                    for (int j = 0; j < 4; ++j) gpv[j] = ((const f32x4*)gpost)[lane + 64 * j];
#pragma unroll
                    for (int rr = 0; rr < 2; ++rr)
#pragma unroll
                        for (int j = 0; j < 4; ++j) s1[rr] += (zz[rr][j].x * zz[rr][j].x + zz[rr][j].y * zz[rr][j].y) + (zz[rr][j].z * zz[rr][j].z + zz[rr][j].w * zz[rr][j].w);
                    const float rz0 = rsqrtf(wave_sum(s1[0]) * (1.f / DM) + EPS), rz1 = rsqrtf(wave_sum(s1[1]) * (1.f / DM) + EPS);
#pragma unroll
                    for (int rr = 0; rr < 2; ++rr) { const float rz = rr ? rz1 : rz0;
#pragma unroll
                        for (int j = 0; j < 4; ++j) { xv[rr][j] = xv[rr][j] + zz[rr][j] * rz * gpv[j];
                            s2[rr] += (xv[rr][j].x * xv[rr][j].x + xv[rr][j].y * xv[rr][j].y) + (xv[rr][j].z * xv[rr][j].z + xv[rr][j].w * xv[rr][j].w); } }
#pragma unroll
                    for (int rr = 0; rr < 2; ++rr) { if (rr == 1 && !two) break; const int mrow = mrow0 + rr * NGW;
#pragma unroll
                        for (int j = 0; j < 4; ++j) {
                            if (l + 1 < NLAYER) { u32x2 o; o.x = pk2(xv[rr][j].x, xv[rr][j].y); o.y = pk2(xv[rr][j].z, xv[rr][j].w); ((u32x2*)(P.out + (size_t)mrow * DM))[lane + 64 * j] = o; }
                            else ((f32x4*)(P.out + (size_t)mrow * DM))[lane + 64 * j] = xv[rr][j]; } }
                    if (l + 1 < NLAYER) {
                        const float r0 = rsqrtf(wave_sum(s2[0]) * (1.f / DM) + EPS), r1 = rsqrtf(wave_sum(s2[1]) * (1.f / DM) + EPS);
#pragma unroll
                        for (int rr = 0; rr < 2; ++rr) { if (rr == 1 && !two) break; const int mrow = mrow0 + rr * NGW; const float rs = rr ? r1 : r0;
#pragma unroll
                            for (int j = 0; j < 4; ++j) { u32x2 o; o.x = pk2(xv[rr][j].x * rs, xv[rr][j].y * rs); o.y = pk2(xv[rr][j].z * rs, xv[rr][j].w * rs); ((u32x2*)(XN + (size_t)mrow * DM))[lane + 64 * j] = o; } }
                    }
                }
            }
            }
        }
        if (ph + 1 < P.ph_hi) {
#if MK_COOP
            if (P.ph_hi < 0) grid.sync();
            xcd_barrier(bar);
#endif
        }
    }
}
}

extern "C" void kernel_launch(void* const* d_in, const int* in_sizes, int n_in, void* d_out, int out_size, void* d_ws, size_t ws_size, hipStream_t stream) {
    using namespace mk;
    static int grid = 0;
    if (grid == 0) {
        if (n_in != 14 || out_size != M_TOK * DM || ws_size < WS_END) { fprintf(stderr, "kernel_launch: unexpected shapes (n_in %d out %d ws %zu)\n", n_in, out_size, ws_size); grid = -1; return; }
        int dev = 0, cus = 0, per_cu = 0;
        (void)hipGetDevice(&dev); (void)hipDeviceGetAttribute(&cus, hipDeviceAttributeMultiprocessorCount, dev);
        if (hipFuncSetAttribute((const void*)fwd, hipFuncAttributeMaxDynamicSharedMemorySize, LDS_BYTES) != hipSuccess) { fprintf(stderr, "kernel_launch: hipFuncSetAttribute failed\n"); grid = -1; return; }
        if (hipOccupancyMaxActiveBlocksPerMultiprocessor(&per_cu, (const void*)fwd, NTHREADS, LDS_BYTES) != hipSuccess || per_cu < 1) { fprintf(stderr, "kernel_launch: occupancy query says %d\n", per_cu); per_cu = 1; }
        (void)hipGetLastError();
        if (cus < 256) { fprintf(stderr, "kernel_launch: built for a 256-CU device (one workgroup per CU), found %d CUs\n", cus); grid = -1; return; }
        grid = 256;
    }
    if (grid < 0) return;
    (void)hipMemsetAsync((char*)d_ws + WS_CTL, 0, CTL_BYTES, stream);
    Params p{};
    p.x = (const float*)d_in[0]; p.pos = (const int*)d_in[1]; p.norm_pre = (const float*)d_in[2]; p.w_in = (const float*)d_in[3]; p.sinks = (const float*)d_in[4];
    p.conv_w = (const float*)d_in[5]; p.conv_b = (const float*)d_in[6]; p.g_cq = (const float*)d_in[7]; p.w_uq = (const float*)d_in[8]; p.g_ckv = (const float*)d_in[9];
    p.w_ukv = (const float*)d_in[10]; p.g_grp = (const float*)d_in[11]; p.w_out = (const float*)d_in[12]; p.g_post = (const float*)d_in[13];
    p.out = (float*)d_out; p.ws = (unsigned char*)d_ws;
    constexpr int NPH = 1 + 6 * NLAYER;
#if MK_COOP
    p.ph_lo = 0; p.ph_hi = NPH;
    void* args[] = {&p};
    hipError_t e = hipLaunchCooperativeKernel((const void*)fwd, dim3(grid), dim3(NTHREADS), args, LDS_BYTES, stream);
    if (e != hipSuccess) fprintf(stderr, "kernel_launch: cooperative launch failed: %s (grid %d)\n", hipGetErrorString(e), grid);
#else
    for (int ph = 0; ph < NPH; ++ph) { p.ph_lo = ph; p.ph_hi = ph + 1; hipLaunchKernelGGL(fwd, dim3(grid), dim3(NTHREADS), LDS_BYTES, stream, p); }
#endif
}
```

```cpp
#include <hip/hip_runtime.h>
#include <hip/hip_cooperative_groups.h>
#include <cstdio>
#include <cstdint>
#include <cmath>
namespace pg8 {
#define PG8_LAS __attribute__((address_space(3)))
typedef unsigned short bf16_t;
typedef short bf16x8 __attribute__((ext_vector_type(8)));
typedef float f32x4 __attribute__((ext_vector_type(4)));
typedef unsigned u32x4 __attribute__((ext_vector_type(4)));
constexpr int BM = 256, BK = 64, HALF = 128, HTB = HALF * BK * 2  , STAGE_BYTES = 8 * HTB, NXCD = 8, WGM = 8;

__host__ __device__ __forceinline__ int lds_byte(int r, int c) { const int st = (r >> 4) * 2 + (c >> 5), rr = r & 15, cc = c & 31, ob = rr * 64 + cc * 2; return st * 1024 + (ob ^ (((ob >> 9) & 1) << 5)); }
__host__ __device__ __forceinline__ void stage_rc(int b, int& R, int& C) { const int st = b / 1024, sb = b % 1024, swz = sb ^ (((sb >> 9) & 1) << 5); R = (st >> 1) * 16 + swz / 64; C = (st & 1) * 32 + (swz % 64) / 2; }
__host__ __device__ __forceinline__ int perm32(int rho) { const int n = rho >> 4, i = rho & 15; return 8 * (i >> 2) + 4 * n + (i & 3); }

struct Unit { int pm, pn; };
struct Gemm { const bf16_t* A; const bf16_t* Bt; int M, N, K; };

struct StaticOrder {
    int nM, nN, nwg, G, c;
    __host__ __device__ void init(int M, int N, int G_, int c_) { nM = M / BM; nN = N / BM; nwg = nM * nN; G = G_; c = c_; }
    __host__ __device__ bool next(int i, Unit& u) const {
        const long L = (long)i * G + c; if (L >= nwg) return false;
        int wgid = (int)L; { const int q = nwg / NXCD, r = nwg % NXCD, xcd = wgid % NXCD, off = wgid / NXCD; wgid = (xcd < r ? xcd * (q + 1) : r * (q + 1) + (xcd - r) * q) + off; }
        const int nig = WGM * nN, gid = wgid / nig, fm = gid * WGM, gsz = (nM - fm) < WGM ? (nM - fm) : WGM;
        u.pm = fm + ((wgid % nig) % gsz); u.pn = (wgid % nig) / gsz; return true;
    }
    __device__ __forceinline__ void a_ready(const Unit&) const {}
    __device__ __forceinline__ void done(const Unit&) const {}
};

__device__ __forceinline__ unsigned cvt_pk_bf16(float lo, float hi) { unsigned r; asm volatile("v_cvt_pk_bf16_f32 %0, %1, %2" : "=v"(r) : "v"(lo), "v"(hi)); return r; }
typedef float f32x2 __attribute__((ext_vector_type(2)));
__device__ __forceinline__ f32x2 gelu_pk(f32x2 v) {
    const f32x2 av = __builtin_elementwise_abs(v), d = av * 0.2316418882f + 1.0f;
    f32x2 t; t.x = __builtin_amdgcn_rcpf(d.x); t.y = __builtin_amdgcn_rcpf(d.y);
    f32x2 q = t * 0.5307027145f + (-0.7265760135f); q = q * t + 0.7107068705f; q = q * t + (-0.142248368f); q = q * t + 0.127414796f; q = q * t;
    const f32x2 s = (v * v) * (-0.72134752044f);
    f32x2 e; e.x = __builtin_amdgcn_exp2f(s.x); e.y = __builtin_amdgcn_exp2f(s.y);
    const f32x2 m = v * (q * e), r = v - m;
    f32x2 o; o.x = v.x < 0.f ? m.x : r.x; o.y = v.y < 0.f ? m.y : r.y; return o;
}

template <int ACT  > struct EpiBf16 {
    static constexpr bool PERM = true, AFTER_DRAIN = false; static_assert(ACT == 0 || ACT == 1, "EpiBf16: ACT is 0 (none) or 1 (gelu_pk)");
    bf16_t* O; int ldc; const float* bias; int split_cols; size_t split_stride; float scale0;
    __device__ __forceinline__ void operator()(const f32x4 (&acc)[2][2][4][2], const Unit& u, int wr, int wc, int fr, int fq) const {
        const int row0 = u.pm * BM + wr * 64 + fr; int colt = u.pn * BM; bf16_t* base = O;
        float sc = 1.f; if (split_cols) { const int t = colt / split_cols; base += (size_t)t * split_stride; colt -= t * split_cols; if (t == 0) sc = scale0; }
        const int col0 = colt + wc * 32 + 8 * fq, bcol0 = u.pn * BM + wc * 32 + 8 * fq;
        f32x4 bv[2][2];
#pragma unroll
        for (int bj = 0; bj < 2; ++bj)
#pragma unroll
            for (int n = 0; n < 2; ++n) bv[bj][n] = bias ? *(const f32x4*)(bias + bcol0 + bj * HALF + 4 * n) : (f32x4){0.f, 0.f, 0.f, 0.f};
#pragma unroll
        for (int ai = 0; ai < 2; ++ai)
#pragma unroll
            for (int m = 0; m < 4; ++m) { bf16_t* rowp = base + (size_t)(row0 + ai * HALF + m * 16) * ldc + col0;
#pragma unroll
                for (int bj = 0; bj < 2; ++bj) { f32x4 v0 = acc[ai][bj][m][0] + bv[bj][0], v1 = acc[ai][bj][m][1] + bv[bj][1];
                    if (ACT == 1) { f32x2 a = gelu_pk((f32x2){v0[0], v0[1]}), b = gelu_pk((f32x2){v0[2], v0[3]}), c = gelu_pk((f32x2){v1[0], v1[1]}), d = gelu_pk((f32x2){v1[2], v1[3]});
                        v0 = (f32x4){a.x, a.y, b.x, b.y}; v1 = (f32x4){c.x, c.y, d.x, d.y}; }
                    v0 = v0 * sc; v1 = v1 * sc; u32x4 w; w.x = cvt_pk_bf16(v0[0], v0[1]); w.y = cvt_pk_bf16(v0[2], v0[3]); w.z = cvt_pk_bf16(v1[0], v1[1]); w.w = cvt_pk_bf16(v1[2], v1[3]);
                    *(u32x4*)(rowp + bj * HALF) = w; } }
    }
};
template <class Epi, class Sched, bool ALIGN_EPI = false, bool SP2 = false>
__device__ __forceinline__ void gemm_phase(PG8_LAS unsigned char* lds, const Gemm g, const Sched& S, const Epi& E) {
    int tid_o = threadIdx.x; asm volatile("" : "+v"(tid_o));
    const int tid = tid_o, wid = __builtin_amdgcn_readfirstlane(tid >> 6), lane = tid & 63, wr = wid >> 2, wc = wid & 3, fr = lane & 15, fq = lane >> 4;
    const int K = g.K, nt = K / BK;
    unsigned voffA[2], voffB[2];
#pragma unroll
    for (int i = 0; i < 2; ++i) { int R, C; stage_rc(tid * 16 + i * 8192, R, C); const int Rb = Epi::PERM ? ((R & ~31) + perm32(R & 31)) : R;
        voffA[i] = (unsigned)(R * K + C) * 2u; voffB[i] = (unsigned)(Rb * K + C) * 2u; }
    const size_t kstep = (size_t)(BK * 2);
    const size_t hstep = (size_t)HALF * K * 2;
    const size_t tstep = 2 * hstep;
    const unsigned ldsw = (unsigned)wid * 1024u;
    const int aoff = lds_byte(wr * 64 + fr, fq * 8), boff = lds_byte(wc * 32 + fr, fq * 8);
#define PG8_SA(b, h) (((b) * 2 + (h)) * HTB)
#define PG8_SB(b, h) ((4 + (b) * 2 + (h)) * HTB)
#define PG8_STAGE(bufoff, gbase, voff) do { _Pragma("unroll") for (int _i = 0; _i < 2; ++_i) \
        __builtin_amdgcn_global_load_lds((const unsigned*)((const char*)(gbase) + (voff)[_i]), (PG8_LAS unsigned*)(lds + (bufoff) + ldsw + _i * 8192), 16, 0, 0); } while (0)
#define PG8_LDA(dst, b, h) do { _Pragma("unroll") for (int m = 0; m < 4; ++m) _Pragma("unroll") for (int k = 0; k < 2; ++k) dst[m][k] = *(const PG8_LAS bf16x8*)(lds + PG8_SA(b, h) + aoff + m * 2048 + k * 1024); } while (0)
#define PG8_LDB(dst, b, h) do { _Pragma("unroll") for (int n = 0; n < 2; ++n) _Pragma("unroll") for (int k = 0; k < 2; ++k) dst[n][k] = *(const PG8_LAS bf16x8*)(lds + PG8_SB(b, h) + boff + n * 2048 + k * 1024); } while (0)
#define PG8_MMA(ai, bj, At, Bt) do { __builtin_amdgcn_s_setprio(1); _Pragma("unroll") for (int m = 0; m < 4; ++m) _Pragma("unroll") for (int n = 0; n < 2; ++n) _Pragma("unroll") for (int k = 0; k < 2; ++k) \
        acc[ai][bj][m][n] = __builtin_amdgcn_mfma_f32_16x16x32_bf16(Bt[n][k], At[m][k], acc[ai][bj][m][n], 0, 0, 0); __builtin_amdgcn_s_setprio(0); } while (0)
#define PG8_WAIT_V(n) asm volatile("s_waitcnt vmcnt(" #n ")" ::: "memory")
#define PG8_WAIT_L(n) asm volatile("s_waitcnt lgkmcnt(" #n ")" ::: "memory")
#define PG8_BAR __builtin_amdgcn_s_barrier()
#define PG8_SCHED __builtin_amdgcn_sched_barrier(0)
    Unit cur, nxt; int ui = 0;
    if (!S.next(0, cur)) return;
    f32x4 acc[2][2][4][2];
#pragma unroll
    for (int a = 0; a < 2; ++a)
#pragma unroll
        for (int b = 0; b < 2; ++b)
#pragma unroll
            for (int m = 0; m < 4; ++m)
#pragma unroll
                for (int n = 0; n < 2; ++n) acc[a][b][m][n] = (f32x4){0.f, 0.f, 0.f, 0.f};
    bf16x8 At[4][2], B0[2][2], B1[2][2];
    const char* cA = (const char*)g.A + (size_t)cur.pm * tstep; const char* cB = (const char*)g.Bt + (size_t)cur.pn * tstep;
    S.a_ready(cur);
    if constexpr (SP2) {
        PG8_STAGE(PG8_SB(0, 0), cB, voffB); PG8_STAGE(PG8_SB(0, 1), cB + hstep, voffB); PG8_STAGE(PG8_SA(0, 0), cA, voffA); PG8_STAGE(PG8_SA(0, 1), cA + hstep, voffA);
        if (wr == 1) PG8_BAR;
        PG8_WAIT_V(2); PG8_BAR;
        PG8_STAGE(PG8_SB(1, 0), cB + kstep, voffB); PG8_STAGE(PG8_SA(1, 0), cA + kstep, voffA); PG8_STAGE(PG8_SB(1, 1), cB + hstep + kstep, voffB);
        PG8_WAIT_V(6); PG8_BAR;
    } else {
        PG8_STAGE(PG8_SB(0, 0), cB, voffB); PG8_STAGE(PG8_SA(0, 0), cA, voffA); PG8_STAGE(PG8_SB(0, 1), cB + hstep, voffB); PG8_STAGE(PG8_SA(0, 1), cA + hstep, voffA);
        if (wr == 1) PG8_BAR;
        PG8_WAIT_V(4); PG8_BAR;
        PG8_STAGE(PG8_SB(1, 0), cB + kstep, voffB); PG8_STAGE(PG8_SA(1, 0), cA + kstep, voffA); PG8_STAGE(PG8_SB(1, 1), cB + hstep + kstep, voffB);
        PG8_WAIT_V(6); PG8_BAR;
    }
    for (;;) {
        const bool has_next = S.next(ui + 1, nxt);
        const char* nA = has_next ? (const char*)g.A + (size_t)nxt.pm * tstep : cA; const char* nB = has_next ? (const char*)g.Bt + (size_t)nxt.pn * tstep : cB;
        for (int t = 0; t < nt; t += 2) {
            const bool last = (t == nt - 2);
            const char* a1 = cA + (size_t)(t + 1) * kstep;
            const char* a2 = last ? nA : cA + (size_t)(t + 2) * kstep; const char* b2 = last ? nB : cB + (size_t)(t + 2) * kstep;
            const char* a3 = a2 + kstep; const char* b3 = b2 + kstep;
            if (last && has_next) S.a_ready(nxt);
            if constexpr (SP2) {
            PG8_LDB(B0, 0, 0); PG8_LDB(B1, 0, 1); PG8_SCHED; PG8_LDA(At, 0, 0); PG8_STAGE(PG8_SA(1, 1), a1 + hstep, voffA);
            PG8_WAIT_V(8); PG8_WAIT_L(0); PG8_BAR; PG8_MMA(0, 0, At, B0); PG8_MMA(0, 1, At, B1); PG8_BAR; PG8_SCHED;
            PG8_LDA(At, 0, 1); PG8_STAGE(PG8_SB(0, 0), b2, voffB); PG8_STAGE(PG8_SB(0, 1), b2 + hstep, voffB); PG8_STAGE(PG8_SA(0, 0), a2, voffA);
            PG8_WAIT_V(8); PG8_WAIT_L(0); PG8_BAR; PG8_MMA(1, 0, At, B0); PG8_MMA(1, 1, At, B1); PG8_BAR; PG8_SCHED;
            PG8_LDB(B0, 1, 0); PG8_LDB(B1, 1, 1); PG8_SCHED; PG8_LDA(At, 1, 0); PG8_STAGE(PG8_SA(0, 1), a2 + hstep, voffA);
            PG8_WAIT_V(8); PG8_WAIT_L(0); PG8_BAR; PG8_MMA(0, 0, At, B0); PG8_MMA(0, 1, At, B1); PG8_BAR; PG8_SCHED;
            PG8_LDA(At, 1, 1); PG8_STAGE(PG8_SB(1, 0), b3, voffB); PG8_STAGE(PG8_SB(1, 1), b3 + hstep, voffB); PG8_STAGE(PG8_SA(1, 0), a3, voffA);
            PG8_WAIT_V(8); PG8_WAIT_L(0); PG8_BAR; PG8_MMA(1, 0, At, B0); PG8_MMA(1, 1, At, B1); PG8_BAR; PG8_SCHED;
            } else {
            PG8_LDB(B0, 0, 0); PG8_SCHED; PG8_LDA(At, 0, 0); PG8_STAGE(PG8_SA(1, 1), a1 + hstep, voffA);
            PG8_WAIT_L(8); PG8_BAR; PG8_WAIT_L(0); PG8_MMA(0, 0, At, B0); PG8_BAR; PG8_SCHED;
            PG8_LDB(B1, 0, 1); PG8_STAGE(PG8_SB(0, 0), b2, voffB);
            PG8_BAR; PG8_WAIT_L(0); PG8_MMA(0, 1, At, B1); PG8_BAR;
            PG8_LDA(At, 0, 1); PG8_STAGE(PG8_SA(0, 0), a2, voffA);
            PG8_BAR; PG8_WAIT_L(0); PG8_MMA(1, 0, At, B0); PG8_BAR; PG8_SCHED;
            PG8_STAGE(PG8_SB(0, 1), b2 + hstep, voffB);
            PG8_WAIT_V(6); PG8_BAR; PG8_MMA(1, 1, At, B1); PG8_BAR;
            PG8_LDB(B0, 1, 0); PG8_SCHED; PG8_LDA(At, 1, 0); PG8_STAGE(PG8_SA(0, 1), a2 + hstep, voffA);
            PG8_WAIT_L(8); PG8_BAR; PG8_WAIT_L(0); PG8_MMA(0, 0, At, B0); PG8_BAR; PG8_SCHED;
            PG8_LDB(B1, 1, 1); PG8_STAGE(PG8_SB(1, 0), b3, voffB);
            PG8_BAR; PG8_WAIT_L(0); PG8_MMA(0, 1, At, B1); PG8_BAR;
            PG8_LDA(At, 1, 1); PG8_STAGE(PG8_SA(1, 0), a3, voffA);
            PG8_BAR; PG8_WAIT_L(0); PG8_MMA(1, 0, At, B0); PG8_BAR; PG8_SCHED;
            PG8_STAGE(PG8_SB(1, 1), b3 + hstep, voffB);
            PG8_WAIT_V(6); PG8_BAR; PG8_MMA(1, 1, At, B1); PG8_BAR;
            }
        }
        if constexpr (ALIGN_EPI) { if (wr == 0) PG8_BAR; }
        if constexpr (!Epi::AFTER_DRAIN) { E(acc, cur, wr, wc, fr, fq); S.done(cur); }
        if (!has_next) break;
#pragma unroll
        for (int a = 0; a < 2; ++a)
#pragma unroll
            for (int b = 0; b < 2; ++b)
#pragma unroll
                for (int m = 0; m < 4; ++m)
#pragma unroll
                    for (int n = 0; n < 2; ++n) acc[a][b][m][n] = (f32x4){0.f, 0.f, 0.f, 0.f};
        cur = nxt; cA = nA; cB = nB; ++ui;
        if constexpr (ALIGN_EPI) { if (wr == 1) PG8_BAR; }
    }
    PG8_WAIT_V(0);
    if constexpr (!ALIGN_EPI) { if (wr == 0) PG8_BAR; }
    PG8_BAR;
    if constexpr (Epi::AFTER_DRAIN) { E.fused(acc, cur, wr, wc, fr, fq, lds, wid, lane); S.done(cur); }
#undef PG8_SA
#undef PG8_SB
#undef PG8_STAGE
#undef PG8_LDA
#undef PG8_LDB
#undef PG8_MMA
#undef PG8_WAIT_V
#undef PG8_WAIT_L
#undef PG8_BAR
#undef PG8_SCHED
}
}
#ifndef MK_COOP
#define MK_COOP 1
#endif
#ifndef MK_REP_K
#define MK_REP_K -1
#endif
#ifndef MK_REP_N
#define MK_REP_N 1
#endif
namespace mk {
using pg8::bf16_t; using pg8::bf16x8; using pg8::f32x4; using pg8::u32x4;
typedef float f32x16 __attribute__((ext_vector_type(16)));
typedef unsigned u32x2 __attribute__((ext_vector_type(2)));
typedef float f32x2_t __attribute__((ext_vector_type(2)));
typedef __bf16 bf16x2_t __attribute__((ext_vector_type(2)));
#define LAS __attribute__((address_space(3)))
#define MFMA32(a, b, c) __builtin_amdgcn_mfma_f32_32x32x16_bf16((a), (b), (c), 0, 0, 0)

constexpr int M_TOK = 16384, SEQ = 8192, DM = 1024, DIN = 3488, DINP = 3584, NLAYER = 2;
constexpr int C_AQ = 0, C_AK = 256, C_AV = 384, C_BB = 512, C_BC = 768, C_BX = 1024, C_CQ = 1280, C_CKV = 1536, C_CKR = 1664,
              C_DQ = 1696, C_DK = 1952, C_DV = 2208, C_GATE = 2464;
constexpr float EPS = 1e-6f, LOG2E = 1.4426950408889634f;
constexpr float SC64 = 0.125f * LOG2E;
constexpr float QSC_MLA = 0.10206207261596575f * LOG2E;
constexpr int NWAVES = 8, NTHREADS = 512;
constexpr int LDS_BYTES = 122880 + 8 * 4096 + 1024;

constexpr size_t MiB = 1u << 20;
constexpr size_t WS_CTL = 0, CTL_BYTES = 65536;
constexpr int CW_BAR = 1024;
constexpr size_t WS_WIN = 1 * MiB;
constexpr size_t WS_WOUT = 15 * MiB;
constexpr size_t WS_WUQ = 19 * MiB;
constexpr size_t WS_WUKV = 19 * MiB + 512 * 1024;
constexpr size_t WS_XN = 32 * MiB;
constexpr size_t WS_H = 64 * MiB;
constexpr size_t WS_QC = 176 * MiB;
constexpr size_t WS_KC = 188 * MiB;
constexpr size_t WS_VTC = 200 * MiB;
constexpr size_t WS_VTA = 208 * MiB;
constexpr size_t WS_VTD = 212 * MiB;
constexpr size_t WS_Y = 220 * MiB;
constexpr size_t WS_END = 252 * MiB;

struct Params {
    const float* x; const int* pos; const float* norm_pre; const float* w_in; const float* sinks; const float* conv_w; const float* conv_b;
    const float* g_cq; const float* w_uq; const float* g_ckv; const float* w_ukv; const float* g_grp; const float* w_out; const float* g_post;
    float* out; unsigned char* ws; int ph_lo, ph_hi;
};

__device__ __forceinline__ unsigned pk2(float lo, float hi) { f32x2_t v = {lo, hi}; bf16x2_t b = __builtin_convertvector(v, bf16x2_t); return __builtin_bit_cast(unsigned, b); }
__device__ __forceinline__ float bf2f(short s) { return __uint_as_float(((unsigned)(unsigned short)s) << 16); }
__device__ __forceinline__ float bflo(unsigned u) { return __uint_as_float(u << 16); }
__device__ __forceinline__ float bfhi(unsigned u) { return __uint_as_float(u & 0xffff0000u); }
__device__ __forceinline__ bf16_t f2bf(float f) { return (bf16_t)(pk2(f, 0.f) & 0xffffu); }
__device__ __forceinline__ int crow(int i, int h) { return (i & 3) + 8 * (i >> 2) + 4 * h; }
__device__ __forceinline__ float ex2(float x) { return __builtin_amdgcn_exp2f(x); }
__device__ __forceinline__ float lg2(float x) { return __builtin_amdgcn_logf(x); }
__device__ __forceinline__ float xh_max(float v) { auto rr = __builtin_amdgcn_permlane32_swap(__float_as_uint(v), __float_as_uint(v), false, false); return fmaxf(__uint_as_float(rr[0]), __uint_as_float(rr[1])); }
__device__ __forceinline__ float xh_sum(float v) { auto rr = __builtin_amdgcn_permlane32_swap(__float_as_uint(v), __float_as_uint(v), false, false); return __uint_as_float(rr[0]) + __uint_as_float(rr[1]); }
__device__ __forceinline__ float xh_other(float v, int h) { auto rr = __builtin_amdgcn_permlane32_swap(__float_as_uint(v), __float_as_uint(v), false, false); return __uint_as_float(h ? rr[0] : rr[1]); }
#define MX3(a, b, c) __builtin_fmaxf(__builtin_fmaxf((a), (b)), (c))
__device__ __forceinline__ float wave_sum(float v) {
#pragma unroll
    for (int o = 1; o < 64; o <<= 1) v += __shfl_xor(v, o);
    return v;
}
__device__ __forceinline__ bf16x8 pack8(const float* e) {
    u32x4 w; w.x = pk2(e[0], e[1]); w.y = pk2(e[2], e[3]); w.z = pk2(e[4], e[5]); w.w = pk2(e[6], e[7]);
    return __builtin_bit_cast(bf16x8, w);
}

__device__ __forceinline__ void conv_wT(const float* __restrict__ W, int K, int N, int NP, const float* __restrict__ gain, bf16_t* __restrict__ dst,
                                        int a0, int a1, int b0, int b1, float sc, int gtid, int gthreads) {
    const int k8n = K / 8; const int items = NP * k8n;
#pragma unroll 2
    for (int it = gtid; it < items; it += gthreads) {
        const int n = it % NP, k8 = it / NP;
        u32x4 o = {0u, 0u, 0u, 0u};
        if (n < N) {
            const float cs = ((n >= a0 && n < a1) || (n >= b0 && n < b1)) ? sc : 1.f;
            float v[8];
#pragma unroll
            for (int j = 0; j < 8; ++j) v[j] = W[(size_t)(k8 * 8 + j) * N + n] * gain[k8 * 8 + j] * cs;
            o.x = pk2(v[0], v[1]); o.y = pk2(v[2], v[3]); o.z = pk2(v[4], v[5]); o.w = pk2(v[6], v[7]);
        }
        *(u32x4*)(dst + (size_t)n * K + k8 * 8) = o;
    }
}
__device__ __forceinline__ void wT_item(const float* __restrict__ W, int K, int N, const float* __restrict__ gain, bf16_t* __restrict__ WT, int a0, int a1, int b0, int b1, float sc,
                                        LAS float* scr, int item, int lane) {
    const int nblk = N / 32, kb = item / nblk, nb = item - kb * nblk, k0 = 64 * kb, n0 = 32 * nb;
#pragma unroll 8
    for (int i = 0; i < 32; ++i) { const int kk = 2 * i + (lane >> 5); scr[kk * 33 + (lane & 31)] = W[(size_t)(k0 + kk) * N + n0 + (lane & 31)]; }
    const int c = lane & 7;
    float g8[8];
#pragma unroll
    for (int j = 0; j < 8; ++j) g8[j] = gain[k0 + 8 * c + j];
#pragma unroll
    for (int j = 0; j < 4; ++j) { const int n = (lane >> 3) + 8 * j, nn = n0 + n; const LAS float* sp = scr + (8 * c) * 33 + n;
        const float cs = ((nn >= a0 && nn < a1) || (nn >= b0 && nn < b1)) ? sc : 1.f;
        u32x4 o; o.x = pk2(sp[0 * 33] * g8[0] * cs, sp[1 * 33] * g8[1] * cs); o.y = pk2(sp[2 * 33] * g8[2] * cs, sp[3 * 33] * g8[3] * cs);
        o.z = pk2(sp[4 * 33] * g8[4] * cs, sp[5 * 33] * g8[5] * cs); o.w = pk2(sp[6 * 33] * g8[6] * cs, sp[7 * 33] * g8[7] * cs);
        *(u32x4*)(WT + (size_t)nn * K + k0 + 8 * c) = o; }
}
__device__ __forceinline__ void rms_row_to_bf16(const float* __restrict__ xrow, bf16_t* __restrict__ orow, int lane) {
    f32x4 v[4]; float s = 0.f;
#pragma unroll
    for (int j = 0; j < 4; ++j) { v[j] = ((const f32x4*)xrow)[lane + 64 * j]; s += (v[j].x * v[j].x + v[j].y * v[j].y) + (v[j].z * v[j].z + v[j].w * v[j].w); }
    const float rs = rsqrtf(wave_sum(s) * (1.f / DM) + EPS);
#pragma unroll
    for (int j = 0; j < 4; ++j) { u32x2 o; o.x = pk2(v[j].x * rs, v[j].y * rs); o.y = pk2(v[j].z * rs, v[j].w * rs); ((u32x2*)orow)[lane + 64 * j] = o; }
}

__device__ __forceinline__ void rope_cs(int pos, int h, float (&cs)[8], float (&sn)[8]) {
#pragma unroll
    for (int i = 0; i < 8; ++i) {
        const int f = (i & 3) + 8 * (i >> 2) + 4 * h;
        const float freq = ex2(-(float)f * 0.830482023721841f);
        const float ang = (float)pos * freq;
        const double rev = (double)ang * 0.15915494309189535;
        const float fr = (float)(rev - __builtin_rint(rev));
        cs[i] = __builtin_amdgcn_cosf(fr); sn[i] = __builtin_amdgcn_sinf(fr);
    }
}
__device__ __forceinline__ void rope_apply(f32x16& a, const float (&cs)[8], const float (&sn)[8]) {
#pragma unroll
    for (int i = 0; i < 8; ++i) { const float x1 = a[i], x2 = a[i + 8]; a[i] = x1 * cs[i] - x2 * sn[i]; a[i + 8] = x1 * sn[i] + x2 * cs[i]; }
}
__device__ __forceinline__ void store_tile_rowmajor(bf16_t* dst  , const f32x16& a, int h) {
#pragma unroll
    for (int g = 0; g < 4; ++g) { u32x2 o; o.x = pk2(a[4 * g], a[4 * g + 1]); o.y = pk2(a[4 * g + 2], a[4 * g + 3]); *(u32x2*)(dst + 8 * g + 4 * h) = o; }
}
constexpr int WQP = 528, WKP = 272, WQ_BYTES = 96 * WQP;
__device__ __forceinline__ void mq_unit(const bf16_t* __restrict__ H, const LAS unsigned char* Wl, const int* __restrict__ pos, bf16_t* __restrict__ QC, int tb, int hh, int lane) {
    const int r = lane & 31, h = lane >> 5, tok = tb * 32 + r;
    const bf16_t* src = H + (size_t)tok * DINP + C_CQ + 8 * h;
    bf16x8 bfr[16]; float ss = 0.f;
#pragma unroll
    for (int s = 0; s < 16; ++s) { bfr[s] = *(const bf16x8*)(src + 16 * s);
#pragma unroll
        for (int j = 0; j < 8; ++j) { const float v = bf2f(bfr[s][j]); ss += v * v; } }
    ss += __shfl_xor(ss, 32);
    const float rs = rsqrtf(ss * (1.f / 256.f) + EPS) * QSC_MLA;
    float cs[8], sn[8]; rope_cs(pos[tok], h, cs, sn);
    const LAS unsigned char* W = Wl + r * WQP + 16 * h;
#pragma unroll 1
    for (int nt = 0; nt < 3; ++nt) {
        f32x16 acc;
#pragma unroll
        for (int i = 0; i < 16; ++i) acc[i] = 0.f;
#pragma unroll
        for (int s = 0; s < 16; ++s) { const bf16x8 a = *(const LAS bf16x8*)(W + nt * 32 * WQP + 32 * s); acc = MFMA32(a, bfr[s], acc); }
#pragma unroll
        for (int i = 0; i < 16; ++i) acc[i] *= rs;
        if (nt == 2) rope_apply(acc, cs, sn);
        store_tile_rowmajor(QC + (size_t)tok * 384 + hh * 96 + nt * 32, acc, h);
    }
}
__device__ __forceinline__ void vt_flush(LAS bf16_t* stg, bf16_t* __restrict__ dst  , int lane) {
    const LAS u32x4* rp = (const LAS u32x4*)(stg + lane * 32);
    u32x4 w[4];
#pragma unroll
    for (int c = 0; c < 4; ++c) w[c] = rp[c];
    u32x4* gp = (u32x4*)(dst + (size_t)lane * SEQ);
#pragma unroll
    for (int c = 0; c < 4; ++c) gp[c] = w[c];
}
__device__ __forceinline__ void mkv_unit(const bf16_t* __restrict__ H, const LAS unsigned char* Wl, const int* __restrict__ pos, bf16_t* __restrict__ KC, bf16_t* __restrict__ VTC, int tb, int hh, int lane, LAS bf16_t* stg) {
    const int r = lane & 31, h = lane >> 5, tok = tb * 32 + r;
    const bf16_t* src = H + (size_t)tok * DINP + C_CKV + 8 * h;
    bf16x8 bfr[8]; float ss = 0.f;
#pragma unroll
    for (int s = 0; s < 8; ++s) { bfr[s] = *(const bf16x8*)(src + 16 * s);
#pragma unroll
        for (int j = 0; j < 8; ++j) { const float v = bf2f(bfr[s][j]); ss += v * v; } }
    ss += __shfl_xor(ss, 32);
    const float rs = rsqrtf(ss * (1.f / 128.f) + EPS);
    const LAS unsigned char* W = Wl + r * WKP + 16 * h;
    const int b = (tb * 32) / SEQ, t0 = (tb * 32) % SEQ;
#pragma unroll 1
    for (int nt = 0; nt < 4; ++nt) {
        f32x16 acc;
#pragma unroll
        for (int i = 0; i < 16; ++i) acc[i] = 0.f;
#pragma unroll
        for (int s = 0; s < 8; ++s) { const bf16x8 a = *(const LAS bf16x8*)(W + nt * 32 * WKP + 32 * s); acc = MFMA32(a, bfr[s], acc); }
#pragma unroll
        for (int i = 0; i < 16; ++i) acc[i] *= rs;
        if (nt < 2) store_tile_rowmajor(KC + (size_t)tok * 384 + hh * 96 + nt * 32, acc, h);
        else {
            LAS bf16_t* sp = stg + ((nt - 2) * 32 + 4 * h) * 32 + r;
#pragma unroll
            for (int i = 0; i < 16; ++i) sp[((i & 3) + 8 * (i >> 2)) * 32] = f2bf(acc[i]);
        }
    }
    vt_flush(stg, VTC + ((size_t)((b * 4 + hh) * 64)) * SEQ + t0, lane);
    f32x16 kr;
    const bf16_t* krp = H + (size_t)tok * DINP + C_CKR + 4 * h;
#pragma unroll
    for (int g = 0; g < 4; ++g) { const u32x2 w = *(const u32x2*)(krp + 8 * g); kr[4 * g] = bflo(w.x); kr[4 * g + 1] = bfhi(w.x); kr[4 * g + 2] = bflo(w.y); kr[4 * g + 3] = bfhi(w.y); }
    float cs[8], sn[8]; rope_cs(pos[tok], h, cs, sn);
    rope_apply(kr, cs, sn);
    store_tile_rowmajor(KC + (size_t)tok * 384 + hh * 96 + 64, kr, h);
}
__device__ __forceinline__ void vt_unit(const bf16_t* __restrict__ H, int col0, int NH, bf16_t* __restrict__ VT, int tb, int head, int lane, LAS bf16_t* stg) {
    const int r = lane & 31, h = lane >> 5, tok = tb * 32 + r, b = (tb * 32) / SEQ, t0 = (tb * 32) % SEQ;
    const bf16_t* src = H + (size_t)tok * DINP + col0 + head * 64 + 32 * h;
    bf16x8 v[4];
#pragma unroll
    for (int c = 0; c < 4; ++c) v[c] = *(const bf16x8*)(src + 8 * c);
    LAS bf16_t* sp = stg + (32 * h) * 32 + r;
#pragma unroll
    for (int c = 0; c < 4; ++c)
#pragma unroll
        for (int j = 0; j < 8; ++j) sp[(8 * c + j) * 32] = (bf16_t)v[c][j];
    vt_flush(stg, VT + ((size_t)((b * NH + head) * 64)) * SEQ + t0, lane);
}
__device__ __forceinline__ void conv_unit(const bf16_t* __restrict__ H, const float* __restrict__ cw, const float* __restrict__ cb, bf16_t* __restrict__ Y, int tb8, int lane) {
    const int tok0 = tb8 * 8, t0 = tok0 % SEQ, ch = 4 * lane;
    const f32x4 w0 = *(const f32x4*)(cw + ch), w1 = *(const f32x4*)(cw + 256 + ch), w2 = *(const f32x4*)(cw + 512 + ch), bs = *(const f32x4*)(cb + ch);
    u32x2 cc[10], xx[10], bb[8];
    const int back = (t0 >= 2) ? 2 : 0;
#pragma unroll
    for (int i = 0; i < 10; ++i) { const int ti = (i < 2) ? (i - back) : (i - 2); const bf16_t* p = H + (size_t)(tok0 + ti) * DINP + ch;
        cc[i] = *(const u32x2*)(p + C_BC); xx[i] = *(const u32x2*)(p + C_BX); if (i >= 2) bb[i - 2] = *(const u32x2*)(p + C_BB); }
    f32x4 u[10];
#pragma unroll
    for (int i = 0; i < 10; ++i) u[i] = (f32x4){bflo(cc[i].x) * bflo(xx[i].x), bfhi(cc[i].x) * bfhi(xx[i].x), bflo(cc[i].y) * bflo(xx[i].y), bfhi(cc[i].y) * bfhi(xx[i].y)};
    if (back == 0) { u[0] = (f32x4){0.f, 0.f, 0.f, 0.f}; u[1] = (f32x4){0.f, 0.f, 0.f, 0.f}; }
#pragma unroll
    for (int i = 0; i < 8; ++i) {
        const f32x4 bg = {bflo(bb[i].x), bfhi(bb[i].x), bflo(bb[i].y), bfhi(bb[i].y)};
        const f32x4 y = bg * (w0 * u[i] + w1 * u[i + 1] + w2 * u[i + 2] + bs);
        u32x2 o; o.x = pk2(y.x, y.y); o.y = pk2(y.z, y.w);
        *(u32x2*)(Y + (size_t)(tok0 + i) * DM + 256 + ch) = o;
    }
}

__device__ __forceinline__ void o_flush(LAS bf16_t* stg, bf16_t* __restrict__ Orow0, int opitch, int lane) {
    u32x4 w[4];
#pragma unroll
    for (int j = 0; j < 4; ++j) w[j] = *(const LAS u32x4*)(stg + (lane + 64 * j) * 8);
#pragma unroll
    for (int j = 0; j < 4; ++j) { const int c = lane + 64 * j; *(u32x4*)(Orow0 + (size_t)(c >> 3) * opitch + (c & 7) * 8) = w[j]; }
}
template <int DKS, bool SINK>
__device__ __forceinline__ void softmax_unit(const bf16_t* __restrict__ Qrow0, int qpitch, const bf16_t* __restrict__ Kb, int kpitch, const bf16_t* __restrict__ VT,
                                             int qb, int kt_begin, int window, float sink2, bf16_t* __restrict__ Orow0, int opitch, int lane, LAS bf16_t* stg) {
    const int r = lane & 31, h = lane >> 5;
    const int pr = (r & ~12) | ((r & 8) >> 1) | ((r & 4) << 1);
    bf16x8 qf[DKS];
#pragma unroll
    for (int s = 0; s < DKS; ++s) qf[s] = *(const bf16x8*)(Qrow0 + (size_t)r * qpitch + 16 * s + 8 * h);
    f32x16 o0, o1;
#pragma unroll
    for (int i = 0; i < 16; ++i) { o0[i] = 0.f; o1[i] = 0.f; }
    float m = -1e30f, l = 0.f;
    const int kt_end = qb + 1, q = 32 * qb + r;
    const bf16_t* kp = Kb + (size_t)(32 * kt_begin + pr) * kpitch + 8 * h;
    const bf16_t* vp = VT + (size_t)r * SEQ + 32 * kt_begin + 8 * h;
    bf16x8 kf[DKS];
#pragma unroll
    for (int s = 0; s < DKS; ++s) kf[s] = *(const bf16x8*)(kp + 16 * s);
    for (int kt = kt_begin; kt < kt_end; ++kt) {
        bf16x8 kn[DKS];
        if (kt + 1 < kt_end) {
#pragma unroll
            for (int s = 0; s < DKS; ++s) kn[s] = *(const bf16x8*)(kp + (size_t)32 * kpitch + 16 * s);
        } else {
#pragma unroll
            for (int s = 0; s < DKS; ++s) kn[s] = kf[s];
        }
        const bf16x8 v00 = *(const bf16x8*)(vp), v01 = *(const bf16x8*)(vp + 32 * SEQ), v10 = *(const bf16x8*)(vp + 16), v11 = *(const bf16x8*)(vp + 32 * SEQ + 16);
        f32x16 p;
#pragma unroll
        for (int i = 0; i < 16; ++i) p[i] = 0.f;
#pragma unroll
        for (int s = 0; s < DKS; ++s) p = MFMA32(kf[s], qf[s], p);
        if (kt == qb || (window != 0 && kt == qb - (window >> 5))) {
            const int k0 = 32 * kt + 8 * h;
#pragma unroll
            for (int i = 0; i < 16; ++i) { const int kv = k0 + 16 * (i >> 3) + (i & 7); const bool ok = (kv <= q) && (window == 0 || kv > q - window); if (!ok) p[i] = -INFINITY; }
        }
        float rm = MX3(p[0], p[1], p[2]);
#pragma unroll
        for (int i = 3; i < 15; i += 2) rm = MX3(rm, p[i], p[i + 1]);
        rm = xh_max(fmaxf(rm, p[15]));
        if (__any(rm > m + 6.f)) {
            const float mn = fmaxf(m, rm), f = ex2(m - mn); m = mn; l *= f;
#pragma unroll
            for (int i = 0; i < 16; ++i) { const float fi = __shfl(f, crow(i, h)); o0[i] *= fi; o1[i] *= fi; }
        }
        float e[16];
#pragma unroll
        for (int i = 0; i < 16; ++i) { e[i] = ex2(p[i] - m); l += e[i]; }
        const bf16x8 pa0 = pack8(e), pa1 = pack8(e + 8);
        o0 = MFMA32(pa0, v00, o0); o1 = MFMA32(pa0, v01, o1);
        o0 = MFMA32(pa1, v10, o0); o1 = MFMA32(pa1, v11, o1);
#pragma unroll
        for (int s = 0; s < DKS; ++s) kf[s] = kn[s];
        kp += (size_t)32 * kpitch; vp += 32;
    }
    l = xh_sum(l);
    if (SINK) l += ex2(sink2 - m);
    const float inv = 1.f / l;
    LAS bf16_t* sp = stg + (4 * h) * 64 + r;
#pragma unroll
    for (int i = 0; i < 16; ++i) { const float fi = __shfl(inv, crow(i, h)); const int ro = ((i & 3) + 8 * (i >> 2)) * 64;
        sp[ro] = f2bf(o0[i] * fi); sp[ro + 32] = f2bf(o1[i] * fi); }
    o_flush(stg, Orow0, opitch, lane);
}


constexpr int KP = 208, VP = 272;
constexpr int KT_BYTES = 128 * KP, VT_BYTES = 64 * VP, TB_BYTES = KT_BYTES + VT_BYTES, MRG_OFF = 2 * TB_BYTES;
static_assert(MRG_OFF + 4 * 34 * 64 * 4 <= 131072, "MLA LDS map");
__device__ __forceinline__ void mla_unit_blk(const bf16_t* __restrict__ QC, const bf16_t* __restrict__ KC, const bf16_t* __restrict__ VTC, bf16_t* __restrict__ Y,
                                             int bh, int g, LAS unsigned char* lds, int tid) {
    const int lane = tid & 63, wave = __builtin_amdgcn_readfirstlane(tid >> 6), r = lane & 31, h = lane >> 5, w4 = wave & 3, kh = wave >> 2;
    const int pr = (r & ~12) | ((r & 8) >> 1) | ((r & 4) << 1);
    const int b = bh >> 2, hh = bh & 3, qb = 4 * g + w4, q = 32 * qb + r;
    const bf16_t* Qp = QC + ((size_t)b * SEQ + q) * 384 + hh * 96 + 8 * h;
    bf16x8 qf[6];
#pragma unroll
    for (int s = 0; s < 6; ++s) qf[s] = *(const bf16x8*)(Qp + 16 * s);
    const bf16_t* Kg = KC + (size_t)b * SEQ * 384 + hh * 96;
    const bf16_t* Vg = VTC + (size_t)(b * 4 + hh) * 64 * SEQ;
    unsigned dgo[6];
#pragma unroll
    for (int i = 0; i < 6; ++i) { const int n = wave + 8 * i; unsigned o = 0u;
        if (n < 26) { const int j = 64 * n + lane, row = j / 13; int cc = j - 13 * row; cc = cc == 12 ? 0 : cc; o = (unsigned)(row * 384 + 8 * cc) * 2u; }
        else if (n < 43) { const int j = 64 * (n - 26) + lane, d = j / 17; int cc = j - 17 * d; cc = cc == 16 ? 0 : cc; o = (unsigned)(d * SEQ + 8 * cc) * 2u; }
        dgo[i] = o; }
#define MLA_DMA(ST, BO) do { const char* kb_ = (const char*)(Kg + (size_t)(ST) * (128 * 384)); const char* vb_ = (const char*)(Vg + (ST) * 128); \
        _Pragma("unroll") for (int i = 0; i < 6; ++i) { const int n = wave + 8 * i; \
            if (n < 26) __builtin_amdgcn_global_load_lds((const unsigned*)(kb_ + dgo[i]), (LAS unsigned*)(lds + (BO) + n * 1024), 16, 0, 0); \
            else if (n < 43) __builtin_amdgcn_global_load_lds((const unsigned*)(vb_ + dgo[i]), (LAS unsigned*)(lds + (BO) + KT_BYTES + (n - 26) * 1024), 16, 0, 0); } } while (0)
#define MLA_DMA_WAIT() asm volatile("s_waitcnt vmcnt(0)" ::: "memory")
    f32x16 o0, o1;
#pragma unroll
    for (int i = 0; i < 16; ++i) { o0[i] = 0.f; o1[i] = 0.f; }
    float m = 0.f, l = 0.f; bool first = true;
    f32x16 negm;
#pragma unroll
    for (int i = 0; i < 16; ++i) negm[i] = 0.f;
    const int nST = g + 1;
    MLA_DMA(0, 0); MLA_DMA_WAIT();
    __syncthreads();
    const int kfo = (64 * kh + pr) * KP + 16 * h;
    const int vfo = KT_BYTES + r * VP + (64 * kh + 8 * h) * 2;
    for (int ST = 0; ST < nST; ++ST) {
        if (ST + 1 < nST) MLA_DMA(ST + 1, ((ST + 1) & 1) * TB_BYTES);
        const int kt0 = 4 * ST + 2 * kh;
        if (kt0 <= qb) {
            const LAS unsigned char* tb = lds + (ST & 1) * TB_BYTES;
            f32x16 p0, p1;
            { const bf16x8 k0 = *(const LAS bf16x8*)(tb + kfo), k1 = *(const LAS bf16x8*)(tb + kfo + 32 * KP); p0 = MFMA32(k0, qf[0], negm); p1 = MFMA32(k1, qf[0], negm); }
#pragma unroll
            for (int s = 1; s < 6; ++s) { const bf16x8 k0 = *(const LAS bf16x8*)(tb + kfo + 32 * s), k1 = *(const LAS bf16x8*)(tb + kfo + 32 * KP + 32 * s);
                p0 = MFMA32(k0, qf[s], p0); p1 = MFMA32(k1, qf[s], p1); }
            if (kt0 + 1 >= qb) {
                const int kb0 = 32 * kt0 + 8 * h;
#pragma unroll
                for (int i = 0; i < 16; ++i) { const int kv = kb0 + 16 * (i >> 3) + (i & 7); if (kv > q) p0[i] = -INFINITY; if (kv + 32 > q) p1[i] = -INFINITY; }
            }
            float ra_ = MX3(p0[0], p0[1], p1[0]), rb_ = MX3(p0[2], p0[3], p1[1]); ra_ = MX3(ra_, p1[2], p1[3]);
#pragma unroll
            for (int i = 4; i < 16; i += 4) { ra_ = MX3(ra_, p0[i], p0[i + 1]); rb_ = MX3(rb_, p0[i + 2], p0[i + 3]); ra_ = MX3(ra_, p1[i], p1[i + 1]); rb_ = MX3(rb_, p1[i + 2], p1[i + 3]); }
            const float rm = xh_max(fmaxf(ra_, rb_));
            if (first || __any(rm > 6.f)) {
                const float dl = first ? rm : fmaxf(rm, 0.f);
                m += dl;
#pragma unroll
                for (int i = 0; i < 16; ++i) { p0[i] -= dl; p1[i] -= dl; negm[i] = -m; }
                if (!first) { const float f = ex2(-dl); l *= f;
#pragma unroll
                    for (int i = 0; i < 16; ++i) { const float fi = __shfl(f, crow(i, h)); o0[i] *= fi; o1[i] *= fi; } }
                first = false;
            }
            float ls = 0.f;
#pragma unroll
            for (int i = 0; i < 16; ++i) { p0[i] = ex2(p0[i]); p1[i] = ex2(p1[i]); ls += p0[i] + p1[i]; }
            l += ls;
            float e[8];
#pragma unroll
            for (int ks = 0; ks < 4; ++ks) {
#pragma unroll
                for (int j = 0; j < 8; ++j) e[j] = (ks < 2) ? p0[8 * ks + j] : p1[8 * (ks - 2) + j];
                const bf16x8 pa = pack8(e);
                const bf16x8 v0 = *(const LAS bf16x8*)(tb + vfo + 32 * ks), v1 = *(const LAS bf16x8*)(tb + vfo + 32 * VP + 32 * ks);
                o0 = MFMA32(pa, v0, o0); o1 = MFMA32(pa, v1, o1);
            }
        }
        MLA_DMA_WAIT();
        __syncthreads();
    }
#undef MLA_DMA
#undef MLA_DMA_WAIT
    if (first) m = -1e30f;
    l = xh_sum(l);
    LAS float* mg = (LAS float*)(lds + MRG_OFF) + w4 * (34 * 64) + lane;
    if (kh == 1) {
#pragma unroll
        for (int i = 0; i < 16; ++i) { mg[i * 64] = o0[i]; mg[(16 + i) * 64] = o1[i]; }
        mg[32 * 64] = m; mg[33 * 64] = l;
    }
    __syncthreads();
    if (kh == 0) {
        const float mb = mg[32 * 64], lb = mg[33 * 64];
        const float mn = fmaxf(m, mb), fa = ex2(m - mn), fb = ex2(mb - mn), inv = 1.f / (l * fa + lb * fb), ga = fa * inv, gb = fb * inv;
        LAS bf16_t* stg = (LAS bf16_t*)(lds + wave * 4096);
        LAS bf16_t* sp = stg + (4 * h) * 64 + r;
#pragma unroll
        for (int i = 0; i < 16; ++i) { const float ra = __shfl(ga, crow(i, h)), rb = __shfl(gb, crow(i, h)); const int ro = ((i & 3) + 8 * (i >> 2)) * 64;
            sp[ro] = f2bf(o0[i] * ra + mg[i * 64] * rb); sp[ro + 32] = f2bf(o1[i] * ra + mg[(16 + i) * 64] * rb); }
        o_flush(stg, Y + ((size_t)b * SEQ + 32 * qb) * DM + 512 + hh * 64, DM, lane);
    }
    __syncthreads();
}

__device__ __forceinline__ void sb_unit(const bf16_t* __restrict__ Qrow0, int qpitch, const bf16_t* __restrict__ Kb, int kpitch, const bf16_t* __restrict__ VT,
                                        int qb, bf16_t* __restrict__ Orow0, int opitch, int lane, LAS bf16_t* stg) {
    const int r = lane & 31, h = lane >> 5;
    const int pr = (r & ~12) | ((r & 8) >> 1) | ((r & 4) << 1);
    bf16x8 qf[4];
#pragma unroll
    for (int s = 0; s < 4; ++s) qf[s] = *(const bf16x8*)(Qrow0 + (size_t)r * qpitch + 16 * s + 8 * h);
    f32x16 o0, o1;
#pragma unroll
    for (int i = 0; i < 16; ++i) { o0[i] = 0.f; o1[i] = 0.f; }
    float carry = 0.f;
    const int q = 32 * qb + r;
    const bf16_t* kp = Kb + (size_t)(32 * qb + pr) * kpitch + 8 * h;
    const bf16_t* vp = VT + (size_t)r * SEQ + 32 * qb + 8 * h;
    bf16x8 kf[4];
#pragma unroll
    for (int s = 0; s < 4; ++s) kf[s] = *(const bf16x8*)(kp + 16 * s);
    for (int kt = qb; kt >= 0; --kt) {
        bf16x8 kn[4];
        if (kt > 0) {
#pragma unroll
            for (int s = 0; s < 4; ++s) kn[s] = *(const bf16x8*)(kp - (size_t)32 * kpitch + 16 * s);
        } else {
#pragma unroll
            for (int s = 0; s < 4; ++s) kn[s] = kf[s];
        }
        const bf16x8 v00 = *(const bf16x8*)(vp), v01 = *(const bf16x8*)(vp + 32 * SEQ), v10 = *(const bf16x8*)(vp + 16), v11 = *(const bf16x8*)(vp + 32 * SEQ + 16);
        f32x16 p;
#pragma unroll
        for (int i = 0; i < 16; ++i) p[i] = 0.f;
#pragma unroll
        for (int s = 0; s < 4; ++s) p = MFMA32(kf[s], qf[s], p);
        const bool diag = (kt == qb);
        const int k0 = 32 * kt + 8 * h;
        float sfx[16];
#pragma unroll
        for (int i = 0; i < 16; ++i) {
            const float z = p[i];
            float L = -(fmaxf(z, 0.f) + lg2(1.f + ex2(-fabsf(z))));
            if (diag) { const int kv = k0 + 16 * (i >> 3) + (i & 7); if (!(kv < q)) L = 0.f; }
            sfx[i] = L;
        }
#pragma unroll
        for (int g = 0; g < 2; ++g)
#pragma unroll
            for (int j = 6; j >= 0; --j) sfx[8 * g + j] += sfx[8 * g + j + 1];
        const float T0 = sfx[0], T1 = sfx[8];
        const float TP0 = __shfl_xor(T0, 32), TP1 = __shfl_xor(T1, 32);
        const float off1 = (h ? 0.f : TP1) + carry, off0 = T1 + TP1 + (h ? 0.f : TP0) + carry;
        float e[16];
#pragma unroll
        for (int i = 0; i < 16; ++i) {
            float a = ex2(p[i] + sfx[i] + (i < 8 ? off0 : off1));
            if (diag) { const int kv = k0 + 16 * (i >> 3) + (i & 7); if (!(kv < q)) a = 0.f; }
            e[i] = a;
        }
        carry += (T0 + T1) + (TP0 + TP1);
        const bf16x8 pa0 = pack8(e), pa1 = pack8(e + 8);
        o0 = MFMA32(pa0, v00, o0); o1 = MFMA32(pa0, v01, o1);
        o0 = MFMA32(pa1, v10, o0); o1 = MFMA32(pa1, v11, o1);
        if (__all(carry < -150.f)) break;
#pragma unroll
        for (int s = 0; s < 4; ++s) kf[s] = kn[s];
        kp -= (size_t)32 * kpitch; vp -= 32;
    }
    LAS bf16_t* sp = stg + (4 * h) * 64 + r;
#pragma unroll
    for (int i = 0; i < 16; ++i) { const int ro = ((i & 3) + 8 * (i >> 2)) * 64; sp[ro] = f2bf(o0[i]); sp[ro + 32] = f2bf(o1[i]); }
    o_flush(stg, Orow0, opitch, lane);
}


constexpr int AKP = 144;
constexpr int SWA_NK = 384, SWA_VP = SWA_NK * 2 + 16, SWA_KB = SWA_NK * AKP;
constexpr int SB_NK = 448, SB_VP = SB_NK * 2 + 16, SB_KB = SB_NK * AKP;
constexpr int STG_OFF = 122880, MISC_OFF = STG_OFF + 8 * 4096;
static_assert(SWA_KB + 64 * SWA_VP <= STG_OFF && SB_KB + 64 * SB_VP <= STG_OFF && MISC_OFF + 1024 == LDS_BYTES, "window LDS map");
template <int NK, int VPB>
__device__ __forceinline__ void stage_kv64(const bf16_t* __restrict__ Kb, int kpitch, const bf16_t* __restrict__ VT, int key0, LAS unsigned char* lds, int tid) {
    constexpr int NCH = NK * 8 / 512, VC = NK / 8;
    u32x4 kr[NCH], vr[NCH];
#pragma unroll
    for (int i = 0; i < NCH; ++i) { const int c = tid + 512 * i, row = c >> 3, cc = c & 7; int key = key0 + row; key = key < 0 ? 0 : key;
        kr[i] = *(const u32x4*)(Kb + (size_t)key * kpitch + 8 * cc); }
#pragma unroll
    for (int i = 0; i < NCH; ++i) { const int c = tid + 512 * i, d = c / VC, cc = c - d * VC; int key = key0 + 8 * cc; key = key < 0 ? 0 : key;
        vr[i] = *(const u32x4*)(VT + (size_t)d * SEQ + key); }
#pragma unroll
    for (int i = 0; i < NCH; ++i) { const int c = tid + 512 * i, row = c >> 3, cc = c & 7; *(LAS u32x4*)(lds + row * AKP + 16 * cc) = kr[i]; }
#pragma unroll
    for (int i = 0; i < NCH; ++i) { const int c = tid + 512 * i, d = c / VC, cc = c - d * VC; *(LAS u32x4*)(lds + NK * AKP + d * VPB + 16 * cc) = vr[i]; }
}
template <int NK, int VPB>
__device__ __forceinline__ void stage_kv64_T(const bf16_t* __restrict__ Kb, int kpitch, const bf16_t* __restrict__ Vb, int vpitch, int key0, LAS unsigned char* lds, int tid) {
    constexpr int NCH = NK * 8 / 512, NB = NK / 32;
    const int lane = tid & 63, wave = __builtin_amdgcn_readfirstlane(tid >> 6), r = lane & 31, h = lane >> 5;
    u32x4 kr[NCH]; bf16x8 vv[2][4];
#pragma unroll
    for (int i = 0; i < NCH; ++i) { const int c = tid + 512 * i, row = c >> 3, cc = c & 7; int key = key0 + row; key = key < 0 ? 0 : key;
        kr[i] = *(const u32x4*)(Kb + (size_t)key * kpitch + 8 * cc); }
#pragma unroll
    for (int t = 0; t < 2; ++t) { const int tbk = wave + 8 * t; if (tbk < NB) { int key = key0 + 32 * tbk + r; key = key < 0 ? 0 : key;
#pragma unroll
        for (int c = 0; c < 4; ++c) vv[t][c] = *(const bf16x8*)(Vb + (size_t)key * vpitch + 32 * h + 8 * c); } }
#pragma unroll
    for (int i = 0; i < NCH; ++i) { const int c = tid + 512 * i, row = c >> 3, cc = c & 7; *(LAS u32x4*)(lds + row * AKP + 16 * cc) = kr[i]; }
#pragma unroll
    for (int t = 0; t < 2; ++t) { const int tbk = wave + 8 * t; if (tbk < NB) { LAS bf16_t* sp = (LAS bf16_t*)(lds + NK * AKP + (32 * h) * VPB) + 32 * tbk + r;
#pragma unroll
        for (int c = 0; c < 4; ++c)
#pragma unroll
            for (int j = 0; j < 8; ++j) sp[(8 * c + j) * (VPB / 2)] = (bf16_t)vv[t][c][j]; } }
}
__device__ __forceinline__ void swa_wave_lds(const bf16_t* __restrict__ Qrow0, int qpitch, const LAS unsigned char* lds, int qb, int kt_base, float sink2,
                                             bf16_t* __restrict__ Orow0, int opitch, int lane, LAS bf16_t* stg) {
    const int r = lane & 31, h = lane >> 5;
    const int pr = (r & ~12) | ((r & 8) >> 1) | ((r & 4) << 1);
    bf16x8 qf[4];
#pragma unroll
    for (int s = 0; s < 4; ++s) qf[s] = *(const bf16x8*)(Qrow0 + (size_t)r * qpitch + 16 * s + 8 * h);
    f32x16 o0, o1;
#pragma unroll
    for (int i = 0; i < 16; ++i) { o0[i] = 0.f; o1[i] = 0.f; }
    float m = -1e30f, l = 0.f;
    const int q = 32 * qb + r, kt_begin = qb - 4 > 0 ? qb - 4 : 0;
    for (int kt = kt_begin; kt <= qb; ++kt) {
        const int rel = kt - kt_base;
        const LAS unsigned char* kp = lds + (32 * rel + pr) * AKP + 16 * h;
        const LAS unsigned char* vp = lds + SWA_KB + r * SWA_VP + (32 * rel + 8 * h) * 2;
        f32x16 p;
#pragma unroll
        for (int i = 0; i < 16; ++i) p[i] = 0.f;
#pragma unroll
        for (int s = 0; s < 4; ++s) p = MFMA32(*(const LAS bf16x8*)(kp + 32 * s), qf[s], p);
        if (kt == qb || kt == qb - 4) {
            const int k0 = 32 * kt + 8 * h;
#pragma unroll
            for (int i = 0; i < 16; ++i) { const int kv = k0 + 16 * (i >> 3) + (i & 7); const bool ok = (kv <= q) && (kv > q - 128); if (!ok) p[i] = -INFINITY; }
        }
        float rm = MX3(p[0], p[1], p[2]);
#pragma unroll
        for (int i = 3; i < 15; i += 2) rm = MX3(rm, p[i], p[i + 1]);
        rm = xh_max(fmaxf(rm, p[15]));
        if (__any(rm > m + 6.f)) {
            const float mn = fmaxf(m, rm), f = ex2(m - mn); m = mn; l *= f;
#pragma unroll
            for (int i = 0; i < 16; ++i) { const float fi = __shfl(f, crow(i, h)); o0[i] *= fi; o1[i] *= fi; }
        }
        float e[16];
#pragma unroll
        for (int i = 0; i < 16; ++i) { e[i] = ex2(p[i] - m); l += e[i]; }
        const bf16x8 pa0 = pack8(e), pa1 = pack8(e + 8);
        o0 = MFMA32(pa0, *(const LAS bf16x8*)(vp), o0); o1 = MFMA32(pa0, *(const LAS bf16x8*)(vp + 32 * SWA_VP), o1);
        o0 = MFMA32(pa1, *(const LAS bf16x8*)(vp + 32), o0); o1 = MFMA32(pa1, *(const LAS bf16x8*)(vp + 32 * SWA_VP + 32), o1);
    }
    l = xh_sum(l);
    l += ex2(sink2 - m);
    const float inv = 1.f / l;
    LAS bf16_t* sp = stg + (4 * h) * 64 + r;
#pragma unroll
    for (int i = 0; i < 16; ++i) { const float fi = __shfl(inv, crow(i, h)); const int ro = ((i & 3) + 8 * (i >> 2)) * 64;
        sp[ro] = f2bf(o0[i] * fi); sp[ro + 32] = f2bf(o1[i] * fi); }
    o_flush(stg, Orow0, opitch, lane);
}
#define SB_STEP(KT_, V00_, V01_, V10_, V11_) do { \
        const bool diag = ((KT_) == qb); const int k0 = 32 * (KT_) + 8 * h; float sfx[16]; \
        _Pragma("unroll") for (int i = 0; i < 16; ++i) { const float z = p[i]; float L = -(fmaxf(z, 0.f) + lg2(1.f + ex2(-fabsf(z)))); \
            if (diag) { const int kv = k0 + 16 * (i >> 3) + (i & 7); if (!(kv < q)) L = 0.f; } sfx[i] = L; } \
        _Pragma("unroll") for (int g = 0; g < 2; ++g) _Pragma("unroll") for (int j = 6; j >= 0; --j) sfx[8 * g + j] += sfx[8 * g + j + 1]; \
        const float T0 = sfx[0], T1 = sfx[8]; const float TP0 = xh_other(T0, h), TP1 = xh_other(T1, h); \
        const float off1 = (h ? 0.f : TP1) + carry, off0 = T1 + TP1 + (h ? 0.f : TP0) + carry; float e[16]; \
        _Pragma("unroll") for (int i = 0; i < 16; ++i) { float a = ex2(p[i] + sfx[i] + (i < 8 ? off0 : off1)); \
            if (diag) { const int kv = k0 + 16 * (i >> 3) + (i & 7); if (!(kv < q)) a = 0.f; } e[i] = a; } \
        carry += (T0 + T1) + (TP0 + TP1); \
        const bf16x8 pa0 = pack8(e), pa1 = pack8(e + 8); \
        o0 = MFMA32(pa0, (V00_), o0); o1 = MFMA32(pa0, (V01_), o1); o0 = MFMA32(pa1, (V10_), o0); o1 = MFMA32(pa1, (V11_), o1); } while (0)
__device__ __forceinline__ void sb_wave_lds(const bf16_t* __restrict__ Qrow0, int qpitch, const LAS unsigned char* lds, const bf16_t* __restrict__ Kb, int kpitch,
                                            const bf16_t* __restrict__ Vb, int vpitch, int qb, int kt_base, bf16_t* __restrict__ Orow0, int opitch, int lane, LAS bf16_t* stg) {
    const int r = lane & 31, h = lane >> 5;
    const int pr = (r & ~12) | ((r & 8) >> 1) | ((r & 4) << 1);
    bf16x8 qf[4];
#pragma unroll
    for (int s = 0; s < 4; ++s) qf[s] = *(const bf16x8*)(Qrow0 + (size_t)r * qpitch + 16 * s + 8 * h);
    f32x16 o0, o1;
#pragma unroll
    for (int i = 0; i < 16; ++i) { o0[i] = 0.f; o1[i] = 0.f; }
    float carry = 0.f;
    const int q = 32 * qb + r;
    const int kt_lo = kt_base > 0 ? kt_base : 0;
    bool done = false;
    int kt = qb;
    for (; kt >= kt_lo; --kt) {
        const int rel = kt - kt_base;
        const LAS unsigned char* kp = lds + (32 * rel + pr) * AKP + 16 * h;
        const LAS unsigned char* vp = lds + SB_KB + r * SB_VP + (32 * rel + 8 * h) * 2;
        f32x16 p;
#pragma unroll
        for (int i = 0; i < 16; ++i) p[i] = 0.f;
#pragma unroll
        for (int s = 0; s < 4; ++s) p = MFMA32(*(const LAS bf16x8*)(kp + 32 * s), qf[s], p);
        SB_STEP(kt, *(const LAS bf16x8*)(vp), *(const LAS bf16x8*)(vp + 32 * SB_VP), *(const LAS bf16x8*)(vp + 32), *(const LAS bf16x8*)(vp + 32 * SB_VP + 32));
        if (__all(carry < -150.f)) { done = true; break; }
    }
    if (!done && kt >= 0) {
        const bf16_t* kp = Kb + (size_t)(32 * kt + pr) * kpitch + 8 * h;
        for (; kt >= 0; --kt) {
            bf16x8 kf[4];
#pragma unroll
            for (int s = 0; s < 4; ++s) kf[s] = *(const bf16x8*)(kp + 16 * s);
            bf16x8 v00, v01, v10, v11;
            { const bf16_t* vg = Vb + (size_t)(32 * kt + 8 * h) * vpitch + r;
#pragma unroll
              for (int j = 0; j < 8; ++j) { v00[j] = (short)vg[(size_t)j * vpitch]; v01[j] = (short)vg[(size_t)j * vpitch + 32]; v10[j] = (short)vg[(size_t)(16 + j) * vpitch]; v11[j] = (short)vg[(size_t)(16 + j) * vpitch + 32]; } }
            f32x16 p;
#pragma unroll
            for (int i = 0; i < 16; ++i) p[i] = 0.f;
#pragma unroll
            for (int s = 0; s < 4; ++s) p = MFMA32(kf[s], qf[s], p);
            SB_STEP(kt, v00, v01, v10, v11);
            if (__all(carry < -150.f)) break;
            kp -= (size_t)32 * kpitch;
        }
    }
    LAS bf16_t* sp = stg + (4 * h) * 64 + r;
#pragma unroll
    for (int i = 0; i < 16; ++i) { const int ro = ((i & 3) + 8 * (i >> 2)) * 64; sp[ro] = f2bf(o0[i]); sp[ro + 32] = f2bf(o1[i]); }
    o_flush(stg, Orow0, opitch, lane);
}
#undef SB_STEP

#define XB_TMO      128
#define XB_XCNT(j)  (256  + 64 * (j))
#define XB_XSUB(j)  (1280 + 64 * (j))
#define XB_XGEN(j)  (2304 + 64 * (j))
#define XB_TOP      3328
#define XB_TOPGEN   3392
#define XCD_BAR_WORDS 3456
#define XB_SPIN_CAP (1u << 18)

__device__ __forceinline__ unsigned xb_ld(unsigned* p)              { return __hip_atomic_load(p, __ATOMIC_RELAXED, __HIP_MEMORY_SCOPE_AGENT); }
__device__ __forceinline__ unsigned xb_add(unsigned* p, unsigned v) { return __hip_atomic_fetch_add(p, v, __ATOMIC_RELAXED, __HIP_MEMORY_SCOPE_AGENT); }
__device__ __forceinline__ unsigned xb_xcc_id() { return (unsigned)__builtin_amdgcn_s_getreg((3 << 11) | 20) & 0xFu; }
#define XB_SPIN(cond, bar) do { unsigned _sp = 0; while (cond) { __builtin_amdgcn_s_sleep(1); \
    if ((++_sp & 255u) == 0u) { if (xb_ld(&(bar)[XB_TMO])) break; if (_sp > XB_SPIN_CAP) { atomicAdd(&(bar)[XB_TMO], 1u); break; } } } } while (0)

struct XcdBarrier {
    unsigned* bar; unsigned x;
    volatile LAS unsigned* st;
};

__device__ __forceinline__ XcdBarrier xcd_barrier_post(unsigned* bar, volatile LAS unsigned* st) {
    XcdBarrier b; b.bar = bar; b.x = xb_xcc_id(); b.st = st;
    if (threadIdx.x == 0) (void)xb_add(&bar[XB_XCNT(b.x)], 1u);
    return b;
}
__device__ __forceinline__ void xcd_barrier_complete(unsigned* bar, unsigned x, unsigned& nloc, unsigned& nx) {
    const unsigned G = gridDim.x * gridDim.y * gridDim.z;
    unsigned sum, cnt, mine, sp = 0u;
    for (;;) {
        sum = 0u; cnt = 0u; mine = 0u;
#pragma unroll
        for (unsigned j = 0; j < 16; ++j) { const unsigned c = xb_ld(&bar[XB_XCNT(j)]); sum += c; cnt += (c > 0u) ? 1u : 0u; mine = (j == x) ? c : mine; }
        if (sum == G) break;
        __builtin_amdgcn_s_sleep(1);
        if ((++sp & 255u) == 0u) { if (xb_ld(&bar[XB_TMO])) break; if (sp > XB_SPIN_CAP) { atomicAdd(&bar[XB_TMO], 1u); break; } }
    }
    nloc = mine > 0u ? mine : 1u; nx = cnt > 0u ? cnt : 1u;
}

__device__ __forceinline__ void xcd_barrier(const XcdBarrier& b) {
    asm volatile("s_waitcnt vmcnt(0)" ::: "memory");
    __syncthreads();
    if (threadIdx.x == 0) {
        unsigned* bar = b.bar;
        __builtin_amdgcn_s_waitcnt(0);
        unsigned nloc = b.st[0], nx = b.st[1];
        if (nloc == 0u) { xcd_barrier_complete(bar, b.x, nloc, nx); b.st[0] = nloc; b.st[1] = nx; }
        const unsigned old = xb_add(&bar[XB_XSUB(b.x)], 1u);
        const unsigned gen = old / nloc;
        if (old + 1u == (gen + 1u) * nloc) {
            __builtin_amdgcn_fence(__ATOMIC_RELEASE, "agent");
            asm volatile("s_waitcnt vmcnt(0)" ::: "memory");
            const unsigned og = xb_add(&bar[XB_TOP], 1u);
            const unsigned tg = og / nx;
            if (og + 1u == (tg + 1u) * nx) xb_add(&bar[XB_TOPGEN], 1u);
            else XB_SPIN(xb_ld(&bar[XB_TOPGEN]) == tg, bar);
            __builtin_amdgcn_fence(__ATOMIC_ACQUIRE, "agent");
            xb_add(&bar[XB_XGEN(b.x)], 1u);
            asm volatile("s_waitcnt vmcnt(0)" ::: "memory");
        } else {
            XB_SPIN(xb_ld(&bar[XB_XGEN(b.x)]) == gen, bar);
            __builtin_amdgcn_fence(__ATOMIC_ACQUIRE, "agent");
            asm volatile("s_waitcnt vmcnt(0)" ::: "memory");
        }
    }
    __syncthreads();
}

__global__ void __launch_bounds__(NTHREADS, 2) fwd(Params P) {
    extern __shared__ __attribute__((aligned(16))) unsigned char lds_raw[];
    LAS unsigned char* lds = (LAS unsigned char*)lds_raw;
    constexpr int G = 256, NGW = G * NWAVES, gthreads = G * NTHREADS;
    const int bx = blockIdx.x;
#if MK_COOP
    cooperative_groups::grid_group grid = cooperative_groups::this_grid();
    volatile LAS unsigned* MISC = (volatile LAS unsigned*)(lds + MISC_OFF);
    if (threadIdx.x < 64) MISC[threadIdx.x] = 0u;
    __syncthreads();
    XcdBarrier bar = xcd_barrier_post((unsigned*)(P.ws + WS_CTL) + CW_BAR, MISC + 8);
#endif
    for (int ph = P.ph_lo; ph < P.ph_hi; ++ph) {
        const int nrep = ((ph >= 1 && ph <= 6 && ((ph - 1) == MK_REP_K || (MK_REP_K == 6 && ph == 3))) || (ph == 0 && MK_REP_K == 7)) ? MK_REP_N : 1;
        for (int rep = 0; rep < nrep; ++rep) {
        int tid_o = threadIdx.x; asm volatile("" : "+v"(tid_o));
        const int tid = tid_o, lane = tid & 63, wave = __builtin_amdgcn_readfirstlane(tid >> 6);
        const int gw = bx * NWAVES + wave, gtid = bx * NTHREADS + tid;
        LAS bf16_t* stg = (LAS bf16_t*)(lds + 122880 + wave * 4096);
        unsigned char* ws = P.ws; asm volatile("" : "+s"(ws));
        unsigned* ctl = (unsigned*)(ws + WS_CTL);
        bf16_t* XN = (bf16_t*)(ws + WS_XN); bf16_t* H = (bf16_t*)(ws + WS_H);
        bf16_t* QC = (bf16_t*)(ws + WS_QC); bf16_t* KC = (bf16_t*)(ws + WS_KC);
        bf16_t* VTC = (bf16_t*)(ws + WS_VTC); bf16_t* VTA = (bf16_t*)(ws + WS_VTA); bf16_t* VTD = (bf16_t*)(ws + WS_VTD);
        bf16_t* Y = (bf16_t*)(ws + WS_Y);
        if (ph == 0) {
            {
                LAS float* scr = (LAS float*)(lds + wave * 16384);
                constexpr int I_IN = (DM / 64) * (DIN / 32), I_OUT = (DM / 64) * (DM / 32), I_UQ = (256 / 64) * (384 / 32), I_UKV = (128 / 64) * (512 / 32), I_L = I_IN + I_OUT + I_UQ + I_UKV;
                for (int it = gw; it < NLAYER * I_L; it += NGW) {
                    const int l = it / I_L; int v = it - l * I_L;
                    if (v < I_IN) { wT_item(P.w_in + (size_t)l * DM * DIN, DM, DIN, P.norm_pre + l * DM, (bf16_t*)(ws + WS_WIN) + (size_t)l * DINP * DM, C_AQ, C_AQ + 256, C_DQ, C_DQ + 256, SC64, scr, v, lane); continue; } v -= I_IN;
                    if (v < I_OUT) { wT_item(P.w_out + (size_t)l * DM * DM, DM, DM, P.g_grp + l * DM, (bf16_t*)(ws + WS_WOUT) + (size_t)l * DM * DM, 0, 0, 0, 0, 1.f, scr, v, lane); continue; } v -= I_OUT;
                    if (v < I_UQ) { wT_item(P.w_uq + (size_t)l * 256 * 384, 256, 384, P.g_cq + l * 256, (bf16_t*)(ws + WS_WUQ + (size_t)l * 262144), 0, 0, 0, 0, 1.f, scr, v, lane); continue; } v -= I_UQ;
                    wT_item(P.w_ukv + (size_t)l * 128 * 512, 128, 512, P.g_ckv + l * 128, (bf16_t*)(ws + WS_WUKV + (size_t)l * 131072), 0, 0, 0, 0, 1.f, scr, v, lane);
                }
                for (int it = gtid; it < NLAYER * (DINP - DIN) * (DM / 8); it += gthreads) { const int l = it / ((DINP - DIN) * (DM / 8)), v = it - l * ((DINP - DIN) * (DM / 8));
                    *(u32x4*)((bf16_t*)(ws + WS_WIN) + (size_t)l * DINP * DM + (size_t)DIN * DM + (size_t)v * 8) = (u32x4){0u, 0u, 0u, 0u}; }
            }
            { const float* __restrict__ xr = P.x; bf16_t* __restrict__ xo = XN;
#pragma unroll 2
              for (int mrow = gw; mrow < M_TOK; mrow += NGW) rms_row_to_bf16(xr + (size_t)mrow * DM, xo + (size_t)mrow * DM, lane); }
        } else {
            const int l = (ph - 1) / 6, k = (ph - 1) % 6;
            if (k == 0 || k == 4) {
                if (k == 0) {
                    pg8::Gemm g{XN, (const bf16_t*)(ws + WS_WIN) + (size_t)l * DINP * DM, M_TOK, DINP, DM}; pg8::StaticOrder S; S.init(M_TOK, DINP, G, bx);
                    pg8::EpiBf16<0> E{H, DINP, nullptr, 0, 0, 1.f};
                    pg8::gemm_phase<pg8::EpiBf16<0>, pg8::StaticOrder, true, true>(lds, g, S, E);
                } else {
                    pg8::Gemm g{XN, (const bf16_t*)(ws + WS_WOUT) + (size_t)l * DM * DM, M_TOK, DM, DM}; pg8::StaticOrder S; S.init(M_TOK, DM, G, bx);
                    pg8::EpiBf16<0> E{Y, DM, nullptr, 0, 0, 1.f};
                    pg8::gemm_phase<pg8::EpiBf16<0>, pg8::StaticOrder, true, true>(lds, g, S, E);
                }
            } else if (k == 1) {
                const bf16_t* WUQ = (const bf16_t*)(ws + WS_WUQ + (size_t)l * 262144);
                const bf16_t* WUKV = (const bf16_t*)(ws + WS_WUKV + (size_t)l * 131072);
                {
                    const int hh = bx & 3, tg = bx >> 2;
                    u32x4 wq[6], wk[4];
#pragma unroll
                    for (int i = 0; i < 6; ++i) { const int c = tid + 512 * i, row = c >> 5, cc = c & 31; wq[i] = *(const u32x4*)(WUQ + (size_t)(hh * 96 + row) * 256 + 8 * cc); }
#pragma unroll
                    for (int i = 0; i < 4; ++i) { const int c = tid + 512 * i, row = c >> 4, cc = c & 15; wk[i] = *(const u32x4*)(WUKV + (size_t)(hh * 128 + row) * 128 + 8 * cc); }
#pragma unroll
                    for (int i = 0; i < 6; ++i) { const int c = tid + 512 * i, row = c >> 5, cc = c & 31; *(LAS u32x4*)(lds + row * WQP + 16 * cc) = wq[i]; }
#pragma unroll
                    for (int i = 0; i < 4; ++i) { const int c = tid + 512 * i, row = c >> 4, cc = c & 15; *(LAS u32x4*)(lds + WQ_BYTES + row * WKP + 16 * cc) = wk[i]; }
                    __syncthreads();
                    const int tb = 8 * tg + wave;
                    mq_unit(H, lds, P.pos, QC, tb, hh, lane);
                    mkv_unit(H, lds + WQ_BYTES, P.pos, KC, VTC, tb, hh, lane, stg);
                }
                constexpr int NTB = M_TOK / 32;
                constexpr int U_ALL = M_TOK / 8;
                for (int u = gw; u < U_ALL; u += NGW) {
                    const int v = u;
                    conv_unit(H, P.conv_w + l * 768, P.conv_b + l * 256, Y, v, lane);
                }
            } else if (k == 2) {
                if (rep == 0 || MK_REP_K == 2)
                for (int pu = bx; pu < 256; pu += G) {
                    const int bh = pu & 7, Gq = pu >> 3;
                    mla_unit_blk(QC, KC, VTC, Y, bh, 63 - Gq, lds, tid);
                    mla_unit_blk(QC, KC, VTC, Y, bh, Gq, lds, tid);
                }
                if (rep == 0 || MK_REP_K == 6) {
                    const int bh = bx & 7, G8 = bx >> 3, b = bh >> 2, hh = bh & 3, qb = 8 * G8 + wave;
                    const size_t row0 = (size_t)b * SEQ + 32 * qb;
                    LAS bf16_t* ostg = (LAS bf16_t*)(lds + STG_OFF + wave * 4096);
                    {
                        const int kvh = hh >> 1;
                        const bf16_t* Kb = H + (size_t)b * SEQ * DINP + C_AK + kvh * 64;
                        stage_kv64_T<SWA_NK, SWA_VP>(Kb, DINP, H + (size_t)b * SEQ * DINP + C_AV + kvh * 64, DINP, 256 * G8 - 128, lds, tid);
                        __syncthreads();
                        swa_wave_lds(H + row0 * DINP + C_AQ + hh * 64, DINP, lds, qb, 8 * G8 - 4, P.sinks[l * 4 + hh] * LOG2E, Y + row0 * DM + hh * 64, DM, lane, ostg);
                        __syncthreads();
                    }
                    {
                        const bf16_t* Kb = H + (size_t)b * SEQ * DINP + C_DK + hh * 64;
                        const bf16_t* Vb = H + (size_t)b * SEQ * DINP + C_DV + hh * 64;
                        stage_kv64_T<SB_NK, SB_VP>(Kb, DINP, Vb, DINP, 256 * G8 - 192, lds, tid);
                        __syncthreads();
                        sb_wave_lds(H + row0 * DINP + C_DQ + hh * 64, DINP, lds, Kb, DINP, Vb, DINP, qb, 8 * G8 - 6, Y + row0 * DM + 768 + hh * 64, DM, lane, ostg);
                        __syncthreads();
                    }
                }
            } else if (k == 3) {
                const bf16_t* __restrict__ Yr = Y; const bf16_t* __restrict__ Hr = H; bf16_t* __restrict__ XNw = XN;
#pragma unroll 2
                for (int mrow = gw; mrow < M_TOK; mrow += NGW) {
                    const u32x4* yp = (const u32x4*)(Yr + (size_t)mrow * DM) + 2 * lane;
                    const u32x4* gp = (const u32x4*)(Hr + (size_t)mrow * DINP + C_GATE) + 2 * lane;
                    const u32x4 y0 = yp[0], y1 = yp[1], g0 = gp[0], g1 = gp[1];
                    float yv[16], gv[16];
#pragma unroll
                    for (int j = 0; j < 4; ++j) { yv[2 * j] = bflo(y0[j]); yv[2 * j + 1] = bfhi(y0[j]); yv[8 + 2 * j] = bflo(y1[j]); yv[8 + 2 * j + 1] = bfhi(y1[j]);
                                                  gv[2 * j] = bflo(g0[j]); gv[2 * j + 1] = bfhi(g0[j]); gv[8 + 2 * j] = bflo(g1[j]); gv[8 + 2 * j + 1] = bfhi(g1[j]); }
                    float ss = 0.f;
#pragma unroll
                    for (int j = 0; j < 16; ++j) ss += yv[j] * yv[j];
                    ss += __shfl_xor(ss, 1); ss += __shfl_xor(ss, 2); ss += __shfl_xor(ss, 4); ss += __shfl_xor(ss, 8);
                    const float rs = rsqrtf(ss * (1.f / 256.f) + EPS);
                    float o[16];
#pragma unroll
                    for (int j = 0; j < 16; ++j) { const float gg = gv[j]; o[j] = yv[j] * rs * gg * __builtin_amdgcn_rcpf(1.f + ex2(-gg * LOG2E)); }
                    u32x4 w0, w1;
#pragma unroll
                    for (int j = 0; j < 4; ++j) { w0[j] = pk2(o[2 * j], o[2 * j + 1]); w1[j] = pk2(o[8 + 2 * j], o[8 + 2 * j + 1]); }
                    u32x4* op = (u32x4*)(XNw + (size_t)mrow * DM) + 2 * lane;
                    op[0] = w0; op[1] = w1;
                }
            } else {
                const float* base = P.x;
                const float* gpost = P.g_post + l * DM;
                for (int mrow0 = gw; mrow0 < M_TOK; mrow0 += 2 * NGW) {
                    f32x4 zz[2][4], xv[2][4]; float s1[2] = {0.f, 0.f}, s2[2] = {0.f, 0.f};
                    const bool two = (mrow0 + NGW < M_TOK);
#pragma unroll
                    for (int rr = 0; rr < 2; ++rr) { const int mrow = (rr == 0 || two) ? mrow0 + rr * NGW : mrow0;
#pragma unroll
                        for (int j = 0; j < 4; ++j) { const u32x2 w = ((const u32x2*)(Y + (size_t)mrow * DM))[lane + 64 * j]; zz[rr][j] = (f32x4){bflo(w.x), bfhi(w.x), bflo(w.y), bfhi(w.y)};
                            if (l == 0) xv[rr][j] = ((const f32x4*)(base + (size_t)mrow * DM))[lane + 64 * j];
                            else { const u32x2 xb = ((const u32x2*)(P.out + (size_t)mrow * DM))[lane + 64 * j]; xv[rr][j] = (f32x4){bflo(xb.x), bfhi(xb.x), bflo(xb.y), bfhi(xb.y)}; } } }
                    f32x4 gpv[4];
#pragma unroll
                    for (int j = 0; j < 4; ++j) gpv[j] = ((const f32x4*)gpost)[lane + 64 * j];
#pragma unroll
                    for (int rr = 0; rr < 2; ++rr)
#pragma unroll
                        for (int j = 0; j < 4; ++j) s1[rr] += (zz[rr][j].x * zz[rr][j].x + zz[rr][j].y * zz[rr][j].y) + (zz[rr][j].z * zz[rr][j].z + zz[rr][j].w * zz[rr][j].w);
                    const float rz0 = rsqrtf(wave_sum(s1[0]) * (1.f / DM) + EPS), rz1 = rsqrtf(wave_sum(s1[1]) * (1.f / DM) + EPS);
#pragma unroll
                    for (int rr = 0; rr < 2; ++rr) { const float rz = rr ? rz1 : rz0;
#pragma unroll
                        for (int j = 0; j < 4; ++j) { xv[rr][j] = xv[rr][j] + zz[rr][j] * rz * gpv[j];
                            s2[rr] += (xv[rr][j].x * xv[rr][j].x + xv[rr][j].y * xv[rr][j].y) + (xv[rr][j].z * xv[rr][j].z + xv[rr][j].w * xv[rr][j].w); } }
#pragma unroll
                    for (int rr = 0; rr < 2; ++rr) { if (rr == 1 && !two) break; const int mrow = mrow0 + rr * NGW;
#pragma unroll
                        for (int j = 0; j < 4; ++j) {
                            if (l + 1 < NLAYER) { u32x2 o; o.x = pk2(xv[rr][j].x, xv[rr][j].y); o.y = pk2(xv[rr][j].z, xv[rr][j].w); ((u32x2*)(P.out + (size_t)mrow * DM))[lane + 64 * j] = o; }
                            else ((f32x4*)(P.out + (size_t)mrow * DM))[lane + 64 * j] = xv[rr][j]; } }
                    if (l + 1 < NLAYER) {
                        const float r0 = rsqrtf(wave_sum(s2[0]) * (1.f / DM) + EPS), r1 = rsqrtf(wave_sum(s2[1]) * (1.f / DM) + EPS);
#pragma unroll
                        for (int rr = 0; rr < 2; ++rr) { if (rr == 1 && !two) break; const int mrow = mrow0 + rr * NGW; const float rs = rr ? r1 : r0;
#pragma unroll
                            for (int j = 0; j < 4; ++j) { u32x2 o; o.x = pk2(xv[rr][j].x * rs, xv[rr][j].y * rs); o.y = pk2(xv[rr][j].z * rs, xv[rr][j].w * rs); ((u32x2*)(XN + (size_t)mrow * DM))[lane + 64 * j] = o; } }
                    }
                }
            }
            }
        }
        if (ph + 1 < P.ph_hi) {
#if MK_COOP
            if (P.ph_hi < 0) grid.sync();
            xcd_barrier(bar);
#endif
        }
    }
}
}

extern "C" void kernel_launch(void* const* d_in, const int* in_sizes, int n_in, void* d_out, int out_size, void* d_ws, size_t ws_size, hipStream_t stream) {
    using namespace mk;
    static int grid = 0;
    if (grid == 0) {
        if (n_in != 14 || out_size != M_TOK * DM || ws_size < WS_END) { fprintf(stderr, "kernel_launch: unexpected shapes (n_in %d out %d ws %zu)\n", n_in, out_size, ws_size); grid = -1; return; }
        int dev = 0, cus = 0, per_cu = 0;
        (void)hipGetDevice(&dev); (void)hipDeviceGetAttribute(&cus, hipDeviceAttributeMultiprocessorCount, dev);
        if (hipFuncSetAttribute((const void*)fwd, hipFuncAttributeMaxDynamicSharedMemorySize, LDS_BYTES) != hipSuccess) { fprintf(stderr, "kernel_launch: hipFuncSetAttribute failed\n"); grid = -1; return; }
        if (hipOccupancyMaxActiveBlocksPerMultiprocessor(&per_cu, (const void*)fwd, NTHREADS, LDS_BYTES) != hipSuccess || per_cu < 1) { fprintf(stderr, "kernel_launch: occupancy query says %d\n", per_cu); per_cu = 1; }
        (void)hipGetLastError();
        if (cus < 256) { fprintf(stderr, "kernel_launch: built for a 256-CU device (one workgroup per CU), found %d CUs\n", cus); grid = -1; return; }
        grid = 256;
    }
    if (grid < 0) return;
    (void)hipMemsetAsync((char*)d_ws + WS_CTL, 0, CTL_BYTES, stream);
    Params p{};
    p.x = (const float*)d_in[0]; p.pos = (const int*)d_in[1]; p.norm_pre = (const float*)d_in[2]; p.w_in = (const float*)d_in[3]; p.sinks = (const float*)d_in[4];
    p.conv_w = (const float*)d_in[5]; p.conv_b = (const float*)d_in[6]; p.g_cq = (const float*)d_in[7]; p.w_uq = (const float*)d_in[8]; p.g_ckv = (const float*)d_in[9];
    p.w_ukv = (const float*)d_in[10]; p.g_grp = (const float*)d_in[11]; p.w_out = (const float*)d_in[12]; p.g_post = (const float*)d_in[13];
    p.out = (float*)d_out; p.ws = (unsigned char*)d_ws;
    constexpr int NPH = 1 + 6 * NLAYER;
#if MK_COOP
    p.ph_lo = 0; p.ph_hi = NPH;
    void* args[] = {&p};
    hipError_t e = hipLaunchCooperativeKernel((const void*)fwd, dim3(grid), dim3(NTHREADS), args, LDS_BYTES, stream);
    if (e != hipSuccess) fprintf(stderr, "kernel_launch: cooperative launch failed: %s (grid %d)\n", hipGetErrorString(e), grid);
#else
    for (int ph = 0; ph < NPH; ++ph) { p.ph_lo = ph; p.ph_hi = ph + 1; hipLaunchKernelGGL(fwd, dim3(grid), dim3(NTHREADS), LDS_BYTES, stream, p); }
#endif
}
```

```cpp
#include <hip/hip_runtime.h>
#include <hip/hip_cooperative_groups.h>
#include <cstdio>
#include <cstdint>
#include <cmath>
namespace pg8 {
#define PG8_LAS __attribute__((address_space(3)))
typedef unsigned short bf16_t;
typedef short bf16x8 __attribute__((ext_vector_type(8)));
typedef float f32x4 __attribute__((ext_vector_type(4)));
typedef unsigned u32x4 __attribute__((ext_vector_type(4)));
constexpr int BM = 256, BK = 64, HALF = 128, HTB = HALF * BK * 2  , STAGE_BYTES = 8 * HTB, NXCD = 8, WGM = 8;

__host__ __device__ __forceinline__ int lds_byte(int r, int c) { const int st = (r >> 4) * 2 + (c >> 5), rr = r & 15, cc = c & 31, ob = rr * 64 + cc * 2; return st * 1024 + (ob ^ (((ob >> 9) & 1) << 5)); }
__host__ __device__ __forceinline__ void stage_rc(int b, int& R, int& C) { const int st = b / 1024, sb = b % 1024, swz = sb ^ (((sb >> 9) & 1) << 5); R = (st >> 1) * 16 + swz / 64; C = (st & 1) * 32 + (swz % 64) / 2; }
__host__ __device__ __forceinline__ int perm32(int rho) { const int n = rho >> 4, i = rho & 15; return 8 * (i >> 2) + 4 * n + (i & 3); }

struct Unit { int pm, pn; };
struct Gemm { const bf16_t* A; const bf16_t* Bt; int M, N, K; };

struct StaticOrder {
    int nM, nN, nwg, G, c;
    __host__ __device__ void init(int M, int N, int G_, int c_) { nM = M / BM; nN = N / BM; nwg = nM * nN; G = G_; c = c_; }
    __host__ __device__ bool next(int i, Unit& u) const {
        const long L = (long)i * G + c; if (L >= nwg) return false;
        int wgid = (int)L; { const int q = nwg / NXCD, r = nwg % NXCD, xcd = wgid % NXCD, off = wgid / NXCD; wgid = (xcd < r ? xcd * (q + 1) : r * (q + 1) + (xcd - r) * q) + off; }
        const int nig = WGM * nN, gid = wgid / nig, fm = gid * WGM, gsz = (nM - fm) < WGM ? (nM - fm) : WGM;
        u.pm = fm + ((wgid % nig) % gsz); u.pn = (wgid % nig) / gsz; return true;
    }
    __device__ __forceinline__ void a_ready(const Unit&) const {}
    __device__ __forceinline__ void done(const Unit&) const {}
};

__device__ __forceinline__ unsigned cvt_pk_bf16(float lo, float hi) { unsigned r; asm volatile("v_cvt_pk_bf16_f32 %0, %1, %2" : "=v"(r) : "v"(lo), "v"(hi)); return r; }
typedef float f32x2 __attribute__((ext_vector_type(2)));
__device__ __forceinline__ f32x2 gelu_pk(f32x2 v) {
    const f32x2 av = __builtin_elementwise_abs(v), d = av * 0.2316418882f + 1.0f;
    f32x2 t; t.x = __builtin_amdgcn_rcpf(d.x); t.y = __builtin_amdgcn_rcpf(d.y);
    f32x2 q = t * 0.5307027145f + (-0.7265760135f); q = q * t + 0.7107068705f; q = q * t + (-0.142248368f); q = q * t + 0.127414796f; q = q * t;
    const f32x2 s = (v * v) * (-0.72134752044f);
    f32x2 e; e.x = __builtin_amdgcn_exp2f(s.x); e.y = __builtin_amdgcn_exp2f(s.y);
    const f32x2 m = v * (q * e), r = v - m;
    f32x2 o; o.x = v.x < 0.f ? m.x : r.x; o.y = v.y < 0.f ? m.y : r.y; return o;
}

template <int ACT  > struct EpiBf16 {
    static constexpr bool PERM = true, AFTER_DRAIN = false; static_assert(ACT == 0 || ACT == 1, "EpiBf16: ACT is 0 (none) or 1 (gelu_pk)");
    bf16_t* O; int ldc; const float* bias; int split_cols; size_t split_stride; float scale0;
    __device__ __forceinline__ void operator()(const f32x4 (&acc)[2][2][4][2], const Unit& u, int wr, int wc, int fr, int fq) const {
        const int row0 = u.pm * BM + wr * 64 + fr; int colt = u.pn * BM; bf16_t* base = O;
        float sc = 1.f; if (split_cols) { const int t = colt / split_cols; base += (size_t)t * split_stride; colt -= t * split_cols; if (t == 0) sc = scale0; }
        const int col0 = colt + wc * 32 + 8 * fq, bcol0 = u.pn * BM + wc * 32 + 8 * fq;
        f32x4 bv[2][2];
#pragma unroll
        for (int bj = 0; bj < 2; ++bj)
#pragma unroll
            for (int n = 0; n < 2; ++n) bv[bj][n] = bias ? *(const f32x4*)(bias + bcol0 + bj * HALF + 4 * n) : (f32x4){0.f, 0.f, 0.f, 0.f};
#pragma unroll
        for (int ai = 0; ai < 2; ++ai)
#pragma unroll
            for (int m = 0; m < 4; ++m) { bf16_t* rowp = base + (size_t)(row0 + ai * HALF + m * 16) * ldc + col0;
#pragma unroll
                for (int bj = 0; bj < 2; ++bj) { f32x4 v0 = acc[ai][bj][m][0] + bv[bj][0], v1 = acc[ai][bj][m][1] + bv[bj][1];
                    if (ACT == 1) { f32x2 a = gelu_pk((f32x2){v0[0], v0[1]}), b = gelu_pk((f32x2){v0[2], v0[3]}), c = gelu_pk((f32x2){v1[0], v1[1]}), d = gelu_pk((f32x2){v1[2], v1[3]});
                        v0 = (f32x4){a.x, a.y, b.x, b.y}; v1 = (f32x4){c.x, c.y, d.x, d.y}; }
                    v0 = v0 * sc; v1 = v1 * sc; u32x4 w; w.x = cvt_pk_bf16(v0[0], v0[1]); w.y = cvt_pk_bf16(v0[2], v0[3]); w.z = cvt_pk_bf16(v1[0], v1[1]); w.w = cvt_pk_bf16(v1[2], v1[3]);
                    *(u32x4*)(rowp + bj * HALF) = w; } }
    }
};
template <class Epi, class Sched, bool ALIGN_EPI = false, bool SP2 = false>
__device__ __forceinline__ void gemm_phase(PG8_LAS unsigned char* lds, const Gemm g, const Sched& S, const Epi& E) {
    int tid_o = threadIdx.x; asm volatile("" : "+v"(tid_o));
    const int tid = tid_o, wid = __builtin_amdgcn_readfirstlane(tid >> 6), lane = tid & 63, wr = wid >> 2, wc = wid & 3, fr = lane & 15, fq = lane >> 4;
    const int K = g.K, nt = K / BK;
    unsigned voffA[2], voffB[2];
#pragma unroll
    for (int i = 0; i < 2; ++i) { int R, C; stage_rc(tid * 16 + i * 8192, R, C); const int Rb = Epi::PERM ? ((R & ~31) + perm32(R & 31)) : R;
        voffA[i] = (unsigned)(R * K + C) * 2u; voffB[i] = (unsigned)(Rb * K + C) * 2u; }
    const size_t kstep = (size_t)(BK * 2);
    const size_t hstep = (size_t)HALF * K * 2;
    const size_t tstep = 2 * hstep;
    const unsigned ldsw = (unsigned)wid * 1024u;
    const int aoff = lds_byte(wr * 64 + fr, fq * 8), boff = lds_byte(wc * 32 + fr, fq * 8);
#define PG8_SA(b, h) (((b) * 2 + (h)) * HTB)
#define PG8_SB(b, h) ((4 + (b) * 2 + (h)) * HTB)
#define PG8_STAGE(bufoff, gbase, voff) do { _Pragma("unroll") for (int _i = 0; _i < 2; ++_i) \
        __builtin_amdgcn_global_load_lds((const unsigned*)((const char*)(gbase) + (voff)[_i]), (PG8_LAS unsigned*)(lds + (bufoff) + ldsw + _i * 8192), 16, 0, 0); } while (0)
#define PG8_LDA(dst, b, h) do { _Pragma("unroll") for (int m = 0; m < 4; ++m) _Pragma("unroll") for (int k = 0; k < 2; ++k) dst[m][k] = *(const PG8_LAS bf16x8*)(lds + PG8_SA(b, h) + aoff + m * 2048 + k * 1024); } while (0)
#define PG8_LDB(dst, b, h) do { _Pragma("unroll") for (int n = 0; n < 2; ++n) _Pragma("unroll") for (int k = 0; k < 2; ++k) dst[n][k] = *(const PG8_LAS bf16x8*)(lds + PG8_SB(b, h) + boff + n * 2048 + k * 1024); } while (0)
#define PG8_MMA(ai, bj, At, Bt) do { __builtin_amdgcn_s_setprio(1); _Pragma("unroll") for (int m = 0; m < 4; ++m) _Pragma("unroll") for (int n = 0; n < 2; ++n) _Pragma("unroll") for (int k = 0; k < 2; ++k) \
        acc[ai][bj][m][n] = __builtin_amdgcn_mfma_f32_16x16x32_bf16(Bt[n][k], At[m][k], acc[ai][bj][m][n], 0, 0, 0); __builtin_amdgcn_s_setprio(0); } while (0)
#define PG8_WAIT_V(n) asm volatile("s_waitcnt vmcnt(" #n ")" ::: "memory")
#define PG8_WAIT_L(n) asm volatile("s_waitcnt lgkmcnt(" #n ")" ::: "memory")
#define PG8_BAR __builtin_amdgcn_s_barrier()
#define PG8_SCHED __builtin_amdgcn_sched_barrier(0)
    Unit cur, nxt; int ui = 0;
    if (!S.next(0, cur)) return;
    f32x4 acc[2][2][4][2];
#pragma unroll
    for (int a = 0; a < 2; ++a)
#pragma unroll
        for (int b = 0; b < 2; ++b)
#pragma unroll
            for (int m = 0; m < 4; ++m)
#pragma unroll
                for (int n = 0; n < 2; ++n) acc[a][b][m][n] = (f32x4){0.f, 0.f, 0.f, 0.f};
    bf16x8 At[4][2], B0[2][2], B1[2][2];
    const char* cA = (const char*)g.A + (size_t)cur.pm * tstep; const char* cB = (const char*)g.Bt + (size_t)cur.pn * tstep;
    S.a_ready(cur);
    if constexpr (SP2) {
        PG8_STAGE(PG8_SB(0, 0), cB, voffB); PG8_STAGE(PG8_SB(0, 1), cB + hstep, voffB); PG8_STAGE(PG8_SA(0, 0), cA, voffA); PG8_STAGE(PG8_SA(0, 1), cA + hstep, voffA);
        if (wr == 1) PG8_BAR;
        PG8_WAIT_V(2); PG8_BAR;
        PG8_STAGE(PG8_SB(1, 0), cB + kstep, voffB); PG8_STAGE(PG8_SA(1, 0), cA + kstep, voffA); PG8_STAGE(PG8_SB(1, 1), cB + hstep + kstep, voffB);
        PG8_WAIT_V(6); PG8_BAR;
    } else {
        PG8_STAGE(PG8_SB(0, 0), cB, voffB); PG8_STAGE(PG8_SA(0, 0), cA, voffA); PG8_STAGE(PG8_SB(0, 1), cB + hstep, voffB); PG8_STAGE(PG8_SA(0, 1), cA + hstep, voffA);
        if (wr == 1) PG8_BAR;
        PG8_WAIT_V(4); PG8_BAR;
        PG8_STAGE(PG8_SB(1, 0), cB + kstep, voffB); PG8_STAGE(PG8_SA(1, 0), cA + kstep, voffA); PG8_STAGE(PG8_SB(1, 1), cB + hstep + kstep, voffB);
        PG8_WAIT_V(6); PG8_BAR;
    }
    for (;;) {
        const bool has_next = S.next(ui + 1, nxt);
        const char* nA = has_next ? (const char*)g.A + (size_t)nxt.pm * tstep : cA; const char* nB = has_next ? (const char*)g.Bt + (size_t)nxt.pn * tstep : cB;
        for (int t = 0; t < nt; t += 2) {
            const bool last = (t == nt - 2);
            const char* a1 = cA + (size_t)(t + 1) * kstep;
            const char* a2 = last ? nA : cA + (size_t)(t + 2) * kstep; const char* b2 = last ? nB : cB + (size_t)(t + 2) * kstep;
            const char* a3 = a2 + kstep; const char* b3 = b2 + kstep;
            if (last && has_next) S.a_ready(nxt);
            if constexpr (SP2) {
            PG8_LDB(B0, 0, 0); PG8_LDB(B1, 0, 1); PG8_SCHED; PG8_LDA(At, 0, 0); PG8_STAGE(PG8_SA(1, 1), a1 + hstep, voffA);
            PG8_WAIT_V(8); PG8_WAIT_L(0); PG8_BAR; PG8_MMA(0, 0, At, B0); PG8_MMA(0, 1, At, B1); PG8_BAR; PG8_SCHED;
            PG8_LDA(At, 0, 1); PG8_STAGE(PG8_SB(0, 0), b2, voffB); PG8_STAGE(PG8_SB(0, 1), b2 + hstep, voffB); PG8_STAGE(PG8_SA(0, 0), a2, voffA);
            PG8_WAIT_V(8); PG8_WAIT_L(0); PG8_BAR; PG8_MMA(1, 0, At, B0); PG8_MMA(1, 1, At, B1); PG8_BAR; PG8_SCHED;
            PG8_LDB(B0, 1, 0); PG8_LDB(B1, 1, 1); PG8_SCHED; PG8_LDA(At, 1, 0); PG8_STAGE(PG8_SA(0, 1), a2 + hstep, voffA);
            PG8_WAIT_V(8); PG8_WAIT_L(0); PG8_BAR; PG8_MMA(0, 0, At, B0); PG8_MMA(0, 1, At, B1); PG8_BAR; PG8_SCHED;
            PG8_LDA(At, 1, 1); PG8_STAGE(PG8_SB(1, 0), b3, voffB); PG8_STAGE(PG8_SB(1, 1), b3 + hstep, voffB); PG8_STAGE(PG8_SA(1, 0), a3, voffA);
            PG8_WAIT_V(8); PG8_WAIT_L(0); PG8_BAR; PG8_MMA(1, 0, At, B0); PG8_MMA(1, 1, At, B1); PG8_BAR; PG8_SCHED;
            } else {
            PG8_LDB(B0, 0, 0); PG8_SCHED; PG8_LDA(At, 0, 0); PG8_STAGE(PG8_SA(1, 1), a1 + hstep, voffA);
            PG8_WAIT_L(8); PG8_BAR; PG8_WAIT_L(0); PG8_MMA(0, 0, At, B0); PG8_BAR; PG8_SCHED;
            PG8_LDB(B1, 0, 1); PG8_STAGE(PG8_SB(0, 0), b2, voffB);
            PG8_BAR; PG8_WAIT_L(0); PG8_MMA(0, 1, At, B1); PG8_BAR;
            PG8_LDA(At, 0, 1); PG8_STAGE(PG8_SA(0, 0), a2, voffA);
            PG8_BAR; PG8_WAIT_L(0); PG8_MMA(1, 0, At, B0); PG8_BAR; PG8_SCHED;
            PG8_STAGE(PG8_SB(0, 1), b2 + hstep, voffB);
            PG8_WAIT_V(6); PG8_BAR; PG8_MMA(1, 1, At, B1); PG8_BAR;
            PG8_LDB(B0, 1, 0); PG8_SCHED; PG8_LDA(At, 1, 0); PG8_STAGE(PG8_SA(0, 1), a2 + hstep, voffA);
            PG8_WAIT_L(8); PG8_BAR; PG8_WAIT_L(0); PG8_MMA(0, 0, At, B0); PG8_BAR; PG8_SCHED;
            PG8_LDB(B1, 1, 1); PG8_STAGE(PG8_SB(1, 0), b3, voffB);
            PG8_BAR; PG8_WAIT_L(0); PG8_MMA(0, 1, At, B1); PG8_BAR;
            PG8_LDA(At, 1, 1); PG8_STAGE(PG8_SA(1, 0), a3, voffA);
            PG8_BAR; PG8_WAIT_L(0); PG8_MMA(1, 0, At, B0); PG8_BAR; PG8_SCHED;
            PG8_STAGE(PG8_SB(1, 1), b3 + hstep, voffB);
            PG8_WAIT_V(6); PG8_BAR; PG8_MMA(1, 1, At, B1); PG8_BAR;
            }
        }
        if constexpr (ALIGN_EPI) { if (wr == 0) PG8_BAR; }
        if constexpr (!Epi::AFTER_DRAIN) { E(acc, cur, wr, wc, fr, fq); S.done(cur); }
        if (!has_next) break;
#pragma unroll
        for (int a = 0; a < 2; ++a)
#pragma unroll
            for (int b = 0; b < 2; ++b)
#pragma unroll
                for (int m = 0; m < 4; ++m)
#pragma unroll
                    for (int n = 0; n < 2; ++n) acc[a][b][m][n] = (f32x4){0.f, 0.f, 0.f, 0.f};
        cur = nxt; cA = nA; cB = nB; ++ui;
        if constexpr (ALIGN_EPI) { if (wr == 1) PG8_BAR; }
    }
    PG8_WAIT_V(0);
    if constexpr (!ALIGN_EPI) { if (wr == 0) PG8_BAR; }
    PG8_BAR;
    if constexpr (Epi::AFTER_DRAIN) { E.fused(acc, cur, wr, wc, fr, fq, lds, wid, lane); S.done(cur); }
#undef PG8_SA
#undef PG8_SB
#undef PG8_STAGE
#undef PG8_LDA
#undef PG8_LDB
#undef PG8_MMA
#undef PG8_WAIT_V
#undef PG8_WAIT_L
#undef PG8_BAR
#undef PG8_SCHED
}
}
#ifndef MK_COOP
#define MK_COOP 1
#endif
#ifndef MK_REP_K
#define MK_REP_K -1
#endif
#ifndef MK_REP_N
#define MK_REP_N 1
#endif
namespace mk {
using pg8::bf16_t; using pg8::bf16x8; using pg8::f32x4; using pg8::u32x4;
typedef float f32x16 __attribute__((ext_vector_type(16)));
typedef unsigned u32x2 __attribute__((ext_vector_type(2)));
typedef float f32x2_t __attribute__((ext_vector_type(2)));
typedef __bf16 bf16x2_t __attribute__((ext_vector_type(2)));
#define LAS __attribute__((address_space(3)))
#define MFMA32(a, b, c) __builtin_amdgcn_mfma_f32_32x32x16_bf16((a), (b), (c), 0, 0, 0)

constexpr int M_TOK = 16384, SEQ = 8192, DM = 1024, DIN = 3488, DINP = 3584, NLAYER = 2;
constexpr int C_AQ = 0, C_AK = 256, C_AV = 384, C_BB = 512, C_BC = 768, C_BX = 1024, C_CQ = 1280, C_CKV = 1536, C_CKR = 1664,
              C_DQ = 1696, C_DK = 1952, C_DV = 2208, C_GATE = 2464;
constexpr float EPS = 1e-6f, LOG2E = 1.4426950408889634f;
constexpr float SC64 = 0.125f * LOG2E;
constexpr float QSC_MLA = 0.10206207261596575f * LOG2E;
constexpr int NWAVES = 8, NTHREADS = 512;
constexpr int LDS_BYTES = 122880 + 8 * 4096 + 1024;

constexpr size_t MiB = 1u << 20;
constexpr size_t WS_CTL = 0, CTL_BYTES = 65536;
constexpr int CW_BAR = 1024;
constexpr size_t WS_WIN = 1 * MiB;
constexpr size_t WS_WOUT = 15 * MiB;
constexpr size_t WS_WUQ = 19 * MiB;
constexpr size_t WS_WUKV = 19 * MiB + 512 * 1024;
constexpr size_t WS_XN = 32 * MiB;
constexpr size_t WS_H = 64 * MiB;
constexpr size_t WS_QC = 176 * MiB;
constexpr size_t WS_KC = 188 * MiB;
constexpr size_t WS_VTC = 200 * MiB;
constexpr size_t WS_VTA = 208 * MiB;
constexpr size_t WS_VTD = 212 * MiB;
constexpr size_t WS_Y = 220 * MiB;
constexpr size_t WS_END = 252 * MiB;

struct Params {
    const float* x; const int* pos; const float* norm_pre; const float* w_in; const float* sinks; const float* conv_w; const float* conv_b;
    const float* g_cq; const float* w_uq; const float* g_ckv; const float* w_ukv; const float* g_grp; const float* w_out; const float* g_post;
    float* out; unsigned char* ws; int ph_lo, ph_hi;
};

__device__ __forceinline__ unsigned pk2(float lo, float hi) { f32x2_t v = {lo, hi}; bf16x2_t b = __builtin_convertvector(v, bf16x2_t); return __builtin_bit_cast(unsigned, b); }
__device__ __forceinline__ float bf2f(short s) { return __uint_as_float(((unsigned)(unsigned short)s) << 16); }
__device__ __forceinline__ float bflo(unsigned u) { return __uint_as_float(u << 16); }
__device__ __forceinline__ float bfhi(unsigned u) { return __uint_as_float(u & 0xffff0000u); }
__device__ __forceinline__ bf16_t f2bf(float f) { return (bf16_t)(pk2(f, 0.f) & 0xffffu); }
__device__ __forceinline__ int crow(int i, int h) { return (i & 3) + 8 * (i >> 2) + 4 * h; }
__device__ __forceinline__ float ex2(float x) { return __builtin_amdgcn_exp2f(x); }
__device__ __forceinline__ float lg2(float x) { return __builtin_amdgcn_logf(x); }
__device__ __forceinline__ float xh_max(float v) { auto rr = __builtin_amdgcn_permlane32_swap(__float_as_uint(v), __float_as_uint(v), false, false); return fmaxf(__uint_as_float(rr[0]), __uint_as_float(rr[1])); }
__device__ __forceinline__ float xh_sum(float v) { auto rr = __builtin_amdgcn_permlane32_swap(__float_as_uint(v), __float_as_uint(v), false, false); return __uint_as_float(rr[0]) + __uint_as_float(rr[1]); }
__device__ __forceinline__ float xh_other(float v, int h) { auto rr = __builtin_amdgcn_permlane32_swap(__float_as_uint(v), __float_as_uint(v), false, false); return __uint_as_float(h ? rr[0] : rr[1]); }
#define MX3(a, b, c) __builtin_fmaxf(__builtin_fmaxf((a), (b)), (c))
__device__ __forceinline__ float wave_sum(float v) {
#pragma unroll
    for (int o = 1; o < 64; o <<= 1) v += __shfl_xor(v, o);
    return v;
}
__device__ __forceinline__ bf16x8 pack8(const float* e) {
    u32x4 w; w.x = pk2(e[0], e[1]); w.y = pk2(e[2], e[3]); w.z = pk2(e[4], e[5]); w.w = pk2(e[6], e[7]);
    return __builtin_bit_cast(bf16x8, w);
}

__device__ __forceinline__ void conv_wT(const float* __restrict__ W, int K, int N, int NP, const float* __restrict__ gain, bf16_t* __restrict__ dst,
                                        int a0, int a1, int b0, int b1, float sc, int gtid, int gthreads) {
    const int k8n = K / 8; const int items = NP * k8n;
#pragma unroll 2
    for (int it = gtid; it < items; it += gthreads) {
        const int n = it % NP, k8 = it / NP;
        u32x4 o = {0u, 0u, 0u, 0u};
        if (n < N) {
            const float cs = ((n >= a0 && n < a1) || (n >= b0 && n < b1)) ? sc : 1.f;
            float v[8];
#pragma unroll
            for (int j = 0; j < 8; ++j) v[j] = W[(size_t)(k8 * 8 + j) * N + n] * gain[k8 * 8 + j] * cs;
            o.x = pk2(v[0], v[1]); o.y = pk2(v[2], v[3]); o.z = pk2(v[4], v[5]); o.w = pk2(v[6], v[7]);
        }
        *(u32x4*)(dst + (size_t)n * K + k8 * 8) = o;
    }
}
__device__ __forceinline__ void wT_item(const float* __restrict__ W, int K, int N, const float* __restrict__ gain, bf16_t* __restrict__ WT, int a0, int a1, int b0, int b1, float sc,
                                        LAS float* scr, int item, int lane) {
    const int nblk = N / 32, kb = item / nblk, nb = item - kb * nblk, k0 = 64 * kb, n0 = 32 * nb;
#pragma unroll 8
    for (int i = 0; i < 32; ++i) { const int kk = 2 * i + (lane >> 5); scr[kk * 33 + (lane & 31)] = W[(size_t)(k0 + kk) * N + n0 + (lane & 31)]; }
    const int c = lane & 7;
    float g8[8];
#pragma unroll
    for (int j = 0; j < 8; ++j) g8[j] = gain[k0 + 8 * c + j];
#pragma unroll
    for (int j = 0; j < 4; ++j) { const int n = (lane >> 3) + 8 * j, nn = n0 + n; const LAS float* sp = scr + (8 * c) * 33 + n;
        const float cs = ((nn >= a0 && nn < a1) || (nn >= b0 && nn < b1)) ? sc : 1.f;
        u32x4 o; o.x = pk2(sp[0 * 33] * g8[0] * cs, sp[1 * 33] * g8[1] * cs); o.y = pk2(sp[2 * 33] * g8[2] * cs, sp[3 * 33] * g8[3] * cs);
        o.z = pk2(sp[4 * 33] * g8[4] * cs, sp[5 * 33] * g8[5] * cs); o.w = pk2(sp[6 * 33] * g8[6] * cs, sp[7 * 33] * g8[7] * cs);
        *(u32x4*)(WT + (size_t)nn * K + k0 + 8 * c) = o; }
}
__device__ __forceinline__ void rms_row_to_bf16(const float* __restrict__ xrow, bf16_t* __restrict__ orow, int lane) {
    f32x4 v[4]; float s = 0.f;
#pragma unroll
    for (int j = 0; j < 4; ++j) { v[j] = __builtin_nontemporal_load((const f32x4*)xrow + lane + 64 * j); s += (v[j].x * v[j].x + v[j].y * v[j].y) + (v[j].z * v[j].z + v[j].w * v[j].w); }
    const float rs = rsqrtf(wave_sum(s) * (1.f / DM) + EPS);
#pragma unroll
    for (int j = 0; j < 4; ++j) { u32x2 o; o.x = pk2(v[j].x * rs, v[j].y * rs); o.y = pk2(v[j].z * rs, v[j].w * rs); ((u32x2*)orow)[lane + 64 * j] = o; }
}

__device__ __forceinline__ void rope_cs(int pos, int h, float (&cs)[8], float (&sn)[8]) {
#pragma unroll
    for (int i = 0; i < 8; ++i) {
        const int f = (i & 3) + 8 * (i >> 2) + 4 * h;
        const float freq = ex2(-(float)f * 0.830482023721841f);
        const float ang = (float)pos * freq;
        const double rev = (double)ang * 0.15915494309189535;
        const float fr = (float)(rev - __builtin_rint(rev));
        cs[i] = __builtin_amdgcn_cosf(fr); sn[i] = __builtin_amdgcn_sinf(fr);
    }
}
__device__ __forceinline__ void rope_apply(f32x16& a, const float (&cs)[8], const float (&sn)[8]) {
#pragma unroll
    for (int i = 0; i < 8; ++i) { const float x1 = a[i], x2 = a[i + 8]; a[i] = x1 * cs[i] - x2 * sn[i]; a[i + 8] = x1 * sn[i] + x2 * cs[i]; }
}
__device__ __forceinline__ void store_tile_rowmajor(bf16_t* dst  , const f32x16& a, int h) {
#pragma unroll
    for (int g = 0; g < 4; ++g) { u32x2 o; o.x = pk2(a[4 * g], a[4 * g + 1]); o.y = pk2(a[4 * g + 2], a[4 * g + 3]); *(u32x2*)(dst + 8 * g + 4 * h) = o; }
}
constexpr int WQP = 528, WKP = 272, WQ_BYTES = 96 * WQP;
__device__ __forceinline__ void mq_unit(const bf16_t* __restrict__ H, const LAS unsigned char* Wl, const int* __restrict__ pos, bf16_t* __restrict__ QC, int tb, int hh, int lane) {
    const int r = lane & 31, h = lane >> 5, tok = tb * 32 + r;
    const bf16_t* src = H + (size_t)tok * DINP + C_CQ + 8 * h;
    bf16x8 bfr[16]; float ss = 0.f;
#pragma unroll
    for (int s = 0; s < 16; ++s) { bfr[s] = *(const bf16x8*)(src + 16 * s);
#pragma unroll
        for (int j = 0; j < 8; ++j) { const float v = bf2f(bfr[s][j]); ss += v * v; } }
    ss += __shfl_xor(ss, 32);
    const float rs = rsqrtf(ss * (1.f / 256.f) + EPS) * QSC_MLA;
    float cs[8], sn[8]; rope_cs(pos[tok], h, cs, sn);
    const LAS unsigned char* W = Wl + r * WQP + 16 * h;
#pragma unroll 1
    for (int nt = 0; nt < 3; ++nt) {
        f32x16 acc;
#pragma unroll
        for (int i = 0; i < 16; ++i) acc[i] = 0.f;
#pragma unroll
        for (int s = 0; s < 16; ++s) { const bf16x8 a = *(const LAS bf16x8*)(W + nt * 32 * WQP + 32 * s); acc = MFMA32(a, bfr[s], acc); }
#pragma unroll
        for (int i = 0; i < 16; ++i) acc[i] *= rs;
        if (nt == 2) rope_apply(acc, cs, sn);
        store_tile_rowmajor(QC + (size_t)tok * 384 + hh * 96 + nt * 32, acc, h);
    }
}
__device__ __forceinline__ void vt_flush(LAS bf16_t* stg, bf16_t* __restrict__ dst  , int lane) {
    const LAS u32x4* rp = (const LAS u32x4*)(stg + lane * 32);
    u32x4 w[4];
#pragma unroll
    for (int c = 0; c < 4; ++c) w[c] = rp[c];
    u32x4* gp = (u32x4*)(dst + (size_t)lane * SEQ);
#pragma unroll
    for (int c = 0; c < 4; ++c) gp[c] = w[c];
}
__device__ __forceinline__ void mkv_unit(const bf16_t* __restrict__ H, const LAS unsigned char* Wl, const int* __restrict__ pos, bf16_t* __restrict__ KC, bf16_t* __restrict__ VTC, int tb, int hh, int lane, LAS bf16_t* stg) {
    const int r = lane & 31, h = lane >> 5, tok = tb * 32 + r;
    const bf16_t* src = H + (size_t)tok * DINP + C_CKV + 8 * h;
    bf16x8 bfr[8]; float ss = 0.f;
#pragma unroll
    for (int s = 0; s < 8; ++s) { bfr[s] = *(const bf16x8*)(src + 16 * s);
#pragma unroll
        for (int j = 0; j < 8; ++j) { const float v = bf2f(bfr[s][j]); ss += v * v; } }
    ss += __shfl_xor(ss, 32);
    const float rs = rsqrtf(ss * (1.f / 128.f) + EPS);
    const LAS unsigned char* W = Wl + r * WKP + 16 * h;
    const int b = (tb * 32) / SEQ, t0 = (tb * 32) % SEQ;
#pragma unroll 1
    for (int nt = 0; nt < 4; ++nt) {
        f32x16 acc;
#pragma unroll
        for (int i = 0; i < 16; ++i) acc[i] = 0.f;
#pragma unroll
        for (int s = 0; s < 8; ++s) { const bf16x8 a = *(const LAS bf16x8*)(W + nt * 32 * WKP + 32 * s); acc = MFMA32(a, bfr[s], acc); }
#pragma unroll
        for (int i = 0; i < 16; ++i) acc[i] *= rs;
        if (nt < 2) store_tile_rowmajor(KC + (size_t)tok * 384 + hh * 96 + nt * 32, acc, h);
        else {
            LAS bf16_t* sp = stg + ((nt - 2) * 32 + 4 * h) * 32 + r;
#pragma unroll
            for (int i = 0; i < 16; ++i) sp[((i & 3) + 8 * (i >> 2)) * 32] = f2bf(acc[i]);
        }
    }
    vt_flush(stg, VTC + ((size_t)((b * 4 + hh) * 64)) * SEQ + t0, lane);
    f32x16 kr;
    const bf16_t* krp = H + (size_t)tok * DINP + C_CKR + 4 * h;
#pragma unroll
    for (int g = 0; g < 4; ++g) { const u32x2 w = *(const u32x2*)(krp + 8 * g); kr[4 * g] = bflo(w.x); kr[4 * g + 1] = bfhi(w.x); kr[4 * g + 2] = bflo(w.y); kr[4 * g + 3] = bfhi(w.y); }
    float cs[8], sn[8]; rope_cs(pos[tok], h, cs, sn);
    rope_apply(kr, cs, sn);
    store_tile_rowmajor(KC + (size_t)tok * 384 + hh * 96 + 64, kr, h);
}
__device__ __forceinline__ void vt_unit(const bf16_t* __restrict__ H, int col0, int NH, bf16_t* __restrict__ VT, int tb, int head, int lane, LAS bf16_t* stg) {
    const int r = lane & 31, h = lane >> 5, tok = tb * 32 + r, b = (tb * 32) / SEQ, t0 = (tb * 32) % SEQ;
    const bf16_t* src = H + (size_t)tok * DINP + col0 + head * 64 + 32 * h;
    bf16x8 v[4];
#pragma unroll
    for (int c = 0; c < 4; ++c) v[c] = *(const bf16x8*)(src + 8 * c);
    LAS bf16_t* sp = stg + (32 * h) * 32 + r;
#pragma unroll
    for (int c = 0; c < 4; ++c)
#pragma unroll
        for (int j = 0; j < 8; ++j) sp[(8 * c + j) * 32] = (bf16_t)v[c][j];
    vt_flush(stg, VT + ((size_t)((b * NH + head) * 64)) * SEQ + t0, lane);
}
__device__ __forceinline__ void conv_unit(const bf16_t* __restrict__ H, const float* __restrict__ cw, const float* __restrict__ cb, bf16_t* __restrict__ Y, int tb8, int lane) {
    const int tok0 = tb8 * 8, t0 = tok0 % SEQ, ch = 4 * lane;
    const f32x4 w0 = *(const f32x4*)(cw + ch), w1 = *(const f32x4*)(cw + 256 + ch), w2 = *(const f32x4*)(cw + 512 + ch), bs = *(const f32x4*)(cb + ch);
    u32x2 cc[10], xx[10], bb[8];
    const int back = (t0 >= 2) ? 2 : 0;
#pragma unroll
    for (int i = 0; i < 10; ++i) { const int ti = (i < 2) ? (i - back) : (i - 2); const bf16_t* p = H + (size_t)(tok0 + ti) * DINP + ch;
        cc[i] = *(const u32x2*)(p + C_BC); xx[i] = *(const u32x2*)(p + C_BX); if (i >= 2) bb[i - 2] = *(const u32x2*)(p + C_BB); }
    f32x4 u[10];
#pragma unroll
    for (int i = 0; i < 10; ++i) u[i] = (f32x4){bflo(cc[i].x) * bflo(xx[i].x), bfhi(cc[i].x) * bfhi(xx[i].x), bflo(cc[i].y) * bflo(xx[i].y), bfhi(cc[i].y) * bfhi(xx[i].y)};
    if (back == 0) { u[0] = (f32x4){0.f, 0.f, 0.f, 0.f}; u[1] = (f32x4){0.f, 0.f, 0.f, 0.f}; }
#pragma unroll
    for (int i = 0; i < 8; ++i) {
        const f32x4 bg = {bflo(bb[i].x), bfhi(bb[i].x), bflo(bb[i].y), bfhi(bb[i].y)};
        const f32x4 y = bg * (w0 * u[i] + w1 * u[i + 1] + w2 * u[i + 2] + bs);
        u32x2 o; o.x = pk2(y.x, y.y); o.y = pk2(y.z, y.w);
        *(u32x2*)(Y + (size_t)(tok0 + i) * DM + 256 + ch) = o;
    }
}

__device__ __forceinline__ void o_flush(LAS bf16_t* stg, bf16_t* __restrict__ Orow0, int opitch, int lane) {
    u32x4 w[4];
#pragma unroll
    for (int j = 0; j < 4; ++j) w[j] = *(const LAS u32x4*)(stg + (lane + 64 * j) * 8);
#pragma unroll
    for (int j = 0; j < 4; ++j) { const int c = lane + 64 * j; *(u32x4*)(Orow0 + (size_t)(c >> 3) * opitch + (c & 7) * 8) = w[j]; }
}
template <int DKS, bool SINK>
__device__ __forceinline__ void softmax_unit(const bf16_t* __restrict__ Qrow0, int qpitch, const bf16_t* __restrict__ Kb, int kpitch, const bf16_t* __restrict__ VT,
                                             int qb, int kt_begin, int window, float sink2, bf16_t* __restrict__ Orow0, int opitch, int lane, LAS bf16_t* stg) {
    const int r = lane & 31, h = lane >> 5;
    const int pr = (r & ~12) | ((r & 8) >> 1) | ((r & 4) << 1);
    bf16x8 qf[DKS];
#pragma unroll
    for (int s = 0; s < DKS; ++s) qf[s] = *(const bf16x8*)(Qrow0 + (size_t)r * qpitch + 16 * s + 8 * h);
    f32x16 o0, o1;
#pragma unroll
    for (int i = 0; i < 16; ++i) { o0[i] = 0.f; o1[i] = 0.f; }
    float m = -1e30f, l = 0.f;
    const int kt_end = qb + 1, q = 32 * qb + r;
    const bf16_t* kp = Kb + (size_t)(32 * kt_begin + pr) * kpitch + 8 * h;
    const bf16_t* vp = VT + (size_t)r * SEQ + 32 * kt_begin + 8 * h;
    bf16x8 kf[DKS];
#pragma unroll
    for (int s = 0; s < DKS; ++s) kf[s] = *(const bf16x8*)(kp + 16 * s);
    for (int kt = kt_begin; kt < kt_end; ++kt) {
        bf16x8 kn[DKS];
        if (kt + 1 < kt_end) {
#pragma unroll
            for (int s = 0; s < DKS; ++s) kn[s] = *(const bf16x8*)(kp + (size_t)32 * kpitch + 16 * s);
        } else {
#pragma unroll
            for (int s = 0; s < DKS; ++s) kn[s] = kf[s];
        }
        const bf16x8 v00 = *(const bf16x8*)(vp), v01 = *(const bf16x8*)(vp + 32 * SEQ), v10 = *(const bf16x8*)(vp + 16), v11 = *(const bf16x8*)(vp + 32 * SEQ + 16);
        f32x16 p;
#pragma unroll
        for (int i = 0; i < 16; ++i) p[i] = 0.f;
#pragma unroll
        for (int s = 0; s < DKS; ++s) p = MFMA32(kf[s], qf[s], p);
        if (kt == qb || (window != 0 && kt == qb - (window >> 5))) {
            const int k0 = 32 * kt + 8 * h;
#pragma unroll
            for (int i = 0; i < 16; ++i) { const int kv = k0 + 16 * (i >> 3) + (i & 7); const bool ok = (kv <= q) && (window == 0 || kv > q - window); if (!ok) p[i] = -INFINITY; }
        }
        float rm = MX3(p[0], p[1], p[2]);
#pragma unroll
        for (int i = 3; i < 15; i += 2) rm = MX3(rm, p[i], p[i + 1]);
        rm = xh_max(fmaxf(rm, p[15]));
        if (__any(rm > m + 6.f)) {
            const float mn = fmaxf(m, rm), f = ex2(m - mn); m = mn; l *= f;
#pragma unroll
            for (int i = 0; i < 16; ++i) { const float fi = __shfl(f, crow(i, h)); o0[i] *= fi; o1[i] *= fi; }
        }
        float e[16];
#pragma unroll
        for (int i = 0; i < 16; ++i) { e[i] = ex2(p[i] - m); l += e[i]; }
        const bf16x8 pa0 = pack8(e), pa1 = pack8(e + 8);
        o0 = MFMA32(pa0, v00, o0); o1 = MFMA32(pa0, v01, o1);
        o0 = MFMA32(pa1, v10, o0); o1 = MFMA32(pa1, v11, o1);
#pragma unroll
        for (int s = 0; s < DKS; ++s) kf[s] = kn[s];
        kp += (size_t)32 * kpitch; vp += 32;
    }
    l = xh_sum(l);
    if (SINK) l += ex2(sink2 - m);
    const float inv = 1.f / l;
    LAS bf16_t* sp = stg + (4 * h) * 64 + r;
#pragma unroll
    for (int i = 0; i < 16; ++i) { const float fi = __shfl(inv, crow(i, h)); const int ro = ((i & 3) + 8 * (i >> 2)) * 64;
        sp[ro] = f2bf(o0[i] * fi); sp[ro + 32] = f2bf(o1[i] * fi); }
    o_flush(stg, Orow0, opitch, lane);
}


constexpr int KP = 208, VP = 272;
constexpr int KT_BYTES = 128 * KP, VT_BYTES = 64 * VP, TB_BYTES = KT_BYTES + VT_BYTES, MRG_OFF = 2 * TB_BYTES;
static_assert(MRG_OFF + 4 * 34 * 64 * 4 <= 131072, "MLA LDS map");
__device__ __forceinline__ void mla_unit_blk(const bf16_t* __restrict__ QC, const bf16_t* __restrict__ KC, const bf16_t* __restrict__ VTC, bf16_t* __restrict__ Y,
                                             int bh, int g, LAS unsigned char* lds, int tid) {
    const int lane = tid & 63, wave = __builtin_amdgcn_readfirstlane(tid >> 6), r = lane & 31, h = lane >> 5, w4 = wave & 3, kh = wave >> 2;
    const int pr = (r & ~12) | ((r & 8) >> 1) | ((r & 4) << 1);
    const int b = bh >> 2, hh = bh & 3, qb = 4 * g + w4, q = 32 * qb + r;
    const bf16_t* Qp = QC + ((size_t)b * SEQ + q) * 384 + hh * 96 + 8 * h;
    bf16x8 qf[6];
#pragma unroll
    for (int s = 0; s < 6; ++s) qf[s] = *(const bf16x8*)(Qp + 16 * s);
    const bf16_t* Kg = KC + (size_t)b * SEQ * 384 + hh * 96;
    const bf16_t* Vg = VTC + (size_t)(b * 4 + hh) * 64 * SEQ;
    unsigned dgo[6];
#pragma unroll
    for (int i = 0; i < 6; ++i) { const int n = wave + 8 * i; unsigned o = 0u;
        if (n < 26) { const int j = 64 * n + lane, row = j / 13; int cc = j - 13 * row; cc = cc == 12 ? 0 : cc; o = (unsigned)(row * 384 + 8 * cc) * 2u; }
        else if (n < 43) { const int j = 64 * (n - 26) + lane, d = j / 17; int cc = j - 17 * d; cc = cc == 16 ? 0 : cc; o = (unsigned)(d * SEQ + 8 * cc) * 2u; }
        dgo[i] = o; }
#define MLA_DMA(ST, BO) do { const char* kb_ = (const char*)(Kg + (size_t)(ST) * (128 * 384)); const char* vb_ = (const char*)(Vg + (ST) * 128); \
        _Pragma("unroll") for (int i = 0; i < 6; ++i) { const int n = wave + 8 * i; \
            if (n < 26) __builtin_amdgcn_global_load_lds((const unsigned*)(kb_ + dgo[i]), (LAS unsigned*)(lds + (BO) + n * 1024), 16, 0, 0); \
            else if (n < 43) __builtin_amdgcn_global_load_lds((const unsigned*)(vb_ + dgo[i]), (LAS unsigned*)(lds + (BO) + KT_BYTES + (n - 26) * 1024), 16, 0, 0); } } while (0)
#define MLA_DMA_WAIT() asm volatile("s_waitcnt vmcnt(0)" ::: "memory")
    f32x16 o0, o1;
#pragma unroll
    for (int i = 0; i < 16; ++i) { o0[i] = 0.f; o1[i] = 0.f; }
    float m = 0.f, l = 0.f; bool first = true;
    f32x16 negm;
#pragma unroll
    for (int i = 0; i < 16; ++i) negm[i] = 0.f;
    const int nST = g + 1;
    MLA_DMA(0, 0); MLA_DMA_WAIT();
    __syncthreads();
    const int kfo = (64 * kh + pr) * KP + 16 * h;
    const int vfo = KT_BYTES + r * VP + (64 * kh + 8 * h) * 2;
    for (int ST = 0; ST < nST; ++ST) {
        if (ST + 1 < nST) MLA_DMA(ST + 1, ((ST + 1) & 1) * TB_BYTES);
        const int kt0 = 4 * ST + 2 * kh;
        if (kt0 <= qb) {
            const LAS unsigned char* tb = lds + (ST & 1) * TB_BYTES;
            f32x16 p0, p1;
            { const bf16x8 k0 = *(const LAS bf16x8*)(tb + kfo), k1 = *(const LAS bf16x8*)(tb + kfo + 32 * KP); p0 = MFMA32(k0, qf[0], negm); p1 = MFMA32(k1, qf[0], negm); }
#pragma unroll
            for (int s = 1; s < 6; ++s) { const bf16x8 k0 = *(const LAS bf16x8*)(tb + kfo + 32 * s), k1 = *(const LAS bf16x8*)(tb + kfo + 32 * KP + 32 * s);
                p0 = MFMA32(k0, qf[s], p0); p1 = MFMA32(k1, qf[s], p1); }
            if (kt0 + 1 >= qb) {
                const int kb0 = 32 * kt0 + 8 * h;
#pragma unroll
                for (int i = 0; i < 16; ++i) { const int kv = kb0 + 16 * (i >> 3) + (i & 7); if (kv > q) p0[i] = -INFINITY; if (kv + 32 > q) p1[i] = -INFINITY; }
            }
            float ra_ = MX3(p0[0], p0[1], p1[0]), rb_ = MX3(p0[2], p0[3], p1[1]); ra_ = MX3(ra_, p1[2], p1[3]);
#pragma unroll
            for (int i = 4; i < 16; i += 4) { ra_ = MX3(ra_, p0[i], p0[i + 1]); rb_ = MX3(rb_, p0[i + 2], p0[i + 3]); ra_ = MX3(ra_, p1[i], p1[i + 1]); rb_ = MX3(rb_, p1[i + 2], p1[i + 3]); }
            const float rm = xh_max(fmaxf(ra_, rb_));
            if (first || __any(rm > 6.f)) {
                const float dl = first ? rm : fmaxf(rm, 0.f);
                m += dl;
#pragma unroll
                for (int i = 0; i < 16; ++i) { p0[i] -= dl; p1[i] -= dl; negm[i] = -m; }
                if (!first) { const float f = ex2(-dl); l *= f;
#pragma unroll
                    for (int i = 0; i < 16; ++i) { const float fi = __shfl(f, crow(i, h)); o0[i] *= fi; o1[i] *= fi; } }
                first = false;
            }
            float ls = 0.f;
#pragma unroll
            for (int i = 0; i < 16; ++i) { p0[i] = ex2(p0[i]); p1[i] = ex2(p1[i]); ls += p0[i] + p1[i]; }
            l += ls;
            float e[8];
#pragma unroll
            for (int ks = 0; ks < 4; ++ks) {
#pragma unroll
                for (int j = 0; j < 8; ++j) e[j] = (ks < 2) ? p0[8 * ks + j] : p1[8 * (ks - 2) + j];
                const bf16x8 pa = pack8(e);
                const bf16x8 v0 = *(const LAS bf16x8*)(tb + vfo + 32 * ks), v1 = *(const LAS bf16x8*)(tb + vfo + 32 * VP + 32 * ks);
                o0 = MFMA32(pa, v0, o0); o1 = MFMA32(pa, v1, o1);
            }
        }
        MLA_DMA_WAIT();
        __syncthreads();
    }
#undef MLA_DMA
#undef MLA_DMA_WAIT
    if (first) m = -1e30f;
    l = xh_sum(l);
    LAS float* mg = (LAS float*)(lds + MRG_OFF) + w4 * (34 * 64) + lane;
    if (kh == 1) {
#pragma unroll
        for (int i = 0; i < 16; ++i) { mg[i * 64] = o0[i]; mg[(16 + i) * 64] = o1[i]; }
        mg[32 * 64] = m; mg[33 * 64] = l;
    }
    __syncthreads();
    if (kh == 0) {
        const float mb = mg[32 * 64], lb = mg[33 * 64];
        const float mn = fmaxf(m, mb), fa = ex2(m - mn), fb = ex2(mb - mn), inv = 1.f / (l * fa + lb * fb), ga = fa * inv, gb = fb * inv;
        LAS bf16_t* stg = (LAS bf16_t*)(lds + wave * 4096);
        LAS bf16_t* sp = stg + (4 * h) * 64 + r;
#pragma unroll
        for (int i = 0; i < 16; ++i) { const float ra = __shfl(ga, crow(i, h)), rb = __shfl(gb, crow(i, h)); const int ro = ((i & 3) + 8 * (i >> 2)) * 64;
            sp[ro] = f2bf(o0[i] * ra + mg[i * 64] * rb); sp[ro + 32] = f2bf(o1[i] * ra + mg[(16 + i) * 64] * rb); }
        o_flush(stg, Y + ((size_t)b * SEQ + 32 * qb) * DM + 512 + hh * 64, DM, lane);
    }
    __syncthreads();
}

__device__ __forceinline__ void sb_unit(const bf16_t* __restrict__ Qrow0, int qpitch, const bf16_t* __restrict__ Kb, int kpitch, const bf16_t* __restrict__ VT,
                                        int qb, bf16_t* __restrict__ Orow0, int opitch, int lane, LAS bf16_t* stg) {
    const int r = lane & 31, h = lane >> 5;
    const int pr = (r & ~12) | ((r & 8) >> 1) | ((r & 4) << 1);
    bf16x8 qf[4];
#pragma unroll
    for (int s = 0; s < 4; ++s) qf[s] = *(const bf16x8*)(Qrow0 + (size_t)r * qpitch + 16 * s + 8 * h);
    f32x16 o0, o1;
#pragma unroll
    for (int i = 0; i < 16; ++i) { o0[i] = 0.f; o1[i] = 0.f; }
    float carry = 0.f;
    const int q = 32 * qb + r;
    const bf16_t* kp = Kb + (size_t)(32 * qb + pr) * kpitch + 8 * h;
    const bf16_t* vp = VT + (size_t)r * SEQ + 32 * qb + 8 * h;
    bf16x8 kf[4];
#pragma unroll
    for (int s = 0; s < 4; ++s) kf[s] = *(const bf16x8*)(kp + 16 * s);
    for (int kt = qb; kt >= 0; --kt) {
        bf16x8 kn[4];
        if (kt > 0) {
#pragma unroll
            for (int s = 0; s < 4; ++s) kn[s] = *(const bf16x8*)(kp - (size_t)32 * kpitch + 16 * s);
        } else {
#pragma unroll
            for (int s = 0; s < 4; ++s) kn[s] = kf[s];
        }
        const bf16x8 v00 = *(const bf16x8*)(vp), v01 = *(const bf16x8*)(vp + 32 * SEQ), v10 = *(const bf16x8*)(vp + 16), v11 = *(const bf16x8*)(vp + 32 * SEQ + 16);
        f32x16 p;
#pragma unroll
        for (int i = 0; i < 16; ++i) p[i] = 0.f;
#pragma unroll
        for (int s = 0; s < 4; ++s) p = MFMA32(kf[s], qf[s], p);
        const bool diag = (kt == qb);
        const int k0 = 32 * kt + 8 * h;
        float sfx[16];
#pragma unroll
        for (int i = 0; i < 16; ++i) {
            const float z = p[i];
            float L = -(fmaxf(z, 0.f) + lg2(1.f + ex2(-fabsf(z))));
            if (diag) { const int kv = k0 + 16 * (i >> 3) + (i & 7); if (!(kv < q)) L = 0.f; }
            sfx[i] = L;
        }
#pragma unroll
        for (int g = 0; g < 2; ++g)
#pragma unroll
            for (int j = 6; j >= 0; --j) sfx[8 * g + j] += sfx[8 * g + j + 1];
        const float T0 = sfx[0], T1 = sfx[8];
        const float TP0 = __shfl_xor(T0, 32), TP1 = __shfl_xor(T1, 32);
        const float off1 = (h ? 0.f : TP1) + carry, off0 = T1 + TP1 + (h ? 0.f : TP0) + carry;
        float e[16];
#pragma unroll
        for (int i = 0; i < 16; ++i) {
            float a = ex2(p[i] + sfx[i] + (i < 8 ? off0 : off1));
            if (diag) { const int kv = k0 + 16 * (i >> 3) + (i & 7); if (!(kv < q)) a = 0.f; }
            e[i] = a;
        }
        carry += (T0 + T1) + (TP0 + TP1);
        const bf16x8 pa0 = pack8(e), pa1 = pack8(e + 8);
        o0 = MFMA32(pa0, v00, o0); o1 = MFMA32(pa0, v01, o1);
        o0 = MFMA32(pa1, v10, o0); o1 = MFMA32(pa1, v11, o1);
        if (__all(carry < -150.f)) break;
#pragma unroll
        for (int s = 0; s < 4; ++s) kf[s] = kn[s];
        kp -= (size_t)32 * kpitch; vp -= 32;
    }
    LAS bf16_t* sp = stg + (4 * h) * 64 + r;
#pragma unroll
    for (int i = 0; i < 16; ++i) { const int ro = ((i & 3) + 8 * (i >> 2)) * 64; sp[ro] = f2bf(o0[i]); sp[ro + 32] = f2bf(o1[i]); }
    o_flush(stg, Orow0, opitch, lane);
}


constexpr int AKP = 144;
constexpr int SWA_NK = 384, SWA_VP = SWA_NK * 2 + 16, SWA_KB = SWA_NK * AKP;
constexpr int SB_NK = 448, SB_VP = SB_NK * 2 + 16, SB_KB = SB_NK * AKP;
constexpr int STG_OFF = 122880, MISC_OFF = STG_OFF + 8 * 4096;
static_assert(SWA_KB + 64 * SWA_VP <= STG_OFF && SB_KB + 64 * SB_VP <= STG_OFF && MISC_OFF + 1024 == LDS_BYTES, "window LDS map");
template <int NK, int VPB>
__device__ __forceinline__ void stage_kv64(const bf16_t* __restrict__ Kb, int kpitch, const bf16_t* __restrict__ VT, int key0, LAS unsigned char* lds, int tid) {
    constexpr int NCH = NK * 8 / 512, VC = NK / 8;
    u32x4 kr[NCH], vr[NCH];
#pragma unroll
    for (int i = 0; i < NCH; ++i) { const int c = tid + 512 * i, row = c >> 3, cc = c & 7; int key = key0 + row; key = key < 0 ? 0 : key;
        kr[i] = *(const u32x4*)(Kb + (size_t)key * kpitch + 8 * cc); }
#pragma unroll
    for (int i = 0; i < NCH; ++i) { const int c = tid + 512 * i, d = c / VC, cc = c - d * VC; int key = key0 + 8 * cc; key = key < 0 ? 0 : key;
        vr[i] = *(const u32x4*)(VT + (size_t)d * SEQ + key); }
#pragma unroll
    for (int i = 0; i < NCH; ++i) { const int c = tid + 512 * i, row = c >> 3, cc = c & 7; *(LAS u32x4*)(lds + row * AKP + 16 * cc) = kr[i]; }
#pragma unroll
    for (int i = 0; i < NCH; ++i) { const int c = tid + 512 * i, d = c / VC, cc = c - d * VC; *(LAS u32x4*)(lds + NK * AKP + d * VPB + 16 * cc) = vr[i]; }
}
template <int NK, int VPB>
__device__ __forceinline__ void stage_kv64_T(const bf16_t* __restrict__ Kb, int kpitch, const bf16_t* __restrict__ Vb, int vpitch, int key0, LAS unsigned char* lds, int tid) {
    constexpr int NCH = NK * 8 / 512, NB = NK / 32;
    const int lane = tid & 63, wave = __builtin_amdgcn_readfirstlane(tid >> 6), r = lane & 31, h = lane >> 5;
    u32x4 kr[NCH]; bf16x8 vv[2][4];
#pragma unroll
    for (int i = 0; i < NCH; ++i) { const int c = tid + 512 * i, row = c >> 3, cc = c & 7; int key = key0 + row; key = key < 0 ? 0 : key;
        kr[i] = *(const u32x4*)(Kb + (size_t)key * kpitch + 8 * cc); }
#pragma unroll
    for (int t = 0; t < 2; ++t) { const int tbk = wave + 8 * t; if (tbk < NB) { int key = key0 + 32 * tbk + r; key = key < 0 ? 0 : key;
#pragma unroll
        for (int c = 0; c < 4; ++c) vv[t][c] = *(const bf16x8*)(Vb + (size_t)key * vpitch + 32 * h + 8 * c); } }
#pragma unroll
    for (int i = 0; i < NCH; ++i) { const int c = tid + 512 * i, row = c >> 3, cc = c & 7; *(LAS u32x4*)(lds + row * AKP + 16 * cc) = kr[i]; }
#pragma unroll
    for (int t = 0; t < 2; ++t) { const int tbk = wave + 8 * t; if (tbk < NB) { LAS bf16_t* sp = (LAS bf16_t*)(lds + NK * AKP + (32 * h) * VPB) + 32 * tbk + r;
#pragma unroll
        for (int c = 0; c < 4; ++c)
#pragma unroll
            for (int j = 0; j < 8; ++j) sp[(8 * c + j) * (VPB / 2)] = (bf16_t)vv[t][c][j]; } }
}
__device__ __forceinline__ void swa_wave_lds(const bf16_t* __restrict__ Qrow0, int qpitch, const LAS unsigned char* lds, int qb, int kt_base, float sink2,
                                             bf16_t* __restrict__ Orow0, int opitch, int lane, LAS bf16_t* stg) {
    const int r = lane & 31, h = lane >> 5;
    const int pr = (r & ~12) | ((r & 8) >> 1) | ((r & 4) << 1);
    bf16x8 qf[4];
#pragma unroll
    for (int s = 0; s < 4; ++s) qf[s] = *(const bf16x8*)(Qrow0 + (size_t)r * qpitch + 16 * s + 8 * h);
    f32x16 o0, o1;
#pragma unroll
    for (int i = 0; i < 16; ++i) { o0[i] = 0.f; o1[i] = 0.f; }
    float m = -1e30f, l = 0.f;
    const int q = 32 * qb + r, kt_begin = qb - 4 > 0 ? qb - 4 : 0;
    for (int kt = kt_begin; kt <= qb; ++kt) {
        const int rel = kt - kt_base;
        const LAS unsigned char* kp = lds + (32 * rel + pr) * AKP + 16 * h;
        const LAS unsigned char* vp = lds + SWA_KB + r * SWA_VP + (32 * rel + 8 * h) * 2;
        f32x16 p;
#pragma unroll
        for (int i = 0; i < 16; ++i) p[i] = 0.f;
#pragma unroll
        for (int s = 0; s < 4; ++s) p = MFMA32(*(const LAS bf16x8*)(kp + 32 * s), qf[s], p);
        if (kt == qb || kt == qb - 4) {
            const int k0 = 32 * kt + 8 * h;
#pragma unroll
            for (int i = 0; i < 16; ++i) { const int kv = k0 + 16 * (i >> 3) + (i & 7); const bool ok = (kv <= q) && (kv > q - 128); if (!ok) p[i] = -INFINITY; }
        }
        float rm = MX3(p[0], p[1], p[2]);
#pragma unroll
        for (int i = 3; i < 15; i += 2) rm = MX3(rm, p[i], p[i + 1]);
        rm = xh_max(fmaxf(rm, p[15]));
        if (__any(rm > m + 6.f)) {
            const float mn = fmaxf(m, rm), f = ex2(m - mn); m = mn; l *= f;
#pragma unroll
            for (int i = 0; i < 16; ++i) { const float fi = __shfl(f, crow(i, h)); o0[i] *= fi; o1[i] *= fi; }
        }
        float e[16];
#pragma unroll
        for (int i = 0; i < 16; ++i) { e[i] = ex2(p[i] - m); l += e[i]; }
        const bf16x8 pa0 = pack8(e), pa1 = pack8(e + 8);
        o0 = MFMA32(pa0, *(const LAS bf16x8*)(vp), o0); o1 = MFMA32(pa0, *(const LAS bf16x8*)(vp + 32 * SWA_VP), o1);
        o0 = MFMA32(pa1, *(const LAS bf16x8*)(vp + 32), o0); o1 = MFMA32(pa1, *(const LAS bf16x8*)(vp + 32 * SWA_VP + 32), o1);
    }
    l = xh_sum(l);
    l += ex2(sink2 - m);
    const float inv = 1.f / l;
    LAS bf16_t* sp = stg + (4 * h) * 64 + r;
#pragma unroll
    for (int i = 0; i < 16; ++i) { const float fi = __shfl(inv, crow(i, h)); const int ro = ((i & 3) + 8 * (i >> 2)) * 64;
        sp[ro] = f2bf(o0[i] * fi); sp[ro + 32] = f2bf(o1[i] * fi); }
    o_flush(stg, Orow0, opitch, lane);
}
#define SB_STEP(KT_, V00_, V01_, V10_, V11_) do { \
        const bool diag = ((KT_) == qb); const int k0 = 32 * (KT_) + 8 * h; float sfx[16]; \
        _Pragma("unroll") for (int i = 0; i < 16; ++i) { const float z = p[i]; float L = -(fmaxf(z, 0.f) + lg2(1.f + ex2(-fabsf(z)))); \
            if (diag) { const int kv = k0 + 16 * (i >> 3) + (i & 7); if (!(kv < q)) L = 0.f; } sfx[i] = L; } \
        _Pragma("unroll") for (int g = 0; g < 2; ++g) _Pragma("unroll") for (int j = 6; j >= 0; --j) sfx[8 * g + j] += sfx[8 * g + j + 1]; \
        const float T0 = sfx[0], T1 = sfx[8]; const float TP0 = xh_other(T0, h), TP1 = xh_other(T1, h); \
        const float off1 = (h ? 0.f : TP1) + carry, off0 = T1 + TP1 + (h ? 0.f : TP0) + carry; float e[16]; \
        _Pragma("unroll") for (int i = 0; i < 16; ++i) { float a = ex2(p[i] + sfx[i] + (i < 8 ? off0 : off1)); \
            if (diag) { const int kv = k0 + 16 * (i >> 3) + (i & 7); if (!(kv < q)) a = 0.f; } e[i] = a; } \
        carry += (T0 + T1) + (TP0 + TP1); \
        const bf16x8 pa0 = pack8(e), pa1 = pack8(e + 8); \
        o0 = MFMA32(pa0, (V00_), o0); o1 = MFMA32(pa0, (V01_), o1); o0 = MFMA32(pa1, (V10_), o0); o1 = MFMA32(pa1, (V11_), o1); } while (0)
__device__ __forceinline__ void sb_wave_lds(const bf16_t* __restrict__ Qrow0, int qpitch, const LAS unsigned char* lds, const bf16_t* __restrict__ Kb, int kpitch,
                                            const bf16_t* __restrict__ Vb, int vpitch, int qb, int kt_base, bf16_t* __restrict__ Orow0, int opitch, int lane, LAS bf16_t* stg) {
    const int r = lane & 31, h = lane >> 5;
    const int pr = (r & ~12) | ((r & 8) >> 1) | ((r & 4) << 1);
    bf16x8 qf[4];
#pragma unroll
    for (int s = 0; s < 4; ++s) qf[s] = *(const bf16x8*)(Qrow0 + (size_t)r * qpitch + 16 * s + 8 * h);
    f32x16 o0, o1;
#pragma unroll
    for (int i = 0; i < 16; ++i) { o0[i] = 0.f; o1[i] = 0.f; }
    float carry = 0.f;
    const int q = 32 * qb + r;
    const int kt_lo = kt_base > 0 ? kt_base : 0;
    bool done = false;
    int kt = qb;
    for (; kt >= kt_lo; --kt) {
        const int rel = kt - kt_base;
        const LAS unsigned char* kp = lds + (32 * rel + pr) * AKP + 16 * h;
        const LAS unsigned char* vp = lds + SB_KB + r * SB_VP + (32 * rel + 8 * h) * 2;
        f32x16 p;
#pragma unroll
        for (int i = 0; i < 16; ++i) p[i] = 0.f;
#pragma unroll
        for (int s = 0; s < 4; ++s) p = MFMA32(*(const LAS bf16x8*)(kp + 32 * s), qf[s], p);
        SB_STEP(kt, *(const LAS bf16x8*)(vp), *(const LAS bf16x8*)(vp + 32 * SB_VP), *(const LAS bf16x8*)(vp + 32), *(const LAS bf16x8*)(vp + 32 * SB_VP + 32));
        if (__all(carry < -150.f)) { done = true; break; }
    }
    if (!done && kt >= 0) {
        const bf16_t* kp = Kb + (size_t)(32 * kt + pr) * kpitch + 8 * h;
        for (; kt >= 0; --kt) {
            bf16x8 kf[4];
#pragma unroll
            for (int s = 0; s < 4; ++s) kf[s] = *(const bf16x8*)(kp + 16 * s);
            bf16x8 v00, v01, v10, v11;
            { const bf16_t* vg = Vb + (size_t)(32 * kt + 8 * h) * vpitch + r;
#pragma unroll
              for (int j = 0; j < 8; ++j) { v00[j] = (short)vg[(size_t)j * vpitch]; v01[j] = (short)vg[(size_t)j * vpitch + 32]; v10[j] = (short)vg[(size_t)(16 + j) * vpitch]; v11[j] = (short)vg[(size_t)(16 + j) * vpitch + 32]; } }
            f32x16 p;
#pragma unroll
            for (int i = 0; i < 16; ++i) p[i] = 0.f;
#pragma unroll
            for (int s = 0; s < 4; ++s) p = MFMA32(kf[s], qf[s], p);
            SB_STEP(kt, v00, v01, v10, v11);
            if (__all(carry < -150.f)) break;
            kp -= (size_t)32 * kpitch;
        }
    }
    LAS bf16_t* sp = stg + (4 * h) * 64 + r;
#pragma unroll
    for (int i = 0; i < 16; ++i) { const int ro = ((i & 3) + 8 * (i >> 2)) * 64; sp[ro] = f2bf(o0[i]); sp[ro + 32] = f2bf(o1[i]); }
    o_flush(stg, Orow0, opitch, lane);
}
#undef SB_STEP

#define XB_TMO      128
#define XB_XCNT(j)  (256  + 64 * (j))
#define XB_XSUB(j)  (1280 + 64 * (j))
#define XB_XGEN(j)  (2304 + 64 * (j))
#define XB_TOP      3328
#define XB_TOPGEN   3392
#define XCD_BAR_WORDS 3456
#define XB_SPIN_CAP (1u << 18)

__device__ __forceinline__ unsigned xb_ld(unsigned* p)              { return __hip_atomic_load(p, __ATOMIC_RELAXED, __HIP_MEMORY_SCOPE_AGENT); }
__device__ __forceinline__ unsigned xb_add(unsigned* p, unsigned v) { return __hip_atomic_fetch_add(p, v, __ATOMIC_RELAXED, __HIP_MEMORY_SCOPE_AGENT); }
__device__ __forceinline__ unsigned xb_xcc_id() { return (unsigned)__builtin_amdgcn_s_getreg((3 << 11) | 20) & 0xFu; }
#define XB_SPIN(cond, bar) do { unsigned _sp = 0; while (cond) { __builtin_amdgcn_s_sleep(1); \
    if ((++_sp & 255u) == 0u) { if (xb_ld(&(bar)[XB_TMO])) break; if (_sp > XB_SPIN_CAP) { atomicAdd(&(bar)[XB_TMO], 1u); break; } } } } while (0)

struct XcdBarrier {
    unsigned* bar; unsigned x;
    volatile LAS unsigned* st;
};

__device__ __forceinline__ XcdBarrier xcd_barrier_post(unsigned* bar, volatile LAS unsigned* st) {
    XcdBarrier b; b.bar = bar; b.x = xb_xcc_id(); b.st = st;
    if (threadIdx.x == 0) (void)xb_add(&bar[XB_XCNT(b.x)], 1u);
    return b;
}
__device__ __forceinline__ void xcd_barrier_complete(unsigned* bar, unsigned x, unsigned& nloc, unsigned& nx) {
    const unsigned G = gridDim.x * gridDim.y * gridDim.z;
    unsigned sum, cnt, mine, sp = 0u;
    for (;;) {
        sum = 0u; cnt = 0u; mine = 0u;
#pragma unroll
        for (unsigned j = 0; j < 16; ++j) { const unsigned c = xb_ld(&bar[XB_XCNT(j)]); sum += c; cnt += (c > 0u) ? 1u : 0u; mine = (j == x) ? c : mine; }
        if (sum == G) break;
        __builtin_amdgcn_s_sleep(1);
        if ((++sp & 255u) == 0u) { if (xb_ld(&bar[XB_TMO])) break; if (sp > XB_SPIN_CAP) { atomicAdd(&bar[XB_TMO], 1u); break; } }
    }
    nloc = mine > 0u ? mine : 1u; nx = cnt > 0u ? cnt : 1u;
}

__device__ __forceinline__ void xcd_barrier(const XcdBarrier& b) {
    asm volatile("s_waitcnt vmcnt(0)" ::: "memory");
    __syncthreads();
    if (threadIdx.x == 0) {
        unsigned* bar = b.bar;
        __builtin_amdgcn_s_waitcnt(0);
        unsigned nloc = b.st[0], nx = b.st[1];
        if (nloc == 0u) { xcd_barrier_complete(bar, b.x, nloc, nx); b.st[0] = nloc; b.st[1] = nx; }
        const unsigned old = xb_add(&bar[XB_XSUB(b.x)], 1u);
        const unsigned gen = old / nloc;
        if (old + 1u == (gen + 1u) * nloc) {
            __builtin_amdgcn_fence(__ATOMIC_RELEASE, "agent");
            asm volatile("s_waitcnt vmcnt(0)" ::: "memory");
            const unsigned og = xb_add(&bar[XB_TOP], 1u);
            const unsigned tg = og / nx;
            if (og + 1u == (tg + 1u) * nx) xb_add(&bar[XB_TOPGEN], 1u);
            else XB_SPIN(xb_ld(&bar[XB_TOPGEN]) == tg, bar);
            __builtin_amdgcn_fence(__ATOMIC_ACQUIRE, "agent");
            xb_add(&bar[XB_XGEN(b.x)], 1u);
            asm volatile("s_waitcnt vmcnt(0)" ::: "memory");
        } else {
            XB_SPIN(xb_ld(&bar[XB_XGEN(b.x)]) == gen, bar);
            __builtin_amdgcn_fence(__ATOMIC_ACQUIRE, "agent");
            asm volatile("s_waitcnt vmcnt(0)" ::: "memory");
        }
    }
    __syncthreads();
}

__global__ void __launch_bounds__(NTHREADS, 2) fwd(Params P) {
    extern __shared__ __attribute__((aligned(16))) unsigned char lds_raw[];
    LAS unsigned char* lds = (LAS unsigned char*)lds_raw;
    constexpr int G = 256, NGW = G * NWAVES, gthreads = G * NTHREADS;
    const int bx = blockIdx.x;
#if MK_COOP
    cooperative_groups::grid_group grid = cooperative_groups::this_grid();
    volatile LAS unsigned* MISC = (volatile LAS unsigned*)(lds + MISC_OFF);
    if (threadIdx.x < 64) MISC[threadIdx.x] = 0u;
    __syncthreads();
    XcdBarrier bar = xcd_barrier_post((unsigned*)(P.ws + WS_CTL) + CW_BAR, MISC + 8);
#endif
    for (int ph = P.ph_lo; ph < P.ph_hi; ++ph) {
        const int nrep = ((ph >= 1 && ph <= 6 && ((ph - 1) == MK_REP_K || (MK_REP_K == 6 && ph == 3))) || (ph == 0 && MK_REP_K == 7)) ? MK_REP_N : 1;
        for (int rep = 0; rep < nrep; ++rep) {
        int tid_o = threadIdx.x; asm volatile("" : "+v"(tid_o));
        const int tid = tid_o, lane = tid & 63, wave = __builtin_amdgcn_readfirstlane(tid >> 6);
        const int gw = bx * NWAVES + wave, gtid = bx * NTHREADS + tid;
        LAS bf16_t* stg = (LAS bf16_t*)(lds + 122880 + wave * 4096);
        unsigned char* ws = P.ws; asm volatile("" : "+s"(ws));
        unsigned* ctl = (unsigned*)(ws + WS_CTL);
        bf16_t* XN = (bf16_t*)(ws + WS_XN); bf16_t* H = (bf16_t*)(ws + WS_H);
        bf16_t* QC = (bf16_t*)(ws + WS_QC); bf16_t* KC = (bf16_t*)(ws + WS_KC);
        bf16_t* VTC = (bf16_t*)(ws + WS_VTC); bf16_t* VTA = (bf16_t*)(ws + WS_VTA); bf16_t* VTD = (bf16_t*)(ws + WS_VTD);
        bf16_t* Y = (bf16_t*)(ws + WS_Y);
        if (ph == 0) {
            {
                LAS float* scr = (LAS float*)(lds + wave * 16384);
                constexpr int I_IN = (DM / 64) * (DIN / 32), I_OUT = (DM / 64) * (DM / 32), I_UQ = (256 / 64) * (384 / 32), I_UKV = (128 / 64) * (512 / 32), I_L = I_IN + I_OUT + I_UQ + I_UKV;
                for (int it = gw; it < NLAYER * I_L; it += NGW) {
                    const int l = it / I_L; int v = it - l * I_L;
                    if (v < I_IN) { wT_item(P.w_in + (size_t)l * DM * DIN, DM, DIN, P.norm_pre + l * DM, (bf16_t*)(ws + WS_WIN) + (size_t)l * DINP * DM, C_AQ, C_AQ + 256, C_DQ, C_DQ + 256, SC64, scr, v, lane); continue; } v -= I_IN;
                    if (v < I_OUT) { wT_item(P.w_out + (size_t)l * DM * DM, DM, DM, P.g_grp + l * DM, (bf16_t*)(ws + WS_WOUT) + (size_t)l * DM * DM, 0, 0, 0, 0, 1.f, scr, v, lane); continue; } v -= I_OUT;
                    if (v < I_UQ) { wT_item(P.w_uq + (size_t)l * 256 * 384, 256, 384, P.g_cq + l * 256, (bf16_t*)(ws + WS_WUQ + (size_t)l * 262144), 0, 0, 0, 0, 1.f, scr, v, lane); continue; } v -= I_UQ;
                    wT_item(P.w_ukv + (size_t)l * 128 * 512, 128, 512, P.g_ckv + l * 128, (bf16_t*)(ws + WS_WUKV + (size_t)l * 131072), 0, 0, 0, 0, 1.f, scr, v, lane);
                }
                for (int it = gtid; it < NLAYER * (DINP - DIN) * (DM / 8); it += gthreads) { const int l = it / ((DINP - DIN) * (DM / 8)), v = it - l * ((DINP - DIN) * (DM / 8));
                    *(u32x4*)((bf16_t*)(ws + WS_WIN) + (size_t)l * DINP * DM + (size_t)DIN * DM + (size_t)v * 8) = (u32x4){0u, 0u, 0u, 0u}; }
            }
            { const float* __restrict__ xr = P.x; bf16_t* __restrict__ xo = XN;
#pragma unroll 2
              for (int mrow = gw; mrow < M_TOK; mrow += NGW) rms_row_to_bf16(xr + (size_t)mrow * DM, xo + (size_t)mrow * DM, lane); }
        } else {
            const int l = (ph - 1) / 6, k = (ph - 1) % 6;
            if (k == 0 || k == 4) {
                if (k == 0) {
                    pg8::Gemm g{XN, (const bf16_t*)(ws + WS_WIN) + (size_t)l * DINP * DM, M_TOK, DINP, DM}; pg8::StaticOrder S; S.init(M_TOK, DINP, G, bx);
                    pg8::EpiBf16<0> E{H, DINP, nullptr, 0, 0, 1.f};
                    pg8::gemm_phase<pg8::EpiBf16<0>, pg8::StaticOrder, true, true>(lds, g, S, E);
                } else {
                    pg8::Gemm g{XN, (const bf16_t*)(ws + WS_WOUT) + (size_t)l * DM * DM, M_TOK, DM, DM}; pg8::StaticOrder S; S.init(M_TOK, DM, G, bx);
                    pg8::EpiBf16<0> E{Y, DM, nullptr, 0, 0, 1.f};
                    pg8::gemm_phase<pg8::EpiBf16<0>, pg8::StaticOrder, true, true>(lds, g, S, E);
                }
            } else if (k == 1) {
                const bf16_t* WUQ = (const bf16_t*)(ws + WS_WUQ + (size_t)l * 262144);
                const bf16_t* WUKV = (const bf16_t*)(ws + WS_WUKV + (size_t)l * 131072);
                {
                    const int hh = bx & 3, tg = bx >> 2;
                    u32x4 wq[6], wk[4];
#pragma unroll
                    for (int i = 0; i < 6; ++i) { const int c = tid + 512 * i, row = c >> 5, cc = c & 31; wq[i] = *(const u32x4*)(WUQ + (size_t)(hh * 96 + row) * 256 + 8 * cc); }
#pragma unroll
                    for (int i = 0; i < 4; ++i) { const int c = tid + 512 * i, row = c >> 4, cc = c & 15; wk[i] = *(const u32x4*)(WUKV + (size_t)(hh * 128 + row) * 128 + 8 * cc); }
#pragma unroll
                    for (int i = 0; i < 6; ++i) { const int c = tid + 512 * i, row = c >> 5, cc = c & 31; *(LAS u32x4*)(lds + row * WQP + 16 * cc) = wq[i]; }
#pragma unroll
                    for (int i = 0; i < 4; ++i) { const int c = tid + 512 * i, row = c >> 4, cc = c & 15; *(LAS u32x4*)(lds + WQ_BYTES + row * WKP + 16 * cc) = wk[i]; }
                    __syncthreads();
                    const int tb = 8 * tg + wave;
                    mq_unit(H, lds, P.pos, QC, tb, hh, lane);
                    mkv_unit(H, lds + WQ_BYTES, P.pos, KC, VTC, tb, hh, lane, stg);
                }
                constexpr int NTB = M_TOK / 32;
                constexpr int U_ALL = M_TOK / 8;
                for (int u = gw; u < U_ALL; u += NGW) {
                    const int v = u;
                    conv_unit(H, P.conv_w + l * 768, P.conv_b + l * 256, Y, v, lane);
                }
            } else if (k == 2) {
                if (rep == 0 || MK_REP_K == 2)
                for (int pu = bx; pu < 256; pu += G) {
                    const int bh = pu & 7, Gq = pu >> 3;
                    mla_unit_blk(QC, KC, VTC, Y, bh, 63 - Gq, lds, tid);
                    mla_unit_blk(QC, KC, VTC, Y, bh, Gq, lds, tid);
                }
                if (rep == 0 || MK_REP_K == 6) {
                    const int bh = bx & 7, G8 = bx >> 3, b = bh >> 2, hh = bh & 3, qb = 8 * G8 + wave;
                    const size_t row0 = (size_t)b * SEQ + 32 * qb;
                    LAS bf16_t* ostg = (LAS bf16_t*)(lds + STG_OFF + wave * 4096);
                    {
                        const int kvh = hh >> 1;
                        const bf16_t* Kb = H + (size_t)b * SEQ * DINP + C_AK + kvh * 64;
                        stage_kv64_T<SWA_NK, SWA_VP>(Kb, DINP, H + (size_t)b * SEQ * DINP + C_AV + kvh * 64, DINP, 256 * G8 - 128, lds, tid);
                        __syncthreads();
                        swa_wave_lds(H + row0 * DINP + C_AQ + hh * 64, DINP, lds, qb, 8 * G8 - 4, P.sinks[l * 4 + hh] * LOG2E, Y + row0 * DM + hh * 64, DM, lane, ostg);
                        __syncthreads();
                    }
                    {
                        const bf16_t* Kb = H + (size_t)b * SEQ * DINP + C_DK + hh * 64;
                        const bf16_t* Vb = H + (size_t)b * SEQ * DINP + C_DV + hh * 64;
                        stage_kv64_T<SB_NK, SB_VP>(Kb, DINP, Vb, DINP, 256 * G8 - 192, lds, tid);
                        __syncthreads();
                        sb_wave_lds(H + row0 * DINP + C_DQ + hh * 64, DINP, lds, Kb, DINP, Vb, DINP, qb, 8 * G8 - 6, Y + row0 * DM + 768 + hh * 64, DM, lane, ostg);
                        __syncthreads();
                    }
                }
            } else if (k == 3) {
                const bf16_t* __restrict__ Yr = Y; const bf16_t* __restrict__ Hr = H; bf16_t* __restrict__ XNw = XN;
#pragma unroll 2
                for (int mrow = gw; mrow < M_TOK; mrow += NGW) {
                    const u32x4* yp = (const u32x4*)(Yr + (size_t)mrow * DM) + 2 * lane;
                    const u32x4* gp = (const u32x4*)(Hr + (size_t)mrow * DINP + C_GATE) + 2 * lane;
                    const u32x4 y0 = yp[0], y1 = yp[1], g0 = gp[0], g1 = gp[1];
                    float yv[16], gv[16];
#pragma unroll
                    for (int j = 0; j < 4; ++j) { yv[2 * j] = bflo(y0[j]); yv[2 * j + 1] = bfhi(y0[j]); yv[8 + 2 * j] = bflo(y1[j]); yv[8 + 2 * j + 1] = bfhi(y1[j]);
                                                  gv[2 * j] = bflo(g0[j]); gv[2 * j + 1] = bfhi(g0[j]); gv[8 + 2 * j] = bflo(g1[j]); gv[8 + 2 * j + 1] = bfhi(g1[j]); }
                    float ss = 0.f;
#pragma unroll
                    for (int j = 0; j < 16; ++j) ss += yv[j] * yv[j];
                    ss += __shfl_xor(ss, 1); ss += __shfl_xor(ss, 2); ss += __shfl_xor(ss, 4); ss += __shfl_xor(ss, 8);
                    const float rs = rsqrtf(ss * (1.f / 256.f) + EPS);
                    float o[16];
#pragma unroll
                    for (int j = 0; j < 16; ++j) { const float gg = gv[j]; o[j] = yv[j] * rs * gg * __builtin_amdgcn_rcpf(1.f + ex2(-gg * LOG2E)); }
                    u32x4 w0, w1;
#pragma unroll
                    for (int j = 0; j < 4; ++j) { w0[j] = pk2(o[2 * j], o[2 * j + 1]); w1[j] = pk2(o[8 + 2 * j], o[8 + 2 * j + 1]); }
                    u32x4* op = (u32x4*)(XNw + (size_t)mrow * DM) + 2 * lane;
                    op[0] = w0; op[1] = w1;
                }
            } else {
                const float* base = P.x;
                const float* gpost = P.g_post + l * DM;
                for (int mrow0 = gw; mrow0 < M_TOK; mrow0 += 2 * NGW) {
                    f32x4 zz[2][4], xv[2][4]; float s1[2] = {0.f, 0.f}, s2[2] = {0.f, 0.f};
                    const bool two = (mrow0 + NGW < M_TOK);
#pragma unroll
                    for (int rr = 0; rr < 2; ++rr) { const int mrow = (rr == 0 || two) ? mrow0 + rr * NGW : mrow0;
#pragma unroll
                        for (int j = 0; j < 4; ++j) { const u32x2 w = ((const u32x2*)(Y + (size_t)mrow * DM))[lane + 64 * j]; zz[rr][j] = (f32x4){bflo(w.x), bfhi(w.x), bflo(w.y), bfhi(w.y)};
                            if (l == 0) xv[rr][j] = __builtin_nontemporal_load((const f32x4*)(base + (size_t)mrow * DM) + lane + 64 * j);
                            else { const u32x2 xb = ((const u32x2*)(P.out + (size_t)mrow * DM))[lane + 64 * j]; xv[rr][j] = (f32x4){bflo(xb.x), bfhi(xb.x), bflo(xb.y), bfhi(xb.y)}; } } }
                    f32x4 gpv[4];
#pragma unroll
                    for (int j = 0; j < 4; ++j) gpv[j] = ((const f32x4*)gpost)[lane + 64 * j];
#pragma unroll
                    for (int rr = 0; rr < 2; ++rr)
#pragma unroll
                        for (int j = 0; j < 4; ++j) s1[rr] += (zz[rr][j].x * zz[rr][j].x + zz[rr][j].y * zz[rr][j].y) + (zz[rr][j].z * zz[rr][j].z + zz[rr][j].w * zz[rr][j].w);
                    const float rz0 = rsqrtf(wave_sum(s1[0]) * (1.f / DM) + EPS), rz1 = rsqrtf(wave_sum(s1[1]) * (1.f / DM) + EPS);
#pragma unroll
                    for (int rr = 0; rr < 2; ++rr) { const float rz = rr ? rz1 : rz0;
#pragma unroll
                        for (int j = 0; j < 4; ++j) { xv[rr][j] = xv[rr][j] + zz[rr][j] * rz * gpv[j];
                            s2[rr] += (xv[rr][j].x * xv[rr][j].x + xv[rr][j].y * xv[rr][j].y) + (xv[rr][j].z * xv[rr][j].z + xv[rr][j].w * xv[rr][j].w); } }
#pragma unroll
                    for (int rr = 0; rr < 2; ++rr) { if (rr == 1 && !two) break; const int mrow = mrow0 + rr * NGW;
#pragma unroll
                        for (int j = 0; j < 4; ++j) {
                            if (l + 1 < NLAYER) { u32x2 o; o.x = pk2(xv[rr][j].x, xv[rr][j].y); o.y = pk2(xv[rr][j].z, xv[rr][j].w); ((u32x2*)(P.out + (size_t)mrow * DM))[lane + 64 * j] = o; }
                            else __builtin_nontemporal_store(xv[rr][j], (f32x4*)(P.out + (size_t)mrow * DM) + lane + 64 * j); } }
                    if (l + 1 < NLAYER) {
                        const float r0 = rsqrtf(wave_sum(s2[0]) * (1.f / DM) + EPS), r1 = rsqrtf(wave_sum(s2[1]) * (1.f / DM) + EPS);
#pragma unroll
                        for (int rr = 0; rr < 2; ++rr) { if (rr == 1 && !two) break; const int mrow = mrow0 + rr * NGW; const float rs = rr ? r1 : r0;
#pragma unroll
                            for (int j = 0; j < 4; ++j) { u32x2 o; o.x = pk2(xv[rr][j].x * rs, xv[rr][j].y * rs); o.y = pk2(xv[rr][j].z * rs, xv[rr][j].w * rs); ((u32x2*)(XN + (size_t)mrow * DM))[lane + 64 * j] = o; } }
                    }
                }
            }
            }
        }
        if (ph + 1 < P.ph_hi) {
#if MK_COOP
            if (P.ph_hi < 0) grid.sync();
            xcd_barrier(bar);
#endif
        }
    }
}
}

extern "C" void kernel_launch(void* const* d_in, const int* in_sizes, int n_in, void* d_out, int out_size, void* d_ws, size_t ws_size, hipStream_t stream) {
    using namespace mk;
    static int grid = 0;
    if (grid == 0) {
        if (n_in != 14 || out_size != M_TOK * DM || ws_size < WS_END) { fprintf(stderr, "kernel_launch: unexpected shapes (n_in %d out %d ws %zu)\n", n_in, out_size, ws_size); grid = -1; return; }
        int dev = 0, cus = 0, per_cu = 0;
        (void)hipGetDevice(&dev); (void)hipDeviceGetAttribute(&cus, hipDeviceAttributeMultiprocessorCount, dev);
        if (hipFuncSetAttribute((const void*)fwd, hipFuncAttributeMaxDynamicSharedMemorySize, LDS_BYTES) != hipSuccess) { fprintf(stderr, "kernel_launch: hipFuncSetAttribute failed\n"); grid = -1; return; }
        if (hipOccupancyMaxActiveBlocksPerMultiprocessor(&per_cu, (const void*)fwd, NTHREADS, LDS_BYTES) != hipSuccess || per_cu < 1) { fprintf(stderr, "kernel_launch: occupancy query says %d\n", per_cu); per_cu = 1; }
        (void)hipGetLastError();
        if (cus < 256) { fprintf(stderr, "kernel_launch: built for a 256-CU device (one workgroup per CU), found %d CUs\n", cus); grid = -1; return; }
        grid = 256;
    }
    if (grid < 0) return;
    (void)hipMemsetAsync((char*)d_ws + WS_CTL, 0, CTL_BYTES, stream);
    Params p{};
    p.x = (const float*)d_in[0]; p.pos = (const int*)d_in[1]; p.norm_pre = (const float*)d_in[2]; p.w_in = (const float*)d_in[3]; p.sinks = (const float*)d_in[4];
    p.conv_w = (const float*)d_in[5]; p.conv_b = (const float*)d_in[6]; p.g_cq = (const float*)d_in[7]; p.w_uq = (const float*)d_in[8]; p.g_ckv = (const float*)d_in[9];
    p.w_ukv = (const float*)d_in[10]; p.g_grp = (const float*)d_in[11]; p.w_out = (const float*)d_in[12]; p.g_post = (const float*)d_in[13];
    p.out = (float*)d_out; p.ws = (unsigned char*)d_ws;
    constexpr int NPH = 1 + 6 * NLAYER;
#if MK_COOP
    p.ph_lo = 0; p.ph_hi = NPH;
    void* args[] = {&p};
    hipError_t e = hipLaunchCooperativeKernel((const void*)fwd, dim3(grid), dim3(NTHREADS), args, LDS_BYTES, stream);
    if (e != hipSuccess) fprintf(stderr, "kernel_launch: cooperative launch failed: %s (grid %d)\n", hipGetErrorString(e), grid);
#else
    for (int ph = 0; ph < NPH; ++ph) { p.ph_lo = ph; p.ph_hi = ph + 1; hipLaunchKernelGGL(fwd, dim3(grid), dim3(NTHREADS), LDS_BYTES, stream, p); }
#endif
}
```

```cpp
#include <hip/hip_runtime.h>
#include <hip/hip_cooperative_groups.h>
#include <cstdio>
#include <cstdint>
#include <cmath>
namespace pg8 {
#define PG8_LAS __attribute__((address_space(3)))
typedef unsigned short bf16_t;
typedef short bf16x8 __attribute__((ext_vector_type(8)));
typedef float f32x4 __attribute__((ext_vector_type(4)));
typedef unsigned u32x4 __attribute__((ext_vector_type(4)));
constexpr int BM = 256, BK = 64, HALF = 128, HTB = HALF * BK * 2  , STAGE_BYTES = 8 * HTB, NXCD = 8, WGM = 8;

__host__ __device__ __forceinline__ int lds_byte(int r, int c) { const int st = (r >> 4) * 2 + (c >> 5), rr = r & 15, cc = c & 31, ob = rr * 64 + cc * 2; return st * 1024 + (ob ^ (((ob >> 9) & 1) << 5)); }
__host__ __device__ __forceinline__ void stage_rc(int b, int& R, int& C) { const int st = b / 1024, sb = b % 1024, swz = sb ^ (((sb >> 9) & 1) << 5); R = (st >> 1) * 16 + swz / 64; C = (st & 1) * 32 + (swz % 64) / 2; }
__host__ __device__ __forceinline__ int perm32(int rho) { const int n = rho >> 4, i = rho & 15; return 8 * (i >> 2) + 4 * n + (i & 3); }

struct Unit { int pm, pn; };
struct Gemm { const bf16_t* A; const bf16_t* Bt; int M, N, K; };

struct StaticOrder {
    int nM, nN, nwg, G, c;
    __host__ __device__ void init(int M, int N, int G_, int c_) { nM = M / BM; nN = N / BM; nwg = nM * nN; G = G_; c = c_; }
    __host__ __device__ bool next(int i, Unit& u) const {
        const long L = (long)i * G + c; if (L >= nwg) return false;
        int wgid = (int)L; { const int q = nwg / NXCD, r = nwg % NXCD, xcd = wgid % NXCD, off = wgid / NXCD; wgid = (xcd < r ? xcd * (q + 1) : r * (q + 1) + (xcd - r) * q) + off; }
        const int nig = WGM * nN, gid = wgid / nig, fm = gid * WGM, gsz = (nM - fm) < WGM ? (nM - fm) : WGM;
        u.pm = fm + ((wgid % nig) % gsz); u.pn = (wgid % nig) / gsz; return true;
    }
    __device__ __forceinline__ void a_ready(const Unit&) const {}
    __device__ __forceinline__ void done(const Unit&) const {}
};

__device__ __forceinline__ unsigned cvt_pk_bf16(float lo, float hi) { unsigned r; asm volatile("v_cvt_pk_bf16_f32 %0, %1, %2" : "=v"(r) : "v"(lo), "v"(hi)); return r; }
typedef float f32x2 __attribute__((ext_vector_type(2)));
__device__ __forceinline__ f32x2 gelu_pk(f32x2 v) {
    const f32x2 av = __builtin_elementwise_abs(v), d = av * 0.2316418882f + 1.0f;
    f32x2 t; t.x = __builtin_amdgcn_rcpf(d.x); t.y = __builtin_amdgcn_rcpf(d.y);
    f32x2 q = t * 0.5307027145f + (-0.7265760135f); q = q * t + 0.7107068705f; q = q * t + (-0.142248368f); q = q * t + 0.127414796f; q = q * t;
    const f32x2 s = (v * v) * (-0.72134752044f);
    f32x2 e; e.x = __builtin_amdgcn_exp2f(s.x); e.y = __builtin_amdgcn_exp2f(s.y);
    const f32x2 m = v * (q * e), r = v - m;
    f32x2 o; o.x = v.x < 0.f ? m.x : r.x; o.y = v.y < 0.f ? m.y : r.y; return o;
}

template <int ACT  > struct EpiBf16 {
    static constexpr bool PERM = true, AFTER_DRAIN = false; static_assert(ACT == 0 || ACT == 1, "EpiBf16: ACT is 0 (none) or 1 (gelu_pk)");
    bf16_t* O; int ldc; const float* bias; int split_cols; size_t split_stride; float scale0;
    __device__ __forceinline__ void operator()(const f32x4 (&acc)[2][2][4][2], const Unit& u, int wr, int wc, int fr, int fq) const {
        const int row0 = u.pm * BM + wr * 64 + fr; int colt = u.pn * BM; bf16_t* base = O;
        float sc = 1.f; if (split_cols) { const int t = colt / split_cols; base += (size_t)t * split_stride; colt -= t * split_cols; if (t == 0) sc = scale0; }
        const int col0 = colt + wc * 32 + 8 * fq, bcol0 = u.pn * BM + wc * 32 + 8 * fq;
        f32x4 bv[2][2];
#pragma unroll
        for (int bj = 0; bj < 2; ++bj)
#pragma unroll
            for (int n = 0; n < 2; ++n) bv[bj][n] = bias ? *(const f32x4*)(bias + bcol0 + bj * HALF + 4 * n) : (f32x4){0.f, 0.f, 0.f, 0.f};
#pragma unroll
        for (int ai = 0; ai < 2; ++ai)
#pragma unroll
            for (int m = 0; m < 4; ++m) { bf16_t* rowp = base + (size_t)(row0 + ai * HALF + m * 16) * ldc + col0;
#pragma unroll
                for (int bj = 0; bj < 2; ++bj) { f32x4 v0 = acc[ai][bj][m][0] + bv[bj][0], v1 = acc[ai][bj][m][1] + bv[bj][1];
                    if (ACT == 1) { f32x2 a = gelu_pk((f32x2){v0[0], v0[1]}), b = gelu_pk((f32x2){v0[2], v0[3]}), c = gelu_pk((f32x2){v1[0], v1[1]}), d = gelu_pk((f32x2){v1[2], v1[3]});
                        v0 = (f32x4){a.x, a.y, b.x, b.y}; v1 = (f32x4){c.x, c.y, d.x, d.y}; }
                    v0 = v0 * sc; v1 = v1 * sc; u32x4 w; w.x = cvt_pk_bf16(v0[0], v0[1]); w.y = cvt_pk_bf16(v0[2], v0[3]); w.z = cvt_pk_bf16(v1[0], v1[1]); w.w = cvt_pk_bf16(v1[2], v1[3]);
                    *(u32x4*)(rowp + bj * HALF) = w; } }
    }
};
template <class Epi, class Sched, bool ALIGN_EPI = false, bool SP2 = false>
__device__ __forceinline__ void gemm_phase(PG8_LAS unsigned char* lds, const Gemm g, const Sched& S, const Epi& E) {
    int tid_o = threadIdx.x; asm volatile("" : "+v"(tid_o));
    const int tid = tid_o, wid = __builtin_amdgcn_readfirstlane(tid >> 6), lane = tid & 63, wr = wid >> 2, wc = wid & 3, fr = lane & 15, fq = lane >> 4;
    const int K = g.K, nt = K / BK;
    unsigned voffA[2], voffB[2];
#pragma unroll
    for (int i = 0; i < 2; ++i) { int R, C; stage_rc(tid * 16 + i * 8192, R, C); const int Rb = Epi::PERM ? ((R & ~31) + perm32(R & 31)) : R;
        voffA[i] = (unsigned)(R * K + C) * 2u; voffB[i] = (unsigned)(Rb * K + C) * 2u; }
    const size_t kstep = (size_t)(BK * 2);
    const size_t hstep = (size_t)HALF * K * 2;
    const size_t tstep = 2 * hstep;
    const unsigned ldsw = (unsigned)wid * 1024u;
    const int aoff = lds_byte(wr * 64 + fr, fq * 8), boff = lds_byte(wc * 32 + fr, fq * 8);
#define PG8_SA(b, h) (((b) * 2 + (h)) * HTB)
#define PG8_SB(b, h) ((4 + (b) * 2 + (h)) * HTB)
#define PG8_STAGE(bufoff, gbase, voff) do { _Pragma("unroll") for (int _i = 0; _i < 2; ++_i) \
        __builtin_amdgcn_global_load_lds((const unsigned*)((const char*)(gbase) + (voff)[_i]), (PG8_LAS unsigned*)(lds + (bufoff) + ldsw + _i * 8192), 16, 0, 0); } while (0)
#define PG8_LDA(dst, b, h) do { _Pragma("unroll") for (int m = 0; m < 4; ++m) _Pragma("unroll") for (int k = 0; k < 2; ++k) dst[m][k] = *(const PG8_LAS bf16x8*)(lds + PG8_SA(b, h) + aoff + m * 2048 + k * 1024); } while (0)
#define PG8_LDB(dst, b, h) do { _Pragma("unroll") for (int n = 0; n < 2; ++n) _Pragma("unroll") for (int k = 0; k < 2; ++k) dst[n][k] = *(const PG8_LAS bf16x8*)(lds + PG8_SB(b, h) + boff + n * 2048 + k * 1024); } while (0)
#define PG8_MMA(ai, bj, At, Bt) do { __builtin_amdgcn_s_setprio(1); _Pragma("unroll") for (int m = 0; m < 4; ++m) _Pragma("unroll") for (int n = 0; n < 2; ++n) _Pragma("unroll") for (int k = 0; k < 2; ++k) \
        acc[ai][bj][m][n] = __builtin_amdgcn_mfma_f32_16x16x32_bf16(Bt[n][k], At[m][k], acc[ai][bj][m][n], 0, 0, 0); __builtin_amdgcn_s_setprio(0); } while (0)
#define PG8_WAIT_V(n) asm volatile("s_waitcnt vmcnt(" #n ")" ::: "memory")
#define PG8_WAIT_L(n) asm volatile("s_waitcnt lgkmcnt(" #n ")" ::: "memory")
#define PG8_BAR __builtin_amdgcn_s_barrier()
#define PG8_SCHED __builtin_amdgcn_sched_barrier(0)
    Unit cur, nxt; int ui = 0;
    if (!S.next(0, cur)) return;
    f32x4 acc[2][2][4][2];
#pragma unroll
    for (int a = 0; a < 2; ++a)
#pragma unroll
        for (int b = 0; b < 2; ++b)
#pragma unroll
            for (int m = 0; m < 4; ++m)
#pragma unroll
                for (int n = 0; n < 2; ++n) acc[a][b][m][n] = (f32x4){0.f, 0.f, 0.f, 0.f};
    bf16x8 At[4][2], B0[2][2], B1[2][2];
    const char* cA = (const char*)g.A + (size_t)cur.pm * tstep; const char* cB = (const char*)g.Bt + (size_t)cur.pn * tstep;
    S.a_ready(cur);
    if constexpr (SP2) {
        PG8_STAGE(PG8_SB(0, 0), cB, voffB); PG8_STAGE(PG8_SB(0, 1), cB + hstep, voffB); PG8_STAGE(PG8_SA(0, 0), cA, voffA); PG8_STAGE(PG8_SA(0, 1), cA + hstep, voffA);
        if (wr == 1) PG8_BAR;
        PG8_WAIT_V(2); PG8_BAR;
        PG8_STAGE(PG8_SB(1, 0), cB + kstep, voffB); PG8_STAGE(PG8_SA(1, 0), cA + kstep, voffA); PG8_STAGE(PG8_SB(1, 1), cB + hstep + kstep, voffB);
        PG8_WAIT_V(6); PG8_BAR;
    } else {
        PG8_STAGE(PG8_SB(0, 0), cB, voffB); PG8_STAGE(PG8_SA(0, 0), cA, voffA); PG8_STAGE(PG8_SB(0, 1), cB + hstep, voffB); PG8_STAGE(PG8_SA(0, 1), cA + hstep, voffA);
        if (wr == 1) PG8_BAR;
        PG8_WAIT_V(4); PG8_BAR;
        PG8_STAGE(PG8_SB(1, 0), cB + kstep, voffB); PG8_STAGE(PG8_SA(1, 0), cA + kstep, voffA); PG8_STAGE(PG8_SB(1, 1), cB + hstep + kstep, voffB);
        PG8_WAIT_V(6); PG8_BAR;
    }
    for (;;) {
        const bool has_next = S.next(ui + 1, nxt);
        const char* nA = has_next ? (const char*)g.A + (size_t)nxt.pm * tstep : cA; const char* nB = has_next ? (const char*)g.Bt + (size_t)nxt.pn * tstep : cB;
        for (int t = 0; t < nt; t += 2) {
            const bool last = (t == nt - 2);
            const char* a1 = cA + (size_t)(t + 1) * kstep;
            const char* a2 = last ? nA : cA + (size_t)(t + 2) * kstep; const char* b2 = last ? nB : cB + (size_t)(t + 2) * kstep;
            const char* a3 = a2 + kstep; const char* b3 = b2 + kstep;
            if (last && has_next) S.a_ready(nxt);
            if constexpr (SP2) {
            PG8_LDB(B0, 0, 0); PG8_LDB(B1, 0, 1); PG8_SCHED; PG8_LDA(At, 0, 0); PG8_STAGE(PG8_SA(1, 1), a1 + hstep, voffA);
            PG8_WAIT_V(8); PG8_WAIT_L(0); PG8_BAR; PG8_MMA(0, 0, At, B0); PG8_MMA(0, 1, At, B1); PG8_BAR; PG8_SCHED;
            PG8_LDA(At, 0, 1); PG8_STAGE(PG8_SB(0, 0), b2, voffB); PG8_STAGE(PG8_SB(0, 1), b2 + hstep, voffB); PG8_STAGE(PG8_SA(0, 0), a2, voffA);
            PG8_WAIT_V(8); PG8_WAIT_L(0); PG8_BAR; PG8_MMA(1, 0, At, B0); PG8_MMA(1, 1, At, B1); PG8_BAR; PG8_SCHED;
            PG8_LDB(B0, 1, 0); PG8_LDB(B1, 1, 1); PG8_SCHED; PG8_LDA(At, 1, 0); PG8_STAGE(PG8_SA(0, 1), a2 + hstep, voffA);
            PG8_WAIT_V(8); PG8_WAIT_L(0); PG8_BAR; PG8_MMA(0, 0, At, B0); PG8_MMA(0, 1, At, B1); PG8_BAR; PG8_SCHED;
            PG8_LDA(At, 1, 1); PG8_STAGE(PG8_SB(1, 0), b3, voffB); PG8_STAGE(PG8_SB(1, 1), b3 + hstep, voffB); PG8_STAGE(PG8_SA(1, 0), a3, voffA);
            PG8_WAIT_V(8); PG8_WAIT_L(0); PG8_BAR; PG8_MMA(1, 0, At, B0); PG8_MMA(1, 1, At, B1); PG8_BAR; PG8_SCHED;
            } else {
            PG8_LDB(B0, 0, 0); PG8_SCHED; PG8_LDA(At, 0, 0); PG8_STAGE(PG8_SA(1, 1), a1 + hstep, voffA);
            PG8_WAIT_L(8); PG8_BAR; PG8_WAIT_L(0); PG8_MMA(0, 0, At, B0); PG8_BAR; PG8_SCHED;
            PG8_LDB(B1, 0, 1); PG8_STAGE(PG8_SB(0, 0), b2, voffB);
            PG8_BAR; PG8_WAIT_L(0); PG8_MMA(0, 1, At, B1); PG8_BAR;
            PG8_LDA(At, 0, 1); PG8_STAGE(PG8_SA(0, 0), a2, voffA);
            PG8_BAR; PG8_WAIT_L(0); PG8_MMA(1, 0, At, B0); PG8_BAR; PG8_SCHED;
            PG8_STAGE(PG8_SB(0, 1), b2 + hstep, voffB);
            PG8_WAIT_V(6); PG8_BAR; PG8_MMA(1, 1, At, B1); PG8_BAR;
            PG8_LDB(B0, 1, 0); PG8_SCHED; PG8_LDA(At, 1, 0); PG8_STAGE(PG8_SA(0, 1), a2 + hstep, voffA);
            PG8_WAIT_L(8); PG8_BAR; PG8_WAIT_L(0); PG8_MMA(0, 0, At, B0); PG8_BAR; PG8_SCHED;
            PG8_LDB(B1, 1, 1); PG8_STAGE(PG8_SB(1, 0), b3, voffB);
            PG8_BAR; PG8_WAIT_L(0); PG8_MMA(0, 1, At, B1); PG8_BAR;
            PG8_LDA(At, 1, 1); PG8_STAGE(PG8_SA(1, 0), a3, voffA);
            PG8_BAR; PG8_WAIT_L(0); PG8_MMA(1, 0, At, B0); PG8_BAR; PG8_SCHED;
            PG8_STAGE(PG8_SB(1, 1), b3 + hstep, voffB);
            PG8_WAIT_V(6); PG8_BAR; PG8_MMA(1, 1, At, B1); PG8_BAR;
            }
        }
        if constexpr (ALIGN_EPI) { if (wr == 0) PG8_BAR; }
        if constexpr (!Epi::AFTER_DRAIN) { E(acc, cur, wr, wc, fr, fq); S.done(cur); }
        if (!has_next) break;
#pragma unroll
        for (int a = 0; a < 2; ++a)
#pragma unroll
            for (int b = 0; b < 2; ++b)
#pragma unroll
                for (int m = 0; m < 4; ++m)
#pragma unroll
                    for (int n = 0; n < 2; ++n) acc[a][b][m][n] = (f32x4){0.f, 0.f, 0.f, 0.f};
        cur = nxt; cA = nA; cB = nB; ++ui;
        if constexpr (ALIGN_EPI) { if (wr == 1) PG8_BAR; }
    }
    PG8_WAIT_V(0);
    if constexpr (!ALIGN_EPI) { if (wr == 0) PG8_BAR; }
    PG8_BAR;
    if constexpr (Epi::AFTER_DRAIN) { E.fused(acc, cur, wr, wc, fr, fq, lds, wid, lane); S.done(cur); }
#undef PG8_SA
#undef PG8_SB
#undef PG8_STAGE
#undef PG8_LDA
#undef PG8_LDB
#undef PG8_MMA
#undef PG8_WAIT_V
#undef PG8_WAIT_L
#undef PG8_BAR
#undef PG8_SCHED
}
}
#ifndef MK_COOP
#define MK_COOP 1
#endif
#ifndef MK_REP_K
#define MK_REP_K -1
#endif
#ifndef MK_REP_N
#define MK_REP_N 1
#endif
namespace mk {
using pg8::bf16_t; using pg8::bf16x8; using pg8::f32x4; using pg8::u32x4;
typedef float f32x16 __attribute__((ext_vector_type(16)));
typedef unsigned u32x2 __attribute__((ext_vector_type(2)));
typedef float f32x2_t __attribute__((ext_vector_type(2)));
typedef __bf16 bf16x2_t __attribute__((ext_vector_type(2)));
#define LAS __attribute__((address_space(3)))
#define MFMA32(a, b, c) __builtin_amdgcn_mfma_f32_32x32x16_bf16((a), (b), (c), 0, 0, 0)

constexpr int M_TOK = 16384, SEQ = 8192, DM = 1024, DIN = 3488, DINP = 3584, NLAYER = 2;
constexpr int C_AQ = 0, C_AK = 256, C_AV = 384, C_BB = 512, C_BC = 768, C_BX = 1024, C_CQ = 1280, C_CKV = 1536, C_CKR = 1664,
              C_DQ = 1696, C_DK = 1952, C_DV = 2208, C_GATE = 2464;
constexpr float EPS = 1e-6f, LOG2E = 1.4426950408889634f;
constexpr float SC64 = 0.125f * LOG2E;
constexpr float QSC_MLA = 0.10206207261596575f * LOG2E;
constexpr int NWAVES = 8, NTHREADS = 512;
constexpr int LDS_BYTES = 122880 + 8 * 4096 + 1024;

constexpr size_t MiB = 1u << 20;
constexpr size_t WS_CTL = 0, CTL_BYTES = 65536;
constexpr int CW_BAR = 1024;
constexpr size_t WS_WIN = 1 * MiB;
constexpr size_t WS_WOUT = 15 * MiB;
constexpr size_t WS_WUQ = 19 * MiB;
constexpr size_t WS_WUKV = 19 * MiB + 512 * 1024;
constexpr size_t WS_XN = 32 * MiB;
constexpr size_t WS_H = 64 * MiB;
constexpr size_t WS_QC = 176 * MiB;
constexpr size_t WS_KC = 188 * MiB;
constexpr size_t WS_VTC = 200 * MiB;
constexpr size_t WS_VTA = 208 * MiB;
constexpr size_t WS_VTD = 212 * MiB;
constexpr size_t WS_Y = 220 * MiB;
constexpr size_t WS_END = 252 * MiB;

struct Params {
    const float* x; const int* pos; const float* norm_pre; const float* w_in; const float* sinks; const float* conv_w; const float* conv_b;
    const float* g_cq; const float* w_uq; const float* g_ckv; const float* w_ukv; const float* g_grp; const float* w_out; const float* g_post;
    float* out; unsigned char* ws; int ph_lo, ph_hi;
};

__device__ __forceinline__ unsigned pk2(float lo, float hi) { f32x2_t v = {lo, hi}; bf16x2_t b = __builtin_convertvector(v, bf16x2_t); return __builtin_bit_cast(unsigned, b); }
__device__ __forceinline__ float bf2f(short s) { return __uint_as_float(((unsigned)(unsigned short)s) << 16); }
__device__ __forceinline__ float bflo(unsigned u) { return __uint_as_float(u << 16); }
__device__ __forceinline__ float bfhi(unsigned u) { return __uint_as_float(u & 0xffff0000u); }
__device__ __forceinline__ bf16_t f2bf(float f) { return (bf16_t)(pk2(f, 0.f) & 0xffffu); }
__device__ __forceinline__ int crow(int i, int h) { return (i & 3) + 8 * (i >> 2) + 4 * h; }
__device__ __forceinline__ float ex2(float x) { return __builtin_amdgcn_exp2f(x); }
__device__ __forceinline__ float lg2(float x) { return __builtin_amdgcn_logf(x); }
__device__ __forceinline__ float xh_max(float v) { auto rr = __builtin_amdgcn_permlane32_swap(__float_as_uint(v), __float_as_uint(v), false, false); return fmaxf(__uint_as_float(rr[0]), __uint_as_float(rr[1])); }
__device__ __forceinline__ float xh_sum(float v) { auto rr = __builtin_amdgcn_permlane32_swap(__float_as_uint(v), __float_as_uint(v), false, false); return __uint_as_float(rr[0]) + __uint_as_float(rr[1]); }
__device__ __forceinline__ float xh_other(float v, int h) { auto rr = __builtin_amdgcn_permlane32_swap(__float_as_uint(v), __float_as_uint(v), false, false); return __uint_as_float(h ? rr[0] : rr[1]); }
#define MX3(a, b, c) __builtin_fmaxf(__builtin_fmaxf((a), (b)), (c))
__device__ __forceinline__ float wave_sum(float v) {
#pragma unroll
    for (int o = 1; o < 64; o <<= 1) v += __shfl_xor(v, o);
    return v;
}
__device__ __forceinline__ bf16x8 pack8(const float* e) {
    u32x4 w; w.x = pk2(e[0], e[1]); w.y = pk2(e[2], e[3]); w.z = pk2(e[4], e[5]); w.w = pk2(e[6], e[7]);
    return __builtin_bit_cast(bf16x8, w);
}

__device__ __forceinline__ void conv_wT(const float* __restrict__ W, int K, int N, int NP, const float* __restrict__ gain, bf16_t* __restrict__ dst,
                                        int a0, int a1, int b0, int b1, float sc, int gtid, int gthreads) {
    const int k8n = K / 8; const int items = NP * k8n;
#pragma unroll 2
    for (int it = gtid; it < items; it += gthreads) {
        const int n = it % NP, k8 = it / NP;
        u32x4 o = {0u, 0u, 0u, 0u};
        if (n < N) {
            const float cs = ((n >= a0 && n < a1) || (n >= b0 && n < b1)) ? sc : 1.f;
            float v[8];
#pragma unroll
            for (int j = 0; j < 8; ++j) v[j] = W[(size_t)(k8 * 8 + j) * N + n] * gain[k8 * 8 + j] * cs;
            o.x = pk2(v[0], v[1]); o.y = pk2(v[2], v[3]); o.z = pk2(v[4], v[5]); o.w = pk2(v[6], v[7]);
        }
        *(u32x4*)(dst + (size_t)n * K + k8 * 8) = o;
    }
}
__device__ __forceinline__ void wT_item(const float* __restrict__ W, int K, int N, const float* __restrict__ gain, bf16_t* __restrict__ WT, int a0, int a1, int b0, int b1, float sc,
                                        LAS float* scr, int item, int lane) {
    const int nblk = N / 32, kb = item / nblk, nb = item - kb * nblk, k0 = 64 * kb, n0 = 32 * nb;
#pragma unroll 8
    for (int i = 0; i < 32; ++i) { const int kk = 2 * i + (lane >> 5); scr[kk * 33 + (lane & 31)] = __builtin_nontemporal_load(W + (size_t)(k0 + kk) * N + n0 + (lane & 31)); }
    const int c = lane & 7;
    float g8[8];
#pragma unroll
    for (int j = 0; j < 8; ++j) g8[j] = gain[k0 + 8 * c + j];
#pragma unroll
    for (int j = 0; j < 4; ++j) { const int n = (lane >> 3) + 8 * j, nn = n0 + n; const LAS float* sp = scr + (8 * c) * 33 + n;
        const float cs = ((nn >= a0 && nn < a1) || (nn >= b0 && nn < b1)) ? sc : 1.f;
        u32x4 o; o.x = pk2(sp[0 * 33] * g8[0] * cs, sp[1 * 33] * g8[1] * cs); o.y = pk2(sp[2 * 33] * g8[2] * cs, sp[3 * 33] * g8[3] * cs);
        o.z = pk2(sp[4 * 33] * g8[4] * cs, sp[5 * 33] * g8[5] * cs); o.w = pk2(sp[6 * 33] * g8[6] * cs, sp[7 * 33] * g8[7] * cs);
        *(u32x4*)(WT + (size_t)nn * K + k0 + 8 * c) = o; }
}
__device__ __forceinline__ void rms_row_to_bf16(const float* __restrict__ xrow, bf16_t* __restrict__ orow, int lane) {
    f32x4 v[4]; float s = 0.f;
#pragma unroll
    for (int j = 0; j < 4; ++j) { v[j] = __builtin_nontemporal_load((const f32x4*)xrow + lane + 64 * j); s += (v[j].x * v[j].x + v[j].y * v[j].y) + (v[j].z * v[j].z + v[j].w * v[j].w); }
    const float rs = rsqrtf(wave_sum(s) * (1.f / DM) + EPS);
#pragma unroll
    for (int j = 0; j < 4; ++j) { u32x2 o; o.x = pk2(v[j].x * rs, v[j].y * rs); o.y = pk2(v[j].z * rs, v[j].w * rs); ((u32x2*)orow)[lane + 64 * j] = o; }
}

__device__ __forceinline__ void rope_cs(int pos, int h, float (&cs)[8], float (&sn)[8]) {
#pragma unroll
    for (int i = 0; i < 8; ++i) {
        const int f = (i & 3) + 8 * (i >> 2) + 4 * h;
        const float freq = ex2(-(float)f * 0.830482023721841f);
        const float ang = (float)pos * freq;
        const double rev = (double)ang * 0.15915494309189535;
        const float fr = (float)(rev - __builtin_rint(rev));
        cs[i] = __builtin_amdgcn_cosf(fr); sn[i] = __builtin_amdgcn_sinf(fr);
    }
}
__device__ __forceinline__ void rope_apply(f32x16& a, const float (&cs)[8], const float (&sn)[8]) {
#pragma unroll
    for (int i = 0; i < 8; ++i) { const float x1 = a[i], x2 = a[i + 8]; a[i] = x1 * cs[i] - x2 * sn[i]; a[i + 8] = x1 * sn[i] + x2 * cs[i]; }
}
__device__ __forceinline__ void store_tile_rowmajor(bf16_t* dst  , const f32x16& a, int h) {
#pragma unroll
    for (int g = 0; g < 4; ++g) { u32x2 o; o.x = pk2(a[4 * g], a[4 * g + 1]); o.y = pk2(a[4 * g + 2], a[4 * g + 3]); *(u32x2*)(dst + 8 * g + 4 * h) = o; }
}
constexpr int WQP = 528, WKP = 272, WQ_BYTES = 96 * WQP;
__device__ __forceinline__ void mq_unit(const bf16_t* __restrict__ H, const LAS unsigned char* Wl, const int* __restrict__ pos, bf16_t* __restrict__ QC, int tb, int hh, int lane) {
    const int r = lane & 31, h = lane >> 5, tok = tb * 32 + r;
    const bf16_t* src = H + (size_t)tok * DINP + C_CQ + 8 * h;
    bf16x8 bfr[16]; float ss = 0.f;
#pragma unroll
    for (int s = 0; s < 16; ++s) { bfr[s] = *(const bf16x8*)(src + 16 * s);
#pragma unroll
        for (int j = 0; j < 8; ++j) { const float v = bf2f(bfr[s][j]); ss += v * v; } }
    ss += __shfl_xor(ss, 32);
    const float rs = rsqrtf(ss * (1.f / 256.f) + EPS) * QSC_MLA;
    float cs[8], sn[8]; rope_cs(pos[tok], h, cs, sn);
    const LAS unsigned char* W = Wl + r * WQP + 16 * h;
#pragma unroll 1
    for (int nt = 0; nt < 3; ++nt) {
        f32x16 acc;
#pragma unroll
        for (int i = 0; i < 16; ++i) acc[i] = 0.f;
#pragma unroll
        for (int s = 0; s < 16; ++s) { const bf16x8 a = *(const LAS bf16x8*)(W + nt * 32 * WQP + 32 * s); acc = MFMA32(a, bfr[s], acc); }
#pragma unroll
        for (int i = 0; i < 16; ++i) acc[i] *= rs;
        if (nt == 2) rope_apply(acc, cs, sn);
        store_tile_rowmajor(QC + (size_t)tok * 384 + hh * 96 + nt * 32, acc, h);
    }
}
__device__ __forceinline__ void vt_flush(LAS bf16_t* stg, bf16_t* __restrict__ dst  , int lane) {
    const LAS u32x4* rp = (const LAS u32x4*)(stg + lane * 32);
    u32x4 w[4];
#pragma unroll
    for (int c = 0; c < 4; ++c) w[c] = rp[c];
    u32x4* gp = (u32x4*)(dst + (size_t)lane * SEQ);
#pragma unroll
    for (int c = 0; c < 4; ++c) gp[c] = w[c];
}
__device__ __forceinline__ void mkv_unit(const bf16_t* __restrict__ H, const LAS unsigned char* Wl, const int* __restrict__ pos, bf16_t* __restrict__ KC, bf16_t* __restrict__ VTC, int tb, int hh, int lane, LAS bf16_t* stg) {
    const int r = lane & 31, h = lane >> 5, tok = tb * 32 + r;
    const bf16_t* src = H + (size_t)tok * DINP + C_CKV + 8 * h;
    bf16x8 bfr[8]; float ss = 0.f;
#pragma unroll
    for (int s = 0; s < 8; ++s) { bfr[s] = *(const bf16x8*)(src + 16 * s);
#pragma unroll
        for (int j = 0; j < 8; ++j) { const float v = bf2f(bfr[s][j]); ss += v * v; } }
    ss += __shfl_xor(ss, 32);
    const float rs = rsqrtf(ss * (1.f / 128.f) + EPS);
    const LAS unsigned char* W = Wl + r * WKP + 16 * h;
    const int b = (tb * 32) / SEQ, t0 = (tb * 32) % SEQ;
#pragma unroll 1
    for (int nt = 0; nt < 4; ++nt) {
        f32x16 acc;
#pragma unroll
        for (int i = 0; i < 16; ++i) acc[i] = 0.f;
#pragma unroll
        for (int s = 0; s < 8; ++s) { const bf16x8 a = *(const LAS bf16x8*)(W + nt * 32 * WKP + 32 * s); acc = MFMA32(a, bfr[s], acc); }
#pragma unroll
        for (int i = 0; i < 16; ++i) acc[i] *= rs;
        if (nt < 2) store_tile_rowmajor(KC + (size_t)tok * 384 + hh * 96 + nt * 32, acc, h);
        else {
            LAS bf16_t* sp = stg + ((nt - 2) * 32 + 4 * h) * 32 + r;
#pragma unroll
            for (int i = 0; i < 16; ++i) sp[((i & 3) + 8 * (i >> 2)) * 32] = f2bf(acc[i]);
        }
    }
    vt_flush(stg, VTC + ((size_t)((b * 4 + hh) * 64)) * SEQ + t0, lane);
    f32x16 kr;
    const bf16_t* krp = H + (size_t)tok * DINP + C_CKR + 4 * h;
#pragma unroll
    for (int g = 0; g < 4; ++g) { const u32x2 w = *(const u32x2*)(krp + 8 * g); kr[4 * g] = bflo(w.x); kr[4 * g + 1] = bfhi(w.x); kr[4 * g + 2] = bflo(w.y); kr[4 * g + 3] = bfhi(w.y); }
    float cs[8], sn[8]; rope_cs(pos[tok], h, cs, sn);
    rope_apply(kr, cs, sn);
    store_tile_rowmajor(KC + (size_t)tok * 384 + hh * 96 + 64, kr, h);
}
__device__ __forceinline__ void vt_unit(const bf16_t* __restrict__ H, int col0, int NH, bf16_t* __restrict__ VT, int tb, int head, int lane, LAS bf16_t* stg) {
    const int r = lane & 31, h = lane >> 5, tok = tb * 32 + r, b = (tb * 32) / SEQ, t0 = (tb * 32) % SEQ;
    const bf16_t* src = H + (size_t)tok * DINP + col0 + head * 64 + 32 * h;
    bf16x8 v[4];
#pragma unroll
    for (int c = 0; c < 4; ++c) v[c] = *(const bf16x8*)(src + 8 * c);
    LAS bf16_t* sp = stg + (32 * h) * 32 + r;
#pragma unroll
    for (int c = 0; c < 4; ++c)
#pragma unroll
        for (int j = 0; j < 8; ++j) sp[(8 * c + j) * 32] = (bf16_t)v[c][j];
    vt_flush(stg, VT + ((size_t)((b * NH + head) * 64)) * SEQ + t0, lane);
}
__device__ __forceinline__ void conv_unit(const bf16_t* __restrict__ H, const float* __restrict__ cw, const float* __restrict__ cb, bf16_t* __restrict__ Y, int tb8, int lane) {
    const int tok0 = tb8 * 8, t0 = tok0 % SEQ, ch = 4 * lane;
    const f32x4 w0 = *(const f32x4*)(cw + ch), w1 = *(const f32x4*)(cw + 256 + ch), w2 = *(const f32x4*)(cw + 512 + ch), bs = *(const f32x4*)(cb + ch);
    u32x2 cc[10], xx[10], bb[8];
    const int back = (t0 >= 2) ? 2 : 0;
#pragma unroll
    for (int i = 0; i < 10; ++i) { const int ti = (i < 2) ? (i - back) : (i - 2); const bf16_t* p = H + (size_t)(tok0 + ti) * DINP + ch;
        cc[i] = *(const u32x2*)(p + C_BC); xx[i] = *(const u32x2*)(p + C_BX); if (i >= 2) bb[i - 2] = *(const u32x2*)(p + C_BB); }
    f32x4 u[10];
#pragma unroll
    for (int i = 0; i < 10; ++i) u[i] = (f32x4){bflo(cc[i].x) * bflo(xx[i].x), bfhi(cc[i].x) * bfhi(xx[i].x), bflo(cc[i].y) * bflo(xx[i].y), bfhi(cc[i].y) * bfhi(xx[i].y)};
    if (back == 0) { u[0] = (f32x4){0.f, 0.f, 0.f, 0.f}; u[1] = (f32x4){0.f, 0.f, 0.f, 0.f}; }
#pragma unroll
    for (int i = 0; i < 8; ++i) {
        const f32x4 bg = {bflo(bb[i].x), bfhi(bb[i].x), bflo(bb[i].y), bfhi(bb[i].y)};
        const f32x4 y = bg * (w0 * u[i] + w1 * u[i + 1] + w2 * u[i + 2] + bs);
        u32x2 o; o.x = pk2(y.x, y.y); o.y = pk2(y.z, y.w);
        *(u32x2*)(Y + (size_t)(tok0 + i) * DM + 256 + ch) = o;
    }
}

__device__ __forceinline__ void o_flush(LAS bf16_t* stg, bf16_t* __restrict__ Orow0, int opitch, int lane) {
    u32x4 w[4];
#pragma unroll
    for (int j = 0; j < 4; ++j) w[j] = *(const LAS u32x4*)(stg + (lane + 64 * j) * 8);
#pragma unroll
    for (int j = 0; j < 4; ++j) { const int c = lane + 64 * j; *(u32x4*)(Orow0 + (size_t)(c >> 3) * opitch + (c & 7) * 8) = w[j]; }
}
template <int DKS, bool SINK>
__device__ __forceinline__ void softmax_unit(const bf16_t* __restrict__ Qrow0, int qpitch, const bf16_t* __restrict__ Kb, int kpitch, const bf16_t* __restrict__ VT,
                                             int qb, int kt_begin, int window, float sink2, bf16_t* __restrict__ Orow0, int opitch, int lane, LAS bf16_t* stg) {
    const int r = lane & 31, h = lane >> 5;
    const int pr = (r & ~12) | ((r & 8) >> 1) | ((r & 4) << 1);
    bf16x8 qf[DKS];
#pragma unroll
    for (int s = 0; s < DKS; ++s) qf[s] = *(const bf16x8*)(Qrow0 + (size_t)r * qpitch + 16 * s + 8 * h);
    f32x16 o0, o1;
#pragma unroll
    for (int i = 0; i < 16; ++i) { o0[i] = 0.f; o1[i] = 0.f; }
    float m = -1e30f, l = 0.f;
    const int kt_end = qb + 1, q = 32 * qb + r;
    const bf16_t* kp = Kb + (size_t)(32 * kt_begin + pr) * kpitch + 8 * h;
    const bf16_t* vp = VT + (size_t)r * SEQ + 32 * kt_begin + 8 * h;
    bf16x8 kf[DKS];
#pragma unroll
    for (int s = 0; s < DKS; ++s) kf[s] = *(const bf16x8*)(kp + 16 * s);
    for (int kt = kt_begin; kt < kt_end; ++kt) {
        bf16x8 kn[DKS];
        if (kt + 1 < kt_end) {
#pragma unroll
            for (int s = 0; s < DKS; ++s) kn[s] = *(const bf16x8*)(kp + (size_t)32 * kpitch + 16 * s);
        } else {
#pragma unroll
            for (int s = 0; s < DKS; ++s) kn[s] = kf[s];
        }
        const bf16x8 v00 = *(const bf16x8*)(vp), v01 = *(const bf16x8*)(vp + 32 * SEQ), v10 = *(const bf16x8*)(vp + 16), v11 = *(const bf16x8*)(vp + 32 * SEQ + 16);
        f32x16 p;
#pragma unroll
        for (int i = 0; i < 16; ++i) p[i] = 0.f;
#pragma unroll
        for (int s = 0; s < DKS; ++s) p = MFMA32(kf[s], qf[s], p);
        if (kt == qb || (window != 0 && kt == qb - (window >> 5))) {
            const int k0 = 32 * kt + 8 * h;
#pragma unroll
            for (int i = 0; i < 16; ++i) { const int kv = k0 + 16 * (i >> 3) + (i & 7); const bool ok = (kv <= q) && (window == 0 || kv > q - window); if (!ok) p[i] = -INFINITY; }
        }
        float rm = MX3(p[0], p[1], p[2]);
#pragma unroll
        for (int i = 3; i < 15; i += 2) rm = MX3(rm, p[i], p[i + 1]);
        rm = xh_max(fmaxf(rm, p[15]));
        if (__any(rm > m + 6.f)) {
            const float mn = fmaxf(m, rm), f = ex2(m - mn); m = mn; l *= f;
#pragma unroll
            for (int i = 0; i < 16; ++i) { const float fi = __shfl(f, crow(i, h)); o0[i] *= fi; o1[i] *= fi; }
        }
        float e[16];
#pragma unroll
        for (int i = 0; i < 16; ++i) { e[i] = ex2(p[i] - m); l += e[i]; }
        const bf16x8 pa0 = pack8(e), pa1 = pack8(e + 8);
        o0 = MFMA32(pa0, v00, o0); o1 = MFMA32(pa0, v01, o1);
        o0 = MFMA32(pa1, v10, o0); o1 = MFMA32(pa1, v11, o1);
#pragma unroll
        for (int s = 0; s < DKS; ++s) kf[s] = kn[s];
        kp += (size_t)32 * kpitch; vp += 32;
    }
    l = xh_sum(l);
    if (SINK) l += ex2(sink2 - m);
    const float inv = 1.f / l;
    LAS bf16_t* sp = stg + (4 * h) * 64 + r;
#pragma unroll
    for (int i = 0; i < 16; ++i) { const float fi = __shfl(inv, crow(i, h)); const int ro = ((i & 3) + 8 * (i >> 2)) * 64;
        sp[ro] = f2bf(o0[i] * fi); sp[ro + 32] = f2bf(o1[i] * fi); }
    o_flush(stg, Orow0, opitch, lane);
}


constexpr int KP = 208, VP = 272;
constexpr int KT_BYTES = 128 * KP, VT_BYTES = 64 * VP, TB_BYTES = KT_BYTES + VT_BYTES, MRG_OFF = 2 * TB_BYTES;
static_assert(MRG_OFF + 4 * 34 * 64 * 4 <= 131072, "MLA LDS map");
__device__ __forceinline__ void mla_unit_blk(const bf16_t* __restrict__ QC, const bf16_t* __restrict__ KC, const bf16_t* __restrict__ VTC, bf16_t* __restrict__ Y,
                                             int bh, int g, LAS unsigned char* lds, int tid) {
    const int lane = tid & 63, wave = __builtin_amdgcn_readfirstlane(tid >> 6), r = lane & 31, h = lane >> 5, w4 = wave & 3, kh = wave >> 2;
    const int pr = (r & ~12) | ((r & 8) >> 1) | ((r & 4) << 1);
    const int b = bh >> 2, hh = bh & 3, qb = 4 * g + w4, q = 32 * qb + r;
    const bf16_t* Qp = QC + ((size_t)b * SEQ + q) * 384 + hh * 96 + 8 * h;
    bf16x8 qf[6];
#pragma unroll
    for (int s = 0; s < 6; ++s) qf[s] = *(const bf16x8*)(Qp + 16 * s);
    const bf16_t* Kg = KC + (size_t)b * SEQ * 384 + hh * 96;
    const bf16_t* Vg = VTC + (size_t)(b * 4 + hh) * 64 * SEQ;
    unsigned dgo[6];
#pragma unroll
    for (int i = 0; i < 6; ++i) { const int n = wave + 8 * i; unsigned o = 0u;
        if (n < 26) { const int j = 64 * n + lane, row = j / 13; int cc = j - 13 * row; cc = cc == 12 ? 0 : cc; o = (unsigned)(row * 384 + 8 * cc) * 2u; }
        else if (n < 43) { const int j = 64 * (n - 26) + lane, d = j / 17; int cc = j - 17 * d; cc = cc == 16 ? 0 : cc; o = (unsigned)(d * SEQ + 8 * cc) * 2u; }
        dgo[i] = o; }
#define MLA_DMA(ST, BO) do { const char* kb_ = (const char*)(Kg + (size_t)(ST) * (128 * 384)); const char* vb_ = (const char*)(Vg + (ST) * 128); \
        _Pragma("unroll") for (int i = 0; i < 6; ++i) { const int n = wave + 8 * i; \
            if (n < 26) __builtin_amdgcn_global_load_lds((const unsigned*)(kb_ + dgo[i]), (LAS unsigned*)(lds + (BO) + n * 1024), 16, 0, 0); \
            else if (n < 43) __builtin_amdgcn_global_load_lds((const unsigned*)(vb_ + dgo[i]), (LAS unsigned*)(lds + (BO) + KT_BYTES + (n - 26) * 1024), 16, 0, 0); } } while (0)
#define MLA_DMA_WAIT() asm volatile("s_waitcnt vmcnt(0)" ::: "memory")
    f32x16 o0, o1;
#pragma unroll
    for (int i = 0; i < 16; ++i) { o0[i] = 0.f; o1[i] = 0.f; }
    float m = 0.f, l = 0.f; bool first = true;
    f32x16 negm;
#pragma unroll
    for (int i = 0; i < 16; ++i) negm[i] = 0.f;
    const int nST = g + 1;
    MLA_DMA(0, 0); MLA_DMA_WAIT();
    __syncthreads();
    const int kfo = (64 * kh + pr) * KP + 16 * h;
    const int vfo = KT_BYTES + r * VP + (64 * kh + 8 * h) * 2;
    for (int ST = 0; ST < nST; ++ST) {
        if (ST + 1 < nST) MLA_DMA(ST + 1, ((ST + 1) & 1) * TB_BYTES);
        const int kt0 = 4 * ST + 2 * kh;
        if (kt0 <= qb) {
            const LAS unsigned char* tb = lds + (ST & 1) * TB_BYTES;
            f32x16 p0, p1;
            { const bf16x8 k0 = *(const LAS bf16x8*)(tb + kfo), k1 = *(const LAS bf16x8*)(tb + kfo + 32 * KP); p0 = MFMA32(k0, qf[0], negm); p1 = MFMA32(k1, qf[0], negm); }
#pragma unroll
            for (int s = 1; s < 6; ++s) { const bf16x8 k0 = *(const LAS bf16x8*)(tb + kfo + 32 * s), k1 = *(const LAS bf16x8*)(tb + kfo + 32 * KP + 32 * s);
                p0 = MFMA32(k0, qf[s], p0); p1 = MFMA32(k1, qf[s], p1); }
            if (kt0 + 1 >= qb) {
                const int kb0 = 32 * kt0 + 8 * h;
#pragma unroll
                for (int i = 0; i < 16; ++i) { const int kv = kb0 + 16 * (i >> 3) + (i & 7); if (kv > q) p0[i] = -INFINITY; if (kv + 32 > q) p1[i] = -INFINITY; }
            }
            float ra_ = MX3(p0[0], p0[1], p1[0]), rb_ = MX3(p0[2], p0[3], p1[1]); ra_ = MX3(ra_, p1[2], p1[3]);
#pragma unroll
            for (int i = 4; i < 16; i += 4) { ra_ = MX3(ra_, p0[i], p0[i + 1]); rb_ = MX3(rb_, p0[i + 2], p0[i + 3]); ra_ = MX3(ra_, p1[i], p1[i + 1]); rb_ = MX3(rb_, p1[i + 2], p1[i + 3]); }
            const float rm = xh_max(fmaxf(ra_, rb_));
            if (first || __any(rm > 6.f)) {
                const float dl = first ? rm : fmaxf(rm, 0.f);
                m += dl;
#pragma unroll
                for (int i = 0; i < 16; ++i) { p0[i] -= dl; p1[i] -= dl; negm[i] = -m; }
                if (!first) { const float f = ex2(-dl); l *= f;
#pragma unroll
                    for (int i = 0; i < 16; ++i) { const float fi = __shfl(f, crow(i, h)); o0[i] *= fi; o1[i] *= fi; } }
                first = false;
            }
            float ls = 0.f;
#pragma unroll
            for (int i = 0; i < 16; ++i) { p0[i] = ex2(p0[i]); p1[i] = ex2(p1[i]); ls += p0[i] + p1[i]; }
            l += ls;
            float e[8];
#pragma unroll
            for (int ks = 0; ks < 4; ++ks) {
#pragma unroll
                for (int j = 0; j < 8; ++j) e[j] = (ks < 2) ? p0[8 * ks + j] : p1[8 * (ks - 2) + j];
                const bf16x8 pa = pack8(e);
                const bf16x8 v0 = *(const LAS bf16x8*)(tb + vfo + 32 * ks), v1 = *(const LAS bf16x8*)(tb + vfo + 32 * VP + 32 * ks);
                o0 = MFMA32(pa, v0, o0); o1 = MFMA32(pa, v1, o1);
            }
        }
        MLA_DMA_WAIT();
        __syncthreads();
    }
#undef MLA_DMA
#undef MLA_DMA_WAIT
    if (first) m = -1e30f;
    l = xh_sum(l);
    LAS float* mg = (LAS float*)(lds + MRG_OFF) + w4 * (34 * 64) + lane;
    if (kh == 1) {
#pragma unroll
        for (int i = 0; i < 16; ++i) { mg[i * 64] = o0[i]; mg[(16 + i) * 64] = o1[i]; }
        mg[32 * 64] = m; mg[33 * 64] = l;
    }
    __syncthreads();
    if (kh == 0) {
        const float mb = mg[32 * 64], lb = mg[33 * 64];
        const float mn = fmaxf(m, mb), fa = ex2(m - mn), fb = ex2(mb - mn), inv = 1.f / (l * fa + lb * fb), ga = fa * inv, gb = fb * inv;
        LAS bf16_t* stg = (LAS bf16_t*)(lds + wave * 4096);
        LAS bf16_t* sp = stg + (4 * h) * 64 + r;
#pragma unroll
        for (int i = 0; i < 16; ++i) { const float ra = __shfl(ga, crow(i, h)), rb = __shfl(gb, crow(i, h)); const int ro = ((i & 3) + 8 * (i >> 2)) * 64;
            sp[ro] = f2bf(o0[i] * ra + mg[i * 64] * rb); sp[ro + 32] = f2bf(o1[i] * ra + mg[(16 + i) * 64] * rb); }
        o_flush(stg, Y + ((size_t)b * SEQ + 32 * qb) * DM + 512 + hh * 64, DM, lane);
    }
    __syncthreads();
}

__device__ __forceinline__ void sb_unit(const bf16_t* __restrict__ Qrow0, int qpitch, const bf16_t* __restrict__ Kb, int kpitch, const bf16_t* __restrict__ VT,
                                        int qb, bf16_t* __restrict__ Orow0, int opitch, int lane, LAS bf16_t* stg) {
    const int r = lane & 31, h = lane >> 5;
    const int pr = (r & ~12) | ((r & 8) >> 1) | ((r & 4) << 1);
    bf16x8 qf[4];
#pragma unroll
    for (int s = 0; s < 4; ++s) qf[s] = *(const bf16x8*)(Qrow0 + (size_t)r * qpitch + 16 * s + 8 * h);
    f32x16 o0, o1;
#pragma unroll
    for (int i = 0; i < 16; ++i) { o0[i] = 0.f; o1[i] = 0.f; }
    float carry = 0.f;
    const int q = 32 * qb + r;
    const bf16_t* kp = Kb + (size_t)(32 * qb + pr) * kpitch + 8 * h;
    const bf16_t* vp = VT + (size_t)r * SEQ + 32 * qb + 8 * h;
    bf16x8 kf[4];
#pragma unroll
    for (int s = 0; s < 4; ++s) kf[s] = *(const bf16x8*)(kp + 16 * s);
    for (int kt = qb; kt >= 0; --kt) {
        bf16x8 kn[4];
        if (kt > 0) {
#pragma unroll
            for (int s = 0; s < 4; ++s) kn[s] = *(const bf16x8*)(kp - (size_t)32 * kpitch + 16 * s);
        } else {
#pragma unroll
            for (int s = 0; s < 4; ++s) kn[s] = kf[s];
        }
        const bf16x8 v00 = *(const bf16x8*)(vp), v01 = *(const bf16x8*)(vp + 32 * SEQ), v10 = *(const bf16x8*)(vp + 16), v11 = *(const bf16x8*)(vp + 32 * SEQ + 16);
        f32x16 p;
#pragma unroll
        for (int i = 0; i < 16; ++i) p[i] = 0.f;
#pragma unroll
        for (int s = 0; s < 4; ++s) p = MFMA32(kf[s], qf[s], p);
        const bool diag = (kt == qb);
        const int k0 = 32 * kt + 8 * h;
        float sfx[16];
#pragma unroll
        for (int i = 0; i < 16; ++i) {
            const float z = p[i];
            float L = -(fmaxf(z, 0.f) + lg2(1.f + ex2(-fabsf(z))));
            if (diag) { const int kv = k0 + 16 * (i >> 3) + (i & 7); if (!(kv < q)) L = 0.f; }
            sfx[i] = L;
        }
#pragma unroll
        for (int g = 0; g < 2; ++g)
#pragma unroll
            for (int j = 6; j >= 0; --j) sfx[8 * g + j] += sfx[8 * g + j + 1];
        const float T0 = sfx[0], T1 = sfx[8];
        const float TP0 = __shfl_xor(T0, 32), TP1 = __shfl_xor(T1, 32);
        const float off1 = (h ? 0.f : TP1) + carry, off0 = T1 + TP1 + (h ? 0.f : TP0) + carry;
        float e[16];
#pragma unroll
        for (int i = 0; i < 16; ++i) {
            float a = ex2(p[i] + sfx[i] + (i < 8 ? off0 : off1));
            if (diag) { const int kv = k0 + 16 * (i >> 3) + (i & 7); if (!(kv < q)) a = 0.f; }
            e[i] = a;
        }
        carry += (T0 + T1) + (TP0 + TP1);
        const bf16x8 pa0 = pack8(e), pa1 = pack8(e + 8);
        o0 = MFMA32(pa0, v00, o0); o1 = MFMA32(pa0, v01, o1);
        o0 = MFMA32(pa1, v10, o0); o1 = MFMA32(pa1, v11, o1);
        if (__all(carry < -150.f)) break;
#pragma unroll
        for (int s = 0; s < 4; ++s) kf[s] = kn[s];
        kp -= (size_t)32 * kpitch; vp -= 32;
    }
    LAS bf16_t* sp = stg + (4 * h) * 64 + r;
#pragma unroll
    for (int i = 0; i < 16; ++i) { const int ro = ((i & 3) + 8 * (i >> 2)) * 64; sp[ro] = f2bf(o0[i]); sp[ro + 32] = f2bf(o1[i]); }
    o_flush(stg, Orow0, opitch, lane);
}


constexpr int AKP = 144;
constexpr int SWA_NK = 384, SWA_VP = SWA_NK * 2 + 16, SWA_KB = SWA_NK * AKP;
constexpr int SB_NK = 448, SB_VP = SB_NK * 2 + 16, SB_KB = SB_NK * AKP;
constexpr int STG_OFF = 122880, MISC_OFF = STG_OFF + 8 * 4096;
static_assert(SWA_KB + 64 * SWA_VP <= STG_OFF && SB_KB + 64 * SB_VP <= STG_OFF && MISC_OFF + 1024 == LDS_BYTES, "window LDS map");
template <int NK, int VPB>
__device__ __forceinline__ void stage_kv64(const bf16_t* __restrict__ Kb, int kpitch, const bf16_t* __restrict__ VT, int key0, LAS unsigned char* lds, int tid) {
    constexpr int NCH = NK * 8 / 512, VC = NK / 8;
    u32x4 kr[NCH], vr[NCH];
#pragma unroll
    for (int i = 0; i < NCH; ++i) { const int c = tid + 512 * i, row = c >> 3, cc = c & 7; int key = key0 + row; key = key < 0 ? 0 : key;
        kr[i] = *(const u32x4*)(Kb + (size_t)key * kpitch + 8 * cc); }
#pragma unroll
    for (int i = 0; i < NCH; ++i) { const int c = tid + 512 * i, d = c / VC, cc = c - d * VC; int key = key0 + 8 * cc; key = key < 0 ? 0 : key;
        vr[i] = *(const u32x4*)(VT + (size_t)d * SEQ + key); }
#pragma unroll
    for (int i = 0; i < NCH; ++i) { const int c = tid + 512 * i, row = c >> 3, cc = c & 7; *(LAS u32x4*)(lds + row * AKP + 16 * cc) = kr[i]; }
#pragma unroll
    for (int i = 0; i < NCH; ++i) { const int c = tid + 512 * i, d = c / VC, cc = c - d * VC; *(LAS u32x4*)(lds + NK * AKP + d * VPB + 16 * cc) = vr[i]; }
}
template <int NK, int VPB>
__device__ __forceinline__ void stage_kv64_T(const bf16_t* __restrict__ Kb, int kpitch, const bf16_t* __restrict__ Vb, int vpitch, int key0, LAS unsigned char* lds, int tid) {
    constexpr int NCH = NK * 8 / 512, NB = NK / 32;
    const int lane = tid & 63, wave = __builtin_amdgcn_readfirstlane(tid >> 6), r = lane & 31, h = lane >> 5;
    u32x4 kr[NCH]; bf16x8 vv[2][4];
#pragma unroll
    for (int i = 0; i < NCH; ++i) { const int c = tid + 512 * i, row = c >> 3, cc = c & 7; int key = key0 + row; key = key < 0 ? 0 : key;
        kr[i] = *(const u32x4*)(Kb + (size_t)key * kpitch + 8 * cc); }
#pragma unroll
    for (int t = 0; t < 2; ++t) { const int tbk = wave + 8 * t; if (tbk < NB) { int key = key0 + 32 * tbk + r; key = key < 0 ? 0 : key;
#pragma unroll
        for (int c = 0; c < 4; ++c) vv[t][c] = *(const bf16x8*)(Vb + (size_t)key * vpitch + 32 * h + 8 * c); } }
#pragma unroll
    for (int i = 0; i < NCH; ++i) { const int c = tid + 512 * i, row = c >> 3, cc = c & 7; *(LAS u32x4*)(lds + row * AKP + 16 * cc) = kr[i]; }
#pragma unroll
    for (int t = 0; t < 2; ++t) { const int tbk = wave + 8 * t; if (tbk < NB) { LAS bf16_t* sp = (LAS bf16_t*)(lds + NK * AKP + (32 * h) * VPB) + 32 * tbk + r;
#pragma unroll
        for (int c = 0; c < 4; ++c)
#pragma unroll
            for (int j = 0; j < 8; ++j) sp[(8 * c + j) * (VPB / 2)] = (bf16_t)vv[t][c][j]; } }
}
__device__ __forceinline__ void swa_wave_lds(const bf16_t* __restrict__ Qrow0, int qpitch, const LAS unsigned char* lds, int qb, int kt_base, float sink2,
                                             bf16_t* __restrict__ Orow0, int opitch, int lane, LAS bf16_t* stg) {
    const int r = lane & 31, h = lane >> 5;
    const int pr = (r & ~12) | ((r & 8) >> 1) | ((r & 4) << 1);
    bf16x8 qf[4];
#pragma unroll
    for (int s = 0; s < 4; ++s) qf[s] = *(const bf16x8*)(Qrow0 + (size_t)r * qpitch + 16 * s + 8 * h);
    f32x16 o0, o1;
#pragma unroll
    for (int i = 0; i < 16; ++i) { o0[i] = 0.f; o1[i] = 0.f; }
    float m = -1e30f, l = 0.f;
    const int q = 32 * qb + r, kt_begin = qb - 4 > 0 ? qb - 4 : 0;
    for (int kt = kt_begin; kt <= qb; ++kt) {
        const int rel = kt - kt_base;
        const LAS unsigned char* kp = lds + (32 * rel + pr) * AKP + 16 * h;
        const LAS unsigned char* vp = lds + SWA_KB + r * SWA_VP + (32 * rel + 8 * h) * 2;
        f32x16 p;
#pragma unroll
        for (int i = 0; i < 16; ++i) p[i] = 0.f;
#pragma unroll
        for (int s = 0; s < 4; ++s) p = MFMA32(*(const LAS bf16x8*)(kp + 32 * s), qf[s], p);
        if (kt == qb || kt == qb - 4) {
            const int k0 = 32 * kt + 8 * h;
#pragma unroll
            for (int i = 0; i < 16; ++i) { const int kv = k0 + 16 * (i >> 3) + (i & 7); const bool ok = (kv <= q) && (kv > q - 128); if (!ok) p[i] = -INFINITY; }
        }
        float rm = MX3(p[0], p[1], p[2]);
#pragma unroll
        for (int i = 3; i < 15; i += 2) rm = MX3(rm, p[i], p[i + 1]);
        rm = xh_max(fmaxf(rm, p[15]));
        if (__any(rm > m + 6.f)) {
            const float mn = fmaxf(m, rm), f = ex2(m - mn); m = mn; l *= f;
#pragma unroll
            for (int i = 0; i < 16; ++i) { const float fi = __shfl(f, crow(i, h)); o0[i] *= fi; o1[i] *= fi; }
        }
        float e[16];
#pragma unroll
        for (int i = 0; i < 16; ++i) { e[i] = ex2(p[i] - m); l += e[i]; }
        const bf16x8 pa0 = pack8(e), pa1 = pack8(e + 8);
        o0 = MFMA32(pa0, *(const LAS bf16x8*)(vp), o0); o1 = MFMA32(pa0, *(const LAS bf16x8*)(vp + 32 * SWA_VP), o1);
        o0 = MFMA32(pa1, *(const LAS bf16x8*)(vp + 32), o0); o1 = MFMA32(pa1, *(const LAS bf16x8*)(vp + 32 * SWA_VP + 32), o1);
    }
    l = xh_sum(l);
    l += ex2(sink2 - m);
    const float inv = 1.f / l;
    LAS bf16_t* sp = stg + (4 * h) * 64 + r;
#pragma unroll
    for (int i = 0; i < 16; ++i) { const float fi = __shfl(inv, crow(i, h)); const int ro = ((i & 3) + 8 * (i >> 2)) * 64;
        sp[ro] = f2bf(o0[i] * fi); sp[ro + 32] = f2bf(o1[i] * fi); }
    o_flush(stg, Orow0, opitch, lane);
}
#define SB_STEP(KT_, V00_, V01_, V10_, V11_) do { \
        const bool diag = ((KT_) == qb); const int k0 = 32 * (KT_) + 8 * h; float sfx[16]; \
        _Pragma("unroll") for (int i = 0; i < 16; ++i) { const float z = p[i]; float L = -(fmaxf(z, 0.f) + lg2(1.f + ex2(-fabsf(z)))); \
            if (diag) { const int kv = k0 + 16 * (i >> 3) + (i & 7); if (!(kv < q)) L = 0.f; } sfx[i] = L; } \
        _Pragma("unroll") for (int g = 0; g < 2; ++g) _Pragma("unroll") for (int j = 6; j >= 0; --j) sfx[8 * g + j] += sfx[8 * g + j + 1]; \
        const float T0 = sfx[0], T1 = sfx[8]; const float TP0 = xh_other(T0, h), TP1 = xh_other(T1, h); \
        const float off1 = (h ? 0.f : TP1) + carry, off0 = T1 + TP1 + (h ? 0.f : TP0) + carry; float e[16]; \
        _Pragma("unroll") for (int i = 0; i < 16; ++i) { float a = ex2(p[i] + sfx[i] + (i < 8 ? off0 : off1)); \
            if (diag) { const int kv = k0 + 16 * (i >> 3) + (i & 7); if (!(kv < q)) a = 0.f; } e[i] = a; } \
        carry += (T0 + T1) + (TP0 + TP1); \
        const bf16x8 pa0 = pack8(e), pa1 = pack8(e + 8); \
        o0 = MFMA32(pa0, (V00_), o0); o1 = MFMA32(pa0, (V01_), o1); o0 = MFMA32(pa1, (V10_), o0); o1 = MFMA32(pa1, (V11_), o1); } while (0)
__device__ __forceinline__ void sb_wave_lds(const bf16_t* __restrict__ Qrow0, int qpitch, const LAS unsigned char* lds, const bf16_t* __restrict__ Kb, int kpitch,
                                            const bf16_t* __restrict__ Vb, int vpitch, int qb, int kt_base, bf16_t* __restrict__ Orow0, int opitch, int lane, LAS bf16_t* stg) {
    const int r = lane & 31, h = lane >> 5;
    const int pr = (r & ~12) | ((r & 8) >> 1) | ((r & 4) << 1);
    bf16x8 qf[4];
#pragma unroll
    for (int s = 0; s < 4; ++s) qf[s] = *(const bf16x8*)(Qrow0 + (size_t)r * qpitch + 16 * s + 8 * h);
    f32x16 o0, o1;
#pragma unroll
    for (int i = 0; i < 16; ++i) { o0[i] = 0.f; o1[i] = 0.f; }
    float carry = 0.f;
    const int q = 32 * qb + r;
    const int kt_lo = kt_base > 0 ? kt_base : 0;
    bool done = false;
    int kt = qb;
    for (; kt >= kt_lo; --kt) {
        const int rel = kt - kt_base;
        const LAS unsigned char* kp = lds + (32 * rel + pr) * AKP + 16 * h;
        const LAS unsigned char* vp = lds + SB_KB + r * SB_VP + (32 * rel + 8 * h) * 2;
        f32x16 p;
#pragma unroll
        for (int i = 0; i < 16; ++i) p[i] = 0.f;
#pragma unroll
        for (int s = 0; s < 4; ++s) p = MFMA32(*(const LAS bf16x8*)(kp + 32 * s), qf[s], p);
        SB_STEP(kt, *(const LAS bf16x8*)(vp), *(const LAS bf16x8*)(vp + 32 * SB_VP), *(const LAS bf16x8*)(vp + 32), *(const LAS bf16x8*)(vp + 32 * SB_VP + 32));
        if (__all(carry < -150.f)) { done = true; break; }
    }
    if (!done && kt >= 0) {
        const bf16_t* kp = Kb + (size_t)(32 * kt + pr) * kpitch + 8 * h;
        for (; kt >= 0; --kt) {
            bf16x8 kf[4];
#pragma unroll
            for (int s = 0; s < 4; ++s) kf[s] = *(const bf16x8*)(kp + 16 * s);
            bf16x8 v00, v01, v10, v11;
            { const bf16_t* vg = Vb + (size_t)(32 * kt + 8 * h) * vpitch + r;
#pragma unroll
              for (int j = 0; j < 8; ++j) { v00[j] = (short)vg[(size_t)j * vpitch]; v01[j] = (short)vg[(size_t)j * vpitch + 32]; v10[j] = (short)vg[(size_t)(16 + j) * vpitch]; v11[j] = (short)vg[(size_t)(16 + j) * vpitch + 32]; } }
            f32x16 p;
#pragma unroll
            for (int i = 0; i < 16; ++i) p[i] = 0.f;
#pragma unroll
            for (int s = 0; s < 4; ++s) p = MFMA32(kf[s], qf[s], p);
            SB_STEP(kt, v00, v01, v10, v11);
            if (__all(carry < -150.f)) break;
            kp -= (size_t)32 * kpitch;
        }
    }
    LAS bf16_t* sp = stg + (4 * h) * 64 + r;
#pragma unroll
    for (int i = 0; i < 16; ++i) { const int ro = ((i & 3) + 8 * (i >> 2)) * 64; sp[ro] = f2bf(o0[i]); sp[ro + 32] = f2bf(o1[i]); }
    o_flush(stg, Orow0, opitch, lane);
}
#undef SB_STEP

#define XB_TMO      128
#define XB_XCNT(j)  (256  + 64 * (j))
#define XB_XSUB(j)  (1280 + 64 * (j))
#define XB_XGEN(j)  (2304 + 64 * (j))
#define XB_TOP      3328
#define XB_TOPGEN   3392
#define XCD_BAR_WORDS 3456
#define XB_SPIN_CAP (1u << 18)

__device__ __forceinline__ unsigned xb_ld(unsigned* p)              { return __hip_atomic_load(p, __ATOMIC_RELAXED, __HIP_MEMORY_SCOPE_AGENT); }
__device__ __forceinline__ unsigned xb_add(unsigned* p, unsigned v) { return __hip_atomic_fetch_add(p, v, __ATOMIC_RELAXED, __HIP_MEMORY_SCOPE_AGENT); }
__device__ __forceinline__ unsigned xb_xcc_id() { return (unsigned)__builtin_amdgcn_s_getreg((3 << 11) | 20) & 0xFu; }
#define XB_SPIN(cond, bar) do { unsigned _sp = 0; while (cond) { __builtin_amdgcn_s_sleep(1); \
    if ((++_sp & 255u) == 0u) { if (xb_ld(&(bar)[XB_TMO])) break; if (_sp > XB_SPIN_CAP) { atomicAdd(&(bar)[XB_TMO], 1u); break; } } } } while (0)

struct XcdBarrier {
    unsigned* bar; unsigned x;
    volatile LAS unsigned* st;
};

__device__ __forceinline__ XcdBarrier xcd_barrier_post(unsigned* bar, volatile LAS unsigned* st) {
    XcdBarrier b; b.bar = bar; b.x = xb_xcc_id(); b.st = st;
    if (threadIdx.x == 0) (void)xb_add(&bar[XB_XCNT(b.x)], 1u);
    return b;
}
__device__ __forceinline__ void xcd_barrier_complete(unsigned* bar, unsigned x, unsigned& nloc, unsigned& nx) {
    const unsigned G = gridDim.x * gridDim.y * gridDim.z;
    unsigned sum, cnt, mine, sp = 0u;
    for (;;) {
        sum = 0u; cnt = 0u; mine = 0u;
#pragma unroll
        for (unsigned j = 0; j < 16; ++j) { const unsigned c = xb_ld(&bar[XB_XCNT(j)]); sum += c; cnt += (c > 0u) ? 1u : 0u; mine = (j == x) ? c : mine; }
        if (sum == G) break;
        __builtin_amdgcn_s_sleep(1);
        if ((++sp & 255u) == 0u) { if (xb_ld(&bar[XB_TMO])) break; if (sp > XB_SPIN_CAP) { atomicAdd(&bar[XB_TMO], 1u); break; } }
    }
    nloc = mine > 0u ? mine : 1u; nx = cnt > 0u ? cnt : 1u;
}

__device__ __forceinline__ void xcd_barrier(const XcdBarrier& b) {
    asm volatile("s_waitcnt vmcnt(0)" ::: "memory");
    __syncthreads();
    if (threadIdx.x == 0) {
        unsigned* bar = b.bar;
        __builtin_amdgcn_s_waitcnt(0);
        unsigned nloc = b.st[0], nx = b.st[1];
        if (nloc == 0u) { xcd_barrier_complete(bar, b.x, nloc, nx); b.st[0] = nloc; b.st[1] = nx; }
        const unsigned old = xb_add(&bar[XB_XSUB(b.x)], 1u);
        const unsigned gen = old / nloc;
        if (old + 1u == (gen + 1u) * nloc) {
            __builtin_amdgcn_fence(__ATOMIC_RELEASE, "agent");
            asm volatile("s_waitcnt vmcnt(0)" ::: "memory");
            const unsigned og = xb_add(&bar[XB_TOP], 1u);
            const unsigned tg = og / nx;
            if (og + 1u == (tg + 1u) * nx) xb_add(&bar[XB_TOPGEN], 1u);
            else XB_SPIN(xb_ld(&bar[XB_TOPGEN]) == tg, bar);
            __builtin_amdgcn_fence(__ATOMIC_ACQUIRE, "agent");
            xb_add(&bar[XB_XGEN(b.x)], 1u);
            asm volatile("s_waitcnt vmcnt(0)" ::: "memory");
        } else {
            XB_SPIN(xb_ld(&bar[XB_XGEN(b.x)]) == gen, bar);
            __builtin_amdgcn_fence(__ATOMIC_ACQUIRE, "agent");
            asm volatile("s_waitcnt vmcnt(0)" ::: "memory");
        }
    }
    __syncthreads();
}

__global__ void __launch_bounds__(NTHREADS, 2) fwd(Params P) {
    extern __shared__ __attribute__((aligned(16))) unsigned char lds_raw[];
    LAS unsigned char* lds = (LAS unsigned char*)lds_raw;
    constexpr int G = 256, NGW = G * NWAVES, gthreads = G * NTHREADS;
    const int bx = blockIdx.x;
#if MK_COOP
    cooperative_groups::grid_group grid = cooperative_groups::this_grid();
    volatile LAS unsigned* MISC = (volatile LAS unsigned*)(lds + MISC_OFF);
    if (threadIdx.x < 64) MISC[threadIdx.x] = 0u;
    __syncthreads();
    XcdBarrier bar = xcd_barrier_post((unsigned*)(P.ws + WS_CTL) + CW_BAR, MISC + 8);
#endif
    for (int ph = P.ph_lo; ph < P.ph_hi; ++ph) {
        const int nrep = ((ph >= 1 && ph <= 6 && ((ph - 1) == MK_REP_K || (MK_REP_K == 6 && ph == 3))) || (ph == 0 && MK_REP_K == 7)) ? MK_REP_N : 1;
        for (int rep = 0; rep < nrep; ++rep) {
        int tid_o = threadIdx.x; asm volatile("" : "+v"(tid_o));
        const int tid = tid_o, lane = tid & 63, wave = __builtin_amdgcn_readfirstlane(tid >> 6);
        const int gw = bx * NWAVES + wave, gtid = bx * NTHREADS + tid;
        LAS bf16_t* stg = (LAS bf16_t*)(lds + 122880 + wave * 4096);
        unsigned char* ws = P.ws; asm volatile("" : "+s"(ws));
        unsigned* ctl = (unsigned*)(ws + WS_CTL);
        bf16_t* XN = (bf16_t*)(ws + WS_XN); bf16_t* H = (bf16_t*)(ws + WS_H);
        bf16_t* QC = (bf16_t*)(ws + WS_QC); bf16_t* KC = (bf16_t*)(ws + WS_KC);
        bf16_t* VTC = (bf16_t*)(ws + WS_VTC); bf16_t* VTA = (bf16_t*)(ws + WS_VTA); bf16_t* VTD = (bf16_t*)(ws + WS_VTD);
        bf16_t* Y = (bf16_t*)(ws + WS_Y);
        if (ph == 0) {
            {
                LAS float* scr = (LAS float*)(lds + wave * 16384);
                constexpr int I_IN = (DM / 64) * (DIN / 32), I_OUT = (DM / 64) * (DM / 32), I_UQ = (256 / 64) * (384 / 32), I_UKV = (128 / 64) * (512 / 32), I_L = I_IN + I_OUT + I_UQ + I_UKV;
                for (int it = gw; it < NLAYER * I_L; it += NGW) {
                    const int l = it / I_L; int v = it - l * I_L;
                    if (v < I_IN) { wT_item(P.w_in + (size_t)l * DM * DIN, DM, DIN, P.norm_pre + l * DM, (bf16_t*)(ws + WS_WIN) + (size_t)l * DINP * DM, C_AQ, C_AQ + 256, C_DQ, C_DQ + 256, SC64, scr, v, lane); continue; } v -= I_IN;
                    if (v < I_OUT) { wT_item(P.w_out + (size_t)l * DM * DM, DM, DM, P.g_grp + l * DM, (bf16_t*)(ws + WS_WOUT) + (size_t)l * DM * DM, 0, 0, 0, 0, 1.f, scr, v, lane); continue; } v -= I_OUT;
                    if (v < I_UQ) { wT_item(P.w_uq + (size_t)l * 256 * 384, 256, 384, P.g_cq + l * 256, (bf16_t*)(ws + WS_WUQ + (size_t)l * 262144), 0, 0, 0, 0, 1.f, scr, v, lane); continue; } v -= I_UQ;
                    wT_item(P.w_ukv + (size_t)l * 128 * 512, 128, 512, P.g_ckv + l * 128, (bf16_t*)(ws + WS_WUKV + (size_t)l * 131072), 0, 0, 0, 0, 1.f, scr, v, lane);
                }
                for (int it = gtid; it < NLAYER * (DINP - DIN) * (DM / 8); it += gthreads) { const int l = it / ((DINP - DIN) * (DM / 8)), v = it - l * ((DINP - DIN) * (DM / 8));
                    *(u32x4*)((bf16_t*)(ws + WS_WIN) + (size_t)l * DINP * DM + (size_t)DIN * DM + (size_t)v * 8) = (u32x4){0u, 0u, 0u, 0u}; }
            }
            { const float* __restrict__ xr = P.x; bf16_t* __restrict__ xo = XN;
#pragma unroll 2
              for (int mrow = gw; mrow < M_TOK; mrow += NGW) rms_row_to_bf16(xr + (size_t)mrow * DM, xo + (size_t)mrow * DM, lane); }
        } else {
            const int l = (ph - 1) / 6, k = (ph - 1) % 6;
            if (k == 0 || k == 4) {
                if (k == 0) {
                    pg8::Gemm g{XN, (const bf16_t*)(ws + WS_WIN) + (size_t)l * DINP * DM, M_TOK, DINP, DM}; pg8::StaticOrder S; S.init(M_TOK, DINP, G, bx);
                    pg8::EpiBf16<0> E{H, DINP, nullptr, 0, 0, 1.f};
                    pg8::gemm_phase<pg8::EpiBf16<0>, pg8::StaticOrder, true, true>(lds, g, S, E);
                } else {
                    pg8::Gemm g{XN, (const bf16_t*)(ws + WS_WOUT) + (size_t)l * DM * DM, M_TOK, DM, DM}; pg8::StaticOrder S; S.init(M_TOK, DM, G, bx);
                    pg8::EpiBf16<0> E{Y, DM, nullptr, 0, 0, 1.f};
                    pg8::gemm_phase<pg8::EpiBf16<0>, pg8::StaticOrder, true, true>(lds, g, S, E);
                }
            } else if (k == 1) {
                const bf16_t* WUQ = (const bf16_t*)(ws + WS_WUQ + (size_t)l * 262144);
                const bf16_t* WUKV = (const bf16_t*)(ws + WS_WUKV + (size_t)l * 131072);
                {
                    const int hh = bx & 3, tg = bx >> 2;
                    u32x4 wq[6], wk[4];
#pragma unroll
                    for (int i = 0; i < 6; ++i) { const int c = tid + 512 * i, row = c >> 5, cc = c & 31; wq[i] = *(const u32x4*)(WUQ + (size_t)(hh * 96 + row) * 256 + 8 * cc); }
#pragma unroll
                    for (int i = 0; i < 4; ++i) { const int c = tid + 512 * i, row = c >> 4, cc = c & 15; wk[i] = *(const u32x4*)(WUKV + (size_t)(hh * 128 + row) * 128 + 8 * cc); }
#pragma unroll
                    for (int i = 0; i < 6; ++i) { const int c = tid + 512 * i, row = c >> 5, cc = c & 31; *(LAS u32x4*)(lds + row * WQP + 16 * cc) = wq[i]; }
#pragma unroll
                    for (int i = 0; i < 4; ++i) { const int c = tid + 512 * i, row = c >> 4, cc = c & 15; *(LAS u32x4*)(lds + WQ_BYTES + row * WKP + 16 * cc) = wk[i]; }
                    __syncthreads();
                    const int tb = 8 * tg + wave;
                    mq_unit(H, lds, P.pos, QC, tb, hh, lane);
                    mkv_unit(H, lds + WQ_BYTES, P.pos, KC, VTC, tb, hh, lane, stg);
                }
                constexpr int NTB = M_TOK / 32;
                constexpr int U_ALL = M_TOK / 8;
                for (int u = gw; u < U_ALL; u += NGW) {
                    const int v = u;
                    conv_unit(H, P.conv_w + l * 768, P.conv_b + l * 256, Y, v, lane);
                }
            } else if (k == 2) {
                if (rep == 0 || MK_REP_K == 2)
                for (int pu = bx; pu < 256; pu += G) {
                    const int bh = pu & 7, Gq = pu >> 3;
                    mla_unit_blk(QC, KC, VTC, Y, bh, 63 - Gq, lds, tid);
                    mla_unit_blk(QC, KC, VTC, Y, bh, Gq, lds, tid);
                }
                if (rep == 0 || MK_REP_K == 6) {
                    const int bh = bx & 7, G8 = bx >> 3, b = bh >> 2, hh = bh & 3, qb = 8 * G8 + wave;
                    const size_t row0 = (size_t)b * SEQ + 32 * qb;
                    LAS bf16_t* ostg = (LAS bf16_t*)(lds + STG_OFF + wave * 4096);
                    {
                        const int kvh = hh >> 1;
                        const bf16_t* Kb = H + (size_t)b * SEQ * DINP + C_AK + kvh * 64;
                        stage_kv64_T<SWA_NK, SWA_VP>(Kb, DINP, H + (size_t)b * SEQ * DINP + C_AV + kvh * 64, DINP, 256 * G8 - 128, lds, tid);
                        __syncthreads();
                        swa_wave_lds(H + row0 * DINP + C_AQ + hh * 64, DINP, lds, qb, 8 * G8 - 4, P.sinks[l * 4 + hh] * LOG2E, Y + row0 * DM + hh * 64, DM, lane, ostg);
                        __syncthreads();
                    }
                    {
                        const bf16_t* Kb = H + (size_t)b * SEQ * DINP + C_DK + hh * 64;
                        const bf16_t* Vb = H + (size_t)b * SEQ * DINP + C_DV + hh * 64;
                        stage_kv64_T<SB_NK, SB_VP>(Kb, DINP, Vb, DINP, 256 * G8 - 192, lds, tid);
                        __syncthreads();
                        sb_wave_lds(H + row0 * DINP + C_DQ + hh * 64, DINP, lds, Kb, DINP, Vb, DINP, qb, 8 * G8 - 6, Y + row0 * DM + 768 + hh * 64, DM, lane, ostg);
                        __syncthreads();
                    }
                }
            } else if (k == 3) {
                const bf16_t* __restrict__ Yr = Y; const bf16_t* __restrict__ Hr = H; bf16_t* __restrict__ XNw = XN;
#pragma unroll 2
                for (int mrow = gw; mrow < M_TOK; mrow += NGW) {
                    const u32x4* yp = (const u32x4*)(Yr + (size_t)mrow * DM) + 2 * lane;
                    const u32x4* gp = (const u32x4*)(Hr + (size_t)mrow * DINP + C_GATE) + 2 * lane;
                    const u32x4 y0 = yp[0], y1 = yp[1], g0 = gp[0], g1 = gp[1];
                    float yv[16], gv[16];
#pragma unroll
                    for (int j = 0; j < 4; ++j) { yv[2 * j] = bflo(y0[j]); yv[2 * j + 1] = bfhi(y0[j]); yv[8 + 2 * j] = bflo(y1[j]); yv[8 + 2 * j + 1] = bfhi(y1[j]);
                                                  gv[2 * j] = bflo(g0[j]); gv[2 * j + 1] = bfhi(g0[j]); gv[8 + 2 * j] = bflo(g1[j]); gv[8 + 2 * j + 1] = bfhi(g1[j]); }
                    float ss = 0.f;
#pragma unroll
                    for (int j = 0; j < 16; ++j) ss += yv[j] * yv[j];
                    ss += __shfl_xor(ss, 1); ss += __shfl_xor(ss, 2); ss += __shfl_xor(ss, 4); ss += __shfl_xor(ss, 8);
                    const float rs = rsqrtf(ss * (1.f / 256.f) + EPS);
                    float o[16];
#pragma unroll
                    for (int j = 0; j < 16; ++j) { const float gg = gv[j]; o[j] = yv[j] * rs * gg * __builtin_amdgcn_rcpf(1.f + ex2(-gg * LOG2E)); }
                    u32x4 w0, w1;
#pragma unroll
                    for (int j = 0; j < 4; ++j) { w0[j] = pk2(o[2 * j], o[2 * j + 1]); w1[j] = pk2(o[8 + 2 * j], o[8 + 2 * j + 1]); }
                    u32x4* op = (u32x4*)(XNw + (size_t)mrow * DM) + 2 * lane;
                    op[0] = w0; op[1] = w1;
                }
            } else {
                const float* base = P.x;
                const float* gpost = P.g_post + l * DM;
                for (int mrow0 = gw; mrow0 < M_TOK; mrow0 += 2 * NGW) {
                    f32x4 zz[2][4], xv[2][4]; float s1[2] = {0.f, 0.f}, s2[2] = {0.f, 0.f};
                    const bool two = (mrow0 + NGW < M_TOK);
#pragma unroll
                    for (int rr = 0; rr < 2; ++rr) { const int mrow = (rr == 0 || two) ? mrow0 + rr * NGW : mrow0;
#pragma unroll
                        for (int j = 0; j < 4; ++j) { const u32x2 w = ((const u32x2*)(Y + (size_t)mrow * DM))[lane + 64 * j]; zz[rr][j] = (f32x4){bflo(w.x), bfhi(w.x), bflo(w.y), bfhi(w.y)};
                            if (l == 0) xv[rr][j] = __builtin_nontemporal_load((const f32x4*)(base + (size_t)mrow * DM) + lane + 64 * j);
                            else { const u32x2 xb = ((const u32x2*)(P.out + (size_t)mrow * DM))[lane + 64 * j]; xv[rr][j] = (f32x4){bflo(xb.x), bfhi(xb.x), bflo(xb.y), bfhi(xb.y)}; } } }
                    f32x4 gpv[4];
#pragma unroll
                    for (int j = 0; j < 4; ++j) gpv[j] = ((const f32x4*)gpost)[lane + 64 * j];
#pragma unroll
                    for (int rr = 0; rr < 2; ++rr)
#pragma unroll
                        for (int j = 0; j < 4; ++j) s1[rr] += (zz[rr][j].x * zz[rr][j].x + zz[rr][j].y * zz[rr][j].y) + (zz[rr][j].z * zz[rr][j].z + zz[rr][j].w * zz[rr][j].w);
                    const float rz0 = rsqrtf(wave_sum(s1[0]) * (1.f / DM) + EPS), rz1 = rsqrtf(wave_sum(s1[1]) * (1.f / DM) + EPS);
#pragma unroll
                    for (int rr = 0; rr < 2; ++rr) { const float rz = rr ? rz1 : rz0;
#pragma unroll
                        for (int j = 0; j < 4; ++j) { xv[rr][j] = xv[rr][j] + zz[rr][j] * rz * gpv[j];
                            s2[rr] += (xv[rr][j].x * xv[rr][j].x + xv[rr][j].y * xv[rr][j].y) + (xv[rr][j].z * xv[rr][j].z + xv[rr][j].w * xv[rr][j].w); } }
#pragma unroll
                    for (int rr = 0; rr < 2; ++rr) { if (rr == 1 && !two) break; const int mrow = mrow0 + rr * NGW;
#pragma unroll
                        for (int j = 0; j < 4; ++j) {
                            if (l + 1 < NLAYER) { u32x2 o; o.x = pk2(xv[rr][j].x, xv[rr][j].y); o.y = pk2(xv[rr][j].z, xv[rr][j].w); __builtin_nontemporal_store(o, (u32x2*)(P.out + (size_t)mrow * DM) + lane + 64 * j); }
                            else __builtin_nontemporal_store(xv[rr][j], (f32x4*)(P.out + (size_t)mrow * DM) + lane + 64 * j); } }
                    if (l + 1 < NLAYER) {
                        const float r0 = rsqrtf(wave_sum(s2[0]) * (1.f / DM) + EPS), r1 = rsqrtf(wave_sum(s2[1]) * (1.f / DM) + EPS);
#pragma unroll
                        for (int rr = 0; rr < 2; ++rr) { if (rr == 1 && !two) break; const int mrow = mrow0 + rr * NGW; const float rs = rr ? r1 : r0;
#pragma unroll
                            for (int j = 0; j < 4; ++j) { u32x2 o; o.x = pk2(xv[rr][j].x * rs, xv[rr][j].y * rs); o.y = pk2(xv[rr][j].z * rs, xv[rr][j].w * rs); ((u32x2*)(XN + (size_t)mrow * DM))[lane + 64 * j] = o; } }
                    }
                }
            }
            }
        }
        if (ph + 1 < P.ph_hi) {
#if MK_COOP
            if (P.ph_hi < 0) grid.sync();
            xcd_barrier(bar);
#endif
        }
    }
}
}

extern "C" void kernel_launch(void* const* d_in, const int* in_sizes, int n_in, void* d_out, int out_size, void* d_ws, size_t ws_size, hipStream_t stream) {
    using namespace mk;
    static int grid = 0;
    if (grid == 0) {
        if (n_in != 14 || out_size != M_TOK * DM || ws_size < WS_END) { fprintf(stderr, "kernel_launch: unexpected shapes (n_in %d out %d ws %zu)\n", n_in, out_size, ws_size); grid = -1; return; }
        int dev = 0, cus = 0, per_cu = 0;
        (void)hipGetDevice(&dev); (void)hipDeviceGetAttribute(&cus, hipDeviceAttributeMultiprocessorCount, dev);
        if (hipFuncSetAttribute((const void*)fwd, hipFuncAttributeMaxDynamicSharedMemorySize, LDS_BYTES) != hipSuccess) { fprintf(stderr, "kernel_launch: hipFuncSetAttribute failed\n"); grid = -1; return; }
        if (hipOccupancyMaxActiveBlocksPerMultiprocessor(&per_cu, (const void*)fwd, NTHREADS, LDS_BYTES) != hipSuccess || per_cu < 1) { fprintf(stderr, "kernel_launch: occupancy query says %d\n", per_cu); per_cu = 1; }
        (void)hipGetLastError();
        if (cus < 256) { fprintf(stderr, "kernel_launch: built for a 256-CU device (one workgroup per CU), found %d CUs\n", cus); grid = -1; return; }
        grid = 256;
    }
    if (grid < 0) return;
    (void)hipMemsetAsync((char*)d_ws + WS_CTL, 0, CTL_BYTES, stream);
    Params p{};
    p.x = (const float*)d_in[0]; p.pos = (const int*)d_in[1]; p.norm_pre = (const float*)d_in[2]; p.w_in = (const float*)d_in[3]; p.sinks = (const float*)d_in[4];
    p.conv_w = (const float*)d_in[5]; p.conv_b = (const float*)d_in[6]; p.g_cq = (const float*)d_in[7]; p.w_uq = (const float*)d_in[8]; p.g_ckv = (const float*)d_in[9];
    p.w_ukv = (const float*)d_in[10]; p.g_grp = (const float*)d_in[11]; p.w_out = (const float*)d_in[12]; p.g_post = (const float*)d_in[13];
    p.out = (float*)d_out; p.ws = (unsigned char*)d_ws;
    constexpr int NPH = 1 + 6 * NLAYER;
#if MK_COOP
    p.ph_lo = 0; p.ph_hi = NPH;
    void* args[] = {&p};
    hipError_t e = hipLaunchCooperativeKernel((const void*)fwd, dim3(grid), dim3(NTHREADS), args, LDS_BYTES, stream);
    if (e != hipSuccess) fprintf(stderr, "kernel_launch: cooperative launch failed: %s (grid %d)\n", hipGetErrorString(e), grid);
#else
    for (int ph = 0; ph < NPH; ++ph) { p.ph_lo = ph; p.ph_hi = ph + 1; hipLaunchKernelGGL(fwd, dim3(grid), dim3(NTHREADS), LDS_BYTES, stream, p); }
#endif
}
```

```cpp
#include <hip/hip_runtime.h>
#include <hip/hip_cooperative_groups.h>
#include <cstdio>
#include <cstdint>
#include <cmath>
namespace pg8 {
#define PG8_LAS __attribute__((address_space(3)))
typedef unsigned short bf16_t;
typedef short bf16x8 __attribute__((ext_vector_type(8)));
typedef float f32x4 __attribute__((ext_vector_type(4)));
typedef unsigned u32x4 __attribute__((ext_vector_type(4)));
constexpr int BM = 256, BK = 64, HALF = 128, HTB = HALF * BK * 2  , STAGE_BYTES = 8 * HTB, NXCD = 8, WGM = 8;

__host__ __device__ __forceinline__ int lds_byte(int r, int c) { const int st = (r >> 4) * 2 + (c >> 5), rr = r & 15, cc = c & 31, ob = rr * 64 + cc * 2; return st * 1024 + (ob ^ (((ob >> 9) & 1) << 5)); }
__host__ __device__ __forceinline__ void stage_rc(int b, int& R, int& C) { const int st = b / 1024, sb = b % 1024, swz = sb ^ (((sb >> 9) & 1) << 5); R = (st >> 1) * 16 + swz / 64; C = (st & 1) * 32 + (swz % 64) / 2; }
__host__ __device__ __forceinline__ int perm32(int rho) { const int n = rho >> 4, i = rho & 15; return 8 * (i >> 2) + 4 * n + (i & 3); }

struct Unit { int pm, pn; };
struct Gemm { const bf16_t* A; const bf16_t* Bt; int M, N, K; };

struct StaticOrder {
    int nM, nN, nwg, G, c;
    __host__ __device__ void init(int M, int N, int G_, int c_) { nM = M / BM; nN = N / BM; nwg = nM * nN; G = G_; c = c_; }
    __host__ __device__ bool next(int i, Unit& u) const {
        const long L = (long)i * G + c; if (L >= nwg) return false;
        int wgid = (int)L; { const int q = nwg / NXCD, r = nwg % NXCD, xcd = wgid % NXCD, off = wgid / NXCD; wgid = (xcd < r ? xcd * (q + 1) : r * (q + 1) + (xcd - r) * q) + off; }
        const int nig = WGM * nN, gid = wgid / nig, fm = gid * WGM, gsz = (nM - fm) < WGM ? (nM - fm) : WGM;
        u.pm = fm + ((wgid % nig) % gsz); u.pn = (wgid % nig) / gsz; return true;
    }
    __device__ __forceinline__ void a_ready(const Unit&) const {}
    __device__ __forceinline__ void done(const Unit&) const {}
};

__device__ __forceinline__ unsigned cvt_pk_bf16(float lo, float hi) { unsigned r; asm volatile("v_cvt_pk_bf16_f32 %0, %1, %2" : "=v"(r) : "v"(lo), "v"(hi)); return r; }
typedef float f32x2 __attribute__((ext_vector_type(2)));
__device__ __forceinline__ f32x2 gelu_pk(f32x2 v) {
    const f32x2 av = __builtin_elementwise_abs(v), d = av * 0.2316418882f + 1.0f;
    f32x2 t; t.x = __builtin_amdgcn_rcpf(d.x); t.y = __builtin_amdgcn_rcpf(d.y);
    f32x2 q = t * 0.5307027145f + (-0.7265760135f); q = q * t + 0.7107068705f; q = q * t + (-0.142248368f); q = q * t + 0.127414796f; q = q * t;
    const f32x2 s = (v * v) * (-0.72134752044f);
    f32x2 e; e.x = __builtin_amdgcn_exp2f(s.x); e.y = __builtin_amdgcn_exp2f(s.y);
    const f32x2 m = v * (q * e), r = v - m;
    f32x2 o; o.x = v.x < 0.f ? m.x : r.x; o.y = v.y < 0.f ? m.y : r.y; return o;
}

template <int ACT  > struct EpiBf16 {
    static constexpr bool PERM = true, AFTER_DRAIN = false; static_assert(ACT == 0 || ACT == 1, "EpiBf16: ACT is 0 (none) or 1 (gelu_pk)");
    bf16_t* O; int ldc; const float* bias; int split_cols; size_t split_stride; float scale0;
    __device__ __forceinline__ void operator()(const f32x4 (&acc)[2][2][4][2], const Unit& u, int wr, int wc, int fr, int fq) const {
        const int row0 = u.pm * BM + wr * 64 + fr; int colt = u.pn * BM; bf16_t* base = O;
        float sc = 1.f; if (split_cols) { const int t = colt / split_cols; base += (size_t)t * split_stride; colt -= t * split_cols; if (t == 0) sc = scale0; }
        const int col0 = colt + wc * 32 + 8 * fq, bcol0 = u.pn * BM + wc * 32 + 8 * fq;
        f32x4 bv[2][2];
#pragma unroll
        for (int bj = 0; bj < 2; ++bj)
#pragma unroll
            for (int n = 0; n < 2; ++n) bv[bj][n] = bias ? *(const f32x4*)(bias + bcol0 + bj * HALF + 4 * n) : (f32x4){0.f, 0.f, 0.f, 0.f};
#pragma unroll
        for (int ai = 0; ai < 2; ++ai)
#pragma unroll
            for (int m = 0; m < 4; ++m) { bf16_t* rowp = base + (size_t)(row0 + ai * HALF + m * 16) * ldc + col0;
#pragma unroll
                for (int bj = 0; bj < 2; ++bj) { f32x4 v0 = acc[ai][bj][m][0] + bv[bj][0], v1 = acc[ai][bj][m][1] + bv[bj][1];
                    if (ACT == 1) { f32x2 a = gelu_pk((f32x2){v0[0], v0[1]}), b = gelu_pk((f32x2){v0[2], v0[3]}), c = gelu_pk((f32x2){v1[0], v1[1]}), d = gelu_pk((f32x2){v1[2], v1[3]});
                        v0 = (f32x4){a.x, a.y, b.x, b.y}; v1 = (f32x4){c.x, c.y, d.x, d.y}; }
                    v0 = v0 * sc; v1 = v1 * sc; u32x4 w; w.x = cvt_pk_bf16(v0[0], v0[1]); w.y = cvt_pk_bf16(v0[2], v0[3]); w.z = cvt_pk_bf16(v1[0], v1[1]); w.w = cvt_pk_bf16(v1[2], v1[3]);
                    *(u32x4*)(rowp + bj * HALF) = w; } }
    }
};
template <class Epi, class Sched, bool ALIGN_EPI = false, bool SP2 = false>
__device__ __forceinline__ void gemm_phase(PG8_LAS unsigned char* lds, const Gemm g, const Sched& S, const Epi& E) {
    int tid_o = threadIdx.x; asm volatile("" : "+v"(tid_o));
    const int tid = tid_o, wid = __builtin_amdgcn_readfirstlane(tid >> 6), lane = tid & 63, wr = wid >> 2, wc = wid & 3, fr = lane & 15, fq = lane >> 4;
    const int K = g.K, nt = K / BK;
    unsigned voffA[2], voffB[2];
#pragma unroll
    for (int i = 0; i < 2; ++i) { int R, C; stage_rc(tid * 16 + i * 8192, R, C); const int Rb = Epi::PERM ? ((R & ~31) + perm32(R & 31)) : R;
        voffA[i] = (unsigned)(R * K + C) * 2u; voffB[i] = (unsigned)(Rb * K + C) * 2u; }
    const size_t kstep = (size_t)(BK * 2);
    const size_t hstep = (size_t)HALF * K * 2;
    const size_t tstep = 2 * hstep;
    const unsigned ldsw = (unsigned)wid * 1024u;
    const int aoff = lds_byte(wr * 64 + fr, fq * 8), boff = lds_byte(wc * 32 + fr, fq * 8);
#define PG8_SA(b, h) (((b) * 2 + (h)) * HTB)
#define PG8_SB(b, h) ((4 + (b) * 2 + (h)) * HTB)
#define PG8_STAGE(bufoff, gbase, voff) do { _Pragma("unroll") for (int _i = 0; _i < 2; ++_i) \
        __builtin_amdgcn_global_load_lds((const unsigned*)((const char*)(gbase) + (voff)[_i]), (PG8_LAS unsigned*)(lds + (bufoff) + ldsw + _i * 8192), 16, 0, 0); } while (0)
#define PG8_LDA(dst, b, h) do { _Pragma("unroll") for (int m = 0; m < 4; ++m) _Pragma("unroll") for (int k = 0; k < 2; ++k) dst[m][k] = *(const PG8_LAS bf16x8*)(lds + PG8_SA(b, h) + aoff + m * 2048 + k * 1024); } while (0)
#define PG8_LDB(dst, b, h) do { _Pragma("unroll") for (int n = 0; n < 2; ++n) _Pragma("unroll") for (int k = 0; k < 2; ++k) dst[n][k] = *(const PG8_LAS bf16x8*)(lds + PG8_SB(b, h) + boff + n * 2048 + k * 1024); } while (0)
#define PG8_MMA(ai, bj, At, Bt) do { __builtin_amdgcn_s_setprio(1); _Pragma("unroll") for (int m = 0; m < 4; ++m) _Pragma("unroll") for (int n = 0; n < 2; ++n) _Pragma("unroll") for (int k = 0; k < 2; ++k) \
        acc[ai][bj][m][n] = __builtin_amdgcn_mfma_f32_16x16x32_bf16(Bt[n][k], At[m][k], acc[ai][bj][m][n], 0, 0, 0); __builtin_amdgcn_s_setprio(0); } while (0)
#define PG8_WAIT_V(n) asm volatile("s_waitcnt vmcnt(" #n ")" ::: "memory")
#define PG8_WAIT_L(n) asm volatile("s_waitcnt lgkmcnt(" #n ")" ::: "memory")
#define PG8_BAR __builtin_amdgcn_s_barrier()
#define PG8_SCHED __builtin_amdgcn_sched_barrier(0)
    Unit cur, nxt; int ui = 0;
    if (!S.next(0, cur)) return;
    f32x4 acc[2][2][4][2];
#pragma unroll
    for (int a = 0; a < 2; ++a)
#pragma unroll
        for (int b = 0; b < 2; ++b)
#pragma unroll
            for (int m = 0; m < 4; ++m)
#pragma unroll
                for (int n = 0; n < 2; ++n) acc[a][b][m][n] = (f32x4){0.f, 0.f, 0.f, 0.f};
    bf16x8 At[4][2], B0[2][2], B1[2][2];
    const char* cA = (const char*)g.A + (size_t)cur.pm * tstep; const char* cB = (const char*)g.Bt + (size_t)cur.pn * tstep;
    S.a_ready(cur);
    if constexpr (SP2) {
        PG8_STAGE(PG8_SB(0, 0), cB, voffB); PG8_STAGE(PG8_SB(0, 1), cB + hstep, voffB); PG8_STAGE(PG8_SA(0, 0), cA, voffA); PG8_STAGE(PG8_SA(0, 1), cA + hstep, voffA);
        if (wr == 1) PG8_BAR;
        PG8_WAIT_V(2); PG8_BAR;
        PG8_STAGE(PG8_SB(1, 0), cB + kstep, voffB); PG8_STAGE(PG8_SA(1, 0), cA + kstep, voffA); PG8_STAGE(PG8_SB(1, 1), cB + hstep + kstep, voffB);
        PG8_WAIT_V(6); PG8_BAR;
    } else {
        PG8_STAGE(PG8_SB(0, 0), cB, voffB); PG8_STAGE(PG8_SA(0, 0), cA, voffA); PG8_STAGE(PG8_SB(0, 1), cB + hstep, voffB); PG8_STAGE(PG8_SA(0, 1), cA + hstep, voffA);
        if (wr == 1) PG8_BAR;
        PG8_WAIT_V(4); PG8_BAR;
        PG8_STAGE(PG8_SB(1, 0), cB + kstep, voffB); PG8_STAGE(PG8_SA(1, 0), cA + kstep, voffA); PG8_STAGE(PG8_SB(1, 1), cB + hstep + kstep, voffB);
        PG8_WAIT_V(6); PG8_BAR;
    }
    for (;;) {
        const bool has_next = S.next(ui + 1, nxt);
        const char* nA = has_next ? (const char*)g.A + (size_t)nxt.pm * tstep : cA; const char* nB = has_next ? (const char*)g.Bt + (size_t)nxt.pn * tstep : cB;
        for (int t = 0; t < nt; t += 2) {
            const bool last = (t == nt - 2);
            const char* a1 = cA + (size_t)(t + 1) * kstep;
            const char* a2 = last ? nA : cA + (size_t)(t + 2) * kstep; const char* b2 = last ? nB : cB + (size_t)(t + 2) * kstep;
            const char* a3 = a2 + kstep; const char* b3 = b2 + kstep;
            if (last && has_next) S.a_ready(nxt);
            if constexpr (SP2) {
            PG8_LDB(B0, 0, 0); PG8_LDB(B1, 0, 1); PG8_SCHED; PG8_LDA(At, 0, 0); PG8_STAGE(PG8_SA(1, 1), a1 + hstep, voffA);
            PG8_WAIT_V(8); PG8_WAIT_L(0); PG8_BAR; PG8_MMA(0, 0, At, B0); PG8_MMA(0, 1, At, B1); PG8_BAR; PG8_SCHED;
            PG8_LDA(At, 0, 1); PG8_STAGE(PG8_SB(0, 0), b2, voffB); PG8_STAGE(PG8_SB(0, 1), b2 + hstep, voffB); PG8_STAGE(PG8_SA(0, 0), a2, voffA);
            PG8_WAIT_V(8); PG8_WAIT_L(0); PG8_BAR; PG8_MMA(1, 0, At, B0); PG8_MMA(1, 1, At, B1); PG8_BAR; PG8_SCHED;
            PG8_LDB(B0, 1, 0); PG8_LDB(B1, 1, 1); PG8_SCHED; PG8_LDA(At, 1, 0); PG8_STAGE(PG8_SA(0, 1), a2 + hstep, voffA);
            PG8_WAIT_V(8); PG8_WAIT_L(0); PG8_BAR; PG8_MMA(0, 0, At, B0); PG8_MMA(0, 1, At, B1); PG8_BAR; PG8_SCHED;
            PG8_LDA(At, 1, 1); PG8_STAGE(PG8_SB(1, 0), b3, voffB); PG8_STAGE(PG8_SB(1, 1), b3 + hstep, voffB); PG8_STAGE(PG8_SA(1, 0), a3, voffA);
            PG8_WAIT_V(8); PG8_WAIT_L(0); PG8_BAR; PG8_MMA(1, 0, At, B0); PG8_MMA(1, 1, At, B1); PG8_BAR; PG8_SCHED;
            } else {
            PG8_LDB(B0, 0, 0); PG8_SCHED; PG8_LDA(At, 0, 0); PG8_STAGE(PG8_SA(1, 1), a1 + hstep, voffA);
            PG8_WAIT_L(8); PG8_BAR; PG8_WAIT_L(0); PG8_MMA(0, 0, At, B0); PG8_BAR; PG8_SCHED;
            PG8_LDB(B1, 0, 1); PG8_STAGE(PG8_SB(0, 0), b2, voffB);
            PG8_BAR; PG8_WAIT_L(0); PG8_MMA(0, 1, At, B1); PG8_BAR;
            PG8_LDA(At, 0, 1); PG8_STAGE(PG8_SA(0, 0), a2, voffA);
            PG8_BAR; PG8_WAIT_L(0); PG8_MMA(1, 0, At, B0); PG8_BAR; PG8_SCHED;
            PG8_STAGE(PG8_SB(0, 1), b2 + hstep, voffB);
            PG8_WAIT_V(6); PG8_BAR; PG8_MMA(1, 1, At, B1); PG8_BAR;
            PG8_LDB(B0, 1, 0); PG8_SCHED; PG8_LDA(At, 1, 0); PG8_STAGE(PG8_SA(0, 1), a2 + hstep, voffA);
            PG8_WAIT_L(8); PG8_BAR; PG8_WAIT_L(0); PG8_MMA(0, 0, At, B0); PG8_BAR; PG8_SCHED;
            PG8_LDB(B1, 1, 1); PG8_STAGE(PG8_SB(1, 0), b3, voffB);
            PG8_BAR; PG8_WAIT_L(0); PG8_MMA(0, 1, At, B1); PG8_BAR;
            PG8_LDA(At, 1, 1); PG8_STAGE(PG8_SA(1, 0), a3, voffA);
            PG8_BAR; PG8_WAIT_L(0); PG8_MMA(1, 0, At, B0); PG8_BAR; PG8_SCHED;
            PG8_STAGE(PG8_SB(1, 1), b3 + hstep, voffB);
            PG8_WAIT_V(6); PG8_BAR; PG8_MMA(1, 1, At, B1); PG8_BAR;
            }
        }
        if constexpr (ALIGN_EPI) { if (wr == 0) PG8_BAR; }
        if constexpr (!Epi::AFTER_DRAIN) { E(acc, cur, wr, wc, fr, fq); S.done(cur); }
        if (!has_next) break;
#pragma unroll
        for (int a = 0; a < 2; ++a)
#pragma unroll
            for (int b = 0; b < 2; ++b)
#pragma unroll
                for (int m = 0; m < 4; ++m)
#pragma unroll
                    for (int n = 0; n < 2; ++n) acc[a][b][m][n] = (f32x4){0.f, 0.f, 0.f, 0.f};
        cur = nxt; cA = nA; cB = nB; ++ui;
        if constexpr (ALIGN_EPI) { if (wr == 1) PG8_BAR; }
    }
    PG8_WAIT_V(0);
    if constexpr (!ALIGN_EPI) { if (wr == 0) PG8_BAR; }
    PG8_BAR;
    if constexpr (Epi::AFTER_DRAIN) { E.fused(acc, cur, wr, wc, fr, fq, lds, wid, lane); S.done(cur); }
#undef PG8_SA
#undef PG8_SB
#undef PG8_STAGE
#undef PG8_LDA
#undef PG8_LDB
#undef PG8_MMA
#undef PG8_WAIT_V
#undef PG8_WAIT_L
#undef PG8_BAR
#undef PG8_SCHED
}
}
#ifndef MK_COOP
#define MK_COOP 1
#endif
#ifndef MK_REP_K
#define MK_REP_K -1
#endif
#ifndef MK_REP_N
#define MK_REP_N 1
#endif
namespace mk {
using pg8::bf16_t; using pg8::bf16x8; using pg8::f32x4; using pg8::u32x4;
typedef float f32x16 __attribute__((ext_vector_type(16)));
typedef unsigned u32x2 __attribute__((ext_vector_type(2)));
typedef float f32x2_t __attribute__((ext_vector_type(2)));
typedef __bf16 bf16x2_t __attribute__((ext_vector_type(2)));
#define LAS __attribute__((address_space(3)))
#define MFMA32(a, b, c) __builtin_amdgcn_mfma_f32_32x32x16_bf16((a), (b), (c), 0, 0, 0)

constexpr int M_TOK = 16384, SEQ = 8192, DM = 1024, DIN = 3488, DINP = 3584, NLAYER = 2;
constexpr int C_AQ = 0, C_AK = 256, C_AV = 384, C_BB = 512, C_BC = 768, C_BX = 1024, C_CQ = 1280, C_CKV = 1536, C_CKR = 1664,
              C_DQ = 1696, C_DK = 1952, C_DV = 2208, C_GATE = 2464;
constexpr float EPS = 1e-6f, LOG2E = 1.4426950408889634f;
constexpr float SC64 = 0.125f * LOG2E;
constexpr float QSC_MLA = 0.10206207261596575f * LOG2E;
constexpr int NWAVES = 8, NTHREADS = 512;
constexpr int LDS_BYTES = 122880 + 8 * 4096 + 1024;

constexpr size_t MiB = 1u << 20;
constexpr size_t WS_CTL = 0, CTL_BYTES = 65536;
constexpr int CW_BAR = 1024;
constexpr size_t WS_WIN = 1 * MiB;
constexpr size_t WS_WOUT = 15 * MiB;
constexpr size_t WS_WUQ = 19 * MiB;
constexpr size_t WS_WUKV = 19 * MiB + 512 * 1024;
constexpr size_t WS_XN = 32 * MiB;
constexpr size_t WS_H = 64 * MiB;
constexpr size_t WS_QC = 176 * MiB;
constexpr size_t WS_KC = 188 * MiB;
constexpr size_t WS_VTC = 200 * MiB;
constexpr size_t WS_VTA = 208 * MiB;
constexpr size_t WS_VTD = 212 * MiB;
constexpr size_t WS_Y = 220 * MiB;
constexpr size_t WS_END = 252 * MiB;

struct Params {
    const float* x; const int* pos; const float* norm_pre; const float* w_in; const float* sinks; const float* conv_w; const float* conv_b;
    const float* g_cq; const float* w_uq; const float* g_ckv; const float* w_ukv; const float* g_grp; const float* w_out; const float* g_post;
    float* out; unsigned char* ws; int ph_lo, ph_hi;
};

__device__ __forceinline__ unsigned pk2(float lo, float hi) { f32x2_t v = {lo, hi}; bf16x2_t b = __builtin_convertvector(v, bf16x2_t); return __builtin_bit_cast(unsigned, b); }
__device__ __forceinline__ float bf2f(short s) { return __uint_as_float(((unsigned)(unsigned short)s) << 16); }
__device__ __forceinline__ float bflo(unsigned u) { return __uint_as_float(u << 16); }
__device__ __forceinline__ float bfhi(unsigned u) { return __uint_as_float(u & 0xffff0000u); }
__device__ __forceinline__ bf16_t f2bf(float f) { return (bf16_t)(pk2(f, 0.f) & 0xffffu); }
__device__ __forceinline__ int crow(int i, int h) { return (i & 3) + 8 * (i >> 2) + 4 * h; }
__device__ __forceinline__ float ex2(float x) { return __builtin_amdgcn_exp2f(x); }
__device__ __forceinline__ float lg2(float x) { return __builtin_amdgcn_logf(x); }
__device__ __forceinline__ float xh_max(float v) { auto rr = __builtin_amdgcn_permlane32_swap(__float_as_uint(v), __float_as_uint(v), false, false); return fmaxf(__uint_as_float(rr[0]), __uint_as_float(rr[1])); }
__device__ __forceinline__ float xh_sum(float v) { auto rr = __builtin_amdgcn_permlane32_swap(__float_as_uint(v), __float_as_uint(v), false, false); return __uint_as_float(rr[0]) + __uint_as_float(rr[1]); }
__device__ __forceinline__ float xh_other(float v, int h) { auto rr = __builtin_amdgcn_permlane32_swap(__float_as_uint(v), __float_as_uint(v), false, false); return __uint_as_float(h ? rr[0] : rr[1]); }
#define MX3(a, b, c) __builtin_fmaxf(__builtin_fmaxf((a), (b)), (c))
__device__ __forceinline__ float wave_sum(float v) {
#pragma unroll
    for (int o = 1; o < 64; o <<= 1) v += __shfl_xor(v, o);
    return v;
}
__device__ __forceinline__ bf16x8 pack8(const float* e) {
    u32x4 w; w.x = pk2(e[0], e[1]); w.y = pk2(e[2], e[3]); w.z = pk2(e[4], e[5]); w.w = pk2(e[6], e[7]);
    return __builtin_bit_cast(bf16x8, w);
}

__device__ __forceinline__ void conv_wT(const float* __restrict__ W, int K, int N, int NP, const float* __restrict__ gain, bf16_t* __restrict__ dst,
                                        int a0, int a1, int b0, int b1, float sc, int gtid, int gthreads) {
    const int k8n = K / 8; const int items = NP * k8n;
#pragma unroll 2
    for (int it = gtid; it < items; it += gthreads) {
        const int n = it % NP, k8 = it / NP;
        u32x4 o = {0u, 0u, 0u, 0u};
        if (n < N) {
            const float cs = ((n >= a0 && n < a1) || (n >= b0 && n < b1)) ? sc : 1.f;
            float v[8];
#pragma unroll
            for (int j = 0; j < 8; ++j) v[j] = W[(size_t)(k8 * 8 + j) * N + n] * gain[k8 * 8 + j] * cs;
            o.x = pk2(v[0], v[1]); o.y = pk2(v[2], v[3]); o.z = pk2(v[4], v[5]); o.w = pk2(v[6], v[7]);
        }
        *(u32x4*)(dst + (size_t)n * K + k8 * 8) = o;
    }
}
__device__ __forceinline__ void wT_item(const float* __restrict__ W, int K, int N, const float* __restrict__ gain, bf16_t* __restrict__ WT, int a0, int a1, int b0, int b1, float sc,
                                        LAS float* scr, int item, int lane) {
    const int nblk = N / 32, kb = item / nblk, nb = item - kb * nblk, k0 = 64 * kb, n0 = 32 * nb;
#pragma unroll 8
    for (int i = 0; i < 32; ++i) { const int kk = 2 * i + (lane >> 5); scr[kk * 33 + (lane & 31)] = __builtin_nontemporal_load(W + (size_t)(k0 + kk) * N + n0 + (lane & 31)); }
    const int c = lane & 7;
    float g8[8];
#pragma unroll
    for (int j = 0; j < 8; ++j) g8[j] = gain[k0 + 8 * c + j];
#pragma unroll
    for (int j = 0; j < 4; ++j) { const int n = (lane >> 3) + 8 * j, nn = n0 + n; const LAS float* sp = scr + (8 * c) * 33 + n;
        const float cs = ((nn >= a0 && nn < a1) || (nn >= b0 && nn < b1)) ? sc : 1.f;
        u32x4 o; o.x = pk2(sp[0 * 33] * g8[0] * cs, sp[1 * 33] * g8[1] * cs); o.y = pk2(sp[2 * 33] * g8[2] * cs, sp[3 * 33] * g8[3] * cs);
        o.z = pk2(sp[4 * 33] * g8[4] * cs, sp[5 * 33] * g8[5] * cs); o.w = pk2(sp[6 * 33] * g8[6] * cs, sp[7 * 33] * g8[7] * cs);
        *(u32x4*)(WT + (size_t)nn * K + k0 + 8 * c) = o; }
}
__device__ __forceinline__ void rms_row_to_bf16(const float* __restrict__ xrow, bf16_t* __restrict__ orow, int lane) {
    f32x4 v[4]; float s = 0.f;
#pragma unroll
    for (int j = 0; j < 4; ++j) { v[j] = __builtin_nontemporal_load((const f32x4*)xrow + lane + 64 * j); s += (v[j].x * v[j].x + v[j].y * v[j].y) + (v[j].z * v[j].z + v[j].w * v[j].w); }
    const float rs = rsqrtf(wave_sum(s) * (1.f / DM) + EPS);
#pragma unroll
    for (int j = 0; j < 4; ++j) { u32x2 o; o.x = pk2(v[j].x * rs, v[j].y * rs); o.y = pk2(v[j].z * rs, v[j].w * rs); ((u32x2*)orow)[lane + 64 * j] = o; }
}

__device__ __forceinline__ void rope_cs(int pos, int h, float (&cs)[8], float (&sn)[8]) {
#pragma unroll
    for (int i = 0; i < 8; ++i) {
        const int f = (i & 3) + 8 * (i >> 2) + 4 * h;
        const float freq = ex2(-(float)f * 0.830482023721841f);
        const float ang = (float)pos * freq;
        const double rev = (double)ang * 0.15915494309189535;
        const float fr = (float)(rev - __builtin_rint(rev));
        cs[i] = __builtin_amdgcn_cosf(fr); sn[i] = __builtin_amdgcn_sinf(fr);
    }
}
__device__ __forceinline__ void rope_apply(f32x16& a, const float (&cs)[8], const float (&sn)[8]) {
#pragma unroll
    for (int i = 0; i < 8; ++i) { const float x1 = a[i], x2 = a[i + 8]; a[i] = x1 * cs[i] - x2 * sn[i]; a[i + 8] = x1 * sn[i] + x2 * cs[i]; }
}
__device__ __forceinline__ void store_tile_rowmajor(bf16_t* dst  , const f32x16& a, int h) {
#pragma unroll
    for (int g = 0; g < 4; ++g) { u32x2 o; o.x = pk2(a[4 * g], a[4 * g + 1]); o.y = pk2(a[4 * g + 2], a[4 * g + 3]); *(u32x2*)(dst + 8 * g + 4 * h) = o; }
}
constexpr int WQP = 528, WKP = 272, WQ_BYTES = 96 * WQP;
__device__ __forceinline__ void mq_unit(const bf16_t* __restrict__ H, const LAS unsigned char* Wl, const int* __restrict__ pos, bf16_t* __restrict__ QC, int tb, int hh, int lane) {
    const int r = lane & 31, h = lane >> 5, tok = tb * 32 + r;
    const bf16_t* src = H + (size_t)tok * DINP + C_CQ + 8 * h;
    bf16x8 bfr[16]; float ss = 0.f;
#pragma unroll
    for (int s = 0; s < 16; ++s) { bfr[s] = *(const bf16x8*)(src + 16 * s);
#pragma unroll
        for (int j = 0; j < 8; ++j) { const float v = bf2f(bfr[s][j]); ss += v * v; } }
    ss += __shfl_xor(ss, 32);
    const float rs = rsqrtf(ss * (1.f / 256.f) + EPS) * QSC_MLA;
    float cs[8], sn[8]; rope_cs(pos[tok], h, cs, sn);
    const LAS unsigned char* W = Wl + r * WQP + 16 * h;
#pragma unroll 1
    for (int nt = 0; nt < 3; ++nt) {
        f32x16 acc;
#pragma unroll
        for (int i = 0; i < 16; ++i) acc[i] = 0.f;
#pragma unroll
        for (int s = 0; s < 16; ++s) { const bf16x8 a = *(const LAS bf16x8*)(W + nt * 32 * WQP + 32 * s); acc = MFMA32(a, bfr[s], acc); }
#pragma unroll
        for (int i = 0; i < 16; ++i) acc[i] *= rs;
        if (nt == 2) rope_apply(acc, cs, sn);
        store_tile_rowmajor(QC + (size_t)tok * 384 + hh * 96 + nt * 32, acc, h);
    }
}
__device__ __forceinline__ void vt_flush(LAS bf16_t* stg, bf16_t* __restrict__ dst  , int lane) {
    const LAS u32x4* rp = (const LAS u32x4*)(stg + lane * 32);
    u32x4 w[4];
#pragma unroll
    for (int c = 0; c < 4; ++c) w[c] = rp[c];
    u32x4* gp = (u32x4*)(dst + (size_t)lane * SEQ);
#pragma unroll
    for (int c = 0; c < 4; ++c) gp[c] = w[c];
}
__device__ __forceinline__ void mkv_unit(const bf16_t* __restrict__ H, const LAS unsigned char* Wl, const int* __restrict__ pos, bf16_t* __restrict__ KC, bf16_t* __restrict__ VTC, int tb, int hh, int lane, LAS bf16_t* stg) {
    const int r = lane & 31, h = lane >> 5, tok = tb * 32 + r;
    const bf16_t* src = H + (size_t)tok * DINP + C_CKV + 8 * h;
    bf16x8 bfr[8]; float ss = 0.f;
#pragma unroll
    for (int s = 0; s < 8; ++s) { bfr[s] = *(const bf16x8*)(src + 16 * s);
#pragma unroll
        for (int j = 0; j < 8; ++j) { const float v = bf2f(bfr[s][j]); ss += v * v; } }
    ss += __shfl_xor(ss, 32);
    const float rs = rsqrtf(ss * (1.f / 128.f) + EPS);
    const LAS unsigned char* W = Wl + r * WKP + 16 * h;
    const int b = (tb * 32) / SEQ, t0 = (tb * 32) % SEQ;
#pragma unroll 1
    for (int nt = 0; nt < 4; ++nt) {
        f32x16 acc;
#pragma unroll
        for (int i = 0; i < 16; ++i) acc[i] = 0.f;
#pragma unroll
        for (int s = 0; s < 8; ++s) { const bf16x8 a = *(const LAS bf16x8*)(W + nt * 32 * WKP + 32 * s); acc = MFMA32(a, bfr[s], acc); }
#pragma unroll
        for (int i = 0; i < 16; ++i) acc[i] *= rs;
        if (nt < 2) store_tile_rowmajor(KC + (size_t)tok * 384 + hh * 96 + nt * 32, acc, h);
        else {
            LAS bf16_t* sp = stg + ((nt - 2) * 32 + 4 * h) * 32 + r;
#pragma unroll
            for (int i = 0; i < 16; ++i) sp[((i & 3) + 8 * (i >> 2)) * 32] = f2bf(acc[i]);
        }
    }
    vt_flush(stg, VTC + ((size_t)((b * 4 + hh) * 64)) * SEQ + t0, lane);
    f32x16 kr;
    const bf16_t* krp = H + (size_t)tok * DINP + C_CKR + 4 * h;
#pragma unroll
    for (int g = 0; g < 4; ++g) { const u32x2 w = *(const u32x2*)(krp + 8 * g); kr[4 * g] = bflo(w.x); kr[4 * g + 1] = bfhi(w.x); kr[4 * g + 2] = bflo(w.y); kr[4 * g + 3] = bfhi(w.y); }
    float cs[8], sn[8]; rope_cs(pos[tok], h, cs, sn);
    rope_apply(kr, cs, sn);
    store_tile_rowmajor(KC + (size_t)tok * 384 + hh * 96 + 64, kr, h);
}
__device__ __forceinline__ void vt_unit(const bf16_t* __restrict__ H, int col0, int NH, bf16_t* __restrict__ VT, int tb, int head, int lane, LAS bf16_t* stg) {
    const int r = lane & 31, h = lane >> 5, tok = tb * 32 + r, b = (tb * 32) / SEQ, t0 = (tb * 32) % SEQ;
    const bf16_t* src = H + (size_t)tok * DINP + col0 + head * 64 + 32 * h;
    bf16x8 v[4];
#pragma unroll
    for (int c = 0; c < 4; ++c) v[c] = *(const bf16x8*)(src + 8 * c);
    LAS bf16_t* sp = stg + (32 * h) * 32 + r;
#pragma unroll
    for (int c = 0; c < 4; ++c)
#pragma unroll
        for (int j = 0; j < 8; ++j) sp[(8 * c + j) * 32] = (bf16_t)v[c][j];
    vt_flush(stg, VT + ((size_t)((b * NH + head) * 64)) * SEQ + t0, lane);
}
__device__ __forceinline__ void conv_unit(const bf16_t* __restrict__ H, const float* __restrict__ cw, const float* __restrict__ cb, bf16_t* __restrict__ Y, int tb8, int lane) {
    const int tok0 = tb8 * 8, t0 = tok0 % SEQ, ch = 4 * lane;
    const f32x4 w0 = *(const f32x4*)(cw + ch), w1 = *(const f32x4*)(cw + 256 + ch), w2 = *(const f32x4*)(cw + 512 + ch), bs = *(const f32x4*)(cb + ch);
    u32x2 cc[10], xx[10], bb[8];
    const int back = (t0 >= 2) ? 2 : 0;
#pragma unroll
    for (int i = 0; i < 10; ++i) { const int ti = (i < 2) ? (i - back) : (i - 2); const bf16_t* p = H + (size_t)(tok0 + ti) * DINP + ch;
        cc[i] = *(const u32x2*)(p + C_BC); xx[i] = *(const u32x2*)(p + C_BX); if (i >= 2) bb[i - 2] = *(const u32x2*)(p + C_BB); }
    f32x4 u[10];
#pragma unroll
    for (int i = 0; i < 10; ++i) u[i] = (f32x4){bflo(cc[i].x) * bflo(xx[i].x), bfhi(cc[i].x) * bfhi(xx[i].x), bflo(cc[i].y) * bflo(xx[i].y), bfhi(cc[i].y) * bfhi(xx[i].y)};
    if (back == 0) { u[0] = (f32x4){0.f, 0.f, 0.f, 0.f}; u[1] = (f32x4){0.f, 0.f, 0.f, 0.f}; }
#pragma unroll
    for (int i = 0; i < 8; ++i) {
        const f32x4 bg = {bflo(bb[i].x), bfhi(bb[i].x), bflo(bb[i].y), bfhi(bb[i].y)};
        const f32x4 y = bg * (w0 * u[i] + w1 * u[i + 1] + w2 * u[i + 2] + bs);
        u32x2 o; o.x = pk2(y.x, y.y); o.y = pk2(y.z, y.w);
        *(u32x2*)(Y + (size_t)(tok0 + i) * DM + 256 + ch) = o;
    }
}

__device__ __forceinline__ void o_flush(LAS bf16_t* stg, bf16_t* __restrict__ Orow0, int opitch, int lane) {
    u32x4 w[4];
#pragma unroll
    for (int j = 0; j < 4; ++j) w[j] = *(const LAS u32x4*)(stg + (lane + 64 * j) * 8);
#pragma unroll
    for (int j = 0; j < 4; ++j) { const int c = lane + 64 * j; *(u32x4*)(Orow0 + (size_t)(c >> 3) * opitch + (c & 7) * 8) = w[j]; }
}
template <int DKS, bool SINK>
__device__ __forceinline__ void softmax_unit(const bf16_t* __restrict__ Qrow0, int qpitch, const bf16_t* __restrict__ Kb, int kpitch, const bf16_t* __restrict__ VT,
                                             int qb, int kt_begin, int window, float sink2, bf16_t* __restrict__ Orow0, int opitch, int lane, LAS bf16_t* stg) {
    const int r = lane & 31, h = lane >> 5;
    const int pr = (r & ~12) | ((r & 8) >> 1) | ((r & 4) << 1);
    bf16x8 qf[DKS];
#pragma unroll
    for (int s = 0; s < DKS; ++s) qf[s] = *(const bf16x8*)(Qrow0 + (size_t)r * qpitch + 16 * s + 8 * h);
    f32x16 o0, o1;
#pragma unroll
    for (int i = 0; i < 16; ++i) { o0[i] = 0.f; o1[i] = 0.f; }
    float m = -1e30f, l = 0.f;
    const int kt_end = qb + 1, q = 32 * qb + r;
    const bf16_t* kp = Kb + (size_t)(32 * kt_begin + pr) * kpitch + 8 * h;
    const bf16_t* vp = VT + (size_t)r * SEQ + 32 * kt_begin + 8 * h;
    bf16x8 kf[DKS];
#pragma unroll
    for (int s = 0; s < DKS; ++s) kf[s] = *(const bf16x8*)(kp + 16 * s);
    for (int kt = kt_begin; kt < kt_end; ++kt) {
        bf16x8 kn[DKS];
        if (kt + 1 < kt_end) {
#pragma unroll
            for (int s = 0; s < DKS; ++s) kn[s] = *(const bf16x8*)(kp + (size_t)32 * kpitch + 16 * s);
        } else {
#pragma unroll
            for (int s = 0; s < DKS; ++s) kn[s] = kf[s];
        }
        const bf16x8 v00 = *(const bf16x8*)(vp), v01 = *(const bf16x8*)(vp + 32 * SEQ), v10 = *(const bf16x8*)(vp + 16), v11 = *(const bf16x8*)(vp + 32 * SEQ + 16);
        f32x16 p;
#pragma unroll
        for (int i = 0; i < 16; ++i) p[i] = 0.f;
#pragma unroll
        for (int s = 0; s < DKS; ++s) p = MFMA32(kf[s], qf[s], p);
        if (kt == qb || (window != 0 && kt == qb - (window >> 5))) {
            const int k0 = 32 * kt + 8 * h;
#pragma unroll
            for (int i = 0; i < 16; ++i) { const int kv = k0 + 16 * (i >> 3) + (i & 7); const bool ok = (kv <= q) && (window == 0 || kv > q - window); if (!ok) p[i] = -INFINITY; }
        }
        float rm = MX3(p[0], p[1], p[2]);
#pragma unroll
        for (int i = 3; i < 15; i += 2) rm = MX3(rm, p[i], p[i + 1]);
        rm = xh_max(fmaxf(rm, p[15]));
        if (__any(rm > m + 6.f)) {
            const float mn = fmaxf(m, rm), f = ex2(m - mn); m = mn; l *= f;
#pragma unroll
            for (int i = 0; i < 16; ++i) { const float fi = __shfl(f, crow(i, h)); o0[i] *= fi; o1[i] *= fi; }
        }
        float e[16];
#pragma unroll
        for (int i = 0; i < 16; ++i) { e[i] = ex2(p[i] - m); l += e[i]; }
        const bf16x8 pa0 = pack8(e), pa1 = pack8(e + 8);
        o0 = MFMA32(pa0, v00, o0); o1 = MFMA32(pa0, v01, o1);
        o0 = MFMA32(pa1, v10, o0); o1 = MFMA32(pa1, v11, o1);
#pragma unroll
        for (int s = 0; s < DKS; ++s) kf[s] = kn[s];
        kp += (size_t)32 * kpitch; vp += 32;
    }
    l = xh_sum(l);
    if (SINK) l += ex2(sink2 - m);
    const float inv = 1.f / l;
    LAS bf16_t* sp = stg + (4 * h) * 64 + r;
#pragma unroll
    for (int i = 0; i < 16; ++i) { const float fi = __shfl(inv, crow(i, h)); const int ro = ((i & 3) + 8 * (i >> 2)) * 64;
        sp[ro] = f2bf(o0[i] * fi); sp[ro + 32] = f2bf(o1[i] * fi); }
    o_flush(stg, Orow0, opitch, lane);
}


constexpr int KP = 208, VP = 272;
constexpr int KT_BYTES = 128 * KP, VT_BYTES = 64 * VP, TB_BYTES = KT_BYTES + VT_BYTES, MRG_OFF = 2 * TB_BYTES;
static_assert(MRG_OFF + 4 * 34 * 64 * 4 <= 131072, "MLA LDS map");
__device__ __forceinline__ void mla_unit_blk(const bf16_t* __restrict__ QC, const bf16_t* __restrict__ KC, const bf16_t* __restrict__ VTC, bf16_t* __restrict__ Y,
                                             int bh, int g, LAS unsigned char* lds, int tid) {
    const int lane = tid & 63, wave = __builtin_amdgcn_readfirstlane(tid >> 6), r = lane & 31, h = lane >> 5, w4 = wave & 3, kh = wave >> 2;
    const int pr = (r & ~12) | ((r & 8) >> 1) | ((r & 4) << 1);
    const int b = bh >> 2, hh = bh & 3, qb = 4 * g + w4, q = 32 * qb + r;
    const bf16_t* Qp = QC + ((size_t)b * SEQ + q) * 384 + hh * 96 + 8 * h;
    bf16x8 qf[6];
#pragma unroll
    for (int s = 0; s < 6; ++s) qf[s] = *(const bf16x8*)(Qp + 16 * s);
    const bf16_t* Kg = KC + (size_t)b * SEQ * 384 + hh * 96;
    const bf16_t* Vg = VTC + (size_t)(b * 4 + hh) * 64 * SEQ;
    unsigned dgo[6];
#pragma unroll
    for (int i = 0; i < 6; ++i) { const int n = wave + 8 * i; unsigned o = 0u;
        if (n < 26) { const int j = 64 * n + lane, row = j / 13; int cc = j - 13 * row; cc = cc == 12 ? 0 : cc; o = (unsigned)(row * 384 + 8 * cc) * 2u; }
        else if (n < 43) { const int j = 64 * (n - 26) + lane, d = j / 17; int cc = j - 17 * d; cc = cc == 16 ? 0 : cc; o = (unsigned)(d * SEQ + 8 * cc) * 2u; }
        dgo[i] = o; }
#define MLA_DMA(ST, BO) do { const char* kb_ = (const char*)(Kg + (size_t)(ST) * (128 * 384)); const char* vb_ = (const char*)(Vg + (ST) * 128); \
        _Pragma("unroll") for (int i = 0; i < 6; ++i) { const int n = wave + 8 * i; \
            if (n < 26) __builtin_amdgcn_global_load_lds((const unsigned*)(kb_ + dgo[i]), (LAS unsigned*)(lds + (BO) + n * 1024), 16, 0, 0); \
            else if (n < 43) __builtin_amdgcn_global_load_lds((const unsigned*)(vb_ + dgo[i]), (LAS unsigned*)(lds + (BO) + KT_BYTES + (n - 26) * 1024), 16, 0, 0); } } while (0)
#define MLA_DMA_WAIT() asm volatile("s_waitcnt vmcnt(0)" ::: "memory")
    f32x16 o0, o1;
#pragma unroll
    for (int i = 0; i < 16; ++i) { o0[i] = 0.f; o1[i] = 0.f; }
    float m = 0.f, l = 0.f; bool first = true;
    f32x16 negm;
#pragma unroll
    for (int i = 0; i < 16; ++i) negm[i] = 0.f;
    const int nST = g + 1;
    MLA_DMA(0, 0); MLA_DMA_WAIT();
    __syncthreads();
    const int kfo = (64 * kh + pr) * KP + 16 * h;
    const int vfo = KT_BYTES + r * VP + (64 * kh + 8 * h) * 2;
    for (int ST = 0; ST < nST; ++ST) {
        if (ST + 1 < nST) MLA_DMA(ST + 1, ((ST + 1) & 1) * TB_BYTES);
        const int kt0 = 4 * ST + 2 * kh;
        if (kt0 <= qb) {
            const LAS unsigned char* tb = lds + (ST & 1) * TB_BYTES;
            f32x16 p0, p1;
            { const bf16x8 k0 = *(const LAS bf16x8*)(tb + kfo), k1 = *(const LAS bf16x8*)(tb + kfo + 32 * KP); p0 = MFMA32(k0, qf[0], negm); p1 = MFMA32(k1, qf[0], negm); }
#pragma unroll
            for (int s = 1; s < 6; ++s) { const bf16x8 k0 = *(const LAS bf16x8*)(tb + kfo + 32 * s), k1 = *(const LAS bf16x8*)(tb + kfo + 32 * KP + 32 * s);
                p0 = MFMA32(k0, qf[s], p0); p1 = MFMA32(k1, qf[s], p1); }
            if (kt0 + 1 >= qb) {
                const int kb0 = 32 * kt0 + 8 * h;
#pragma unroll
                for (int i = 0; i < 16; ++i) { const int kv = kb0 + 16 * (i >> 3) + (i & 7); if (kv > q) p0[i] = -INFINITY; if (kv + 32 > q) p1[i] = -INFINITY; }
            }
            float ra_ = MX3(p0[0], p0[1], p1[0]), rb_ = MX3(p0[2], p0[3], p1[1]); ra_ = MX3(ra_, p1[2], p1[3]);
#pragma unroll
            for (int i = 4; i < 16; i += 4) { ra_ = MX3(ra_, p0[i], p0[i + 1]); rb_ = MX3(rb_, p0[i + 2], p0[i + 3]); ra_ = MX3(ra_, p1[i], p1[i + 1]); rb_ = MX3(rb_, p1[i + 2], p1[i + 3]); }
            const float rm = xh_max(fmaxf(ra_, rb_));
            if (first || __any(rm > 6.f)) {
                const float dl = first ? rm : fmaxf(rm, 0.f);
                m += dl;
#pragma unroll
                for (int i = 0; i < 16; ++i) { p0[i] -= dl; p1[i] -= dl; negm[i] = -m; }
                if (!first) { const float f = ex2(-dl); l *= f;
#pragma unroll
                    for (int i = 0; i < 16; ++i) { const float fi = __shfl(f, crow(i, h)); o0[i] *= fi; o1[i] *= fi; } }
                first = false;
            }
            float ls = 0.f;
#pragma unroll
            for (int i = 0; i < 16; ++i) { p0[i] = ex2(p0[i]); p1[i] = ex2(p1[i]); ls += p0[i] + p1[i]; }
            l += ls;
            float e[8];
#pragma unroll
            for (int ks = 0; ks < 4; ++ks) {
#pragma unroll
                for (int j = 0; j < 8; ++j) e[j] = (ks < 2) ? p0[8 * ks + j] : p1[8 * (ks - 2) + j];
                const bf16x8 pa = pack8(e);
                const bf16x8 v0 = *(const LAS bf16x8*)(tb + vfo + 32 * ks), v1 = *(const LAS bf16x8*)(tb + vfo + 32 * VP + 32 * ks);
                o0 = MFMA32(pa, v0, o0); o1 = MFMA32(pa, v1, o1);
            }
        }
        MLA_DMA_WAIT();
        __syncthreads();
    }
#undef MLA_DMA
#undef MLA_DMA_WAIT
    if (first) m = -1e30f;
    l = xh_sum(l);
    LAS float* mg = (LAS float*)(lds + MRG_OFF) + w4 * (34 * 64) + lane;
    if (kh == 1) {
#pragma unroll
        for (int i = 0; i < 16; ++i) { mg[i * 64] = o0[i]; mg[(16 + i) * 64] = o1[i]; }
        mg[32 * 64] = m; mg[33 * 64] = l;
    }
    __syncthreads();
    if (kh == 0) {
        const float mb = mg[32 * 64], lb = mg[33 * 64];
        const float mn = fmaxf(m, mb), fa = ex2(m - mn), fb = ex2(mb - mn), inv = 1.f / (l * fa + lb * fb), ga = fa * inv, gb = fb * inv;
        LAS bf16_t* stg = (LAS bf16_t*)(lds + wave * 4096);
        LAS bf16_t* sp = stg + (4 * h) * 64 + r;
#pragma unroll
        for (int i = 0; i < 16; ++i) { const float ra = __shfl(ga, crow(i, h)), rb = __shfl(gb, crow(i, h)); const int ro = ((i & 3) + 8 * (i >> 2)) * 64;
            sp[ro] = f2bf(o0[i] * ra + mg[i * 64] * rb); sp[ro + 32] = f2bf(o1[i] * ra + mg[(16 + i) * 64] * rb); }
        o_flush(stg, Y + ((size_t)b * SEQ + 32 * qb) * DM + 512 + hh * 64, DM, lane);
    }
    __syncthreads();
}

__device__ __forceinline__ void sb_unit(const bf16_t* __restrict__ Qrow0, int qpitch, const bf16_t* __restrict__ Kb, int kpitch, const bf16_t* __restrict__ VT,
                                        int qb, bf16_t* __restrict__ Orow0, int opitch, int lane, LAS bf16_t* stg) {
    const int r = lane & 31, h = lane >> 5;
    const int pr = (r & ~12) | ((r & 8) >> 1) | ((r & 4) << 1);
    bf16x8 qf[4];
#pragma unroll
    for (int s = 0; s < 4; ++s) qf[s] = *(const bf16x8*)(Qrow0 + (size_t)r * qpitch + 16 * s + 8 * h);
    f32x16 o0, o1;
#pragma unroll
    for (int i = 0; i < 16; ++i) { o0[i] = 0.f; o1[i] = 0.f; }
    float carry = 0.f;
    const int q = 32 * qb + r;
    const bf16_t* kp = Kb + (size_t)(32 * qb + pr) * kpitch + 8 * h;
    const bf16_t* vp = VT + (size_t)r * SEQ + 32 * qb + 8 * h;
    bf16x8 kf[4];
#pragma unroll
    for (int s = 0; s < 4; ++s) kf[s] = *(const bf16x8*)(kp + 16 * s);
    for (int kt = qb; kt >= 0; --kt) {
        bf16x8 kn[4];
        if (kt > 0) {
#pragma unroll
            for (int s = 0; s < 4; ++s) kn[s] = *(const bf16x8*)(kp - (size_t)32 * kpitch + 16 * s);
        } else {
#pragma unroll
            for (int s = 0; s < 4; ++s) kn[s] = kf[s];
        }
        const bf16x8 v00 = *(const bf16x8*)(vp), v01 = *(const bf16x8*)(vp + 32 * SEQ), v10 = *(const bf16x8*)(vp + 16), v11 = *(const bf16x8*)(vp + 32 * SEQ + 16);
        f32x16 p;
#pragma unroll
        for (int i = 0; i < 16; ++i) p[i] = 0.f;
#pragma unroll
        for (int s = 0; s < 4; ++s) p = MFMA32(kf[s], qf[s], p);
        const bool diag = (kt == qb);
        const int k0 = 32 * kt + 8 * h;
        float sfx[16];
#pragma unroll
        for (int i = 0; i < 16; ++i) {
            const float z = p[i];
            float L = -(fmaxf(z, 0.f) + lg2(1.f + ex2(-fabsf(z))));
            if (diag) { const int kv = k0 + 16 * (i >> 3) + (i & 7); if (!(kv < q)) L = 0.f; }
            sfx[i] = L;
        }
#pragma unroll
        for (int g = 0; g < 2; ++g)
#pragma unroll
            for (int j = 6; j >= 0; --j) sfx[8 * g + j] += sfx[8 * g + j + 1];
        const float T0 = sfx[0], T1 = sfx[8];
        const float TP0 = __shfl_xor(T0, 32), TP1 = __shfl_xor(T1, 32);
        const float off1 = (h ? 0.f : TP1) + carry, off0 = T1 + TP1 + (h ? 0.f : TP0) + carry;
        float e[16];
#pragma unroll
        for (int i = 0; i < 16; ++i) {
            float a = ex2(p[i] + sfx[i] + (i < 8 ? off0 : off1));
            if (diag) { const int kv = k0 + 16 * (i >> 3) + (i & 7); if (!(kv < q)) a = 0.f; }
            e[i] = a;
        }
        carry += (T0 + T1) + (TP0 + TP1);
        const bf16x8 pa0 = pack8(e), pa1 = pack8(e + 8);
        o0 = MFMA32(pa0, v00, o0); o1 = MFMA32(pa0, v01, o1);
        o0 = MFMA32(pa1, v10, o0); o1 = MFMA32(pa1, v11, o1);
        if (__all(carry < -150.f)) break;
#pragma unroll
        for (int s = 0; s < 4; ++s) kf[s] = kn[s];
        kp -= (size_t)32 * kpitch; vp -= 32;
    }
    LAS bf16_t* sp = stg + (4 * h) * 64 + r;
#pragma unroll
    for (int i = 0; i < 16; ++i) { const int ro = ((i & 3) + 8 * (i >> 2)) * 64; sp[ro] = f2bf(o0[i]); sp[ro + 32] = f2bf(o1[i]); }
    o_flush(stg, Orow0, opitch, lane);
}


constexpr int AKP = 144;
constexpr int SWA_NK = 384, SWA_VP = SWA_NK * 2 + 16, SWA_KB = SWA_NK * AKP;
constexpr int SB_NK = 448, SB_VP = SB_NK * 2 + 16, SB_KB = SB_NK * AKP;
constexpr int STG_OFF = 122880, MISC_OFF = STG_OFF + 8 * 4096;
static_assert(SWA_KB + 64 * SWA_VP <= STG_OFF && SB_KB + 64 * SB_VP <= STG_OFF && MISC_OFF + 1024 == LDS_BYTES, "window LDS map");
template <int NK, int VPB>
__device__ __forceinline__ void stage_kv64(const bf16_t* __restrict__ Kb, int kpitch, const bf16_t* __restrict__ VT, int key0, LAS unsigned char* lds, int tid) {
    constexpr int NCH = NK * 8 / 512, VC = NK / 8;
    u32x4 kr[NCH], vr[NCH];
#pragma unroll
    for (int i = 0; i < NCH; ++i) { const int c = tid + 512 * i, row = c >> 3, cc = c & 7; int key = key0 + row; key = key < 0 ? 0 : key;
        kr[i] = *(const u32x4*)(Kb + (size_t)key * kpitch + 8 * cc); }
#pragma unroll
    for (int i = 0; i < NCH; ++i) { const int c = tid + 512 * i, d = c / VC, cc = c - d * VC; int key = key0 + 8 * cc; key = key < 0 ? 0 : key;
        vr[i] = *(const u32x4*)(VT + (size_t)d * SEQ + key); }
#pragma unroll
    for (int i = 0; i < NCH; ++i) { const int c = tid + 512 * i, row = c >> 3, cc = c & 7; *(LAS u32x4*)(lds + row * AKP + 16 * cc) = kr[i]; }
#pragma unroll
    for (int i = 0; i < NCH; ++i) { const int c = tid + 512 * i, d = c / VC, cc = c - d * VC; *(LAS u32x4*)(lds + NK * AKP + d * VPB + 16 * cc) = vr[i]; }
}
template <int NK, int VPB>
__device__ __forceinline__ void stage_kv64_T(const bf16_t* __restrict__ Kb, int kpitch, const bf16_t* __restrict__ Vb, int vpitch, int key0, LAS unsigned char* lds, int tid) {
    constexpr int NCH = NK * 8 / 512, NB = NK / 32;
    const int lane = tid & 63, wave = __builtin_amdgcn_readfirstlane(tid >> 6), r = lane & 31, h = lane >> 5;
    u32x4 kr[NCH]; bf16x8 vv[2][4];
#pragma unroll
    for (int i = 0; i < NCH; ++i) { const int c = tid + 512 * i, row = c >> 3, cc = c & 7; int key = key0 + row; key = key < 0 ? 0 : key;
        kr[i] = *(const u32x4*)(Kb + (size_t)key * kpitch + 8 * cc); }
#pragma unroll
    for (int t = 0; t < 2; ++t) { const int tbk = wave + 8 * t; if (tbk < NB) { int key = key0 + 32 * tbk + r; key = key < 0 ? 0 : key;
#pragma unroll
        for (int c = 0; c < 4; ++c) vv[t][c] = *(const bf16x8*)(Vb + (size_t)key * vpitch + 32 * h + 8 * c); } }
#pragma unroll
    for (int i = 0; i < NCH; ++i) { const int c = tid + 512 * i, row = c >> 3, cc = c & 7; *(LAS u32x4*)(lds + row * AKP + 16 * cc) = kr[i]; }
#pragma unroll
    for (int t = 0; t < 2; ++t) { const int tbk = wave + 8 * t; if (tbk < NB) { LAS bf16_t* sp = (LAS bf16_t*)(lds + NK * AKP + (32 * h) * VPB) + 32 * tbk + r;
#pragma unroll
        for (int c = 0; c < 4; ++c)
#pragma unroll
            for (int j = 0; j < 8; ++j) sp[(8 * c + j) * (VPB / 2)] = (bf16_t)vv[t][c][j]; } }
}
__device__ __forceinline__ void swa_wave_lds(const bf16_t* __restrict__ Qrow0, int qpitch, const LAS unsigned char* lds, int qb, int kt_base, float sink2,
                                             bf16_t* __restrict__ Orow0, int opitch, int lane, LAS bf16_t* stg) {
    const int r = lane & 31, h = lane >> 5;
    const int pr = (r & ~12) | ((r & 8) >> 1) | ((r & 4) << 1);
    bf16x8 qf[4];
#pragma unroll
    for (int s = 0; s < 4; ++s) qf[s] = *(const bf16x8*)(Qrow0 + (size_t)r * qpitch + 16 * s + 8 * h);
    f32x16 o0, o1;
#pragma unroll
    for (int i = 0; i < 16; ++i) { o0[i] = 0.f; o1[i] = 0.f; }
    float m = -1e30f, l = 0.f;
    const int q = 32 * qb + r, kt_begin = qb - 4 > 0 ? qb - 4 : 0;
    for (int kt = kt_begin; kt <= qb; ++kt) {
        const int rel = kt - kt_base;
        const LAS unsigned char* kp = lds + (32 * rel + pr) * AKP + 16 * h;
        const LAS unsigned char* vp = lds + SWA_KB + r * SWA_VP + (32 * rel + 8 * h) * 2;
        f32x16 p;
#pragma unroll
        for (int i = 0; i < 16; ++i) p[i] = 0.f;
#pragma unroll
        for (int s = 0; s < 4; ++s) p = MFMA32(*(const LAS bf16x8*)(kp + 32 * s), qf[s], p);
        if (kt == qb || kt == qb - 4) {
            const int k0 = 32 * kt + 8 * h;
#pragma unroll
            for (int i = 0; i < 16; ++i) { const int kv = k0 + 16 * (i >> 3) + (i & 7); const bool ok = (kv <= q) && (kv > q - 128); if (!ok) p[i] = -INFINITY; }
        }
        float rm = MX3(p[0], p[1], p[2]);
#pragma unroll
        for (int i = 3; i < 15; i += 2) rm = MX3(rm, p[i], p[i + 1]);
        rm = xh_max(fmaxf(rm, p[15]));
        if (__any(rm > m + 6.f)) {
            const float mn = fmaxf(m, rm), f = ex2(m - mn); m = mn; l *= f;
#pragma unroll
            for (int i = 0; i < 16; ++i) { const float fi = __shfl(f, crow(i, h)); o0[i] *= fi; o1[i] *= fi; }
        }
        float e[16];
#pragma unroll
        for (int i = 0; i < 16; ++i) { e[i] = ex2(p[i] - m); l += e[i]; }
        const bf16x8 pa0 = pack8(e), pa1 = pack8(e + 8);
        o0 = MFMA32(pa0, *(const LAS bf16x8*)(vp), o0); o1 = MFMA32(pa0, *(const LAS bf16x8*)(vp + 32 * SWA_VP), o1);
        o0 = MFMA32(pa1, *(const LAS bf16x8*)(vp + 32), o0); o1 = MFMA32(pa1, *(const LAS bf16x8*)(vp + 32 * SWA_VP + 32), o1);
    }
    l = xh_sum(l);
    l += ex2(sink2 - m);
    const float inv = 1.f / l;
    LAS bf16_t* sp = stg + (4 * h) * 64 + r;
#pragma unroll
    for (int i = 0; i < 16; ++i) { const float fi = __shfl(inv, crow(i, h)); const int ro = ((i & 3) + 8 * (i >> 2)) * 64;
        sp[ro] = f2bf(o0[i] * fi); sp[ro + 32] = f2bf(o1[i] * fi); }
    o_flush(stg, Orow0, opitch, lane);
}
#define SB_STEP(KT_, V00_, V01_, V10_, V11_) do { \
        const bool diag = ((KT_) == qb); const int k0 = 32 * (KT_) + 8 * h; float sfx[16]; \
        _Pragma("unroll") for (int i = 0; i < 16; ++i) { const float z = p[i]; float L = -(fmaxf(z, 0.f) + lg2(1.f + ex2(-fabsf(z)))); \
            if (diag) { const int kv = k0 + 16 * (i >> 3) + (i & 7); if (!(kv < q)) L = 0.f; } sfx[i] = L; } \
        _Pragma("unroll") for (int g = 0; g < 2; ++g) _Pragma("unroll") for (int j = 6; j >= 0; --j) sfx[8 * g + j] += sfx[8 * g + j + 1]; \
        const float T0 = sfx[0], T1 = sfx[8]; const float TP0 = xh_other(T0, h), TP1 = xh_other(T1, h); \
        const float off1 = (h ? 0.f : TP1) + carry, off0 = T1 + TP1 + (h ? 0.f : TP0) + carry; float e[16]; \
        _Pragma("unroll") for (int i = 0; i < 16; ++i) { float a = ex2(p[i] + sfx[i] + (i < 8 ? off0 : off1)); \
            if (diag) { const int kv = k0 + 16 * (i >> 3) + (i & 7); if (!(kv < q)) a = 0.f; } e[i] = a; } \
        carry += (T0 + T1) + (TP0 + TP1); \
        const bf16x8 pa0 = pack8(e), pa1 = pack8(e + 8); \
        o0 = MFMA32(pa0, (V00_), o0); o1 = MFMA32(pa0, (V01_), o1); o0 = MFMA32(pa1, (V10_), o0); o1 = MFMA32(pa1, (V11_), o1); } while (0)
__device__ __forceinline__ void sb_wave_lds(const bf16_t* __restrict__ Qrow0, int qpitch, const LAS unsigned char* lds, const bf16_t* __restrict__ Kb, int kpitch,
                                            const bf16_t* __restrict__ Vb, int vpitch, int qb, int kt_base, bf16_t* __restrict__ Orow0, int opitch, int lane, LAS bf16_t* stg) {
    const int r = lane & 31, h = lane >> 5;
    const int pr = (r & ~12) | ((r & 8) >> 1) | ((r & 4) << 1);
    bf16x8 qf[4];
#pragma unroll
    for (int s = 0; s < 4; ++s) qf[s] = *(const bf16x8*)(Qrow0 + (size_t)r * qpitch + 16 * s + 8 * h);
    f32x16 o0, o1;
#pragma unroll
    for (int i = 0; i < 16; ++i) { o0[i] = 0.f; o1[i] = 0.f; }
    float carry = 0.f;
    const int q = 32 * qb + r;
    const int kt_lo = kt_base > 0 ? kt_base : 0;
    bool done = false;
    int kt = qb;
    for (; kt >= kt_lo; --kt) {
        const int rel = kt - kt_base;
        const LAS unsigned char* kp = lds + (32 * rel + pr) * AKP + 16 * h;
        const LAS unsigned char* vp = lds + SB_KB + r * SB_VP + (32 * rel + 8 * h) * 2;
        f32x16 p;
#pragma unroll
        for (int i = 0; i < 16; ++i) p[i] = 0.f;
#pragma unroll
        for (int s = 0; s < 4; ++s) p = MFMA32(*(const LAS bf16x8*)(kp + 32 * s), qf[s], p);
        SB_STEP(kt, *(const LAS bf16x8*)(vp), *(const LAS bf16x8*)(vp + 32 * SB_VP), *(const LAS bf16x8*)(vp + 32), *(const LAS bf16x8*)(vp + 32 * SB_VP + 32));
        if (__all(carry < -150.f)) { done = true; break; }
    }
    if (!done && kt >= 0) {
        const bf16_t* kp = Kb + (size_t)(32 * kt + pr) * kpitch + 8 * h;
        for (; kt >= 0; --kt) {
            bf16x8 kf[4];
#pragma unroll
            for (int s = 0; s < 4; ++s) kf[s] = *(const bf16x8*)(kp + 16 * s);
            bf16x8 v00, v01, v10, v11;
            { const bf16_t* vg = Vb + (size_t)(32 * kt + 8 * h) * vpitch + r;
#pragma unroll
              for (int j = 0; j < 8; ++j) { v00[j] = (short)vg[(size_t)j * vpitch]; v01[j] = (short)vg[(size_t)j * vpitch + 32]; v10[j] = (short)vg[(size_t)(16 + j) * vpitch]; v11[j] = (short)vg[(size_t)(16 + j) * vpitch + 32]; } }
            f32x16 p;
#pragma unroll
            for (int i = 0; i < 16; ++i) p[i] = 0.f;
#pragma unroll
            for (int s = 0; s < 4; ++s) p = MFMA32(kf[s], qf[s], p);
            SB_STEP(kt, v00, v01, v10, v11);
            if (__all(carry < -150.f)) break;
            kp -= (size_t)32 * kpitch;
        }
    }
    LAS bf16_t* sp = stg + (4 * h) * 64 + r;
#pragma unroll
    for (int i = 0; i < 16; ++i) { const int ro = ((i & 3) + 8 * (i >> 2)) * 64; sp[ro] = f2bf(o0[i]); sp[ro + 32] = f2bf(o1[i]); }
    o_flush(stg, Orow0, opitch, lane);
}
#undef SB_STEP

#define XB_TMO      128
#define XB_XCNT(j)  (256  + 64 * (j))
#define XB_XSUB(j)  (1280 + 64 * (j))
#define XB_XGEN(j)  (2304 + 64 * (j))
#define XB_TOP      3328
#define XB_TOPGEN   3392
#define XCD_BAR_WORDS 3456
#define XB_SPIN_CAP (1u << 18)

__device__ __forceinline__ unsigned xb_ld(unsigned* p)              { return __hip_atomic_load(p, __ATOMIC_RELAXED, __HIP_MEMORY_SCOPE_AGENT); }
__device__ __forceinline__ unsigned xb_add(unsigned* p, unsigned v) { return __hip_atomic_fetch_add(p, v, __ATOMIC_RELAXED, __HIP_MEMORY_SCOPE_AGENT); }
__device__ __forceinline__ unsigned xb_xcc_id() { return (unsigned)__builtin_amdgcn_s_getreg((3 << 11) | 20) & 0xFu; }
#define XB_SPIN(cond, bar) do { unsigned _sp = 0; while (cond) { __builtin_amdgcn_s_sleep(1); \
    if ((++_sp & 255u) == 0u) { if (xb_ld(&(bar)[XB_TMO])) break; if (_sp > XB_SPIN_CAP) { atomicAdd(&(bar)[XB_TMO], 1u); break; } } } } while (0)

struct XcdBarrier {
    unsigned* bar; unsigned x;
    volatile LAS unsigned* st;
};

__device__ __forceinline__ XcdBarrier xcd_barrier_post(unsigned* bar, volatile LAS unsigned* st) {
    XcdBarrier b; b.bar = bar; b.x = xb_xcc_id(); b.st = st;
    if (threadIdx.x == 0) (void)xb_add(&bar[XB_XCNT(b.x)], 1u);
    return b;
}
__device__ __forceinline__ void xcd_barrier_complete(unsigned* bar, unsigned x, unsigned& nloc, unsigned& nx) {
    const unsigned G = gridDim.x * gridDim.y * gridDim.z;
    unsigned sum, cnt, mine, sp = 0u;
    for (;;) {
        sum = 0u; cnt = 0u; mine = 0u;
#pragma unroll
        for (unsigned j = 0; j < 16; ++j) { const unsigned c = xb_ld(&bar[XB_XCNT(j)]); sum += c; cnt += (c > 0u) ? 1u : 0u; mine = (j == x) ? c : mine; }
        if (sum == G) break;
        __builtin_amdgcn_s_sleep(1);
        if ((++sp & 255u) == 0u) { if (xb_ld(&bar[XB_TMO])) break; if (sp > XB_SPIN_CAP) { atomicAdd(&bar[XB_TMO], 1u); break; } }
    }
    nloc = mine > 0u ? mine : 1u; nx = cnt > 0u ? cnt : 1u;
}

__device__ __forceinline__ void xcd_barrier(const XcdBarrier& b) {
    asm volatile("s_waitcnt vmcnt(0)" ::: "memory");
    __syncthreads();
    if (threadIdx.x == 0) {
        unsigned* bar = b.bar;
        __builtin_amdgcn_s_waitcnt(0);
        unsigned nloc = b.st[0], nx = b.st[1];
        if (nloc == 0u) { xcd_barrier_complete(bar, b.x, nloc, nx); b.st[0] = nloc; b.st[1] = nx; }
        const unsigned old = xb_add(&bar[XB_XSUB(b.x)], 1u);
        const unsigned gen = old / nloc;
        if (old + 1u == (gen + 1u) * nloc) {
            __builtin_amdgcn_fence(__ATOMIC_RELEASE, "agent");
            asm volatile("s_waitcnt vmcnt(0)" ::: "memory");
            const unsigned og = xb_add(&bar[XB_TOP], 1u);
            const unsigned tg = og / nx;
            if (og + 1u == (tg + 1u) * nx) xb_add(&bar[XB_TOPGEN], 1u);
            else XB_SPIN(xb_ld(&bar[XB_TOPGEN]) == tg, bar);
            __builtin_amdgcn_fence(__ATOMIC_ACQUIRE, "agent");
            xb_add(&bar[XB_XGEN(b.x)], 1u);
            asm volatile("s_waitcnt vmcnt(0)" ::: "memory");
        } else {
            XB_SPIN(xb_ld(&bar[XB_XGEN(b.x)]) == gen, bar);
            __builtin_amdgcn_fence(__ATOMIC_ACQUIRE, "agent");
            asm volatile("s_waitcnt vmcnt(0)" ::: "memory");
        }
    }
    __syncthreads();
}

__global__ void __launch_bounds__(NTHREADS, 2) fwd(Params P) {
    extern __shared__ __attribute__((aligned(16))) unsigned char lds_raw[];
    LAS unsigned char* lds = (LAS unsigned char*)lds_raw;
    constexpr int G = 256, NGW = G * NWAVES, gthreads = G * NTHREADS;
    const int bx = blockIdx.x;
#if MK_COOP
    cooperative_groups::grid_group grid = cooperative_groups::this_grid();
    volatile LAS unsigned* MISC = (volatile LAS unsigned*)(lds + MISC_OFF);
    if (threadIdx.x < 64) MISC[threadIdx.x] = 0u;
    __syncthreads();
    XcdBarrier bar = xcd_barrier_post((unsigned*)(P.ws + WS_CTL) + CW_BAR, MISC + 8);
#endif
    for (int ph = P.ph_lo; ph < P.ph_hi; ++ph) {
        const int nrep = ((ph >= 1 && ph <= 6 && ((ph - 1) == MK_REP_K || (MK_REP_K == 6 && ph == 3))) || (ph == 0 && MK_REP_K == 7)) ? MK_REP_N : 1;
        for (int rep = 0; rep < nrep; ++rep) {
        int tid_o = threadIdx.x; asm volatile("" : "+v"(tid_o));
        const int tid = tid_o, lane = tid & 63, wave = __builtin_amdgcn_readfirstlane(tid >> 6);
        const int gw = bx * NWAVES + wave, gtid = bx * NTHREADS + tid;
        LAS bf16_t* stg = (LAS bf16_t*)(lds + 122880 + wave * 4096);
        unsigned char* ws = P.ws; asm volatile("" : "+s"(ws));
        unsigned* ctl = (unsigned*)(ws + WS_CTL);
        bf16_t* XN = (bf16_t*)(ws + WS_XN); bf16_t* H = (bf16_t*)(ws + WS_H);
        bf16_t* QC = (bf16_t*)(ws + WS_QC); bf16_t* KC = (bf16_t*)(ws + WS_KC);
        bf16_t* VTC = (bf16_t*)(ws + WS_VTC); bf16_t* VTA = (bf16_t*)(ws + WS_VTA); bf16_t* VTD = (bf16_t*)(ws + WS_VTD);
        bf16_t* Y = (bf16_t*)(ws + WS_Y);
        if (ph == 0) {
            {
                LAS float* scr = (LAS float*)(lds + wave * 16384);
                constexpr int I_IN = (DM / 64) * (DIN / 32), I_OUT = (DM / 64) * (DM / 32), I_UQ = (256 / 64) * (384 / 32), I_UKV = (128 / 64) * (512 / 32), I_L = I_IN + I_OUT + I_UQ + I_UKV;
                for (int it = gw; it < NLAYER * I_L; it += NGW) {
                    const int l = it / I_L; int v = it - l * I_L;
                    if (v < I_IN) { wT_item(P.w_in + (size_t)l * DM * DIN, DM, DIN, P.norm_pre + l * DM, (bf16_t*)(ws + WS_WIN) + (size_t)l * DINP * DM, C_AQ, C_AQ + 256, C_DQ, C_DQ + 256, SC64, scr, v, lane); continue; } v -= I_IN;
                    if (v < I_OUT) { wT_item(P.w_out + (size_t)l * DM * DM, DM, DM, P.g_grp + l * DM, (bf16_t*)(ws + WS_WOUT) + (size_t)l * DM * DM, 0, 0, 0, 0, 1.f, scr, v, lane); continue; } v -= I_OUT;
                    if (v < I_UQ) { wT_item(P.w_uq + (size_t)l * 256 * 384, 256, 384, P.g_cq + l * 256, (bf16_t*)(ws + WS_WUQ + (size_t)l * 262144), 0, 0, 0, 0, 1.f, scr, v, lane); continue; } v -= I_UQ;
                    wT_item(P.w_ukv + (size_t)l * 128 * 512, 128, 512, P.g_ckv + l * 128, (bf16_t*)(ws + WS_WUKV + (size_t)l * 131072), 0, 0, 0, 0, 1.f, scr, v, lane);
                }
                for (int it = gtid; it < NLAYER * (DINP - DIN) * (DM / 8); it += gthreads) { const int l = it / ((DINP - DIN) * (DM / 8)), v = it - l * ((DINP - DIN) * (DM / 8));
                    *(u32x4*)((bf16_t*)(ws + WS_WIN) + (size_t)l * DINP * DM + (size_t)DIN * DM + (size_t)v * 8) = (u32x4){0u, 0u, 0u, 0u}; }
            }
            { const float* __restrict__ xr = P.x; bf16_t* __restrict__ xo = XN;
#pragma unroll 2
              for (int mrow = gw; mrow < M_TOK; mrow += NGW) rms_row_to_bf16(xr + (size_t)mrow * DM, xo + (size_t)mrow * DM, lane); }
        } else {
            const int l = (ph - 1) / 6, k = (ph - 1) % 6;
            if (k == 0 || k == 4) {
                if (k == 0) {
                    pg8::Gemm g{XN, (const bf16_t*)(ws + WS_WIN) + (size_t)l * DINP * DM, M_TOK, DINP, DM}; pg8::StaticOrder S; S.init(M_TOK, DINP, G, bx);
                    pg8::EpiBf16<0> E{H, DINP, nullptr, 0, 0, 1.f};
                    pg8::gemm_phase<pg8::EpiBf16<0>, pg8::StaticOrder, true, true>(lds, g, S, E);
                } else {
                    pg8::Gemm g{XN, (const bf16_t*)(ws + WS_WOUT) + (size_t)l * DM * DM, M_TOK, DM, DM}; pg8::StaticOrder S; S.init(M_TOK, DM, G, bx);
                    pg8::EpiBf16<0> E{Y, DM, nullptr, 0, 0, 1.f};
                    pg8::gemm_phase<pg8::EpiBf16<0>, pg8::StaticOrder, true, true>(lds, g, S, E);
                }
            } else if (k == 1) {
                const bf16_t* WUQ = (const bf16_t*)(ws + WS_WUQ + (size_t)l * 262144);
                const bf16_t* WUKV = (const bf16_t*)(ws + WS_WUKV + (size_t)l * 131072);
                {
                    const int hh = bx & 3, tg = bx >> 2;
                    u32x4 wq[6], wk[4];
#pragma unroll
                    for (int i = 0; i < 6; ++i) { const int c = tid + 512 * i, row = c >> 5, cc = c & 31; wq[i] = *(const u32x4*)(WUQ + (size_t)(hh * 96 + row) * 256 + 8 * cc); }
#pragma unroll
                    for (int i = 0; i < 4; ++i) { const int c = tid + 512 * i, row = c >> 4, cc = c & 15; wk[i] = *(const u32x4*)(WUKV + (size_t)(hh * 128 + row) * 128 + 8 * cc); }
#pragma unroll
                    for (int i = 0; i < 6; ++i) { const int c = tid + 512 * i, row = c >> 5, cc = c & 31; *(LAS u32x4*)(lds + row * WQP + 16 * cc) = wq[i]; }
#pragma unroll
                    for (int i = 0; i < 4; ++i) { const int c = tid + 512 * i, row = c >> 4, cc = c & 15; *(LAS u32x4*)(lds + WQ_BYTES + row * WKP + 16 * cc) = wk[i]; }
                    __syncthreads();
                    const int tb = 8 * tg + wave;
                    mq_unit(H, lds, P.pos, QC, tb, hh, lane);
                    mkv_unit(H, lds + WQ_BYTES, P.pos, KC, VTC, tb, hh, lane, stg);
                }
                constexpr int NTB = M_TOK / 32;
                constexpr int U_ALL = M_TOK / 8;
                for (int u = gw; u < U_ALL; u += NGW) {
                    const int v = u;
                    conv_unit(H, P.conv_w + l * 768, P.conv_b + l * 256, Y, v, lane);
                }
            } else if (k == 2) {
                if (rep == 0 || MK_REP_K == 2)
                for (int pu = bx; pu < 256; pu += G) {
                    const int bh = pu & 7, Gq = pu >> 3;
                    mla_unit_blk(QC, KC, VTC, Y, bh, 63 - Gq, lds, tid);
                    mla_unit_blk(QC, KC, VTC, Y, bh, Gq, lds, tid);
                }
                if (rep == 0 || MK_REP_K == 6) {
                    const int bh = bx & 7, G8 = bx >> 3, b = bh >> 2, hh = bh & 3, qb = 8 * G8 + wave;
                    const size_t row0 = (size_t)b * SEQ + 32 * qb;
                    LAS bf16_t* ostg = (LAS bf16_t*)(lds + STG_OFF + wave * 4096);
                    {
                        const int kvh = hh >> 1;
                        const bf16_t* Kb = H + (size_t)b * SEQ * DINP + C_AK + kvh * 64;
                        stage_kv64_T<SWA_NK, SWA_VP>(Kb, DINP, H + (size_t)b * SEQ * DINP + C_AV + kvh * 64, DINP, 256 * G8 - 128, lds, tid);
                        __syncthreads();
                        swa_wave_lds(H + row0 * DINP + C_AQ + hh * 64, DINP, lds, qb, 8 * G8 - 4, P.sinks[l * 4 + hh] * LOG2E, Y + row0 * DM + hh * 64, DM, lane, ostg);
                        __syncthreads();
                    }
                    {
                        const bf16_t* Kb = H + (size_t)b * SEQ * DINP + C_DK + hh * 64;
                        const bf16_t* Vb = H + (size_t)b * SEQ * DINP + C_DV + hh * 64;
                        stage_kv64_T<SB_NK, SB_VP>(Kb, DINP, Vb, DINP, 256 * G8 - 192, lds, tid);
                        __syncthreads();
                        sb_wave_lds(H + row0 * DINP + C_DQ + hh * 64, DINP, lds, Kb, DINP, Vb, DINP, qb, 8 * G8 - 6, Y + row0 * DM + 768 + hh * 64, DM, lane, ostg);
                        __syncthreads();
                    }
                }
            } else if (k == 3) {
                const bf16_t* __restrict__ Yr = Y; const bf16_t* __restrict__ Hr = H; bf16_t* __restrict__ XNw = XN;
#pragma unroll 2
                for (int mrow = gw; mrow < M_TOK; mrow += NGW) {
                    const u32x4* yp = (const u32x4*)(Yr + (size_t)mrow * DM) + 2 * lane;
                    const u32x4* gp = (const u32x4*)(Hr + (size_t)mrow * DINP + C_GATE) + 2 * lane;
                    const u32x4 y0 = yp[0], y1 = yp[1], g0 = gp[0], g1 = gp[1];
                    float yv[16], gv[16];
#pragma unroll
                    for (int j = 0; j < 4; ++j) { yv[2 * j] = bflo(y0[j]); yv[2 * j + 1] = bfhi(y0[j]); yv[8 + 2 * j] = bflo(y1[j]); yv[8 + 2 * j + 1] = bfhi(y1[j]);
                                                  gv[2 * j] = bflo(g0[j]); gv[2 * j + 1] = bfhi(g0[j]); gv[8 + 2 * j] = bflo(g1[j]); gv[8 + 2 * j + 1] = bfhi(g1[j]); }
                    float ss = 0.f;
#pragma unroll
                    for (int j = 0; j < 16; ++j) ss += yv[j] * yv[j];
                    ss += __shfl_xor(ss, 1); ss += __shfl_xor(ss, 2); ss += __shfl_xor(ss, 4); ss += __shfl_xor(ss, 8);
                    const float rs = rsqrtf(ss * (1.f / 256.f) + EPS);
                    float o[16];
#pragma unroll
                    for (int j = 0; j < 16; ++j) { const float gg = gv[j]; o[j] = yv[j] * rs * gg * __builtin_amdgcn_rcpf(1.f + ex2(-gg * LOG2E)); }
                    u32x4 w0, w1;
#pragma unroll
                    for (int j = 0; j < 4; ++j) { w0[j] = pk2(o[2 * j], o[2 * j + 1]); w1[j] = pk2(o[8 + 2 * j], o[8 + 2 * j + 1]); }
                    u32x4* op = (u32x4*)(XNw + (size_t)mrow * DM) + 2 * lane;
                    op[0] = w0; op[1] = w1;
                }
            } else {
                const float* base = P.x;
                const float* gpost = P.g_post + l * DM;
                for (int mrow0 = gw; mrow0 < M_TOK; mrow0 += 2 * NGW) {
                    f32x4 zz[2][4], xv[2][4]; float s1[2] = {0.f, 0.f}, s2[2] = {0.f, 0.f};
                    const bool two = (mrow0 + NGW < M_TOK);
#pragma unroll
                    for (int rr = 0; rr < 2; ++rr) { const int mrow = (rr == 0 || two) ? mrow0 + rr * NGW : mrow0;
#pragma unroll
                        for (int j = 0; j < 4; ++j) { const u32x2 w = __builtin_nontemporal_load((const u32x2*)(Y + (size_t)mrow * DM) + lane + 64 * j); zz[rr][j] = (f32x4){bflo(w.x), bfhi(w.x), bflo(w.y), bfhi(w.y)};
                            if (l == 0) xv[rr][j] = __builtin_nontemporal_load((const f32x4*)(base + (size_t)mrow * DM) + lane + 64 * j);
                            else { const u32x2 xb = __builtin_nontemporal_load((const u32x2*)(P.out + (size_t)mrow * DM) + lane + 64 * j); xv[rr][j] = (f32x4){bflo(xb.x), bfhi(xb.x), bflo(xb.y), bfhi(xb.y)}; } } }
                    f32x4 gpv[4];
#pragma unroll
                    for (int j = 0; j < 4; ++j) gpv[j] = ((const f32x4*)gpost)[lane + 64 * j];
#pragma unroll
                    for (int rr = 0; rr < 2; ++rr)
#pragma unroll
                        for (int j = 0; j < 4; ++j) s1[rr] += (zz[rr][j].x * zz[rr][j].x + zz[rr][j].y * zz[rr][j].y) + (zz[rr][j].z * zz[rr][j].z + zz[rr][j].w * zz[rr][j].w);
                    const float rz0 = rsqrtf(wave_sum(s1[0]) * (1.f / DM) + EPS), rz1 = rsqrtf(wave_sum(s1[1]) * (1.f / DM) + EPS);
#pragma unroll
                    for (int rr = 0; rr < 2; ++rr) { const float rz = rr ? rz1 : rz0;
#pragma unroll
                        for (int j = 0; j < 4; ++j) { xv[rr][j] = xv[rr][j] + zz[rr][j] * rz * gpv[j];
                            s2[rr] += (xv[rr][j].x * xv[rr][j].x + xv[rr][j].y * xv[rr][j].y) + (xv[rr][j].z * xv[rr][j].z + xv[rr][j].w * xv[rr][j].w); } }
#pragma unroll
                    for (int rr = 0; rr < 2; ++rr) { if (rr == 1 && !two) break; const int mrow = mrow0 + rr * NGW;
#pragma unroll
                        for (int j = 0; j < 4; ++j) {
                            if (l + 1 < NLAYER) { u32x2 o; o.x = pk2(xv[rr][j].x, xv[rr][j].y); o.y = pk2(xv[rr][j].z, xv[rr][j].w); __builtin_nontemporal_store(o, (u32x2*)(P.out + (size_t)mrow * DM) + lane + 64 * j); }
                            else __builtin_nontemporal_store(xv[rr][j], (f32x4*)(P.out + (size_t)mrow * DM) + lane + 64 * j); } }
                    if (l + 1 < NLAYER) {
                        const float r0 = rsqrtf(wave_sum(s2[0]) * (1.f / DM) + EPS), r1 = rsqrtf(wave_sum(s2[1]) * (1.f / DM) + EPS);
#pragma unroll
                        for (int rr = 0; rr < 2; ++rr) { if (rr == 1 && !two) break; const int mrow = mrow0 + rr * NGW; const float rs = rr ? r1 : r0;
#pragma unroll
                            for (int j = 0; j < 4; ++j) { u32x2 o; o.x = pk2(xv[rr][j].x * rs, xv[rr][j].y * rs); o.y = pk2(xv[rr][j].z * rs, xv[rr][j].w * rs); ((u32x2*)(XN + (size_t)mrow * DM))[lane + 64 * j] = o; } }
                    }
                }
            }
            }
        }
        if (ph + 1 < P.ph_hi) {
#if MK_COOP
            if (P.ph_hi < 0) grid.sync();
            xcd_barrier(bar);
#endif
        }
    }
}
}

extern "C" void kernel_launch(void* const* d_in, const int* in_sizes, int n_in, void* d_out, int out_size, void* d_ws, size_t ws_size, hipStream_t stream) {
    using namespace mk;
    static int grid = 0;
    if (grid == 0) {
        if (n_in != 14 || out_size != M_TOK * DM || ws_size < WS_END) { fprintf(stderr, "kernel_launch: unexpected shapes (n_in %d out %d ws %zu)\n", n_in, out_size, ws_size); grid = -1; return; }
        int dev = 0, cus = 0, per_cu = 0;
        (void)hipGetDevice(&dev); (void)hipDeviceGetAttribute(&cus, hipDeviceAttributeMultiprocessorCount, dev);
        if (hipFuncSetAttribute((const void*)fwd, hipFuncAttributeMaxDynamicSharedMemorySize, LDS_BYTES) != hipSuccess) { fprintf(stderr, "kernel_launch: hipFuncSetAttribute failed\n"); grid = -1; return; }
        if (hipOccupancyMaxActiveBlocksPerMultiprocessor(&per_cu, (const void*)fwd, NTHREADS, LDS_BYTES) != hipSuccess || per_cu < 1) { fprintf(stderr, "kernel_launch: occupancy query says %d\n", per_cu); per_cu = 1; }
        (void)hipGetLastError();
        if (cus < 256) { fprintf(stderr, "kernel_launch: built for a 256-CU device (one workgroup per CU), found %d CUs\n", cus); grid = -1; return; }
        grid = 256;
    }
    if (grid < 0) return;
    (void)hipMemsetAsync((char*)d_ws + WS_CTL, 0, CTL_BYTES, stream);
    Params p{};
    p.x = (const float*)d_in[0]; p.pos = (const int*)d_in[1]; p.norm_pre = (const float*)d_in[2]; p.w_in = (const float*)d_in[3]; p.sinks = (const float*)d_in[4];
    p.conv_w = (const float*)d_in[5]; p.conv_b = (const float*)d_in[6]; p.g_cq = (const float*)d_in[7]; p.w_uq = (const float*)d_in[8]; p.g_ckv = (const float*)d_in[9];
    p.w_ukv = (const float*)d_in[10]; p.g_grp = (const float*)d_in[11]; p.w_out = (const float*)d_in[12]; p.g_post = (const float*)d_in[13];
    p.out = (float*)d_out; p.ws = (unsigned char*)d_ws;
    constexpr int NPH = 1 + 6 * NLAYER;
#if MK_COOP
    p.ph_lo = 0; p.ph_hi = NPH;
    void* args[] = {&p};
    hipError_t e = hipLaunchCooperativeKernel((const void*)fwd, dim3(grid), dim3(NTHREADS), args, LDS_BYTES, stream);
    if (e != hipSuccess) fprintf(stderr, "kernel_launch: cooperative launch failed: %s (grid %d)\n", hipGetErrorString(e), grid);
#else
    for (int ph = 0; ph < NPH; ++ph) { p.ph_lo = ph; p.ph_hi = ph + 1; hipLaunchKernelGGL(fwd, dim3(grid), dim3(NTHREADS), LDS_BYTES, stream, p); }
#endif
}
```

```cpp
#include <hip/hip_runtime.h>
#include <hip/hip_cooperative_groups.h>
#include <cstdio>
#include <cstdint>
#include <cmath>
namespace pg8 {
#define PG8_LAS __attribute__((address_space(3)))
typedef unsigned short bf16_t;
typedef short bf16x8 __attribute__((ext_vector_type(8)));
typedef float f32x4 __attribute__((ext_vector_type(4)));
typedef unsigned u32x4 __attribute__((ext_vector_type(4)));
constexpr int BM = 256, BK = 64, HALF = 128, HTB = HALF * BK * 2  , STAGE_BYTES = 8 * HTB, NXCD = 8, WGM = 8;

__host__ __device__ __forceinline__ int lds_byte(int r, int c) { const int st = (r >> 4) * 2 + (c >> 5), rr = r & 15, cc = c & 31, ob = rr * 64 + cc * 2; return st * 1024 + (ob ^ (((ob >> 9) & 1) << 5)); }
__host__ __device__ __forceinline__ void stage_rc(int b, int& R, int& C) { const int st = b / 1024, sb = b % 1024, swz = sb ^ (((sb >> 9) & 1) << 5); R = (st >> 1) * 16 + swz / 64; C = (st & 1) * 32 + (swz % 64) / 2; }
__host__ __device__ __forceinline__ int perm32(int rho) { const int n = rho >> 4, i = rho & 15; return 8 * (i >> 2) + 4 * n + (i & 3); }

struct Unit { int pm, pn; };
struct Gemm { const bf16_t* A; const bf16_t* Bt; int M, N, K; };

struct StaticOrder {
    int nM, nN, nwg, G, c;
    __host__ __device__ void init(int M, int N, int G_, int c_) { nM = M / BM; nN = N / BM; nwg = nM * nN; G = G_; c = c_; }
    __host__ __device__ bool next(int i, Unit& u) const {
        const long L = (long)i * G + c; if (L >= nwg) return false;
        int wgid = (int)L; { const int q = nwg / NXCD, r = nwg % NXCD, xcd = wgid % NXCD, off = wgid / NXCD; wgid = (xcd < r ? xcd * (q + 1) : r * (q + 1) + (xcd - r) * q) + off; }
        const int nig = WGM * nN, gid = wgid / nig, fm = gid * WGM, gsz = (nM - fm) < WGM ? (nM - fm) : WGM;
        u.pm = fm + ((wgid % nig) % gsz); u.pn = (wgid % nig) / gsz; return true;
    }
    __device__ __forceinline__ void a_ready(const Unit&) const {}
    __device__ __forceinline__ void done(const Unit&) const {}
};

__device__ __forceinline__ unsigned cvt_pk_bf16(float lo, float hi) { unsigned r; asm volatile("v_cvt_pk_bf16_f32 %0, %1, %2" : "=v"(r) : "v"(lo), "v"(hi)); return r; }
typedef float f32x2 __attribute__((ext_vector_type(2)));
__device__ __forceinline__ f32x2 gelu_pk(f32x2 v) {
    const f32x2 av = __builtin_elementwise_abs(v), d = av * 0.2316418882f + 1.0f;
    f32x2 t; t.x = __builtin_amdgcn_rcpf(d.x); t.y = __builtin_amdgcn_rcpf(d.y);
    f32x2 q = t * 0.5307027145f + (-0.7265760135f); q = q * t + 0.7107068705f; q = q * t + (-0.142248368f); q = q * t + 0.127414796f; q = q * t;
    const f32x2 s = (v * v) * (-0.72134752044f);
    f32x2 e; e.x = __builtin_amdgcn_exp2f(s.x); e.y = __builtin_amdgcn_exp2f(s.y);
    const f32x2 m = v * (q * e), r = v - m;
    f32x2 o; o.x = v.x < 0.f ? m.x : r.x; o.y = v.y < 0.f ? m.y : r.y; return o;
}

template <int ACT  > struct EpiBf16 {
    static constexpr bool PERM = true, AFTER_DRAIN = false; static_assert(ACT == 0 || ACT == 1, "EpiBf16: ACT is 0 (none) or 1 (gelu_pk)");
    bf16_t* O; int ldc; const float* bias; int split_cols; size_t split_stride; float scale0;
    __device__ __forceinline__ void operator()(const f32x4 (&acc)[2][2][4][2], const Unit& u, int wr, int wc, int fr, int fq) const {
        const int row0 = u.pm * BM + wr * 64 + fr; int colt = u.pn * BM; bf16_t* base = O;
        float sc = 1.f; if (split_cols) { const int t = colt / split_cols; base += (size_t)t * split_stride; colt -= t * split_cols; if (t == 0) sc = scale0; }
        const int col0 = colt + wc * 32 + 8 * fq, bcol0 = u.pn * BM + wc * 32 + 8 * fq;
        f32x4 bv[2][2];
#pragma unroll
        for (int bj = 0; bj < 2; ++bj)
#pragma unroll
            for (int n = 0; n < 2; ++n) bv[bj][n] = bias ? *(const f32x4*)(bias + bcol0 + bj * HALF + 4 * n) : (f32x4){0.f, 0.f, 0.f, 0.f};
#pragma unroll
        for (int ai = 0; ai < 2; ++ai)
#pragma unroll
            for (int m = 0; m < 4; ++m) { bf16_t* rowp = base + (size_t)(row0 + ai * HALF + m * 16) * ldc + col0;
#pragma unroll
                for (int bj = 0; bj < 2; ++bj) { f32x4 v0 = acc[ai][bj][m][0] + bv[bj][0], v1 = acc[ai][bj][m][1] + bv[bj][1];
                    if (ACT == 1) { f32x2 a = gelu_pk((f32x2){v0[0], v0[1]}), b = gelu_pk((f32x2){v0[2], v0[3]}), c = gelu_pk((f32x2){v1[0], v1[1]}), d = gelu_pk((f32x2){v1[2], v1[3]});
                        v0 = (f32x4){a.x, a.y, b.x, b.y}; v1 = (f32x4){c.x, c.y, d.x, d.y}; }
                    v0 = v0 * sc; v1 = v1 * sc; u32x4 w; w.x = cvt_pk_bf16(v0[0], v0[1]); w.y = cvt_pk_bf16(v0[2], v0[3]); w.z = cvt_pk_bf16(v1[0], v1[1]); w.w = cvt_pk_bf16(v1[2], v1[3]);
                    *(u32x4*)(rowp + bj * HALF) = w; } }
    }
};
template <class Epi, class Sched, bool ALIGN_EPI = false, bool SP2 = false>
__device__ __forceinline__ void gemm_phase(PG8_LAS unsigned char* lds, const Gemm g, const Sched& S, const Epi& E) {
    int tid_o = threadIdx.x; asm volatile("" : "+v"(tid_o));
    const int tid = tid_o, wid = __builtin_amdgcn_readfirstlane(tid >> 6), lane = tid & 63, wr = wid >> 2, wc = wid & 3, fr = lane & 15, fq = lane >> 4;
    const int K = g.K, nt = K / BK;
    unsigned voffA[2], voffB[2];
#pragma unroll
    for (int i = 0; i < 2; ++i) { int R, C; stage_rc(tid * 16 + i * 8192, R, C); const int Rb = Epi::PERM ? ((R & ~31) + perm32(R & 31)) : R;
        voffA[i] = (unsigned)(R * K + C) * 2u; voffB[i] = (unsigned)(Rb * K + C) * 2u; }
    const size_t kstep = (size_t)(BK * 2);
    const size_t hstep = (size_t)HALF * K * 2;
    const size_t tstep = 2 * hstep;
    const unsigned ldsw = (unsigned)wid * 1024u;
    const int aoff = lds_byte(wr * 64 + fr, fq * 8), boff = lds_byte(wc * 32 + fr, fq * 8);
#define PG8_SA(b, h) (((b) * 2 + (h)) * HTB)
#define PG8_SB(b, h) ((4 + (b) * 2 + (h)) * HTB)
#define PG8_STAGE(bufoff, gbase, voff) do { _Pragma("unroll") for (int _i = 0; _i < 2; ++_i) \
        __builtin_amdgcn_global_load_lds((const unsigned*)((const char*)(gbase) + (voff)[_i]), (PG8_LAS unsigned*)(lds + (bufoff) + ldsw + _i * 8192), 16, 0, 0); } while (0)
#define PG8_LDA(dst, b, h) do { _Pragma("unroll") for (int m = 0; m < 4; ++m) _Pragma("unroll") for (int k = 0; k < 2; ++k) dst[m][k] = *(const PG8_LAS bf16x8*)(lds + PG8_SA(b, h) + aoff + m * 2048 + k * 1024); } while (0)
#define PG8_LDB(dst, b, h) do { _Pragma("unroll") for (int n = 0; n < 2; ++n) _Pragma("unroll") for (int k = 0; k < 2; ++k) dst[n][k] = *(const PG8_LAS bf16x8*)(lds + PG8_SB(b, h) + boff + n * 2048 + k * 1024); } while (0)
#define PG8_MMA(ai, bj, At, Bt) do { __builtin_amdgcn_s_setprio(1); _Pragma("unroll") for (int m = 0; m < 4; ++m) _Pragma("unroll") for (int n = 0; n < 2; ++n) _Pragma("unroll") for (int k = 0; k < 2; ++k) \
        acc[ai][bj][m][n] = __builtin_amdgcn_mfma_f32_16x16x32_bf16(Bt[n][k], At[m][k], acc[ai][bj][m][n], 0, 0, 0); __builtin_amdgcn_s_setprio(0); } while (0)
#define PG8_WAIT_V(n) asm volatile("s_waitcnt vmcnt(" #n ")" ::: "memory")
#define PG8_WAIT_L(n) asm volatile("s_waitcnt lgkmcnt(" #n ")" ::: "memory")
#define PG8_BAR __builtin_amdgcn_s_barrier()
#define PG8_SCHED __builtin_amdgcn_sched_barrier(0)
    Unit cur, nxt; int ui = 0;
    if (!S.next(0, cur)) return;
    f32x4 acc[2][2][4][2];
#pragma unroll
    for (int a = 0; a < 2; ++a)
#pragma unroll
        for (int b = 0; b < 2; ++b)
#pragma unroll
            for (int m = 0; m < 4; ++m)
#pragma unroll
                for (int n = 0; n < 2; ++n) acc[a][b][m][n] = (f32x4){0.f, 0.f, 0.f, 0.f};
    bf16x8 At[4][2], B0[2][2], B1[2][2];
    const char* cA = (const char*)g.A + (size_t)cur.pm * tstep; const char* cB = (const char*)g.Bt + (size_t)cur.pn * tstep;
    S.a_ready(cur);
    if constexpr (SP2) {
        PG8_STAGE(PG8_SB(0, 0), cB, voffB); PG8_STAGE(PG8_SB(0, 1), cB + hstep, voffB); PG8_STAGE(PG8_SA(0, 0), cA, voffA); PG8_STAGE(PG8_SA(0, 1), cA + hstep, voffA);
        if (wr == 1) PG8_BAR;
        PG8_WAIT_V(2); PG8_BAR;
        PG8_STAGE(PG8_SB(1, 0), cB + kstep, voffB); PG8_STAGE(PG8_SA(1, 0), cA + kstep, voffA); PG8_STAGE(PG8_SB(1, 1), cB + hstep + kstep, voffB);
        PG8_WAIT_V(6); PG8_BAR;
    } else {
        PG8_STAGE(PG8_SB(0, 0), cB, voffB); PG8_STAGE(PG8_SA(0, 0), cA, voffA); PG8_STAGE(PG8_SB(0, 1), cB + hstep, voffB); PG8_STAGE(PG8_SA(0, 1), cA + hstep, voffA);
        if (wr == 1) PG8_BAR;
        PG8_WAIT_V(4); PG8_BAR;
        PG8_STAGE(PG8_SB(1, 0), cB + kstep, voffB); PG8_STAGE(PG8_SA(1, 0), cA + kstep, voffA); PG8_STAGE(PG8_SB(1, 1), cB + hstep + kstep, voffB);
        PG8_WAIT_V(6); PG8_BAR;
    }
    for (;;) {
        const bool has_next = S.next(ui + 1, nxt);
        const char* nA = has_next ? (const char*)g.A + (size_t)nxt.pm * tstep : cA; const char* nB = has_next ? (const char*)g.Bt + (size_t)nxt.pn * tstep : cB;
        for (int t = 0; t < nt; t += 2) {
            const bool last = (t == nt - 2);
            const char* a1 = cA + (size_t)(t + 1) * kstep;
            const char* a2 = last ? nA : cA + (size_t)(t + 2) * kstep; const char* b2 = last ? nB : cB + (size_t)(t + 2) * kstep;
            const char* a3 = a2 + kstep; const char* b3 = b2 + kstep;
            if (last && has_next) S.a_ready(nxt);
            if constexpr (SP2) {
            PG8_LDB(B0, 0, 0); PG8_LDB(B1, 0, 1); PG8_SCHED; PG8_LDA(At, 0, 0); PG8_STAGE(PG8_SA(1, 1), a1 + hstep, voffA);
            PG8_WAIT_V(8); PG8_WAIT_L(0); PG8_BAR; PG8_MMA(0, 0, At, B0); PG8_MMA(0, 1, At, B1); PG8_BAR; PG8_SCHED;
            PG8_LDA(At, 0, 1); PG8_STAGE(PG8_SB(0, 0), b2, voffB); PG8_STAGE(PG8_SB(0, 1), b2 + hstep, voffB); PG8_STAGE(PG8_SA(0, 0), a2, voffA);
            PG8_WAIT_V(8); PG8_WAIT_L(0); PG8_BAR; PG8_MMA(1, 0, At, B0); PG8_MMA(1, 1, At, B1); PG8_BAR; PG8_SCHED;
            PG8_LDB(B0, 1, 0); PG8_LDB(B1, 1, 1); PG8_SCHED; PG8_LDA(At, 1, 0); PG8_STAGE(PG8_SA(0, 1), a2 + hstep, voffA);
            PG8_WAIT_V(8); PG8_WAIT_L(0); PG8_BAR; PG8_MMA(0, 0, At, B0); PG8_MMA(0, 1, At, B1); PG8_BAR; PG8_SCHED;
            PG8_LDA(At, 1, 1); PG8_STAGE(PG8_SB(1, 0), b3, voffB); PG8_STAGE(PG8_SB(1, 1), b3 + hstep, voffB); PG8_STAGE(PG8_SA(1, 0), a3, voffA);
            PG8_WAIT_V(8); PG8_WAIT_L(0); PG8_BAR; PG8_MMA(1, 0, At, B0); PG8_MMA(1, 1, At, B1); PG8_BAR; PG8_SCHED;
            } else {
            PG8_LDB(B0, 0, 0); PG8_SCHED; PG8_LDA(At, 0, 0); PG8_STAGE(PG8_SA(1, 1), a1 + hstep, voffA);
            PG8_WAIT_L(8); PG8_BAR; PG8_WAIT_L(0); PG8_MMA(0, 0, At, B0); PG8_BAR; PG8_SCHED;
            PG8_LDB(B1, 0, 1); PG8_STAGE(PG8_SB(0, 0), b2, voffB);
            PG8_BAR; PG8_WAIT_L(0); PG8_MMA(0, 1, At, B1); PG8_BAR;
            PG8_LDA(At, 0, 1); PG8_STAGE(PG8_SA(0, 0), a2, voffA);
            PG8_BAR; PG8_WAIT_L(0); PG8_MMA(1, 0, At, B0); PG8_BAR; PG8_SCHED;
            PG8_STAGE(PG8_SB(0, 1), b2 + hstep, voffB);
            PG8_WAIT_V(6); PG8_BAR; PG8_MMA(1, 1, At, B1); PG8_BAR;
            PG8_LDB(B0, 1, 0); PG8_SCHED; PG8_LDA(At, 1, 0); PG8_STAGE(PG8_SA(0, 1), a2 + hstep, voffA);
            PG8_WAIT_L(8); PG8_BAR; PG8_WAIT_L(0); PG8_MMA(0, 0, At, B0); PG8_BAR; PG8_SCHED;
            PG8_LDB(B1, 1, 1); PG8_STAGE(PG8_SB(1, 0), b3, voffB);
            PG8_BAR; PG8_WAIT_L(0); PG8_MMA(0, 1, At, B1); PG8_BAR;
            PG8_LDA(At, 1, 1); PG8_STAGE(PG8_SA(1, 0), a3, voffA);
            PG8_BAR; PG8_WAIT_L(0); PG8_MMA(1, 0, At, B0); PG8_BAR; PG8_SCHED;
            PG8_STAGE(PG8_SB(1, 1), b3 + hstep, voffB);
            PG8_WAIT_V(6); PG8_BAR; PG8_MMA(1, 1, At, B1); PG8_BAR;
            }
        }
        if constexpr (ALIGN_EPI) { if (wr == 0) PG8_BAR; }
        if constexpr (!Epi::AFTER_DRAIN) { E(acc, cur, wr, wc, fr, fq); S.done(cur); }
        if (!has_next) break;
#pragma unroll
        for (int a = 0; a < 2; ++a)
#pragma unroll
            for (int b = 0; b < 2; ++b)
#pragma unroll
                for (int m = 0; m < 4; ++m)
#pragma unroll
                    for (int n = 0; n < 2; ++n) acc[a][b][m][n] = (f32x4){0.f, 0.f, 0.f, 0.f};
        cur = nxt; cA = nA; cB = nB; ++ui;
        if constexpr (ALIGN_EPI) { if (wr == 1) PG8_BAR; }
    }
    PG8_WAIT_V(0);
    if constexpr (!ALIGN_EPI) { if (wr == 0) PG8_BAR; }
    PG8_BAR;
    if constexpr (Epi::AFTER_DRAIN) { E.fused(acc, cur, wr, wc, fr, fq, lds, wid, lane); S.done(cur); }
#undef PG8_SA
#undef PG8_SB
#undef PG8_STAGE
#undef PG8_LDA
#undef PG8_LDB
#undef PG8_MMA
#undef PG8_WAIT_V
#undef PG8_WAIT_L
#undef PG8_BAR
#undef PG8_SCHED
}
}
#ifndef MK_COOP
#define MK_COOP 1
#endif
#ifndef MK_REP_K
#define MK_REP_K -1
#endif
#ifndef MK_REP_N
#define MK_REP_N 1
#endif
namespace mk {
using pg8::bf16_t; using pg8::bf16x8; using pg8::f32x4; using pg8::u32x4;
typedef float f32x16 __attribute__((ext_vector_type(16)));
typedef unsigned u32x2 __attribute__((ext_vector_type(2)));
typedef float f32x2_t __attribute__((ext_vector_type(2)));
typedef __bf16 bf16x2_t __attribute__((ext_vector_type(2)));
#define LAS __attribute__((address_space(3)))
#define MFMA32(a, b, c) __builtin_amdgcn_mfma_f32_32x32x16_bf16((a), (b), (c), 0, 0, 0)

constexpr int M_TOK = 16384, SEQ = 8192, DM = 1024, DIN = 3488, DINP = 3584, NLAYER = 2;
constexpr int C_AQ = 0, C_AK = 256, C_AV = 384, C_BB = 512, C_BC = 768, C_BX = 1024, C_CQ = 1280, C_CKV = 1536, C_CKR = 1664,
              C_DQ = 1696, C_DK = 1952, C_DV = 2208, C_GATE = 2464;
constexpr float EPS = 1e-6f, LOG2E = 1.4426950408889634f;
constexpr float SC64 = 0.125f * LOG2E;
constexpr float QSC_MLA = 0.10206207261596575f * LOG2E;
constexpr int NWAVES = 8, NTHREADS = 512;
constexpr int LDS_BYTES = 122880 + 8 * 4096 + 1024;

constexpr size_t MiB = 1u << 20;
constexpr size_t WS_CTL = 0, CTL_BYTES = 65536;
constexpr int CW_BAR = 1024;
constexpr size_t WS_WIN = 1 * MiB;
constexpr size_t WS_WOUT = 15 * MiB;
constexpr size_t WS_WUQ = 19 * MiB;
constexpr size_t WS_WUKV = 19 * MiB + 512 * 1024;
constexpr size_t WS_XN = 32 * MiB;
constexpr size_t WS_H = 64 * MiB;
constexpr size_t WS_QC = 176 * MiB;
constexpr size_t WS_KC = 188 * MiB;
constexpr size_t WS_VTC = 200 * MiB;
constexpr size_t WS_VTA = 208 * MiB;
constexpr size_t WS_VTD = 212 * MiB;
constexpr size_t WS_Y = 220 * MiB;
constexpr size_t WS_END = 252 * MiB;

struct Params {
    const float* x; const int* pos; const float* norm_pre; const float* w_in; const float* sinks; const float* conv_w; const float* conv_b;
    const float* g_cq; const float* w_uq; const float* g_ckv; const float* w_ukv; const float* g_grp; const float* w_out; const float* g_post;
    float* out; unsigned char* ws; int ph_lo, ph_hi;
};

__device__ __forceinline__ unsigned pk2(float lo, float hi) { f32x2_t v = {lo, hi}; bf16x2_t b = __builtin_convertvector(v, bf16x2_t); return __builtin_bit_cast(unsigned, b); }
__device__ __forceinline__ float bf2f(short s) { return __uint_as_float(((unsigned)(unsigned short)s) << 16); }
__device__ __forceinline__ float bflo(unsigned u) { return __uint_as_float(u << 16); }
__device__ __forceinline__ float bfhi(unsigned u) { return __uint_as_float(u & 0xffff0000u); }
__device__ __forceinline__ bf16_t f2bf(float f) { return (bf16_t)(pk2(f, 0.f) & 0xffffu); }
__device__ __forceinline__ int crow(int i, int h) { return (i & 3) + 8 * (i >> 2) + 4 * h; }
__device__ __forceinline__ float ex2(float x) { return __builtin_amdgcn_exp2f(x); }
__device__ __forceinline__ float lg2(float x) { return __builtin_amdgcn_logf(x); }
__device__ __forceinline__ float xh_max(float v) { auto rr = __builtin_amdgcn_permlane32_swap(__float_as_uint(v), __float_as_uint(v), false, false); return fmaxf(__uint_as_float(rr[0]), __uint_as_float(rr[1])); }
__device__ __forceinline__ float xh_sum(float v) { auto rr = __builtin_amdgcn_permlane32_swap(__float_as_uint(v), __float_as_uint(v), false, false); return __uint_as_float(rr[0]) + __uint_as_float(rr[1]); }
__device__ __forceinline__ float xh_other(float v, int h) { auto rr = __builtin_amdgcn_permlane32_swap(__float_as_uint(v), __float_as_uint(v), false, false); return __uint_as_float(h ? rr[0] : rr[1]); }
#define MX3(a, b, c) __builtin_fmaxf(__builtin_fmaxf((a), (b)), (c))
__device__ __forceinline__ float wave_sum(float v) {
#pragma unroll
    for (int o = 1; o < 64; o <<= 1) v += __shfl_xor(v, o);
    return v;
}
__device__ __forceinline__ bf16x8 pack8(const float* e) {
    u32x4 w; w.x = pk2(e[0], e[1]); w.y = pk2(e[2], e[3]); w.z = pk2(e[4], e[5]); w.w = pk2(e[6], e[7]);
    return __builtin_bit_cast(bf16x8, w);
}

__device__ __forceinline__ void conv_wT(const float* __restrict__ W, int K, int N, int NP, const float* __restrict__ gain, bf16_t* __restrict__ dst,
                                        int a0, int a1, int b0, int b1, float sc, int gtid, int gthreads) {
    const int k8n = K / 8; const int items = NP * k8n;
#pragma unroll 2
    for (int it = gtid; it < items; it += gthreads) {
        const int n = it % NP, k8 = it / NP;
        u32x4 o = {0u, 0u, 0u, 0u};
        if (n < N) {
            const float cs = ((n >= a0 && n < a1) || (n >= b0 && n < b1)) ? sc : 1.f;
            float v[8];
#pragma unroll
            for (int j = 0; j < 8; ++j) v[j] = W[(size_t)(k8 * 8 + j) * N + n] * gain[k8 * 8 + j] * cs;
            o.x = pk2(v[0], v[1]); o.y = pk2(v[2], v[3]); o.z = pk2(v[4], v[5]); o.w = pk2(v[6], v[7]);
        }
        *(u32x4*)(dst + (size_t)n * K + k8 * 8) = o;
    }
}
__device__ __forceinline__ void wT_item(const float* __restrict__ W, int K, int N, const float* __restrict__ gain, bf16_t* __restrict__ WT, int a0, int a1, int b0, int b1, float sc,
                                        LAS float* scr, int item, int lane) {
    const int nblk = N / 32, kb = item / nblk, nb = item - kb * nblk, k0 = 64 * kb, n0 = 32 * nb;
#pragma unroll 8
    for (int i = 0; i < 32; ++i) { const int kk = 2 * i + (lane >> 5); scr[kk * 33 + (lane & 31)] = __builtin_nontemporal_load(W + (size_t)(k0 + kk) * N + n0 + (lane & 31)); }
    const int c = lane & 7;
    float g8[8];
#pragma unroll
    for (int j = 0; j < 8; ++j) g8[j] = gain[k0 + 8 * c + j];
#pragma unroll
    for (int j = 0; j < 4; ++j) { const int n = (lane >> 3) + 8 * j, nn = n0 + n; const LAS float* sp = scr + (8 * c) * 33 + n;
        const float cs = ((nn >= a0 && nn < a1) || (nn >= b0 && nn < b1)) ? sc : 1.f;
        u32x4 o; o.x = pk2(sp[0 * 33] * g8[0] * cs, sp[1 * 33] * g8[1] * cs); o.y = pk2(sp[2 * 33] * g8[2] * cs, sp[3 * 33] * g8[3] * cs);
        o.z = pk2(sp[4 * 33] * g8[4] * cs, sp[5 * 33] * g8[5] * cs); o.w = pk2(sp[6 * 33] * g8[6] * cs, sp[7 * 33] * g8[7] * cs);
        *(u32x4*)(WT + (size_t)nn * K + k0 + 8 * c) = o; }
}
__device__ __forceinline__ void rms_row_to_bf16(const float* __restrict__ xrow, bf16_t* __restrict__ orow, int lane) {
    f32x4 v[4]; float s = 0.f;
#pragma unroll
    for (int j = 0; j < 4; ++j) { v[j] = __builtin_nontemporal_load((const f32x4*)xrow + lane + 64 * j); s += (v[j].x * v[j].x + v[j].y * v[j].y) + (v[j].z * v[j].z + v[j].w * v[j].w); }
    const float rs = rsqrtf(wave_sum(s) * (1.f / DM) + EPS);
#pragma unroll
    for (int j = 0; j < 4; ++j) { u32x2 o; o.x = pk2(v[j].x * rs, v[j].y * rs); o.y = pk2(v[j].z * rs, v[j].w * rs); ((u32x2*)orow)[lane + 64 * j] = o; }
}

__device__ __forceinline__ void rope_cs(int pos, int h, float (&cs)[8], float (&sn)[8]) {
#pragma unroll
    for (int i = 0; i < 8; ++i) {
        const int f = (i & 3) + 8 * (i >> 2) + 4 * h;
        const float freq = ex2(-(float)f * 0.830482023721841f);
        const float ang = (float)pos * freq;
        const double rev = (double)ang * 0.15915494309189535;
        const float fr = (float)(rev - __builtin_rint(rev));
        cs[i] = __builtin_amdgcn_cosf(fr); sn[i] = __builtin_amdgcn_sinf(fr);
    }
}
__device__ __forceinline__ void rope_apply(f32x16& a, const float (&cs)[8], const float (&sn)[8]) {
#pragma unroll
    for (int i = 0; i < 8; ++i) { const float x1 = a[i], x2 = a[i + 8]; a[i] = x1 * cs[i] - x2 * sn[i]; a[i + 8] = x1 * sn[i] + x2 * cs[i]; }
}
__device__ __forceinline__ void store_tile_rowmajor(bf16_t* dst  , const f32x16& a, int h) {
#pragma unroll
    for (int g = 0; g < 4; ++g) { u32x2 o; o.x = pk2(a[4 * g], a[4 * g + 1]); o.y = pk2(a[4 * g + 2], a[4 * g + 3]); *(u32x2*)(dst + 8 * g + 4 * h) = o; }
}
constexpr int WQP = 528, WKP = 272, WQ_BYTES = 96 * WQP;
__device__ __forceinline__ void mq_unit(const bf16_t* __restrict__ H, const LAS unsigned char* Wl, const int* __restrict__ pos, bf16_t* __restrict__ QC, int tb, int hh, int lane) {
    const int r = lane & 31, h = lane >> 5, tok = tb * 32 + r;
    const bf16_t* src = H + (size_t)tok * DINP + C_CQ + 8 * h;
    bf16x8 bfr[16]; float ss = 0.f;
#pragma unroll
    for (int s = 0; s < 16; ++s) { bfr[s] = *(const bf16x8*)(src + 16 * s);
#pragma unroll
        for (int j = 0; j < 8; ++j) { const float v = bf2f(bfr[s][j]); ss += v * v; } }
    ss += __shfl_xor(ss, 32);
    const float rs = rsqrtf(ss * (1.f / 256.f) + EPS) * QSC_MLA;
    float cs[8], sn[8]; rope_cs(pos[tok], h, cs, sn);
    const LAS unsigned char* W = Wl + r * WQP + 16 * h;
#pragma unroll 1
    for (int nt = 0; nt < 3; ++nt) {
        f32x16 acc;
#pragma unroll
        for (int i = 0; i < 16; ++i) acc[i] = 0.f;
#pragma unroll
        for (int s = 0; s < 16; ++s) { const bf16x8 a = *(const LAS bf16x8*)(W + nt * 32 * WQP + 32 * s); acc = MFMA32(a, bfr[s], acc); }
#pragma unroll
        for (int i = 0; i < 16; ++i) acc[i] *= rs;
        if (nt == 2) rope_apply(acc, cs, sn);
        store_tile_rowmajor(QC + (size_t)tok * 384 + hh * 96 + nt * 32, acc, h);
    }
}
__device__ __forceinline__ void vt_flush(LAS bf16_t* stg, bf16_t* __restrict__ dst  , int lane) {
    const LAS u32x4* rp = (const LAS u32x4*)(stg + lane * 32);
    u32x4 w[4];
#pragma unroll
    for (int c = 0; c < 4; ++c) w[c] = rp[c];
    u32x4* gp = (u32x4*)(dst + (size_t)lane * SEQ);
#pragma unroll
    for (int c = 0; c < 4; ++c) gp[c] = w[c];
}
__device__ __forceinline__ void mkv_unit(const bf16_t* __restrict__ H, const LAS unsigned char* Wl, const int* __restrict__ pos, bf16_t* __restrict__ KC, bf16_t* __restrict__ VTC, int tb, int hh, int lane, LAS bf16_t* stg) {
    const int r = lane & 31, h = lane >> 5, tok = tb * 32 + r;
    const bf16_t* src = H + (size_t)tok * DINP + C_CKV + 8 * h;
    bf16x8 bfr[8]; float ss = 0.f;
#pragma unroll
    for (int s = 0; s < 8; ++s) { bfr[s] = *(const bf16x8*)(src + 16 * s);
#pragma unroll
        for (int j = 0; j < 8; ++j) { const float v = bf2f(bfr[s][j]); ss += v * v; } }
    ss += __shfl_xor(ss, 32);
    const float rs = rsqrtf(ss * (1.f / 128.f) + EPS);
    const LAS unsigned char* W = Wl + r * WKP + 16 * h;
    const int b = (tb * 32) / SEQ, t0 = (tb * 32) % SEQ;
#pragma unroll 1
    for (int nt = 0; nt < 4; ++nt) {
        f32x16 acc;
#pragma unroll
        for (int i = 0; i < 16; ++i) acc[i] = 0.f;
#pragma unroll
        for (int s = 0; s < 8; ++s) { const bf16x8 a = *(const LAS bf16x8*)(W + nt * 32 * WKP + 32 * s); acc = MFMA32(a, bfr[s], acc); }
#pragma unroll
        for (int i = 0; i < 16; ++i) acc[i] *= rs;
        if (nt < 2) store_tile_rowmajor(KC + (size_t)tok * 384 + hh * 96 + nt * 32, acc, h);
        else {
            LAS bf16_t* sp = stg + ((nt - 2) * 32 + 4 * h) * 32 + r;
#pragma unroll
            for (int i = 0; i < 16; ++i) sp[((i & 3) + 8 * (i >> 2)) * 32] = f2bf(acc[i]);
        }
    }
    vt_flush(stg, VTC + ((size_t)((b * 4 + hh) * 64)) * SEQ + t0, lane);
    f32x16 kr;
    const bf16_t* krp = H + (size_t)tok * DINP + C_CKR + 4 * h;
#pragma unroll
    for (int g = 0; g < 4; ++g) { const u32x2 w = *(const u32x2*)(krp + 8 * g); kr[4 * g] = bflo(w.x); kr[4 * g + 1] = bfhi(w.x); kr[4 * g + 2] = bflo(w.y); kr[4 * g + 3] = bfhi(w.y); }
    float cs[8], sn[8]; rope_cs(pos[tok], h, cs, sn);
    rope_apply(kr, cs, sn);
    store_tile_rowmajor(KC + (size_t)tok * 384 + hh * 96 + 64, kr, h);
}
__device__ __forceinline__ void vt_unit(const bf16_t* __restrict__ H, int col0, int NH, bf16_t* __restrict__ VT, int tb, int head, int lane, LAS bf16_t* stg) {
    const int r = lane & 31, h = lane >> 5, tok = tb * 32 + r, b = (tb * 32) / SEQ, t0 = (tb * 32) % SEQ;
    const bf16_t* src = H + (size_t)tok * DINP + col0 + head * 64 + 32 * h;
    bf16x8 v[4];
#pragma unroll
    for (int c = 0; c < 4; ++c) v[c] = *(const bf16x8*)(src + 8 * c);
    LAS bf16_t* sp = stg + (32 * h) * 32 + r;
#pragma unroll
    for (int c = 0; c < 4; ++c)
#pragma unroll
        for (int j = 0; j < 8; ++j) sp[(8 * c + j) * 32] = (bf16_t)v[c][j];
    vt_flush(stg, VT + ((size_t)((b * NH + head) * 64)) * SEQ + t0, lane);
}
__device__ __forceinline__ void conv_unit(const bf16_t* __restrict__ H, const float* __restrict__ cw, const float* __restrict__ cb, bf16_t* __restrict__ Y, int tb8, int lane) {
    const int tok0 = tb8 * 8, t0 = tok0 % SEQ, ch = 4 * lane;
    const f32x4 w0 = *(const f32x4*)(cw + ch), w1 = *(const f32x4*)(cw + 256 + ch), w2 = *(const f32x4*)(cw + 512 + ch), bs = *(const f32x4*)(cb + ch);
    u32x2 cc[10], xx[10], bb[8];
    const int back = (t0 >= 2) ? 2 : 0;
#pragma unroll
    for (int i = 0; i < 10; ++i) { const int ti = (i < 2) ? (i - back) : (i - 2); const bf16_t* p = H + (size_t)(tok0 + ti) * DINP + ch;
        cc[i] = *(const u32x2*)(p + C_BC); xx[i] = *(const u32x2*)(p + C_BX); if (i >= 2) bb[i - 2] = *(const u32x2*)(p + C_BB); }
    f32x4 u[10];
#pragma unroll
    for (int i = 0; i < 10; ++i) u[i] = (f32x4){bflo(cc[i].x) * bflo(xx[i].x), bfhi(cc[i].x) * bfhi(xx[i].x), bflo(cc[i].y) * bflo(xx[i].y), bfhi(cc[i].y) * bfhi(xx[i].y)};
    if (back == 0) { u[0] = (f32x4){0.f, 0.f, 0.f, 0.f}; u[1] = (f32x4){0.f, 0.f, 0.f, 0.f}; }
#pragma unroll
    for (int i = 0; i < 8; ++i) {
        const f32x4 bg = {bflo(bb[i].x), bfhi(bb[i].x), bflo(bb[i].y), bfhi(bb[i].y)};
        const f32x4 y = bg * (w0 * u[i] + w1 * u[i + 1] + w2 * u[i + 2] + bs);
        u32x2 o; o.x = pk2(y.x, y.y); o.y = pk2(y.z, y.w);
        *(u32x2*)(Y + (size_t)(tok0 + i) * DM + 256 + ch) = o;
    }
}

__device__ __forceinline__ void o_flush(LAS bf16_t* stg, bf16_t* __restrict__ Orow0, int opitch, int lane) {
    u32x4 w[4];
#pragma unroll
    for (int j = 0; j < 4; ++j) w[j] = *(const LAS u32x4*)(stg + (lane + 64 * j) * 8);
#pragma unroll
    for (int j = 0; j < 4; ++j) { const int c = lane + 64 * j; *(u32x4*)(Orow0 + (size_t)(c >> 3) * opitch + (c & 7) * 8) = w[j]; }
}
template <int DKS, bool SINK>
__device__ __forceinline__ void softmax_unit(const bf16_t* __restrict__ Qrow0, int qpitch, const bf16_t* __restrict__ Kb, int kpitch, const bf16_t* __restrict__ VT,
                                             int qb, int kt_begin, int window, float sink2, bf16_t* __restrict__ Orow0, int opitch, int lane, LAS bf16_t* stg) {
    const int r = lane & 31, h = lane >> 5;
    const int pr = (r & ~12) | ((r & 8) >> 1) | ((r & 4) << 1);
    bf16x8 qf[DKS];
#pragma unroll
    for (int s = 0; s < DKS; ++s) qf[s] = *(const bf16x8*)(Qrow0 + (size_t)r * qpitch + 16 * s + 8 * h);
    f32x16 o0, o1;
#pragma unroll
    for (int i = 0; i < 16; ++i) { o0[i] = 0.f; o1[i] = 0.f; }
    float m = -1e30f, l = 0.f;
    const int kt_end = qb + 1, q = 32 * qb + r;
    const bf16_t* kp = Kb + (size_t)(32 * kt_begin + pr) * kpitch + 8 * h;
    const bf16_t* vp = VT + (size_t)r * SEQ + 32 * kt_begin + 8 * h;
    bf16x8 kf[DKS];
#pragma unroll
    for (int s = 0; s < DKS; ++s) kf[s] = *(const bf16x8*)(kp + 16 * s);
    for (int kt = kt_begin; kt < kt_end; ++kt) {
        bf16x8 kn[DKS];
        if (kt + 1 < kt_end) {
#pragma unroll
            for (int s = 0; s < DKS; ++s) kn[s] = *(const bf16x8*)(kp + (size_t)32 * kpitch + 16 * s);
        } else {
#pragma unroll
            for (int s = 0; s < DKS; ++s) kn[s] = kf[s];
        }
        const bf16x8 v00 = *(const bf16x8*)(vp), v01 = *(const bf16x8*)(vp + 32 * SEQ), v10 = *(const bf16x8*)(vp + 16), v11 = *(const bf16x8*)(vp + 32 * SEQ + 16);
        f32x16 p;
#pragma unroll
        for (int i = 0; i < 16; ++i) p[i] = 0.f;
#pragma unroll
        for (int s = 0; s < DKS; ++s) p = MFMA32(kf[s], qf[s], p);
        if (kt == qb || (window != 0 && kt == qb - (window >> 5))) {
            const int k0 = 32 * kt + 8 * h;
#pragma unroll
            for (int i = 0; i < 16; ++i) { const int kv = k0 + 16 * (i >> 3) + (i & 7); const bool ok = (kv <= q) && (window == 0 || kv > q - window); if (!ok) p[i] = -INFINITY; }
        }
        float rm = MX3(p[0], p[1], p[2]);
#pragma unroll
        for (int i = 3; i < 15; i += 2) rm = MX3(rm, p[i], p[i + 1]);
        rm = xh_max(fmaxf(rm, p[15]));
        if (__any(rm > m + 6.f)) {
            const float mn = fmaxf(m, rm), f = ex2(m - mn); m = mn; l *= f;
#pragma unroll
            for (int i = 0; i < 16; ++i) { const float fi = __shfl(f, crow(i, h)); o0[i] *= fi; o1[i] *= fi; }
        }
        float e[16];
#pragma unroll
        for (int i = 0; i < 16; ++i) { e[i] = ex2(p[i] - m); l += e[i]; }
        const bf16x8 pa0 = pack8(e), pa1 = pack8(e + 8);
        o0 = MFMA32(pa0, v00, o0); o1 = MFMA32(pa0, v01, o1);
        o0 = MFMA32(pa1, v10, o0); o1 = MFMA32(pa1, v11, o1);
#pragma unroll
        for (int s = 0; s < DKS; ++s) kf[s] = kn[s];
        kp += (size_t)32 * kpitch; vp += 32;
    }
    l = xh_sum(l);
    if (SINK) l += ex2(sink2 - m);
    const float inv = 1.f / l;
    LAS bf16_t* sp = stg + (4 * h) * 64 + r;
#pragma unroll
    for (int i = 0; i < 16; ++i) { const float fi = __shfl(inv, crow(i, h)); const int ro = ((i & 3) + 8 * (i >> 2)) * 64;
        sp[ro] = f2bf(o0[i] * fi); sp[ro + 32] = f2bf(o1[i] * fi); }
    o_flush(stg, Orow0, opitch, lane);
}


constexpr int KP = 208, VP = 272;
constexpr int KT_BYTES = 128 * KP, VT_BYTES = 64 * VP, TB_BYTES = KT_BYTES + VT_BYTES, MRG_OFF = 2 * TB_BYTES;
static_assert(MRG_OFF + 4 * 34 * 64 * 4 <= 131072, "MLA LDS map");
__device__ __forceinline__ void mla_unit_blk(const bf16_t* __restrict__ QC, const bf16_t* __restrict__ KC, const bf16_t* __restrict__ VTC, bf16_t* __restrict__ Y,
                                             int bh, int g, LAS unsigned char* lds, int tid) {
    const int lane = tid & 63, wave = __builtin_amdgcn_readfirstlane(tid >> 6), r = lane & 31, h = lane >> 5, w4 = wave & 3, kh = wave >> 2;
    const int pr = (r & ~12) | ((r & 8) >> 1) | ((r & 4) << 1);
    const int b = bh >> 2, hh = bh & 3, qb = 4 * g + w4, q = 32 * qb + r;
    const bf16_t* Qp = QC + ((size_t)b * SEQ + q) * 384 + hh * 96 + 8 * h;
    bf16x8 qf[6];
#pragma unroll
    for (int s = 0; s < 6; ++s) qf[s] = *(const bf16x8*)(Qp + 16 * s);
    const bf16_t* Kg = KC + (size_t)b * SEQ * 384 + hh * 96;
    const bf16_t* Vg = VTC + (size_t)(b * 4 + hh) * 64 * SEQ;
    unsigned dgo[6];
#pragma unroll
    for (int i = 0; i < 6; ++i) { const int n = wave + 8 * i; unsigned o = 0u;
        if (n < 26) { const int j = 64 * n + lane, row = j / 13; int cc = j - 13 * row; cc = cc == 12 ? 0 : cc; o = (unsigned)(row * 384 + 8 * cc) * 2u; }
        else if (n < 43) { const int j = 64 * (n - 26) + lane, d = j / 17; int cc = j - 17 * d; cc = cc == 16 ? 0 : cc; o = (unsigned)(d * SEQ + 8 * cc) * 2u; }
        dgo[i] = o; }
#define MLA_DMA(ST, BO) do { const char* kb_ = (const char*)(Kg + (size_t)(ST) * (128 * 384)); const char* vb_ = (const char*)(Vg + (ST) * 128); \
        _Pragma("unroll") for (int i = 0; i < 6; ++i) { const int n = wave + 8 * i; \
            if (n < 26) __builtin_amdgcn_global_load_lds((const unsigned*)(kb_ + dgo[i]), (LAS unsigned*)(lds + (BO) + n * 1024), 16, 0, 0); \
            else if (n < 43) __builtin_amdgcn_global_load_lds((const unsigned*)(vb_ + dgo[i]), (LAS unsigned*)(lds + (BO) + KT_BYTES + (n - 26) * 1024), 16, 0, 0); } } while (0)
#define MLA_DMA_WAIT() asm volatile("s_waitcnt vmcnt(0)" ::: "memory")
    f32x16 o0, o1;
#pragma unroll
    for (int i = 0; i < 16; ++i) { o0[i] = 0.f; o1[i] = 0.f; }
    float m = 0.f, l = 0.f; bool first = true;
    f32x16 negm;
#pragma unroll
    for (int i = 0; i < 16; ++i) negm[i] = 0.f;
    const int nST = g + 1;
    MLA_DMA(0, 0); MLA_DMA_WAIT();
    __syncthreads();
    const int kfo = (64 * kh + pr) * KP + 16 * h;
    const int vfo = KT_BYTES + r * VP + (64 * kh + 8 * h) * 2;
    for (int ST = 0; ST < nST; ++ST) {
        if (ST + 1 < nST) MLA_DMA(ST + 1, ((ST + 1) & 1) * TB_BYTES);
        const int kt0 = 4 * ST + 2 * kh;
        if (kt0 <= qb) {
            const LAS unsigned char* tb = lds + (ST & 1) * TB_BYTES;
            f32x16 p0, p1;
            bf16x8 kf0[6], kf1[6];
#pragma unroll
            for (int s = 0; s < 6; ++s) { kf0[s] = *(const LAS bf16x8*)(tb + kfo + 32 * s); kf1[s] = *(const LAS bf16x8*)(tb + kfo + 32 * KP + 32 * s); }
            __builtin_amdgcn_sched_barrier(0);
            p0 = MFMA32(kf0[0], qf[0], negm); p1 = MFMA32(kf1[0], qf[0], negm);
#pragma unroll
            for (int s = 1; s < 6; ++s) { p0 = MFMA32(kf0[s], qf[s], p0); p1 = MFMA32(kf1[s], qf[s], p1); }
            bf16x8 vf0[4], vf1[4];
#pragma unroll
            for (int ks = 0; ks < 4; ++ks) { vf0[ks] = *(const LAS bf16x8*)(tb + vfo + 32 * ks); vf1[ks] = *(const LAS bf16x8*)(tb + vfo + 32 * VP + 32 * ks); }
            __builtin_amdgcn_sched_barrier(0);
            if (kt0 + 1 >= qb) {
                const int kb0 = 32 * kt0 + 8 * h;
#pragma unroll
                for (int i = 0; i < 16; ++i) { const int kv = kb0 + 16 * (i >> 3) + (i & 7); if (kv > q) p0[i] = -INFINITY; if (kv + 32 > q) p1[i] = -INFINITY; }
            }
            float ra_ = MX3(p0[0], p0[1], p1[0]), rb_ = MX3(p0[2], p0[3], p1[1]); ra_ = MX3(ra_, p1[2], p1[3]);
#pragma unroll
            for (int i = 4; i < 16; i += 4) { ra_ = MX3(ra_, p0[i], p0[i + 1]); rb_ = MX3(rb_, p0[i + 2], p0[i + 3]); ra_ = MX3(ra_, p1[i], p1[i + 1]); rb_ = MX3(rb_, p1[i + 2], p1[i + 3]); }
            const float rm = xh_max(fmaxf(ra_, rb_));
            if (first || __any(rm > 6.f)) {
                const float dl = first ? rm : fmaxf(rm, 0.f);
                m += dl;
#pragma unroll
                for (int i = 0; i < 16; ++i) { p0[i] -= dl; p1[i] -= dl; negm[i] = -m; }
                if (!first) { const float f = ex2(-dl); l *= f;
#pragma unroll
                    for (int i = 0; i < 16; ++i) { const float fi = __shfl(f, crow(i, h)); o0[i] *= fi; o1[i] *= fi; } }
                first = false;
            }
            float ls = 0.f;
#pragma unroll
            for (int i = 0; i < 16; ++i) { p0[i] = ex2(p0[i]); p1[i] = ex2(p1[i]); ls += p0[i] + p1[i]; }
            l += ls;
            float e[8];
#pragma unroll
            for (int ks = 0; ks < 4; ++ks) {
#pragma unroll
                for (int j = 0; j < 8; ++j) e[j] = (ks < 2) ? p0[8 * ks + j] : p1[8 * (ks - 2) + j];
                const bf16x8 pa = pack8(e);
                o0 = MFMA32(pa, vf0[ks], o0); o1 = MFMA32(pa, vf1[ks], o1);
            }
        }
        MLA_DMA_WAIT();
        __syncthreads();
    }
#undef MLA_DMA
#undef MLA_DMA_WAIT
    if (first) m = -1e30f;
    l = xh_sum(l);
    LAS float* mg = (LAS float*)(lds + MRG_OFF) + w4 * (34 * 64) + lane;
    if (kh == 1) {
#pragma unroll
        for (int i = 0; i < 16; ++i) { mg[i * 64] = o0[i]; mg[(16 + i) * 64] = o1[i]; }
        mg[32 * 64] = m; mg[33 * 64] = l;
    }
    __syncthreads();
    if (kh == 0) {
        const float mb = mg[32 * 64], lb = mg[33 * 64];
        const float mn = fmaxf(m, mb), fa = ex2(m - mn), fb = ex2(mb - mn), inv = 1.f / (l * fa + lb * fb), ga = fa * inv, gb = fb * inv;
        LAS bf16_t* stg = (LAS bf16_t*)(lds + wave * 4096);
        LAS bf16_t* sp = stg + (4 * h) * 64 + r;
#pragma unroll
        for (int i = 0; i < 16; ++i) { const float ra = __shfl(ga, crow(i, h)), rb = __shfl(gb, crow(i, h)); const int ro = ((i & 3) + 8 * (i >> 2)) * 64;
            sp[ro] = f2bf(o0[i] * ra + mg[i * 64] * rb); sp[ro + 32] = f2bf(o1[i] * ra + mg[(16 + i) * 64] * rb); }
        o_flush(stg, Y + ((size_t)b * SEQ + 32 * qb) * DM + 512 + hh * 64, DM, lane);
    }
    __syncthreads();
}

__device__ __forceinline__ void sb_unit(const bf16_t* __restrict__ Qrow0, int qpitch, const bf16_t* __restrict__ Kb, int kpitch, const bf16_t* __restrict__ VT,
                                        int qb, bf16_t* __restrict__ Orow0, int opitch, int lane, LAS bf16_t* stg) {
    const int r = lane & 31, h = lane >> 5;
    const int pr = (r & ~12) | ((r & 8) >> 1) | ((r & 4) << 1);
    bf16x8 qf[4];
#pragma unroll
    for (int s = 0; s < 4; ++s) qf[s] = *(const bf16x8*)(Qrow0 + (size_t)r * qpitch + 16 * s + 8 * h);
    f32x16 o0, o1;
#pragma unroll
    for (int i = 0; i < 16; ++i) { o0[i] = 0.f; o1[i] = 0.f; }
    float carry = 0.f;
    const int q = 32 * qb + r;
    const bf16_t* kp = Kb + (size_t)(32 * qb + pr) * kpitch + 8 * h;
    const bf16_t* vp = VT + (size_t)r * SEQ + 32 * qb + 8 * h;
    bf16x8 kf[4];
#pragma unroll
    for (int s = 0; s < 4; ++s) kf[s] = *(const bf16x8*)(kp + 16 * s);
    for (int kt = qb; kt >= 0; --kt) {
        bf16x8 kn[4];
        if (kt > 0) {
#pragma unroll
            for (int s = 0; s < 4; ++s) kn[s] = *(const bf16x8*)(kp - (size_t)32 * kpitch + 16 * s);
        } else {
#pragma unroll
            for (int s = 0; s < 4; ++s) kn[s] = kf[s];
        }
        const bf16x8 v00 = *(const bf16x8*)(vp), v01 = *(const bf16x8*)(vp + 32 * SEQ), v10 = *(const bf16x8*)(vp + 16), v11 = *(const bf16x8*)(vp + 32 * SEQ + 16);
        f32x16 p;
#pragma unroll
        for (int i = 0; i < 16; ++i) p[i] = 0.f;
#pragma unroll
        for (int s = 0; s < 4; ++s) p = MFMA32(kf[s], qf[s], p);
        const bool diag = (kt == qb);
        const int k0 = 32 * kt + 8 * h;
        float sfx[16];
#pragma unroll
        for (int i = 0; i < 16; ++i) {
            const float z = p[i];
            float L = -(fmaxf(z, 0.f) + lg2(1.f + ex2(-fabsf(z))));
            if (diag) { const int kv = k0 + 16 * (i >> 3) + (i & 7); if (!(kv < q)) L = 0.f; }
            sfx[i] = L;
        }
#pragma unroll
        for (int g = 0; g < 2; ++g)
#pragma unroll
            for (int j = 6; j >= 0; --j) sfx[8 * g + j] += sfx[8 * g + j + 1];
        const float T0 = sfx[0], T1 = sfx[8];
        const float TP0 = __shfl_xor(T0, 32), TP1 = __shfl_xor(T1, 32);
        const float off1 = (h ? 0.f : TP1) + carry, off0 = T1 + TP1 + (h ? 0.f : TP0) + carry;
        float e[16];
#pragma unroll
        for (int i = 0; i < 16; ++i) {
            float a = ex2(p[i] + sfx[i] + (i < 8 ? off0 : off1));
            if (diag) { const int kv = k0 + 16 * (i >> 3) + (i & 7); if (!(kv < q)) a = 0.f; }
            e[i] = a;
        }
        carry += (T0 + T1) + (TP0 + TP1);
        const bf16x8 pa0 = pack8(e), pa1 = pack8(e + 8);
        o0 = MFMA32(pa0, v00, o0); o1 = MFMA32(pa0, v01, o1);
        o0 = MFMA32(pa1, v10, o0); o1 = MFMA32(pa1, v11, o1);
        if (__all(carry < -150.f)) break;
#pragma unroll
        for (int s = 0; s < 4; ++s) kf[s] = kn[s];
        kp -= (size_t)32 * kpitch; vp -= 32;
    }
    LAS bf16_t* sp = stg + (4 * h) * 64 + r;
#pragma unroll
    for (int i = 0; i < 16; ++i) { const int ro = ((i & 3) + 8 * (i >> 2)) * 64; sp[ro] = f2bf(o0[i]); sp[ro + 32] = f2bf(o1[i]); }
    o_flush(stg, Orow0, opitch, lane);
}


constexpr int AKP = 144;
constexpr int SWA_NK = 384, SWA_VP = SWA_NK * 2 + 16, SWA_KB = SWA_NK * AKP;
constexpr int SB_NK = 448, SB_VP = SB_NK * 2 + 16, SB_KB = SB_NK * AKP;
constexpr int STG_OFF = 122880, MISC_OFF = STG_OFF + 8 * 4096;
static_assert(SWA_KB + 64 * SWA_VP <= STG_OFF && SB_KB + 64 * SB_VP <= STG_OFF && MISC_OFF + 1024 == LDS_BYTES, "window LDS map");
template <int NK, int VPB>
__device__ __forceinline__ void stage_kv64(const bf16_t* __restrict__ Kb, int kpitch, const bf16_t* __restrict__ VT, int key0, LAS unsigned char* lds, int tid) {
    constexpr int NCH = NK * 8 / 512, VC = NK / 8;
    u32x4 kr[NCH], vr[NCH];
#pragma unroll
    for (int i = 0; i < NCH; ++i) { const int c = tid + 512 * i, row = c >> 3, cc = c & 7; int key = key0 + row; key = key < 0 ? 0 : key;
        kr[i] = *(const u32x4*)(Kb + (size_t)key * kpitch + 8 * cc); }
#pragma unroll
    for (int i = 0; i < NCH; ++i) { const int c = tid + 512 * i, d = c / VC, cc = c - d * VC; int key = key0 + 8 * cc; key = key < 0 ? 0 : key;
        vr[i] = *(const u32x4*)(VT + (size_t)d * SEQ + key); }
#pragma unroll
    for (int i = 0; i < NCH; ++i) { const int c = tid + 512 * i, row = c >> 3, cc = c & 7; *(LAS u32x4*)(lds + row * AKP + 16 * cc) = kr[i]; }
#pragma unroll
    for (int i = 0; i < NCH; ++i) { const int c = tid + 512 * i, d = c / VC, cc = c - d * VC; *(LAS u32x4*)(lds + NK * AKP + d * VPB + 16 * cc) = vr[i]; }
}
template <int NK, int VPB>
__device__ __forceinline__ void stage_kv64_T(const bf16_t* __restrict__ Kb, int kpitch, const bf16_t* __restrict__ Vb, int vpitch, int key0, LAS unsigned char* lds, int tid) {
    constexpr int NCH = NK * 8 / 512, NB = NK / 32;
    const int lane = tid & 63, wave = __builtin_amdgcn_readfirstlane(tid >> 6), r = lane & 31, h = lane >> 5;
    u32x4 kr[NCH]; bf16x8 vv[2][4];
#pragma unroll
    for (int i = 0; i < NCH; ++i) { const int c = tid + 512 * i, row = c >> 3, cc = c & 7; int key = key0 + row; key = key < 0 ? 0 : key;
        kr[i] = *(const u32x4*)(Kb + (size_t)key * kpitch + 8 * cc); }
#pragma unroll
    for (int t = 0; t < 2; ++t) { const int tbk = wave + 8 * t; if (tbk < NB) { int key = key0 + 32 * tbk + r; key = key < 0 ? 0 : key;
#pragma unroll
        for (int c = 0; c < 4; ++c) vv[t][c] = *(const bf16x8*)(Vb + (size_t)key * vpitch + 32 * h + 8 * c); } }
#pragma unroll
    for (int i = 0; i < NCH; ++i) { const int c = tid + 512 * i, row = c >> 3, cc = c & 7; *(LAS u32x4*)(lds + row * AKP + 16 * cc) = kr[i]; }
#pragma unroll
    for (int t = 0; t < 2; ++t) { const int tbk = wave + 8 * t; if (tbk < NB) { LAS bf16_t* sp = (LAS bf16_t*)(lds + NK * AKP + (32 * h) * VPB) + 32 * tbk + r;
#pragma unroll
        for (int c = 0; c < 4; ++c)
#pragma unroll
            for (int j = 0; j < 8; ++j) sp[(8 * c + j) * (VPB / 2)] = (bf16_t)vv[t][c][j]; } }
}
__device__ __forceinline__ void swa_wave_lds(const bf16_t* __restrict__ Qrow0, int qpitch, const LAS unsigned char* lds, int qb, int kt_base, float sink2,
                                             bf16_t* __restrict__ Orow0, int opitch, int lane, LAS bf16_t* stg) {
    const int r = lane & 31, h = lane >> 5;
    const int pr = (r & ~12) | ((r & 8) >> 1) | ((r & 4) << 1);
    bf16x8 qf[4];
#pragma unroll
    for (int s = 0; s < 4; ++s) qf[s] = *(const bf16x8*)(Qrow0 + (size_t)r * qpitch + 16 * s + 8 * h);
    f32x16 o0, o1;
#pragma unroll
    for (int i = 0; i < 16; ++i) { o0[i] = 0.f; o1[i] = 0.f; }
    float m = -1e30f, l = 0.f;
    const int q = 32 * qb + r, kt_begin = qb - 4 > 0 ? qb - 4 : 0;
    for (int kt = kt_begin; kt <= qb; ++kt) {
        const int rel = kt - kt_base;
        const LAS unsigned char* kp = lds + (32 * rel + pr) * AKP + 16 * h;
        const LAS unsigned char* vp = lds + SWA_KB + r * SWA_VP + (32 * rel + 8 * h) * 2;
        f32x16 p;
#pragma unroll
        for (int i = 0; i < 16; ++i) p[i] = 0.f;
#pragma unroll
        for (int s = 0; s < 4; ++s) p = MFMA32(*(const LAS bf16x8*)(kp + 32 * s), qf[s], p);
        if (kt == qb || kt == qb - 4) {
            const int k0 = 32 * kt + 8 * h;
#pragma unroll
            for (int i = 0; i < 16; ++i) { const int kv = k0 + 16 * (i >> 3) + (i & 7); const bool ok = (kv <= q) && (kv > q - 128); if (!ok) p[i] = -INFINITY; }
        }
        float rm = MX3(p[0], p[1], p[2]);
#pragma unroll
        for (int i = 3; i < 15; i += 2) rm = MX3(rm, p[i], p[i + 1]);
        rm = xh_max(fmaxf(rm, p[15]));
        if (__any(rm > m + 6.f)) {
            const float mn = fmaxf(m, rm), f = ex2(m - mn); m = mn; l *= f;
#pragma unroll
            for (int i = 0; i < 16; ++i) { const float fi = __shfl(f, crow(i, h)); o0[i] *= fi; o1[i] *= fi; }
        }
        float e[16];
#pragma unroll
        for (int i = 0; i < 16; ++i) { e[i] = ex2(p[i] - m); l += e[i]; }
        const bf16x8 pa0 = pack8(e), pa1 = pack8(e + 8);
        o0 = MFMA32(pa0, *(const LAS bf16x8*)(vp), o0); o1 = MFMA32(pa0, *(const LAS bf16x8*)(vp + 32 * SWA_VP), o1);
        o0 = MFMA32(pa1, *(const LAS bf16x8*)(vp + 32), o0); o1 = MFMA32(pa1, *(const LAS bf16x8*)(vp + 32 * SWA_VP + 32), o1);
    }
    l = xh_sum(l);
    l += ex2(sink2 - m);
    const float inv = 1.f / l;
    LAS bf16_t* sp = stg + (4 * h) * 64 + r;
#pragma unroll
    for (int i = 0; i < 16; ++i) { const float fi = __shfl(inv, crow(i, h)); const int ro = ((i & 3) + 8 * (i >> 2)) * 64;
        sp[ro] = f2bf(o0[i] * fi); sp[ro + 32] = f2bf(o1[i] * fi); }
    o_flush(stg, Orow0, opitch, lane);
}
#define SB_STEP(KT_, V00_, V01_, V10_, V11_) do { \
        const bool diag = ((KT_) == qb); const int k0 = 32 * (KT_) + 8 * h; float sfx[16]; \
        _Pragma("unroll") for (int i = 0; i < 16; ++i) { const float z = p[i]; float L = -(fmaxf(z, 0.f) + lg2(1.f + ex2(-fabsf(z)))); \
            if (diag) { const int kv = k0 + 16 * (i >> 3) + (i & 7); if (!(kv < q)) L = 0.f; } sfx[i] = L; } \
        _Pragma("unroll") for (int g = 0; g < 2; ++g) _Pragma("unroll") for (int j = 6; j >= 0; --j) sfx[8 * g + j] += sfx[8 * g + j + 1]; \
        const float T0 = sfx[0], T1 = sfx[8]; const float TP0 = xh_other(T0, h), TP1 = xh_other(T1, h); \
        const float off1 = (h ? 0.f : TP1) + carry, off0 = T1 + TP1 + (h ? 0.f : TP0) + carry; float e[16]; \
        _Pragma("unroll") for (int i = 0; i < 16; ++i) { float a = ex2(p[i] + sfx[i] + (i < 8 ? off0 : off1)); \
            if (diag) { const int kv = k0 + 16 * (i >> 3) + (i & 7); if (!(kv < q)) a = 0.f; } e[i] = a; } \
        carry += (T0 + T1) + (TP0 + TP1); \
        const bf16x8 pa0 = pack8(e), pa1 = pack8(e + 8); \
        o0 = MFMA32(pa0, (V00_), o0); o1 = MFMA32(pa0, (V01_), o1); o0 = MFMA32(pa1, (V10_), o0); o1 = MFMA32(pa1, (V11_), o1); } while (0)
__device__ __forceinline__ void sb_wave_lds(const bf16_t* __restrict__ Qrow0, int qpitch, const LAS unsigned char* lds, const bf16_t* __restrict__ Kb, int kpitch,
                                            const bf16_t* __restrict__ Vb, int vpitch, int qb, int kt_base, bf16_t* __restrict__ Orow0, int opitch, int lane, LAS bf16_t* stg) {
    const int r = lane & 31, h = lane >> 5;
    const int pr = (r & ~12) | ((r & 8) >> 1) | ((r & 4) << 1);
    bf16x8 qf[4];
#pragma unroll
    for (int s = 0; s < 4; ++s) qf[s] = *(const bf16x8*)(Qrow0 + (size_t)r * qpitch + 16 * s + 8 * h);
    f32x16 o0, o1;
#pragma unroll
    for (int i = 0; i < 16; ++i) { o0[i] = 0.f; o1[i] = 0.f; }
    float carry = 0.f;
    const int q = 32 * qb + r;
    const int kt_lo = kt_base > 0 ? kt_base : 0;
    bool done = false;
    int kt = qb;
    for (; kt >= kt_lo; --kt) {
        const int rel = kt - kt_base;
        const LAS unsigned char* kp = lds + (32 * rel + pr) * AKP + 16 * h;
        const LAS unsigned char* vp = lds + SB_KB + r * SB_VP + (32 * rel + 8 * h) * 2;
        f32x16 p;
#pragma unroll
        for (int i = 0; i < 16; ++i) p[i] = 0.f;
#pragma unroll
        for (int s = 0; s < 4; ++s) p = MFMA32(*(const LAS bf16x8*)(kp + 32 * s), qf[s], p);
        SB_STEP(kt, *(const LAS bf16x8*)(vp), *(const LAS bf16x8*)(vp + 32 * SB_VP), *(const LAS bf16x8*)(vp + 32), *(const LAS bf16x8*)(vp + 32 * SB_VP + 32));
        if (__all(carry < -150.f)) { done = true; break; }
    }
    if (!done && kt >= 0) {
        const bf16_t* kp = Kb + (size_t)(32 * kt + pr) * kpitch + 8 * h;
        for (; kt >= 0; --kt) {
            bf16x8 kf[4];
#pragma unroll
            for (int s = 0; s < 4; ++s) kf[s] = *(const bf16x8*)(kp + 16 * s);
            bf16x8 v00, v01, v10, v11;
            { const bf16_t* vg = Vb + (size_t)(32 * kt + 8 * h) * vpitch + r;
#pragma unroll
              for (int j = 0; j < 8; ++j) { v00[j] = (short)vg[(size_t)j * vpitch]; v01[j] = (short)vg[(size_t)j * vpitch + 32]; v10[j] = (short)vg[(size_t)(16 + j) * vpitch]; v11[j] = (short)vg[(size_t)(16 + j) * vpitch + 32]; } }
            f32x16 p;
#pragma unroll
            for (int i = 0; i < 16; ++i) p[i] = 0.f;
#pragma unroll
            for (int s = 0; s < 4; ++s) p = MFMA32(kf[s], qf[s], p);
            SB_STEP(kt, v00, v01, v10, v11);
            if (__all(carry < -150.f)) break;
            kp -= (size_t)32 * kpitch;
        }
    }
    LAS bf16_t* sp = stg + (4 * h) * 64 + r;
#pragma unroll
    for (int i = 0; i < 16; ++i) { const int ro = ((i & 3) + 8 * (i >> 2)) * 64; sp[ro] = f2bf(o0[i]); sp[ro + 32] = f2bf(o1[i]); }
    o_flush(stg, Orow0, opitch, lane);
}
#undef SB_STEP

#define XB_TMO      128
#define XB_XCNT(j)  (256  + 64 * (j))
#define XB_XSUB(j)  (1280 + 64 * (j))
#define XB_XGEN(j)  (2304 + 64 * (j))
#define XB_TOP      3328
#define XB_TOPGEN   3392
#define XCD_BAR_WORDS 3456
#define XB_SPIN_CAP (1u << 18)

__device__ __forceinline__ unsigned xb_ld(unsigned* p)              { return __hip_atomic_load(p, __ATOMIC_RELAXED, __HIP_MEMORY_SCOPE_AGENT); }
__device__ __forceinline__ unsigned xb_add(unsigned* p, unsigned v) { return __hip_atomic_fetch_add(p, v, __ATOMIC_RELAXED, __HIP_MEMORY_SCOPE_AGENT); }
__device__ __forceinline__ unsigned xb_xcc_id() { return (unsigned)__builtin_amdgcn_s_getreg((3 << 11) | 20) & 0xFu; }
#define XB_SPIN(cond, bar) do { unsigned _sp = 0; while (cond) { __builtin_amdgcn_s_sleep(1); \
    if ((++_sp & 255u) == 0u) { if (xb_ld(&(bar)[XB_TMO])) break; if (_sp > XB_SPIN_CAP) { atomicAdd(&(bar)[XB_TMO], 1u); break; } } } } while (0)

struct XcdBarrier {
    unsigned* bar; unsigned x;
    volatile LAS unsigned* st;
};

__device__ __forceinline__ XcdBarrier xcd_barrier_post(unsigned* bar, volatile LAS unsigned* st) {
    XcdBarrier b; b.bar = bar; b.x = xb_xcc_id(); b.st = st;
    if (threadIdx.x == 0) (void)xb_add(&bar[XB_XCNT(b.x)], 1u);
    return b;
}
__device__ __forceinline__ void xcd_barrier_complete(unsigned* bar, unsigned x, unsigned& nloc, unsigned& nx) {
    const unsigned G = gridDim.x * gridDim.y * gridDim.z;
    unsigned sum, cnt, mine, sp = 0u;
    for (;;) {
        sum = 0u; cnt = 0u; mine = 0u;
#pragma unroll
        for (unsigned j = 0; j < 16; ++j) { const unsigned c = xb_ld(&bar[XB_XCNT(j)]); sum += c; cnt += (c > 0u) ? 1u : 0u; mine = (j == x) ? c : mine; }
        if (sum == G) break;
        __builtin_amdgcn_s_sleep(1);
        if ((++sp & 255u) == 0u) { if (xb_ld(&bar[XB_TMO])) break; if (sp > XB_SPIN_CAP) { atomicAdd(&bar[XB_TMO], 1u); break; } }
    }
    nloc = mine > 0u ? mine : 1u; nx = cnt > 0u ? cnt : 1u;
}

__device__ __forceinline__ void xcd_barrier(const XcdBarrier& b) {
    asm volatile("s_waitcnt vmcnt(0)" ::: "memory");
    __syncthreads();
    if (threadIdx.x == 0) {
        unsigned* bar = b.bar;
        __builtin_amdgcn_s_waitcnt(0);
        unsigned nloc = b.st[0], nx = b.st[1];
        if (nloc == 0u) { xcd_barrier_complete(bar, b.x, nloc, nx); b.st[0] = nloc; b.st[1] = nx; }
        const unsigned old = xb_add(&bar[XB_XSUB(b.x)], 1u);
        const unsigned gen = old / nloc;
        if (old + 1u == (gen + 1u) * nloc) {
            __builtin_amdgcn_fence(__ATOMIC_RELEASE, "agent");
            asm volatile("s_waitcnt vmcnt(0)" ::: "memory");
            const unsigned og = xb_add(&bar[XB_TOP], 1u);
            const unsigned tg = og / nx;
            if (og + 1u == (tg + 1u) * nx) xb_add(&bar[XB_TOPGEN], 1u);
            else XB_SPIN(xb_ld(&bar[XB_TOPGEN]) == tg, bar);
            __builtin_amdgcn_fence(__ATOMIC_ACQUIRE, "agent");
            xb_add(&bar[XB_XGEN(b.x)], 1u);
            asm volatile("s_waitcnt vmcnt(0)" ::: "memory");
        } else {
            XB_SPIN(xb_ld(&bar[XB_XGEN(b.x)]) == gen, bar);
            __builtin_amdgcn_fence(__ATOMIC_ACQUIRE, "agent");
            asm volatile("s_waitcnt vmcnt(0)" ::: "memory");
        }
    }
    __syncthreads();
}

__global__ void __launch_bounds__(NTHREADS, 2) fwd(Params P) {
    extern __shared__ __attribute__((aligned(16))) unsigned char lds_raw[];
    LAS unsigned char* lds = (LAS unsigned char*)lds_raw;
    constexpr int G = 256, NGW = G * NWAVES, gthreads = G * NTHREADS;
    const int bx = blockIdx.x;
#if MK_COOP
    cooperative_groups::grid_group grid = cooperative_groups::this_grid();
    volatile LAS unsigned* MISC = (volatile LAS unsigned*)(lds + MISC_OFF);
    if (threadIdx.x < 64) MISC[threadIdx.x] = 0u;
    __syncthreads();
    XcdBarrier bar = xcd_barrier_post((unsigned*)(P.ws + WS_CTL) + CW_BAR, MISC + 8);
#endif
    for (int ph = P.ph_lo; ph < P.ph_hi; ++ph) {
        const int nrep = ((ph >= 1 && ph <= 6 && ((ph - 1) == MK_REP_K || (MK_REP_K == 6 && ph == 3))) || (ph == 0 && MK_REP_K == 7)) ? MK_REP_N : 1;
        for (int rep = 0; rep < nrep; ++rep) {
        int tid_o = threadIdx.x; asm volatile("" : "+v"(tid_o));
        const int tid = tid_o, lane = tid & 63, wave = __builtin_amdgcn_readfirstlane(tid >> 6);
        const int gw = bx * NWAVES + wave, gtid = bx * NTHREADS + tid;
        LAS bf16_t* stg = (LAS bf16_t*)(lds + 122880 + wave * 4096);
        unsigned char* ws = P.ws; asm volatile("" : "+s"(ws));
        unsigned* ctl = (unsigned*)(ws + WS_CTL);
        bf16_t* XN = (bf16_t*)(ws + WS_XN); bf16_t* H = (bf16_t*)(ws + WS_H);
        bf16_t* QC = (bf16_t*)(ws + WS_QC); bf16_t* KC = (bf16_t*)(ws + WS_KC);
        bf16_t* VTC = (bf16_t*)(ws + WS_VTC); bf16_t* VTA = (bf16_t*)(ws + WS_VTA); bf16_t* VTD = (bf16_t*)(ws + WS_VTD);
        bf16_t* Y = (bf16_t*)(ws + WS_Y);
        if (ph == 0) {
            {
                LAS float* scr = (LAS float*)(lds + wave * 16384);
                constexpr int I_IN = (DM / 64) * (DIN / 32), I_OUT = (DM / 64) * (DM / 32), I_UQ = (256 / 64) * (384 / 32), I_UKV = (128 / 64) * (512 / 32), I_L = I_IN + I_OUT + I_UQ + I_UKV;
                for (int it = gw; it < NLAYER * I_L; it += NGW) {
                    const int l = it / I_L; int v = it - l * I_L;
                    if (v < I_IN) { wT_item(P.w_in + (size_t)l * DM * DIN, DM, DIN, P.norm_pre + l * DM, (bf16_t*)(ws + WS_WIN) + (size_t)l * DINP * DM, C_AQ, C_AQ + 256, C_DQ, C_DQ + 256, SC64, scr, v, lane); continue; } v -= I_IN;
                    if (v < I_OUT) { wT_item(P.w_out + (size_t)l * DM * DM, DM, DM, P.g_grp + l * DM, (bf16_t*)(ws + WS_WOUT) + (size_t)l * DM * DM, 0, 0, 0, 0, 1.f, scr, v, lane); continue; } v -= I_OUT;
                    if (v < I_UQ) { wT_item(P.w_uq + (size_t)l * 256 * 384, 256, 384, P.g_cq + l * 256, (bf16_t*)(ws + WS_WUQ + (size_t)l * 262144), 0, 0, 0, 0, 1.f, scr, v, lane); continue; } v -= I_UQ;
                    wT_item(P.w_ukv + (size_t)l * 128 * 512, 128, 512, P.g_ckv + l * 128, (bf16_t*)(ws + WS_WUKV + (size_t)l * 131072), 0, 0, 0, 0, 1.f, scr, v, lane);
                }
                for (int it = gtid; it < NLAYER * (DINP - DIN) * (DM / 8); it += gthreads) { const int l = it / ((DINP - DIN) * (DM / 8)), v = it - l * ((DINP - DIN) * (DM / 8));
                    *(u32x4*)((bf16_t*)(ws + WS_WIN) + (size_t)l * DINP * DM + (size_t)DIN * DM + (size_t)v * 8) = (u32x4){0u, 0u, 0u, 0u}; }
            }
            { const float* __restrict__ xr = P.x; bf16_t* __restrict__ xo = XN;
#pragma unroll 2
              for (int mrow = gw; mrow < M_TOK; mrow += NGW) rms_row_to_bf16(xr + (size_t)mrow * DM, xo + (size_t)mrow * DM, lane); }
        } else {
            const int l = (ph - 1) / 6, k = (ph - 1) % 6;
            if (k == 0 || k == 4) {
                if (k == 0) {
                    pg8::Gemm g{XN, (const bf16_t*)(ws + WS_WIN) + (size_t)l * DINP * DM, M_TOK, DINP, DM}; pg8::StaticOrder S; S.init(M_TOK, DINP, G, bx);
                    pg8::EpiBf16<0> E{H, DINP, nullptr, 0, 0, 1.f};
                    pg8::gemm_phase<pg8::EpiBf16<0>, pg8::StaticOrder, true, true>(lds, g, S, E);
                } else {
                    pg8::Gemm g{XN, (const bf16_t*)(ws + WS_WOUT) + (size_t)l * DM * DM, M_TOK, DM, DM}; pg8::StaticOrder S; S.init(M_TOK, DM, G, bx);
                    pg8::EpiBf16<0> E{Y, DM, nullptr, 0, 0, 1.f};
                    pg8::gemm_phase<pg8::EpiBf16<0>, pg8::StaticOrder, true, true>(lds, g, S, E);
                }
            } else if (k == 1) {
                const bf16_t* WUQ = (const bf16_t*)(ws + WS_WUQ + (size_t)l * 262144);
                const bf16_t* WUKV = (const bf16_t*)(ws + WS_WUKV + (size_t)l * 131072);
                {
                    const int hh = bx & 3, tg = bx >> 2;
                    u32x4 wq[6], wk[4];
#pragma unroll
                    for (int i = 0; i < 6; ++i) { const int c = tid + 512 * i, row = c >> 5, cc = c & 31; wq[i] = *(const u32x4*)(WUQ + (size_t)(hh * 96 + row) * 256 + 8 * cc); }
#pragma unroll
                    for (int i = 0; i < 4; ++i) { const int c = tid + 512 * i, row = c >> 4, cc = c & 15; wk[i] = *(const u32x4*)(WUKV + (size_t)(hh * 128 + row) * 128 + 8 * cc); }
#pragma unroll
                    for (int i = 0; i < 6; ++i) { const int c = tid + 512 * i, row = c >> 5, cc = c & 31; *(LAS u32x4*)(lds + row * WQP + 16 * cc) = wq[i]; }
#pragma unroll
                    for (int i = 0; i < 4; ++i) { const int c = tid + 512 * i, row = c >> 4, cc = c & 15; *(LAS u32x4*)(lds + WQ_BYTES + row * WKP + 16 * cc) = wk[i]; }
                    __syncthreads();
                    const int tb = 8 * tg + wave;
                    mq_unit(H, lds, P.pos, QC, tb, hh, lane);
                    mkv_unit(H, lds + WQ_BYTES, P.pos, KC, VTC, tb, hh, lane, stg);
                }
                constexpr int NTB = M_TOK / 32;
                constexpr int U_ALL = M_TOK / 8;
                for (int u = gw; u < U_ALL; u += NGW) {
                    const int v = u;
                    conv_unit(H, P.conv_w + l * 768, P.conv_b + l * 256, Y, v, lane);
                }
            } else if (k == 2) {
                if (rep == 0 || MK_REP_K == 2)
                for (int pu = bx; pu < 256; pu += G) {
                    const int bh = pu & 7, Gq = pu >> 3;
                    mla_unit_blk(QC, KC, VTC, Y, bh, 63 - Gq, lds, tid);
                    mla_unit_blk(QC, KC, VTC, Y, bh, Gq, lds, tid);
                }
                if (rep == 0 || MK_REP_K == 6) {
                    const int bh = bx & 7, G8 = bx >> 3, b = bh >> 2, hh = bh & 3, qb = 8 * G8 + wave;
                    const size_t row0 = (size_t)b * SEQ + 32 * qb;
                    LAS bf16_t* ostg = (LAS bf16_t*)(lds + STG_OFF + wave * 4096);
                    {
                        const int kvh = hh >> 1;
                        const bf16_t* Kb = H + (size_t)b * SEQ * DINP + C_AK + kvh * 64;
                        stage_kv64_T<SWA_NK, SWA_VP>(Kb, DINP, H + (size_t)b * SEQ * DINP + C_AV + kvh * 64, DINP, 256 * G8 - 128, lds, tid);
                        __syncthreads();
                        swa_wave_lds(H + row0 * DINP + C_AQ + hh * 64, DINP, lds, qb, 8 * G8 - 4, P.sinks[l * 4 + hh] * LOG2E, Y + row0 * DM + hh * 64, DM, lane, ostg);
                        __syncthreads();
                    }
                    {
                        const bf16_t* Kb = H + (size_t)b * SEQ * DINP + C_DK + hh * 64;
                        const bf16_t* Vb = H + (size_t)b * SEQ * DINP + C_DV + hh * 64;
                        stage_kv64_T<SB_NK, SB_VP>(Kb, DINP, Vb, DINP, 256 * G8 - 192, lds, tid);
                        __syncthreads();
                        sb_wave_lds(H + row0 * DINP + C_DQ + hh * 64, DINP, lds, Kb, DINP, Vb, DINP, qb, 8 * G8 - 6, Y + row0 * DM + 768 + hh * 64, DM, lane, ostg);
                        __syncthreads();
                    }
                }
            } else if (k == 3) {
                const bf16_t* __restrict__ Yr = Y; const bf16_t* __restrict__ Hr = H; bf16_t* __restrict__ XNw = XN;
#pragma unroll 2
                for (int mrow = gw; mrow < M_TOK; mrow += NGW) {
                    const u32x4* yp = (const u32x4*)(Yr + (size_t)mrow * DM) + 2 * lane;
                    const u32x4* gp = (const u32x4*)(Hr + (size_t)mrow * DINP + C_GATE) + 2 * lane;
                    const u32x4 y0 = yp[0], y1 = yp[1], g0 = gp[0], g1 = gp[1];
                    float yv[16], gv[16];
#pragma unroll
                    for (int j = 0; j < 4; ++j) { yv[2 * j] = bflo(y0[j]); yv[2 * j + 1] = bfhi(y0[j]); yv[8 + 2 * j] = bflo(y1[j]); yv[8 + 2 * j + 1] = bfhi(y1[j]);
                                                  gv[2 * j] = bflo(g0[j]); gv[2 * j + 1] = bfhi(g0[j]); gv[8 + 2 * j] = bflo(g1[j]); gv[8 + 2 * j + 1] = bfhi(g1[j]); }
                    float ss = 0.f;
#pragma unroll
                    for (int j = 0; j < 16; ++j) ss += yv[j] * yv[j];
                    ss += __shfl_xor(ss, 1); ss += __shfl_xor(ss, 2); ss += __shfl_xor(ss, 4); ss += __shfl_xor(ss, 8);
                    const float rs = rsqrtf(ss * (1.f / 256.f) + EPS);
                    float o[16];
#pragma unroll
                    for (int j = 0; j < 16; ++j) { const float gg = gv[j]; o[j] = yv[j] * rs * gg * __builtin_amdgcn_rcpf(1.f + ex2(-gg * LOG2E)); }
                    u32x4 w0, w1;
#pragma unroll
                    for (int j = 0; j < 4; ++j) { w0[j] = pk2(o[2 * j], o[2 * j + 1]); w1[j] = pk2(o[8 + 2 * j], o[8 + 2 * j + 1]); }
                    u32x4* op = (u32x4*)(XNw + (size_t)mrow * DM) + 2 * lane;
                    op[0] = w0; op[1] = w1;
                }
            } else {
                const float* base = P.x;
                const float* gpost = P.g_post + l * DM;
                for (int mrow0 = gw; mrow0 < M_TOK; mrow0 += 2 * NGW) {
                    f32x4 zz[2][4], xv[2][4]; float s1[2] = {0.f, 0.f}, s2[2] = {0.f, 0.f};
                    const bool two = (mrow0 + NGW < M_TOK);
#pragma unroll
                    for (int rr = 0; rr < 2; ++rr) { const int mrow = (rr == 0 || two) ? mrow0 + rr * NGW : mrow0;
#pragma unroll
                        for (int j = 0; j < 4; ++j) { const u32x2 w = __builtin_nontemporal_load((const u32x2*)(Y + (size_t)mrow * DM) + lane + 64 * j); zz[rr][j] = (f32x4){bflo(w.x), bfhi(w.x), bflo(w.y), bfhi(w.y)};
                            if (l == 0) xv[rr][j] = __builtin_nontemporal_load((const f32x4*)(base + (size_t)mrow * DM) + lane + 64 * j);
                            else { const u32x2 xb = __builtin_nontemporal_load((const u32x2*)(P.out + (size_t)mrow * DM) + lane + 64 * j); xv[rr][j] = (f32x4){bflo(xb.x), bfhi(xb.x), bflo(xb.y), bfhi(xb.y)}; } } }
                    f32x4 gpv[4];
#pragma unroll
                    for (int j = 0; j < 4; ++j) gpv[j] = ((const f32x4*)gpost)[lane + 64 * j];
#pragma unroll
                    for (int rr = 0; rr < 2; ++rr)
#pragma unroll
                        for (int j = 0; j < 4; ++j) s1[rr] += (zz[rr][j].x * zz[rr][j].x + zz[rr][j].y * zz[rr][j].y) + (zz[rr][j].z * zz[rr][j].z + zz[rr][j].w * zz[rr][j].w);
                    const float rz0 = rsqrtf(wave_sum(s1[0]) * (1.f / DM) + EPS), rz1 = rsqrtf(wave_sum(s1[1]) * (1.f / DM) + EPS);
#pragma unroll
                    for (int rr = 0; rr < 2; ++rr) { const float rz = rr ? rz1 : rz0;
#pragma unroll
                        for (int j = 0; j < 4; ++j) { xv[rr][j] = xv[rr][j] + zz[rr][j] * rz * gpv[j];
                            s2[rr] += (xv[rr][j].x * xv[rr][j].x + xv[rr][j].y * xv[rr][j].y) + (xv[rr][j].z * xv[rr][j].z + xv[rr][j].w * xv[rr][j].w); } }
#pragma unroll
                    for (int rr = 0; rr < 2; ++rr) { if (rr == 1 && !two) break; const int mrow = mrow0 + rr * NGW;
#pragma unroll
                        for (int j = 0; j < 4; ++j) {
                            if (l + 1 < NLAYER) { u32x2 o; o.x = pk2(xv[rr][j].x, xv[rr][j].y); o.y = pk2(xv[rr][j].z, xv[rr][j].w); __builtin_nontemporal_store(o, (u32x2*)(P.out + (size_t)mrow * DM) + lane + 64 * j); }
                            else __builtin_nontemporal_store(xv[rr][j], (f32x4*)(P.out + (size_t)mrow * DM) + lane + 64 * j); } }
                    if (l + 1 < NLAYER) {
                        const float r0 = rsqrtf(wave_sum(s2[0]) * (1.f / DM) + EPS), r1 = rsqrtf(wave_sum(s2[1]) * (1.f / DM) + EPS);
#pragma unroll
                        for (int rr = 0; rr < 2; ++rr) { if (rr == 1 && !two) break; const int mrow = mrow0 + rr * NGW; const float rs = rr ? r1 : r0;
#pragma unroll
                            for (int j = 0; j < 4; ++j) { u32x2 o; o.x = pk2(xv[rr][j].x * rs, xv[rr][j].y * rs); o.y = pk2(xv[rr][j].z * rs, xv[rr][j].w * rs); ((u32x2*)(XN + (size_t)mrow * DM))[lane + 64 * j] = o; } }
                    }
                }
            }
            }
        }
        if (ph + 1 < P.ph_hi) {
#if MK_COOP
            if (P.ph_hi < 0) grid.sync();
            xcd_barrier(bar);
#endif
        }
    }
}
}

extern "C" void kernel_launch(void* const* d_in, const int* in_sizes, int n_in, void* d_out, int out_size, void* d_ws, size_t ws_size, hipStream_t stream) {
    using namespace mk;
    static int grid = 0;
    if (grid == 0) {
        if (n_in != 14 || out_size != M_TOK * DM || ws_size < WS_END) { fprintf(stderr, "kernel_launch: unexpected shapes (n_in %d out %d ws %zu)\n", n_in, out_size, ws_size); grid = -1; return; }
        int dev = 0, cus = 0, per_cu = 0;
        (void)hipGetDevice(&dev); (void)hipDeviceGetAttribute(&cus, hipDeviceAttributeMultiprocessorCount, dev);
        if (hipFuncSetAttribute((const void*)fwd, hipFuncAttributeMaxDynamicSharedMemorySize, LDS_BYTES) != hipSuccess) { fprintf(stderr, "kernel_launch: hipFuncSetAttribute failed\n"); grid = -1; return; }
        if (hipOccupancyMaxActiveBlocksPerMultiprocessor(&per_cu, (const void*)fwd, NTHREADS, LDS_BYTES) != hipSuccess || per_cu < 1) { fprintf(stderr, "kernel_launch: occupancy query says %d\n", per_cu); per_cu = 1; }
        (void)hipGetLastError();
        if (cus < 256) { fprintf(stderr, "kernel_launch: built for a 256-CU device (one workgroup per CU), found %d CUs\n", cus); grid = -1; return; }
        grid = 256;
    }
    if (grid < 0) return;
    (void)hipMemsetAsync((char*)d_ws + WS_CTL, 0, CTL_BYTES, stream);
    Params p{};
    p.x = (const float*)d_in[0]; p.pos = (const int*)d_in[1]; p.norm_pre = (const float*)d_in[2]; p.w_in = (const float*)d_in[3]; p.sinks = (const float*)d_in[4];
    p.conv_w = (const float*)d_in[5]; p.conv_b = (const float*)d_in[6]; p.g_cq = (const float*)d_in[7]; p.w_uq = (const float*)d_in[8]; p.g_ckv = (const float*)d_in[9];
    p.w_ukv = (const float*)d_in[10]; p.g_grp = (const float*)d_in[11]; p.w_out = (const float*)d_in[12]; p.g_post = (const float*)d_in[13];
    p.out = (float*)d_out; p.ws = (unsigned char*)d_ws;
    constexpr int NPH = 1 + 6 * NLAYER;
#if MK_COOP
    p.ph_lo = 0; p.ph_hi = NPH;
    void* args[] = {&p};
    hipError_t e = hipLaunchCooperativeKernel((const void*)fwd, dim3(grid), dim3(NTHREADS), args, LDS_BYTES, stream);
    if (e != hipSuccess) fprintf(stderr, "kernel_launch: cooperative launch failed: %s (grid %d)\n", hipGetErrorString(e), grid);
#else
    for (int ph = 0; ph < NPH; ++ph) { p.ph_lo = ph; p.ph_hi = ph + 1; hipLaunchKernelGGL(fwd, dim3(grid), dim3(NTHREADS), LDS_BYTES, stream, p); }
#endif
}
```
